# Optimizing an MI355X kernel written in HIP

```python
import jax, jax.numpy as jnp
from jax import lax
import numpy as np

D_MODEL = 1024
BATCH = 8
SEQ = 4096
DEPTH = 2
DEC_BATCH = 16
DEC_SEQ = 32
PAST_LEN = 1024

CHUNK = 64
EXPAND = 2
MIX_WIDTH = EXPAND * D_MODEL
N_A_LAYERS = DEPTH // 2
N_B_LAYERS = DEPTH - N_A_LAYERS
RWKV_HEAD = 64
RWKV_HEADS = MIX_WIDTH // RWKV_HEAD
DECAY_RANK = 64
ICLR_RANK = 64
SB_HEAD = 128
SB_HEADS = MIX_WIDTH // SB_HEAD
BLOCK_Q = 128
RMS_EPS = 1e-6
GN_EPS = 64e-5
L2_EPS = 1e-12

kernel_name = "yoco_rwkv7_stickbreaking_stream"


def rms_norm(x, g):
    xf = x.astype(jnp.float32)
    y = xf * lax.rsqrt(jnp.mean(xf * xf, axis=-1, keepdims=True) + RMS_EPS)
    return y.astype(x.dtype) * g


def ada_modulate(x, c, g, w_ada, b_ada):
    shift, scale, gate = jnp.split(c @ w_ada + b_ada, 3, axis=-1)
    h = rms_norm(x, g) * (1 + scale[:, None]) + shift[:, None]
    return h, gate[:, None]


def l2_normalize(x):
    xf = x.astype(jnp.float32)
    return (xf * lax.rsqrt(jnp.sum(xf * xf, axis=-1, keepdims=True) + L2_EPS)).astype(x.dtype)


def rwkv7_recurrence(r, decay, k, v, kk, a, s0):
    def step(s, inp):
        r_t, w_t, k_t, v_t, kk_t, a_t = inp
        s_kk = jnp.einsum('bhvk,bhk->bhv', s, kk_t)
        s = (s * w_t[:, :, None, :]
             - s_kk[..., None] * (kk_t * a_t)[:, :, None, :]
             + v_t[..., None] * k_t[:, :, None, :])
        return s, jnp.einsum('bhvk,bhk->bhv', s, r_t)
    xs = tuple(jnp.swapaxes(t.astype(jnp.float32), 0, 1) for t in (r, decay, k, v, kk, a))
    s_fin, ys = lax.scan(step, s0.astype(jnp.float32), xs)
    return jnp.swapaxes(ys, 0, 1).astype(v.dtype), s_fin.astype(s0.dtype)


def rwkv7_layer(x, c, shift_prev, s0, norm_g, ada_w, ada_b, w_in, mu_in, mu_w, mu_a,
                w0, w1, w2, a0, a1, a2, k_k, k_a, r_k, ln_g, ln_b, w_out):
    B, T, _ = x.shape
    h, gate = ada_modulate(x, c, norm_g, ada_w, ada_b)
    h_prev = jnp.concatenate([shift_prev[:, None].astype(h.dtype), h[:, :-1]], axis=1)
    dx = h_prev - h
    w_mu = (w_in.reshape(D_MODEL, 4, MIX_WIDTH) * mu_in.T[:, :, None]).reshape(D_MODEL, 4 * MIX_WIDTH)
    proj = jnp.concatenate([h, dx], axis=-1) @ jnp.concatenate([w_in, w_mu], axis=0)
    r, k, v, z = jnp.split(proj, 4, axis=-1)
    xw = h + dx * mu_w
    xa = h + dx * mu_a
    w_log = -jax.nn.softplus(-(w0 + jnp.tanh(xw @ w1) @ w2)) - 0.5
    decay = jnp.exp(-jnp.exp(w_log.astype(jnp.float32)))
    a = jax.nn.sigmoid(a0 + (xa @ a1) @ a2)
    heads = lambda t: t.reshape(B, T, RWKV_HEADS, RWKV_HEAD)
    r, k, v, a, decay = heads(r), heads(k), heads(v), heads(a), heads(decay)
    kk = l2_normalize(k * k_k.reshape(RWKV_HEADS, RWKV_HEAD))
    k = k * (1 + (a - 1) * k_a.reshape(RWKV_HEADS, RWKV_HEAD))
    y, s_new = rwkv7_recurrence(r, decay, k, v, kk, a, s0)
    yf = y.astype(jnp.float32)
    mean = jnp.mean(yf, axis=-1, keepdims=True)
    var = jnp.mean(jnp.square(yf - mean), axis=-1, keepdims=True)
    y = ((yf - mean) * lax.rsqrt(var + GN_EPS)).astype(y.dtype)
    y = y * ln_g.reshape(RWKV_HEADS, RWKV_HEAD) + ln_b.reshape(RWKV_HEADS, RWKV_HEAD)
    y = y + jnp.sum(r * k * r_k, axis=-1, keepdims=True) * v
    y = y.reshape(B, T, MIX_WIDTH) * jax.nn.silu(z)
    return x + gate * (y @ w_out), h[:, -1], s_new


def head_rms(x, g):
    xf = x.astype(jnp.float32)
    y = xf * lax.rsqrt(jnp.mean(xf * xf, axis=-1, keepdims=True) + RMS_EPS)
    return y.astype(x.dtype) * g


def shared_kv(x_mid, kv_norm_g, kv_w, k_gain):
    B, T, _ = x_mid.shape
    k, v = jnp.split(rms_norm(x_mid, kv_norm_g) @ kv_w, 2, axis=-1)
    k = head_rms(k.reshape(B, T, SB_HEADS, SB_HEAD), k_gain)
    return k, v.reshape(B, T, SB_HEADS, SB_HEAD)


def sb_block(q, k, v, q_start):
    Tq, Tk = q.shape[1], k.shape[1]
    z = jnp.einsum('bqhd,bkhd->bhqk', q, k).astype(jnp.float32) * (SB_HEAD ** -0.5)
    q_pos = q_start + jnp.arange(Tq)
    k_pos = jnp.arange(Tk)
    mask = k_pos[None, :] < q_pos[:, None]
    log_stay = jnp.where(mask, jax.nn.log_sigmoid(-z), 0.0)
    tail = lax.cumsum(log_stay, axis=3, reverse=True) - log_stay
    weights = jnp.where(mask, jnp.exp(jax.nn.log_sigmoid(z) + tail), 0.0)
    return jnp.einsum('bhqk,bkhd->bqhd', weights.astype(v.dtype), v)


def sb_sweep(q, k, v, offset):
    T = q.shape[1]
    outs = []
    for s in range(0, T, BLOCK_Q):
        e = min(s + BLOCK_Q, T)
        outs.append(sb_block(q[:, s:e], k[:, :offset + e], v[:, :offset + e], offset + s))
    return jnp.concatenate(outs, axis=1)


def sb_layer(x, c, k_all, v_all, offset, norm_g, ada_w, ada_b, w_in, q_gain, w_out):
    B, T, _ = x.shape
    h, gate = ada_modulate(x, c, norm_g, ada_w, ada_b)
    q, z = jnp.split(h @ w_in, 2, axis=-1)
    q = head_rms(q.reshape(B, T, SB_HEADS, SB_HEAD), q_gain)
    o = sb_sweep(q, k_all, v_all, offset).reshape(B, T, MIX_WIDTH)
    return x + gate * ((o * jax.nn.silu(z)) @ w_out)


def trunk(x, c, past_k, past_v, shift0, wkv0, p):
    new_shift, new_wkv = [], []
    k_new = v_new = k_all = v_all = None
    offset = 0 if past_k is None else past_k.shape[1]
    for layer in range(DEPTH):
        if layer < N_A_LAYERS:
            i = layer
            x, sh, s = rwkv7_layer(
                x, c, shift0[i], wkv0[i], p['a_norm_g'][i], p['a_ada_w'][i], p['a_ada_b'][i],
                p['a_w_in'][i], p['a_mu_in'][i], p['a_mu_w'][i], p['a_mu_a'][i],
                p['a_w0'][i], p['a_w1'][i], p['a_w2'][i], p['a_a0'][i], p['a_a1'][i], p['a_a2'][i],
                p['a_k_k'][i], p['a_k_a'][i], p['a_r_k'][i], p['a_ln_g'][i], p['a_ln_b'][i],
                p['a_w_out'][i])
            new_shift.append(sh)
            new_wkv.append(s)
            if layer == N_A_LAYERS - 1:
                k_new, v_new = shared_kv(x, p['kv_norm_g'], p['kv_w'], p['k_gain'])
                if past_k is None:
                    k_all, v_all = k_new, v_new
                else:
                    k_all = jnp.concatenate([past_k.astype(k_new.dtype), k_new], axis=1)
                    v_all = jnp.concatenate([past_v.astype(v_new.dtype), v_new], axis=1)
        else:
            j = layer - N_A_LAYERS
            x = sb_layer(x, c, k_all, v_all, offset, p['b_norm_g'][j], p['b_ada_w'][j],
                         p['b_ada_b'][j], p['b_w_in'][j], p['b_q_gain'][j], p['b_w_out'][j])
    return x, k_new, v_new, jnp.stack(new_wkv), jnp.stack(new_shift)


def setup_inputs(seed: int = 0) -> dict:
    key = jax.random.key(seed)
    ks = iter(jax.random.split(key, 48))
    f32 = jnp.float32
    nrm = lambda shape, s: jax.random.normal(next(ks), shape, f32) * s
    uni = lambda shape: jax.random.uniform(next(ks), shape, f32)
    D, E, NA, NB = D_MODEL, MIX_WIDTH, N_A_LAYERS, N_B_LAYERS
    return {
        'x_prompt': nrm((BATCH, SEQ, D), 1.0),
        'x_sample': nrm((DEC_BATCH, DEC_SEQ, D), 1.0),
        'cache_k': nrm((DEC_BATCH, PAST_LEN, SB_HEADS, SB_HEAD), 1.0),
        'cache_v': nrm((DEC_BATCH, PAST_LEN, SB_HEADS, SB_HEAD), 1.0),
        'state_wkv': nrm((NA, DEC_BATCH, RWKV_HEADS, RWKV_HEAD, RWKV_HEAD), RWKV_HEAD ** -0.5),
        'state_shift': nrm((NA, DEC_BATCH, D), 1.0),
        'c_prompt': nrm((BATCH, D), 1.0),
        'c_sample': nrm((DEC_BATCH, D), 1.0),
        'a_norm_g': 1.0 + nrm((NA, D), 0.05),
        'a_ada_w': nrm((NA, D, 3 * D), 0.5 * D ** -0.5),
        'a_ada_b': nrm((NA, 3 * D), 0.01),
        'a_w_in': nrm((NA, D, 4 * E), D ** -0.5),
        'a_mu_in': uni((NA, 4, D)),
        'a_mu_w': uni((NA, D)),
        'a_mu_a': uni((NA, D)),
        'a_w0': nrm((NA, E), 0.5),
        'a_w1': nrm((NA, D, DECAY_RANK), D ** -0.5),
        'a_w2': nrm((NA, DECAY_RANK, E), 0.5 * DECAY_RANK ** -0.5),
        'a_a0': nrm((NA, E), 0.5),
        'a_a1': nrm((NA, D, ICLR_RANK), D ** -0.5),
        'a_a2': nrm((NA, ICLR_RANK, E), 0.5 * ICLR_RANK ** -0.5),
        'a_k_k': 0.85 + nrm((NA, E), 0.05),
        'a_k_a': 1.0 + nrm((NA, E), 0.05),
        'a_r_k': nrm((NA, RWKV_HEADS, RWKV_HEAD), 0.1),
        'a_ln_g': 1.0 + nrm((NA, E), 0.05),
        'a_ln_b': nrm((NA, E), 0.01),
        'a_w_out': nrm((NA, E, D), E ** -0.5),
        'kv_norm_g': 1.0 + nrm((D,), 0.05),
        'kv_w': nrm((D, 2 * E), D ** -0.5),
        'k_gain': 1.0 + nrm((SB_HEAD,), 0.05),
        'b_norm_g': 1.0 + nrm((NB, D), 0.05),
        'b_ada_w': nrm((NB, D, 3 * D), 0.5 * D ** -0.5),
        'b_ada_b': nrm((NB, 3 * D), 0.01),
        'b_w_in': nrm((NB, D, 2 * E), D ** -0.5),
        'b_q_gain': 1.0 + nrm((NB, SB_HEAD), 0.05),
        'b_w_out': nrm((NB, E, D), E ** -0.5),
    }


def reference(x_prompt, x_sample, cache_k, cache_v, state_wkv, state_shift, c_prompt, c_sample,
              a_norm_g, a_ada_w, a_ada_b, a_w_in, a_mu_in, a_mu_w, a_mu_a, a_w0, a_w1, a_w2,
              a_a0, a_a1, a_a2, a_k_k, a_k_a, a_r_k, a_ln_g, a_ln_b, a_w_out,
              kv_norm_g, kv_w, k_gain,
              b_norm_g, b_ada_w, b_ada_b, b_w_in, b_q_gain, b_w_out):
    p = dict(a_norm_g=a_norm_g, a_ada_w=a_ada_w, a_ada_b=a_ada_b, a_w_in=a_w_in, a_mu_in=a_mu_in,
             a_mu_w=a_mu_w, a_mu_a=a_mu_a, a_w0=a_w0, a_w1=a_w1, a_w2=a_w2, a_a0=a_a0,
             a_a1=a_a1, a_a2=a_a2, a_k_k=a_k_k, a_k_a=a_k_a, a_r_k=a_r_k, a_ln_g=a_ln_g,
             a_ln_b=a_ln_b, a_w_out=a_w_out, kv_norm_g=kv_norm_g, kv_w=kv_w, k_gain=k_gain,
             b_norm_g=b_norm_g, b_ada_w=b_ada_w, b_ada_b=b_ada_b, b_w_in=b_w_in,
             b_q_gain=b_q_gain, b_w_out=b_w_out)
    bp = x_prompt.shape[0]
    shift0_p = jnp.zeros((N_A_LAYERS, bp, D_MODEL), x_prompt.dtype)
    wkv0_p = jnp.zeros((N_A_LAYERS, bp, RWKV_HEADS, RWKV_HEAD, RWKV_HEAD), x_prompt.dtype)
    y_prompt, k_prompt, v_prompt, wkv_prompt, shift_prompt = trunk(
        x_prompt, c_prompt, None, None, shift0_p, wkv0_p, p)
    y_sample, k_sample, v_sample, wkv_sample, shift_sample = trunk(
        x_sample, c_sample, cache_k, cache_v, state_shift, state_wkv, p)
    return (y_prompt, y_sample, k_prompt, v_prompt, wkv_prompt, shift_prompt,
            k_sample, v_sample, wkv_sample, shift_sample)
```

```cpp
#include <hip/hip_runtime.h>
#include <hip/hip_cooperative_groups.h>
#include <cstdio>
namespace cg = cooperative_groups;

typedef unsigned short u16;
typedef short bf16x8 __attribute__((ext_vector_type(8)));
typedef short s16x4 __attribute__((ext_vector_type(4)));
typedef float f32x4 __attribute__((ext_vector_type(4)));
typedef float f32x2 __attribute__((ext_vector_type(2)));
typedef __bf16 bf16x2_t __attribute__((ext_vector_type(2)));

#define DEV __device__ __forceinline__

#define NTOK 33280
#define TP 32768
#define NTHREADS 512

#define OFF_Y_P 0
#define OFF_Y_S 33554432
#define OFF_K_P 34078720
#define OFF_V_P 101187584
#define OFF_WKV_P 168296448
#define OFF_SH_P 169345024
#define OFF_K_S 169353216
#define OFF_V_S 170401792
#define OFF_WKV_S 171450368
#define OFF_SH_S 173547520

#define SLOT 136314880ull
#define WS_W (7ull * SLOT)
#define WS_WT_IN (WS_W)
#define WS_WT_OUTA (WS_WT_IN + 16777216ull)
#define WS_WT_KV (WS_WT_OUTA + 4194304ull)
#define WS_WT_INB (WS_WT_KV + 8388608ull)
#define WS_WT_OUTB (WS_WT_INB + 8388608ull)
#define WS_W2T (WS_WT_OUTB + 4194304ull)
#define WS_A2T (WS_W2T + 262144ull)
#define WS_L1T (WS_A2T + 262144ull)
#define WS_MOD (WS_L1T + 524288ull)
#define WS_SH (WS_MOD + 589824ull)
#define WS_END (WS_SH + 49152ull)
#define WS_H0 (6ull * SLOT)
#define WS_T (6ull * SLOT + 68157440ull)

struct Params {
  const float* in[36];
  float* out;
  char* ws;
};

enum { I_XP = 0, I_XS, I_CK, I_CV, I_SWKV, I_SSH, I_CP, I_CS, I_ANG, I_AADAW, I_AADAB, I_AWIN, I_AMUIN, I_AMUW, I_AMUA,
       I_AW0, I_AW1, I_AW2, I_AA0, I_AA1, I_AA2, I_AKK, I_AKA, I_ARK, I_ALNG, I_ALNB, I_AWOUT, I_KVNG, I_KVW, I_KGAIN,
       I_BNG, I_BADAW, I_BADAB, I_BWIN, I_BQG, I_BWOUT };

DEV int seq_of(int t) { return t < TP ? (t >> 12) : 8 + ((t - TP) >> 5); }
DEV bool seq_start(int t) { return t < TP ? ((t & 4095) == 0) : (((t - TP) & 31) == 0); }

DEV unsigned pack2(float a, float b) {
  f32x2 v = {a, b};
  bf16x2_t r = __builtin_convertvector(v, bf16x2_t);
  return *(unsigned*)&r;
}
DEV float bflo(unsigned w) { return __uint_as_float(w << 16); }
DEV float bfhi(unsigned w) { return __uint_as_float(w & 0xffff0000u); }
DEV void unpack8(const uint4& x, float* f) {
  f[0] = bflo(x.x); f[1] = bfhi(x.x); f[2] = bflo(x.y); f[3] = bfhi(x.y);
  f[4] = bflo(x.z); f[5] = bfhi(x.z); f[6] = bflo(x.w); f[7] = bfhi(x.w);
}
DEV float sigmoidf_(float x) { return 1.0f / (1.0f + __expf(-x)); }

template <int CTRL>
DEV float dppf(float x) {
  return __int_as_float(__builtin_amdgcn_update_dpp(0, __float_as_int(x), CTRL, 0xf, 0xf, true));
}
DEV float red4(float x) { x += dppf<0xB1>(x); x += dppf<0x4E>(x); return x; }
DEV float red8(float x) { x = red4(x); x += dppf<0x141>(x); return x; }
DEV float red16(float x) { x = red8(x); x += dppf<0x140>(x); return x; }
DEV float wave_sum(float x) {
#pragma unroll
  for (int o = 32; o >= 1; o >>= 1) x += __shfl_xor(x, o);
  return x;
}

#define GEMM_STAGE_BYTES 49152

template <int AMODE>
DEV void gemm_main(f32x4 (&acc)[4][4], const u16* __restrict__ A, int lda, const u16* __restrict__ Bt, int ldb, int nk,
                   int m0, int n0, const float* __restrict__ mu, const u16* __restrict__ SH, char* smem) {
  const int tid = threadIdx.x, lane = tid & 63, wid = tid >> 6, wr = wid >> 1, wc = wid & 1, fr = lane & 15, fq = lane >> 4;
  const int lrow = tid >> 3, lch = tid & 7;
#pragma unroll
  for (int i = 0; i < 4; ++i)
#pragma unroll
    for (int j = 0; j < 4; ++j) acc[i][j] = (f32x4){0.f, 0.f, 0.f, 0.f};

  const u16* pa0; const u16* pa1; const u16* pa2; const u16* pa3;
  const u16* pp0 = nullptr; const u16* pp1 = nullptr; const u16* pp2 = nullptr; const u16* pp3 = nullptr;
  {
    int m = m0 + lrow;
    pa0 = A + (size_t)m * lda + lch * 8;
    pa1 = pa0 + (size_t)64 * lda; pa2 = pa0 + (size_t)128 * lda; pa3 = pa0 + (size_t)192 * lda;
    if (AMODE != 0) {
      pp0 = seq_start(m) ? SH + seq_of(m) * 1024 + lch * 8 : pa0 - lda;
      pp1 = seq_start(m + 64) ? SH + seq_of(m + 64) * 1024 + lch * 8 : pa1 - lda;
      pp2 = seq_start(m + 128) ? SH + seq_of(m + 128) * 1024 + lch * 8 : pa2 - lda;
      pp3 = seq_start(m + 192) ? SH + seq_of(m + 192) * 1024 + lch * 8 : pa3 - lda;
    }
  }
  const u16* pb0 = Bt + (size_t)(n0 + lrow) * ldb + lch * 8;
  const u16* pb1 = pb0 + (size_t)64 * ldb;
  const int wsw = (lch ^ ((lrow >> 1) & 7)) << 4;
  const int woffA = lrow * 128 + wsw;

  uint4 ra0, ra1, ra2, ra3, rp0, rp1, rp2, rp3, rb0, rb1;
  float4 mu0, mu1;
  rp0 = rp1 = rp2 = rp3 = make_uint4(0, 0, 0, 0);
  mu0 = mu1 = make_float4(0, 0, 0, 0);

#define G_LOAD(kt)                                                                     \
  {                                                                                    \
    const int k0_ = (kt) * 64;                                                         \
    if (AMODE == 0) {                                                                  \
      ra0 = *(const uint4*)(pa0 + k0_); ra1 = *(const uint4*)(pa1 + k0_);              \
      ra2 = *(const uint4*)(pa2 + k0_); ra3 = *(const uint4*)(pa3 + k0_);              \
    } else if (AMODE == 1) {                                                           \
      ra0 = *(const uint4*)(pa0 + k0_); ra1 = *(const uint4*)(pa1 + k0_);              \
      ra2 = *(const uint4*)(pa2 + k0_); ra3 = *(const uint4*)(pa3 + k0_);              \
      rp0 = *(const uint4*)(pp0 + k0_); rp1 = *(const uint4*)(pp1 + k0_);              \
      rp2 = *(const uint4*)(pp2 + k0_); rp3 = *(const uint4*)(pp3 + k0_);              \
      mu0 = *(const float4*)(mu + k0_ + lch * 8); mu1 = *(const float4*)(mu + k0_ + lch * 8 + 4); \
    } else {                                                                           \
      const int kk_ = k0_ & 1023;                                                      \
      ra0 = *(const uint4*)(pa0 + kk_); ra1 = *(const uint4*)(pa1 + kk_);              \
      ra2 = *(const uint4*)(pa2 + kk_); ra3 = *(const uint4*)(pa3 + kk_);              \
      if (k0_ >= 1024) {                                                               \
        rp0 = *(const uint4*)(pp0 + kk_); rp1 = *(const uint4*)(pp1 + kk_);            \
        rp2 = *(const uint4*)(pp2 + kk_); rp3 = *(const uint4*)(pp3 + kk_);            \
      }                                                                                \
    }                                                                                  \
    rb0 = *(const uint4*)(pb0 + k0_); rb1 = *(const uint4*)(pb1 + k0_);                \
  }

#define G_XFORM(dst, a_, p_, kt)                                                       \
  {                                                                                    \
    if (AMODE == 0) dst = a_;                                                          \
    else if (AMODE == 1) {                                                             \
      float h_[8], q_[8]; unpack8(a_, h_); unpack8(p_, q_);                            \
      dst.x = pack2(h_[0] + mu0.x * (q_[0] - h_[0]), h_[1] + mu0.y * (q_[1] - h_[1])); \
      dst.y = pack2(h_[2] + mu0.z * (q_[2] - h_[2]), h_[3] + mu0.w * (q_[3] - h_[3])); \
      dst.z = pack2(h_[4] + mu1.x * (q_[4] - h_[4]), h_[5] + mu1.y * (q_[5] - h_[5])); \
      dst.w = pack2(h_[6] + mu1.z * (q_[6] - h_[6]), h_[7] + mu1.w * (q_[7] - h_[7])); \
    } else {                                                                           \
      if ((kt) * 64 >= 1024) {                                                         \
        float h_[8], q_[8]; unpack8(a_, h_); unpack8(p_, q_);                          \
        dst.x = pack2(q_[0] - h_[0], q_[1] - h_[1]); dst.y = pack2(q_[2] - h_[2], q_[3] - h_[3]); \
        dst.z = pack2(q_[4] - h_[4], q_[5] - h_[5]); dst.w = pack2(q_[6] - h_[6], q_[7] - h_[7]); \
      } else dst = a_;                                                                 \
    }                                                                                  \
  }

#define G_STORE(stage, kt)                                                             \
  {                                                                                    \
    char* sA_ = smem + (stage) * GEMM_STAGE_BYTES; char* sB_ = sA_ + 32768;            \
    uint4 v_;                                                                          \
    G_XFORM(v_, ra0, rp0, kt); *(uint4*)(sA_ + woffA) = v_;                            \
    G_XFORM(v_, ra1, rp1, kt); *(uint4*)(sA_ + woffA + 64 * 128) = v_;                 \
    G_XFORM(v_, ra2, rp2, kt); *(uint4*)(sA_ + woffA + 128 * 128) = v_;                \
    G_XFORM(v_, ra3, rp3, kt); *(uint4*)(sA_ + woffA + 192 * 128) = v_;                \
    *(uint4*)(sB_ + woffA) = rb0; *(uint4*)(sB_ + woffA + 64 * 128) = rb1;             \
  }

  G_LOAD(0);
  G_STORE(0, 0);
  __syncthreads();
  const int rsw = (fr >> 1) & 7;
  for (int kt = 0; kt < nk; ++kt) {
    const int st = kt & 1;
    if (kt + 1 < nk) G_LOAD(kt + 1);
    {
      const char* sA = smem + st * GEMM_STAGE_BYTES;
      const char* sB = sA + 32768;
#pragma unroll
      for (int kk = 0; kk < 2; ++kk) {
        bf16x8 af[4], bfr[4];
        const int cho = ((kk * 4 + fq) ^ rsw) << 4;
#pragma unroll
        for (int i = 0; i < 4; ++i) af[i] = *(const bf16x8*)(sA + (wr * 64 + i * 16 + fr) * 128 + cho);
#pragma unroll
        for (int j = 0; j < 4; ++j) bfr[j] = *(const bf16x8*)(sB + (wc * 64 + j * 16 + fr) * 128 + cho);
#pragma unroll
        for (int i = 0; i < 4; ++i)
#pragma unroll
          for (int j = 0; j < 4; ++j) acc[i][j] = __builtin_amdgcn_mfma_f32_16x16x32_bf16(bfr[j], af[i], acc[i][j], 0, 0, 0);
      }
    }
    if (kt + 1 < nk) G_STORE(st ^ 1, kt + 1);
    __syncthreads();
  }
#undef G_LOAD
#undef G_XFORM
#undef G_STORE
}

DEV void transpose_tile(const float* __restrict__ src, int N, int k0, int n0, const float* __restrict__ scale, u16* __restrict__ dst,
                        int dstride, int drow0, int dcol0, char* smem) {
  float* tile = (float*)smem;
  const int tid = threadIdx.x;
#pragma unroll
  for (int i = 0; i < 2; ++i) {
    int kl = (tid >> 4) + 32 * i, n4 = (tid & 15) * 4;
    float4 v = *(const float4*)(src + (size_t)(k0 + kl) * N + n0 + n4);
    float s = scale ? scale[k0 + kl] : 1.0f;
    tile[kl * 65 + n4 + 0] = v.x * s; tile[kl * 65 + n4 + 1] = v.y * s;
    tile[kl * 65 + n4 + 2] = v.z * s; tile[kl * 65 + n4 + 3] = v.w * s;
  }
  __syncthreads();
  {
    int nl = tid >> 3, k8 = (tid & 7) * 8;
    uint4 o;
    o.x = pack2(tile[(k8 + 0) * 65 + nl], tile[(k8 + 1) * 65 + nl]);
    o.y = pack2(tile[(k8 + 2) * 65 + nl], tile[(k8 + 3) * 65 + nl]);
    o.z = pack2(tile[(k8 + 4) * 65 + nl], tile[(k8 + 5) * 65 + nl]);
    o.w = pack2(tile[(k8 + 6) * 65 + nl], tile[(k8 + 7) * 65 + nl]);
    *(uint4*)(dst + (size_t)(drow0 + n0 + nl) * dstride + dcol0 + k0 + k8) = o;
  }
  __syncthreads();
}

DEV void phase_prep(const Params& p, char* smem) {
  const int tid = threadIdx.x;
  char* ws = p.ws;
  if (blockIdx.x < 96) {
    float* cL = (float*)smem;
    float* red = (float*)(smem + 98304);
    for (int e = tid; e < 24 * 256; e += NTHREADS) {
      int s = e >> 8, k4 = (e & 255) * 4;
      float4 v = s < 8 ? *(const float4*)(p.in[I_CP] + s * 1024 + k4) : *(const float4*)(p.in[I_CS] + (s - 8) * 1024 + k4);
      *(float4*)(cL + s * 1024 + k4) = v;
    }
    __syncthreads();
    for (int item = blockIdx.x; item < 96; item += gridDim.x) {
      const int l = item / 48, j0 = (item % 48) * 64;
      const float* W = (l == 0 ? p.in[I_AADAW] : p.in[I_BADAW]);
      const float* bias = (l == 0 ? p.in[I_AADAB] : p.in[I_BADAB]);
      const int col = tid & 63, kg = tid >> 6;
      float acc[24];
#pragma unroll
      for (int s = 0; s < 24; ++s) acc[s] = 0.f;
      for (int k = kg * 128; k < kg * 128 + 128; ++k) {
        float w = W[(size_t)k * 3072 + j0 + col];
#pragma unroll
        for (int s = 0; s < 24; ++s) acc[s] += cL[s * 1024 + k] * w;
      }
#pragma unroll
      for (int s = 0; s < 24; ++s) red[(kg * 24 + s) * 64 + col] = acc[s];
      __syncthreads();
      float* mod = (float*)(ws + WS_MOD);
      for (int e = tid; e < 24 * 64; e += NTHREADS) {
        int s = e >> 6, c = e & 63;
        float t = bias[j0 + c];
#pragma unroll
        for (int g = 0; g < 8; ++g) t += red[(g * 24 + s) * 64 + c];
        mod[(size_t)(l * 24 + s) * 3072 + j0 + c] = t;
      }
      __syncthreads();
    }
  }
  if (blockIdx.x == gridDim.x - 1) {
    u16* SH = (u16*)(ws + WS_SH);
    for (int e = tid; e < 24 * 1024; e += NTHREADS) {
      int s = e >> 10, k = e & 1023;
      float v = s < 8 ? 0.f : p.in[I_SSH][(s - 8) * 1024 + k];
      SH[e] = (u16)(pack2(v, 0.f) & 0xffff);
    }
  }
  const int NT_TOTAL = 2048 + 512 + 1024 + 1024 + 512 + 32 + 32 + 64;
  for (int t = blockIdx.x; t < NT_TOTAL; t += gridDim.x) {
    const float* src; int K, N; u16* dst; int dstride, drow0 = 0, dcol0 = 0; const float* scale = nullptr; int tt = t;
    if (tt < 2048) { src = p.in[I_AWIN]; K = 1024; N = 8192; dst = (u16*)(ws + WS_WT_IN); dstride = 1024; }
    else if ((tt -= 2048) < 512) { src = p.in[I_AWOUT]; K = 2048; N = 1024; dst = (u16*)(ws + WS_WT_OUTA); dstride = 2048; }
    else if ((tt -= 512) < 1024) { src = p.in[I_KVW]; K = 1024; N = 4096; dst = (u16*)(ws + WS_WT_KV); dstride = 1024; }
    else if ((tt -= 1024) < 1024) { src = p.in[I_BWIN]; K = 1024; N = 4096; dst = (u16*)(ws + WS_WT_INB); dstride = 1024; }
    else if ((tt -= 1024) < 512) { src = p.in[I_BWOUT]; K = 2048; N = 1024; dst = (u16*)(ws + WS_WT_OUTB); dstride = 2048; }
    else if ((tt -= 512) < 32) { src = p.in[I_AW2]; K = 64; N = 2048; dst = (u16*)(ws + WS_W2T); dstride = 64; }
    else if ((tt -= 32) < 32) { src = p.in[I_AA2]; K = 64; N = 2048; dst = (u16*)(ws + WS_A2T); dstride = 64; }
    else {
      tt -= 32;
      int job = tt >> 4; tt &= 15;
      K = 1024; N = 64; dst = (u16*)(ws + WS_L1T); dstride = 2048;
      src = (job < 2) ? p.in[I_AW1] : p.in[I_AA1];
      drow0 = (job < 2) ? 0 : 64;
      if (job & 1) { dcol0 = 1024; scale = (job < 2) ? p.in[I_AMUW] : p.in[I_AMUA]; }
    }
    const int ntn = N / 64;
    const int kt = tt / ntn, nt = tt % ntn;
    transpose_tile(src, N, kt * 64, nt * 64, scale, dst, dstride, drow0, dcol0, smem);
  }
}

DEV void phase_norm0(const Params& p) {
  const int lane = threadIdx.x & 63, wid = threadIdx.x >> 6;
  const float* mod = (const float*)(p.ws + WS_MOD);
  u16* H0 = (u16*)(p.ws + WS_H0);
  const float* g = p.in[I_ANG];
  for (int t = blockIdx.x * 8 + wid; t < NTOK; t += gridDim.x * 8) {
    const float* x = t < TP ? p.in[I_XP] + (size_t)t * 1024 : p.in[I_XS] + (size_t)(t - TP) * 1024;
    const int s = seq_of(t);
    const float* md = mod + (size_t)s * 3072;
    float4 v[4];
    float ss = 0.f;
#pragma unroll
    for (int i = 0; i < 4; ++i) {
      v[i] = *(const float4*)(x + lane * 4 + 256 * i);
      ss += v[i].x * v[i].x + v[i].y * v[i].y + v[i].z * v[i].z + v[i].w * v[i].w;
    }
    ss = wave_sum(ss);
    const float rstd = rsqrtf(ss * (1.0f / 1024.0f) + 1e-6f);
    bool last = t < TP ? ((t & 4095) == 4095) : (((t - TP) & 31) == 31);
    float* so = t < TP ? p.out + OFF_SH_P + (t >> 12) * 1024 : p.out + OFF_SH_S + ((t - TP) >> 5) * 1024;
#pragma unroll
    for (int i = 0; i < 4; ++i) {
      const int c = lane * 4 + 256 * i;
      float4 gg = *(const float4*)(g + c), sh = *(const float4*)(md + c), sc = *(const float4*)(md + 1024 + c);
      float4 h;
      h.x = v[i].x * rstd * gg.x * (1.f + sc.x) + sh.x;
      h.y = v[i].y * rstd * gg.y * (1.f + sc.y) + sh.y;
      h.z = v[i].z * rstd * gg.z * (1.f + sc.z) + sh.z;
      h.w = v[i].w * rstd * gg.w * (1.f + sc.w) + sh.w;
      uint2 o; o.x = pack2(h.x, h.y); o.y = pack2(h.z, h.w);
      *(uint2*)(H0 + (size_t)t * 1024 + c) = o;
      if (last) *(float4*)(so + c) = h;
    }
  }
}

DEV void phase_proj0(const Params& p, char* smem) {
  const int tid = threadIdx.x, lane = tid & 63, wid = tid >> 6, wr = wid >> 1, wc = wid & 1, fr = lane & 15, fq = lane >> 4;
  char* ws = p.ws;
  const u16* H0 = (const u16*)(ws + WS_H0);
  const u16* SH = (const u16*)(ws + WS_SH);
  u16* T = (u16*)(ws + WS_T);
  f32x4 acc[4][4];
  const int NITEMS = 130 + 130 * 64;
  for (int item = blockIdx.x; item < NITEMS; item += gridDim.x) {
    if (item < 130) {
      const int m0 = item * 256;
      gemm_main<2>(acc, H0, 1024, (const u16*)(ws + WS_L1T), 2048, 32, m0, 0, nullptr, SH, smem);
#pragma unroll
      for (int i = 0; i < 4; ++i)
#pragma unroll
        for (int j = 0; j < 4; ++j) {
          const int m = m0 + wr * 64 + i * 16 + fr, n = wc * 64 + j * 16 + fq * 4;
          f32x4 v = acc[i][j];
          if (wc == 0) { v[0] = tanhf(v[0]); v[1] = tanhf(v[1]); v[2] = tanhf(v[2]); v[3] = tanhf(v[3]); }
          uint2 o; o.x = pack2(v[0], v[1]); o.y = pack2(v[2], v[3]);
          *(uint2*)(T + (size_t)m * 128 + n) = o;
        }
      __threadfence_block();
      __syncthreads();
      for (int nt = 0; nt < 32; ++nt) {
        const int which = nt >> 4, n0 = (nt & 15) * 128;
        gemm_main<0>(acc, T + which * 64, 128, (const u16*)(ws + (which ? WS_A2T : WS_W2T)), 64, 1, m0, n0, nullptr, nullptr, smem);
        const float* bias = which ? p.in[I_AA0] : p.in[I_AW0];
        u16* dst = (u16*)(ws + (which ? 5ull : 4ull) * SLOT);
#pragma unroll
        for (int i = 0; i < 4; ++i)
#pragma unroll
          for (int j = 0; j < 4; ++j) {
            const int m = m0 + wr * 64 + i * 16 + fr, n = n0 + wc * 64 + j * 16 + fq * 4;
            float4 b4 = *(const float4*)(bias + n);
            f32x4 v = acc[i][j];
            float s0 = sigmoidf_(v[0] + b4.x), s1 = sigmoidf_(v[1] + b4.y), s2 = sigmoidf_(v[2] + b4.z), s3 = sigmoidf_(v[3] + b4.w);
            if (!which) { s0 *= -0.60653066f; s1 *= -0.60653066f; s2 *= -0.60653066f; s3 *= -0.60653066f; }
            uint2 o; o.x = pack2(s0, s1); o.y = pack2(s2, s3);
            *(uint2*)(dst + (size_t)m * 2048 + n) = o;
          }
      }
    } else {
      const int idx = item - 130;
      const int mt = idx >> 6, nt = idx & 63;
      const int part = nt >> 4;
      const int m0 = mt * 256, n0 = nt * 128;
      gemm_main<1>(acc, H0, 1024, (const u16*)(ws + WS_WT_IN), 1024, 16, m0, n0, p.in[I_AMUIN] + part * 1024, SH, smem);
      u16* dst = (u16*)(ws + (size_t)part * SLOT);
      const int nb = n0 - part * 2048;
#pragma unroll
      for (int i = 0; i < 4; ++i)
#pragma unroll
        for (int j = 0; j < 4; ++j) {
          const int m = m0 + wr * 64 + i * 16 + fr, n = nb + wc * 64 + j * 16 + fq * 4;
          f32x4 v = acc[i][j];
          uint2 o; o.x = pack2(v[0], v[1]); o.y = pack2(v[2], v[3]);
          *(uint2*)(dst + (size_t)m * 2048 + n) = o;
        }
    }
  }
}

DEV void phase_scan(const Params& p, char* smem) {
  const int tid = threadIdx.x, lane = tid & 63, wid = tid >> 6;
  float* Lkk = (float*)smem;
  float* Lw = Lkk + 4096;
  float* Lb = Lw + 4096;
  float* Lk = Lb + 4096;
  float* Lr = Lk + 4096;
  float* Lv = Lr + 4096;
  float* LY = Lv + 4096;
  float* Lbon = LY + 4096;
  char* ws = p.ws;
  const u16* gR = (const u16*)(ws + 0 * SLOT);
  const u16* gK = (const u16*)(ws + 1 * SLOT);
  const u16* gV = (const u16*)(ws + 2 * SLOT);
  const u16* gZ = (const u16*)(ws + 3 * SLOT);
  const u16* gW = (const u16*)(ws + 4 * SLOT);
  const u16* gA = (const u16*)(ws + 5 * SLOT);
  u16* YG = (u16*)(ws + 6 * SLOT);
  const int tt = tid >> 3, c8 = (tid & 7) * 8;
  const int rp = wid * 4 + (lane >> 4), kc = lane & 15;

  for (int item = blockIdx.x; item < 768; item += gridDim.x) {
    int h, tok0, nsteps; const float* sinit; float* sout;
    if (item < 256) { h = item & 31; tok0 = (item >> 5) * 4096; nsteps = 4096; sinit = nullptr; sout = p.out + OFF_WKV_P + (size_t)item * 4096; }
    else { int it = item - 256; h = it & 31; tok0 = TP + (it >> 5) * 32; nsteps = 32; sinit = p.in[I_SWKV] + (size_t)it * 4096; sout = p.out + OFF_WKV_S + (size_t)it * 4096; }
    const int nch = (nsteps + 63) >> 6;
    const int col0 = h * 64 + c8;
    float s0[4], s1[4];
    if (sinit) {
      float4 a = *(const float4*)(sinit + (2 * rp) * 64 + kc * 4), b = *(const float4*)(sinit + (2 * rp + 1) * 64 + kc * 4);
      s0[0] = a.x; s0[1] = a.y; s0[2] = a.z; s0[3] = a.w; s1[0] = b.x; s1[1] = b.y; s1[2] = b.z; s1[3] = b.w;
    } else {
#pragma unroll
      for (int j = 0; j < 4; ++j) { s0[j] = 0.f; s1[j] = 0.f; }
    }
    uint4 cr, ck, cv, cz, cw, ca;
#define SCAN_LOAD(c)                                                                   \
    {                                                                                  \
      const int tl_ = (c) * 64 + tt;                                                   \
      if (tl_ < nsteps) {                                                              \
        const size_t o_ = (size_t)(tok0 + tl_) * 2048 + col0;                          \
        cr = *(const uint4*)(gR + o_); ck = *(const uint4*)(gK + o_); cv = *(const uint4*)(gV + o_); \
        cz = *(const uint4*)(gZ + o_); cw = *(const uint4*)(gW + o_); ca = *(const uint4*)(gA + o_); \
      } else { cr = ck = cv = cz = cw = ca = make_uint4(0, 0, 0, 0); }                 \
    }
    SCAN_LOAD(0);
    for (int c = 0; c < nch; ++c) {
      uint4 zc = cz;
      {
        float r[8], k[8], v[8], lw[8], a[8];
        unpack8(cr, r); unpack8(ck, k); unpack8(cv, v); unpack8(cw, lw); unpack8(ca, a);
        float kkv[8], kp[8], bon = 0.f, ss = 0.f;
#pragma unroll
        for (int j = 0; j < 8; ++j) {
          const float kkc = p.in[I_AKK][col0 + j], kac = p.in[I_AKA][col0 + j], rkc = p.in[I_ARK][col0 + j];
          kkv[j] = k[j] * kkc; ss += kkv[j] * kkv[j];
          kp[j] = k[j] * (1.f + (a[j] - 1.f) * kac);
          bon += r[j] * kp[j] * rkc;
        }
        ss = red8(ss); bon = red8(bon);
        const float inv = rsqrtf(ss + 1e-12f);
        float4 o0, o1;
        float* d;
        d = Lkk + tt * 64 + c8;
        o0 = make_float4(kkv[0] * inv, kkv[1] * inv, kkv[2] * inv, kkv[3] * inv); o1 = make_float4(kkv[4] * inv, kkv[5] * inv, kkv[6] * inv, kkv[7] * inv);
        *(float4*)d = o0; *(float4*)(d + 4) = o1;
        d = Lb + tt * 64 + c8;
        *(float4*)d = make_float4(o0.x * a[0], o0.y * a[1], o0.z * a[2], o0.w * a[3]);
        *(float4*)(d + 4) = make_float4(o1.x * a[4], o1.y * a[5], o1.z * a[6], o1.w * a[7]);
        d = Lw + tt * 64 + c8;
        *(float4*)d = make_float4(__expf(lw[0]), __expf(lw[1]), __expf(lw[2]), __expf(lw[3]));
        *(float4*)(d + 4) = make_float4(__expf(lw[4]), __expf(lw[5]), __expf(lw[6]), __expf(lw[7]));
        d = Lk + tt * 64 + c8;
        *(float4*)d = make_float4(kp[0], kp[1], kp[2], kp[3]); *(float4*)(d + 4) = make_float4(kp[4], kp[5], kp[6], kp[7]);
        d = Lr + tt * 64 + c8;
        *(float4*)d = make_float4(r[0], r[1], r[2], r[3]); *(float4*)(d + 4) = make_float4(r[4], r[5], r[6], r[7]);
        d = Lv + tt * 64 + c8;
        *(float4*)d = make_float4(v[0], v[1], v[2], v[3]); *(float4*)(d + 4) = make_float4(v[4], v[5], v[6], v[7]);
        if ((tid & 7) == 0) Lbon[tt] = bon;
      }
      __syncthreads();
      if (c + 1 < nch) SCAN_LOAD(c + 1);
      {
        const int nT = min(64, nsteps - c * 64);
        const float* pk = Lkk + kc * 4; const float* pw = Lw + kc * 4; const float* pb = Lb + kc * 4;
        const float* pkk = Lk + kc * 4; const float* pr = Lr + kc * 4; const float* pv = Lv + rp * 2;
        float4 kk4 = *(const float4*)pk, w4 = *(const float4*)pw, b4 = *(const float4*)pb, k4 = *(const float4*)pkk, r4 = *(const float4*)pr;
        float2 v2 = *(const float2*)pv;
        for (int t = 0; t < nT; ++t) {
          float4 nkk4 = kk4, nw4 = w4, nb4 = b4, nk4 = k4, nr4 = r4; float2 nv2 = v2;
          if (t + 1 < nT) {
            const int o = (t + 1) * 64;
            nkk4 = *(const float4*)(pk + o); nw4 = *(const float4*)(pw + o); nb4 = *(const float4*)(pb + o);
            nk4 = *(const float4*)(pkk + o); nr4 = *(const float4*)(pr + o); nv2 = *(const float2*)(pv + o);
          }
          float sa0 = s0[0] * kk4.x + s0[1] * kk4.y + s0[2] * kk4.z + s0[3] * kk4.w;
          float sa1 = s1[0] * kk4.x + s1[1] * kk4.y + s1[2] * kk4.z + s1[3] * kk4.w;
          sa0 = red16(sa0); sa1 = red16(sa1);
          s0[0] = s0[0] * w4.x + (v2.x * k4.x - sa0 * b4.x);
          s0[1] = s0[1] * w4.y + (v2.x * k4.y - sa0 * b4.y);
          s0[2] = s0[2] * w4.z + (v2.x * k4.z - sa0 * b4.z);
          s0[3] = s0[3] * w4.w + (v2.x * k4.w - sa0 * b4.w);
          s1[0] = s1[0] * w4.x + (v2.y * k4.x - sa1 * b4.x);
          s1[1] = s1[1] * w4.y + (v2.y * k4.y - sa1 * b4.y);
          s1[2] = s1[2] * w4.z + (v2.y * k4.z - sa1 * b4.z);
          s1[3] = s1[3] * w4.w + (v2.y * k4.w - sa1 * b4.w);
          float y0 = s0[0] * r4.x + s0[1] * r4.y + s0[2] * r4.z + s0[3] * r4.w;
          float y1 = s1[0] * r4.x + s1[1] * r4.y + s1[2] * r4.z + s1[3] * r4.w;
          y0 = red16(y0); y1 = red16(y1);
          if (kc == 0) *(float2*)(LY + t * 64 + rp * 2) = make_float2(y0, y1);
          kk4 = nkk4; w4 = nw4; b4 = nb4; k4 = nk4; r4 = nr4; v2 = nv2;
        }
      }
      __syncthreads();
      {
        const int tl = c * 64 + tt;
        if (tl < nsteps) {
          float y[8], z[8];
          float4 a = *(const float4*)(LY + tt * 64 + c8), b = *(const float4*)(LY + tt * 64 + c8 + 4);
          y[0] = a.x; y[1] = a.y; y[2] = a.z; y[3] = a.w; y[4] = b.x; y[5] = b.y; y[6] = b.z; y[7] = b.w;
          float sm = y[0] + y[1] + y[2] + y[3] + y[4] + y[5] + y[6] + y[7];
          sm = red8(sm);
          const float mean = sm * (1.f / 64.f);
          float vs = 0.f;
#pragma unroll
          for (int j = 0; j < 8; ++j) { y[j] -= mean; vs += y[j] * y[j]; }
          vs = red8(vs);
          const float rstd = rsqrtf(vs * (1.f / 64.f) + 64e-5f);
          const float bon = Lbon[tt];
          float4 va = *(const float4*)(Lv + tt * 64 + c8), vb = *(const float4*)(Lv + tt * 64 + c8 + 4);
          float vv[8] = {va.x, va.y, va.z, va.w, vb.x, vb.y, vb.z, vb.w};
          unpack8(zc, z);
          float o[8];
#pragma unroll
          for (int j = 0; j < 8; ++j) {
            float g = p.in[I_ALNG][col0 + j], bb = p.in[I_ALNB][col0 + j];
            float t = y[j] * rstd * g + bb + bon * vv[j];
            o[j] = t * z[j] * sigmoidf_(z[j]);
          }
          uint4 ov; ov.x = pack2(o[0], o[1]); ov.y = pack2(o[2], o[3]); ov.z = pack2(o[4], o[5]); ov.w = pack2(o[6], o[7]);
          *(uint4*)(YG + (size_t)(tok0 + tl) * 2048 + col0) = ov;
        }
      }
      __syncthreads();
    }
#undef SCAN_LOAD
    *(float4*)(sout + (2 * rp) * 64 + kc * 4) = make_float4(s0[0], s0[1], s0[2], s0[3]);
    *(float4*)(sout + (2 * rp + 1) * 64 + kc * 4) = make_float4(s1[0], s1[1], s1[2], s1[3]);
  }
}

template <int LAYER>
DEV void phase_outproj(const Params& p, char* smem) {
  const int tid = threadIdx.x, lane = tid & 63, wid = tid >> 6, wr = wid >> 1, wc = wid & 1, fr = lane & 15, fq = lane >> 4;
  char* ws = p.ws;
  const u16* A = (const u16*)(ws + 6 * SLOT);
  const u16* Bt = (const u16*)(ws + (LAYER == 0 ? WS_WT_OUTA : WS_WT_OUTB));
  const float* mod = (const float*)(ws + WS_MOD) + (size_t)LAYER * 24 * 3072;
  float* xmid = (float*)(ws + 0 * SLOT);
  f32x4 acc[4][4];
  for (int item = blockIdx.x; item < 130 * 8; item += gridDim.x) {
    const int m0 = (item >> 3) * 256, n0 = (item & 7) * 128;
    gemm_main<0>(acc, A, 2048, Bt, 2048, 32, m0, n0, nullptr, nullptr, smem);
#pragma unroll
    for (int i = 0; i < 4; ++i) {
      const int m = m0 + wr * 64 + i * 16 + fr;
      const float* gate = mod + (size_t)seq_of(m) * 3072 + 2048;
#pragma unroll
      for (int j = 0; j < 4; ++j) {
        const int n = n0 + wc * 64 + j * 16 + fq * 4;
        float4 g4 = *(const float4*)(gate + n);
        f32x4 v = acc[i][j];
        if (LAYER == 0) {
          const float* xr = m < TP ? p.in[I_XP] + (size_t)m * 1024 : p.in[I_XS] + (size_t)(m - TP) * 1024;
          float4 x4 = *(const float4*)(xr + n);
          *(float4*)(xmid + (size_t)m * 1024 + n) = make_float4(x4.x + g4.x * v[0], x4.y + g4.y * v[1], x4.z + g4.z * v[2], x4.w + g4.w * v[3]);
        } else {
          float4 x4 = *(const float4*)(xmid + (size_t)m * 1024 + n);
          float* yo = m < TP ? p.out + OFF_Y_P + (size_t)m * 1024 : p.out + OFF_Y_S + (size_t)(m - TP) * 1024;
          *(float4*)(yo + n) = make_float4(x4.x + g4.x * v[0], x4.y + g4.y * v[1], x4.z + g4.z * v[2], x4.w + g4.w * v[3]);
        }
      }
    }
  }
}

DEV void phase_norm1(const Params& p) {
  const int lane = threadIdx.x & 63, wid = threadIdx.x >> 6;
  const float* mod = (const float*)(p.ws + WS_MOD) + (size_t)24 * 3072;
  const float* xmid = (const float*)(p.ws + 0 * SLOT);
  u16* AKV = (u16*)(p.ws + 1 * SLOT);
  u16* AQ = AKV + (size_t)NTOK * 1024;
  const float* gkv = p.in[I_KVNG];
  const float* gb = p.in[I_BNG];
  for (int t = blockIdx.x * 8 + wid; t < NTOK; t += gridDim.x * 8) {
    const float* x = xmid + (size_t)t * 1024;
    const float* md = mod + (size_t)seq_of(t) * 3072;
    float4 v[4];
    float ss = 0.f;
#pragma unroll
    for (int i = 0; i < 4; ++i) {
      v[i] = *(const float4*)(x + lane * 4 + 256 * i);
      ss += v[i].x * v[i].x + v[i].y * v[i].y + v[i].z * v[i].z + v[i].w * v[i].w;
    }
    ss = wave_sum(ss);
    const float rstd = rsqrtf(ss * (1.0f / 1024.0f) + 1e-6f);
#pragma unroll
    for (int i = 0; i < 4; ++i) {
      const int c = lane * 4 + 256 * i;
      float4 g1 = *(const float4*)(gkv + c), g2 = *(const float4*)(gb + c), sh = *(const float4*)(md + c), sc = *(const float4*)(md + 1024 + c);
      float xn0 = v[i].x * rstd, xn1 = v[i].y * rstd, xn2 = v[i].z * rstd, xn3 = v[i].w * rstd;
      uint2 o;
      o.x = pack2(xn0 * g1.x, xn1 * g1.y); o.y = pack2(xn2 * g1.z, xn3 * g1.w);
      *(uint2*)(AKV + (size_t)t * 1024 + c) = o;
      o.x = pack2(xn0 * g2.x * (1.f + sc.x) + sh.x, xn1 * g2.y * (1.f + sc.y) + sh.y);
      o.y = pack2(xn2 * g2.z * (1.f + sc.z) + sh.z, xn3 * g2.w * (1.f + sc.w) + sh.w);
      *(uint2*)(AQ + (size_t)t * 1024 + c) = o;
    }
  }
}

#define QSCALE (0.08838834764831845f * 1.4426950408889634f)
DEV void phase_proj1(const Params& p, char* smem) {
  const int tid = threadIdx.x, lane = tid & 63, wid = tid >> 6, wr = wid >> 1, wc = wid & 1, fr = lane & 15, fq = lane >> 4;
  char* ws = p.ws;
  const u16* AKV = (const u16*)(ws + 1 * SLOT);
  const u16* AQ = AKV + (size_t)NTOK * 1024;
  u16* KB = (u16*)(ws + 2 * SLOT);
  u16* VB = (u16*)(ws + 3 * SLOT);
  u16* QB = (u16*)(ws + 4 * SLOT);
  u16* ZS = (u16*)(ws + 5 * SLOT);
  f32x4 acc[4][4];
  float* red = (float*)smem;
  for (int item = blockIdx.x; item < 130 * 64; item += gridDim.x) {
    const int mt = item >> 6, t = item & 63;
    const int isq = t >> 5, nt = t & 31;
    const int m0 = mt * 256, n0 = nt * 128;
    gemm_main<0>(acc, isq ? AQ : AKV, 1024, (const u16*)(ws + (isq ? WS_WT_INB : WS_WT_KV)), 1024, 16, m0, n0, nullptr, nullptr, smem);
    if (nt < 16) {
#pragma unroll
      for (int i = 0; i < 4; ++i) {
        float ss = 0.f;
#pragma unroll
        for (int j = 0; j < 4; ++j) ss += acc[i][j][0] * acc[i][j][0] + acc[i][j][1] * acc[i][j][1] + acc[i][j][2] * acc[i][j][2] + acc[i][j][3] * acc[i][j][3];
        red[(wr * 64 + i * 16 + fr) * 8 + wc * 4 + fq] = ss;
      }
      __syncthreads();
      const float* gain = isq ? p.in[I_BQG] : p.in[I_KGAIN];
#pragma unroll
      for (int i = 0; i < 4; ++i) {
        const int row = wr * 64 + i * 16 + fr, m = m0 + row;
        float4 ra = *(const float4*)(red + row * 8), rb = *(const float4*)(red + row * 8 + 4);
        float tot = ra.x + ra.y + ra.z + ra.w + rb.x + rb.y + rb.z + rb.w;
        float rs = rsqrtf(tot * (1.f / 128.f) + 1e-6f);
        if (isq) rs *= QSCALE;
#pragma unroll
        for (int j = 0; j < 4; ++j) {
          const int d = wc * 64 + j * 16 + fq * 4, n = n0 + d;
          float4 g4 = *(const float4*)(gain + d);
          f32x4 v = acc[i][j];
          float o0 = v[0] * rs * g4.x, o1 = v[1] * rs * g4.y, o2 = v[2] * rs * g4.z, o3 = v[3] * rs * g4.w;
          uint2 o; o.x = pack2(o0, o1); o.y = pack2(o2, o3);
          if (isq) {
            *(uint2*)(QB + (size_t)m * 2048 + n) = o;
          } else {
            *(uint2*)(KB + (size_t)m * 2048 + n) = o;
            float* ko = m < TP ? p.out + OFF_K_P + (size_t)m * 2048 : p.out + OFF_K_S + (size_t)(m - TP) * 2048;
            *(float4*)(ko + n) = make_float4(o0, o1, o2, o3);
          }
        }
      }
      __syncthreads();
    } else {
#pragma unroll
      for (int i = 0; i < 4; ++i) {
        const int m = m0 + wr * 64 + i * 16 + fr;
#pragma unroll
        for (int j = 0; j < 4; ++j) {
          const int n = n0 - 2048 + wc * 64 + j * 16 + fq * 4;
          f32x4 v = acc[i][j];
          if (isq) {
            float o0 = v[0] * sigmoidf_(v[0]), o1 = v[1] * sigmoidf_(v[1]), o2 = v[2] * sigmoidf_(v[2]), o3 = v[3] * sigmoidf_(v[3]);
            uint2 o; o.x = pack2(o0, o1); o.y = pack2(o2, o3);
            *(uint2*)(ZS + (size_t)m * 2048 + n) = o;
          } else {
            uint2 o; o.x = pack2(v[0], v[1]); o.y = pack2(v[2], v[3]);
            *(uint2*)(VB + (size_t)m * 2048 + n) = o;
            float* vo = m < TP ? p.out + OFF_V_P + (size_t)m * 2048 : p.out + OFF_V_S + (size_t)(m - TP) * 2048;
            *(float4*)(vo + n) = make_float4(v[0], v[1], v[2], v[3]);
          }
        }
      }
    }
  }
}

DEV unsigned off_b(unsigned row, unsigned ch) { return 256u * row + 16u * (ch ^ (((row & 3) << 2) | ((row >> 2) & 3))); }

DEV void phase_attn(const Params& p, char* smem) {
  const int tid = threadIdx.x, lane = tid & 63, w = tid >> 6, fr = lane & 15, fq = lane >> 4;
  char* ws = p.ws;
  const u16* KB = (const u16*)(ws + 2 * SLOT);
  const u16* VB = (const u16*)(ws + 3 * SLOT);
  const u16* QB = (const u16*)(ws + 4 * SLOT);
  const u16* ZS = (const u16*)(ws + 5 * SLOT);
  u16* OG = (u16*)(ws + 6 * SLOT);
  const int lrow = tid >> 4, lch = tid & 15;
  const unsigned lw0 = off_b(lrow, lch), lw1 = off_b(lrow + 32, lch);
  const int tq = (lane & 15) >> 2, tp = lane & 3;

  for (int item = blockIdx.x; item < 4096 + 256; item += gridDim.x) {
    int b, h, nq, qpos0, tokq0, ntiles, nkeys, tokk0; bool sample;
    if (item < 4096) {
      const int qblk = 31 - (item >> 7), bh = item & 127;
      b = bh >> 4; h = bh & 15; nq = 128; qpos0 = qblk * 128; tokq0 = b * 4096 + qpos0; ntiles = 2 * qblk + 2; nkeys = qpos0 + 128; tokk0 = b * 4096; sample = false;
    } else {
      const int bh = item - 4096;
      b = bh >> 4; h = bh & 15; nq = 32; qpos0 = 1024; tokq0 = TP + b * 32; ntiles = 17; nkeys = 1056; tokk0 = TP + b * 32 - 1024; sample = true;
    }
    const bool wactive = (w * 16) < nq;
    const int qp = qpos0 + w * 16 + fr;
    const int qwmax = qpos0 + w * 16 + 15;
    bf16x8 qf[4];
#pragma unroll
    for (int ks = 0; ks < 4; ++ks) {
      if (wactive) qf[ks] = *(const bf16x8*)(QB + (size_t)(tokq0 + w * 16 + fr) * 2048 + h * 128 + ks * 32 + fq * 8);
      else qf[ks] = (bf16x8){0, 0, 0, 0, 0, 0, 0, 0};
    }
    f32x4 O[8];
#pragma unroll
    for (int dt = 0; dt < 8; ++dt) O[dt] = (f32x4){0, 0, 0, 0};
    float carry = 0.f;

    uint4 lk0, lk1, lv0, lv1;
#define ATT_LOAD(kb)                                                                                  \
    {                                                                                                 \
      const int kx0_ = (kb) * 64 + lrow, kx1_ = kx0_ + 32;                                            \
      if (sample && (kb) < 16) {                                                                      \
        const float* ck_ = p.in[I_CK] + ((size_t)(b * 1024 + kx0_) * 16 + h) * 128 + lch * 8;         \
        const float* cv_ = p.in[I_CV] + ((size_t)(b * 1024 + kx0_) * 16 + h) * 128 + lch * 8;         \
        float4 a_ = *(const float4*)ck_, b_ = *(const float4*)(ck_ + 4);                              \
        float4 c_ = *(const float4*)(ck_ + 32 * 2048), d_ = *(const float4*)(ck_ + 32 * 2048 + 4);    \
        lk0 = make_uint4(pack2(a_.x, a_.y), pack2(a_.z, a_.w), pack2(b_.x, b_.y), pack2(b_.z, b_.w)); \
        lk1 = make_uint4(pack2(c_.x, c_.y), pack2(c_.z, c_.w), pack2(d_.x, d_.y), pack2(d_.z, d_.w)); \
        a_ = *(const float4*)cv_; b_ = *(const float4*)(cv_ + 4);                                     \
        c_ = *(const float4*)(cv_ + 32 * 2048); d_ = *(const float4*)(cv_ + 32 * 2048 + 4);           \
        lv0 = make_uint4(pack2(a_.x, a_.y), pack2(a_.z, a_.w), pack2(b_.x, b_.y), pack2(b_.z, b_.w)); \
        lv1 = make_uint4(pack2(c_.x, c_.y), pack2(c_.z, c_.w), pack2(d_.x, d_.y), pack2(d_.z, d_.w)); \
      } else {                                                                                        \
        const size_t o0_ = (size_t)(tokk0 + kx0_) * 2048 + h * 128 + lch * 8;                         \
        const size_t o1_ = o0_ + (size_t)32 * 2048;                                                   \
        if (kx0_ < nkeys) { lk0 = *(const uint4*)(KB + o0_); lv0 = *(const uint4*)(VB + o0_); }       \
        else { lk0 = make_uint4(0, 0, 0, 0); lv0 = lk0; }                                             \
        if (kx1_ < nkeys) { lk1 = *(const uint4*)(KB + o1_); lv1 = *(const uint4*)(VB + o1_); }       \
        else { lk1 = make_uint4(0, 0, 0, 0); lv1 = lk1; }                                             \
      }                                                                                               \
    }
#define ATT_STORE(st)                                                                                 \
    {                                                                                                 \
      char* sK_ = smem + (st) * 32768; char* sV_ = sK_ + 16384;                                       \
      *(uint4*)(sK_ + lw0) = lk0; *(uint4*)(sK_ + lw1) = lk1;                                         \
      *(uint4*)(sV_ + lw0) = lv0; *(uint4*)(sV_ + lw1) = lv1;                                         \
    }
    ATT_LOAD(ntiles - 1);
    ATT_STORE(0);
    __syncthreads();
    for (int it = 0; it < ntiles; ++it) {
      const int kb = ntiles - 1 - it, st = it & 1;
      if (it + 1 < ntiles) ATT_LOAD(kb - 1);
      if (wactive && kb * 64 < qwmax) {
        const char* sK = smem + st * 32768;
        const char* sV = sK + 16384;
        f32x4 S[4];
#pragma unroll
        for (int mt = 0; mt < 4; ++mt) S[mt] = (f32x4){0, 0, 0, 0};
#pragma unroll
        for (int ks = 0; ks < 4; ++ks)
#pragma unroll
          for (int mt = 0; mt < 4; ++mt) {
            bf16x8 a = *(const bf16x8*)(sK + off_b(mt * 16 + fr, ks * 4 + fq));
            S[mt] = __builtin_amdgcn_mfma_f32_16x16x32_bf16(a, qf[ks], S[mt], 0, 0, 0);
          }
        bf16x8 wf[2];
        {
          float ee[4][4], tot[4], hi[4];
#pragma unroll
          for (int mt = 0; mt < 4; ++mt) {
            const int kbase = kb * 64 + mt * 16 + fq * 4;
            float ls[4];
#pragma unroll
            for (int jj = 0; jj < 4; ++jj) {
              const float u = S[mt][jj];
              const bool valid = (kbase + jj) < qp;
              const float l = -__builtin_amdgcn_logf(1.0f + __builtin_amdgcn_exp2f(u));
              ls[jj] = valid ? l : 0.f;
              ee[mt][jj] = valid ? (u + l) : -1e30f;
            }
            const float x3 = ls[3], x2 = x3 + ls[2], x1 = x2 + ls[1], seg = x1 + ls[0];
            ee[mt][2] += x3; ee[mt][1] += x2; ee[mt][0] += x1;
            const float t1 = __shfl_xor(seg, 16), t2 = __shfl_xor(seg, 32), t3 = __shfl_xor(t1, 32);
            tot[mt] = seg + t1 + t2 + t3;
            hi[mt] = fq == 0 ? (t1 + t2 + t3) : fq == 1 ? (t2 + t3) : fq == 2 ? t1 : 0.f;
          }
          float run = carry;
          float wv[4][4];
#pragma unroll
          for (int mt = 3; mt >= 0; --mt) {
            const float base = run + hi[mt];
            run += tot[mt];
#pragma unroll
            for (int jj = 0; jj < 4; ++jj) wv[mt][jj] = __builtin_amdgcn_exp2f(ee[mt][jj] + base);
          }
          carry = run;
#pragma unroll
          for (int p2 = 0; p2 < 2; ++p2) {
            uint4 pk;
            pk.x = pack2(wv[2 * p2][0], wv[2 * p2][1]); pk.y = pack2(wv[2 * p2][2], wv[2 * p2][3]);
            pk.z = pack2(wv[2 * p2 + 1][0], wv[2 * p2 + 1][1]); pk.w = pack2(wv[2 * p2 + 1][2], wv[2 * p2 + 1][3]);
            wf[p2] = *(bf16x8*)&pk;
          }
        }
#pragma unroll
        for (int p2 = 0; p2 < 2; ++p2)
#pragma unroll
          for (int dt = 0; dt < 8; ++dt) {
            const unsigned r0 = 32 * p2 + 4 * fq + tq, r1 = r0 + 16;
            const unsigned ch = 2 * dt + (tp >> 1);
            const char* a0 = sV + off_b(r0, ch) + 8 * (tp & 1);
            const char* a1 = sV + off_b(r1, ch) + 8 * (tp & 1);
            s16x4 lo = __builtin_amdgcn_ds_read_tr16_b64_v4i16((s16x4 __attribute__((address_space(3)))*)(a0));
            s16x4 hi4 = __builtin_amdgcn_ds_read_tr16_b64_v4i16((s16x4 __attribute__((address_space(3)))*)(a1));
            bf16x8 a = {lo[0], lo[1], lo[2], lo[3], hi4[0], hi4[1], hi4[2], hi4[3]};
            O[dt] = __builtin_amdgcn_mfma_f32_16x16x32_bf16(a, wf[p2], O[dt], 0, 0, 0);
          }
      }
      if (it + 1 < ntiles) ATT_STORE(st ^ 1);
      __syncthreads();
    }
#undef ATT_LOAD
#undef ATT_STORE
    if (wactive) {
      const size_t rowoff = (size_t)(tokq0 + w * 16 + fr) * 2048 + h * 128;
#pragma unroll
      for (int dt = 0; dt < 8; ++dt) {
        const int d = dt * 16 + fq * 4;
        uint2 z = *(const uint2*)(ZS + rowoff + d);
        f32x4 v = O[dt];
        uint2 o;
        o.x = pack2(v[0] * bflo(z.x), v[1] * bfhi(z.x)); o.y = pack2(v[2] * bflo(z.y), v[3] * bfhi(z.y));
        *(uint2*)(OG + rowoff + d) = o;
      }
    }
  }
}

__global__ void __launch_bounds__(NTHREADS) mega(Params p, int lo, int hi) {
  __shared__ __attribute__((aligned(16))) char smem[147456];
  cg::grid_group grid = cg::this_grid();
#define RUN_PHASE(k, call) if ((k) >= lo && (k) < hi) { if ((k) > lo) grid.sync(); call; }
  RUN_PHASE(0, phase_prep(p, smem))
  RUN_PHASE(1, phase_norm0(p))
  RUN_PHASE(2, phase_proj0(p, smem))
  RUN_PHASE(3, phase_scan(p, smem))
  RUN_PHASE(4, phase_outproj<0>(p, smem))
  RUN_PHASE(5, phase_norm1(p))
  RUN_PHASE(6, phase_proj1(p, smem))
  RUN_PHASE(7, phase_attn(p, smem))
  RUN_PHASE(8, phase_outproj<1>(p, smem))
}

#ifndef N_LAUNCH_MODE
#define N_LAUNCH_MODE 1
#endif

extern "C" void kernel_launch(void* const* d_in, const int* in_sizes, int n_in, void* d_out, int out_size, void* d_ws, size_t ws_size,
                              hipStream_t stream) {
  Params p{};
  for (int i = 0; i < 36; ++i) p.in[i] = (const float*)d_in[i];
  p.out = (float*)d_out;
  p.ws = (char*)d_ws;
  static int grid_blocks = 0;
  if (!grid_blocks) {
    int dev = 0, cus = 0, per_cu = 0;
    hipGetDevice(&dev);
    hipDeviceGetAttribute(&cus, hipDeviceAttributeMultiprocessorCount, dev);
    hipOccupancyMaxActiveBlocksPerMultiprocessor(&per_cu, mega, NTHREADS, 0);
    if (per_cu < 1) per_cu = 1;
    grid_blocks = cus * per_cu;
  }
  if (ws_size < WS_END) { fprintf(stderr, "workspace too small: %zu < %llu\n", ws_size, (unsigned long long)WS_END); return; }
#if N_LAUNCH_MODE == 1
  int lo = 0, hi = 9;
  void* args[] = {&p, &lo, &hi};
  hipError_t e = hipLaunchCooperativeKernel((void*)mega, dim3(grid_blocks), dim3(NTHREADS), args, 0, stream);
  if (e != hipSuccess) fprintf(stderr, "cooperative launch failed: %s (grid %d)\n", hipGetErrorString(e), grid_blocks);
#else
  for (int ph = 0; ph < 9; ++ph) hipLaunchKernelGGL(mega, dim3(grid_blocks), dim3(NTHREADS), 0, stream, p, ph, ph + 1);
#endif
}
```

```cpp
#include <hip/hip_runtime.h>
#include <hip/hip_cooperative_groups.h>
#include <cstdio>
namespace cg = cooperative_groups;

typedef unsigned short u16;
typedef short bf16x8 __attribute__((ext_vector_type(8)));
typedef short s16x4 __attribute__((ext_vector_type(4)));
typedef float f32x4 __attribute__((ext_vector_type(4)));
typedef float f32x2 __attribute__((ext_vector_type(2)));
typedef __bf16 bf16x2_t __attribute__((ext_vector_type(2)));

#define DEV __device__ __forceinline__

#define NTOK 33280
#define TP 32768
#define NTHREADS 512

#define OFF_Y_P 0
#define OFF_Y_S 33554432
#define OFF_K_P 34078720
#define OFF_V_P 101187584
#define OFF_WKV_P 168296448
#define OFF_SH_P 169345024
#define OFF_K_S 169353216
#define OFF_V_S 170401792
#define OFF_WKV_S 171450368
#define OFF_SH_S 173547520

#define SLOT 136314880ull
#define WS_W (7ull * SLOT)
#define WS_WT_IN (WS_W)
#define WS_WT_OUTA (WS_WT_IN + 16777216ull)
#define WS_WT_KV (WS_WT_OUTA + 4194304ull)
#define WS_WT_INB (WS_WT_KV + 8388608ull)
#define WS_WT_OUTB (WS_WT_INB + 8388608ull)
#define WS_W2T (WS_WT_OUTB + 4194304ull)
#define WS_A2T (WS_W2T + 262144ull)
#define WS_L1T (WS_A2T + 262144ull)
#define WS_MOD (WS_L1T + 524288ull)
#define WS_SH (WS_MOD + 589824ull)
#define WS_CTR (WS_SH + 49152ull)
#define WS_END (WS_CTR + 4096ull)
#define WS_H0 (6ull * SLOT)
#define WS_T (6ull * SLOT + 68157440ull)

struct Params {
  const float* in[36];
  float* out;
  char* ws;
};

enum { I_XP = 0, I_XS, I_CK, I_CV, I_SWKV, I_SSH, I_CP, I_CS, I_ANG, I_AADAW, I_AADAB, I_AWIN, I_AMUIN, I_AMUW, I_AMUA,
       I_AW0, I_AW1, I_AW2, I_AA0, I_AA1, I_AA2, I_AKK, I_AKA, I_ARK, I_ALNG, I_ALNB, I_AWOUT, I_KVNG, I_KVW, I_KGAIN,
       I_BNG, I_BADAW, I_BADAB, I_BWIN, I_BQG, I_BWOUT };

DEV int seq_of(int t) { return t < TP ? (t >> 12) : 8 + ((t - TP) >> 5); }
DEV bool seq_start(int t) { return t < TP ? ((t & 4095) == 0) : (((t - TP) & 31) == 0); }

DEV unsigned pack2(float a, float b) {
  f32x2 v = {a, b};
  bf16x2_t r = __builtin_convertvector(v, bf16x2_t);
  return *(unsigned*)&r;
}
DEV float bflo(unsigned w) { return __uint_as_float(w << 16); }
DEV float bfhi(unsigned w) { return __uint_as_float(w & 0xffff0000u); }
DEV void unpack8(const uint4& x, float* f) {
  f[0] = bflo(x.x); f[1] = bfhi(x.x); f[2] = bflo(x.y); f[3] = bfhi(x.y);
  f[4] = bflo(x.z); f[5] = bfhi(x.z); f[6] = bflo(x.w); f[7] = bfhi(x.w);
}
DEV float sigmoidf_(float x) { return 1.0f / (1.0f + __expf(-x)); }

template <int CTRL>
DEV float dppf(float x) {
  return __int_as_float(__builtin_amdgcn_update_dpp(0, __float_as_int(x), CTRL, 0xf, 0xf, true));
}
DEV float red4(float x) { x += dppf<0xB1>(x); x += dppf<0x4E>(x); return x; }
DEV float red8(float x) { x = red4(x); x += dppf<0x141>(x); return x; }
DEV float red16(float x) { x = red8(x); x += dppf<0x140>(x); return x; }
DEV float wave_sum(float x) {
#pragma unroll
  for (int o = 32; o >= 1; o >>= 1) x += __shfl_xor(x, o);
  return x;
}


#define SCHED_SLOT_OFF 147440
DEV unsigned* sched_ctr(const Params& p, int phase_slot) { return (unsigned*)(p.ws + WS_CTR) + (phase_slot * 8 + (blockIdx.x & 7)) * 16; }
DEV int sched_first(unsigned* ctr, char* smem) {
  int* slot = (int*)(smem + SCHED_SLOT_OFF);
  __syncthreads();
  if (threadIdx.x == 0) *slot = (int)atomicAdd(ctr, 1u);
  __syncthreads();
  return *slot;
}
DEV int sched_prefetch(unsigned* ctr) { return threadIdx.x == 0 ? (int)atomicAdd(ctr, 1u) : 0; }
DEV int sched_commit(int nxt, char* smem) {
  int* slot = (int*)(smem + SCHED_SLOT_OFF);
  __syncthreads();
  if (threadIdx.x == 0) *slot = nxt;
  __syncthreads();
  return *slot;
}

#define GEMM_STAGE_BYTES 49152

template <int AMODE>
DEV void gemm_main(f32x4 (&acc)[4][4], const u16* __restrict__ A, int lda, const u16* __restrict__ Bt, int ldb, int nk,
                   int m0, int n0, const float* __restrict__ mu, const u16* __restrict__ SH, char* smem) {
  const int tid = threadIdx.x, lane = tid & 63, wid = tid >> 6, wr = wid >> 1, wc = wid & 1, fr = lane & 15, fq = lane >> 4;
  const int lrow = tid >> 3, lch = tid & 7;
#pragma unroll
  for (int i = 0; i < 4; ++i)
#pragma unroll
    for (int j = 0; j < 4; ++j) acc[i][j] = (f32x4){0.f, 0.f, 0.f, 0.f};

  const u16* pa0; const u16* pa1; const u16* pa2; const u16* pa3;
  const u16* pp0 = nullptr;
  const int arow = 4 * lrow;
  {
    int m = m0 + arow;
    pa0 = A + (size_t)m * lda + lch * 8;
    pa1 = pa0 + lda; pa2 = pa1 + lda; pa3 = pa2 + lda;
    if (AMODE != 0) pp0 = seq_start(m) ? SH + seq_of(m) * 1024 + lch * 8 : pa0 - lda;
  }
  const u16* pb0 = Bt + (size_t)(n0 + lrow) * ldb + lch * 8;
  const u16* pb1 = pb0 + (size_t)64 * ldb;
  const int woffB = lrow * 128 + ((lch ^ ((lrow >> 1) & 7)) << 4);
  const int woffA0 = (arow + 0) * 128 + ((lch ^ (((arow + 0) >> 1) & 7)) << 4);
  const int woffA1 = (arow + 1) * 128 + ((lch ^ (((arow + 1) >> 1) & 7)) << 4);
  const int woffA2 = (arow + 2) * 128 + ((lch ^ (((arow + 2) >> 1) & 7)) << 4);
  const int woffA3 = (arow + 3) * 128 + ((lch ^ (((arow + 3) >> 1) & 7)) << 4);

  uint4 ra0, ra1, ra2, ra3, rp0, rb0, rb1;
  float4 mu0, mu1;
  rp0 = make_uint4(0, 0, 0, 0);
  mu0 = mu1 = make_float4(0, 0, 0, 0);

#define G_LOAD(kt)                                                                     \
  {                                                                                    \
    const int k0_ = (kt) * 64;                                                         \
    if (AMODE == 0) {                                                                  \
      ra0 = *(const uint4*)(pa0 + k0_); ra1 = *(const uint4*)(pa1 + k0_);              \
      ra2 = *(const uint4*)(pa2 + k0_); ra3 = *(const uint4*)(pa3 + k0_);              \
    } else if (AMODE == 1) {                                                           \
      ra0 = *(const uint4*)(pa0 + k0_); ra1 = *(const uint4*)(pa1 + k0_);              \
      ra2 = *(const uint4*)(pa2 + k0_); ra3 = *(const uint4*)(pa3 + k0_);              \
      rp0 = *(const uint4*)(pp0 + k0_);                                                \
      mu0 = *(const float4*)(mu + k0_ + lch * 8); mu1 = *(const float4*)(mu + k0_ + lch * 8 + 4); \
    } else {                                                                           \
      const int kk_ = k0_ & 1023;                                                      \
      ra0 = *(const uint4*)(pa0 + kk_); ra1 = *(const uint4*)(pa1 + kk_);              \
      ra2 = *(const uint4*)(pa2 + kk_); ra3 = *(const uint4*)(pa3 + kk_);              \
      if (k0_ >= 1024) rp0 = *(const uint4*)(pp0 + kk_);                               \
    }                                                                                  \
    rb0 = *(const uint4*)(pb0 + k0_); rb1 = *(const uint4*)(pb1 + k0_);                \
  }

#define G_XFORM(dst, a_, p_, kt)                                                       \
  {                                                                                    \
    if (AMODE == 0) dst = a_;                                                          \
    else if (AMODE == 1) {                                                             \
      float h_[8], q_[8]; unpack8(a_, h_); unpack8(p_, q_);                            \
      dst.x = pack2(h_[0] + mu0.x * (q_[0] - h_[0]), h_[1] + mu0.y * (q_[1] - h_[1])); \
      dst.y = pack2(h_[2] + mu0.z * (q_[2] - h_[2]), h_[3] + mu0.w * (q_[3] - h_[3])); \
      dst.z = pack2(h_[4] + mu1.x * (q_[4] - h_[4]), h_[5] + mu1.y * (q_[5] - h_[5])); \
      dst.w = pack2(h_[6] + mu1.z * (q_[6] - h_[6]), h_[7] + mu1.w * (q_[7] - h_[7])); \
    } else {                                                                           \
      if ((kt) * 64 >= 1024) {                                                         \
        float h_[8], q_[8]; unpack8(a_, h_); unpack8(p_, q_);                          \
        dst.x = pack2(q_[0] - h_[0], q_[1] - h_[1]); dst.y = pack2(q_[2] - h_[2], q_[3] - h_[3]); \
        dst.z = pack2(q_[4] - h_[4], q_[5] - h_[5]); dst.w = pack2(q_[6] - h_[6], q_[7] - h_[7]); \
      } else dst = a_;                                                                 \
    }                                                                                  \
  }

#define G_STORE(stage, kt)                                                             \
  {                                                                                    \
    char* sA_ = smem + (stage) * GEMM_STAGE_BYTES; char* sB_ = sA_ + 32768;            \
    uint4 v_;                                                                          \
    G_XFORM(v_, ra0, rp0, kt); *(uint4*)(sA_ + woffA0) = v_;                           \
    G_XFORM(v_, ra1, ra0, kt); *(uint4*)(sA_ + woffA1) = v_;                           \
    G_XFORM(v_, ra2, ra1, kt); *(uint4*)(sA_ + woffA2) = v_;                           \
    G_XFORM(v_, ra3, ra2, kt); *(uint4*)(sA_ + woffA3) = v_;                           \
    *(uint4*)(sB_ + woffB) = rb0; *(uint4*)(sB_ + woffB + 64 * 128) = rb1;             \
  }

  G_LOAD(0);
  G_STORE(0, 0);
  __syncthreads();
  const int rsw = (fr >> 1) & 7;
  for (int kt = 0; kt < nk; ++kt) {
    const int st = kt & 1;
    if (kt + 1 < nk) G_LOAD(kt + 1);
    {
      const char* sA = smem + st * GEMM_STAGE_BYTES;
      const char* sB = sA + 32768;
#pragma unroll
      for (int kk = 0; kk < 2; ++kk) {
        bf16x8 af[4], bfr[4];
        const int cho = ((kk * 4 + fq) ^ rsw) << 4;
#pragma unroll
        for (int i = 0; i < 4; ++i) af[i] = *(const bf16x8*)(sA + (wr * 64 + i * 16 + fr) * 128 + cho);
#pragma unroll
        for (int j = 0; j < 4; ++j) bfr[j] = *(const bf16x8*)(sB + (wc * 64 + j * 16 + fr) * 128 + cho);
#pragma unroll
        for (int i = 0; i < 4; ++i)
#pragma unroll
          for (int j = 0; j < 4; ++j) acc[i][j] = __builtin_amdgcn_mfma_f32_16x16x32_bf16(bfr[j], af[i], acc[i][j], 0, 0, 0);
      }
    }
    if (kt + 1 < nk) G_STORE(st ^ 1, kt + 1);
    __syncthreads();
  }
#undef G_LOAD
#undef G_XFORM
#undef G_STORE
}

DEV void transpose_tile(const float* __restrict__ src, int N, int k0, int n0, const float* __restrict__ scale, u16* __restrict__ dst,
                        int dstride, int drow0, int dcol0, char* smem) {
  float* tile = (float*)smem;
  const int tid = threadIdx.x;
#pragma unroll
  for (int i = 0; i < 2; ++i) {
    int kl = (tid >> 4) + 32 * i, n4 = (tid & 15) * 4;
    float4 v = *(const float4*)(src + (size_t)(k0 + kl) * N + n0 + n4);
    float s = scale ? scale[k0 + kl] : 1.0f;
    tile[kl * 65 + n4 + 0] = v.x * s; tile[kl * 65 + n4 + 1] = v.y * s;
    tile[kl * 65 + n4 + 2] = v.z * s; tile[kl * 65 + n4 + 3] = v.w * s;
  }
  __syncthreads();
  {
    int nl = tid >> 3, k8 = (tid & 7) * 8;
    uint4 o;
    o.x = pack2(tile[(k8 + 0) * 65 + nl], tile[(k8 + 1) * 65 + nl]);
    o.y = pack2(tile[(k8 + 2) * 65 + nl], tile[(k8 + 3) * 65 + nl]);
    o.z = pack2(tile[(k8 + 4) * 65 + nl], tile[(k8 + 5) * 65 + nl]);
    o.w = pack2(tile[(k8 + 6) * 65 + nl], tile[(k8 + 7) * 65 + nl]);
    *(uint4*)(dst + (size_t)(drow0 + n0 + nl) * dstride + dcol0 + k0 + k8) = o;
  }
  __syncthreads();
}

DEV void phase_prep(const Params& p, char* smem) {
  const int tid = threadIdx.x;
  char* ws = p.ws;
  if (blockIdx.x < 96) {
    float* cL = (float*)smem;
    float* red = (float*)(smem + 98304);
    for (int e = tid; e < 24 * 256; e += NTHREADS) {
      int s = e >> 8, k4 = (e & 255) * 4;
      float4 v = s < 8 ? *(const float4*)(p.in[I_CP] + s * 1024 + k4) : *(const float4*)(p.in[I_CS] + (s - 8) * 1024 + k4);
      *(float4*)(cL + s * 1024 + k4) = v;
    }
    __syncthreads();
    for (int item = blockIdx.x; item < 96; item += gridDim.x) {
      const int l = item / 48, j0 = (item % 48) * 64;
      const float* W = (l == 0 ? p.in[I_AADAW] : p.in[I_BADAW]);
      const float* bias = (l == 0 ? p.in[I_AADAB] : p.in[I_BADAB]);
      const int col = tid & 63, kg = tid >> 6;
      float acc[24];
#pragma unroll
      for (int s = 0; s < 24; ++s) acc[s] = 0.f;
      for (int k = kg * 128; k < kg * 128 + 128; ++k) {
        float w = W[(size_t)k * 3072 + j0 + col];
#pragma unroll
        for (int s = 0; s < 24; ++s) acc[s] += cL[s * 1024 + k] * w;
      }
#pragma unroll
      for (int s = 0; s < 24; ++s) red[(kg * 24 + s) * 64 + col] = acc[s];
      __syncthreads();
      float* mod = (float*)(ws + WS_MOD);
      for (int e = tid; e < 24 * 64; e += NTHREADS) {
        int s = e >> 6, c = e & 63;
        float t = bias[j0 + c];
#pragma unroll
        for (int g = 0; g < 8; ++g) t += red[(g * 24 + s) * 64 + c];
        mod[(size_t)(l * 24 + s) * 3072 + j0 + c] = t;
      }
      __syncthreads();
    }
  }
  if (blockIdx.x == 0) for (int e = tid; e < 1024; e += NTHREADS) ((unsigned*)(ws + WS_CTR))[tid] = 0u;
  if (blockIdx.x == gridDim.x - 1) {
    u16* SH = (u16*)(ws + WS_SH);
    for (int e = tid; e < 24 * 1024; e += NTHREADS) {
      int s = e >> 10, k = e & 1023;
      float v = s < 8 ? 0.f : p.in[I_SSH][(s - 8) * 1024 + k];
      SH[e] = (u16)(pack2(v, 0.f) & 0xffff);
    }
  }
  const int NT_TOTAL = 2048 + 512 + 1024 + 1024 + 512 + 32 + 32 + 64;
  for (int t = blockIdx.x; t < NT_TOTAL; t += gridDim.x) {
    const float* src; int K, N; u16* dst; int dstride, drow0 = 0, dcol0 = 0; const float* scale = nullptr; int tt = t;
    if (tt < 2048) { src = p.in[I_AWIN]; K = 1024; N = 8192; dst = (u16*)(ws + WS_WT_IN); dstride = 1024; }
    else if ((tt -= 2048) < 512) { src = p.in[I_AWOUT]; K = 2048; N = 1024; dst = (u16*)(ws + WS_WT_OUTA); dstride = 2048; }
    else if ((tt -= 512) < 1024) { src = p.in[I_KVW]; K = 1024; N = 4096; dst = (u16*)(ws + WS_WT_KV); dstride = 1024; }
    else if ((tt -= 1024) < 1024) { src = p.in[I_BWIN]; K = 1024; N = 4096; dst = (u16*)(ws + WS_WT_INB); dstride = 1024; }
    else if ((tt -= 1024) < 512) { src = p.in[I_BWOUT]; K = 2048; N = 1024; dst = (u16*)(ws + WS_WT_OUTB); dstride = 2048; }
    else if ((tt -= 512) < 32) { src = p.in[I_AW2]; K = 64; N = 2048; dst = (u16*)(ws + WS_W2T); dstride = 64; }
    else if ((tt -= 32) < 32) { src = p.in[I_AA2]; K = 64; N = 2048; dst = (u16*)(ws + WS_A2T); dstride = 64; }
    else {
      tt -= 32;
      int job = tt >> 4; tt &= 15;
      K = 1024; N = 64; dst = (u16*)(ws + WS_L1T); dstride = 2048;
      src = (job < 2) ? p.in[I_AW1] : p.in[I_AA1];
      drow0 = (job < 2) ? 0 : 64;
      if (job & 1) { dcol0 = 1024; scale = (job < 2) ? p.in[I_AMUW] : p.in[I_AMUA]; }
    }
    const int ntn = N / 64;
    const int kt = tt / ntn, nt = tt % ntn;
    transpose_tile(src, N, kt * 64, nt * 64, scale, dst, dstride, drow0, dcol0, smem);
  }
}

DEV void phase_norm0(const Params& p) {
  const int lane = threadIdx.x & 63, wid = threadIdx.x >> 6;
  const float* mod = (const float*)(p.ws + WS_MOD);
  u16* H0 = (u16*)(p.ws + WS_H0);
  const float* g = p.in[I_ANG];
  for (int t = blockIdx.x * 8 + wid; t < NTOK; t += gridDim.x * 8) {
    const float* x = t < TP ? p.in[I_XP] + (size_t)t * 1024 : p.in[I_XS] + (size_t)(t - TP) * 1024;
    const int s = seq_of(t);
    const float* md = mod + (size_t)s * 3072;
    float4 v[4];
    float ss = 0.f;
#pragma unroll
    for (int i = 0; i < 4; ++i) {
      v[i] = *(const float4*)(x + lane * 4 + 256 * i);
      ss += v[i].x * v[i].x + v[i].y * v[i].y + v[i].z * v[i].z + v[i].w * v[i].w;
    }
    ss = wave_sum(ss);
    const float rstd = rsqrtf(ss * (1.0f / 1024.0f) + 1e-6f);
    bool last = t < TP ? ((t & 4095) == 4095) : (((t - TP) & 31) == 31);
    float* so = t < TP ? p.out + OFF_SH_P + (t >> 12) * 1024 : p.out + OFF_SH_S + ((t - TP) >> 5) * 1024;
#pragma unroll
    for (int i = 0; i < 4; ++i) {
      const int c = lane * 4 + 256 * i;
      float4 gg = *(const float4*)(g + c), sh = *(const float4*)(md + c), sc = *(const float4*)(md + 1024 + c);
      float4 h;
      h.x = v[i].x * rstd * gg.x * (1.f + sc.x) + sh.x;
      h.y = v[i].y * rstd * gg.y * (1.f + sc.y) + sh.y;
      h.z = v[i].z * rstd * gg.z * (1.f + sc.z) + sh.z;
      h.w = v[i].w * rstd * gg.w * (1.f + sc.w) + sh.w;
      uint2 o; o.x = pack2(h.x, h.y); o.y = pack2(h.z, h.w);
      *(uint2*)(H0 + (size_t)t * 1024 + c) = o;
      if (last) *(float4*)(so + c) = h;
    }
  }
}

DEV void phase_proj0(const Params& p, char* smem) {
  const int tid = threadIdx.x, lane = tid & 63, wid = tid >> 6, wr = wid >> 1, wc = wid & 1, fr = lane & 15, fq = lane >> 4;
  char* ws = p.ws;
  const u16* H0 = (const u16*)(ws + WS_H0);
  const u16* SH = (const u16*)(ws + WS_SH);
  u16* T = (u16*)(ws + WS_T);
  f32x4 acc[4][4];
  unsigned* ctr = sched_ctr(p, 0);
  const int xcd = blockIdx.x & 7;
  int nxt;
  for (int li = sched_first(ctr, smem); li < 17 + 1040; li = sched_commit(nxt, smem)) {
    nxt = sched_prefetch(ctr);
    if (li < 17) {
      const int lmt = xcd + 8 * li;
      if (lmt >= 130) continue;
      const int m0 = lmt * 256;
      gemm_main<2>(acc, H0, 1024, (const u16*)(ws + WS_L1T), 2048, 32, m0, 0, nullptr, SH, smem);
#pragma unroll
      for (int i = 0; i < 4; ++i)
#pragma unroll
        for (int j = 0; j < 4; ++j) {
          const int m = m0 + wr * 64 + i * 16 + fr, n = wc * 64 + j * 16 + fq * 4;
          f32x4 v = acc[i][j];
          if (wc == 0) { v[0] = tanhf(v[0]); v[1] = tanhf(v[1]); v[2] = tanhf(v[2]); v[3] = tanhf(v[3]); }
          uint2 o; o.x = pack2(v[0], v[1]); o.y = pack2(v[2], v[3]);
          *(uint2*)(T + (size_t)m * 128 + n) = o;
        }
      __threadfence_block();
      __syncthreads();
      for (int nt = 0; nt < 32; ++nt) {
        const int which = nt >> 4, n0 = (nt & 15) * 128;
        gemm_main<0>(acc, T + which * 64, 128, (const u16*)(ws + (which ? WS_A2T : WS_W2T)), 64, 1, m0, n0, nullptr, nullptr, smem);
        const float* bias = which ? p.in[I_AA0] : p.in[I_AW0];
        u16* dst = (u16*)(ws + (which ? 5ull : 4ull) * SLOT);
#pragma unroll
        for (int i = 0; i < 4; ++i)
#pragma unroll
          for (int j = 0; j < 4; ++j) {
            const int m = m0 + wr * 64 + i * 16 + fr, n = n0 + wc * 64 + j * 16 + fq * 4;
            float4 b4 = *(const float4*)(bias + n);
            f32x4 v = acc[i][j];
            float s0 = sigmoidf_(v[0] + b4.x), s1 = sigmoidf_(v[1] + b4.y), s2 = sigmoidf_(v[2] + b4.z), s3 = sigmoidf_(v[3] + b4.w);
            if (!which) { s0 *= -0.60653066f; s1 *= -0.60653066f; s2 *= -0.60653066f; s3 *= -0.60653066f; }
            uint2 o; o.x = pack2(s0, s1); o.y = pack2(s2, s3);
            *(uint2*)(dst + (size_t)m * 2048 + n) = o;
          }
      }
    } else {
      const int q = li - 17;
      const int mt = q >> 3, nt = 8 * xcd + (q & 7);
      const int part = nt >> 4;
      const int m0 = mt * 256, n0 = nt * 128;
      gemm_main<1>(acc, H0, 1024, (const u16*)(ws + WS_WT_IN), 1024, 16, m0, n0, p.in[I_AMUIN] + part * 1024, SH, smem);
      u16* dst = (u16*)(ws + (size_t)part * SLOT);
      const int nb = n0 - part * 2048;
#pragma unroll
      for (int i = 0; i < 4; ++i)
#pragma unroll
        for (int j = 0; j < 4; ++j) {
          const int m = m0 + wr * 64 + i * 16 + fr, n = nb + wc * 64 + j * 16 + fq * 4;
          f32x4 v = acc[i][j];
          uint2 o; o.x = pack2(v[0], v[1]); o.y = pack2(v[2], v[3]);
          *(uint2*)(dst + (size_t)m * 2048 + n) = o;
        }
    }
  }
}

DEV void phase_scan(const Params& p, char* smem) {
  const int tid = threadIdx.x, lane = tid & 63, wid = tid >> 6;
  float* Lkk = (float*)smem;
  float* Lw = Lkk + 4096;
  float* Lb = Lw + 4096;
  float* Lk = Lb + 4096;
  float* Lr = Lk + 4096;
  float* Lv = Lr + 4096;
  float* LY = Lv + 4096;
  float* Lbon = LY + 4096;
  char* ws = p.ws;
  const u16* gR = (const u16*)(ws + 0 * SLOT);
  const u16* gK = (const u16*)(ws + 1 * SLOT);
  const u16* gV = (const u16*)(ws + 2 * SLOT);
  const u16* gZ = (const u16*)(ws + 3 * SLOT);
  const u16* gW = (const u16*)(ws + 4 * SLOT);
  const u16* gA = (const u16*)(ws + 5 * SLOT);
  u16* YG = (u16*)(ws + 6 * SLOT);
  const int tt = tid >> 3, c8 = (tid & 7) * 8;
  const int rp = wid * 4 + (lane >> 4), kc = lane & 15;

  for (int item = blockIdx.x; item < 768; item += gridDim.x) {
    int h, tok0, nsteps; const float* sinit; float* sout;
    if (item < 256) { h = item & 31; tok0 = (item >> 5) * 4096; nsteps = 4096; sinit = nullptr; sout = p.out + OFF_WKV_P + (size_t)item * 4096; }
    else { int it = item - 256; h = it & 31; tok0 = TP + (it >> 5) * 32; nsteps = 32; sinit = p.in[I_SWKV] + (size_t)it * 4096; sout = p.out + OFF_WKV_S + (size_t)it * 4096; }
    const int nch = (nsteps + 63) >> 6;
    const int col0 = h * 64 + c8;
    float s0[4], s1[4];
    if (sinit) {
      float4 a = *(const float4*)(sinit + (2 * rp) * 64 + kc * 4), b = *(const float4*)(sinit + (2 * rp + 1) * 64 + kc * 4);
      s0[0] = a.x; s0[1] = a.y; s0[2] = a.z; s0[3] = a.w; s1[0] = b.x; s1[1] = b.y; s1[2] = b.z; s1[3] = b.w;
    } else {
#pragma unroll
      for (int j = 0; j < 4; ++j) { s0[j] = 0.f; s1[j] = 0.f; }
    }
    uint4 cr, ck, cv, cz, cw, ca;
#define SCAN_LOAD(c)                                                                   \
    {                                                                                  \
      const int tl_ = (c) * 64 + tt;                                                   \
      if (tl_ < nsteps) {                                                              \
        const size_t o_ = (size_t)(tok0 + tl_) * 2048 + col0;                          \
        cr = *(const uint4*)(gR + o_); ck = *(const uint4*)(gK + o_); cv = *(const uint4*)(gV + o_); \
        cz = *(const uint4*)(gZ + o_); cw = *(const uint4*)(gW + o_); ca = *(const uint4*)(gA + o_); \
      } else { cr = ck = cv = cz = cw = ca = make_uint4(0, 0, 0, 0); }                 \
    }
    SCAN_LOAD(0);
    for (int c = 0; c < nch; ++c) {
      uint4 zc = cz;
      {
        float r[8], k[8], v[8], lw[8], a[8];
        unpack8(cr, r); unpack8(ck, k); unpack8(cv, v); unpack8(cw, lw); unpack8(ca, a);
        float kkv[8], kp[8], bon = 0.f, ss = 0.f;
#pragma unroll
        for (int j = 0; j < 8; ++j) {
          const float kkc = p.in[I_AKK][col0 + j], kac = p.in[I_AKA][col0 + j], rkc = p.in[I_ARK][col0 + j];
          kkv[j] = k[j] * kkc; ss += kkv[j] * kkv[j];
          kp[j] = k[j] * (1.f + (a[j] - 1.f) * kac);
          bon += r[j] * kp[j] * rkc;
        }
        ss = red8(ss); bon = red8(bon);
        const float inv = rsqrtf(ss + 1e-12f);
        float4 o0, o1;
        float* d;
        d = Lkk + tt * 64 + c8;
        o0 = make_float4(kkv[0] * inv, kkv[1] * inv, kkv[2] * inv, kkv[3] * inv); o1 = make_float4(kkv[4] * inv, kkv[5] * inv, kkv[6] * inv, kkv[7] * inv);
        *(float4*)d = o0; *(float4*)(d + 4) = o1;
        d = Lb + tt * 64 + c8;
        *(float4*)d = make_float4(o0.x * a[0], o0.y * a[1], o0.z * a[2], o0.w * a[3]);
        *(float4*)(d + 4) = make_float4(o1.x * a[4], o1.y * a[5], o1.z * a[6], o1.w * a[7]);
        d = Lw + tt * 64 + c8;
        *(float4*)d = make_float4(__expf(lw[0]), __expf(lw[1]), __expf(lw[2]), __expf(lw[3]));
        *(float4*)(d + 4) = make_float4(__expf(lw[4]), __expf(lw[5]), __expf(lw[6]), __expf(lw[7]));
        d = Lk + tt * 64 + c8;
        *(float4*)d = make_float4(kp[0], kp[1], kp[2], kp[3]); *(float4*)(d + 4) = make_float4(kp[4], kp[5], kp[6], kp[7]);
        d = Lr + tt * 64 + c8;
        *(float4*)d = make_float4(r[0], r[1], r[2], r[3]); *(float4*)(d + 4) = make_float4(r[4], r[5], r[6], r[7]);
        d = Lv + tt * 64 + c8;
        *(float4*)d = make_float4(v[0], v[1], v[2], v[3]); *(float4*)(d + 4) = make_float4(v[4], v[5], v[6], v[7]);
        if ((tid & 7) == 0) Lbon[tt] = bon;
      }
      __syncthreads();
      if (c + 1 < nch) SCAN_LOAD(c + 1);
      {
        const int nT = min(64, nsteps - c * 64);
        const float* pk = Lkk + kc * 4; const float* pw = Lw + kc * 4; const float* pb = Lb + kc * 4;
        const float* pkk = Lk + kc * 4; const float* pr = Lr + kc * 4; const float* pv = Lv + rp * 2;
        float4 kk4 = *(const float4*)pk, w4 = *(const float4*)pw, b4 = *(const float4*)pb, k4 = *(const float4*)pkk, r4 = *(const float4*)pr;
        float2 v2 = *(const float2*)pv;
        for (int t = 0; t < nT; ++t) {
          float4 nkk4 = kk4, nw4 = w4, nb4 = b4, nk4 = k4, nr4 = r4; float2 nv2 = v2;
          if (t + 1 < nT) {
            const int o = (t + 1) * 64;
            nkk4 = *(const float4*)(pk + o); nw4 = *(const float4*)(pw + o); nb4 = *(const float4*)(pb + o);
            nk4 = *(const float4*)(pkk + o); nr4 = *(const float4*)(pr + o); nv2 = *(const float2*)(pv + o);
          }
          float sa0 = s0[0] * kk4.x + s0[1] * kk4.y + s0[2] * kk4.z + s0[3] * kk4.w;
          float sa1 = s1[0] * kk4.x + s1[1] * kk4.y + s1[2] * kk4.z + s1[3] * kk4.w;
          sa0 = red16(sa0); sa1 = red16(sa1);
          s0[0] = s0[0] * w4.x + (v2.x * k4.x - sa0 * b4.x);
          s0[1] = s0[1] * w4.y + (v2.x * k4.y - sa0 * b4.y);
          s0[2] = s0[2] * w4.z + (v2.x * k4.z - sa0 * b4.z);
          s0[3] = s0[3] * w4.w + (v2.x * k4.w - sa0 * b4.w);
          s1[0] = s1[0] * w4.x + (v2.y * k4.x - sa1 * b4.x);
          s1[1] = s1[1] * w4.y + (v2.y * k4.y - sa1 * b4.y);
          s1[2] = s1[2] * w4.z + (v2.y * k4.z - sa1 * b4.z);
          s1[3] = s1[3] * w4.w + (v2.y * k4.w - sa1 * b4.w);
          float y0 = s0[0] * r4.x + s0[1] * r4.y + s0[2] * r4.z + s0[3] * r4.w;
          float y1 = s1[0] * r4.x + s1[1] * r4.y + s1[2] * r4.z + s1[3] * r4.w;
          y0 = red16(y0); y1 = red16(y1);
          if (kc == 0) *(float2*)(LY + t * 64 + rp * 2) = make_float2(y0, y1);
          kk4 = nkk4; w4 = nw4; b4 = nb4; k4 = nk4; r4 = nr4; v2 = nv2;
        }
      }
      __syncthreads();
      {
        const int tl = c * 64 + tt;
        if (tl < nsteps) {
          float y[8], z[8];
          float4 a = *(const float4*)(LY + tt * 64 + c8), b = *(const float4*)(LY + tt * 64 + c8 + 4);
          y[0] = a.x; y[1] = a.y; y[2] = a.z; y[3] = a.w; y[4] = b.x; y[5] = b.y; y[6] = b.z; y[7] = b.w;
          float sm = y[0] + y[1] + y[2] + y[3] + y[4] + y[5] + y[6] + y[7];
          sm = red8(sm);
          const float mean = sm * (1.f / 64.f);
          float vs = 0.f;
#pragma unroll
          for (int j = 0; j < 8; ++j) { y[j] -= mean; vs += y[j] * y[j]; }
          vs = red8(vs);
          const float rstd = rsqrtf(vs * (1.f / 64.f) + 64e-5f);
          const float bon = Lbon[tt];
          float4 va = *(const float4*)(Lv + tt * 64 + c8), vb = *(const float4*)(Lv + tt * 64 + c8 + 4);
          float vv[8] = {va.x, va.y, va.z, va.w, vb.x, vb.y, vb.z, vb.w};
          unpack8(zc, z);
          float o[8];
#pragma unroll
          for (int j = 0; j < 8; ++j) {
            float g = p.in[I_ALNG][col0 + j], bb = p.in[I_ALNB][col0 + j];
            float t = y[j] * rstd * g + bb + bon * vv[j];
            o[j] = t * z[j] * sigmoidf_(z[j]);
          }
          uint4 ov; ov.x = pack2(o[0], o[1]); ov.y = pack2(o[2], o[3]); ov.z = pack2(o[4], o[5]); ov.w = pack2(o[6], o[7]);
          *(uint4*)(YG + (size_t)(tok0 + tl) * 2048 + col0) = ov;
        }
      }
      __syncthreads();
    }
#undef SCAN_LOAD
    *(float4*)(sout + (2 * rp) * 64 + kc * 4) = make_float4(s0[0], s0[1], s0[2], s0[3]);
    *(float4*)(sout + (2 * rp + 1) * 64 + kc * 4) = make_float4(s1[0], s1[1], s1[2], s1[3]);
  }
}

template <int LAYER>
DEV void phase_outproj(const Params& p, char* smem) {
  const int tid = threadIdx.x, lane = tid & 63, wid = tid >> 6, wr = wid >> 1, wc = wid & 1, fr = lane & 15, fq = lane >> 4;
  char* ws = p.ws;
  const u16* A = (const u16*)(ws + 6 * SLOT);
  const u16* Bt = (const u16*)(ws + (LAYER == 0 ? WS_WT_OUTA : WS_WT_OUTB));
  const float* mod = (const float*)(ws + WS_MOD) + (size_t)LAYER * 24 * 3072;
  float* xmid = (float*)(ws + 0 * SLOT);
  f32x4 acc[4][4];
  unsigned* ctr = sched_ctr(p, LAYER == 0 ? 1 : 3);
  int nxt;
  for (int li = sched_first(ctr, smem); li < 130; li = sched_commit(nxt, smem)) {
    nxt = sched_prefetch(ctr);
    const int item = 130 * (blockIdx.x & 7) + li;
    const int m0 = (item >> 3) * 256, n0 = (item & 7) * 128;
    gemm_main<0>(acc, A, 2048, Bt, 2048, 32, m0, n0, nullptr, nullptr, smem);
#pragma unroll
    for (int i = 0; i < 4; ++i) {
      const int m = m0 + wr * 64 + i * 16 + fr;
      const float* gate = mod + (size_t)seq_of(m) * 3072 + 2048;
#pragma unroll
      for (int j = 0; j < 4; ++j) {
        const int n = n0 + wc * 64 + j * 16 + fq * 4;
        float4 g4 = *(const float4*)(gate + n);
        f32x4 v = acc[i][j];
        if (LAYER == 0) {
          const float* xr = m < TP ? p.in[I_XP] + (size_t)m * 1024 : p.in[I_XS] + (size_t)(m - TP) * 1024;
          float4 x4 = *(const float4*)(xr + n);
          *(float4*)(xmid + (size_t)m * 1024 + n) = make_float4(x4.x + g4.x * v[0], x4.y + g4.y * v[1], x4.z + g4.z * v[2], x4.w + g4.w * v[3]);
        } else {
          float4 x4 = *(const float4*)(xmid + (size_t)m * 1024 + n);
          float* yo = m < TP ? p.out + OFF_Y_P + (size_t)m * 1024 : p.out + OFF_Y_S + (size_t)(m - TP) * 1024;
          *(float4*)(yo + n) = make_float4(x4.x + g4.x * v[0], x4.y + g4.y * v[1], x4.z + g4.z * v[2], x4.w + g4.w * v[3]);
        }
      }
    }
  }
}

DEV void phase_norm1(const Params& p) {
  const int lane = threadIdx.x & 63, wid = threadIdx.x >> 6;
  const float* mod = (const float*)(p.ws + WS_MOD) + (size_t)24 * 3072;
  const float* xmid = (const float*)(p.ws + 0 * SLOT);
  u16* AKV = (u16*)(p.ws + 1 * SLOT);
  u16* AQ = AKV + (size_t)NTOK * 1024;
  const float* gkv = p.in[I_KVNG];
  const float* gb = p.in[I_BNG];
  for (int t = blockIdx.x * 8 + wid; t < NTOK; t += gridDim.x * 8) {
    const float* x = xmid + (size_t)t * 1024;
    const float* md = mod + (size_t)seq_of(t) * 3072;
    float4 v[4];
    float ss = 0.f;
#pragma unroll
    for (int i = 0; i < 4; ++i) {
      v[i] = *(const float4*)(x + lane * 4 + 256 * i);
      ss += v[i].x * v[i].x + v[i].y * v[i].y + v[i].z * v[i].z + v[i].w * v[i].w;
    }
    ss = wave_sum(ss);
    const float rstd = rsqrtf(ss * (1.0f / 1024.0f) + 1e-6f);
#pragma unroll
    for (int i = 0; i < 4; ++i) {
      const int c = lane * 4 + 256 * i;
      float4 g1 = *(const float4*)(gkv + c), g2 = *(const float4*)(gb + c), sh = *(const float4*)(md + c), sc = *(const float4*)(md + 1024 + c);
      float xn0 = v[i].x * rstd, xn1 = v[i].y * rstd, xn2 = v[i].z * rstd, xn3 = v[i].w * rstd;
      uint2 o;
      o.x = pack2(xn0 * g1.x, xn1 * g1.y); o.y = pack2(xn2 * g1.z, xn3 * g1.w);
      *(uint2*)(AKV + (size_t)t * 1024 + c) = o;
      o.x = pack2(xn0 * g2.x * (1.f + sc.x) + sh.x, xn1 * g2.y * (1.f + sc.y) + sh.y);
      o.y = pack2(xn2 * g2.z * (1.f + sc.z) + sh.z, xn3 * g2.w * (1.f + sc.w) + sh.w);
      *(uint2*)(AQ + (size_t)t * 1024 + c) = o;
    }
  }
}

#define QSCALE (0.08838834764831845f * 1.4426950408889634f)
DEV void phase_proj1(const Params& p, char* smem) {
  const int tid = threadIdx.x, lane = tid & 63, wid = tid >> 6, wr = wid >> 1, wc = wid & 1, fr = lane & 15, fq = lane >> 4;
  char* ws = p.ws;
  const u16* AKV = (const u16*)(ws + 1 * SLOT);
  const u16* AQ = AKV + (size_t)NTOK * 1024;
  u16* KB = (u16*)(ws + 2 * SLOT);
  u16* VB = (u16*)(ws + 3 * SLOT);
  u16* QB = (u16*)(ws + 4 * SLOT);
  u16* ZS = (u16*)(ws + 5 * SLOT);
  f32x4 acc[4][4];
  float* red = (float*)smem;
  unsigned* ctr = sched_ctr(p, 2);
  int nxt;
  for (int li = sched_first(ctr, smem); li < 1040; li = sched_commit(nxt, smem)) {
    nxt = sched_prefetch(ctr);
    const int mt = li >> 3, t = 8 * (blockIdx.x & 7) + (li & 7);
    const int isq = t >> 5, nt = t & 31;
    const int m0 = mt * 256, n0 = nt * 128;
    gemm_main<0>(acc, isq ? AQ : AKV, 1024, (const u16*)(ws + (isq ? WS_WT_INB : WS_WT_KV)), 1024, 16, m0, n0, nullptr, nullptr, smem);
    if (nt < 16) {
#pragma unroll
      for (int i = 0; i < 4; ++i) {
        float ss = 0.f;
#pragma unroll
        for (int j = 0; j < 4; ++j) ss += acc[i][j][0] * acc[i][j][0] + acc[i][j][1] * acc[i][j][1] + acc[i][j][2] * acc[i][j][2] + acc[i][j][3] * acc[i][j][3];
        red[(wr * 64 + i * 16 + fr) * 8 + wc * 4 + fq] = ss;
      }
      __syncthreads();
      const float* gain = isq ? p.in[I_BQG] : p.in[I_KGAIN];
#pragma unroll
      for (int i = 0; i < 4; ++i) {
        const int row = wr * 64 + i * 16 + fr, m = m0 + row;
        float4 ra = *(const float4*)(red + row * 8), rb = *(const float4*)(red + row * 8 + 4);
        float tot = ra.x + ra.y + ra.z + ra.w + rb.x + rb.y + rb.z + rb.w;
        float rs = rsqrtf(tot * (1.f / 128.f) + 1e-6f);
        if (isq) rs *= QSCALE;
#pragma unroll
        for (int j = 0; j < 4; ++j) {
          const int d = wc * 64 + j * 16 + fq * 4, n = n0 + d;
          float4 g4 = *(const float4*)(gain + d);
          f32x4 v = acc[i][j];
          float o0 = v[0] * rs * g4.x, o1 = v[1] * rs * g4.y, o2 = v[2] * rs * g4.z, o3 = v[3] * rs * g4.w;
          uint2 o; o.x = pack2(o0, o1); o.y = pack2(o2, o3);
          if (isq) {
            *(uint2*)(QB + (size_t)m * 2048 + n) = o;
          } else {
            *(uint2*)(KB + (size_t)m * 2048 + n) = o;
            float* ko = m < TP ? p.out + OFF_K_P + (size_t)m * 2048 : p.out + OFF_K_S + (size_t)(m - TP) * 2048;
            *(float4*)(ko + n) = make_float4(o0, o1, o2, o3);
          }
        }
      }
      __syncthreads();
    } else {
#pragma unroll
      for (int i = 0; i < 4; ++i) {
        const int m = m0 + wr * 64 + i * 16 + fr;
#pragma unroll
        for (int j = 0; j < 4; ++j) {
          const int n = n0 - 2048 + wc * 64 + j * 16 + fq * 4;
          f32x4 v = acc[i][j];
          if (isq) {
            float o0 = v[0] * sigmoidf_(v[0]), o1 = v[1] * sigmoidf_(v[1]), o2 = v[2] * sigmoidf_(v[2]), o3 = v[3] * sigmoidf_(v[3]);
            uint2 o; o.x = pack2(o0, o1); o.y = pack2(o2, o3);
            *(uint2*)(ZS + (size_t)m * 2048 + n) = o;
          } else {
            uint2 o; o.x = pack2(v[0], v[1]); o.y = pack2(v[2], v[3]);
            *(uint2*)(VB + (size_t)m * 2048 + n) = o;
            float* vo = m < TP ? p.out + OFF_V_P + (size_t)m * 2048 : p.out + OFF_V_S + (size_t)(m - TP) * 2048;
            *(float4*)(vo + n) = make_float4(v[0], v[1], v[2], v[3]);
          }
        }
      }
    }
  }
}

DEV unsigned off_b(unsigned row, unsigned ch) { return 256u * row + 16u * (ch ^ (((row & 3) << 2) | ((row >> 2) & 3))); }

DEV void phase_attn(const Params& p, char* smem) {
  const int tid = threadIdx.x, lane = tid & 63, w = tid >> 6, fr = lane & 15, fq = lane >> 4;
  char* ws = p.ws;
  const u16* KB = (const u16*)(ws + 2 * SLOT);
  const u16* VB = (const u16*)(ws + 3 * SLOT);
  const u16* QB = (const u16*)(ws + 4 * SLOT);
  const u16* ZS = (const u16*)(ws + 5 * SLOT);
  u16* OG = (u16*)(ws + 6 * SLOT);
  const int lrow = tid >> 4, lch = tid & 15;
  const unsigned lw0 = off_b(lrow, lch), lw1 = off_b(lrow + 32, lch);
  const int tq = (lane & 15) >> 2, tp = lane & 3;

  for (int item = blockIdx.x; item < 4096 + 256; item += gridDim.x) {
    int b, h, nq, qpos0, tokq0, ntiles, nkeys, tokk0; bool sample;
    if (item < 4096) {
      const int qblk = 31 - (item >> 7), bh = item & 127;
      b = bh >> 4; h = bh & 15; nq = 128; qpos0 = qblk * 128; tokq0 = b * 4096 + qpos0; ntiles = 2 * qblk + 2; nkeys = qpos0 + 128; tokk0 = b * 4096; sample = false;
    } else {
      const int bh = item - 4096;
      b = bh >> 4; h = bh & 15; nq = 32; qpos0 = 1024; tokq0 = TP + b * 32; ntiles = 17; nkeys = 1056; tokk0 = TP + b * 32 - 1024; sample = true;
    }
    const bool wactive = (w * 16) < nq;
    int* dflag = (int*)(smem + 65536);
    __syncthreads();
    if (lane == 0) dflag[w] = wactive ? 0 : 1;
    bool wdone = !wactive;
    const int qp = qpos0 + w * 16 + fr;
    const int qwmax = qpos0 + w * 16 + 15;
    bf16x8 qf[4];
#pragma unroll
    for (int ks = 0; ks < 4; ++ks) {
      if (wactive) qf[ks] = *(const bf16x8*)(QB + (size_t)(tokq0 + w * 16 + fr) * 2048 + h * 128 + ks * 32 + fq * 8);
      else qf[ks] = (bf16x8){0, 0, 0, 0, 0, 0, 0, 0};
    }
    f32x4 O[8];
#pragma unroll
    for (int dt = 0; dt < 8; ++dt) O[dt] = (f32x4){0, 0, 0, 0};
    float carry = 0.f;

    uint4 lk0, lk1, lv0, lv1;
#define ATT_LOAD(kb)                                                                                  \
    {                                                                                                 \
      const int kx0_ = (kb) * 64 + lrow, kx1_ = kx0_ + 32;                                            \
      if (sample && (kb) < 16) {                                                                      \
        const float* ck_ = p.in[I_CK] + ((size_t)(b * 1024 + kx0_) * 16 + h) * 128 + lch * 8;         \
        const float* cv_ = p.in[I_CV] + ((size_t)(b * 1024 + kx0_) * 16 + h) * 128 + lch * 8;         \
        float4 a_ = *(const float4*)ck_, b_ = *(const float4*)(ck_ + 4);                              \
        float4 c_ = *(const float4*)(ck_ + 32 * 2048), d_ = *(const float4*)(ck_ + 32 * 2048 + 4);    \
        lk0 = make_uint4(pack2(a_.x, a_.y), pack2(a_.z, a_.w), pack2(b_.x, b_.y), pack2(b_.z, b_.w)); \
        lk1 = make_uint4(pack2(c_.x, c_.y), pack2(c_.z, c_.w), pack2(d_.x, d_.y), pack2(d_.z, d_.w)); \
        a_ = *(const float4*)cv_; b_ = *(const float4*)(cv_ + 4);                                     \
        c_ = *(const float4*)(cv_ + 32 * 2048); d_ = *(const float4*)(cv_ + 32 * 2048 + 4);           \
        lv0 = make_uint4(pack2(a_.x, a_.y), pack2(a_.z, a_.w), pack2(b_.x, b_.y), pack2(b_.z, b_.w)); \
        lv1 = make_uint4(pack2(c_.x, c_.y), pack2(c_.z, c_.w), pack2(d_.x, d_.y), pack2(d_.z, d_.w)); \
      } else {                                                                                        \
        const size_t o0_ = (size_t)(tokk0 + kx0_) * 2048 + h * 128 + lch * 8;                         \
        const size_t o1_ = o0_ + (size_t)32 * 2048;                                                   \
        if (kx0_ < nkeys) { lk0 = *(const uint4*)(KB + o0_); lv0 = *(const uint4*)(VB + o0_); }       \
        else { lk0 = make_uint4(0, 0, 0, 0); lv0 = lk0; }                                             \
        if (kx1_ < nkeys) { lk1 = *(const uint4*)(KB + o1_); lv1 = *(const uint4*)(VB + o1_); }       \
        else { lk1 = make_uint4(0, 0, 0, 0); lv1 = lk1; }                                             \
      }                                                                                               \
    }
#define ATT_STORE(st)                                                                                 \
    {                                                                                                 \
      char* sK_ = smem + (st) * 32768; char* sV_ = sK_ + 16384;                                       \
      *(uint4*)(sK_ + lw0) = lk0; *(uint4*)(sK_ + lw1) = lk1;                                         \
      *(uint4*)(sV_ + lw0) = lv0; *(uint4*)(sV_ + lw1) = lv1;                                         \
    }
    ATT_LOAD(ntiles - 1);
    ATT_STORE(0);
    __syncthreads();
    for (int it = 0; it < ntiles; ++it) {
      const int kb = ntiles - 1 - it, st = it & 1;
      if (it + 1 < ntiles) ATT_LOAD(kb - 1);
      if (!wdone && kb * 64 < qwmax) {
        const char* sK = smem + st * 32768;
        const char* sV = sK + 16384;
        f32x4 S[4];
#pragma unroll
        for (int mt = 0; mt < 4; ++mt) S[mt] = (f32x4){0, 0, 0, 0};
#pragma unroll
        for (int ks = 0; ks < 4; ++ks)
#pragma unroll
          for (int mt = 0; mt < 4; ++mt) {
            bf16x8 a = *(const bf16x8*)(sK + off_b(mt * 16 + fr, ks * 4 + fq));
            S[mt] = __builtin_amdgcn_mfma_f32_16x16x32_bf16(a, qf[ks], S[mt], 0, 0, 0);
          }
        bf16x8 wf[2];
        {
          float ee[4][4], tot[4], hi[4];
#pragma unroll
          for (int mt = 0; mt < 4; ++mt) {
            const int kbase = kb * 64 + mt * 16 + fq * 4;
            float ls[4];
#pragma unroll
            for (int jj = 0; jj < 4; ++jj) {
              const float u = S[mt][jj];
              const bool valid = (kbase + jj) < qp;
              const float l = -__builtin_amdgcn_logf(1.0f + __builtin_amdgcn_exp2f(u));
              ls[jj] = valid ? l : 0.f;
              ee[mt][jj] = valid ? (u + l) : -1e30f;
            }
            const float x3 = ls[3], x2 = x3 + ls[2], x1 = x2 + ls[1], seg = x1 + ls[0];
            ee[mt][2] += x3; ee[mt][1] += x2; ee[mt][0] += x1;
            const float t1 = __shfl_xor(seg, 16), t2 = __shfl_xor(seg, 32), t3 = __shfl_xor(t1, 32);
            tot[mt] = seg + t1 + t2 + t3;
            hi[mt] = fq == 0 ? (t1 + t2 + t3) : fq == 1 ? (t2 + t3) : fq == 2 ? t1 : 0.f;
          }
          float run = carry;
          float wv[4][4];
#pragma unroll
          for (int mt = 3; mt >= 0; --mt) {
            const float base = run + hi[mt];
            run += tot[mt];
#pragma unroll
            for (int jj = 0; jj < 4; ++jj) wv[mt][jj] = __builtin_amdgcn_exp2f(ee[mt][jj] + base);
          }
          carry = run;
          if (__all(carry < -150.0f)) { wdone = true; if (lane == 0) dflag[w] = 1; }
#pragma unroll
          for (int p2 = 0; p2 < 2; ++p2) {
            uint4 pk;
            pk.x = pack2(wv[2 * p2][0], wv[2 * p2][1]); pk.y = pack2(wv[2 * p2][2], wv[2 * p2][3]);
            pk.z = pack2(wv[2 * p2 + 1][0], wv[2 * p2 + 1][1]); pk.w = pack2(wv[2 * p2 + 1][2], wv[2 * p2 + 1][3]);
            wf[p2] = *(bf16x8*)&pk;
          }
        }
#pragma unroll
        for (int p2 = 0; p2 < 2; ++p2)
#pragma unroll
          for (int dt = 0; dt < 8; ++dt) {
            const unsigned r0 = 32 * p2 + 4 * fq + tq, r1 = r0 + 16;
            const unsigned ch = 2 * dt + (tp >> 1);
            const char* a0 = sV + off_b(r0, ch) + 8 * (tp & 1);
            const char* a1 = sV + off_b(r1, ch) + 8 * (tp & 1);
            s16x4 lo = __builtin_amdgcn_ds_read_tr16_b64_v4i16((s16x4 __attribute__((address_space(3)))*)(a0));
            s16x4 hi4 = __builtin_amdgcn_ds_read_tr16_b64_v4i16((s16x4 __attribute__((address_space(3)))*)(a1));
            bf16x8 a = {lo[0], lo[1], lo[2], lo[3], hi4[0], hi4[1], hi4[2], hi4[3]};
            O[dt] = __builtin_amdgcn_mfma_f32_16x16x32_bf16(a, wf[p2], O[dt], 0, 0, 0);
          }
      }
      if (it + 1 < ntiles) ATT_STORE(st ^ 1);
      __syncthreads();
      {
        const int4 f0 = *(const int4*)dflag, f1 = *(const int4*)(dflag + 4);
        if (f0.x & f0.y & f0.z & f0.w & f1.x & f1.y & f1.z & f1.w) break;
      }
    }
#undef ATT_LOAD
#undef ATT_STORE
    if (wactive) {
      const size_t rowoff = (size_t)(tokq0 + w * 16 + fr) * 2048 + h * 128;
#pragma unroll
      for (int dt = 0; dt < 8; ++dt) {
        const int d = dt * 16 + fq * 4;
        uint2 z = *(const uint2*)(ZS + rowoff + d);
        f32x4 v = O[dt];
        uint2 o;
        o.x = pack2(v[0] * bflo(z.x), v[1] * bfhi(z.x)); o.y = pack2(v[2] * bflo(z.y), v[3] * bfhi(z.y));
        *(uint2*)(OG + rowoff + d) = o;
      }
    }
  }
}

__global__ void __launch_bounds__(NTHREADS) mega(Params p, int lo, int hi) {
  __shared__ __attribute__((aligned(16))) char smem[147456];
  cg::grid_group grid = cg::this_grid();
#ifndef PROBE_DOUBLE
#define PROBE_DOUBLE -1
#endif
#define RUN_PHASE(k, call) if ((k) >= lo && (k) < hi) { if ((k) > lo) grid.sync(); call; if ((k) == PROBE_DOUBLE) { __syncthreads(); call; } }
  RUN_PHASE(0, phase_prep(p, smem))
  RUN_PHASE(1, phase_norm0(p))
  RUN_PHASE(2, phase_proj0(p, smem))
  RUN_PHASE(3, phase_scan(p, smem))
  RUN_PHASE(4, phase_outproj<0>(p, smem))
  RUN_PHASE(5, phase_norm1(p))
  RUN_PHASE(6, phase_proj1(p, smem))
  RUN_PHASE(7, phase_attn(p, smem))
  RUN_PHASE(8, phase_outproj<1>(p, smem))
}

#ifndef N_LAUNCH_MODE
#define N_LAUNCH_MODE 1
#endif

extern "C" void kernel_launch(void* const* d_in, const int* in_sizes, int n_in, void* d_out, int out_size, void* d_ws, size_t ws_size,
                              hipStream_t stream) {
  Params p{};
  for (int i = 0; i < 36; ++i) p.in[i] = (const float*)d_in[i];
  p.out = (float*)d_out;
  p.ws = (char*)d_ws;
  static int grid_blocks = 0;
  if (!grid_blocks) {
    int dev = 0, cus = 0, per_cu = 0;
    hipGetDevice(&dev);
    hipDeviceGetAttribute(&cus, hipDeviceAttributeMultiprocessorCount, dev);
    hipOccupancyMaxActiveBlocksPerMultiprocessor(&per_cu, mega, NTHREADS, 0);
    if (per_cu < 1) per_cu = 1;
    grid_blocks = cus * per_cu;
  }
  if (ws_size < WS_END) { fprintf(stderr, "workspace too small: %zu < %llu\n", ws_size, (unsigned long long)WS_END); return; }
#if N_LAUNCH_MODE == 1
  int lo = 0, hi = 9;
  void* args[] = {&p, &lo, &hi};
  hipError_t e = hipLaunchCooperativeKernel((void*)mega, dim3(grid_blocks), dim3(NTHREADS), args, 0, stream);
  if (e != hipSuccess) fprintf(stderr, "cooperative launch failed: %s (grid %d)\n", hipGetErrorString(e), grid_blocks);
#else
  for (int ph = 0; ph < 9; ++ph) hipLaunchKernelGGL(mega, dim3(grid_blocks), dim3(NTHREADS), 0, stream, p, ph, ph + 1);
#endif
}
```

```cpp
#include <hip/hip_runtime.h>
#include <hip/hip_cooperative_groups.h>
#include <cstdio>
namespace cg = cooperative_groups;

typedef unsigned short u16;
typedef short bf16x8 __attribute__((ext_vector_type(8)));
typedef short s16x4 __attribute__((ext_vector_type(4)));
typedef float f32x4 __attribute__((ext_vector_type(4)));
typedef float f32x2 __attribute__((ext_vector_type(2)));
typedef __bf16 bf16x2_t __attribute__((ext_vector_type(2)));

#define DEV __device__ __forceinline__

#define NTOK 33280
#define TP 32768
#define NTHREADS 512

#define OFF_Y_P 0
#define OFF_Y_S 33554432
#define OFF_K_P 34078720
#define OFF_V_P 101187584
#define OFF_WKV_P 168296448
#define OFF_SH_P 169345024
#define OFF_K_S 169353216
#define OFF_V_S 170401792
#define OFF_WKV_S 171450368
#define OFF_SH_S 173547520

#define SLOT 136314880ull
#define WS_W (7ull * SLOT)
#define WS_WT_IN (WS_W)
#define WS_WT_OUTA (WS_WT_IN + 16777216ull)
#define WS_WT_KV (WS_WT_OUTA + 4194304ull)
#define WS_WT_INB (WS_WT_KV + 8388608ull)
#define WS_WT_OUTB (WS_WT_INB + 8388608ull)
#define WS_W2T (WS_WT_OUTB + 4194304ull)
#define WS_A2T (WS_W2T + 262144ull)
#define WS_L1T (WS_A2T + 262144ull)
#define WS_MOD (WS_L1T + 524288ull)
#define WS_SH (WS_MOD + 589824ull)
#define WS_CTR (WS_SH + 49152ull)
#define WS_END (WS_CTR + 4096ull)
#define WS_H0 (6ull * SLOT)
#define WS_T (6ull * SLOT + 68157440ull)

struct Params {
  const float* in[36];
  float* out;
  char* ws;
};

enum { I_XP = 0, I_XS, I_CK, I_CV, I_SWKV, I_SSH, I_CP, I_CS, I_ANG, I_AADAW, I_AADAB, I_AWIN, I_AMUIN, I_AMUW, I_AMUA,
       I_AW0, I_AW1, I_AW2, I_AA0, I_AA1, I_AA2, I_AKK, I_AKA, I_ARK, I_ALNG, I_ALNB, I_AWOUT, I_KVNG, I_KVW, I_KGAIN,
       I_BNG, I_BADAW, I_BADAB, I_BWIN, I_BQG, I_BWOUT };

DEV int seq_of(int t) { return t < TP ? (t >> 12) : 8 + ((t - TP) >> 5); }
DEV bool seq_start(int t) { return t < TP ? ((t & 4095) == 0) : (((t - TP) & 31) == 0); }

DEV unsigned pack2(float a, float b) {
  f32x2 v = {a, b};
  bf16x2_t r = __builtin_convertvector(v, bf16x2_t);
  return *(unsigned*)&r;
}
DEV float bflo(unsigned w) { return __uint_as_float(w << 16); }
DEV float bfhi(unsigned w) { return __uint_as_float(w & 0xffff0000u); }
DEV void unpack8(const uint4& x, float* f) {
  f[0] = bflo(x.x); f[1] = bfhi(x.x); f[2] = bflo(x.y); f[3] = bfhi(x.y);
  f[4] = bflo(x.z); f[5] = bfhi(x.z); f[6] = bflo(x.w); f[7] = bfhi(x.w);
}
DEV float sigmoidf_(float x) { return 1.0f / (1.0f + __expf(-x)); }

template <int CTRL>
DEV float dppf(float x) {
  return __int_as_float(__builtin_amdgcn_update_dpp(0, __float_as_int(x), CTRL, 0xf, 0xf, true));
}
DEV float red4(float x) { x += dppf<0xB1>(x); x += dppf<0x4E>(x); return x; }
DEV float red8(float x) { x = red4(x); x += dppf<0x141>(x); return x; }
DEV float red16(float x) { x = red8(x); x += dppf<0x140>(x); return x; }
DEV float wave_sum(float x) {
#pragma unroll
  for (int o = 32; o >= 1; o >>= 1) x += __shfl_xor(x, o);
  return x;
}


#define SCHED_SLOT_OFF 147440
DEV unsigned* sched_ctr(const Params& p, int phase_slot) { return (unsigned*)(p.ws + WS_CTR) + (phase_slot * 8 + (blockIdx.x & 7)) * 16; }
DEV int sched_first(unsigned* ctr, char* smem) {
  int* slot = (int*)(smem + SCHED_SLOT_OFF);
  __syncthreads();
  if (threadIdx.x == 0) *slot = (int)atomicAdd(ctr, 1u);
  __syncthreads();
  return *slot;
}
DEV int sched_prefetch(unsigned* ctr) { return threadIdx.x == 0 ? (int)atomicAdd(ctr, 1u) : 0; }
DEV int sched_commit(int nxt, char* smem) {
  int* slot = (int*)(smem + SCHED_SLOT_OFF);
  __syncthreads();
  if (threadIdx.x == 0) *slot = nxt;
  __syncthreads();
  return *slot;
}

#define GEMM_STAGE_BYTES 49152

template <int AMODE>
DEV void gemm_main(f32x4 (&acc)[4][4], const u16* __restrict__ A, int lda, const u16* __restrict__ Bt, int ldb, int nk,
                   int m0, int n0, const float* __restrict__ mu, const u16* __restrict__ SH, char* smem) {
  const int tid = threadIdx.x, lane = tid & 63, wid = tid >> 6, wr = wid >> 1, wc = wid & 1, fr = lane & 15, fq = lane >> 4;
  const int lrow = tid >> 3, lch = tid & 7;
#pragma unroll
  for (int i = 0; i < 4; ++i)
#pragma unroll
    for (int j = 0; j < 4; ++j) acc[i][j] = (f32x4){0.f, 0.f, 0.f, 0.f};

  const u16* pa0; const u16* pa1; const u16* pa2; const u16* pa3;
  const u16* pp0 = nullptr;
  const int arow = 4 * lrow;
  {
    int m = m0 + arow;
    pa0 = A + (size_t)m * lda + lch * 8;
    pa1 = pa0 + lda; pa2 = pa1 + lda; pa3 = pa2 + lda;
    if (AMODE != 0) pp0 = seq_start(m) ? SH + seq_of(m) * 1024 + lch * 8 : pa0 - lda;
  }
  const u16* pb0 = Bt + (size_t)(n0 + lrow) * ldb + lch * 8;
  const u16* pb1 = pb0 + (size_t)64 * ldb;
  const int woffB = lrow * 128 + ((lch ^ ((lrow >> 1) & 7)) << 4);
  const int woffA0 = (arow + 0) * 128 + ((lch ^ (((arow + 0) >> 1) & 7)) << 4);
  const int woffA1 = (arow + 1) * 128 + ((lch ^ (((arow + 1) >> 1) & 7)) << 4);
  const int woffA2 = (arow + 2) * 128 + ((lch ^ (((arow + 2) >> 1) & 7)) << 4);
  const int woffA3 = (arow + 3) * 128 + ((lch ^ (((arow + 3) >> 1) & 7)) << 4);

  uint4 ra0, ra1, ra2, ra3, rp0, rb0, rb1;
  float4 mu0, mu1;
  rp0 = make_uint4(0, 0, 0, 0);
  mu0 = mu1 = make_float4(0, 0, 0, 0);

#define G_LOAD(kt)                                                                     \
  {                                                                                    \
    const int k0_ = (kt) * 64;                                                         \
    if (AMODE == 0) {                                                                  \
      ra0 = *(const uint4*)(pa0 + k0_); ra1 = *(const uint4*)(pa1 + k0_);              \
      ra2 = *(const uint4*)(pa2 + k0_); ra3 = *(const uint4*)(pa3 + k0_);              \
    } else if (AMODE == 1) {                                                           \
      ra0 = *(const uint4*)(pa0 + k0_); ra1 = *(const uint4*)(pa1 + k0_);              \
      ra2 = *(const uint4*)(pa2 + k0_); ra3 = *(const uint4*)(pa3 + k0_);              \
      rp0 = *(const uint4*)(pp0 + k0_);                                                \
      mu0 = *(const float4*)(mu + k0_ + lch * 8); mu1 = *(const float4*)(mu + k0_ + lch * 8 + 4); \
    } else {                                                                           \
      const int kk_ = k0_ & 1023;                                                      \
      ra0 = *(const uint4*)(pa0 + kk_); ra1 = *(const uint4*)(pa1 + kk_);              \
      ra2 = *(const uint4*)(pa2 + kk_); ra3 = *(const uint4*)(pa3 + kk_);              \
      if (k0_ >= 1024) rp0 = *(const uint4*)(pp0 + kk_);                               \
    }                                                                                  \
    rb0 = *(const uint4*)(pb0 + k0_); rb1 = *(const uint4*)(pb1 + k0_);                \
  }

#define G_XFORM(dst, a_, p_, kt)                                                       \
  {                                                                                    \
    if (AMODE == 0) dst = a_;                                                          \
    else if (AMODE == 1) {                                                             \
      float h_[8], q_[8]; unpack8(a_, h_); unpack8(p_, q_);                            \
      dst.x = pack2(h_[0] + mu0.x * (q_[0] - h_[0]), h_[1] + mu0.y * (q_[1] - h_[1])); \
      dst.y = pack2(h_[2] + mu0.z * (q_[2] - h_[2]), h_[3] + mu0.w * (q_[3] - h_[3])); \
      dst.z = pack2(h_[4] + mu1.x * (q_[4] - h_[4]), h_[5] + mu1.y * (q_[5] - h_[5])); \
      dst.w = pack2(h_[6] + mu1.z * (q_[6] - h_[6]), h_[7] + mu1.w * (q_[7] - h_[7])); \
    } else {                                                                           \
      if ((kt) * 64 >= 1024) {                                                         \
        float h_[8], q_[8]; unpack8(a_, h_); unpack8(p_, q_);                          \
        dst.x = pack2(q_[0] - h_[0], q_[1] - h_[1]); dst.y = pack2(q_[2] - h_[2], q_[3] - h_[3]); \
        dst.z = pack2(q_[4] - h_[4], q_[5] - h_[5]); dst.w = pack2(q_[6] - h_[6], q_[7] - h_[7]); \
      } else dst = a_;                                                                 \
    }                                                                                  \
  }

#define G_STORE(stage, kt)                                                             \
  {                                                                                    \
    char* sA_ = smem + (stage) * GEMM_STAGE_BYTES; char* sB_ = sA_ + 32768;            \
    uint4 v_;                                                                          \
    G_XFORM(v_, ra0, rp0, kt); *(uint4*)(sA_ + woffA0) = v_;                           \
    G_XFORM(v_, ra1, ra0, kt); *(uint4*)(sA_ + woffA1) = v_;                           \
    G_XFORM(v_, ra2, ra1, kt); *(uint4*)(sA_ + woffA2) = v_;                           \
    G_XFORM(v_, ra3, ra2, kt); *(uint4*)(sA_ + woffA3) = v_;                           \
    *(uint4*)(sB_ + woffB) = rb0; *(uint4*)(sB_ + woffB + 64 * 128) = rb1;             \
  }

  G_LOAD(0);
  G_STORE(0, 0);
  __syncthreads();
  const int rsw = (fr >> 1) & 7;
  for (int kt = 0; kt < nk; ++kt) {
    const int st = kt & 1;
    if (kt + 1 < nk) G_LOAD(kt + 1);
    {
      const char* sA = smem + st * GEMM_STAGE_BYTES;
      const char* sB = sA + 32768;
#pragma unroll
      for (int kk = 0; kk < 2; ++kk) {
        bf16x8 af[4], bfr[4];
        const int cho = ((kk * 4 + fq) ^ rsw) << 4;
#pragma unroll
        for (int i = 0; i < 4; ++i) af[i] = *(const bf16x8*)(sA + (wr * 64 + i * 16 + fr) * 128 + cho);
#pragma unroll
        for (int j = 0; j < 4; ++j) bfr[j] = *(const bf16x8*)(sB + (wc * 64 + j * 16 + fr) * 128 + cho);
#pragma unroll
        for (int i = 0; i < 4; ++i)
#pragma unroll
          for (int j = 0; j < 4; ++j) acc[i][j] = __builtin_amdgcn_mfma_f32_16x16x32_bf16(bfr[j], af[i], acc[i][j], 0, 0, 0);
      }
    }
    if (kt + 1 < nk) G_STORE(st ^ 1, kt + 1);
    __syncthreads();
  }
#undef G_LOAD
#undef G_XFORM
#undef G_STORE
}


#define G2_STAGE_BYTES 65536
template <int AMODE>
DEV void gemm_main256(f32x4 (&acc)[8][4], const u16* __restrict__ A, int lda, const u16* __restrict__ Bt, int ldb, int nk,
                      int m0, int n0, const float* __restrict__ mu, const u16* __restrict__ SH, char* smem) {
  const int tid = threadIdx.x, lane = tid & 63, wid = tid >> 6, wr = wid >> 2, wc = wid & 3, fr = lane & 15, fq = lane >> 4;
  const int lrow = tid >> 3, lch = tid & 7;
#pragma unroll
  for (int i = 0; i < 8; ++i)
#pragma unroll
    for (int j = 0; j < 4; ++j) acc[i][j] = (f32x4){0.f, 0.f, 0.f, 0.f};
  const int arow = 4 * lrow;
  const u16* pa0 = A + (size_t)(m0 + arow) * lda + lch * 8;
  const u16* pp0 = nullptr;
  if (AMODE != 0) pp0 = seq_start(m0 + arow) ? SH + seq_of(m0 + arow) * 1024 + lch * 8 : pa0 - lda;
  const u16* pb0 = Bt + (size_t)(n0 + lrow) * ldb + lch * 8;
  const size_t bstr = (size_t)64 * ldb;
  const int woffB = lrow * 128 + ((lch ^ ((lrow >> 1) & 7)) << 4);
  const int woffA0 = (arow + 0) * 128 + ((lch ^ (((arow + 0) >> 1) & 7)) << 4);
  const int woffA1 = (arow + 1) * 128 + ((lch ^ (((arow + 1) >> 1) & 7)) << 4);
  const int woffA2 = (arow + 2) * 128 + ((lch ^ (((arow + 2) >> 1) & 7)) << 4);
  const int woffA3 = (arow + 3) * 128 + ((lch ^ (((arow + 3) >> 1) & 7)) << 4);
  uint4 ra0, ra1, ra2, ra3, rp0, rb0, rb1, rb2, rb3;
  float4 mu0, mu1;
  rp0 = make_uint4(0, 0, 0, 0);
  mu0 = mu1 = make_float4(0, 0, 0, 0);

#define H_LOAD(kt)                                                                     \
  {                                                                                    \
    const int k0_ = (kt) * 64;                                                         \
    ra0 = *(const uint4*)(pa0 + k0_); ra1 = *(const uint4*)(pa0 + lda + k0_);          \
    ra2 = *(const uint4*)(pa0 + 2 * lda + k0_); ra3 = *(const uint4*)(pa0 + 3 * lda + k0_); \
    if (AMODE == 1) rp0 = *(const uint4*)(pp0 + k0_);                                  \
    rb0 = *(const uint4*)(pb0 + k0_); rb1 = *(const uint4*)(pb0 + bstr + k0_);         \
    rb2 = *(const uint4*)(pb0 + 2 * bstr + k0_); rb3 = *(const uint4*)(pb0 + 3 * bstr + k0_); \
  }
#define H_XFORM(dst, a_, p_)                                                           \
  {                                                                                    \
    if (AMODE == 0) dst = a_;                                                          \
    else {                                                                             \
      float h_[8], q_[8]; unpack8(a_, h_); unpack8(p_, q_);                            \
      dst.x = pack2(h_[0] + mu0.x * (q_[0] - h_[0]), h_[1] + mu0.y * (q_[1] - h_[1])); \
      dst.y = pack2(h_[2] + mu0.z * (q_[2] - h_[2]), h_[3] + mu0.w * (q_[3] - h_[3])); \
      dst.z = pack2(h_[4] + mu1.x * (q_[4] - h_[4]), h_[5] + mu1.y * (q_[5] - h_[5])); \
      dst.w = pack2(h_[6] + mu1.z * (q_[6] - h_[6]), h_[7] + mu1.w * (q_[7] - h_[7])); \
    }                                                                                  \
  }
#define H_STORE(stage, kt)                                                             \
  {                                                                                    \
    char* sA_ = smem + (stage) * G2_STAGE_BYTES; char* sB_ = sA_ + 32768;              \
    uint4 v_;                                                                          \
    if (AMODE == 1) { mu0 = *(const float4*)(muL + (kt) * 64 + lch * 8); mu1 = *(const float4*)(muL + (kt) * 64 + lch * 8 + 4); } \
    H_XFORM(v_, ra0, rp0); *(uint4*)(sA_ + woffA0) = v_;                               \
    H_XFORM(v_, ra1, ra0); *(uint4*)(sA_ + woffA1) = v_;                               \
    H_XFORM(v_, ra2, ra1); *(uint4*)(sA_ + woffA2) = v_;                               \
    H_XFORM(v_, ra3, ra2); *(uint4*)(sA_ + woffA3) = v_;                               \
    *(uint4*)(sB_ + woffB) = rb0; *(uint4*)(sB_ + woffB + 64 * 128) = rb1;             \
    *(uint4*)(sB_ + woffB + 128 * 128) = rb2; *(uint4*)(sB_ + woffB + 192 * 128) = rb3; \
  }
  const float* muL = (const float*)(smem + 2 * G2_STAGE_BYTES);
  if (AMODE == 1) {
    if (tid < 256) *(float4*)(smem + 2 * G2_STAGE_BYTES + tid * 16) = *(const float4*)(mu + tid * 4);
    __syncthreads();
  }
  H_LOAD(0);
  H_STORE(0, 0);
  __syncthreads();
  const int rsw = (fr >> 1) & 7;
  for (int kt = 0; kt < nk; ++kt) {
    const int st = kt & 1;
    if (kt + 1 < nk) H_LOAD(kt + 1);
    {
      const char* sA = smem + st * G2_STAGE_BYTES;
      const char* sB = sA + 32768;
#pragma unroll
      for (int kk = 0; kk < 2; ++kk) {
        bf16x8 bfr[4];
        const int cho = ((kk * 4 + fq) ^ rsw) << 4;
#pragma unroll
        for (int j = 0; j < 4; ++j) bfr[j] = *(const bf16x8*)(sB + (wc * 64 + j * 16 + fr) * 128 + cho);
#pragma unroll
        for (int i = 0; i < 8; ++i) {
          const bf16x8 af = *(const bf16x8*)(sA + (wr * 128 + i * 16 + fr) * 128 + cho);
#pragma unroll
          for (int j = 0; j < 4; ++j) acc[i][j] = __builtin_amdgcn_mfma_f32_16x16x32_bf16(bfr[j], af, acc[i][j], 0, 0, 0);
        }
      }
    }
    if (kt + 1 < nk) H_STORE(st ^ 1, kt + 1);
    __syncthreads();
  }
#undef H_LOAD
#undef H_XFORM
#undef H_STORE
}

DEV void transpose_tile(const float* __restrict__ src, int N, int k0, int n0, const float* __restrict__ scale, u16* __restrict__ dst,
                        int dstride, int drow0, int dcol0, char* smem) {
  float* tile = (float*)smem;
  const int tid = threadIdx.x;
#pragma unroll
  for (int i = 0; i < 2; ++i) {
    int kl = (tid >> 4) + 32 * i, n4 = (tid & 15) * 4;
    float4 v = *(const float4*)(src + (size_t)(k0 + kl) * N + n0 + n4);
    float s = scale ? scale[k0 + kl] : 1.0f;
    tile[kl * 65 + n4 + 0] = v.x * s; tile[kl * 65 + n4 + 1] = v.y * s;
    tile[kl * 65 + n4 + 2] = v.z * s; tile[kl * 65 + n4 + 3] = v.w * s;
  }
  __syncthreads();
  {
    int nl = tid >> 3, k8 = (tid & 7) * 8;
    uint4 o;
    o.x = pack2(tile[(k8 + 0) * 65 + nl], tile[(k8 + 1) * 65 + nl]);
    o.y = pack2(tile[(k8 + 2) * 65 + nl], tile[(k8 + 3) * 65 + nl]);
    o.z = pack2(tile[(k8 + 4) * 65 + nl], tile[(k8 + 5) * 65 + nl]);
    o.w = pack2(tile[(k8 + 6) * 65 + nl], tile[(k8 + 7) * 65 + nl]);
    *(uint4*)(dst + (size_t)(drow0 + n0 + nl) * dstride + dcol0 + k0 + k8) = o;
  }
  __syncthreads();
}

DEV void phase_prep(const Params& p, char* smem) {
  const int tid = threadIdx.x;
  char* ws = p.ws;
  if (blockIdx.x < 96) {
    float* cL = (float*)smem;
    float* red = (float*)(smem + 98304);
    for (int e = tid; e < 24 * 256; e += NTHREADS) {
      int s = e >> 8, k4 = (e & 255) * 4;
      float4 v = s < 8 ? *(const float4*)(p.in[I_CP] + s * 1024 + k4) : *(const float4*)(p.in[I_CS] + (s - 8) * 1024 + k4);
      *(float4*)(cL + s * 1024 + k4) = v;
    }
    __syncthreads();
    for (int item = blockIdx.x; item < 96; item += gridDim.x) {
      const int l = item / 48, j0 = (item % 48) * 64;
      const float* W = (l == 0 ? p.in[I_AADAW] : p.in[I_BADAW]);
      const float* bias = (l == 0 ? p.in[I_AADAB] : p.in[I_BADAB]);
      const int col = tid & 63, kg = tid >> 6;
      float acc[24];
#pragma unroll
      for (int s = 0; s < 24; ++s) acc[s] = 0.f;
      for (int k = kg * 128; k < kg * 128 + 128; ++k) {
        float w = W[(size_t)k * 3072 + j0 + col];
#pragma unroll
        for (int s = 0; s < 24; ++s) acc[s] += cL[s * 1024 + k] * w;
      }
#pragma unroll
      for (int s = 0; s < 24; ++s) red[(kg * 24 + s) * 64 + col] = acc[s];
      __syncthreads();
      float* mod = (float*)(ws + WS_MOD);
      for (int e = tid; e < 24 * 64; e += NTHREADS) {
        int s = e >> 6, c = e & 63;
        float t = bias[j0 + c];
#pragma unroll
        for (int g = 0; g < 8; ++g) t += red[(g * 24 + s) * 64 + c];
        mod[(size_t)(l * 24 + s) * 3072 + j0 + c] = t;
      }
      __syncthreads();
    }
  }
  if (blockIdx.x == 0) for (int e = tid; e < 1024; e += NTHREADS) ((unsigned*)(ws + WS_CTR))[tid] = 0u;
  if (blockIdx.x == gridDim.x - 1) {
    u16* SH = (u16*)(ws + WS_SH);
    for (int e = tid; e < 24 * 1024; e += NTHREADS) {
      int s = e >> 10, k = e & 1023;
      float v = s < 8 ? 0.f : p.in[I_SSH][(s - 8) * 1024 + k];
      SH[e] = (u16)(pack2(v, 0.f) & 0xffff);
    }
  }
  const int NT_TOTAL = 2048 + 512 + 1024 + 1024 + 512 + 32 + 32 + 64;
  for (int t = blockIdx.x; t < NT_TOTAL; t += gridDim.x) {
    const float* src; int K, N; u16* dst; int dstride, drow0 = 0, dcol0 = 0; const float* scale = nullptr; int tt = t;
    if (tt < 2048) { src = p.in[I_AWIN]; K = 1024; N = 8192; dst = (u16*)(ws + WS_WT_IN); dstride = 1024; }
    else if ((tt -= 2048) < 512) { src = p.in[I_AWOUT]; K = 2048; N = 1024; dst = (u16*)(ws + WS_WT_OUTA); dstride = 2048; }
    else if ((tt -= 512) < 1024) { src = p.in[I_KVW]; K = 1024; N = 4096; dst = (u16*)(ws + WS_WT_KV); dstride = 1024; }
    else if ((tt -= 1024) < 1024) { src = p.in[I_BWIN]; K = 1024; N = 4096; dst = (u16*)(ws + WS_WT_INB); dstride = 1024; }
    else if ((tt -= 1024) < 512) { src = p.in[I_BWOUT]; K = 2048; N = 1024; dst = (u16*)(ws + WS_WT_OUTB); dstride = 2048; }
    else if ((tt -= 512) < 32) { src = p.in[I_AW2]; K = 64; N = 2048; dst = (u16*)(ws + WS_W2T); dstride = 64; }
    else if ((tt -= 32) < 32) { src = p.in[I_AA2]; K = 64; N = 2048; dst = (u16*)(ws + WS_A2T); dstride = 64; }
    else {
      tt -= 32;
      int job = tt >> 4; tt &= 15;
      K = 1024; N = 64; dst = (u16*)(ws + WS_L1T); dstride = 2048;
      src = (job < 2) ? p.in[I_AW1] : p.in[I_AA1];
      drow0 = (job < 2) ? 0 : 64;
      if (job & 1) { dcol0 = 1024; scale = (job < 2) ? p.in[I_AMUW] : p.in[I_AMUA]; }
    }
    const int ntn = N / 64;
    const int kt = tt / ntn, nt = tt % ntn;
    transpose_tile(src, N, kt * 64, nt * 64, scale, dst, dstride, drow0, dcol0, smem);
  }
}

DEV void phase_norm0(const Params& p) {
  const int lane = threadIdx.x & 63, wid = threadIdx.x >> 6;
  const float* mod = (const float*)(p.ws + WS_MOD);
  u16* H0 = (u16*)(p.ws + WS_H0);
  const float* g = p.in[I_ANG];
  for (int t = blockIdx.x * 8 + wid; t < NTOK; t += gridDim.x * 8) {
    const float* x = t < TP ? p.in[I_XP] + (size_t)t * 1024 : p.in[I_XS] + (size_t)(t - TP) * 1024;
    const int s = seq_of(t);
    const float* md = mod + (size_t)s * 3072;
    float4 v[4];
    float ss = 0.f;
#pragma unroll
    for (int i = 0; i < 4; ++i) {
      v[i] = *(const float4*)(x + lane * 4 + 256 * i);
      ss += v[i].x * v[i].x + v[i].y * v[i].y + v[i].z * v[i].z + v[i].w * v[i].w;
    }
    ss = wave_sum(ss);
    const float rstd = rsqrtf(ss * (1.0f / 1024.0f) + 1e-6f);
    bool last = t < TP ? ((t & 4095) == 4095) : (((t - TP) & 31) == 31);
    float* so = t < TP ? p.out + OFF_SH_P + (t >> 12) * 1024 : p.out + OFF_SH_S + ((t - TP) >> 5) * 1024;
#pragma unroll
    for (int i = 0; i < 4; ++i) {
      const int c = lane * 4 + 256 * i;
      float4 gg = *(const float4*)(g + c), sh = *(const float4*)(md + c), sc = *(const float4*)(md + 1024 + c);
      float4 h;
      h.x = v[i].x * rstd * gg.x * (1.f + sc.x) + sh.x;
      h.y = v[i].y * rstd * gg.y * (1.f + sc.y) + sh.y;
      h.z = v[i].z * rstd * gg.z * (1.f + sc.z) + sh.z;
      h.w = v[i].w * rstd * gg.w * (1.f + sc.w) + sh.w;
      uint2 o; o.x = pack2(h.x, h.y); o.y = pack2(h.z, h.w);
      *(uint2*)(H0 + (size_t)t * 1024 + c) = o;
      if (last) *(float4*)(so + c) = h;
    }
  }
}

DEV void phase_proj0(const Params& p, char* smem) {
  const int tid = threadIdx.x, lane = tid & 63, wid = tid >> 6, fr = lane & 15, fq = lane >> 4;
  char* ws = p.ws;
  const u16* H0 = (const u16*)(ws + WS_H0);
  const u16* SH = (const u16*)(ws + WS_SH);
  u16* T = (u16*)(ws + WS_T);
  unsigned* ctr = sched_ctr(p, 0);
  const int xcd = blockIdx.x & 7;
  int nxt;
  for (int li = sched_first(ctr, smem); li < 17 + 520; li = sched_commit(nxt, smem)) {
    nxt = sched_prefetch(ctr);
    if (li < 17) {
      const int lmt = xcd + 8 * li;
      if (lmt >= 130) continue;
      const int m0 = lmt * 256;
      {
        const int wr = wid >> 1, wc = wid & 1;
        f32x4 acc[4][4];
        gemm_main<2>(acc, H0, 1024, (const u16*)(ws + WS_L1T), 2048, 32, m0, 0, nullptr, SH, smem);
#pragma unroll
        for (int i = 0; i < 4; ++i)
#pragma unroll
          for (int j = 0; j < 4; ++j) {
            const int m = m0 + wr * 64 + i * 16 + fr, n = wc * 64 + j * 16 + fq * 4;
            f32x4 v = acc[i][j];
            if (wc == 0) { v[0] = tanhf(v[0]); v[1] = tanhf(v[1]); v[2] = tanhf(v[2]); v[3] = tanhf(v[3]); }
            uint2 o; o.x = pack2(v[0], v[1]); o.y = pack2(v[2], v[3]);
            *(uint2*)(T + (size_t)m * 128 + n) = o;
          }
      }
      __threadfence_block();
      __syncthreads();
      {
        const int wr = wid >> 1, wc = wid & 1;
        f32x4 acc[4][4];
        for (int nt = 0; nt < 32; ++nt) {
          const int which = nt >> 4, n0 = (nt & 15) * 128;
          gemm_main<0>(acc, T + which * 64, 128, (const u16*)(ws + (which ? WS_A2T : WS_W2T)), 64, 1, m0, n0, nullptr, nullptr, smem);
          const float* bias = which ? p.in[I_AA0] : p.in[I_AW0];
          u16* dst = (u16*)(ws + (which ? 5ull : 4ull) * SLOT);
          const float sc = which ? 1.0f : -0.60653066f;
#pragma unroll
          for (int i = 0; i < 4; ++i)
#pragma unroll
            for (int j = 0; j < 4; ++j) {
              const int m = m0 + wr * 64 + i * 16 + fr, n = n0 + wc * 64 + j * 16 + fq * 4;
              float4 b4 = *(const float4*)(bias + n);
              f32x4 v = acc[i][j];
              float s0 = sc * sigmoidf_(v[0] + b4.x), s1 = sc * sigmoidf_(v[1] + b4.y), s2 = sc * sigmoidf_(v[2] + b4.z), s3 = sc * sigmoidf_(v[3] + b4.w);
              uint2 o; o.x = pack2(s0, s1); o.y = pack2(s2, s3);
              *(uint2*)(dst + (size_t)m * 2048 + n) = o;
            }
        }
      }
    } else {
      const int wr = wid >> 2, wc = wid & 3;
      f32x4 acc[8][4];
      const int q = li - 17;
      const int mt = q >> 2, nt = 4 * xcd + (q & 3);
      const int part = nt >> 3;
      const int m0 = mt * 256, n0 = nt * 256;
      gemm_main256<1>(acc, H0, 1024, (const u16*)(ws + WS_WT_IN), 1024, 16, m0, n0, p.in[I_AMUIN] + part * 1024, SH, smem);
      u16* dst = (u16*)(ws + (size_t)part * SLOT);
      const int nb = n0 - part * 2048;
#pragma unroll
      for (int i = 0; i < 8; ++i)
#pragma unroll
        for (int j = 0; j < 4; ++j) {
          const int m = m0 + wr * 128 + i * 16 + fr, n = nb + wc * 64 + j * 16 + fq * 4;
          f32x4 v = acc[i][j];
          uint2 o; o.x = pack2(v[0], v[1]); o.y = pack2(v[2], v[3]);
          *(uint2*)(dst + (size_t)m * 2048 + n) = o;
        }
    }
  }
}

DEV void phase_scan(const Params& p, char* smem) {
  const int tid = threadIdx.x, lane = tid & 63, wid = tid >> 6;
  float* Lkk = (float*)smem;
  float* Lw = Lkk + 4096;
  float* Lb = Lw + 4096;
  float* Lk = Lb + 4096;
  float* Lr = Lk + 4096;
  float* Lv = Lr + 4096;
  float* LY = Lv + 4096;
  float* Lbon = LY + 4096;
  char* ws = p.ws;
  const u16* gR = (const u16*)(ws + 0 * SLOT);
  const u16* gK = (const u16*)(ws + 1 * SLOT);
  const u16* gV = (const u16*)(ws + 2 * SLOT);
  const u16* gZ = (const u16*)(ws + 3 * SLOT);
  const u16* gW = (const u16*)(ws + 4 * SLOT);
  const u16* gA = (const u16*)(ws + 5 * SLOT);
  u16* YG = (u16*)(ws + 6 * SLOT);
  const int tt = tid >> 3, c8 = (tid & 7) * 8;
  const int rp = wid * 4 + (lane >> 4), kc = lane & 15;

  for (int item = blockIdx.x; item < 768; item += gridDim.x) {
    int h, tok0, nsteps; const float* sinit; float* sout;
    if (item < 256) { h = item & 31; tok0 = (item >> 5) * 4096; nsteps = 4096; sinit = nullptr; sout = p.out + OFF_WKV_P + (size_t)item * 4096; }
    else { int it = item - 256; h = it & 31; tok0 = TP + (it >> 5) * 32; nsteps = 32; sinit = p.in[I_SWKV] + (size_t)it * 4096; sout = p.out + OFF_WKV_S + (size_t)it * 4096; }
    const int nch = (nsteps + 63) >> 6;
    const int col0 = h * 64 + c8;
    float s0[4], s1[4];
    if (sinit) {
      float4 a = *(const float4*)(sinit + (2 * rp) * 64 + kc * 4), b = *(const float4*)(sinit + (2 * rp + 1) * 64 + kc * 4);
      s0[0] = a.x; s0[1] = a.y; s0[2] = a.z; s0[3] = a.w; s1[0] = b.x; s1[1] = b.y; s1[2] = b.z; s1[3] = b.w;
    } else {
#pragma unroll
      for (int j = 0; j < 4; ++j) { s0[j] = 0.f; s1[j] = 0.f; }
    }
    uint4 cr, ck, cv, cz, cw, ca;
#define SCAN_LOAD(c)                                                                   \
    {                                                                                  \
      const int tl_ = (c) * 64 + tt;                                                   \
      if (tl_ < nsteps) {                                                              \
        const size_t o_ = (size_t)(tok0 + tl_) * 2048 + col0;                          \
        cr = *(const uint4*)(gR + o_); ck = *(const uint4*)(gK + o_); cv = *(const uint4*)(gV + o_); \
        cz = *(const uint4*)(gZ + o_); cw = *(const uint4*)(gW + o_); ca = *(const uint4*)(gA + o_); \
      } else { cr = ck = cv = cz = cw = ca = make_uint4(0, 0, 0, 0); }                 \
    }
    SCAN_LOAD(0);
    for (int c = 0; c < nch; ++c) {
      uint4 zc = cz;
      {
        float r[8], k[8], v[8], lw[8], a[8];
        unpack8(cr, r); unpack8(ck, k); unpack8(cv, v); unpack8(cw, lw); unpack8(ca, a);
        float kkv[8], kp[8], bon = 0.f, ss = 0.f;
#pragma unroll
        for (int j = 0; j < 8; ++j) {
          const float kkc = p.in[I_AKK][col0 + j], kac = p.in[I_AKA][col0 + j], rkc = p.in[I_ARK][col0 + j];
          kkv[j] = k[j] * kkc; ss += kkv[j] * kkv[j];
          kp[j] = k[j] * (1.f + (a[j] - 1.f) * kac);
          bon += r[j] * kp[j] * rkc;
        }
        ss = red8(ss); bon = red8(bon);
        const float inv = rsqrtf(ss + 1e-12f);
        float4 o0, o1;
        float* d;
        d = Lkk + tt * 64 + c8;
        o0 = make_float4(kkv[0] * inv, kkv[1] * inv, kkv[2] * inv, kkv[3] * inv); o1 = make_float4(kkv[4] * inv, kkv[5] * inv, kkv[6] * inv, kkv[7] * inv);
        *(float4*)d = o0; *(float4*)(d + 4) = o1;
        d = Lb + tt * 64 + c8;
        *(float4*)d = make_float4(o0.x * a[0], o0.y * a[1], o0.z * a[2], o0.w * a[3]);
        *(float4*)(d + 4) = make_float4(o1.x * a[4], o1.y * a[5], o1.z * a[6], o1.w * a[7]);
        d = Lw + tt * 64 + c8;
        *(float4*)d = make_float4(__expf(lw[0]), __expf(lw[1]), __expf(lw[2]), __expf(lw[3]));
        *(float4*)(d + 4) = make_float4(__expf(lw[4]), __expf(lw[5]), __expf(lw[6]), __expf(lw[7]));
        d = Lk + tt * 64 + c8;
        *(float4*)d = make_float4(kp[0], kp[1], kp[2], kp[3]); *(float4*)(d + 4) = make_float4(kp[4], kp[5], kp[6], kp[7]);
        d = Lr + tt * 64 + c8;
        *(float4*)d = make_float4(r[0], r[1], r[2], r[3]); *(float4*)(d + 4) = make_float4(r[4], r[5], r[6], r[7]);
        d = Lv + tt * 64 + c8;
        *(float4*)d = make_float4(v[0], v[1], v[2], v[3]); *(float4*)(d + 4) = make_float4(v[4], v[5], v[6], v[7]);
        if ((tid & 7) == 0) Lbon[tt] = bon;
      }
      __syncthreads();
      if (c + 1 < nch) SCAN_LOAD(c + 1);
      {
        const int nT = min(64, nsteps - c * 64);
        const float* pk = Lkk + kc * 4; const float* pw = Lw + kc * 4; const float* pb = Lb + kc * 4;
        const float* pkk = Lk + kc * 4; const float* pr = Lr + kc * 4; const float* pv = Lv + rp * 2;
        float4 kk4 = *(const float4*)pk, w4 = *(const float4*)pw, b4 = *(const float4*)pb, k4 = *(const float4*)pkk, r4 = *(const float4*)pr;
        float2 v2 = *(const float2*)pv;
        for (int t = 0; t < nT; ++t) {
          float4 nkk4 = kk4, nw4 = w4, nb4 = b4, nk4 = k4, nr4 = r4; float2 nv2 = v2;
          if (t + 1 < nT) {
            const int o = (t + 1) * 64;
            nkk4 = *(const float4*)(pk + o); nw4 = *(const float4*)(pw + o); nb4 = *(const float4*)(pb + o);
            nk4 = *(const float4*)(pkk + o); nr4 = *(const float4*)(pr + o); nv2 = *(const float2*)(pv + o);
          }
          float sa0 = s0[0] * kk4.x + s0[1] * kk4.y + s0[2] * kk4.z + s0[3] * kk4.w;
          float sa1 = s1[0] * kk4.x + s1[1] * kk4.y + s1[2] * kk4.z + s1[3] * kk4.w;
          sa0 = red16(sa0); sa1 = red16(sa1);
          s0[0] = s0[0] * w4.x + (v2.x * k4.x - sa0 * b4.x);
          s0[1] = s0[1] * w4.y + (v2.x * k4.y - sa0 * b4.y);
          s0[2] = s0[2] * w4.z + (v2.x * k4.z - sa0 * b4.z);
          s0[3] = s0[3] * w4.w + (v2.x * k4.w - sa0 * b4.w);
          s1[0] = s1[0] * w4.x + (v2.y * k4.x - sa1 * b4.x);
          s1[1] = s1[1] * w4.y + (v2.y * k4.y - sa1 * b4.y);
          s1[2] = s1[2] * w4.z + (v2.y * k4.z - sa1 * b4.z);
          s1[3] = s1[3] * w4.w + (v2.y * k4.w - sa1 * b4.w);
          float y0 = s0[0] * r4.x + s0[1] * r4.y + s0[2] * r4.z + s0[3] * r4.w;
          float y1 = s1[0] * r4.x + s1[1] * r4.y + s1[2] * r4.z + s1[3] * r4.w;
          y0 = red16(y0); y1 = red16(y1);
          if (kc == 0) *(float2*)(LY + t * 64 + rp * 2) = make_float2(y0, y1);
          kk4 = nkk4; w4 = nw4; b4 = nb4; k4 = nk4; r4 = nr4; v2 = nv2;
        }
      }
      __syncthreads();
      {
        const int tl = c * 64 + tt;
        if (tl < nsteps) {
          float y[8], z[8];
          float4 a = *(const float4*)(LY + tt * 64 + c8), b = *(const float4*)(LY + tt * 64 + c8 + 4);
          y[0] = a.x; y[1] = a.y; y[2] = a.z; y[3] = a.w; y[4] = b.x; y[5] = b.y; y[6] = b.z; y[7] = b.w;
          float sm = y[0] + y[1] + y[2] + y[3] + y[4] + y[5] + y[6] + y[7];
          sm = red8(sm);
          const float mean = sm * (1.f / 64.f);
          float vs = 0.f;
#pragma unroll
          for (int j = 0; j < 8; ++j) { y[j] -= mean; vs += y[j] * y[j]; }
          vs = red8(vs);
          const float rstd = rsqrtf(vs * (1.f / 64.f) + 64e-5f);
          const float bon = Lbon[tt];
          float4 va = *(const float4*)(Lv + tt * 64 + c8), vb = *(const float4*)(Lv + tt * 64 + c8 + 4);
          float vv[8] = {va.x, va.y, va.z, va.w, vb.x, vb.y, vb.z, vb.w};
          unpack8(zc, z);
          float o[8];
#pragma unroll
          for (int j = 0; j < 8; ++j) {
            float g = p.in[I_ALNG][col0 + j], bb = p.in[I_ALNB][col0 + j];
            float t = y[j] * rstd * g + bb + bon * vv[j];
            o[j] = t * z[j] * sigmoidf_(z[j]);
          }
          uint4 ov; ov.x = pack2(o[0], o[1]); ov.y = pack2(o[2], o[3]); ov.z = pack2(o[4], o[5]); ov.w = pack2(o[6], o[7]);
          *(uint4*)(YG + (size_t)(tok0 + tl) * 2048 + col0) = ov;
        }
      }
      __syncthreads();
    }
#undef SCAN_LOAD
    *(float4*)(sout + (2 * rp) * 64 + kc * 4) = make_float4(s0[0], s0[1], s0[2], s0[3]);
    *(float4*)(sout + (2 * rp + 1) * 64 + kc * 4) = make_float4(s1[0], s1[1], s1[2], s1[3]);
  }
}

template <int LAYER>
DEV void phase_outproj(const Params& p, char* smem) {
  const int tid = threadIdx.x, lane = tid & 63, wid = tid >> 6, wr = wid >> 1, wc = wid & 1, fr = lane & 15, fq = lane >> 4;
  char* ws = p.ws;
  const u16* A = (const u16*)(ws + 6 * SLOT);
  const u16* Bt = (const u16*)(ws + (LAYER == 0 ? WS_WT_OUTA : WS_WT_OUTB));
  const float* mod = (const float*)(ws + WS_MOD) + (size_t)LAYER * 24 * 3072;
  float* xmid = (float*)(ws + 0 * SLOT);
  f32x4 acc[4][4];
  unsigned* ctr = sched_ctr(p, LAYER == 0 ? 1 : 3);
  int nxt;
  for (int li = sched_first(ctr, smem); li < 130; li = sched_commit(nxt, smem)) {
    nxt = sched_prefetch(ctr);
    const int item = 130 * (blockIdx.x & 7) + li;
    const int m0 = (item >> 3) * 256, n0 = (item & 7) * 128;
    gemm_main<0>(acc, A, 2048, Bt, 2048, 32, m0, n0, nullptr, nullptr, smem);
#pragma unroll
    for (int i = 0; i < 4; ++i) {
      const int m = m0 + wr * 64 + i * 16 + fr;
      const float* gate = mod + (size_t)seq_of(m) * 3072 + 2048;
#pragma unroll
      for (int j = 0; j < 4; ++j) {
        const int n = n0 + wc * 64 + j * 16 + fq * 4;
        float4 g4 = *(const float4*)(gate + n);
        f32x4 v = acc[i][j];
        if (LAYER == 0) {
          const float* xr = m < TP ? p.in[I_XP] + (size_t)m * 1024 : p.in[I_XS] + (size_t)(m - TP) * 1024;
          float4 x4 = *(const float4*)(xr + n);
          *(float4*)(xmid + (size_t)m * 1024 + n) = make_float4(x4.x + g4.x * v[0], x4.y + g4.y * v[1], x4.z + g4.z * v[2], x4.w + g4.w * v[3]);
        } else {
          float4 x4 = *(const float4*)(xmid + (size_t)m * 1024 + n);
          float* yo = m < TP ? p.out + OFF_Y_P + (size_t)m * 1024 : p.out + OFF_Y_S + (size_t)(m - TP) * 1024;
          *(float4*)(yo + n) = make_float4(x4.x + g4.x * v[0], x4.y + g4.y * v[1], x4.z + g4.z * v[2], x4.w + g4.w * v[3]);
        }
      }
    }
  }
}

DEV void phase_norm1(const Params& p) {
  const int lane = threadIdx.x & 63, wid = threadIdx.x >> 6;
  const float* mod = (const float*)(p.ws + WS_MOD) + (size_t)24 * 3072;
  const float* xmid = (const float*)(p.ws + 0 * SLOT);
  u16* AKV = (u16*)(p.ws + 1 * SLOT);
  u16* AQ = AKV + (size_t)NTOK * 1024;
  const float* gkv = p.in[I_KVNG];
  const float* gb = p.in[I_BNG];
  for (int t = blockIdx.x * 8 + wid; t < NTOK; t += gridDim.x * 8) {
    const float* x = xmid + (size_t)t * 1024;
    const float* md = mod + (size_t)seq_of(t) * 3072;
    float4 v[4];
    float ss = 0.f;
#pragma unroll
    for (int i = 0; i < 4; ++i) {
      v[i] = *(const float4*)(x + lane * 4 + 256 * i);
      ss += v[i].x * v[i].x + v[i].y * v[i].y + v[i].z * v[i].z + v[i].w * v[i].w;
    }
    ss = wave_sum(ss);
    const float rstd = rsqrtf(ss * (1.0f / 1024.0f) + 1e-6f);
#pragma unroll
    for (int i = 0; i < 4; ++i) {
      const int c = lane * 4 + 256 * i;
      float4 g1 = *(const float4*)(gkv + c), g2 = *(const float4*)(gb + c), sh = *(const float4*)(md + c), sc = *(const float4*)(md + 1024 + c);
      float xn0 = v[i].x * rstd, xn1 = v[i].y * rstd, xn2 = v[i].z * rstd, xn3 = v[i].w * rstd;
      uint2 o;
      o.x = pack2(xn0 * g1.x, xn1 * g1.y); o.y = pack2(xn2 * g1.z, xn3 * g1.w);
      *(uint2*)(AKV + (size_t)t * 1024 + c) = o;
      o.x = pack2(xn0 * g2.x * (1.f + sc.x) + sh.x, xn1 * g2.y * (1.f + sc.y) + sh.y);
      o.y = pack2(xn2 * g2.z * (1.f + sc.z) + sh.z, xn3 * g2.w * (1.f + sc.w) + sh.w);
      *(uint2*)(AQ + (size_t)t * 1024 + c) = o;
    }
  }
}

#define QSCALE (0.08838834764831845f * 1.4426950408889634f)
DEV void phase_proj1(const Params& p, char* smem) {
  const int tid = threadIdx.x, lane = tid & 63, wid = tid >> 6, wr = wid >> 2, wc = wid & 3, fr = lane & 15, fq = lane >> 4;
  char* ws = p.ws;
  const u16* AKV = (const u16*)(ws + 1 * SLOT);
  const u16* AQ = AKV + (size_t)NTOK * 1024;
  u16* KB = (u16*)(ws + 2 * SLOT);
  u16* VB = (u16*)(ws + 3 * SLOT);
  u16* QB = (u16*)(ws + 4 * SLOT);
  u16* ZS = (u16*)(ws + 5 * SLOT);
  f32x4 acc[8][4];
  float* red = (float*)smem;
  unsigned* ctr = sched_ctr(p, 2);
  int nxt;
  for (int li = sched_first(ctr, smem); li < 520; li = sched_commit(nxt, smem)) {
    nxt = sched_prefetch(ctr);
    const int mt = li >> 2, t = 4 * (blockIdx.x & 7) + (li & 3);
    const int isq = t >> 4, nt = t & 15;
    const int m0 = mt * 256, n0 = nt * 256;
    gemm_main256<0>(acc, isq ? AQ : AKV, 1024, (const u16*)(ws + (isq ? WS_WT_INB : WS_WT_KV)), 1024, 16, m0, n0, nullptr, nullptr, smem);
    if (nt < 8) {
#pragma unroll
      for (int i = 0; i < 8; ++i) {
        float ss = 0.f;
#pragma unroll
        for (int j = 0; j < 4; ++j) ss += acc[i][j][0] * acc[i][j][0] + acc[i][j][1] * acc[i][j][1] + acc[i][j][2] * acc[i][j][2] + acc[i][j][3] * acc[i][j][3];
        red[(wr * 128 + i * 16 + fr) * 16 + wc * 4 + fq] = ss;
      }
      __syncthreads();
      const float* gain = isq ? p.in[I_BQG] : p.in[I_KGAIN];
#pragma unroll
      for (int i = 0; i < 8; ++i) {
        const int row = wr * 128 + i * 16 + fr, m = m0 + row;
        float4 ra = *(const float4*)(red + row * 16 + (wc >> 1) * 8), rb = *(const float4*)(red + row * 16 + (wc >> 1) * 8 + 4);
        float tot = ra.x + ra.y + ra.z + ra.w + rb.x + rb.y + rb.z + rb.w;
        float rs = rsqrtf(tot * (1.f / 128.f) + 1e-6f);
        if (isq) rs *= QSCALE;
#pragma unroll
        for (int j = 0; j < 4; ++j) {
          const int d = (wc & 1) * 64 + j * 16 + fq * 4, n = n0 + wc * 64 + j * 16 + fq * 4;
          float4 g4 = *(const float4*)(gain + d);
          f32x4 v = acc[i][j];
          float o0 = v[0] * rs * g4.x, o1 = v[1] * rs * g4.y, o2 = v[2] * rs * g4.z, o3 = v[3] * rs * g4.w;
          uint2 o; o.x = pack2(o0, o1); o.y = pack2(o2, o3);
          if (isq) {
            *(uint2*)(QB + (size_t)m * 2048 + n) = o;
          } else {
            *(uint2*)(KB + (size_t)m * 2048 + n) = o;
            float* ko = m < TP ? p.out + OFF_K_P + (size_t)m * 2048 : p.out + OFF_K_S + (size_t)(m - TP) * 2048;
            *(float4*)(ko + n) = make_float4(o0, o1, o2, o3);
          }
        }
      }
      __syncthreads();
    } else {
#pragma unroll
      for (int i = 0; i < 8; ++i) {
        const int m = m0 + wr * 128 + i * 16 + fr;
#pragma unroll
        for (int j = 0; j < 4; ++j) {
          const int n = n0 - 2048 + wc * 64 + j * 16 + fq * 4;
          f32x4 v = acc[i][j];
          if (isq) {
            float o0 = v[0] * sigmoidf_(v[0]), o1 = v[1] * sigmoidf_(v[1]), o2 = v[2] * sigmoidf_(v[2]), o3 = v[3] * sigmoidf_(v[3]);
            uint2 o; o.x = pack2(o0, o1); o.y = pack2(o2, o3);
            *(uint2*)(ZS + (size_t)m * 2048 + n) = o;
          } else {
            uint2 o; o.x = pack2(v[0], v[1]); o.y = pack2(v[2], v[3]);
            *(uint2*)(VB + (size_t)m * 2048 + n) = o;
            float* vo = m < TP ? p.out + OFF_V_P + (size_t)m * 2048 : p.out + OFF_V_S + (size_t)(m - TP) * 2048;
            *(float4*)(vo + n) = make_float4(v[0], v[1], v[2], v[3]);
          }
        }
      }
    }
  }
}

DEV unsigned off_b(unsigned row, unsigned ch) { return 256u * row + 16u * (ch ^ (((row & 3) << 2) | ((row >> 2) & 3))); }

DEV void phase_attn(const Params& p, char* smem) {
  const int tid = threadIdx.x, lane = tid & 63, w = tid >> 6, fr = lane & 15, fq = lane >> 4;
  char* ws = p.ws;
  const u16* KB = (const u16*)(ws + 2 * SLOT);
  const u16* VB = (const u16*)(ws + 3 * SLOT);
  const u16* QB = (const u16*)(ws + 4 * SLOT);
  const u16* ZS = (const u16*)(ws + 5 * SLOT);
  u16* OG = (u16*)(ws + 6 * SLOT);
  const int lrow = tid >> 4, lch = tid & 15;
  const unsigned lw0 = off_b(lrow, lch), lw1 = off_b(lrow + 32, lch);
  const int tq = (lane & 15) >> 2, tp = lane & 3;

  for (int item = blockIdx.x; item < 4096 + 256; item += gridDim.x) {
    int b, h, nq, qpos0, tokq0, ntiles, nkeys, tokk0; bool sample;
    if (item < 4096) {
      const int qblk = 31 - (item >> 7), bh = item & 127;
      b = bh >> 4; h = bh & 15; nq = 128; qpos0 = qblk * 128; tokq0 = b * 4096 + qpos0; ntiles = 2 * qblk + 2; nkeys = qpos0 + 128; tokk0 = b * 4096; sample = false;
    } else {
      const int bh = item - 4096;
      b = bh >> 4; h = bh & 15; nq = 32; qpos0 = 1024; tokq0 = TP + b * 32; ntiles = 17; nkeys = 1056; tokk0 = TP + b * 32 - 1024; sample = true;
    }
    const bool wactive = (w * 16) < nq;
    int* dflag = (int*)(smem + 65536);
    __syncthreads();
    if (lane == 0) dflag[w] = wactive ? 0 : 1;
    bool wdone = !wactive;
    const int qp = qpos0 + w * 16 + fr;
    const int qwmax = qpos0 + w * 16 + 15;
    bf16x8 qf[4];
#pragma unroll
    for (int ks = 0; ks < 4; ++ks) {
      if (wactive) qf[ks] = *(const bf16x8*)(QB + (size_t)(tokq0 + w * 16 + fr) * 2048 + h * 128 + ks * 32 + fq * 8);
      else qf[ks] = (bf16x8){0, 0, 0, 0, 0, 0, 0, 0};
    }
    f32x4 O[8];
#pragma unroll
    for (int dt = 0; dt < 8; ++dt) O[dt] = (f32x4){0, 0, 0, 0};
    float carry = 0.f;

    uint4 lk0, lk1, lv0, lv1;
#define ATT_LOAD(kb)                                                                                  \
    {                                                                                                 \
      const int kx0_ = (kb) * 64 + lrow, kx1_ = kx0_ + 32;                                            \
      if (sample && (kb) < 16) {                                                                      \
        const float* ck_ = p.in[I_CK] + ((size_t)(b * 1024 + kx0_) * 16 + h) * 128 + lch * 8;         \
        const float* cv_ = p.in[I_CV] + ((size_t)(b * 1024 + kx0_) * 16 + h) * 128 + lch * 8;         \
        float4 a_ = *(const float4*)ck_, b_ = *(const float4*)(ck_ + 4);                              \
        float4 c_ = *(const float4*)(ck_ + 32 * 2048), d_ = *(const float4*)(ck_ + 32 * 2048 + 4);    \
        lk0 = make_uint4(pack2(a_.x, a_.y), pack2(a_.z, a_.w), pack2(b_.x, b_.y), pack2(b_.z, b_.w)); \
        lk1 = make_uint4(pack2(c_.x, c_.y), pack2(c_.z, c_.w), pack2(d_.x, d_.y), pack2(d_.z, d_.w)); \
        a_ = *(const float4*)cv_; b_ = *(const float4*)(cv_ + 4);                                     \
        c_ = *(const float4*)(cv_ + 32 * 2048); d_ = *(const float4*)(cv_ + 32 * 2048 + 4);           \
        lv0 = make_uint4(pack2(a_.x, a_.y), pack2(a_.z, a_.w), pack2(b_.x, b_.y), pack2(b_.z, b_.w)); \
        lv1 = make_uint4(pack2(c_.x, c_.y), pack2(c_.z, c_.w), pack2(d_.x, d_.y), pack2(d_.z, d_.w)); \
      } else {                                                                                        \
        const size_t o0_ = (size_t)(tokk0 + kx0_) * 2048 + h * 128 + lch * 8;                         \
        const size_t o1_ = o0_ + (size_t)32 * 2048;                                                   \
        if (kx0_ < nkeys) { lk0 = *(const uint4*)(KB + o0_); lv0 = *(const uint4*)(VB + o0_); }       \
        else { lk0 = make_uint4(0, 0, 0, 0); lv0 = lk0; }                                             \
        if (kx1_ < nkeys) { lk1 = *(const uint4*)(KB + o1_); lv1 = *(const uint4*)(VB + o1_); }       \
        else { lk1 = make_uint4(0, 0, 0, 0); lv1 = lk1; }                                             \
      }                                                                                               \
    }
#define ATT_STORE(st)                                                                                 \
    {                                                                                                 \
      char* sK_ = smem + (st) * 32768; char* sV_ = sK_ + 16384;                                       \
      *(uint4*)(sK_ + lw0) = lk0; *(uint4*)(sK_ + lw1) = lk1;                                         \
      *(uint4*)(sV_ + lw0) = lv0; *(uint4*)(sV_ + lw1) = lv1;                                         \
    }
    ATT_LOAD(ntiles - 1);
    ATT_STORE(0);
    __syncthreads();
    for (int it = 0; it < ntiles; ++it) {
      const int kb = ntiles - 1 - it, st = it & 1;
      if (it + 1 < ntiles) ATT_LOAD(kb - 1);
      if (!wdone && kb * 64 < qwmax) {
        const char* sK = smem + st * 32768;
        const char* sV = sK + 16384;
        f32x4 S[4];
#pragma unroll
        for (int mt = 0; mt < 4; ++mt) S[mt] = (f32x4){0, 0, 0, 0};
#pragma unroll
        for (int ks = 0; ks < 4; ++ks)
#pragma unroll
          for (int mt = 0; mt < 4; ++mt) {
            bf16x8 a = *(const bf16x8*)(sK + off_b(mt * 16 + fr, ks * 4 + fq));
            S[mt] = __builtin_amdgcn_mfma_f32_16x16x32_bf16(a, qf[ks], S[mt], 0, 0, 0);
          }
        bf16x8 wf[2];
        {
          float ee[4][4], tot[4], hi[4];
#pragma unroll
          for (int mt = 0; mt < 4; ++mt) {
            const int kbase = kb * 64 + mt * 16 + fq * 4;
            float ls[4];
#pragma unroll
            for (int jj = 0; jj < 4; ++jj) {
              const float u = S[mt][jj];
              const bool valid = (kbase + jj) < qp;
              const float l = -__builtin_amdgcn_logf(1.0f + __builtin_amdgcn_exp2f(u));
              ls[jj] = valid ? l : 0.f;
              ee[mt][jj] = valid ? (u + l) : -1e30f;
            }
            const float x3 = ls[3], x2 = x3 + ls[2], x1 = x2 + ls[1], seg = x1 + ls[0];
            ee[mt][2] += x3; ee[mt][1] += x2; ee[mt][0] += x1;
            const float t1 = __shfl_xor(seg, 16), t2 = __shfl_xor(seg, 32), t3 = __shfl_xor(t1, 32);
            tot[mt] = seg + t1 + t2 + t3;
            hi[mt] = fq == 0 ? (t1 + t2 + t3) : fq == 1 ? (t2 + t3) : fq == 2 ? t1 : 0.f;
          }
          float run = carry;
          float wv[4][4];
#pragma unroll
          for (int mt = 3; mt >= 0; --mt) {
            const float base = run + hi[mt];
            run += tot[mt];
#pragma unroll
            for (int jj = 0; jj < 4; ++jj) wv[mt][jj] = __builtin_amdgcn_exp2f(ee[mt][jj] + base);
          }
          carry = run;
          if (__all(carry < -150.0f)) { wdone = true; if (lane == 0) dflag[w] = 1; }
#pragma unroll
          for (int p2 = 0; p2 < 2; ++p2) {
            uint4 pk;
            pk.x = pack2(wv[2 * p2][0], wv[2 * p2][1]); pk.y = pack2(wv[2 * p2][2], wv[2 * p2][3]);
            pk.z = pack2(wv[2 * p2 + 1][0], wv[2 * p2 + 1][1]); pk.w = pack2(wv[2 * p2 + 1][2], wv[2 * p2 + 1][3]);
            wf[p2] = *(bf16x8*)&pk;
          }
        }
#pragma unroll
        for (int p2 = 0; p2 < 2; ++p2)
#pragma unroll
          for (int dt = 0; dt < 8; ++dt) {
            const unsigned r0 = 32 * p2 + 4 * fq + tq, r1 = r0 + 16;
            const unsigned ch = 2 * dt + (tp >> 1);
            const char* a0 = sV + off_b(r0, ch) + 8 * (tp & 1);
            const char* a1 = sV + off_b(r1, ch) + 8 * (tp & 1);
            s16x4 lo = __builtin_amdgcn_ds_read_tr16_b64_v4i16((s16x4 __attribute__((address_space(3)))*)(a0));
            s16x4 hi4 = __builtin_amdgcn_ds_read_tr16_b64_v4i16((s16x4 __attribute__((address_space(3)))*)(a1));
            bf16x8 a = {lo[0], lo[1], lo[2], lo[3], hi4[0], hi4[1], hi4[2], hi4[3]};
            O[dt] = __builtin_amdgcn_mfma_f32_16x16x32_bf16(a, wf[p2], O[dt], 0, 0, 0);
          }
      }
      if (it + 1 < ntiles) ATT_STORE(st ^ 1);
      __syncthreads();
      {
        const int4 f0 = *(const int4*)dflag, f1 = *(const int4*)(dflag + 4);
        if (f0.x & f0.y & f0.z & f0.w & f1.x & f1.y & f1.z & f1.w) break;
      }
    }
#undef ATT_LOAD
#undef ATT_STORE
    if (wactive) {
      const size_t rowoff = (size_t)(tokq0 + w * 16 + fr) * 2048 + h * 128;
#pragma unroll
      for (int dt = 0; dt < 8; ++dt) {
        const int d = dt * 16 + fq * 4;
        uint2 z = *(const uint2*)(ZS + rowoff + d);
        f32x4 v = O[dt];
        uint2 o;
        o.x = pack2(v[0] * bflo(z.x), v[1] * bfhi(z.x)); o.y = pack2(v[2] * bflo(z.y), v[3] * bfhi(z.y));
        *(uint2*)(OG + rowoff + d) = o;
      }
    }
  }
}

__global__ void __launch_bounds__(NTHREADS) mega(Params p, int lo, int hi) {
  __shared__ __attribute__((aligned(16))) char smem[147456];
  cg::grid_group grid = cg::this_grid();
#ifndef PROBE_DOUBLE
#define PROBE_DOUBLE -1
#endif
#define RUN_PHASE(k, call) if ((k) >= lo && (k) < hi) { if ((k) > lo) grid.sync(); call; if ((k) == PROBE_DOUBLE) { __syncthreads(); call; } }
  RUN_PHASE(0, phase_prep(p, smem))
  RUN_PHASE(1, phase_norm0(p))
  RUN_PHASE(2, phase_proj0(p, smem))
  RUN_PHASE(3, phase_scan(p, smem))
  RUN_PHASE(4, phase_outproj<0>(p, smem))
  RUN_PHASE(5, phase_norm1(p))
  RUN_PHASE(6, phase_proj1(p, smem))
  RUN_PHASE(7, phase_attn(p, smem))
  RUN_PHASE(8, phase_outproj<1>(p, smem))
}

#ifndef N_LAUNCH_MODE
#define N_LAUNCH_MODE 1
#endif

extern "C" void kernel_launch(void* const* d_in, const int* in_sizes, int n_in, void* d_out, int out_size, void* d_ws, size_t ws_size,
                              hipStream_t stream) {
  Params p{};
  for (int i = 0; i < 36; ++i) p.in[i] = (const float*)d_in[i];
  p.out = (float*)d_out;
  p.ws = (char*)d_ws;
  static int grid_blocks = 0;
  if (!grid_blocks) {
    int dev = 0, cus = 0, per_cu = 0;
    hipGetDevice(&dev);
    hipDeviceGetAttribute(&cus, hipDeviceAttributeMultiprocessorCount, dev);
    hipOccupancyMaxActiveBlocksPerMultiprocessor(&per_cu, mega, NTHREADS, 0);
    if (per_cu < 1) per_cu = 1;
    grid_blocks = cus * per_cu;
  }
  if (ws_size < WS_END) { fprintf(stderr, "workspace too small: %zu < %llu\n", ws_size, (unsigned long long)WS_END); return; }
#if N_LAUNCH_MODE == 1
  int lo = 0, hi = 9;
  void* args[] = {&p, &lo, &hi};
  hipError_t e = hipLaunchCooperativeKernel((void*)mega, dim3(grid_blocks), dim3(NTHREADS), args, 0, stream);
  if (e != hipSuccess) fprintf(stderr, "cooperative launch failed: %s (grid %d)\n", hipGetErrorString(e), grid_blocks);
#else
  for (int ph = 0; ph < 9; ++ph) hipLaunchKernelGGL(mega, dim3(grid_blocks), dim3(NTHREADS), 0, stream, p, ph, ph + 1);
#endif
}
```

```cpp
#include <hip/hip_runtime.h>
#include <hip/hip_cooperative_groups.h>
#include <cstdio>
namespace cg = cooperative_groups;

typedef unsigned short u16;
typedef short bf16x8 __attribute__((ext_vector_type(8)));
typedef short s16x4 __attribute__((ext_vector_type(4)));
typedef float f32x4 __attribute__((ext_vector_type(4)));
typedef float f32x2 __attribute__((ext_vector_type(2)));
typedef __bf16 bf16x2_t __attribute__((ext_vector_type(2)));

#define DEV __device__ __forceinline__

#define NTOK 33280
#define TP 32768
#define NTHREADS 512

#define OFF_Y_P 0
#define OFF_Y_S 33554432
#define OFF_K_P 34078720
#define OFF_V_P 101187584
#define OFF_WKV_P 168296448
#define OFF_SH_P 169345024
#define OFF_K_S 169353216
#define OFF_V_S 170401792
#define OFF_WKV_S 171450368
#define OFF_SH_S 173547520

#define SLOT 136314880ull
#define WS_W (7ull * SLOT)
#define WS_WT_IN (WS_W)
#define WS_WT_OUTA (WS_WT_IN + 16777216ull)
#define WS_WT_KV (WS_WT_OUTA + 4194304ull)
#define WS_WT_INB (WS_WT_KV + 8388608ull)
#define WS_WT_OUTB (WS_WT_INB + 8388608ull)
#define WS_W2T (WS_WT_OUTB + 4194304ull)
#define WS_A2T (WS_W2T + 262144ull)
#define WS_L1T (WS_A2T + 262144ull)
#define WS_MOD (WS_L1T + 524288ull)
#define WS_SH (WS_MOD + 589824ull)
#define WS_CTR (WS_SH + 49152ull)
#define WS_BAR (WS_CTR + 4096ull)
#define WS_END (WS_BAR + 256ull)
#define WS_H0 (6ull * SLOT)
#define WS_T (6ull * SLOT + 68157440ull)

struct Params {
  const float* in[36];
  float* out;
  char* ws;
};

enum { I_XP = 0, I_XS, I_CK, I_CV, I_SWKV, I_SSH, I_CP, I_CS, I_ANG, I_AADAW, I_AADAB, I_AWIN, I_AMUIN, I_AMUW, I_AMUA,
       I_AW0, I_AW1, I_AW2, I_AA0, I_AA1, I_AA2, I_AKK, I_AKA, I_ARK, I_ALNG, I_ALNB, I_AWOUT, I_KVNG, I_KVW, I_KGAIN,
       I_BNG, I_BADAW, I_BADAB, I_BWIN, I_BQG, I_BWOUT };

DEV int seq_of(int t) { return t < TP ? (t >> 12) : 8 + ((t - TP) >> 5); }
DEV bool seq_start(int t) { return t < TP ? ((t & 4095) == 0) : (((t - TP) & 31) == 0); }

DEV unsigned pack2(float a, float b) {
  f32x2 v = {a, b};
  bf16x2_t r = __builtin_convertvector(v, bf16x2_t);
  return *(unsigned*)&r;
}
DEV float bflo(unsigned w) { return __uint_as_float(w << 16); }
DEV float bfhi(unsigned w) { return __uint_as_float(w & 0xffff0000u); }
DEV void unpack8(const uint4& x, float* f) {
  f[0] = bflo(x.x); f[1] = bfhi(x.x); f[2] = bflo(x.y); f[3] = bfhi(x.y);
  f[4] = bflo(x.z); f[5] = bfhi(x.z); f[6] = bflo(x.w); f[7] = bfhi(x.w);
}
DEV float sigmoidf_(float x) { return 1.0f / (1.0f + __expf(-x)); }

template <int CTRL>
DEV float dppf(float x) {
  return __int_as_float(__builtin_amdgcn_update_dpp(0, __float_as_int(x), CTRL, 0xf, 0xf, true));
}
DEV float red4(float x) { x += dppf<0xB1>(x); x += dppf<0x4E>(x); return x; }
DEV float red8(float x) { x = red4(x); x += dppf<0x141>(x); return x; }
DEV float red16(float x) { x = red8(x); x += dppf<0x140>(x); return x; }
DEV float wave_sum(float x) {
#pragma unroll
  for (int o = 32; o >= 1; o >>= 1) x += __shfl_xor(x, o);
  return x;
}


#define SCHED_SLOT_OFF 147440
DEV unsigned* sched_ctr(const Params& p, int phase_slot) { return (unsigned*)(p.ws + WS_CTR) + (phase_slot * 8 + (blockIdx.x & 7)) * 16; }
DEV int sched_first(unsigned* ctr, char* smem) {
  int* slot = (int*)(smem + SCHED_SLOT_OFF);
  __syncthreads();
  if (threadIdx.x == 0) *slot = (int)atomicAdd(ctr, 1u);
  __syncthreads();
  return *slot;
}

DEV void group_sync(unsigned* bar, unsigned target) {
  __syncthreads();
  if (threadIdx.x == 0) {
    __hip_atomic_fetch_add(bar, 1u, __ATOMIC_RELAXED, __HIP_MEMORY_SCOPE_AGENT);
    while (__hip_atomic_load(bar, __ATOMIC_RELAXED, __HIP_MEMORY_SCOPE_AGENT) < target) __builtin_amdgcn_s_sleep(2);
  }
  __syncthreads();
}
DEV int sched_prefetch(unsigned* ctr) { return threadIdx.x == 0 ? (int)atomicAdd(ctr, 1u) : 0; }
DEV int sched_commit(int nxt, char* smem) {
  int* slot = (int*)(smem + SCHED_SLOT_OFF);
  __syncthreads();
  if (threadIdx.x == 0) *slot = nxt;
  __syncthreads();
  return *slot;
}

#define GEMM_STAGE_BYTES 49152

template <int AMODE>
DEV void gemm_main(f32x4 (&acc)[4][4], const u16* __restrict__ A, int lda, const u16* __restrict__ Bt, int ldb, int nk,
                   int m0, int n0, const float* __restrict__ mu, const u16* __restrict__ SH, char* smem) {
  const int tid = threadIdx.x, lane = tid & 63, wid = tid >> 6, wr = wid >> 1, wc = wid & 1, fr = lane & 15, fq = lane >> 4;
  const int lrow = tid >> 3, lch = tid & 7;
#pragma unroll
  for (int i = 0; i < 4; ++i)
#pragma unroll
    for (int j = 0; j < 4; ++j) acc[i][j] = (f32x4){0.f, 0.f, 0.f, 0.f};

  const u16* pa0; const u16* pa1; const u16* pa2; const u16* pa3;
  const u16* pp0 = nullptr;
  const int arow = 4 * lrow;
  {
    int m = m0 + arow;
    pa0 = A + (size_t)m * lda + lch * 8;
    pa1 = pa0 + lda; pa2 = pa1 + lda; pa3 = pa2 + lda;
    if (AMODE != 0) pp0 = seq_start(m) ? SH + seq_of(m) * 1024 + lch * 8 : pa0 - lda;
  }
  const u16* pb0 = Bt + (size_t)(n0 + lrow) * ldb + lch * 8;
  const u16* pb1 = pb0 + (size_t)64 * ldb;
  const int woffB = lrow * 128 + ((lch ^ ((lrow >> 1) & 7)) << 4);
  const int woffA0 = (arow + 0) * 128 + ((lch ^ (((arow + 0) >> 1) & 7)) << 4);
  const int woffA1 = (arow + 1) * 128 + ((lch ^ (((arow + 1) >> 1) & 7)) << 4);
  const int woffA2 = (arow + 2) * 128 + ((lch ^ (((arow + 2) >> 1) & 7)) << 4);
  const int woffA3 = (arow + 3) * 128 + ((lch ^ (((arow + 3) >> 1) & 7)) << 4);

  uint4 ra0, ra1, ra2, ra3, rp0, rb0, rb1;
  float4 mu0, mu1;
  rp0 = make_uint4(0, 0, 0, 0);
  mu0 = mu1 = make_float4(0, 0, 0, 0);

#define G_LOAD(kt)                                                                     \
  {                                                                                    \
    const int k0_ = (kt) * 64;                                                         \
    if (AMODE == 0) {                                                                  \
      ra0 = *(const uint4*)(pa0 + k0_); ra1 = *(const uint4*)(pa1 + k0_);              \
      ra2 = *(const uint4*)(pa2 + k0_); ra3 = *(const uint4*)(pa3 + k0_);              \
    } else if (AMODE == 1) {                                                           \
      ra0 = *(const uint4*)(pa0 + k0_); ra1 = *(const uint4*)(pa1 + k0_);              \
      ra2 = *(const uint4*)(pa2 + k0_); ra3 = *(const uint4*)(pa3 + k0_);              \
      rp0 = *(const uint4*)(pp0 + k0_);                                                \
      mu0 = *(const float4*)(mu + k0_ + lch * 8); mu1 = *(const float4*)(mu + k0_ + lch * 8 + 4); \
    } else {                                                                           \
      const int kk_ = k0_ & 1023;                                                      \
      ra0 = *(const uint4*)(pa0 + kk_); ra1 = *(const uint4*)(pa1 + kk_);              \
      ra2 = *(const uint4*)(pa2 + kk_); ra3 = *(const uint4*)(pa3 + kk_);              \
      if (k0_ >= 1024) rp0 = *(const uint4*)(pp0 + kk_);                               \
    }                                                                                  \
    rb0 = *(const uint4*)(pb0 + k0_); rb1 = *(const uint4*)(pb1 + k0_);                \
  }

#define G_XFORM(dst, a_, p_, kt)                                                       \
  {                                                                                    \
    if (AMODE == 0) dst = a_;                                                          \
    else if (AMODE == 1) {                                                             \
      float h_[8], q_[8]; unpack8(a_, h_); unpack8(p_, q_);                            \
      dst.x = pack2(h_[0] + mu0.x * (q_[0] - h_[0]), h_[1] + mu0.y * (q_[1] - h_[1])); \
      dst.y = pack2(h_[2] + mu0.z * (q_[2] - h_[2]), h_[3] + mu0.w * (q_[3] - h_[3])); \
      dst.z = pack2(h_[4] + mu1.x * (q_[4] - h_[4]), h_[5] + mu1.y * (q_[5] - h_[5])); \
      dst.w = pack2(h_[6] + mu1.z * (q_[6] - h_[6]), h_[7] + mu1.w * (q_[7] - h_[7])); \
    } else {                                                                           \
      if ((kt) * 64 >= 1024) {                                                         \
        float h_[8], q_[8]; unpack8(a_, h_); unpack8(p_, q_);                          \
        dst.x = pack2(q_[0] - h_[0], q_[1] - h_[1]); dst.y = pack2(q_[2] - h_[2], q_[3] - h_[3]); \
        dst.z = pack2(q_[4] - h_[4], q_[5] - h_[5]); dst.w = pack2(q_[6] - h_[6], q_[7] - h_[7]); \
      } else dst = a_;                                                                 \
    }                                                                                  \
  }

#define G_STORE(stage, kt)                                                             \
  {                                                                                    \
    char* sA_ = smem + (stage) * GEMM_STAGE_BYTES; char* sB_ = sA_ + 32768;            \
    uint4 v_;                                                                          \
    G_XFORM(v_, ra0, rp0, kt); *(uint4*)(sA_ + woffA0) = v_;                           \
    G_XFORM(v_, ra1, ra0, kt); *(uint4*)(sA_ + woffA1) = v_;                           \
    G_XFORM(v_, ra2, ra1, kt); *(uint4*)(sA_ + woffA2) = v_;                           \
    G_XFORM(v_, ra3, ra2, kt); *(uint4*)(sA_ + woffA3) = v_;                           \
    *(uint4*)(sB_ + woffB) = rb0; *(uint4*)(sB_ + woffB + 64 * 128) = rb1;             \
  }

  G_LOAD(0);
  G_STORE(0, 0);
  __syncthreads();
  const int rsw = (fr >> 1) & 7;
  for (int kt = 0; kt < nk; ++kt) {
    const int st = kt & 1;
    if (kt + 1 < nk) G_LOAD(kt + 1);
    __builtin_amdgcn_sched_barrier(0);
    {
      const char* sA = smem + st * GEMM_STAGE_BYTES;
      const char* sB = sA + 32768;
#pragma unroll
      for (int kk = 0; kk < 2; ++kk) {
        bf16x8 af[4], bfr[4];
        const int cho = ((kk * 4 + fq) ^ rsw) << 4;
#pragma unroll
        for (int i = 0; i < 4; ++i) af[i] = *(const bf16x8*)(sA + (wr * 64 + i * 16 + fr) * 128 + cho);
#pragma unroll
        for (int j = 0; j < 4; ++j) bfr[j] = *(const bf16x8*)(sB + (wc * 64 + j * 16 + fr) * 128 + cho);
#pragma unroll
        for (int i = 0; i < 4; ++i)
#pragma unroll
          for (int j = 0; j < 4; ++j) acc[i][j] = __builtin_amdgcn_mfma_f32_16x16x32_bf16(bfr[j], af[i], acc[i][j], 0, 0, 0);
      }
    }
    if (kt + 1 < nk) G_STORE(st ^ 1, kt + 1);
    __syncthreads();
  }
#undef G_LOAD
#undef G_XFORM
#undef G_STORE
}


#define G2_STAGE_BYTES 65536
template <int AMODE>
DEV void gemm_main256(f32x4 (&acc)[8][4], const u16* __restrict__ A, int lda, const u16* __restrict__ Bt, int ldb, int nk,
                      int m0, int n0, const float* __restrict__ mu, const u16* __restrict__ SH, char* smem) {
  const int tid = threadIdx.x, lane = tid & 63, wid = tid >> 6, wr = wid >> 2, wc = wid & 3, fr = lane & 15, fq = lane >> 4;
  const int lrow = tid >> 3, lch = tid & 7;
#pragma unroll
  for (int i = 0; i < 8; ++i)
#pragma unroll
    for (int j = 0; j < 4; ++j) acc[i][j] = (f32x4){0.f, 0.f, 0.f, 0.f};
  const int arow = 4 * lrow;
  const u16* pa0 = A + (size_t)(m0 + arow) * lda + lch * 8;
  const u16* pp0 = nullptr;
  if (AMODE != 0) pp0 = seq_start(m0 + arow) ? SH + seq_of(m0 + arow) * 1024 + lch * 8 : pa0 - lda;
  const u16* pb0 = Bt + (size_t)(n0 + lrow) * ldb + lch * 8;
  const size_t bstr = (size_t)64 * ldb;
  const int woffB = lrow * 128 + ((lch ^ ((lrow >> 1) & 7)) << 4);
  const int woffA0 = (arow + 0) * 128 + ((lch ^ (((arow + 0) >> 1) & 7)) << 4);
  const int woffA1 = (arow + 1) * 128 + ((lch ^ (((arow + 1) >> 1) & 7)) << 4);
  const int woffA2 = (arow + 2) * 128 + ((lch ^ (((arow + 2) >> 1) & 7)) << 4);
  const int woffA3 = (arow + 3) * 128 + ((lch ^ (((arow + 3) >> 1) & 7)) << 4);
  uint4 ra0, ra1, ra2, ra3, rp0, rb0, rb1, rb2, rb3;
  float4 mu0, mu1;
  rp0 = make_uint4(0, 0, 0, 0);
  mu0 = mu1 = make_float4(0, 0, 0, 0);

#define H_LOAD(kt)                                                                     \
  {                                                                                    \
    const int k0_ = (kt) * 64;                                                         \
    ra0 = *(const uint4*)(pa0 + k0_); ra1 = *(const uint4*)(pa0 + lda + k0_);          \
    ra2 = *(const uint4*)(pa0 + 2 * lda + k0_); ra3 = *(const uint4*)(pa0 + 3 * lda + k0_); \
    if (AMODE == 1) rp0 = *(const uint4*)(pp0 + k0_);                                  \
    rb0 = *(const uint4*)(pb0 + k0_); rb1 = *(const uint4*)(pb0 + bstr + k0_);         \
    rb2 = *(const uint4*)(pb0 + 2 * bstr + k0_); rb3 = *(const uint4*)(pb0 + 3 * bstr + k0_); \
  }
#define H_XFORM(dst, a_, p_)                                                           \
  {                                                                                    \
    if (AMODE == 0) dst = a_;                                                          \
    else {                                                                             \
      float h_[8], q_[8]; unpack8(a_, h_); unpack8(p_, q_);                            \
      dst.x = pack2(h_[0] + mu0.x * (q_[0] - h_[0]), h_[1] + mu0.y * (q_[1] - h_[1])); \
      dst.y = pack2(h_[2] + mu0.z * (q_[2] - h_[2]), h_[3] + mu0.w * (q_[3] - h_[3])); \
      dst.z = pack2(h_[4] + mu1.x * (q_[4] - h_[4]), h_[5] + mu1.y * (q_[5] - h_[5])); \
      dst.w = pack2(h_[6] + mu1.z * (q_[6] - h_[6]), h_[7] + mu1.w * (q_[7] - h_[7])); \
    }                                                                                  \
  }
#define H_STORE(stage, kt)                                                             \
  {                                                                                    \
    char* sA_ = smem + (stage) * G2_STAGE_BYTES; char* sB_ = sA_ + 32768;              \
    uint4 v_;                                                                          \
    if (AMODE == 1) { mu0 = *(const float4*)(muL + (kt) * 64 + lch * 8); mu1 = *(const float4*)(muL + (kt) * 64 + lch * 8 + 4); } \
    H_XFORM(v_, ra0, rp0); *(uint4*)(sA_ + woffA0) = v_;                               \
    H_XFORM(v_, ra1, ra0); *(uint4*)(sA_ + woffA1) = v_;                               \
    H_XFORM(v_, ra2, ra1); *(uint4*)(sA_ + woffA2) = v_;                               \
    H_XFORM(v_, ra3, ra2); *(uint4*)(sA_ + woffA3) = v_;                               \
    *(uint4*)(sB_ + woffB) = rb0; *(uint4*)(sB_ + woffB + 64 * 128) = rb1;             \
    *(uint4*)(sB_ + woffB + 128 * 128) = rb2; *(uint4*)(sB_ + woffB + 192 * 128) = rb3; \
  }
  const float* muL = (const float*)(smem + 2 * G2_STAGE_BYTES);
  if (AMODE == 1) {
    if (tid < 256) *(float4*)(smem + 2 * G2_STAGE_BYTES + tid * 16) = *(const float4*)(mu + tid * 4);
    __syncthreads();
  }
  H_LOAD(0);
  H_STORE(0, 0);
  __syncthreads();
  const int rsw = (fr >> 1) & 7;
  for (int kt = 0; kt < nk; ++kt) {
    const int st = kt & 1;
    if (kt + 1 < nk) H_LOAD(kt + 1);
    __builtin_amdgcn_sched_barrier(0);
    {
      const char* sA = smem + st * G2_STAGE_BYTES;
      const char* sB = sA + 32768;
#pragma unroll
      for (int kk = 0; kk < 2; ++kk) {
        bf16x8 bfr[4];
        const int cho = ((kk * 4 + fq) ^ rsw) << 4;
#pragma unroll
        for (int j = 0; j < 4; ++j) bfr[j] = *(const bf16x8*)(sB + (wc * 64 + j * 16 + fr) * 128 + cho);
#pragma unroll
        for (int i = 0; i < 8; ++i) {
          const bf16x8 af = *(const bf16x8*)(sA + (wr * 128 + i * 16 + fr) * 128 + cho);
#pragma unroll
          for (int j = 0; j < 4; ++j) acc[i][j] = __builtin_amdgcn_mfma_f32_16x16x32_bf16(bfr[j], af, acc[i][j], 0, 0, 0);
        }
      }
    }
    if (kt + 1 < nk) H_STORE(st ^ 1, kt + 1);
    __syncthreads();
  }
#undef H_LOAD
#undef H_XFORM
#undef H_STORE
}

DEV void transpose_tile(const float* __restrict__ src, int N, int k0, int n0, const float* __restrict__ scale, u16* __restrict__ dst,
                        int dstride, int drow0, int dcol0, char* smem) {
  float* tile = (float*)smem;
  const int tid = threadIdx.x;
#pragma unroll
  for (int i = 0; i < 2; ++i) {
    int kl = (tid >> 4) + 32 * i, n4 = (tid & 15) * 4;
    float4 v = *(const float4*)(src + (size_t)(k0 + kl) * N + n0 + n4);
    float s = scale ? scale[k0 + kl] : 1.0f;
    tile[kl * 65 + n4 + 0] = v.x * s; tile[kl * 65 + n4 + 1] = v.y * s;
    tile[kl * 65 + n4 + 2] = v.z * s; tile[kl * 65 + n4 + 3] = v.w * s;
  }
  __syncthreads();
  {
    int nl = tid >> 3, k8 = (tid & 7) * 8;
    uint4 o;
    o.x = pack2(tile[(k8 + 0) * 65 + nl], tile[(k8 + 1) * 65 + nl]);
    o.y = pack2(tile[(k8 + 2) * 65 + nl], tile[(k8 + 3) * 65 + nl]);
    o.z = pack2(tile[(k8 + 4) * 65 + nl], tile[(k8 + 5) * 65 + nl]);
    o.w = pack2(tile[(k8 + 6) * 65 + nl], tile[(k8 + 7) * 65 + nl]);
    *(uint4*)(dst + (size_t)(drow0 + n0 + nl) * dstride + dcol0 + k0 + k8) = o;
  }
  __syncthreads();
}

DEV void phase_prep(const Params& p, char* smem) {
  const int tid = threadIdx.x;
  char* ws = p.ws;
  if (blockIdx.x < 96) {
    float* cL = (float*)smem;
    float* red = (float*)(smem + 98304);
    for (int e = tid; e < 24 * 256; e += NTHREADS) {
      int s = e >> 8, k4 = (e & 255) * 4;
      float4 v = s < 8 ? *(const float4*)(p.in[I_CP] + s * 1024 + k4) : *(const float4*)(p.in[I_CS] + (s - 8) * 1024 + k4);
      *(float4*)(cL + s * 1024 + k4) = v;
    }
    __syncthreads();
    for (int item = blockIdx.x; item < 96; item += gridDim.x) {
      const int l = item / 48, j0 = (item % 48) * 64;
      const float* W = (l == 0 ? p.in[I_AADAW] : p.in[I_BADAW]);
      const float* bias = (l == 0 ? p.in[I_AADAB] : p.in[I_BADAB]);
      const int col = tid & 63, kg = tid >> 6;
      float acc[24];
#pragma unroll
      for (int s = 0; s < 24; ++s) acc[s] = 0.f;
      for (int k = kg * 128; k < kg * 128 + 128; ++k) {
        float w = W[(size_t)k * 3072 + j0 + col];
#pragma unroll
        for (int s = 0; s < 24; ++s) acc[s] += cL[s * 1024 + k] * w;
      }
#pragma unroll
      for (int s = 0; s < 24; ++s) red[(kg * 24 + s) * 64 + col] = acc[s];
      __syncthreads();
      float* mod = (float*)(ws + WS_MOD);
      for (int e = tid; e < 24 * 64; e += NTHREADS) {
        int s = e >> 6, c = e & 63;
        float t = bias[j0 + c];
#pragma unroll
        for (int g = 0; g < 8; ++g) t += red[(g * 24 + s) * 64 + c];
        mod[(size_t)(l * 24 + s) * 3072 + j0 + c] = t;
      }
      __syncthreads();
    }
  }
  if (blockIdx.x == 0) for (int e = tid; e < 1024; e += NTHREADS) ((unsigned*)(ws + WS_CTR))[e] = 0u;
  if (blockIdx.x == gridDim.x - 1) {
    u16* SH = (u16*)(ws + WS_SH);
    for (int e = tid; e < 24 * 1024; e += NTHREADS) {
      int s = e >> 10, k = e & 1023;
      float v = s < 8 ? 0.f : p.in[I_SSH][(s - 8) * 1024 + k];
      SH[e] = (u16)(pack2(v, 0.f) & 0xffff);
    }
  }
  const int NT_TOTAL = 2048 + 512 + 1024 + 1024 + 512 + 32 + 32 + 64;
  for (int t = blockIdx.x; t < NT_TOTAL; t += gridDim.x) {
    const float* src; int K, N; u16* dst; int dstride, drow0 = 0, dcol0 = 0; const float* scale = nullptr; int tt = t;
    if (tt < 2048) { src = p.in[I_AWIN]; K = 1024; N = 8192; dst = (u16*)(ws + WS_WT_IN); dstride = 1024; }
    else if ((tt -= 2048) < 512) { src = p.in[I_AWOUT]; K = 2048; N = 1024; dst = (u16*)(ws + WS_WT_OUTA); dstride = 2048; }
    else if ((tt -= 512) < 1024) { src = p.in[I_KVW]; K = 1024; N = 4096; dst = (u16*)(ws + WS_WT_KV); dstride = 1024; }
    else if ((tt -= 1024) < 1024) { src = p.in[I_BWIN]; K = 1024; N = 4096; dst = (u16*)(ws + WS_WT_INB); dstride = 1024; }
    else if ((tt -= 1024) < 512) { src = p.in[I_BWOUT]; K = 2048; N = 1024; dst = (u16*)(ws + WS_WT_OUTB); dstride = 2048; }
    else if ((tt -= 512) < 32) { src = p.in[I_AW2]; K = 64; N = 2048; dst = (u16*)(ws + WS_W2T); dstride = 64; }
    else if ((tt -= 32) < 32) { src = p.in[I_AA2]; K = 64; N = 2048; dst = (u16*)(ws + WS_A2T); dstride = 64; }
    else {
      tt -= 32;
      int job = tt >> 4; tt &= 15;
      K = 1024; N = 64; dst = (u16*)(ws + WS_L1T); dstride = 2048;
      src = (job < 2) ? p.in[I_AW1] : p.in[I_AA1];
      drow0 = (job < 2) ? 0 : 64;
      if (job & 1) { dcol0 = 1024; scale = (job < 2) ? p.in[I_AMUW] : p.in[I_AMUA]; }
    }
    const int ntn = N / 64;
    const int kt = tt / ntn, nt = tt % ntn;
    transpose_tile(src, N, kt * 64, nt * 64, scale, dst, dstride, drow0, dcol0, smem);
  }
}

DEV void phase_norm0(const Params& p) {
  const int lane = threadIdx.x & 63, wid = threadIdx.x >> 6;
  const float* mod = (const float*)(p.ws + WS_MOD);
  u16* H0 = (u16*)(p.ws + WS_H0);
  const float* g = p.in[I_ANG];
  for (int t = blockIdx.x * 8 + wid; t < NTOK; t += gridDim.x * 8) {
    const float* x = t < TP ? p.in[I_XP] + (size_t)t * 1024 : p.in[I_XS] + (size_t)(t - TP) * 1024;
    const int s = seq_of(t);
    const float* md = mod + (size_t)s * 3072;
    float4 v[4];
    float ss = 0.f;
#pragma unroll
    for (int i = 0; i < 4; ++i) {
      v[i] = *(const float4*)(x + lane * 4 + 256 * i);
      ss += v[i].x * v[i].x + v[i].y * v[i].y + v[i].z * v[i].z + v[i].w * v[i].w;
    }
    ss = wave_sum(ss);
    const float rstd = rsqrtf(ss * (1.0f / 1024.0f) + 1e-6f);
    bool last = t < TP ? ((t & 4095) == 4095) : (((t - TP) & 31) == 31);
    float* so = t < TP ? p.out + OFF_SH_P + (t >> 12) * 1024 : p.out + OFF_SH_S + ((t - TP) >> 5) * 1024;
#pragma unroll
    for (int i = 0; i < 4; ++i) {
      const int c = lane * 4 + 256 * i;
      float4 gg = *(const float4*)(g + c), sh = *(const float4*)(md + c), sc = *(const float4*)(md + 1024 + c);
      float4 h;
      h.x = v[i].x * rstd * gg.x * (1.f + sc.x) + sh.x;
      h.y = v[i].y * rstd * gg.y * (1.f + sc.y) + sh.y;
      h.z = v[i].z * rstd * gg.z * (1.f + sc.z) + sh.z;
      h.w = v[i].w * rstd * gg.w * (1.f + sc.w) + sh.w;
      uint2 o; o.x = pack2(h.x, h.y); o.y = pack2(h.z, h.w);
      *(uint2*)(H0 + (size_t)t * 1024 + c) = o;
      if (last) *(float4*)(so + c) = h;
    }
  }
}

DEV void phase_proj0(const Params& p, char* smem) {
  const int tid = threadIdx.x, lane = tid & 63, wid = tid >> 6, fr = lane & 15, fq = lane >> 4;
  char* ws = p.ws;
  const u16* H0 = (const u16*)(ws + WS_H0);
  const u16* SH = (const u16*)(ws + WS_SH);
  u16* T = (u16*)(ws + WS_T);
  unsigned* ctr = sched_ctr(p, 0);
  const int xcd = blockIdx.x & 7;
  int nxt;
  for (int li = sched_first(ctr, smem); li < 17 + 520; li = sched_commit(nxt, smem)) {
    nxt = sched_prefetch(ctr);
    if (li < 17) {
      const int lmt = xcd + 8 * li;
      if (lmt >= 130) continue;
      const int m0 = lmt * 256;
      {
        const int wr = wid >> 1, wc = wid & 1;
        f32x4 acc[4][4];
        gemm_main<2>(acc, H0, 1024, (const u16*)(ws + WS_L1T), 2048, 32, m0, 0, nullptr, SH, smem);
#pragma unroll
        for (int i = 0; i < 4; ++i)
#pragma unroll
          for (int j = 0; j < 4; ++j) {
            const int m = m0 + wr * 64 + i * 16 + fr, n = wc * 64 + j * 16 + fq * 4;
            f32x4 v = acc[i][j];
            if (wc == 0) { v[0] = tanhf(v[0]); v[1] = tanhf(v[1]); v[2] = tanhf(v[2]); v[3] = tanhf(v[3]); }
            uint2 o; o.x = pack2(v[0], v[1]); o.y = pack2(v[2], v[3]);
            *(uint2*)(T + (size_t)m * 128 + n) = o;
          }
      }
      __threadfence_block();
      __syncthreads();
      {
        const int wr = wid >> 1, wc = wid & 1;
        f32x4 acc[4][4];
        for (int nt = 0; nt < 32; ++nt) {
          const int which = nt >> 4, n0 = (nt & 15) * 128;
          gemm_main<0>(acc, T + which * 64, 128, (const u16*)(ws + (which ? WS_A2T : WS_W2T)), 64, 1, m0, n0, nullptr, nullptr, smem);
          const float* bias = which ? p.in[I_AA0] : p.in[I_AW0];
          u16* dst = (u16*)(ws + (which ? 5ull : 4ull) * SLOT);
          const float sc = which ? 1.0f : -0.60653066f;
#pragma unroll
          for (int i = 0; i < 4; ++i)
#pragma unroll
            for (int j = 0; j < 4; ++j) {
              const int m = m0 + wr * 64 + i * 16 + fr, n = n0 + wc * 64 + j * 16 + fq * 4;
              float4 b4 = *(const float4*)(bias + n);
              f32x4 v = acc[i][j];
              float s0 = sc * sigmoidf_(v[0] + b4.x), s1 = sc * sigmoidf_(v[1] + b4.y), s2 = sc * sigmoidf_(v[2] + b4.z), s3 = sc * sigmoidf_(v[3] + b4.w);
              uint2 o; o.x = pack2(s0, s1); o.y = pack2(s2, s3);
              *(uint2*)(dst + (size_t)m * 2048 + n) = o;
            }
        }
      }
    } else {
      const int wr = wid >> 2, wc = wid & 3;
      f32x4 acc[8][4];
      const int q = li - 17;
      const int mt = q >> 2, nt = 4 * xcd + (q & 3);
      const int part = nt >> 3;
      const int m0 = mt * 256, n0 = nt * 256;
      gemm_main256<1>(acc, H0, 1024, (const u16*)(ws + WS_WT_IN), 1024, 16, m0, n0, p.in[I_AMUIN] + part * 1024, SH, smem);
      u16* dst = (u16*)(ws + (size_t)part * SLOT);
      const int nb = n0 - part * 2048;
#pragma unroll
      for (int i = 0; i < 8; ++i)
#pragma unroll
        for (int j = 0; j < 4; ++j) {
          const int m = m0 + wr * 128 + i * 16 + fr, n = nb + wc * 64 + j * 16 + fq * 4;
          f32x4 v = acc[i][j];
          uint2 o; o.x = pack2(v[0], v[1]); o.y = pack2(v[2], v[3]);
          *(uint2*)(dst + (size_t)m * 2048 + n) = o;
        }
    }
  }
}

DEV void phase_scan(const Params& p, char* smem) {
  const int tid = threadIdx.x, lane = tid & 63, wid = tid >> 6;
  float* Lkk = (float*)smem;
  float* Lw = Lkk + 4096;
  float* Lb = Lw + 4096;
  float* Lk = Lb + 4096;
  float* Lwr = Lk + 4096;
  float* Lv = Lwr + 4096;
  float* LY = Lv + 4096;
  float* Lbon = LY + 4096;
  float* Lsc = Lbon + 64;
  char* ws = p.ws;
  const u16* gR = (const u16*)(ws + 0 * SLOT);
  const u16* gK = (const u16*)(ws + 1 * SLOT);
  const u16* gV = (const u16*)(ws + 2 * SLOT);
  const u16* gZ = (const u16*)(ws + 3 * SLOT);
  const u16* gW = (const u16*)(ws + 4 * SLOT);
  const u16* gA = (const u16*)(ws + 5 * SLOT);
  u16* YG = (u16*)(ws + 6 * SLOT);
  const int tt = tid >> 3, c8 = (tid & 7) * 8;
  const int rp = wid * 4 + (lane >> 4), kc = lane & 15;

  for (int item = blockIdx.x; item < 768; item += gridDim.x) {
    int h, tok0, nsteps; const float* sinit; float* sout;
    if (item < 256) { h = item & 31; tok0 = (item >> 5) * 4096; nsteps = 4096; sinit = nullptr; sout = p.out + OFF_WKV_P + (size_t)item * 4096; }
    else { int it = item - 256; h = it & 31; tok0 = TP + (it >> 5) * 32; nsteps = 32; sinit = p.in[I_SWKV] + (size_t)it * 4096; sout = p.out + OFF_WKV_S + (size_t)it * 4096; }
    const int nch = (nsteps + 63) >> 6;
    const int col0 = h * 64 + c8;
    float ckk[8], cka[8], crk[8], clg[8], clb[8];
    {
      float4 t0, t1;
      t0 = *(const float4*)(p.in[I_AKK] + col0); t1 = *(const float4*)(p.in[I_AKK] + col0 + 4);
      ckk[0] = t0.x; ckk[1] = t0.y; ckk[2] = t0.z; ckk[3] = t0.w; ckk[4] = t1.x; ckk[5] = t1.y; ckk[6] = t1.z; ckk[7] = t1.w;
      t0 = *(const float4*)(p.in[I_AKA] + col0); t1 = *(const float4*)(p.in[I_AKA] + col0 + 4);
      cka[0] = t0.x; cka[1] = t0.y; cka[2] = t0.z; cka[3] = t0.w; cka[4] = t1.x; cka[5] = t1.y; cka[6] = t1.z; cka[7] = t1.w;
      t0 = *(const float4*)(p.in[I_ARK] + col0); t1 = *(const float4*)(p.in[I_ARK] + col0 + 4);
      crk[0] = t0.x; crk[1] = t0.y; crk[2] = t0.z; crk[3] = t0.w; crk[4] = t1.x; crk[5] = t1.y; crk[6] = t1.z; crk[7] = t1.w;
      t0 = *(const float4*)(p.in[I_ALNG] + col0); t1 = *(const float4*)(p.in[I_ALNG] + col0 + 4);
      clg[0] = t0.x; clg[1] = t0.y; clg[2] = t0.z; clg[3] = t0.w; clg[4] = t1.x; clg[5] = t1.y; clg[6] = t1.z; clg[7] = t1.w;
      t0 = *(const float4*)(p.in[I_ALNB] + col0); t1 = *(const float4*)(p.in[I_ALNB] + col0 + 4);
      clb[0] = t0.x; clb[1] = t0.y; clb[2] = t0.z; clb[3] = t0.w; clb[4] = t1.x; clb[5] = t1.y; clb[6] = t1.z; clb[7] = t1.w;
    }
    float s0[4], s1[4];
    if (sinit) {
      float4 a = *(const float4*)(sinit + (2 * rp) * 64 + kc * 4), b = *(const float4*)(sinit + (2 * rp + 1) * 64 + kc * 4);
      s0[0] = a.x; s0[1] = a.y; s0[2] = a.z; s0[3] = a.w; s1[0] = b.x; s1[1] = b.y; s1[2] = b.z; s1[3] = b.w;
    } else {
#pragma unroll
      for (int j = 0; j < 4; ++j) { s0[j] = 0.f; s1[j] = 0.f; }
    }
    uint4 cr, ck, cv, cz, cw, ca;
#define SCAN_LOAD(c)                                                                   \
    {                                                                                  \
      const int tl_ = (c) * 64 + tt;                                                   \
      if (tl_ < nsteps) {                                                              \
        const size_t o_ = (size_t)(tok0 + tl_) * 2048 + col0;                          \
        cr = *(const uint4*)(gR + o_); ck = *(const uint4*)(gK + o_); cv = *(const uint4*)(gV + o_); \
        cz = *(const uint4*)(gZ + o_); cw = *(const uint4*)(gW + o_); ca = *(const uint4*)(gA + o_); \
      } else { cr = ck = cv = cz = cw = ca = make_uint4(0, 0, 0, 0); }                 \
    }
    SCAN_LOAD(0);
    for (int c = 0; c < nch; ++c) {
      uint4 zc = cz;
      {
        float r[8], k[8], v[8], lw[8], a[8];
        unpack8(cr, r); unpack8(ck, k); unpack8(cv, v); unpack8(cw, lw); unpack8(ca, a);
        float kkv[8], kp[8], w[8], bon = 0.f, ss = 0.f, kr = 0.f;
#pragma unroll
        for (int j = 0; j < 8; ++j) {
          kkv[j] = k[j] * ckk[j]; ss += kkv[j] * kkv[j];
          kp[j] = k[j] * (1.f + (a[j] - 1.f) * cka[j]);
          bon += r[j] * kp[j] * crk[j];
          kr += r[j] * kp[j];
          w[j] = __expf(lw[j]);
        }
        ss = red8(ss); bon = red8(bon); kr = red8(kr);
        const float inv = rsqrtf(ss + 1e-12f);
        float bb[8], br = 0.f;
#pragma unroll
        for (int j = 0; j < 8; ++j) { kkv[j] *= inv; bb[j] = kkv[j] * a[j]; br += bb[j] * r[j]; }
        br = red8(br);
        float* d;
        d = Lkk + tt * 64 + c8;
        *(float4*)d = make_float4(kkv[0], kkv[1], kkv[2], kkv[3]); *(float4*)(d + 4) = make_float4(kkv[4], kkv[5], kkv[6], kkv[7]);
        d = Lb + tt * 64 + c8;
        *(float4*)d = make_float4(bb[0], bb[1], bb[2], bb[3]); *(float4*)(d + 4) = make_float4(bb[4], bb[5], bb[6], bb[7]);
        d = Lw + tt * 64 + c8;
        *(float4*)d = make_float4(w[0], w[1], w[2], w[3]); *(float4*)(d + 4) = make_float4(w[4], w[5], w[6], w[7]);
        d = Lk + tt * 64 + c8;
        *(float4*)d = make_float4(kp[0], kp[1], kp[2], kp[3]); *(float4*)(d + 4) = make_float4(kp[4], kp[5], kp[6], kp[7]);
        d = Lwr + tt * 64 + c8;
        *(float4*)d = make_float4(w[0] * r[0], w[1] * r[1], w[2] * r[2], w[3] * r[3]);
        *(float4*)(d + 4) = make_float4(w[4] * r[4], w[5] * r[5], w[6] * r[6], w[7] * r[7]);
        d = Lv + tt * 64 + c8;
        *(float4*)d = make_float4(v[0], v[1], v[2], v[3]); *(float4*)(d + 4) = make_float4(v[4], v[5], v[6], v[7]);
        if ((tid & 7) == 0) { Lbon[tt] = bon; *(float2*)(Lsc + tt * 2) = make_float2(br, kr); }
      }
      __syncthreads();
      if (c + 1 < nch) SCAN_LOAD(c + 1);
      {
        const int nT = min(64, nsteps - c * 64);
        const float* pk = Lkk + kc * 4; const float* pw = Lw + kc * 4; const float* pb = Lb + kc * 4;
        const float* pkp = Lk + kc * 4; const float* pwr = Lwr + kc * 4; const float* pv = Lv + rp * 2;
        float* py = LY + rp * 2;
#define SCAN_LD(S, o)                                                                  \
        S##kk = *(const float4*)(pk + (o)); S##w = *(const float4*)(pw + (o)); S##b = *(const float4*)(pb + (o)); \
        S##k = *(const float4*)(pkp + (o)); S##wr = *(const float4*)(pwr + (o)); S##v = *(const float2*)(pv + (o)); \
        S##sc = *(const float2*)(Lsc + ((o) >> 5));
#define SCAN_STEP(S, o)                                                                \
        {                                                                              \
          float d0 = s0[0] * S##kk.x + s0[1] * S##kk.y + s0[2] * S##kk.z + s0[3] * S##kk.w;  \
          float d1 = s1[0] * S##kk.x + s1[1] * S##kk.y + s1[2] * S##kk.z + s1[3] * S##kk.w;  \
          float e0 = s0[0] * S##wr.x + s0[1] * S##wr.y + s0[2] * S##wr.z + s0[3] * S##wr.w;  \
          float e1 = s1[0] * S##wr.x + s1[1] * S##wr.y + s1[2] * S##wr.z + s1[3] * S##wr.w;  \
          d0 += dppf<0xB1>(d0); d1 += dppf<0xB1>(d1); e0 += dppf<0xB1>(e0); e1 += dppf<0xB1>(e1);       \
          d0 += dppf<0x4E>(d0); d1 += dppf<0x4E>(d1); e0 += dppf<0x4E>(e0); e1 += dppf<0x4E>(e1);       \
          d0 += dppf<0x141>(d0); d1 += dppf<0x141>(d1); e0 += dppf<0x141>(e0); e1 += dppf<0x141>(e1);   \
          d0 += dppf<0x140>(d0); d1 += dppf<0x140>(d1); e0 += dppf<0x140>(e0); e1 += dppf<0x140>(e1);   \
          s0[0] = s0[0] * S##w.x + (S##v.x * S##k.x - d0 * S##b.x);                    \
          s0[1] = s0[1] * S##w.y + (S##v.x * S##k.y - d0 * S##b.y);                    \
          s0[2] = s0[2] * S##w.z + (S##v.x * S##k.z - d0 * S##b.z);                    \
          s0[3] = s0[3] * S##w.w + (S##v.x * S##k.w - d0 * S##b.w);                    \
          s1[0] = s1[0] * S##w.x + (S##v.y * S##k.x - d1 * S##b.x);                    \
          s1[1] = s1[1] * S##w.y + (S##v.y * S##k.y - d1 * S##b.y);                    \
          s1[2] = s1[2] * S##w.z + (S##v.y * S##k.z - d1 * S##b.z);                    \
          s1[3] = s1[3] * S##w.w + (S##v.y * S##k.w - d1 * S##b.w);                    \
          if (kc == 0) *(float2*)(py + (o)) = make_float2(e0 - d0 * S##sc.x + S##v.x * S##sc.y, e1 - d1 * S##sc.x + S##v.y * S##sc.y); \
        }
        float4 Akk, Aw, Ab, Ak, Awr, Bkk, Bw, Bb, Bk, Bwr; float2 Av, Asc, Bv, Bsc;
        SCAN_LD(A, 0);
        for (int t = 0; t < nT; t += 2) {
          SCAN_LD(B, (t + 1) * 64);
          SCAN_STEP(A, t * 64);
          if (t + 2 < nT) { SCAN_LD(A, (t + 2) * 64); }
          SCAN_STEP(B, (t + 1) * 64);
        }
#undef SCAN_LD
#undef SCAN_STEP
      }
      __syncthreads();
      {
        const int tl = c * 64 + tt;
        if (tl < nsteps) {
          float y[8], z[8];
          float4 a = *(const float4*)(LY + tt * 64 + c8), b = *(const float4*)(LY + tt * 64 + c8 + 4);
          y[0] = a.x; y[1] = a.y; y[2] = a.z; y[3] = a.w; y[4] = b.x; y[5] = b.y; y[6] = b.z; y[7] = b.w;
          float sm = y[0] + y[1] + y[2] + y[3] + y[4] + y[5] + y[6] + y[7];
          sm = red8(sm);
          const float mean = sm * (1.f / 64.f);
          float vs = 0.f;
#pragma unroll
          for (int j = 0; j < 8; ++j) { y[j] -= mean; vs += y[j] * y[j]; }
          vs = red8(vs);
          const float rstd = rsqrtf(vs * (1.f / 64.f) + 64e-5f);
          const float bon = Lbon[tt];
          float4 va = *(const float4*)(Lv + tt * 64 + c8), vb = *(const float4*)(Lv + tt * 64 + c8 + 4);
          float vv[8] = {va.x, va.y, va.z, va.w, vb.x, vb.y, vb.z, vb.w};
          unpack8(zc, z);
          float o[8];
#pragma unroll
          for (int j = 0; j < 8; ++j) {
            float t = y[j] * rstd * clg[j] + clb[j] + bon * vv[j];
            o[j] = t * z[j] * sigmoidf_(z[j]);
          }
          uint4 ov; ov.x = pack2(o[0], o[1]); ov.y = pack2(o[2], o[3]); ov.z = pack2(o[4], o[5]); ov.w = pack2(o[6], o[7]);
          *(uint4*)(YG + (size_t)(tok0 + tl) * 2048 + col0) = ov;
        }
      }
      __syncthreads();
    }
#undef SCAN_LOAD
    *(float4*)(sout + (2 * rp) * 64 + kc * 4) = make_float4(s0[0], s0[1], s0[2], s0[3]);
    *(float4*)(sout + (2 * rp + 1) * 64 + kc * 4) = make_float4(s1[0], s1[1], s1[2], s1[3]);
  }
}

template <int LAYER>
DEV void phase_outproj(const Params& p, char* smem) {
  const int tid = threadIdx.x, lane = tid & 63, wid = tid >> 6, wr = wid >> 1, wc = wid & 1, fr = lane & 15, fq = lane >> 4;
  char* ws = p.ws;
  const u16* A = (const u16*)(ws + 6 * SLOT);
  const u16* Bt = (const u16*)(ws + (LAYER == 0 ? WS_WT_OUTA : WS_WT_OUTB));
  const float* mod = (const float*)(ws + WS_MOD) + (size_t)LAYER * 24 * 3072;
  float* xmid = (float*)(ws + 0 * SLOT);
  f32x4 acc[4][4];
  unsigned* ctr = sched_ctr(p, LAYER == 0 ? 1 : 3);
  int nxt;
  for (int li = sched_first(ctr, smem); li < 130; li = sched_commit(nxt, smem)) {
    nxt = sched_prefetch(ctr);
    const int item = 130 * (blockIdx.x & 7) + li;
    const int m0 = (item >> 3) * 256, n0 = (item & 7) * 128;
    gemm_main<0>(acc, A, 2048, Bt, 2048, 32, m0, n0, nullptr, nullptr, smem);
#pragma unroll
    for (int i = 0; i < 4; ++i) {
      const int m = m0 + wr * 64 + i * 16 + fr;
      const float* gate = mod + (size_t)seq_of(m) * 3072 + 2048;
#pragma unroll
      for (int j = 0; j < 4; ++j) {
        const int n = n0 + wc * 64 + j * 16 + fq * 4;
        float4 g4 = *(const float4*)(gate + n);
        f32x4 v = acc[i][j];
        if (LAYER == 0) {
          const float* xr = m < TP ? p.in[I_XP] + (size_t)m * 1024 : p.in[I_XS] + (size_t)(m - TP) * 1024;
          float4 x4 = *(const float4*)(xr + n);
          *(float4*)(xmid + (size_t)m * 1024 + n) = make_float4(x4.x + g4.x * v[0], x4.y + g4.y * v[1], x4.z + g4.z * v[2], x4.w + g4.w * v[3]);
        } else {
          float4 x4 = *(const float4*)(xmid + (size_t)m * 1024 + n);
          float* yo = m < TP ? p.out + OFF_Y_P + (size_t)m * 1024 : p.out + OFF_Y_S + (size_t)(m - TP) * 1024;
          *(float4*)(yo + n) = make_float4(x4.x + g4.x * v[0], x4.y + g4.y * v[1], x4.z + g4.z * v[2], x4.w + g4.w * v[3]);
        }
      }
    }
  }
}

DEV void phase_norm1(const Params& p) {
  const int lane = threadIdx.x & 63, wid = threadIdx.x >> 6;
  const float* mod = (const float*)(p.ws + WS_MOD) + (size_t)24 * 3072;
  const float* xmid = (const float*)(p.ws + 0 * SLOT);
  u16* AKV = (u16*)(p.ws + 1 * SLOT);
  u16* AQ = AKV + (size_t)NTOK * 1024;
  const float* gkv = p.in[I_KVNG];
  const float* gb = p.in[I_BNG];
  for (int t = blockIdx.x * 8 + wid; t < NTOK; t += gridDim.x * 8) {
    const float* x = xmid + (size_t)t * 1024;
    const float* md = mod + (size_t)seq_of(t) * 3072;
    float4 v[4];
    float ss = 0.f;
#pragma unroll
    for (int i = 0; i < 4; ++i) {
      v[i] = *(const float4*)(x + lane * 4 + 256 * i);
      ss += v[i].x * v[i].x + v[i].y * v[i].y + v[i].z * v[i].z + v[i].w * v[i].w;
    }
    ss = wave_sum(ss);
    const float rstd = rsqrtf(ss * (1.0f / 1024.0f) + 1e-6f);
#pragma unroll
    for (int i = 0; i < 4; ++i) {
      const int c = lane * 4 + 256 * i;
      float4 g1 = *(const float4*)(gkv + c), g2 = *(const float4*)(gb + c), sh = *(const float4*)(md + c), sc = *(const float4*)(md + 1024 + c);
      float xn0 = v[i].x * rstd, xn1 = v[i].y * rstd, xn2 = v[i].z * rstd, xn3 = v[i].w * rstd;
      uint2 o;
      o.x = pack2(xn0 * g1.x, xn1 * g1.y); o.y = pack2(xn2 * g1.z, xn3 * g1.w);
      *(uint2*)(AKV + (size_t)t * 1024 + c) = o;
      o.x = pack2(xn0 * g2.x * (1.f + sc.x) + sh.x, xn1 * g2.y * (1.f + sc.y) + sh.y);
      o.y = pack2(xn2 * g2.z * (1.f + sc.z) + sh.z, xn3 * g2.w * (1.f + sc.w) + sh.w);
      *(uint2*)(AQ + (size_t)t * 1024 + c) = o;
    }
  }
}

#define QSCALE (0.08838834764831845f * 1.4426950408889634f)
DEV void phase_proj1(const Params& p, char* smem) {
  const int tid = threadIdx.x, lane = tid & 63, wid = tid >> 6, wr = wid >> 2, wc = wid & 3, fr = lane & 15, fq = lane >> 4;
  char* ws = p.ws;
  const u16* AKV = (const u16*)(ws + 1 * SLOT);
  const u16* AQ = AKV + (size_t)NTOK * 1024;
  u16* KB = (u16*)(ws + 2 * SLOT);
  u16* VB = (u16*)(ws + 3 * SLOT);
  u16* QB = (u16*)(ws + 4 * SLOT);
  u16* ZS = (u16*)(ws + 5 * SLOT);
  f32x4 acc[8][4];
  float* red = (float*)smem;
  unsigned* bar = sched_ctr(p, 2);
  const int gsz = gridDim.x >> 3, gj = blockIdx.x >> 3;
  for (int r = 0; r * gsz < 520; ++r) {
    group_sync(bar, (unsigned)((r + 1) * gsz));
    const int li = r * gsz + gj;
    if (li >= 520) continue;
    const int mt = li >> 2, t = 4 * (blockIdx.x & 7) + (li & 3);
    const int isq = t >> 4, nt = t & 15;
    const int m0 = mt * 256, n0 = nt * 256;
    gemm_main256<0>(acc, isq ? AQ : AKV, 1024, (const u16*)(ws + (isq ? WS_WT_INB : WS_WT_KV)), 1024, 16, m0, n0, nullptr, nullptr, smem);
    if (nt < 8) {
#pragma unroll
      for (int i = 0; i < 8; ++i) {
        float ss = 0.f;
#pragma unroll
        for (int j = 0; j < 4; ++j) ss += acc[i][j][0] * acc[i][j][0] + acc[i][j][1] * acc[i][j][1] + acc[i][j][2] * acc[i][j][2] + acc[i][j][3] * acc[i][j][3];
        red[(wr * 128 + i * 16 + fr) * 16 + wc * 4 + fq] = ss;
      }
      __syncthreads();
      const float* gain = isq ? p.in[I_BQG] : p.in[I_KGAIN];
#pragma unroll
      for (int i = 0; i < 8; ++i) {
        const int row = wr * 128 + i * 16 + fr, m = m0 + row;
        float4 ra = *(const float4*)(red + row * 16 + (wc >> 1) * 8), rb = *(const float4*)(red + row * 16 + (wc >> 1) * 8 + 4);
        float tot = ra.x + ra.y + ra.z + ra.w + rb.x + rb.y + rb.z + rb.w;
        float rs = rsqrtf(tot * (1.f / 128.f) + 1e-6f);
        if (isq) rs *= QSCALE;
#pragma unroll
        for (int j = 0; j < 4; ++j) {
          const int d = (wc & 1) * 64 + j * 16 + fq * 4, n = n0 + wc * 64 + j * 16 + fq * 4;
          float4 g4 = *(const float4*)(gain + d);
          f32x4 v = acc[i][j];
          float o0 = v[0] * rs * g4.x, o1 = v[1] * rs * g4.y, o2 = v[2] * rs * g4.z, o3 = v[3] * rs * g4.w;
          uint2 o; o.x = pack2(o0, o1); o.y = pack2(o2, o3);
          if (isq) {
            *(uint2*)(QB + (size_t)m * 2048 + n) = o;
          } else {
            *(uint2*)(KB + (size_t)m * 2048 + n) = o;
            float* ko = m < TP ? p.out + OFF_K_P + (size_t)m * 2048 : p.out + OFF_K_S + (size_t)(m - TP) * 2048;
            *(float4*)(ko + n) = make_float4(o0, o1, o2, o3);
          }
        }
      }
      __syncthreads();
    } else {
#pragma unroll
      for (int i = 0; i < 8; ++i) {
        const int m = m0 + wr * 128 + i * 16 + fr;
#pragma unroll
        for (int j = 0; j < 4; ++j) {
          const int n = n0 - 2048 + wc * 64 + j * 16 + fq * 4;
          f32x4 v = acc[i][j];
          if (isq) {
            float o0 = v[0] * sigmoidf_(v[0]), o1 = v[1] * sigmoidf_(v[1]), o2 = v[2] * sigmoidf_(v[2]), o3 = v[3] * sigmoidf_(v[3]);
            uint2 o; o.x = pack2(o0, o1); o.y = pack2(o2, o3);
            *(uint2*)(ZS + (size_t)m * 2048 + n) = o;
          } else {
            uint2 o; o.x = pack2(v[0], v[1]); o.y = pack2(v[2], v[3]);
            *(uint2*)(VB + (size_t)m * 2048 + n) = o;
            float* vo = m < TP ? p.out + OFF_V_P + (size_t)m * 2048 : p.out + OFF_V_S + (size_t)(m - TP) * 2048;
            *(float4*)(vo + n) = make_float4(v[0], v[1], v[2], v[3]);
          }
        }
      }
    }
  }
}

DEV unsigned off_b(unsigned row, unsigned ch) { return 256u * row + 16u * (ch ^ (((row & 3) << 2) | ((row >> 2) & 3))); }

DEV void phase_attn(const Params& p, char* smem) {
  const int tid = threadIdx.x, lane = tid & 63, w = tid >> 6, fr = lane & 15, fq = lane >> 4;
  char* ws = p.ws;
  const u16* KB = (const u16*)(ws + 2 * SLOT);
  const u16* VB = (const u16*)(ws + 3 * SLOT);
  const u16* QB = (const u16*)(ws + 4 * SLOT);
  const u16* ZS = (const u16*)(ws + 5 * SLOT);
  u16* OG = (u16*)(ws + 6 * SLOT);
  const int lrow = tid >> 4, lch = tid & 15;
  const unsigned lw0 = off_b(lrow, lch), lw1 = off_b(lrow + 32, lch);
  const int tq = (lane & 15) >> 2, tp = lane & 3;

  for (int item = blockIdx.x; item < 4096 + 256; item += gridDim.x) {
    int b, h, nq, qpos0, tokq0, ntiles, nkeys, tokk0; bool sample;
    if (item < 4096) {
      const int qblk = 31 - (item >> 7), bh = item & 127;
      b = bh >> 4; h = bh & 15; nq = 128; qpos0 = qblk * 128; tokq0 = b * 4096 + qpos0; ntiles = 2 * qblk + 2; nkeys = qpos0 + 128; tokk0 = b * 4096; sample = false;
    } else {
      const int bh = item - 4096;
      b = bh >> 4; h = bh & 15; nq = 32; qpos0 = 1024; tokq0 = TP + b * 32; ntiles = 17; nkeys = 1056; tokk0 = TP + b * 32 - 1024; sample = true;
    }
    const bool wactive = (w * 16) < nq;
    int* dflag = (int*)(smem + 65536);
    __syncthreads();
    if (lane == 0) dflag[w] = wactive ? 0 : 1;
    bool wdone = !wactive;
    const int qp = qpos0 + w * 16 + fr;
    const int qwmax = qpos0 + w * 16 + 15;
    bf16x8 qf[4];
#pragma unroll
    for (int ks = 0; ks < 4; ++ks) {
      if (wactive) qf[ks] = *(const bf16x8*)(QB + (size_t)(tokq0 + w * 16 + fr) * 2048 + h * 128 + ks * 32 + fq * 8);
      else qf[ks] = (bf16x8){0, 0, 0, 0, 0, 0, 0, 0};
    }
    f32x4 O[8];
#pragma unroll
    for (int dt = 0; dt < 8; ++dt) O[dt] = (f32x4){0, 0, 0, 0};
    float carry = 0.f;

    uint4 lk0, lk1, lv0, lv1;
#define ATT_LOAD(kb)                                                                                  \
    {                                                                                                 \
      const int kx0_ = (kb) * 64 + lrow, kx1_ = kx0_ + 32;                                            \
      if (sample && (kb) < 16) {                                                                      \
        const float* ck_ = p.in[I_CK] + ((size_t)(b * 1024 + kx0_) * 16 + h) * 128 + lch * 8;         \
        const float* cv_ = p.in[I_CV] + ((size_t)(b * 1024 + kx0_) * 16 + h) * 128 + lch * 8;         \
        float4 a_ = *(const float4*)ck_, b_ = *(const float4*)(ck_ + 4);                              \
        float4 c_ = *(const float4*)(ck_ + 32 * 2048), d_ = *(const float4*)(ck_ + 32 * 2048 + 4);    \
        lk0 = make_uint4(pack2(a_.x, a_.y), pack2(a_.z, a_.w), pack2(b_.x, b_.y), pack2(b_.z, b_.w)); \
        lk1 = make_uint4(pack2(c_.x, c_.y), pack2(c_.z, c_.w), pack2(d_.x, d_.y), pack2(d_.z, d_.w)); \
        a_ = *(const float4*)cv_; b_ = *(const float4*)(cv_ + 4);                                     \
        c_ = *(const float4*)(cv_ + 32 * 2048); d_ = *(const float4*)(cv_ + 32 * 2048 + 4);           \
        lv0 = make_uint4(pack2(a_.x, a_.y), pack2(a_.z, a_.w), pack2(b_.x, b_.y), pack2(b_.z, b_.w)); \
        lv1 = make_uint4(pack2(c_.x, c_.y), pack2(c_.z, c_.w), pack2(d_.x, d_.y), pack2(d_.z, d_.w)); \
      } else {                                                                                        \
        const size_t o0_ = (size_t)(tokk0 + kx0_) * 2048 + h * 128 + lch * 8;                         \
        const size_t o1_ = o0_ + (size_t)32 * 2048;                                                   \
        if (kx0_ < nkeys) { lk0 = *(const uint4*)(KB + o0_); lv0 = *(const uint4*)(VB + o0_); }       \
        else { lk0 = make_uint4(0, 0, 0, 0); lv0 = lk0; }                                             \
        if (kx1_ < nkeys) { lk1 = *(const uint4*)(KB + o1_); lv1 = *(const uint4*)(VB + o1_); }       \
        else { lk1 = make_uint4(0, 0, 0, 0); lv1 = lk1; }                                             \
      }                                                                                               \
    }
#define ATT_STORE(st)                                                                                 \
    {                                                                                                 \
      char* sK_ = smem + (st) * 32768; char* sV_ = sK_ + 16384;                                       \
      *(uint4*)(sK_ + lw0) = lk0; *(uint4*)(sK_ + lw1) = lk1;                                         \
      *(uint4*)(sV_ + lw0) = lv0; *(uint4*)(sV_ + lw1) = lv1;                                         \
    }
    ATT_LOAD(ntiles - 1);
    ATT_STORE(0);
    __syncthreads();
    for (int it = 0; it < ntiles; ++it) {
      const int kb = ntiles - 1 - it, st = it & 1;
      if (it + 1 < ntiles) ATT_LOAD(kb - 1);
      if (!wdone && kb * 64 < qwmax) {
        const char* sK = smem + st * 32768;
        const char* sV = sK + 16384;
        f32x4 S[4];
#pragma unroll
        for (int mt = 0; mt < 4; ++mt) S[mt] = (f32x4){0, 0, 0, 0};
#pragma unroll
        for (int ks = 0; ks < 4; ++ks)
#pragma unroll
          for (int mt = 0; mt < 4; ++mt) {
            bf16x8 a = *(const bf16x8*)(sK + off_b(mt * 16 + fr, ks * 4 + fq));
            S[mt] = __builtin_amdgcn_mfma_f32_16x16x32_bf16(a, qf[ks], S[mt], 0, 0, 0);
          }
        bf16x8 wf[2];
        {
          float ee[4][4], tot[4], hi[4];
#pragma unroll
          for (int mt = 0; mt < 4; ++mt) {
            const int kbase = kb * 64 + mt * 16 + fq * 4;
            float ls[4];
#pragma unroll
            for (int jj = 0; jj < 4; ++jj) {
              const float u = S[mt][jj];
              const bool valid = (kbase + jj) < qp;
              const float l = -__builtin_amdgcn_logf(1.0f + __builtin_amdgcn_exp2f(u));
              ls[jj] = valid ? l : 0.f;
              ee[mt][jj] = valid ? (u + l) : -1e30f;
            }
            const float x3 = ls[3], x2 = x3 + ls[2], x1 = x2 + ls[1], seg = x1 + ls[0];
            ee[mt][2] += x3; ee[mt][1] += x2; ee[mt][0] += x1;
            const float t1 = __shfl_xor(seg, 16), t2 = __shfl_xor(seg, 32), t3 = __shfl_xor(t1, 32);
            tot[mt] = seg + t1 + t2 + t3;
            hi[mt] = fq == 0 ? (t1 + t2 + t3) : fq == 1 ? (t2 + t3) : fq == 2 ? t1 : 0.f;
          }
          float run = carry;
          float wv[4][4];
#pragma unroll
          for (int mt = 3; mt >= 0; --mt) {
            const float base = run + hi[mt];
            run += tot[mt];
#pragma unroll
            for (int jj = 0; jj < 4; ++jj) wv[mt][jj] = __builtin_amdgcn_exp2f(ee[mt][jj] + base);
          }
          carry = run;
          if (__all(carry < -150.0f)) { wdone = true; if (lane == 0) dflag[w] = 1; }
#pragma unroll
          for (int p2 = 0; p2 < 2; ++p2) {
            uint4 pk;
            pk.x = pack2(wv[2 * p2][0], wv[2 * p2][1]); pk.y = pack2(wv[2 * p2][2], wv[2 * p2][3]);
            pk.z = pack2(wv[2 * p2 + 1][0], wv[2 * p2 + 1][1]); pk.w = pack2(wv[2 * p2 + 1][2], wv[2 * p2 + 1][3]);
            wf[p2] = *(bf16x8*)&pk;
          }
        }
#pragma unroll
        for (int p2 = 0; p2 < 2; ++p2)
#pragma unroll
          for (int dt = 0; dt < 8; ++dt) {
            const unsigned r0 = 32 * p2 + 4 * fq + tq, r1 = r0 + 16;
            const unsigned ch = 2 * dt + (tp >> 1);
            const char* a0 = sV + off_b(r0, ch) + 8 * (tp & 1);
            const char* a1 = sV + off_b(r1, ch) + 8 * (tp & 1);
            s16x4 lo = __builtin_amdgcn_ds_read_tr16_b64_v4i16((s16x4 __attribute__((address_space(3)))*)(a0));
            s16x4 hi4 = __builtin_amdgcn_ds_read_tr16_b64_v4i16((s16x4 __attribute__((address_space(3)))*)(a1));
            bf16x8 a = {lo[0], lo[1], lo[2], lo[3], hi4[0], hi4[1], hi4[2], hi4[3]};
            O[dt] = __builtin_amdgcn_mfma_f32_16x16x32_bf16(a, wf[p2], O[dt], 0, 0, 0);
          }
      }
      if (it + 1 < ntiles) ATT_STORE(st ^ 1);
      __syncthreads();
      {
        const int4 f0 = *(const int4*)dflag, f1 = *(const int4*)(dflag + 4);
        if (f0.x & f0.y & f0.z & f0.w & f1.x & f1.y & f1.z & f1.w) break;
      }
    }
#undef ATT_LOAD
#undef ATT_STORE
    if (wactive) {
      const size_t rowoff = (size_t)(tokq0 + w * 16 + fr) * 2048 + h * 128;
#pragma unroll
      for (int dt = 0; dt < 8; ++dt) {
        const int d = dt * 16 + fq * 4;
        uint2 z = *(const uint2*)(ZS + rowoff + d);
        f32x4 v = O[dt];
        uint2 o;
        o.x = pack2(v[0] * bflo(z.x), v[1] * bfhi(z.x)); o.y = pack2(v[2] * bflo(z.y), v[3] * bfhi(z.y));
        *(uint2*)(OG + rowoff + d) = o;
      }
    }
  }
}


DEV void grid_barrier(unsigned* bar, unsigned target) {
  __syncthreads();
  if (threadIdx.x == 0) {
    __builtin_amdgcn_fence(__ATOMIC_RELEASE, "agent");
    asm volatile("s_waitcnt vmcnt(0)" ::: "memory");
    __hip_atomic_fetch_add(bar, 1u, __ATOMIC_RELAXED, __HIP_MEMORY_SCOPE_AGENT);
    while (__hip_atomic_load(bar, __ATOMIC_RELAXED, __HIP_MEMORY_SCOPE_AGENT) < target) __builtin_amdgcn_s_sleep(1);
    __builtin_amdgcn_fence(__ATOMIC_ACQUIRE, "agent");
    asm volatile("s_waitcnt vmcnt(0)" ::: "memory");
  }
  __syncthreads();
}

__global__ void __launch_bounds__(NTHREADS) mega(Params p, int lo, int hi) {
  __shared__ __attribute__((aligned(16))) char smem[147456];
  cg::grid_group grid = cg::this_grid();
#ifndef PROBE_DOUBLE
#define PROBE_DOUBLE -1
#endif
#define RUN_PHASE(k, call) if ((k) >= lo && (k) < hi) { if ((k) > lo) { if ((k) == lo + 1) grid.sync(); else grid_barrier((unsigned*)(p.ws + WS_BAR), (unsigned)((k) - lo - 1) * gridDim.x); } call; }
  RUN_PHASE(0, phase_prep(p, smem))
  RUN_PHASE(1, phase_norm0(p))
  RUN_PHASE(2, phase_proj0(p, smem))
  RUN_PHASE(3, phase_scan(p, smem))
  RUN_PHASE(4, phase_outproj<0>(p, smem))
  RUN_PHASE(5, phase_norm1(p))
  RUN_PHASE(6, phase_proj1(p, smem))
  RUN_PHASE(7, phase_attn(p, smem))
  RUN_PHASE(8, phase_outproj<1>(p, smem))
}

#ifndef N_LAUNCH_MODE
#define N_LAUNCH_MODE 1
#endif

extern "C" void kernel_launch(void* const* d_in, const int* in_sizes, int n_in, void* d_out, int out_size, void* d_ws, size_t ws_size,
                              hipStream_t stream) {
  Params p{};
  for (int i = 0; i < 36; ++i) p.in[i] = (const float*)d_in[i];
  p.out = (float*)d_out;
  p.ws = (char*)d_ws;
  static int grid_blocks = 0;
  if (!grid_blocks) {
    int dev = 0, cus = 0, per_cu = 0;
    hipGetDevice(&dev);
    hipDeviceGetAttribute(&cus, hipDeviceAttributeMultiprocessorCount, dev);
    hipOccupancyMaxActiveBlocksPerMultiprocessor(&per_cu, mega, NTHREADS, 0);
    if (per_cu < 1) per_cu = 1;
    grid_blocks = cus * per_cu;
  }
  if (ws_size < WS_END) { fprintf(stderr, "workspace too small: %zu < %llu\n", ws_size, (unsigned long long)WS_END); return; }
#if N_LAUNCH_MODE == 1
  int lo = 0, hi = 9;
  hipMemsetAsync((char*)d_ws + WS_BAR, 0, 256, stream);
  void* args[] = {&p, &lo, &hi};
  hipError_t e = hipLaunchCooperativeKernel((void*)mega, dim3(grid_blocks), dim3(NTHREADS), args, 0, stream);
  if (e != hipSuccess) fprintf(stderr, "cooperative launch failed: %s (grid %d)\n", hipGetErrorString(e), grid_blocks);
#else
  for (int ph = 0; ph < 9; ++ph) hipLaunchKernelGGL(mega, dim3(grid_blocks), dim3(NTHREADS), 0, stream, p, ph, ph + 1);
#endif
}
```

```cpp
#include <hip/hip_runtime.h>
#include <hip/hip_cooperative_groups.h>
#include <cstdio>
namespace cg = cooperative_groups;

typedef unsigned short u16;
typedef short bf16x8 __attribute__((ext_vector_type(8)));
typedef short s16x4 __attribute__((ext_vector_type(4)));
typedef float f32x4 __attribute__((ext_vector_type(4)));
typedef float f32x2 __attribute__((ext_vector_type(2)));
typedef __bf16 bf16x2_t __attribute__((ext_vector_type(2)));

#define DEV __device__ __forceinline__

#define NTOK 33280
#define TP 32768
#define NTHREADS 512

#define OFF_Y_P 0
#define OFF_Y_S 33554432
#define OFF_K_P 34078720
#define OFF_V_P 101187584
#define OFF_WKV_P 168296448
#define OFF_SH_P 169345024
#define OFF_K_S 169353216
#define OFF_V_S 170401792
#define OFF_WKV_S 171450368
#define OFF_SH_S 173547520

#define SLOT 136314880ull
#define WS_W (7ull * SLOT)
#define WS_WT_IN (WS_W)
#define WS_WT_OUTA (WS_WT_IN + 16777216ull)
#define WS_WT_KV (WS_WT_OUTA + 4194304ull)
#define WS_WT_INB (WS_WT_KV + 8388608ull)
#define WS_WT_OUTB (WS_WT_INB + 8388608ull)
#define WS_W2T (WS_WT_OUTB + 4194304ull)
#define WS_A2T (WS_W2T + 262144ull)
#define WS_L1T (WS_A2T + 262144ull)
#define WS_MOD (WS_L1T + 524288ull)
#define WS_SH (WS_MOD + 589824ull)
#define WS_CTR (WS_SH + 49152ull)
#define WS_BAR (WS_CTR + 4096ull)
#define WS_END (WS_BAR + 256ull)
#define WS_H0 (6ull * SLOT)
#define WS_T (6ull * SLOT + 68157440ull)

struct Params {
  const float* in[36];
  float* out;
  char* ws;
};

enum { I_XP = 0, I_XS, I_CK, I_CV, I_SWKV, I_SSH, I_CP, I_CS, I_ANG, I_AADAW, I_AADAB, I_AWIN, I_AMUIN, I_AMUW, I_AMUA,
       I_AW0, I_AW1, I_AW2, I_AA0, I_AA1, I_AA2, I_AKK, I_AKA, I_ARK, I_ALNG, I_ALNB, I_AWOUT, I_KVNG, I_KVW, I_KGAIN,
       I_BNG, I_BADAW, I_BADAB, I_BWIN, I_BQG, I_BWOUT };

DEV int seq_of(int t) { return t < TP ? (t >> 12) : 8 + ((t - TP) >> 5); }
DEV bool seq_start(int t) { return t < TP ? ((t & 4095) == 0) : (((t - TP) & 31) == 0); }

DEV unsigned pack2(float a, float b) {
  f32x2 v = {a, b};
  bf16x2_t r = __builtin_convertvector(v, bf16x2_t);
  return *(unsigned*)&r;
}
DEV float bflo(unsigned w) { return __uint_as_float(w << 16); }
DEV float bfhi(unsigned w) { return __uint_as_float(w & 0xffff0000u); }
DEV void unpack8(const uint4& x, float* f) {
  f[0] = bflo(x.x); f[1] = bfhi(x.x); f[2] = bflo(x.y); f[3] = bfhi(x.y);
  f[4] = bflo(x.z); f[5] = bfhi(x.z); f[6] = bflo(x.w); f[7] = bfhi(x.w);
}
DEV float sigmoidf_(float x) { return 1.0f / (1.0f + __expf(-x)); }

template <int CTRL>
DEV float dppf(float x) {
  return __int_as_float(__builtin_amdgcn_update_dpp(0, __float_as_int(x), CTRL, 0xf, 0xf, true));
}
DEV float red4(float x) { x += dppf<0xB1>(x); x += dppf<0x4E>(x); return x; }
DEV float red8(float x) { x = red4(x); x += dppf<0x141>(x); return x; }
DEV float red16(float x) { x = red8(x); x += dppf<0x140>(x); return x; }
DEV float wave_sum(float x) {
#pragma unroll
  for (int o = 32; o >= 1; o >>= 1) x += __shfl_xor(x, o);
  return x;
}


#define SCHED_SLOT_OFF 147440
DEV int xcc_id() { return (int)(__builtin_amdgcn_s_getreg((3 << 11) | 20) & 0x7u); }
DEV unsigned* sched_ctr(const Params& p, int phase_slot, int list) { return (unsigned*)(p.ws + WS_CTR) + (phase_slot * 8 + list) * 16; }
DEV int sched_first(unsigned* ctr, char* smem) {
  int* slot = (int*)(smem + SCHED_SLOT_OFF);
  __syncthreads();
  if (threadIdx.x == 0) *slot = (int)atomicAdd(ctr, 1u);
  __syncthreads();
  return *slot;
}

DEV void group_sync(unsigned* bar, unsigned target) {
  __syncthreads();
  if (threadIdx.x == 0) {
    __hip_atomic_fetch_add(bar, 1u, __ATOMIC_RELAXED, __HIP_MEMORY_SCOPE_AGENT);
    while (__hip_atomic_load(bar, __ATOMIC_RELAXED, __HIP_MEMORY_SCOPE_AGENT) < target) __builtin_amdgcn_s_sleep(2);
  }
  __syncthreads();
}
DEV int sched_prefetch(unsigned* ctr) { return threadIdx.x == 0 ? (int)atomicAdd(ctr, 1u) : 0; }
DEV int sched_commit(int nxt, char* smem) {
  int* slot = (int*)(smem + SCHED_SLOT_OFF);
  __syncthreads();
  if (threadIdx.x == 0) *slot = nxt;
  __syncthreads();
  return *slot;
}

#define GEMM_STAGE_BYTES 49152

template <int AMODE>
DEV void gemm_main(f32x4 (&acc)[4][4], const u16* __restrict__ A, int lda, const u16* __restrict__ Bt, int ldb, int nk,
                   int m0, int n0, const float* __restrict__ mu, const u16* __restrict__ SH, char* smem) {
  const int tid = threadIdx.x, lane = tid & 63, wid = tid >> 6, wr = wid >> 1, wc = wid & 1, fr = lane & 15, fq = lane >> 4;
  const int lrow = tid >> 3, lch = tid & 7;
#pragma unroll
  for (int i = 0; i < 4; ++i)
#pragma unroll
    for (int j = 0; j < 4; ++j) acc[i][j] = (f32x4){0.f, 0.f, 0.f, 0.f};

  const u16* pa0; const u16* pa1; const u16* pa2; const u16* pa3;
  const u16* pp0 = nullptr;
  const int arow = 4 * lrow;
  {
    int m = m0 + arow;
    pa0 = A + (size_t)m * lda + lch * 8;
    pa1 = pa0 + lda; pa2 = pa1 + lda; pa3 = pa2 + lda;
    if (AMODE != 0) pp0 = seq_start(m) ? SH + seq_of(m) * 1024 + lch * 8 : pa0 - lda;
  }
  const u16* pb0 = Bt + (size_t)(n0 + lrow) * ldb + lch * 8;
  const u16* pb1 = pb0 + (size_t)64 * ldb;
  const int woffB = lrow * 128 + ((lch ^ ((lrow >> 1) & 7)) << 4);
  const int woffA0 = (arow + 0) * 128 + ((lch ^ (((arow + 0) >> 1) & 7)) << 4);
  const int woffA1 = (arow + 1) * 128 + ((lch ^ (((arow + 1) >> 1) & 7)) << 4);
  const int woffA2 = (arow + 2) * 128 + ((lch ^ (((arow + 2) >> 1) & 7)) << 4);
  const int woffA3 = (arow + 3) * 128 + ((lch ^ (((arow + 3) >> 1) & 7)) << 4);

  uint4 ra0, ra1, ra2, ra3, rp0, rb0, rb1;
  float4 mu0, mu1;
  rp0 = make_uint4(0, 0, 0, 0);
  mu0 = mu1 = make_float4(0, 0, 0, 0);

#define G_LOAD(kt)                                                                     \
  {                                                                                    \
    const int k0_ = (kt) * 64;                                                         \
    if (AMODE == 0) {                                                                  \
      ra0 = *(const uint4*)(pa0 + k0_); ra1 = *(const uint4*)(pa1 + k0_);              \
      ra2 = *(const uint4*)(pa2 + k0_); ra3 = *(const uint4*)(pa3 + k0_);              \
    } else if (AMODE == 1) {                                                           \
      ra0 = *(const uint4*)(pa0 + k0_); ra1 = *(const uint4*)(pa1 + k0_);              \
      ra2 = *(const uint4*)(pa2 + k0_); ra3 = *(const uint4*)(pa3 + k0_);              \
      rp0 = *(const uint4*)(pp0 + k0_);                                                \
      mu0 = *(const float4*)(mu + k0_ + lch * 8); mu1 = *(const float4*)(mu + k0_ + lch * 8 + 4); \
    } else {                                                                           \
      const int kk_ = k0_ & 1023;                                                      \
      ra0 = *(const uint4*)(pa0 + kk_); ra1 = *(const uint4*)(pa1 + kk_);              \
      ra2 = *(const uint4*)(pa2 + kk_); ra3 = *(const uint4*)(pa3 + kk_);              \
      if (k0_ >= 1024) rp0 = *(const uint4*)(pp0 + kk_);                               \
    }                                                                                  \
    rb0 = *(const uint4*)(pb0 + k0_); rb1 = *(const uint4*)(pb1 + k0_);                \
  }

#define G_XFORM(dst, a_, p_, kt)                                                       \
  {                                                                                    \
    if (AMODE == 0) dst = a_;                                                          \
    else if (AMODE == 1) {                                                             \
      float h_[8], q_[8]; unpack8(a_, h_); unpack8(p_, q_);                            \
      dst.x = pack2(h_[0] + mu0.x * (q_[0] - h_[0]), h_[1] + mu0.y * (q_[1] - h_[1])); \
      dst.y = pack2(h_[2] + mu0.z * (q_[2] - h_[2]), h_[3] + mu0.w * (q_[3] - h_[3])); \
      dst.z = pack2(h_[4] + mu1.x * (q_[4] - h_[4]), h_[5] + mu1.y * (q_[5] - h_[5])); \
      dst.w = pack2(h_[6] + mu1.z * (q_[6] - h_[6]), h_[7] + mu1.w * (q_[7] - h_[7])); \
    } else {                                                                           \
      if ((kt) * 64 >= 1024) {                                                         \
        float h_[8], q_[8]; unpack8(a_, h_); unpack8(p_, q_);                          \
        dst.x = pack2(q_[0] - h_[0], q_[1] - h_[1]); dst.y = pack2(q_[2] - h_[2], q_[3] - h_[3]); \
        dst.z = pack2(q_[4] - h_[4], q_[5] - h_[5]); dst.w = pack2(q_[6] - h_[6], q_[7] - h_[7]); \
      } else dst = a_;                                                                 \
    }                                                                                  \
  }

#define G_STORE(stage, kt)                                                             \
  {                                                                                    \
    char* sA_ = smem + (stage) * GEMM_STAGE_BYTES; char* sB_ = sA_ + 32768;            \
    uint4 v_;                                                                          \
    G_XFORM(v_, ra0, rp0, kt); *(uint4*)(sA_ + woffA0) = v_;                           \
    G_XFORM(v_, ra1, ra0, kt); *(uint4*)(sA_ + woffA1) = v_;                           \
    G_XFORM(v_, ra2, ra1, kt); *(uint4*)(sA_ + woffA2) = v_;                           \
    G_XFORM(v_, ra3, ra2, kt); *(uint4*)(sA_ + woffA3) = v_;                           \
    *(uint4*)(sB_ + woffB) = rb0; *(uint4*)(sB_ + woffB + 64 * 128) = rb1;             \
  }

  G_LOAD(0);
  G_STORE(0, 0);
  __syncthreads();
  const int rsw = (fr >> 1) & 7;
  for (int kt = 0; kt < nk; ++kt) {
    const int st = kt & 1;
    if (kt + 1 < nk) G_LOAD(kt + 1);
    __builtin_amdgcn_sched_barrier(0);
    {
      const char* sA = smem + st * GEMM_STAGE_BYTES;
      const char* sB = sA + 32768;
#pragma unroll
      for (int kk = 0; kk < 2; ++kk) {
        bf16x8 af[4], bfr[4];
        const int cho = ((kk * 4 + fq) ^ rsw) << 4;
#pragma unroll
        for (int i = 0; i < 4; ++i) af[i] = *(const bf16x8*)(sA + (wr * 64 + i * 16 + fr) * 128 + cho);
#pragma unroll
        for (int j = 0; j < 4; ++j) bfr[j] = *(const bf16x8*)(sB + (wc * 64 + j * 16 + fr) * 128 + cho);
#pragma unroll
        for (int i = 0; i < 4; ++i)
#pragma unroll
          for (int j = 0; j < 4; ++j) acc[i][j] = __builtin_amdgcn_mfma_f32_16x16x32_bf16(bfr[j], af[i], acc[i][j], 0, 0, 0);
      }
    }
    if (kt + 1 < nk) G_STORE(st ^ 1, kt + 1);
    __syncthreads();
  }
#undef G_LOAD
#undef G_XFORM
#undef G_STORE
}


#define G2_STAGE_BYTES 32768
#define G2_MU_OFF (3 * G2_STAGE_BYTES)
DEV int g2_swz(int row) { return (0x78 >> (2 * ((row >> 2) & 3))) & 3; }
template <int AMODE>
DEV void gemm_main256(f32x4 (&acc)[8][4], const u16* __restrict__ A, int lda, const u16* __restrict__ Bt, int ldb, int nk64,
                      int m0, int n0, const float* __restrict__ mu, const u16* __restrict__ SH, char* smem) {
  const int tid = threadIdx.x, lane = tid & 63, wid = tid >> 6, wr = wid >> 2, wc = wid & 3, fr = lane & 15, fq = lane >> 4;
  const int nk = nk64 * 2;
  const int lrow2 = 2 * (tid >> 2), lch = tid & 3;
#pragma unroll
  for (int i = 0; i < 8; ++i)
#pragma unroll
    for (int j = 0; j < 4; ++j) acc[i][j] = (f32x4){0.f, 0.f, 0.f, 0.f};
  const u16* pa0 = A + (size_t)(m0 + lrow2) * lda + lch * 8;
  const u16* pp0 = nullptr;
  if (AMODE != 0) pp0 = seq_start(m0 + lrow2) ? SH + seq_of(m0 + lrow2) * 1024 + lch * 8 : pa0 - lda;
  const u16* pb0 = Bt + (size_t)(n0 + lrow2) * ldb + lch * 8;
  const int woff0 = (lrow2 + 0) * 64 + ((lch ^ g2_swz(lrow2 + 0)) << 4);
  const int woff1 = (lrow2 + 1) * 64 + ((lch ^ g2_swz(lrow2 + 1)) << 4);
  const float* muL = (const float*)(smem + G2_MU_OFF);
  if (AMODE == 1) {
    if (tid < 256) *(float4*)(smem + G2_MU_OFF + tid * 16) = *(const float4*)(mu + tid * 4);
  }
  uint4 xa0, xa1, xp, xb0, xb1;
  uint4 ya0, ya1, yp, yb0, yb1;
  xp = yp = make_uint4(0, 0, 0, 0);

#define K_LOAD(S, kt)                                                                  \
  {                                                                                    \
    const int k0_ = (kt) * 32;                                                         \
    S##a0 = *(const uint4*)(pa0 + k0_); S##a1 = *(const uint4*)(pa0 + lda + k0_);      \
    if (AMODE == 1) S##p = *(const uint4*)(pp0 + k0_);                                 \
    S##b0 = *(const uint4*)(pb0 + k0_); S##b1 = *(const uint4*)(pb0 + ldb + k0_);      \
  }
#define K_XFORM(dst, a_, p_)                                                           \
  {                                                                                    \
    if (AMODE == 0) dst = a_;                                                          \
    else {                                                                             \
      float h_[8], q_[8]; unpack8(a_, h_); unpack8(p_, q_);                            \
      dst.x = pack2(h_[0] + mu0.x * (q_[0] - h_[0]), h_[1] + mu0.y * (q_[1] - h_[1])); \
      dst.y = pack2(h_[2] + mu0.z * (q_[2] - h_[2]), h_[3] + mu0.w * (q_[3] - h_[3])); \
      dst.z = pack2(h_[4] + mu1.x * (q_[4] - h_[4]), h_[5] + mu1.y * (q_[5] - h_[5])); \
      dst.w = pack2(h_[6] + mu1.z * (q_[6] - h_[6]), h_[7] + mu1.w * (q_[7] - h_[7])); \
    }                                                                                  \
  }
#define K_STORE(S, stage, kt)                                                          \
  {                                                                                    \
    char* sA_ = smem + (stage) * G2_STAGE_BYTES; char* sB_ = sA_ + 16384;              \
    uint4 v_; float4 mu0, mu1;                                                         \
    if (AMODE == 1) { mu0 = *(const float4*)(muL + (kt) * 32 + lch * 8); mu1 = *(const float4*)(muL + (kt) * 32 + lch * 8 + 4); } \
    K_XFORM(v_, S##a0, S##p); *(uint4*)(sA_ + woff0) = v_;                             \
    K_XFORM(v_, S##a1, S##a0); *(uint4*)(sA_ + woff1) = v_;                            \
    *(uint4*)(sB_ + woff0) = S##b0; *(uint4*)(sB_ + woff1) = S##b1;                    \
  }
#define K_COMPUTE_HALF(stage, i0)                                                      \
  {                                                                                    \
    const char* sA_ = smem + (stage) * G2_STAGE_BYTES;                                 \
    _Pragma("unroll") for (int i = (i0); i < (i0) + 4; ++i) {                          \
      const bf16x8 af = *(const bf16x8*)(sA_ + (wr * 128 + i * 16 + fr) * 64 + cho);   \
      _Pragma("unroll") for (int j = 0; j < 4; ++j) acc[i][j] = __builtin_amdgcn_mfma_f32_16x16x32_bf16(bfr[j], af, acc[i][j], 0, 0, 0); \
    }                                                                                  \
  }
#define K_LOAD_B(stage)                                                                \
  {                                                                                    \
    const char* sB_ = smem + (stage) * G2_STAGE_BYTES + 16384;                         \
    _Pragma("unroll") for (int j = 0; j < 4; ++j) bfr[j] = *(const bf16x8*)(sB_ + (wc * 64 + j * 16 + fr) * 64 + cho); \
  }
#define K_ITER(kt, L, S)                                                               \
  {                                                                                    \
    K_LOAD(L, min((kt) + 2, nk - 1));                                                  \
    __builtin_amdgcn_sched_barrier(0);                                                 \
    bf16x8 bfr[4];                                                                     \
    K_LOAD_B(cu);                                                                      \
    K_COMPUTE_HALF(cu, 0);                                                             \
    __builtin_amdgcn_sched_barrier(0);                                                 \
    K_STORE(S, nx, min((kt) + 1, nk - 1));                                             \
    __builtin_amdgcn_sched_barrier(0);                                                 \
    if (AMODE == 1) K_LOAD_B(cu);                                                      \
    K_COMPUTE_HALF(cu, 4);                                                             \
    __syncthreads();                                                                   \
    cu = nx; nx = (nx == 2) ? 0 : nx + 1;                                              \
  }
  const int cho = (fq ^ g2_swz(fr)) << 4;
  if (AMODE == 1) __syncthreads();
  K_LOAD(x, 0);
  K_LOAD(y, 1);
  K_STORE(x, 0, 0);
  __syncthreads();
  int cu = 0, nx = 1;
  for (int kt = 0; kt < nk; kt += 2) {
    K_ITER(kt, x, y);
    K_ITER(kt + 1, y, x);
  }
#undef K_LOAD
#undef K_XFORM
#undef K_STORE
#undef K_COMPUTE_HALF
#undef K_LOAD_B
#undef K_ITER
}

DEV void transpose_tile(const float* __restrict__ src, int N, int k0, int n0, const float* __restrict__ scale, u16* __restrict__ dst,
                        int dstride, int drow0, int dcol0, char* smem) {
  float* tile = (float*)smem;
  const int tid = threadIdx.x;
#pragma unroll
  for (int i = 0; i < 2; ++i) {
    int kl = (tid >> 4) + 32 * i, n4 = (tid & 15) * 4;
    float4 v = *(const float4*)(src + (size_t)(k0 + kl) * N + n0 + n4);
    float s = scale ? scale[k0 + kl] : 1.0f;
    tile[kl * 65 + n4 + 0] = v.x * s; tile[kl * 65 + n4 + 1] = v.y * s;
    tile[kl * 65 + n4 + 2] = v.z * s; tile[kl * 65 + n4 + 3] = v.w * s;
  }
  __syncthreads();
  {
    int nl = tid >> 3, k8 = (tid & 7) * 8;
    uint4 o;
    o.x = pack2(tile[(k8 + 0) * 65 + nl], tile[(k8 + 1) * 65 + nl]);
    o.y = pack2(tile[(k8 + 2) * 65 + nl], tile[(k8 + 3) * 65 + nl]);
    o.z = pack2(tile[(k8 + 4) * 65 + nl], tile[(k8 + 5) * 65 + nl]);
    o.w = pack2(tile[(k8 + 6) * 65 + nl], tile[(k8 + 7) * 65 + nl]);
    *(uint4*)(dst + (size_t)(drow0 + n0 + nl) * dstride + dcol0 + k0 + k8) = o;
  }
  __syncthreads();
}

DEV void phase_prep(const Params& p, char* smem) {
  const int tid = threadIdx.x;
  char* ws = p.ws;
  if (blockIdx.x < 96) {
    float* cL = (float*)smem;
    float* red = (float*)(smem + 98304);
    for (int e = tid; e < 24 * 256; e += NTHREADS) {
      int s = e >> 8, k4 = (e & 255) * 4;
      float4 v = s < 8 ? *(const float4*)(p.in[I_CP] + s * 1024 + k4) : *(const float4*)(p.in[I_CS] + (s - 8) * 1024 + k4);
      *(float4*)(cL + s * 1024 + k4) = v;
    }
    __syncthreads();
    for (int item = blockIdx.x; item < 96; item += gridDim.x) {
      const int l = item / 48, j0 = (item % 48) * 64;
      const float* W = (l == 0 ? p.in[I_AADAW] : p.in[I_BADAW]);
      const float* bias = (l == 0 ? p.in[I_AADAB] : p.in[I_BADAB]);
      const int col = tid & 63, kg = tid >> 6;
      float acc[24];
#pragma unroll
      for (int s = 0; s < 24; ++s) acc[s] = 0.f;
      for (int k = kg * 128; k < kg * 128 + 128; ++k) {
        float w = W[(size_t)k * 3072 + j0 + col];
#pragma unroll
        for (int s = 0; s < 24; ++s) acc[s] += cL[s * 1024 + k] * w;
      }
#pragma unroll
      for (int s = 0; s < 24; ++s) red[(kg * 24 + s) * 64 + col] = acc[s];
      __syncthreads();
      float* mod = (float*)(ws + WS_MOD);
      for (int e = tid; e < 24 * 64; e += NTHREADS) {
        int s = e >> 6, c = e & 63;
        float t = bias[j0 + c];
#pragma unroll
        for (int g = 0; g < 8; ++g) t += red[(g * 24 + s) * 64 + c];
        mod[(size_t)(l * 24 + s) * 3072 + j0 + c] = t;
      }
      __syncthreads();
    }
  }
  if (blockIdx.x == 0) for (int e = tid; e < 1024; e += NTHREADS) ((unsigned*)(ws + WS_CTR))[e] = 0u;
  if (blockIdx.x == gridDim.x - 1) {
    u16* SH = (u16*)(ws + WS_SH);
    for (int e = tid; e < 24 * 1024; e += NTHREADS) {
      int s = e >> 10, k = e & 1023;
      float v = s < 8 ? 0.f : p.in[I_SSH][(s - 8) * 1024 + k];
      SH[e] = (u16)(pack2(v, 0.f) & 0xffff);
    }
  }
  const int NT_TOTAL = 2048 + 512 + 1024 + 1024 + 512 + 32 + 32 + 64;
  for (int t = blockIdx.x; t < NT_TOTAL; t += gridDim.x) {
    const float* src; int K, N; u16* dst; int dstride, drow0 = 0, dcol0 = 0; const float* scale = nullptr; int tt = t;
    if (tt < 2048) { src = p.in[I_AWIN]; K = 1024; N = 8192; dst = (u16*)(ws + WS_WT_IN); dstride = 1024; }
    else if ((tt -= 2048) < 512) { src = p.in[I_AWOUT]; K = 2048; N = 1024; dst = (u16*)(ws + WS_WT_OUTA); dstride = 2048; }
    else if ((tt -= 512) < 1024) { src = p.in[I_KVW]; K = 1024; N = 4096; dst = (u16*)(ws + WS_WT_KV); dstride = 1024; }
    else if ((tt -= 1024) < 1024) { src = p.in[I_BWIN]; K = 1024; N = 4096; dst = (u16*)(ws + WS_WT_INB); dstride = 1024; }
    else if ((tt -= 1024) < 512) { src = p.in[I_BWOUT]; K = 2048; N = 1024; dst = (u16*)(ws + WS_WT_OUTB); dstride = 2048; }
    else if ((tt -= 512) < 32) { src = p.in[I_AW2]; K = 64; N = 2048; dst = (u16*)(ws + WS_W2T); dstride = 64; }
    else if ((tt -= 32) < 32) { src = p.in[I_AA2]; K = 64; N = 2048; dst = (u16*)(ws + WS_A2T); dstride = 64; }
    else {
      tt -= 32;
      int job = tt >> 4; tt &= 15;
      K = 1024; N = 64; dst = (u16*)(ws + WS_L1T); dstride = 2048;
      src = (job < 2) ? p.in[I_AW1] : p.in[I_AA1];
      drow0 = (job < 2) ? 0 : 64;
      if (job & 1) { dcol0 = 1024; scale = (job < 2) ? p.in[I_AMUW] : p.in[I_AMUA]; }
    }
    const int ntn = N / 64;
    const int kt = tt / ntn, nt = tt % ntn;
    transpose_tile(src, N, kt * 64, nt * 64, scale, dst, dstride, drow0, dcol0, smem);
  }
}

DEV void phase_norm0(const Params& p) {
  const int lane = threadIdx.x & 63, wid = threadIdx.x >> 6;
  const float* mod = (const float*)(p.ws + WS_MOD);
  u16* H0 = (u16*)(p.ws + WS_H0);
  const float* g = p.in[I_ANG];
  for (int t = blockIdx.x * 8 + wid; t < NTOK; t += gridDim.x * 8) {
    const float* x = t < TP ? p.in[I_XP] + (size_t)t * 1024 : p.in[I_XS] + (size_t)(t - TP) * 1024;
    const int s = seq_of(t);
    const float* md = mod + (size_t)s * 3072;
    float4 v[4];
    float ss = 0.f;
#pragma unroll
    for (int i = 0; i < 4; ++i) {
      v[i] = *(const float4*)(x + lane * 4 + 256 * i);
      ss += v[i].x * v[i].x + v[i].y * v[i].y + v[i].z * v[i].z + v[i].w * v[i].w;
    }
    ss = wave_sum(ss);
    const float rstd = rsqrtf(ss * (1.0f / 1024.0f) + 1e-6f);
    bool last = t < TP ? ((t & 4095) == 4095) : (((t - TP) & 31) == 31);
    float* so = t < TP ? p.out + OFF_SH_P + (t >> 12) * 1024 : p.out + OFF_SH_S + ((t - TP) >> 5) * 1024;
#pragma unroll
    for (int i = 0; i < 4; ++i) {
      const int c = lane * 4 + 256 * i;
      float4 gg = *(const float4*)(g + c), sh = *(const float4*)(md + c), sc = *(const float4*)(md + 1024 + c);
      float4 h;
      h.x = v[i].x * rstd * gg.x * (1.f + sc.x) + sh.x;
      h.y = v[i].y * rstd * gg.y * (1.f + sc.y) + sh.y;
      h.z = v[i].z * rstd * gg.z * (1.f + sc.z) + sh.z;
      h.w = v[i].w * rstd * gg.w * (1.f + sc.w) + sh.w;
      uint2 o; o.x = pack2(h.x, h.y); o.y = pack2(h.z, h.w);
      *(uint2*)(H0 + (size_t)t * 1024 + c) = o;
      if (last) *(float4*)(so + c) = h;
    }
  }
}

DEV void phase_proj0_lora(const Params& p, char* smem) {
  const int tid = threadIdx.x, lane = tid & 63, wid = tid >> 6, fr = lane & 15, fq = lane >> 4;
  const int wr = wid >> 1, wc = wid & 1;
  char* ws = p.ws;
  const u16* H0 = (const u16*)(ws + WS_H0);
  const u16* SH = (const u16*)(ws + WS_SH);
  u16* T = (u16*)(ws + WS_T);
  const int xcc0 = xcc_id();
  int nxt;
  f32x4 acc[4][4];
  for (int ls = 0; ls < 8; ++ls) {
  const int xcd = (xcc0 + ls) & 7;
  unsigned* ctr = sched_ctr(p, 0, xcd);
  for (int li = sched_first(ctr, smem); li < 17; li = sched_commit(nxt, smem)) {
    nxt = sched_prefetch(ctr);
    const int lmt = xcd + 8 * li;
    if (lmt >= 130) continue;
    const int m0 = lmt * 256;
    gemm_main<2>(acc, H0, 1024, (const u16*)(ws + WS_L1T), 2048, 32, m0, 0, nullptr, SH, smem);
#pragma unroll
    for (int i = 0; i < 4; ++i)
#pragma unroll
      for (int j = 0; j < 4; ++j) {
        const int m = m0 + wr * 64 + i * 16 + fr, n = wc * 64 + j * 16 + fq * 4;
        f32x4 v = acc[i][j];
        if (wc == 0) { v[0] = tanhf(v[0]); v[1] = tanhf(v[1]); v[2] = tanhf(v[2]); v[3] = tanhf(v[3]); }
        uint2 o; o.x = pack2(v[0], v[1]); o.y = pack2(v[2], v[3]);
        *(uint2*)(T + (size_t)m * 128 + n) = o;
      }
    __threadfence_block();
    __syncthreads();
    for (int nt = 0; nt < 32; ++nt) {
      const int which = nt >> 4, n0 = (nt & 15) * 128;
      gemm_main<0>(acc, T + which * 64, 128, (const u16*)(ws + (which ? WS_A2T : WS_W2T)), 64, 1, m0, n0, nullptr, nullptr, smem);
      const float* bias = which ? p.in[I_AA0] : p.in[I_AW0];
      u16* dst = (u16*)(ws + (which ? 5ull : 4ull) * SLOT);
      const float sc = which ? 1.0f : -0.60653066f;
#pragma unroll
      for (int i = 0; i < 4; ++i)
#pragma unroll
        for (int j = 0; j < 4; ++j) {
          const int m = m0 + wr * 64 + i * 16 + fr, n = n0 + wc * 64 + j * 16 + fq * 4;
          float4 b4 = *(const float4*)(bias + n);
          f32x4 v = acc[i][j];
          float s0 = sc * sigmoidf_(v[0] + b4.x), s1 = sc * sigmoidf_(v[1] + b4.y), s2 = sc * sigmoidf_(v[2] + b4.z), s3 = sc * sigmoidf_(v[3] + b4.w);
          uint2 o; o.x = pack2(s0, s1); o.y = pack2(s2, s3);
          *(uint2*)(dst + (size_t)m * 2048 + n) = o;
        }
    }
  }
  }
}

DEV void phase_proj0_main(const Params& p, char* smem) {
  const int tid = threadIdx.x, lane = tid & 63, wid = tid >> 6, fr = lane & 15, fq = lane >> 4;
  const int wr = wid >> 2, wc = wid & 3;
  char* ws = p.ws;
  const u16* H0 = (const u16*)(ws + WS_H0);
  const u16* SH = (const u16*)(ws + WS_SH);
  const int xcc0 = xcc_id();
  int nxt;
  f32x4 acc[8][4];
  for (int ls = 0; ls < 8; ++ls) {
  const int xcd = (xcc0 + ls) & 7;
  unsigned* ctr = sched_ctr(p, 4, xcd);
  for (int q = sched_first(ctr, smem); q < 520; q = sched_commit(nxt, smem)) {
    nxt = sched_prefetch(ctr);
    const int mt = q >> 2, nt = 4 * xcd + (q & 3);
    const int part = nt >> 3;
    const int m0 = mt * 256, n0 = nt * 256;
    gemm_main256<1>(acc, H0, 1024, (const u16*)(ws + WS_WT_IN), 1024, 16, m0, n0, p.in[I_AMUIN] + part * 1024, SH, smem);
    u16* dst = (u16*)(ws + (size_t)part * SLOT);
    const int nb = n0 - part * 2048;
#pragma unroll
    for (int i = 0; i < 8; ++i)
#pragma unroll
      for (int j = 0; j < 4; ++j) {
        const int m = m0 + wr * 128 + i * 16 + fr, n = nb + wc * 64 + j * 16 + fq * 4;
        f32x4 v = acc[i][j];
        uint2 o; o.x = pack2(v[0], v[1]); o.y = pack2(v[2], v[3]);
        *(uint2*)(dst + (size_t)m * 2048 + n) = o;
      }
  }
  }
}

DEV void phase_proj0(const Params& p, char* smem) {
  phase_proj0_lora(p, smem);
  phase_proj0_main(p, smem);
}

DEV void phase_scan(const Params& p, char* smem) {
  const int tid = threadIdx.x, lane = tid & 63, wid = tid >> 6;
  float* Lkk = (float*)smem;
  float* Lw = Lkk + 4096;
  float* Lb = Lw + 4096;
  float* Lk = Lb + 4096;
  float* Lwr = Lk + 4096;
  float* Lv = Lwr + 4096;
  float* LY = Lv + 4096;
  float* Lbon = LY + 4096;
  float* Lsc = Lbon + 64;
  char* ws = p.ws;
  const u16* gR = (const u16*)(ws + 0 * SLOT);
  const u16* gK = (const u16*)(ws + 1 * SLOT);
  const u16* gV = (const u16*)(ws + 2 * SLOT);
  const u16* gZ = (const u16*)(ws + 3 * SLOT);
  const u16* gW = (const u16*)(ws + 4 * SLOT);
  const u16* gA = (const u16*)(ws + 5 * SLOT);
  u16* YG = (u16*)(ws + 6 * SLOT);
  const int tt = tid >> 3, c8 = (tid & 7) * 8;
  const int rp = wid * 4 + (lane >> 4), kc = lane & 15;

  for (int item = blockIdx.x; item < 768; item += gridDim.x) {
    int h, tok0, nsteps; const float* sinit; float* sout;
    if (item < 256) { h = item & 31; tok0 = (item >> 5) * 4096; nsteps = 4096; sinit = nullptr; sout = p.out + OFF_WKV_P + (size_t)item * 4096; }
    else { int it = item - 256; h = it & 31; tok0 = TP + (it >> 5) * 32; nsteps = 32; sinit = p.in[I_SWKV] + (size_t)it * 4096; sout = p.out + OFF_WKV_S + (size_t)it * 4096; }
    const int nch = (nsteps + 63) >> 6;
    const int col0 = h * 64 + c8;
    float ckk[8], cka[8], crk[8], clg[8], clb[8];
    {
      float4 t0, t1;
      t0 = *(const float4*)(p.in[I_AKK] + col0); t1 = *(const float4*)(p.in[I_AKK] + col0 + 4);
      ckk[0] = t0.x; ckk[1] = t0.y; ckk[2] = t0.z; ckk[3] = t0.w; ckk[4] = t1.x; ckk[5] = t1.y; ckk[6] = t1.z; ckk[7] = t1.w;
      t0 = *(const float4*)(p.in[I_AKA] + col0); t1 = *(const float4*)(p.in[I_AKA] + col0 + 4);
      cka[0] = t0.x; cka[1] = t0.y; cka[2] = t0.z; cka[3] = t0.w; cka[4] = t1.x; cka[5] = t1.y; cka[6] = t1.z; cka[7] = t1.w;
      t0 = *(const float4*)(p.in[I_ARK] + col0); t1 = *(const float4*)(p.in[I_ARK] + col0 + 4);
      crk[0] = t0.x; crk[1] = t0.y; crk[2] = t0.z; crk[3] = t0.w; crk[4] = t1.x; crk[5] = t1.y; crk[6] = t1.z; crk[7] = t1.w;
      t0 = *(const float4*)(p.in[I_ALNG] + col0); t1 = *(const float4*)(p.in[I_ALNG] + col0 + 4);
      clg[0] = t0.x; clg[1] = t0.y; clg[2] = t0.z; clg[3] = t0.w; clg[4] = t1.x; clg[5] = t1.y; clg[6] = t1.z; clg[7] = t1.w;
      t0 = *(const float4*)(p.in[I_ALNB] + col0); t1 = *(const float4*)(p.in[I_ALNB] + col0 + 4);
      clb[0] = t0.x; clb[1] = t0.y; clb[2] = t0.z; clb[3] = t0.w; clb[4] = t1.x; clb[5] = t1.y; clb[6] = t1.z; clb[7] = t1.w;
    }
    float s0[4], s1[4];
    if (sinit) {
      float4 a = *(const float4*)(sinit + (2 * rp) * 64 + kc * 4), b = *(const float4*)(sinit + (2 * rp + 1) * 64 + kc * 4);
      s0[0] = a.x; s0[1] = a.y; s0[2] = a.z; s0[3] = a.w; s1[0] = b.x; s1[1] = b.y; s1[2] = b.z; s1[3] = b.w;
    } else {
#pragma unroll
      for (int j = 0; j < 4; ++j) { s0[j] = 0.f; s1[j] = 0.f; }
    }
    uint4 cr, ck, cv, cz, cw, ca;
#define SCAN_LOAD(c)                                                                   \
    {                                                                                  \
      const int tl_ = (c) * 64 + tt;                                                   \
      if (tl_ < nsteps) {                                                              \
        const size_t o_ = (size_t)(tok0 + tl_) * 2048 + col0;                          \
        cr = *(const uint4*)(gR + o_); ck = *(const uint4*)(gK + o_); cv = *(const uint4*)(gV + o_); \
        cz = *(const uint4*)(gZ + o_); cw = *(const uint4*)(gW + o_); ca = *(const uint4*)(gA + o_); \
      } else { cr = ck = cv = cz = cw = ca = make_uint4(0, 0, 0, 0); }                 \
    }
    SCAN_LOAD(0);
    for (int c = 0; c < nch; ++c) {
      uint4 zc = cz;
      {
        float r[8], k[8], v[8], lw[8], a[8];
        unpack8(cr, r); unpack8(ck, k); unpack8(cv, v); unpack8(cw, lw); unpack8(ca, a);
        float kkv[8], kp[8], w[8], bon = 0.f, ss = 0.f, kr = 0.f;
#pragma unroll
        for (int j = 0; j < 8; ++j) {
          kkv[j] = k[j] * ckk[j]; ss += kkv[j] * kkv[j];
          kp[j] = k[j] * (1.f + (a[j] - 1.f) * cka[j]);
          bon += r[j] * kp[j] * crk[j];
          kr += r[j] * kp[j];
          w[j] = __expf(lw[j]);
        }
        ss = red8(ss); bon = red8(bon); kr = red8(kr);
        const float inv = rsqrtf(ss + 1e-12f);
        float bb[8], br = 0.f;
#pragma unroll
        for (int j = 0; j < 8; ++j) { kkv[j] *= inv; bb[j] = kkv[j] * a[j]; br += bb[j] * r[j]; }
        br = red8(br);
        float* d;
        d = Lkk + tt * 64 + c8;
        *(float4*)d = make_float4(kkv[0], kkv[1], kkv[2], kkv[3]); *(float4*)(d + 4) = make_float4(kkv[4], kkv[5], kkv[6], kkv[7]);
        d = Lb + tt * 64 + c8;
        *(float4*)d = make_float4(bb[0], bb[1], bb[2], bb[3]); *(float4*)(d + 4) = make_float4(bb[4], bb[5], bb[6], bb[7]);
        d = Lw + tt * 64 + c8;
        *(float4*)d = make_float4(w[0], w[1], w[2], w[3]); *(float4*)(d + 4) = make_float4(w[4], w[5], w[6], w[7]);
        d = Lk + tt * 64 + c8;
        *(float4*)d = make_float4(kp[0], kp[1], kp[2], kp[3]); *(float4*)(d + 4) = make_float4(kp[4], kp[5], kp[6], kp[7]);
        d = Lwr + tt * 64 + c8;
        *(float4*)d = make_float4(w[0] * r[0], w[1] * r[1], w[2] * r[2], w[3] * r[3]);
        *(float4*)(d + 4) = make_float4(w[4] * r[4], w[5] * r[5], w[6] * r[6], w[7] * r[7]);
        d = Lv + tt * 64 + c8;
        *(float4*)d = make_float4(v[0], v[1], v[2], v[3]); *(float4*)(d + 4) = make_float4(v[4], v[5], v[6], v[7]);
        if ((tid & 7) == 0) { Lbon[tt] = bon; *(float2*)(Lsc + tt * 2) = make_float2(br, kr); }
      }
      __syncthreads();
      if (c + 1 < nch) SCAN_LOAD(c + 1);
      {
        const int nT = min(64, nsteps - c * 64);
        const float* pk = Lkk + kc * 4; const float* pw = Lw + kc * 4; const float* pb = Lb + kc * 4;
        const float* pkp = Lk + kc * 4; const float* pwr = Lwr + kc * 4; const float* pv = Lv + rp * 2;
        float* py = LY + rp * 2;
#define SCAN_LD(S, o)                                                                  \
        S##kk = *(const float4*)(pk + (o)); S##w = *(const float4*)(pw + (o)); S##b = *(const float4*)(pb + (o)); \
        S##k = *(const float4*)(pkp + (o)); S##wr = *(const float4*)(pwr + (o)); S##v = *(const float2*)(pv + (o)); \
        S##sc = *(const float2*)(Lsc + ((o) >> 5));
#define SCAN_STEP(S, o)                                                                \
        {                                                                              \
          float d0 = s0[0] * S##kk.x + s0[1] * S##kk.y + s0[2] * S##kk.z + s0[3] * S##kk.w;  \
          float d1 = s1[0] * S##kk.x + s1[1] * S##kk.y + s1[2] * S##kk.z + s1[3] * S##kk.w;  \
          float e0 = s0[0] * S##wr.x + s0[1] * S##wr.y + s0[2] * S##wr.z + s0[3] * S##wr.w;  \
          float e1 = s1[0] * S##wr.x + s1[1] * S##wr.y + s1[2] * S##wr.z + s1[3] * S##wr.w;  \
          d0 += dppf<0xB1>(d0); d1 += dppf<0xB1>(d1); e0 += dppf<0xB1>(e0); e1 += dppf<0xB1>(e1);       \
          d0 += dppf<0x4E>(d0); d1 += dppf<0x4E>(d1); e0 += dppf<0x4E>(e0); e1 += dppf<0x4E>(e1);       \
          d0 += dppf<0x141>(d0); d1 += dppf<0x141>(d1); e0 += dppf<0x141>(e0); e1 += dppf<0x141>(e1);   \
          d0 += dppf<0x140>(d0); d1 += dppf<0x140>(d1); e0 += dppf<0x140>(e0); e1 += dppf<0x140>(e1);   \
          s0[0] = s0[0] * S##w.x + (S##v.x * S##k.x - d0 * S##b.x);                    \
          s0[1] = s0[1] * S##w.y + (S##v.x * S##k.y - d0 * S##b.y);                    \
          s0[2] = s0[2] * S##w.z + (S##v.x * S##k.z - d0 * S##b.z);                    \
          s0[3] = s0[3] * S##w.w + (S##v.x * S##k.w - d0 * S##b.w);                    \
          s1[0] = s1[0] * S##w.x + (S##v.y * S##k.x - d1 * S##b.x);                    \
          s1[1] = s1[1] * S##w.y + (S##v.y * S##k.y - d1 * S##b.y);                    \
          s1[2] = s1[2] * S##w.z + (S##v.y * S##k.z - d1 * S##b.z);                    \
          s1[3] = s1[3] * S##w.w + (S##v.y * S##k.w - d1 * S##b.w);                    \
          if (kc == 0) *(float2*)(py + (o)) = make_float2(e0 - d0 * S##sc.x + S##v.x * S##sc.y, e1 - d1 * S##sc.x + S##v.y * S##sc.y); \
        }
        float4 Akk, Aw, Ab, Ak, Awr, Bkk, Bw, Bb, Bk, Bwr; float2 Av, Asc, Bv, Bsc;
        SCAN_LD(A, 0);
        for (int t = 0; t < nT; t += 2) {
          SCAN_LD(B, (t + 1) * 64);
          SCAN_STEP(A, t * 64);
          SCAN_LD(A, (t + 2) * 64);
          SCAN_STEP(B, (t + 1) * 64);
        }
#undef SCAN_LD
#undef SCAN_STEP
      }
      __syncthreads();
      {
        const int tl = c * 64 + tt;
        if (tl < nsteps) {
          float y[8], z[8];
          float4 a = *(const float4*)(LY + tt * 64 + c8), b = *(const float4*)(LY + tt * 64 + c8 + 4);
          y[0] = a.x; y[1] = a.y; y[2] = a.z; y[3] = a.w; y[4] = b.x; y[5] = b.y; y[6] = b.z; y[7] = b.w;
          float sm = y[0] + y[1] + y[2] + y[3] + y[4] + y[5] + y[6] + y[7];
          sm = red8(sm);
          const float mean = sm * (1.f / 64.f);
          float vs = 0.f;
#pragma unroll
          for (int j = 0; j < 8; ++j) { y[j] -= mean; vs += y[j] * y[j]; }
          vs = red8(vs);
          const float rstd = rsqrtf(vs * (1.f / 64.f) + 64e-5f);
          const float bon = Lbon[tt];
          float4 va = *(const float4*)(Lv + tt * 64 + c8), vb = *(const float4*)(Lv + tt * 64 + c8 + 4);
          float vv[8] = {va.x, va.y, va.z, va.w, vb.x, vb.y, vb.z, vb.w};
          unpack8(zc, z);
          float o[8];
#pragma unroll
          for (int j = 0; j < 8; ++j) {
            float t = y[j] * rstd * clg[j] + clb[j] + bon * vv[j];
            o[j] = t * z[j] * sigmoidf_(z[j]);
          }
          uint4 ov; ov.x = pack2(o[0], o[1]); ov.y = pack2(o[2], o[3]); ov.z = pack2(o[4], o[5]); ov.w = pack2(o[6], o[7]);
          *(uint4*)(YG + (size_t)(tok0 + tl) * 2048 + col0) = ov;
        }
      }
      __syncthreads();
    }
#undef SCAN_LOAD
    *(float4*)(sout + (2 * rp) * 64 + kc * 4) = make_float4(s0[0], s0[1], s0[2], s0[3]);
    *(float4*)(sout + (2 * rp + 1) * 64 + kc * 4) = make_float4(s1[0], s1[1], s1[2], s1[3]);
  }
}

template <int LAYER>
DEV void phase_outproj(const Params& p, char* smem) {
  const int tid = threadIdx.x, lane = tid & 63, wid = tid >> 6, wr = wid >> 1, wc = wid & 1, fr = lane & 15, fq = lane >> 4;
  char* ws = p.ws;
  const u16* A = (const u16*)(ws + 6 * SLOT);
  const u16* Bt = (const u16*)(ws + (LAYER == 0 ? WS_WT_OUTA : WS_WT_OUTB));
  const float* mod = (const float*)(ws + WS_MOD) + (size_t)LAYER * 24 * 3072;
  float* xmid = (float*)(ws + 0 * SLOT);
  f32x4 acc[4][4];
  const int xcc0 = xcc_id();
  int nxt;
  for (int ls = 0; ls < 8; ++ls) {
  const int xcd = (xcc0 + ls) & 7;
  unsigned* ctr = sched_ctr(p, LAYER == 0 ? 1 : 3, xcd);
  for (int li = sched_first(ctr, smem); li < 130; li = sched_commit(nxt, smem)) {
    nxt = sched_prefetch(ctr);
    const int item = 130 * xcd + li;
    const int m0 = (item >> 3) * 256, n0 = (item & 7) * 128;
    gemm_main<0>(acc, A, 2048, Bt, 2048, 32, m0, n0, nullptr, nullptr, smem);
#pragma unroll
    for (int i = 0; i < 4; ++i) {
      const int m = m0 + wr * 64 + i * 16 + fr;
      const float* gate = mod + (size_t)seq_of(m) * 3072 + 2048;
#pragma unroll
      for (int j = 0; j < 4; ++j) {
        const int n = n0 + wc * 64 + j * 16 + fq * 4;
        float4 g4 = *(const float4*)(gate + n);
        f32x4 v = acc[i][j];
        if (LAYER == 0) {
          const float* xr = m < TP ? p.in[I_XP] + (size_t)m * 1024 : p.in[I_XS] + (size_t)(m - TP) * 1024;
          float4 x4 = *(const float4*)(xr + n);
          *(float4*)(xmid + (size_t)m * 1024 + n) = make_float4(x4.x + g4.x * v[0], x4.y + g4.y * v[1], x4.z + g4.z * v[2], x4.w + g4.w * v[3]);
        } else {
          float4 x4 = *(const float4*)(xmid + (size_t)m * 1024 + n);
          float* yo = m < TP ? p.out + OFF_Y_P + (size_t)m * 1024 : p.out + OFF_Y_S + (size_t)(m - TP) * 1024;
          *(float4*)(yo + n) = make_float4(x4.x + g4.x * v[0], x4.y + g4.y * v[1], x4.z + g4.z * v[2], x4.w + g4.w * v[3]);
        }
      }
    }
  }
}
}

DEV void phase_norm1(const Params& p) {
  const int lane = threadIdx.x & 63, wid = threadIdx.x >> 6;
  const float* mod = (const float*)(p.ws + WS_MOD) + (size_t)24 * 3072;
  const float* xmid = (const float*)(p.ws + 0 * SLOT);
  u16* AKV = (u16*)(p.ws + 1 * SLOT);
  u16* AQ = AKV + (size_t)NTOK * 1024;
  const float* gkv = p.in[I_KVNG];
  const float* gb = p.in[I_BNG];
  for (int t = blockIdx.x * 8 + wid; t < NTOK; t += gridDim.x * 8) {
    const float* x = xmid + (size_t)t * 1024;
    const float* md = mod + (size_t)seq_of(t) * 3072;
    float4 v[4];
    float ss = 0.f;
#pragma unroll
    for (int i = 0; i < 4; ++i) {
      v[i] = *(const float4*)(x + lane * 4 + 256 * i);
      ss += v[i].x * v[i].x + v[i].y * v[i].y + v[i].z * v[i].z + v[i].w * v[i].w;
    }
    ss = wave_sum(ss);
    const float rstd = rsqrtf(ss * (1.0f / 1024.0f) + 1e-6f);
#pragma unroll
    for (int i = 0; i < 4; ++i) {
      const int c = lane * 4 + 256 * i;
      float4 g1 = *(const float4*)(gkv + c), g2 = *(const float4*)(gb + c), sh = *(const float4*)(md + c), sc = *(const float4*)(md + 1024 + c);
      float xn0 = v[i].x * rstd, xn1 = v[i].y * rstd, xn2 = v[i].z * rstd, xn3 = v[i].w * rstd;
      uint2 o;
      o.x = pack2(xn0 * g1.x, xn1 * g1.y); o.y = pack2(xn2 * g1.z, xn3 * g1.w);
      *(uint2*)(AKV + (size_t)t * 1024 + c) = o;
      o.x = pack2(xn0 * g2.x * (1.f + sc.x) + sh.x, xn1 * g2.y * (1.f + sc.y) + sh.y);
      o.y = pack2(xn2 * g2.z * (1.f + sc.z) + sh.z, xn3 * g2.w * (1.f + sc.w) + sh.w);
      *(uint2*)(AQ + (size_t)t * 1024 + c) = o;
    }
  }
}

#define QSCALE (0.08838834764831845f * 1.4426950408889634f)
DEV void phase_proj1(const Params& p, char* smem) {
  const int tid = threadIdx.x, lane = tid & 63, wid = tid >> 6, wr = wid >> 2, wc = wid & 3, fr = lane & 15, fq = lane >> 4;
  char* ws = p.ws;
  const u16* AKV = (const u16*)(ws + 1 * SLOT);
  const u16* AQ = AKV + (size_t)NTOK * 1024;
  u16* KB = (u16*)(ws + 2 * SLOT);
  u16* VB = (u16*)(ws + 3 * SLOT);
  u16* QB = (u16*)(ws + 4 * SLOT);
  u16* ZS = (u16*)(ws + 5 * SLOT);
  f32x4 acc[8][4];
  float* red = (float*)smem;
  const int xcc0 = xcc_id();
  int nxt;
  for (int ls = 0; ls < 8; ++ls) {
  const int xcd = (xcc0 + ls) & 7;
  unsigned* ctr = sched_ctr(p, 2, xcd);
  for (int li = sched_first(ctr, smem); li < 520; li = sched_commit(nxt, smem)) {
    nxt = sched_prefetch(ctr);
    const int mt = li >> 2, t = 4 * xcd + (li & 3);
    const int isq = t >> 4, nt = t & 15;
    const int m0 = mt * 256, n0 = nt * 256;
    gemm_main256<0>(acc, isq ? AQ : AKV, 1024, (const u16*)(ws + (isq ? WS_WT_INB : WS_WT_KV)), 1024, 16, m0, n0, nullptr, nullptr, smem);
    if (nt < 8) {
#pragma unroll
      for (int i = 0; i < 8; ++i) {
        float ss = 0.f;
#pragma unroll
        for (int j = 0; j < 4; ++j) ss += acc[i][j][0] * acc[i][j][0] + acc[i][j][1] * acc[i][j][1] + acc[i][j][2] * acc[i][j][2] + acc[i][j][3] * acc[i][j][3];
        red[(wr * 128 + i * 16 + fr) * 16 + wc * 4 + fq] = ss;
      }
      __syncthreads();
      const float* gain = isq ? p.in[I_BQG] : p.in[I_KGAIN];
#pragma unroll
      for (int i = 0; i < 8; ++i) {
        const int row = wr * 128 + i * 16 + fr, m = m0 + row;
        float4 ra = *(const float4*)(red + row * 16 + (wc >> 1) * 8), rb = *(const float4*)(red + row * 16 + (wc >> 1) * 8 + 4);
        float tot = ra.x + ra.y + ra.z + ra.w + rb.x + rb.y + rb.z + rb.w;
        float rs = rsqrtf(tot * (1.f / 128.f) + 1e-6f);
        if (isq) rs *= QSCALE;
#pragma unroll
        for (int j = 0; j < 4; ++j) {
          const int d = (wc & 1) * 64 + j * 16 + fq * 4, n = n0 + wc * 64 + j * 16 + fq * 4;
          float4 g4 = *(const float4*)(gain + d);
          f32x4 v = acc[i][j];
          float o0 = v[0] * rs * g4.x, o1 = v[1] * rs * g4.y, o2 = v[2] * rs * g4.z, o3 = v[3] * rs * g4.w;
          uint2 o; o.x = pack2(o0, o1); o.y = pack2(o2, o3);
          if (isq) {
            *(uint2*)(QB + (size_t)m * 2048 + n) = o;
          } else {
            *(uint2*)(KB + (size_t)m * 2048 + n) = o;
            float* ko = m < TP ? p.out + OFF_K_P + (size_t)m * 2048 : p.out + OFF_K_S + (size_t)(m - TP) * 2048;
            *(float4*)(ko + n) = make_float4(o0, o1, o2, o3);
          }
        }
      }
      __syncthreads();
    } else {
#pragma unroll
      for (int i = 0; i < 8; ++i) {
        const int m = m0 + wr * 128 + i * 16 + fr;
#pragma unroll
        for (int j = 0; j < 4; ++j) {
          const int n = n0 - 2048 + wc * 64 + j * 16 + fq * 4;
          f32x4 v = acc[i][j];
          if (isq) {
            float o0 = v[0] * sigmoidf_(v[0]), o1 = v[1] * sigmoidf_(v[1]), o2 = v[2] * sigmoidf_(v[2]), o3 = v[3] * sigmoidf_(v[3]);
            uint2 o; o.x = pack2(o0, o1); o.y = pack2(o2, o3);
            *(uint2*)(ZS + (size_t)m * 2048 + n) = o;
          } else {
            uint2 o; o.x = pack2(v[0], v[1]); o.y = pack2(v[2], v[3]);
            *(uint2*)(VB + (size_t)m * 2048 + n) = o;
            float* vo = m < TP ? p.out + OFF_V_P + (size_t)m * 2048 : p.out + OFF_V_S + (size_t)(m - TP) * 2048;
            *(float4*)(vo + n) = make_float4(v[0], v[1], v[2], v[3]);
          }
        }
      }
    }
  }
}
}

DEV unsigned off_b(unsigned row, unsigned ch) { return 256u * row + 16u * (ch ^ (((row & 3) << 2) | ((row >> 2) & 3))); }

DEV void phase_attn(const Params& p, char* smem) {
  const int tid = threadIdx.x, lane = tid & 63, w = tid >> 6, fr = lane & 15, fq = lane >> 4;
  char* ws = p.ws;
  const u16* KB = (const u16*)(ws + 2 * SLOT);
  const u16* VB = (const u16*)(ws + 3 * SLOT);
  const u16* QB = (const u16*)(ws + 4 * SLOT);
  const u16* ZS = (const u16*)(ws + 5 * SLOT);
  u16* OG = (u16*)(ws + 6 * SLOT);
  const int lrow = tid >> 4, lch = tid & 15;
  const unsigned lw0 = off_b(lrow, lch), lw1 = off_b(lrow + 32, lch);
  const int tq = (lane & 15) >> 2, tp = lane & 3;

  for (int item = blockIdx.x; item < 4096 + 256; item += gridDim.x) {
    int b, h, nq, qpos0, tokq0, ntiles, nkeys, tokk0; bool sample;
    if (item < 4096) {
      const int qblk = 31 - (item >> 7), bh = item & 127;
      b = bh >> 4; h = bh & 15; nq = 128; qpos0 = qblk * 128; tokq0 = b * 4096 + qpos0; ntiles = 2 * qblk + 2; nkeys = qpos0 + 128; tokk0 = b * 4096; sample = false;
    } else {
      const int bh = item - 4096;
      b = bh >> 4; h = bh & 15; nq = 32; qpos0 = 1024; tokq0 = TP + b * 32; ntiles = 17; nkeys = 1056; tokk0 = TP + b * 32 - 1024; sample = true;
    }
    const bool wactive = (w * 16) < nq;
    int* dflag = (int*)(smem + 65536);
    __syncthreads();
    if (lane == 0) dflag[w] = wactive ? 0 : 1;
    bool wdone = !wactive;
    const int qp = qpos0 + w * 16 + fr;
    const int qwmax = qpos0 + w * 16 + 15;
    bf16x8 qf[4];
#pragma unroll
    for (int ks = 0; ks < 4; ++ks) {
      if (wactive) qf[ks] = *(const bf16x8*)(QB + (size_t)(tokq0 + w * 16 + fr) * 2048 + h * 128 + ks * 32 + fq * 8);
      else qf[ks] = (bf16x8){0, 0, 0, 0, 0, 0, 0, 0};
    }
    f32x4 O[8];
#pragma unroll
    for (int dt = 0; dt < 8; ++dt) O[dt] = (f32x4){0, 0, 0, 0};
    float carry = 0.f;

    uint4 lk0, lk1, lv0, lv1;
#define ATT_LOAD(kb)                                                                                  \
    {                                                                                                 \
      const int kx0_ = (kb) * 64 + lrow, kx1_ = kx0_ + 32;                                            \
      if (sample && (kb) < 16) {                                                                      \
        const float* ck_ = p.in[I_CK] + ((size_t)(b * 1024 + kx0_) * 16 + h) * 128 + lch * 8;         \
        const float* cv_ = p.in[I_CV] + ((size_t)(b * 1024 + kx0_) * 16 + h) * 128 + lch * 8;         \
        float4 a_ = *(const float4*)ck_, b_ = *(const float4*)(ck_ + 4);                              \
        float4 c_ = *(const float4*)(ck_ + 32 * 2048), d_ = *(const float4*)(ck_ + 32 * 2048 + 4);    \
        lk0 = make_uint4(pack2(a_.x, a_.y), pack2(a_.z, a_.w), pack2(b_.x, b_.y), pack2(b_.z, b_.w)); \
        lk1 = make_uint4(pack2(c_.x, c_.y), pack2(c_.z, c_.w), pack2(d_.x, d_.y), pack2(d_.z, d_.w)); \
        a_ = *(const float4*)cv_; b_ = *(const float4*)(cv_ + 4);                                     \
        c_ = *(const float4*)(cv_ + 32 * 2048); d_ = *(const float4*)(cv_ + 32 * 2048 + 4);           \
        lv0 = make_uint4(pack2(a_.x, a_.y), pack2(a_.z, a_.w), pack2(b_.x, b_.y), pack2(b_.z, b_.w)); \
        lv1 = make_uint4(pack2(c_.x, c_.y), pack2(c_.z, c_.w), pack2(d_.x, d_.y), pack2(d_.z, d_.w)); \
      } else {                                                                                        \
        const size_t o0_ = (size_t)(tokk0 + kx0_) * 2048 + h * 128 + lch * 8;                         \
        const size_t o1_ = o0_ + (size_t)32 * 2048;                                                   \
        if (kx0_ < nkeys) { lk0 = *(const uint4*)(KB + o0_); lv0 = *(const uint4*)(VB + o0_); }       \
        else { lk0 = make_uint4(0, 0, 0, 0); lv0 = lk0; }                                             \
        if (kx1_ < nkeys) { lk1 = *(const uint4*)(KB + o1_); lv1 = *(const uint4*)(VB + o1_); }       \
        else { lk1 = make_uint4(0, 0, 0, 0); lv1 = lk1; }                                             \
      }                                                                                               \
    }
#define ATT_STORE(st)                                                                                 \
    {                                                                                                 \
      char* sK_ = smem + (st) * 32768; char* sV_ = sK_ + 16384;                                       \
      *(uint4*)(sK_ + lw0) = lk0; *(uint4*)(sK_ + lw1) = lk1;                                         \
      *(uint4*)(sV_ + lw0) = lv0; *(uint4*)(sV_ + lw1) = lv1;                                         \
    }
    ATT_LOAD(ntiles - 1);
    ATT_STORE(0);
    __syncthreads();
    for (int it = 0; it < ntiles; ++it) {
      const int kb = ntiles - 1 - it, st = it & 1;
      if (it + 1 < ntiles) ATT_LOAD(kb - 1);
      if (!wdone && kb * 64 < qwmax) {
        const char* sK = smem + st * 32768;
        const char* sV = sK + 16384;
        f32x4 S[4];
#pragma unroll
        for (int mt = 0; mt < 4; ++mt) S[mt] = (f32x4){0, 0, 0, 0};
#pragma unroll
        for (int ks = 0; ks < 4; ++ks)
#pragma unroll
          for (int mt = 0; mt < 4; ++mt) {
            bf16x8 a = *(const bf16x8*)(sK + off_b(mt * 16 + fr, ks * 4 + fq));
            S[mt] = __builtin_amdgcn_mfma_f32_16x16x32_bf16(a, qf[ks], S[mt], 0, 0, 0);
          }
        bf16x8 wf[2];
        {
          float ee[4][4], tot[4], hi[4];
#pragma unroll
          for (int mt = 0; mt < 4; ++mt) {
            const int kbase = kb * 64 + mt * 16 + fq * 4;
            float ls[4];
#pragma unroll
            for (int jj = 0; jj < 4; ++jj) {
              const float u = S[mt][jj];
              const bool valid = (kbase + jj) < qp;
              const float l = -__builtin_amdgcn_logf(1.0f + __builtin_amdgcn_exp2f(u));
              ls[jj] = valid ? l : 0.f;
              ee[mt][jj] = valid ? (u + l) : -1e30f;
            }
            const float x3 = ls[3], x2 = x3 + ls[2], x1 = x2 + ls[1], seg = x1 + ls[0];
            ee[mt][2] += x3; ee[mt][1] += x2; ee[mt][0] += x1;
            const float t1 = __shfl_xor(seg, 16), t2 = __shfl_xor(seg, 32), t3 = __shfl_xor(t1, 32);
            tot[mt] = seg + t1 + t2 + t3;
            hi[mt] = fq == 0 ? (t1 + t2 + t3) : fq == 1 ? (t2 + t3) : fq == 2 ? t1 : 0.f;
          }
          float run = carry;
          float wv[4][4];
#pragma unroll
          for (int mt = 3; mt >= 0; --mt) {
            const float base = run + hi[mt];
            run += tot[mt];
#pragma unroll
            for (int jj = 0; jj < 4; ++jj) wv[mt][jj] = __builtin_amdgcn_exp2f(ee[mt][jj] + base);
          }
          carry = run;
          if (__all(carry < -150.0f)) { wdone = true; if (lane == 0) dflag[w] = 1; }
#pragma unroll
          for (int p2 = 0; p2 < 2; ++p2) {
            uint4 pk;
            pk.x = pack2(wv[2 * p2][0], wv[2 * p2][1]); pk.y = pack2(wv[2 * p2][2], wv[2 * p2][3]);
            pk.z = pack2(wv[2 * p2 + 1][0], wv[2 * p2 + 1][1]); pk.w = pack2(wv[2 * p2 + 1][2], wv[2 * p2 + 1][3]);
            wf[p2] = *(bf16x8*)&pk;
          }
        }
#pragma unroll
        for (int p2 = 0; p2 < 2; ++p2)
#pragma unroll
          for (int dt = 0; dt < 8; ++dt) {
            const unsigned r0 = 32 * p2 + 4 * fq + tq, r1 = r0 + 16;
            const unsigned ch = 2 * dt + (tp >> 1);
            const char* a0 = sV + off_b(r0, ch) + 8 * (tp & 1);
            const char* a1 = sV + off_b(r1, ch) + 8 * (tp & 1);
            s16x4 lo = __builtin_amdgcn_ds_read_tr16_b64_v4i16((s16x4 __attribute__((address_space(3)))*)(a0));
            s16x4 hi4 = __builtin_amdgcn_ds_read_tr16_b64_v4i16((s16x4 __attribute__((address_space(3)))*)(a1));
            bf16x8 a = {lo[0], lo[1], lo[2], lo[3], hi4[0], hi4[1], hi4[2], hi4[3]};
            O[dt] = __builtin_amdgcn_mfma_f32_16x16x32_bf16(a, wf[p2], O[dt], 0, 0, 0);
          }
      }
      if (it + 1 < ntiles) ATT_STORE(st ^ 1);
      __syncthreads();
      {
        const int4 f0 = *(const int4*)dflag, f1 = *(const int4*)(dflag + 4);
        if (f0.x & f0.y & f0.z & f0.w & f1.x & f1.y & f1.z & f1.w) break;
      }
    }
#undef ATT_LOAD
#undef ATT_STORE
    if (wactive) {
      const size_t rowoff = (size_t)(tokq0 + w * 16 + fr) * 2048 + h * 128;
#pragma unroll
      for (int dt = 0; dt < 8; ++dt) {
        const int d = dt * 16 + fq * 4;
        uint2 z = *(const uint2*)(ZS + rowoff + d);
        f32x4 v = O[dt];
        uint2 o;
        o.x = pack2(v[0] * bflo(z.x), v[1] * bfhi(z.x)); o.y = pack2(v[2] * bflo(z.y), v[3] * bfhi(z.y));
        *(uint2*)(OG + rowoff + d) = o;
      }
    }
  }
}


DEV void grid_barrier(unsigned* bar, unsigned target) {
  __syncthreads();
  if (threadIdx.x == 0) {
    __builtin_amdgcn_fence(__ATOMIC_RELEASE, "agent");
    asm volatile("s_waitcnt vmcnt(0)" ::: "memory");
    __hip_atomic_fetch_add(bar, 1u, __ATOMIC_RELAXED, __HIP_MEMORY_SCOPE_AGENT);
    while (__hip_atomic_load(bar, __ATOMIC_RELAXED, __HIP_MEMORY_SCOPE_AGENT) < target) __builtin_amdgcn_s_sleep(1);
    __builtin_amdgcn_fence(__ATOMIC_ACQUIRE, "agent");
    asm volatile("s_waitcnt vmcnt(0)" ::: "memory");
  }
  __syncthreads();
}

__global__ void __launch_bounds__(NTHREADS) __attribute__((target("no-packed-fp32-ops"))) mega(Params p, int lo, int hi) {
  __shared__ __attribute__((aligned(16))) char smem[147456];
  cg::grid_group grid = cg::this_grid();
#ifndef PROBE_DOUBLE
#define PROBE_DOUBLE -1
#endif
#define RUN_PHASE(k, call) if ((k) >= lo && (k) < hi) { if ((k) > lo) { if ((k) == lo + 1) grid.sync(); else grid_barrier((unsigned*)(p.ws + WS_BAR), (unsigned)((k) - lo - 1) * gridDim.x); } call; }
  RUN_PHASE(0, phase_prep(p, smem))
  RUN_PHASE(1, phase_norm0(p))
  RUN_PHASE(2, phase_proj0(p, smem))
  RUN_PHASE(3, phase_scan(p, smem))
  RUN_PHASE(4, phase_outproj<0>(p, smem))
  RUN_PHASE(5, phase_norm1(p))
  RUN_PHASE(6, phase_proj1(p, smem))
  RUN_PHASE(7, phase_attn(p, smem))
  RUN_PHASE(8, phase_outproj<1>(p, smem))
}

#ifndef N_LAUNCH_MODE
#define N_LAUNCH_MODE 1
#endif

extern "C" void kernel_launch(void* const* d_in, const int* in_sizes, int n_in, void* d_out, int out_size, void* d_ws, size_t ws_size,
                              hipStream_t stream) {
  Params p{};
  for (int i = 0; i < 36; ++i) p.in[i] = (const float*)d_in[i];
  p.out = (float*)d_out;
  p.ws = (char*)d_ws;
  static int grid_blocks = 0;
  if (!grid_blocks) {
    int dev = 0, cus = 0, per_cu = 0;
    hipGetDevice(&dev);
    hipDeviceGetAttribute(&cus, hipDeviceAttributeMultiprocessorCount, dev);
    hipOccupancyMaxActiveBlocksPerMultiprocessor(&per_cu, mega, NTHREADS, 0);
    if (per_cu < 1) per_cu = 1;
    grid_blocks = cus * per_cu;
  }
  if (ws_size < WS_END) { fprintf(stderr, "workspace too small: %zu < %llu\n", ws_size, (unsigned long long)WS_END); return; }
#if N_LAUNCH_MODE == 1
  int lo = 0, hi = 9;
  hipMemsetAsync((char*)d_ws + WS_BAR, 0, 256, stream);
  void* args[] = {&p, &lo, &hi};
  hipError_t e = hipLaunchCooperativeKernel((void*)mega, dim3(grid_blocks), dim3(NTHREADS), args, 0, stream);
  if (e != hipSuccess) fprintf(stderr, "cooperative launch failed: %s (grid %d)\n", hipGetErrorString(e), grid_blocks);
#else
  for (int ph = 0; ph < 9; ++ph) hipLaunchKernelGGL(mega, dim3(grid_blocks), dim3(NTHREADS), 0, stream, p, ph, ph + 1);
#endif
}
```

```cpp
#include <hip/hip_runtime.h>
#include <hip/hip_cooperative_groups.h>
#include <cstdio>
namespace cg = cooperative_groups;

typedef unsigned short u16;
typedef short bf16x8 __attribute__((ext_vector_type(8)));
typedef short s16x4 __attribute__((ext_vector_type(4)));
typedef float f32x4 __attribute__((ext_vector_type(4)));
typedef float f32x2 __attribute__((ext_vector_type(2)));
typedef __bf16 bf16x2_t __attribute__((ext_vector_type(2)));

#define DEV __device__ __forceinline__

#define NTOK 33280
#define TP 32768
#define NTHREADS 512

#define OFF_Y_P 0
#define OFF_Y_S 33554432
#define OFF_K_P 34078720
#define OFF_V_P 101187584
#define OFF_WKV_P 168296448
#define OFF_SH_P 169345024
#define OFF_K_S 169353216
#define OFF_V_S 170401792
#define OFF_WKV_S 171450368
#define OFF_SH_S 173547520

#define SLOT 136314880ull
#define WS_W (7ull * SLOT)
#define WS_WT_IN (WS_W)
#define WS_WT_OUTA (WS_WT_IN + 16777216ull)
#define WS_WT_KV (WS_WT_OUTA + 4194304ull)
#define WS_WT_INB (WS_WT_KV + 8388608ull)
#define WS_WT_OUTB (WS_WT_INB + 8388608ull)
#define WS_W2T (WS_WT_OUTB + 4194304ull)
#define WS_A2T (WS_W2T + 262144ull)
#define WS_L1T (WS_A2T + 262144ull)
#define WS_MOD (WS_L1T + 524288ull)
#define WS_SH (WS_MOD + 589824ull)
#define WS_CTR (WS_SH + 49152ull)
#define WS_BAR (WS_CTR + 4096ull)
#define WS_END (WS_BAR + 256ull)
#define WS_H0 (6ull * SLOT)
#define WS_T (6ull * SLOT + 68157440ull)

struct Params {
  const float* in[36];
  float* out;
  char* ws;
};

enum { I_XP = 0, I_XS, I_CK, I_CV, I_SWKV, I_SSH, I_CP, I_CS, I_ANG, I_AADAW, I_AADAB, I_AWIN, I_AMUIN, I_AMUW, I_AMUA,
       I_AW0, I_AW1, I_AW2, I_AA0, I_AA1, I_AA2, I_AKK, I_AKA, I_ARK, I_ALNG, I_ALNB, I_AWOUT, I_KVNG, I_KVW, I_KGAIN,
       I_BNG, I_BADAW, I_BADAB, I_BWIN, I_BQG, I_BWOUT };

DEV int seq_of(int t) { return t < TP ? (t >> 12) : 8 + ((t - TP) >> 5); }
DEV bool seq_start(int t) { return t < TP ? ((t & 4095) == 0) : (((t - TP) & 31) == 0); }

DEV unsigned pack2(float a, float b) {
  f32x2 v = {a, b};
  bf16x2_t r = __builtin_convertvector(v, bf16x2_t);
  return *(unsigned*)&r;
}
DEV float bflo(unsigned w) { return __uint_as_float(w << 16); }
DEV float bfhi(unsigned w) { return __uint_as_float(w & 0xffff0000u); }
DEV void unpack8(const uint4& x, float* f) {
  f[0] = bflo(x.x); f[1] = bfhi(x.x); f[2] = bflo(x.y); f[3] = bfhi(x.y);
  f[4] = bflo(x.z); f[5] = bfhi(x.z); f[6] = bflo(x.w); f[7] = bfhi(x.w);
}
DEV float sigmoidf_(float x) { return 1.0f / (1.0f + __expf(-x)); }

template <int CTRL>
DEV float dppf(float x) {
  return __int_as_float(__builtin_amdgcn_update_dpp(0, __float_as_int(x), CTRL, 0xf, 0xf, true));
}
DEV float red4(float x) { x += dppf<0xB1>(x); x += dppf<0x4E>(x); return x; }
DEV float red8(float x) { x = red4(x); x += dppf<0x141>(x); return x; }
DEV float red16(float x) { x = red8(x); x += dppf<0x140>(x); return x; }
DEV float wave_sum(float x) {
#pragma unroll
  for (int o = 32; o >= 1; o >>= 1) x += __shfl_xor(x, o);
  return x;
}


#define SCHED_SLOT_OFF 147440
DEV int xcc_id() { return (int)(__builtin_amdgcn_s_getreg((3 << 11) | 20) & 0x7u); }
DEV unsigned* sched_ctr(const Params& p, int phase_slot, int list) { return (unsigned*)(p.ws + WS_CTR) + (phase_slot * 8 + list) * 16; }
DEV int sched_first(unsigned* ctr, char* smem) {
  int* slot = (int*)(smem + SCHED_SLOT_OFF);
  __syncthreads();
  if (threadIdx.x == 0) *slot = (int)atomicAdd(ctr, 1u);
  __syncthreads();
  return *slot;
}

DEV void group_sync(unsigned* bar, unsigned target) {
  __syncthreads();
  if (threadIdx.x == 0) {
    __hip_atomic_fetch_add(bar, 1u, __ATOMIC_RELAXED, __HIP_MEMORY_SCOPE_AGENT);
    while (__hip_atomic_load(bar, __ATOMIC_RELAXED, __HIP_MEMORY_SCOPE_AGENT) < target) __builtin_amdgcn_s_sleep(2);
  }
  __syncthreads();
}
DEV int sched_prefetch(unsigned* ctr) { return threadIdx.x == 0 ? (int)atomicAdd(ctr, 1u) : 0; }
DEV int sched_commit(int nxt, char* smem) {
  int* slot = (int*)(smem + SCHED_SLOT_OFF);
  __syncthreads();
  if (threadIdx.x == 0) *slot = nxt;
  __syncthreads();
  return *slot;
}

#define GEMM_STAGE_BYTES 49152

template <int AMODE>
DEV void gemm_main(f32x4 (&acc)[4][4], const u16* __restrict__ A, int lda, const u16* __restrict__ Bt, int ldb, int nk,
                   int m0, int n0, const float* __restrict__ mu, const u16* __restrict__ SH, char* smem) {
  const int tid = threadIdx.x, lane = tid & 63, wid = tid >> 6, wr = wid >> 1, wc = wid & 1, fr = lane & 15, fq = lane >> 4;
  const int lrow = tid >> 3, lch = tid & 7;
#pragma unroll
  for (int i = 0; i < 4; ++i)
#pragma unroll
    for (int j = 0; j < 4; ++j) acc[i][j] = (f32x4){0.f, 0.f, 0.f, 0.f};

  const u16* pa0; const u16* pa1; const u16* pa2; const u16* pa3;
  const u16* pp0 = nullptr;
  const int arow = 4 * lrow;
  {
    int m = m0 + arow;
    pa0 = A + (size_t)m * lda + lch * 8;
    pa1 = pa0 + lda; pa2 = pa1 + lda; pa3 = pa2 + lda;
    if (AMODE != 0) pp0 = seq_start(m) ? SH + seq_of(m) * 1024 + lch * 8 : pa0 - lda;
  }
  const u16* pb0 = Bt + (size_t)(n0 + lrow) * ldb + lch * 8;
  const u16* pb1 = pb0 + (size_t)64 * ldb;
  const int woffB = lrow * 128 + ((lch ^ ((lrow >> 1) & 7)) << 4);
  const int woffA0 = (arow + 0) * 128 + ((lch ^ (((arow + 0) >> 1) & 7)) << 4);
  const int woffA1 = (arow + 1) * 128 + ((lch ^ (((arow + 1) >> 1) & 7)) << 4);
  const int woffA2 = (arow + 2) * 128 + ((lch ^ (((arow + 2) >> 1) & 7)) << 4);
  const int woffA3 = (arow + 3) * 128 + ((lch ^ (((arow + 3) >> 1) & 7)) << 4);

  uint4 ra0, ra1, ra2, ra3, rp0, rb0, rb1;
  float4 mu0, mu1;
  rp0 = make_uint4(0, 0, 0, 0);
  mu0 = mu1 = make_float4(0, 0, 0, 0);

#define G_LOAD(kt)                                                                     \
  {                                                                                    \
    const int k0_ = (kt) * 64;                                                         \
    if (AMODE == 0) {                                                                  \
      ra0 = *(const uint4*)(pa0 + k0_); ra1 = *(const uint4*)(pa1 + k0_);              \
      ra2 = *(const uint4*)(pa2 + k0_); ra3 = *(const uint4*)(pa3 + k0_);              \
    } else if (AMODE == 1) {                                                           \
      ra0 = *(const uint4*)(pa0 + k0_); ra1 = *(const uint4*)(pa1 + k0_);              \
      ra2 = *(const uint4*)(pa2 + k0_); ra3 = *(const uint4*)(pa3 + k0_);              \
      rp0 = *(const uint4*)(pp0 + k0_);                                                \
      mu0 = *(const float4*)(mu + k0_ + lch * 8); mu1 = *(const float4*)(mu + k0_ + lch * 8 + 4); \
    } else {                                                                           \
      const int kk_ = k0_ & 1023;                                                      \
      ra0 = *(const uint4*)(pa0 + kk_); ra1 = *(const uint4*)(pa1 + kk_);              \
      ra2 = *(const uint4*)(pa2 + kk_); ra3 = *(const uint4*)(pa3 + kk_);              \
      if (k0_ >= 1024) rp0 = *(const uint4*)(pp0 + kk_);                               \
    }                                                                                  \
    rb0 = *(const uint4*)(pb0 + k0_); rb1 = *(const uint4*)(pb1 + k0_);                \
  }

#define G_XFORM(dst, a_, p_, kt)                                                       \
  {                                                                                    \
    if (AMODE == 0) dst = a_;                                                          \
    else if (AMODE == 1) {                                                             \
      float h_[8], q_[8]; unpack8(a_, h_); unpack8(p_, q_);                            \
      dst.x = pack2(h_[0] + mu0.x * (q_[0] - h_[0]), h_[1] + mu0.y * (q_[1] - h_[1])); \
      dst.y = pack2(h_[2] + mu0.z * (q_[2] - h_[2]), h_[3] + mu0.w * (q_[3] - h_[3])); \
      dst.z = pack2(h_[4] + mu1.x * (q_[4] - h_[4]), h_[5] + mu1.y * (q_[5] - h_[5])); \
      dst.w = pack2(h_[6] + mu1.z * (q_[6] - h_[6]), h_[7] + mu1.w * (q_[7] - h_[7])); \
    } else {                                                                           \
      if ((kt) * 64 >= 1024) {                                                         \
        float h_[8], q_[8]; unpack8(a_, h_); unpack8(p_, q_);                          \
        dst.x = pack2(q_[0] - h_[0], q_[1] - h_[1]); dst.y = pack2(q_[2] - h_[2], q_[3] - h_[3]); \
        dst.z = pack2(q_[4] - h_[4], q_[5] - h_[5]); dst.w = pack2(q_[6] - h_[6], q_[7] - h_[7]); \
      } else dst = a_;                                                                 \
    }                                                                                  \
  }

#define G_STORE(stage, kt)                                                             \
  {                                                                                    \
    char* sA_ = smem + (stage) * GEMM_STAGE_BYTES; char* sB_ = sA_ + 32768;            \
    uint4 v_;                                                                          \
    G_XFORM(v_, ra0, rp0, kt); *(uint4*)(sA_ + woffA0) = v_;                           \
    G_XFORM(v_, ra1, ra0, kt); *(uint4*)(sA_ + woffA1) = v_;                           \
    G_XFORM(v_, ra2, ra1, kt); *(uint4*)(sA_ + woffA2) = v_;                           \
    G_XFORM(v_, ra3, ra2, kt); *(uint4*)(sA_ + woffA3) = v_;                           \
    *(uint4*)(sB_ + woffB) = rb0; *(uint4*)(sB_ + woffB + 64 * 128) = rb1;             \
  }

  G_LOAD(0);
  G_STORE(0, 0);
  __syncthreads();
  const int rsw = (fr >> 1) & 7;
  for (int kt = 0; kt < nk; ++kt) {
    const int st = kt & 1;
    if (kt + 1 < nk) G_LOAD(kt + 1);
    __builtin_amdgcn_sched_barrier(0);
    {
      const char* sA = smem + st * GEMM_STAGE_BYTES;
      const char* sB = sA + 32768;
#pragma unroll
      for (int kk = 0; kk < 2; ++kk) {
        bf16x8 af[4], bfr[4];
        const int cho = ((kk * 4 + fq) ^ rsw) << 4;
#pragma unroll
        for (int i = 0; i < 4; ++i) af[i] = *(const bf16x8*)(sA + (wr * 64 + i * 16 + fr) * 128 + cho);
#pragma unroll
        for (int j = 0; j < 4; ++j) bfr[j] = *(const bf16x8*)(sB + (wc * 64 + j * 16 + fr) * 128 + cho);
#pragma unroll
        for (int i = 0; i < 4; ++i)
#pragma unroll
          for (int j = 0; j < 4; ++j) acc[i][j] = __builtin_amdgcn_mfma_f32_16x16x32_bf16(bfr[j], af[i], acc[i][j], 0, 0, 0);
      }
    }
    if (kt + 1 < nk) G_STORE(st ^ 1, kt + 1);
    __syncthreads();
  }
#undef G_LOAD
#undef G_XFORM
#undef G_STORE
}


#define G2_STAGE_BYTES 32768
#define G2_MU_OFF (3 * G2_STAGE_BYTES)
DEV int g2_swz(int row) { return (0x78 >> (2 * ((row >> 2) & 3))) & 3; }
template <int AMODE>
DEV void gemm_main256(f32x4 (&acc)[8][4], const u16* __restrict__ A, int lda, const u16* __restrict__ Bt, int ldb, int nk64,
                      int m0, int n0, const float* __restrict__ mu, const u16* __restrict__ SH, char* smem) {
  const int tid = threadIdx.x, lane = tid & 63, wid = tid >> 6, wr = wid >> 2, wc = wid & 3, fr = lane & 15, fq = lane >> 4;
  const int nk = nk64 * 2;
  const int lrow2 = 2 * (tid >> 2), lch = tid & 3;
#pragma unroll
  for (int i = 0; i < 8; ++i)
#pragma unroll
    for (int j = 0; j < 4; ++j) acc[i][j] = (f32x4){0.f, 0.f, 0.f, 0.f};
  const u16* pa0 = A + (size_t)(m0 + lrow2) * lda + lch * 8;
  const u16* pp0 = nullptr;
  if (AMODE != 0) pp0 = seq_start(m0 + lrow2) ? SH + seq_of(m0 + lrow2) * 1024 + lch * 8 : pa0 - lda;
  const u16* pb0 = Bt + (size_t)(n0 + lrow2) * ldb + lch * 8;
  const int woff0 = (lrow2 + 0) * 64 + ((lch ^ g2_swz(lrow2 + 0)) << 4);
  const int woff1 = (lrow2 + 1) * 64 + ((lch ^ g2_swz(lrow2 + 1)) << 4);
  const float* muL = (const float*)(smem + G2_MU_OFF);
  if (AMODE == 1) {
    if (tid < 256) *(float4*)(smem + G2_MU_OFF + tid * 16) = *(const float4*)(mu + tid * 4);
  }
  uint4 xa0, xa1, xp, xb0, xb1;
  uint4 ya0, ya1, yp, yb0, yb1;
  xp = yp = make_uint4(0, 0, 0, 0);

#define K_LOAD(S, kt)                                                                  \
  {                                                                                    \
    const int k0_ = (kt) * 32;                                                         \
    S##a0 = *(const uint4*)(pa0 + k0_); S##a1 = *(const uint4*)(pa0 + lda + k0_);      \
    if (AMODE == 1) S##p = *(const uint4*)(pp0 + k0_);                                 \
    S##b0 = *(const uint4*)(pb0 + k0_); S##b1 = *(const uint4*)(pb0 + ldb + k0_);      \
  }
#define K_XFORM(dst, a_, p_)                                                           \
  {                                                                                    \
    if (AMODE == 0) dst = a_;                                                          \
    else {                                                                             \
      float h_[8], q_[8]; unpack8(a_, h_); unpack8(p_, q_);                            \
      dst.x = pack2(h_[0] + mu0.x * (q_[0] - h_[0]), h_[1] + mu0.y * (q_[1] - h_[1])); \
      dst.y = pack2(h_[2] + mu0.z * (q_[2] - h_[2]), h_[3] + mu0.w * (q_[3] - h_[3])); \
      dst.z = pack2(h_[4] + mu1.x * (q_[4] - h_[4]), h_[5] + mu1.y * (q_[5] - h_[5])); \
      dst.w = pack2(h_[6] + mu1.z * (q_[6] - h_[6]), h_[7] + mu1.w * (q_[7] - h_[7])); \
    }                                                                                  \
  }
#define K_STORE(S, stage, kt)                                                          \
  {                                                                                    \
    char* sA_ = smem + (stage) * G2_STAGE_BYTES; char* sB_ = sA_ + 16384;              \
    uint4 v_; float4 mu0, mu1;                                                         \
    if (AMODE == 1) { mu0 = *(const float4*)(muL + (kt) * 32 + lch * 8); mu1 = *(const float4*)(muL + (kt) * 32 + lch * 8 + 4); } \
    K_XFORM(v_, S##a0, S##p); *(uint4*)(sA_ + woff0) = v_;                             \
    K_XFORM(v_, S##a1, S##a0); *(uint4*)(sA_ + woff1) = v_;                            \
    *(uint4*)(sB_ + woff0) = S##b0; *(uint4*)(sB_ + woff1) = S##b1;                    \
  }
#define K_COMPUTE_HALF(stage, i0)                                                      \
  {                                                                                    \
    const char* sA_ = smem + (stage) * G2_STAGE_BYTES;                                 \
    _Pragma("unroll") for (int i = (i0); i < (i0) + 4; ++i) {                          \
      const bf16x8 af = *(const bf16x8*)(sA_ + (wr * 128 + i * 16 + fr) * 64 + cho);   \
      _Pragma("unroll") for (int j = 0; j < 4; ++j) acc[i][j] = __builtin_amdgcn_mfma_f32_16x16x32_bf16(bfr[j], af, acc[i][j], 0, 0, 0); \
    }                                                                                  \
  }
#define K_LOAD_B(stage)                                                                \
  {                                                                                    \
    const char* sB_ = smem + (stage) * G2_STAGE_BYTES + 16384;                         \
    _Pragma("unroll") for (int j = 0; j < 4; ++j) bfr[j] = *(const bf16x8*)(sB_ + (wc * 64 + j * 16 + fr) * 64 + cho); \
  }
#define K_ITER(kt, L, S)                                                               \
  {                                                                                    \
    K_LOAD(L, min((kt) + 2, nk - 1));                                                  \
    __builtin_amdgcn_sched_barrier(0);                                                 \
    bf16x8 bfr[4];                                                                     \
    K_LOAD_B(cu);                                                                      \
    K_COMPUTE_HALF(cu, 0);                                                             \
    __builtin_amdgcn_sched_barrier(0);                                                 \
    K_STORE(S, nx, min((kt) + 1, nk - 1));                                             \
    __builtin_amdgcn_sched_barrier(0);                                                 \
    if (AMODE == 1) K_LOAD_B(cu);                                                      \
    K_COMPUTE_HALF(cu, 4);                                                             \
    __syncthreads();                                                                   \
    cu = nx; nx = (nx == 2) ? 0 : nx + 1;                                              \
  }
  const int cho = (fq ^ g2_swz(fr)) << 4;
  if (AMODE == 1) __syncthreads();
  K_LOAD(x, 0);
  K_LOAD(y, 1);
  K_STORE(x, 0, 0);
  __syncthreads();
  int cu = 0, nx = 1;
  for (int kt = 0; kt < nk; kt += 2) {
    K_ITER(kt, x, y);
    K_ITER(kt + 1, y, x);
  }
#undef K_LOAD
#undef K_XFORM
#undef K_STORE
#undef K_COMPUTE_HALF
#undef K_LOAD_B
#undef K_ITER
}


#define GD_NST 4
DEV void gemm_main256_dma(f32x4 (&acc)[8][4], const u16* __restrict__ A, int lda, const u16* __restrict__ Bt, int ldb, int nk64,
                          int m0, int n0, char* smem) {
  const int tid = threadIdx.x, lane = tid & 63, wid = tid >> 6, wr = wid >> 2, wc = wid & 3, fr = lane & 15, fq = lane >> 4;
  const int nk = nk64 * 2;
#pragma unroll
  for (int i = 0; i < 8; ++i)
#pragma unroll
    for (int j = 0; j < 4; ++j) acc[i][j] = (f32x4){0.f, 0.f, 0.f, 0.f};
  const int prow = 16 * wid + (lane >> 2);
  const int pch = (lane & 3) ^ g2_swz(prow);
  const u16* srcA = A + (size_t)(m0 + prow) * lda + pch * 8;
  const u16* srcB = Bt + (size_t)(n0 + prow) * ldb + pch * 8;
  const size_t a128 = (size_t)128 * lda, b128 = (size_t)128 * ldb;
  char* ldsw = smem + (16 * wid) * 64;
#define D_FILL(kt, stage)                                                              \
  {                                                                                    \
    const int k0_ = (kt) * 32;                                                         \
    char* d_ = ldsw + (stage) * G2_STAGE_BYTES;                                        \
    __builtin_amdgcn_global_load_lds((const unsigned*)(srcA + k0_), (unsigned*)(d_), 16, 0, 0);               \
    __builtin_amdgcn_global_load_lds((const unsigned*)(srcA + a128 + k0_), (unsigned*)(d_ + 8192), 16, 0, 0); \
    __builtin_amdgcn_global_load_lds((const unsigned*)(srcB + k0_), (unsigned*)(d_ + 16384), 16, 0, 0);       \
    __builtin_amdgcn_global_load_lds((const unsigned*)(srcB + b128 + k0_), (unsigned*)(d_ + 16384 + 8192), 16, 0, 0); \
  }
  const int cho = (fq ^ g2_swz(fr)) << 4;
  __syncthreads();
  D_FILL(0, 0);
  D_FILL(min(1, nk - 1), 1);
  D_FILL(min(2, nk - 1), 2);
  int cu = 0, fill = 3;
  for (int kt = 0; kt < nk; ++kt) {
    asm volatile("s_waitcnt vmcnt(8)" ::: "memory");
    asm volatile("s_waitcnt lgkmcnt(0)" ::: "memory");
    __builtin_amdgcn_s_barrier();
    D_FILL(min(kt + 3, nk - 1), fill);
    {
      const char* sA_ = smem + cu * G2_STAGE_BYTES;
      const char* sB_ = sA_ + 16384;
      bf16x8 bfr[4];
#pragma unroll
      for (int j = 0; j < 4; ++j) bfr[j] = *(const bf16x8*)(sB_ + (wc * 64 + j * 16 + fr) * 64 + cho);
#pragma unroll
      for (int i = 0; i < 8; ++i) {
        const bf16x8 af = *(const bf16x8*)(sA_ + (wr * 128 + i * 16 + fr) * 64 + cho);
#pragma unroll
        for (int j = 0; j < 4; ++j) acc[i][j] = __builtin_amdgcn_mfma_f32_16x16x32_bf16(bfr[j], af, acc[i][j], 0, 0, 0);
      }
    }
    cu = (cu == GD_NST - 1) ? 0 : cu + 1;
    fill = (fill == GD_NST - 1) ? 0 : fill + 1;
  }
  asm volatile("s_waitcnt vmcnt(0)" ::: "memory");
  asm volatile("s_waitcnt lgkmcnt(0)" ::: "memory");
  __builtin_amdgcn_s_barrier();
#undef D_FILL
}

DEV void transpose_tile(const float* __restrict__ src, int N, int k0, int n0, const float* __restrict__ scale, u16* __restrict__ dst,
                        int dstride, int drow0, int dcol0, char* smem) {
  float* tile = (float*)smem;
  const int tid = threadIdx.x;
#pragma unroll
  for (int i = 0; i < 2; ++i) {
    int kl = (tid >> 4) + 32 * i, n4 = (tid & 15) * 4;
    float4 v = *(const float4*)(src + (size_t)(k0 + kl) * N + n0 + n4);
    float s = scale ? scale[k0 + kl] : 1.0f;
    tile[kl * 65 + n4 + 0] = v.x * s; tile[kl * 65 + n4 + 1] = v.y * s;
    tile[kl * 65 + n4 + 2] = v.z * s; tile[kl * 65 + n4 + 3] = v.w * s;
  }
  __syncthreads();
  {
    int nl = tid >> 3, k8 = (tid & 7) * 8;
    uint4 o;
    o.x = pack2(tile[(k8 + 0) * 65 + nl], tile[(k8 + 1) * 65 + nl]);
    o.y = pack2(tile[(k8 + 2) * 65 + nl], tile[(k8 + 3) * 65 + nl]);
    o.z = pack2(tile[(k8 + 4) * 65 + nl], tile[(k8 + 5) * 65 + nl]);
    o.w = pack2(tile[(k8 + 6) * 65 + nl], tile[(k8 + 7) * 65 + nl]);
    *(uint4*)(dst + (size_t)(drow0 + n0 + nl) * dstride + dcol0 + k0 + k8) = o;
  }
  __syncthreads();
}

DEV void phase_prep(const Params& p, char* smem) {
  const int tid = threadIdx.x;
  char* ws = p.ws;
  if (blockIdx.x < 96) {
    float* cL = (float*)smem;
    float* red = (float*)(smem + 98304);
    for (int e = tid; e < 24 * 256; e += NTHREADS) {
      int s = e >> 8, k4 = (e & 255) * 4;
      float4 v = s < 8 ? *(const float4*)(p.in[I_CP] + s * 1024 + k4) : *(const float4*)(p.in[I_CS] + (s - 8) * 1024 + k4);
      *(float4*)(cL + s * 1024 + k4) = v;
    }
    __syncthreads();
    for (int item = blockIdx.x; item < 96; item += gridDim.x) {
      const int l = item / 48, j0 = (item % 48) * 64;
      const float* W = (l == 0 ? p.in[I_AADAW] : p.in[I_BADAW]);
      const float* bias = (l == 0 ? p.in[I_AADAB] : p.in[I_BADAB]);
      const int col = tid & 63, kg = tid >> 6;
      float acc[24];
#pragma unroll
      for (int s = 0; s < 24; ++s) acc[s] = 0.f;
      for (int k = kg * 128; k < kg * 128 + 128; ++k) {
        float w = W[(size_t)k * 3072 + j0 + col];
#pragma unroll
        for (int s = 0; s < 24; ++s) acc[s] += cL[s * 1024 + k] * w;
      }
#pragma unroll
      for (int s = 0; s < 24; ++s) red[(kg * 24 + s) * 64 + col] = acc[s];
      __syncthreads();
      float* mod = (float*)(ws + WS_MOD);
      for (int e = tid; e < 24 * 64; e += NTHREADS) {
        int s = e >> 6, c = e & 63;
        float t = bias[j0 + c];
#pragma unroll
        for (int g = 0; g < 8; ++g) t += red[(g * 24 + s) * 64 + c];
        mod[(size_t)(l * 24 + s) * 3072 + j0 + c] = t;
      }
      __syncthreads();
    }
  }
  if (blockIdx.x == 0) for (int e = tid; e < 1024; e += NTHREADS) ((unsigned*)(ws + WS_CTR))[e] = 0u;
  if (blockIdx.x == gridDim.x - 1) {
    u16* SH = (u16*)(ws + WS_SH);
    for (int e = tid; e < 24 * 1024; e += NTHREADS) {
      int s = e >> 10, k = e & 1023;
      float v = s < 8 ? 0.f : p.in[I_SSH][(s - 8) * 1024 + k];
      SH[e] = (u16)(pack2(v, 0.f) & 0xffff);
    }
  }
  const int NT_TOTAL = 2048 + 512 + 1024 + 1024 + 512 + 32 + 32 + 64;
  for (int t = blockIdx.x; t < NT_TOTAL; t += gridDim.x) {
    const float* src; int K, N; u16* dst; int dstride, drow0 = 0, dcol0 = 0; const float* scale = nullptr; int tt = t;
    if (tt < 2048) { src = p.in[I_AWIN]; K = 1024; N = 8192; dst = (u16*)(ws + WS_WT_IN); dstride = 1024; }
    else if ((tt -= 2048) < 512) { src = p.in[I_AWOUT]; K = 2048; N = 1024; dst = (u16*)(ws + WS_WT_OUTA); dstride = 2048; }
    else if ((tt -= 512) < 1024) { src = p.in[I_KVW]; K = 1024; N = 4096; dst = (u16*)(ws + WS_WT_KV); dstride = 1024; }
    else if ((tt -= 1024) < 1024) { src = p.in[I_BWIN]; K = 1024; N = 4096; dst = (u16*)(ws + WS_WT_INB); dstride = 1024; }
    else if ((tt -= 1024) < 512) { src = p.in[I_BWOUT]; K = 2048; N = 1024; dst = (u16*)(ws + WS_WT_OUTB); dstride = 2048; }
    else if ((tt -= 512) < 32) { src = p.in[I_AW2]; K = 64; N = 2048; dst = (u16*)(ws + WS_W2T); dstride = 64; }
    else if ((tt -= 32) < 32) { src = p.in[I_AA2]; K = 64; N = 2048; dst = (u16*)(ws + WS_A2T); dstride = 64; }
    else {
      tt -= 32;
      int job = tt >> 4; tt &= 15;
      K = 1024; N = 64; dst = (u16*)(ws + WS_L1T); dstride = 2048;
      src = (job < 2) ? p.in[I_AW1] : p.in[I_AA1];
      drow0 = (job < 2) ? 0 : 64;
      if (job & 1) { dcol0 = 1024; scale = (job < 2) ? p.in[I_AMUW] : p.in[I_AMUA]; }
    }
    const int ntn = N / 64;
    const int kt = tt / ntn, nt = tt % ntn;
    transpose_tile(src, N, kt * 64, nt * 64, scale, dst, dstride, drow0, dcol0, smem);
  }
}

DEV void phase_norm0(const Params& p) {
  const int lane = threadIdx.x & 63, wid = threadIdx.x >> 6;
  const float* mod = (const float*)(p.ws + WS_MOD);
  u16* H0 = (u16*)(p.ws + WS_H0);
  const float* g = p.in[I_ANG];
  for (int t = blockIdx.x * 8 + wid; t < NTOK; t += gridDim.x * 8) {
    const float* x = t < TP ? p.in[I_XP] + (size_t)t * 1024 : p.in[I_XS] + (size_t)(t - TP) * 1024;
    const int s = seq_of(t);
    const float* md = mod + (size_t)s * 3072;
    float4 v[4];
    float ss = 0.f;
#pragma unroll
    for (int i = 0; i < 4; ++i) {
      v[i] = *(const float4*)(x + lane * 4 + 256 * i);
      ss += v[i].x * v[i].x + v[i].y * v[i].y + v[i].z * v[i].z + v[i].w * v[i].w;
    }
    ss = wave_sum(ss);
    const float rstd = rsqrtf(ss * (1.0f / 1024.0f) + 1e-6f);
    bool last = t < TP ? ((t & 4095) == 4095) : (((t - TP) & 31) == 31);
    float* so = t < TP ? p.out + OFF_SH_P + (t >> 12) * 1024 : p.out + OFF_SH_S + ((t - TP) >> 5) * 1024;
#pragma unroll
    for (int i = 0; i < 4; ++i) {
      const int c = lane * 4 + 256 * i;
      float4 gg = *(const float4*)(g + c), sh = *(const float4*)(md + c), sc = *(const float4*)(md + 1024 + c);
      float4 h;
      h.x = v[i].x * rstd * gg.x * (1.f + sc.x) + sh.x;
      h.y = v[i].y * rstd * gg.y * (1.f + sc.y) + sh.y;
      h.z = v[i].z * rstd * gg.z * (1.f + sc.z) + sh.z;
      h.w = v[i].w * rstd * gg.w * (1.f + sc.w) + sh.w;
      uint2 o; o.x = pack2(h.x, h.y); o.y = pack2(h.z, h.w);
      *(uint2*)(H0 + (size_t)t * 1024 + c) = o;
      if (last) *(float4*)(so + c) = h;
    }
  }
}

DEV void phase_proj0_lora(const Params& p, char* smem) {
  const int tid = threadIdx.x, lane = tid & 63, wid = tid >> 6, fr = lane & 15, fq = lane >> 4;
  const int wr = wid >> 1, wc = wid & 1;
  char* ws = p.ws;
  const u16* H0 = (const u16*)(ws + WS_H0);
  const u16* SH = (const u16*)(ws + WS_SH);
  u16* T = (u16*)(ws + WS_T);
  const int xcc0 = xcc_id();
  int nxt;
  f32x4 acc[4][4];
  for (int ls = 0; ls < 8; ++ls) {
  const int xcd = (xcc0 + ls) & 7;
  unsigned* ctr = sched_ctr(p, 0, xcd);
  for (int li = sched_first(ctr, smem); li < 17; li = sched_commit(nxt, smem)) {
    nxt = sched_prefetch(ctr);
    const int lmt = xcd + 8 * li;
    if (lmt >= 130) continue;
    const int m0 = lmt * 256;
    gemm_main<2>(acc, H0, 1024, (const u16*)(ws + WS_L1T), 2048, 32, m0, 0, nullptr, SH, smem);
#pragma unroll
    for (int i = 0; i < 4; ++i)
#pragma unroll
      for (int j = 0; j < 4; ++j) {
        const int m = m0 + wr * 64 + i * 16 + fr, n = wc * 64 + j * 16 + fq * 4;
        f32x4 v = acc[i][j];
        if (wc == 0) { v[0] = tanhf(v[0]); v[1] = tanhf(v[1]); v[2] = tanhf(v[2]); v[3] = tanhf(v[3]); }
        uint2 o; o.x = pack2(v[0], v[1]); o.y = pack2(v[2], v[3]);
        *(uint2*)(T + (size_t)m * 128 + n) = o;
      }
    __threadfence_block();
    __syncthreads();
    for (int nt = 0; nt < 32; ++nt) {
      const int which = nt >> 4, n0 = (nt & 15) * 128;
      gemm_main<0>(acc, T + which * 64, 128, (const u16*)(ws + (which ? WS_A2T : WS_W2T)), 64, 1, m0, n0, nullptr, nullptr, smem);
      const float* bias = which ? p.in[I_AA0] : p.in[I_AW0];
      u16* dst = (u16*)(ws + (which ? 5ull : 4ull) * SLOT);
      const float sc = which ? 1.0f : -0.60653066f;
#pragma unroll
      for (int i = 0; i < 4; ++i)
#pragma unroll
        for (int j = 0; j < 4; ++j) {
          const int m = m0 + wr * 64 + i * 16 + fr, n = n0 + wc * 64 + j * 16 + fq * 4;
          float4 b4 = *(const float4*)(bias + n);
          f32x4 v = acc[i][j];
          float s0 = sc * sigmoidf_(v[0] + b4.x), s1 = sc * sigmoidf_(v[1] + b4.y), s2 = sc * sigmoidf_(v[2] + b4.z), s3 = sc * sigmoidf_(v[3] + b4.w);
          uint2 o; o.x = pack2(s0, s1); o.y = pack2(s2, s3);
          *(uint2*)(dst + (size_t)m * 2048 + n) = o;
        }
    }
  }
  }
}

DEV void phase_proj0_main(const Params& p, char* smem) {
  const int tid = threadIdx.x, lane = tid & 63, wid = tid >> 6, fr = lane & 15, fq = lane >> 4;
  const int wr = wid >> 2, wc = wid & 3;
  char* ws = p.ws;
  const u16* H0 = (const u16*)(ws + WS_H0);
  const u16* SH = (const u16*)(ws + WS_SH);
  const int xcc0 = xcc_id();
  int nxt;
  f32x4 acc[8][4];
  for (int ls = 0; ls < 8; ++ls) {
  const int xcd = (xcc0 + ls) & 7;
  unsigned* ctr = sched_ctr(p, 4, xcd);
  for (int q = sched_first(ctr, smem); q < 520; q = sched_commit(nxt, smem)) {
    nxt = sched_prefetch(ctr);
    const int mt = q >> 2, nt = 4 * xcd + (q & 3);
    const int part = nt >> 3;
    const int m0 = mt * 256, n0 = nt * 256;
    gemm_main256<1>(acc, H0, 1024, (const u16*)(ws + WS_WT_IN), 1024, 16, m0, n0, p.in[I_AMUIN] + part * 1024, SH, smem);
    u16* dst = (u16*)(ws + (size_t)part * SLOT);
    const int nb = n0 - part * 2048;
#pragma unroll
    for (int i = 0; i < 8; ++i)
#pragma unroll
      for (int j = 0; j < 4; ++j) {
        const int m = m0 + wr * 128 + i * 16 + fr, n = nb + wc * 64 + j * 16 + fq * 4;
        f32x4 v = acc[i][j];
        uint2 o; o.x = pack2(v[0], v[1]); o.y = pack2(v[2], v[3]);
        *(uint2*)(dst + (size_t)m * 2048 + n) = o;
      }
  }
  }
}

DEV void phase_proj0(const Params& p, char* smem) {
  phase_proj0_lora(p, smem);
  phase_proj0_main(p, smem);
}

DEV void phase_scan(const Params& p, char* smem) {
  const int tid = threadIdx.x, lane = tid & 63, wid = tid >> 6;
  float* Lkk = (float*)smem;
  float* Lw = Lkk + 4096;
  float* Lb = Lw + 4096;
  float* Lk = Lb + 4096;
  float* Lwr = Lk + 4096;
  float* Lv = Lwr + 4096;
  float* LY = Lv + 4096;
  float* Lbon = LY + 4096;
  float* Lsc = Lbon + 64;
  char* ws = p.ws;
  const u16* gR = (const u16*)(ws + 0 * SLOT);
  const u16* gK = (const u16*)(ws + 1 * SLOT);
  const u16* gV = (const u16*)(ws + 2 * SLOT);
  const u16* gZ = (const u16*)(ws + 3 * SLOT);
  const u16* gW = (const u16*)(ws + 4 * SLOT);
  const u16* gA = (const u16*)(ws + 5 * SLOT);
  u16* YG = (u16*)(ws + 6 * SLOT);
  const int tt = tid >> 3, c8 = (tid & 7) * 8;
  const int rp = wid * 4 + (lane >> 4), kc = lane & 15;

  for (int item = blockIdx.x; item < 768; item += gridDim.x) {
    int h, tok0, nsteps; const float* sinit; float* sout;
    if (item < 256) { h = item & 31; tok0 = (item >> 5) * 4096; nsteps = 4096; sinit = nullptr; sout = p.out + OFF_WKV_P + (size_t)item * 4096; }
    else { int it = item - 256; h = it & 31; tok0 = TP + (it >> 5) * 32; nsteps = 32; sinit = p.in[I_SWKV] + (size_t)it * 4096; sout = p.out + OFF_WKV_S + (size_t)it * 4096; }
    const int nch = (nsteps + 63) >> 6;
    const int col0 = h * 64 + c8;
    float ckk[8], cka[8], crk[8], clg[8], clb[8];
    {
      float4 t0, t1;
      t0 = *(const float4*)(p.in[I_AKK] + col0); t1 = *(const float4*)(p.in[I_AKK] + col0 + 4);
      ckk[0] = t0.x; ckk[1] = t0.y; ckk[2] = t0.z; ckk[3] = t0.w; ckk[4] = t1.x; ckk[5] = t1.y; ckk[6] = t1.z; ckk[7] = t1.w;
      t0 = *(const float4*)(p.in[I_AKA] + col0); t1 = *(const float4*)(p.in[I_AKA] + col0 + 4);
      cka[0] = t0.x; cka[1] = t0.y; cka[2] = t0.z; cka[3] = t0.w; cka[4] = t1.x; cka[5] = t1.y; cka[6] = t1.z; cka[7] = t1.w;
      t0 = *(const float4*)(p.in[I_ARK] + col0); t1 = *(const float4*)(p.in[I_ARK] + col0 + 4);
      crk[0] = t0.x; crk[1] = t0.y; crk[2] = t0.z; crk[3] = t0.w; crk[4] = t1.x; crk[5] = t1.y; crk[6] = t1.z; crk[7] = t1.w;
      t0 = *(const float4*)(p.in[I_ALNG] + col0); t1 = *(const float4*)(p.in[I_ALNG] + col0 + 4);
      clg[0] = t0.x; clg[1] = t0.y; clg[2] = t0.z; clg[3] = t0.w; clg[4] = t1.x; clg[5] = t1.y; clg[6] = t1.z; clg[7] = t1.w;
      t0 = *(const float4*)(p.in[I_ALNB] + col0); t1 = *(const float4*)(p.in[I_ALNB] + col0 + 4);
      clb[0] = t0.x; clb[1] = t0.y; clb[2] = t0.z; clb[3] = t0.w; clb[4] = t1.x; clb[5] = t1.y; clb[6] = t1.z; clb[7] = t1.w;
    }
    float s0[4], s1[4];
    if (sinit) {
      float4 a = *(const float4*)(sinit + (2 * rp) * 64 + kc * 4), b = *(const float4*)(sinit + (2 * rp + 1) * 64 + kc * 4);
      s0[0] = a.x; s0[1] = a.y; s0[2] = a.z; s0[3] = a.w; s1[0] = b.x; s1[1] = b.y; s1[2] = b.z; s1[3] = b.w;
    } else {
#pragma unroll
      for (int j = 0; j < 4; ++j) { s0[j] = 0.f; s1[j] = 0.f; }
    }
    uint4 cr, ck, cv, cz, cw, ca;
#define SCAN_LOAD(c)                                                                   \
    {                                                                                  \
      const int tl_ = (c) * 64 + tt;                                                   \
      if (tl_ < nsteps) {                                                              \
        const size_t o_ = (size_t)(tok0 + tl_) * 2048 + col0;                          \
        cr = *(const uint4*)(gR + o_); ck = *(const uint4*)(gK + o_); cv = *(const uint4*)(gV + o_); \
        cz = *(const uint4*)(gZ + o_); cw = *(const uint4*)(gW + o_); ca = *(const uint4*)(gA + o_); \
      } else { cr = ck = cv = cz = cw = ca = make_uint4(0, 0, 0, 0); }                 \
    }
    SCAN_LOAD(0);
    for (int c = 0; c < nch; ++c) {
      uint4 zc = cz;
      {
        float r[8], k[8], v[8], lw[8], a[8];
        unpack8(cr, r); unpack8(ck, k); unpack8(cv, v); unpack8(cw, lw); unpack8(ca, a);
        float kkv[8], kp[8], w[8], bon = 0.f, ss = 0.f, kr = 0.f;
#pragma unroll
        for (int j = 0; j < 8; ++j) {
          kkv[j] = k[j] * ckk[j]; ss += kkv[j] * kkv[j];
          kp[j] = k[j] * (1.f + (a[j] - 1.f) * cka[j]);
          bon += r[j] * kp[j] * crk[j];
          kr += r[j] * kp[j];
          w[j] = __expf(lw[j]);
        }
        ss = red8(ss); bon = red8(bon); kr = red8(kr);
        const float inv = rsqrtf(ss + 1e-12f);
        float bb[8], br = 0.f;
#pragma unroll
        for (int j = 0; j < 8; ++j) { kkv[j] *= inv; bb[j] = kkv[j] * a[j]; br += bb[j] * r[j]; }
        br = red8(br);
        float* d;
        d = Lkk + tt * 64 + c8;
        *(float4*)d = make_float4(kkv[0], kkv[1], kkv[2], kkv[3]); *(float4*)(d + 4) = make_float4(kkv[4], kkv[5], kkv[6], kkv[7]);
        d = Lb + tt * 64 + c8;
        *(float4*)d = make_float4(bb[0], bb[1], bb[2], bb[3]); *(float4*)(d + 4) = make_float4(bb[4], bb[5], bb[6], bb[7]);
        d = Lw + tt * 64 + c8;
        *(float4*)d = make_float4(w[0], w[1], w[2], w[3]); *(float4*)(d + 4) = make_float4(w[4], w[5], w[6], w[7]);
        d = Lk + tt * 64 + c8;
        *(float4*)d = make_float4(kp[0], kp[1], kp[2], kp[3]); *(float4*)(d + 4) = make_float4(kp[4], kp[5], kp[6], kp[7]);
        d = Lwr + tt * 64 + c8;
        *(float4*)d = make_float4(w[0] * r[0], w[1] * r[1], w[2] * r[2], w[3] * r[3]);
        *(float4*)(d + 4) = make_float4(w[4] * r[4], w[5] * r[5], w[6] * r[6], w[7] * r[7]);
        d = Lv + tt * 64 + c8;
        *(float4*)d = make_float4(v[0], v[1], v[2], v[3]); *(float4*)(d + 4) = make_float4(v[4], v[5], v[6], v[7]);
        if ((tid & 7) == 0) { Lbon[tt] = bon; *(float2*)(Lsc + tt * 2) = make_float2(br, kr); }
      }
      __syncthreads();
      if (c + 1 < nch) SCAN_LOAD(c + 1);
      {
        const int nT = min(64, nsteps - c * 64);
        const float* pk = Lkk + kc * 4; const float* pw = Lw + kc * 4; const float* pb = Lb + kc * 4;
        const float* pkp = Lk + kc * 4; const float* pwr = Lwr + kc * 4; const float* pv = Lv + rp * 2;
        float* py = LY + rp * 2;
#define SCAN_LD(S, o)                                                                  \
        S##kk = *(const float4*)(pk + (o)); S##w = *(const float4*)(pw + (o)); S##b = *(const float4*)(pb + (o)); \
        S##k = *(const float4*)(pkp + (o)); S##wr = *(const float4*)(pwr + (o)); S##v = *(const float2*)(pv + (o)); \
        S##sc = *(const float2*)(Lsc + ((o) >> 5));
#define SCAN_STEP(S, o)                                                                \
        {                                                                              \
          float d0 = s0[0] * S##kk.x + s0[1] * S##kk.y + s0[2] * S##kk.z + s0[3] * S##kk.w;  \
          float d1 = s1[0] * S##kk.x + s1[1] * S##kk.y + s1[2] * S##kk.z + s1[3] * S##kk.w;  \
          float e0 = s0[0] * S##wr.x + s0[1] * S##wr.y + s0[2] * S##wr.z + s0[3] * S##wr.w;  \
          float e1 = s1[0] * S##wr.x + s1[1] * S##wr.y + s1[2] * S##wr.z + s1[3] * S##wr.w;  \
          d0 += dppf<0xB1>(d0); d1 += dppf<0xB1>(d1); e0 += dppf<0xB1>(e0); e1 += dppf<0xB1>(e1);       \
          d0 += dppf<0x4E>(d0); d1 += dppf<0x4E>(d1); e0 += dppf<0x4E>(e0); e1 += dppf<0x4E>(e1);       \
          d0 += dppf<0x141>(d0); d1 += dppf<0x141>(d1); e0 += dppf<0x141>(e0); e1 += dppf<0x141>(e1);   \
          d0 += dppf<0x140>(d0); d1 += dppf<0x140>(d1); e0 += dppf<0x140>(e0); e1 += dppf<0x140>(e1);   \
          s0[0] = s0[0] * S##w.x + (S##v.x * S##k.x - d0 * S##b.x);                    \
          s0[1] = s0[1] * S##w.y + (S##v.x * S##k.y - d0 * S##b.y);                    \
          s0[2] = s0[2] * S##w.z + (S##v.x * S##k.z - d0 * S##b.z);                    \
          s0[3] = s0[3] * S##w.w + (S##v.x * S##k.w - d0 * S##b.w);                    \
          s1[0] = s1[0] * S##w.x + (S##v.y * S##k.x - d1 * S##b.x);                    \
          s1[1] = s1[1] * S##w.y + (S##v.y * S##k.y - d1 * S##b.y);                    \
          s1[2] = s1[2] * S##w.z + (S##v.y * S##k.z - d1 * S##b.z);                    \
          s1[3] = s1[3] * S##w.w + (S##v.y * S##k.w - d1 * S##b.w);                    \
          if (kc == 0) *(float2*)(py + (o)) = make_float2(e0 - d0 * S##sc.x + S##v.x * S##sc.y, e1 - d1 * S##sc.x + S##v.y * S##sc.y); \
        }
        float4 Akk, Aw, Ab, Ak, Awr, Bkk, Bw, Bb, Bk, Bwr; float2 Av, Asc, Bv, Bsc;
        SCAN_LD(A, 0);
        for (int t = 0; t < nT; t += 2) {
          SCAN_LD(B, (t + 1) * 64);
          SCAN_STEP(A, t * 64);
          SCAN_LD(A, (t + 2) * 64);
          SCAN_STEP(B, (t + 1) * 64);
        }
#undef SCAN_LD
#undef SCAN_STEP
      }
      __syncthreads();
      {
        const int tl = c * 64 + tt;
        if (tl < nsteps) {
          float y[8], z[8];
          float4 a = *(const float4*)(LY + tt * 64 + c8), b = *(const float4*)(LY + tt * 64 + c8 + 4);
          y[0] = a.x; y[1] = a.y; y[2] = a.z; y[3] = a.w; y[4] = b.x; y[5] = b.y; y[6] = b.z; y[7] = b.w;
          float sm = y[0] + y[1] + y[2] + y[3] + y[4] + y[5] + y[6] + y[7];
          sm = red8(sm);
          const float mean = sm * (1.f / 64.f);
          float vs = 0.f;
#pragma unroll
          for (int j = 0; j < 8; ++j) { y[j] -= mean; vs += y[j] * y[j]; }
          vs = red8(vs);
          const float rstd = rsqrtf(vs * (1.f / 64.f) + 64e-5f);
          const float bon = Lbon[tt];
          float4 va = *(const float4*)(Lv + tt * 64 + c8), vb = *(const float4*)(Lv + tt * 64 + c8 + 4);
          float vv[8] = {va.x, va.y, va.z, va.w, vb.x, vb.y, vb.z, vb.w};
          unpack8(zc, z);
          float o[8];
#pragma unroll
          for (int j = 0; j < 8; ++j) {
            float t = y[j] * rstd * clg[j] + clb[j] + bon * vv[j];
            o[j] = t * z[j] * sigmoidf_(z[j]);
          }
          uint4 ov; ov.x = pack2(o[0], o[1]); ov.y = pack2(o[2], o[3]); ov.z = pack2(o[4], o[5]); ov.w = pack2(o[6], o[7]);
          *(uint4*)(YG + (size_t)(tok0 + tl) * 2048 + col0) = ov;
        }
      }
      __syncthreads();
    }
#undef SCAN_LOAD
    *(float4*)(sout + (2 * rp) * 64 + kc * 4) = make_float4(s0[0], s0[1], s0[2], s0[3]);
    *(float4*)(sout + (2 * rp + 1) * 64 + kc * 4) = make_float4(s1[0], s1[1], s1[2], s1[3]);
  }
}

template <int LAYER>
DEV void outproj_store(const Params& p, const float* mod, float* xmid, int m, int n, f32x4 v) {
  const float* gate = mod + (size_t)seq_of(m) * 3072 + 2048;
  float4 g4 = *(const float4*)(gate + n);
  if (LAYER == 0) {
    const float* xr = m < TP ? p.in[I_XP] + (size_t)m * 1024 : p.in[I_XS] + (size_t)(m - TP) * 1024;
    float4 x4 = *(const float4*)(xr + n);
    *(float4*)(xmid + (size_t)m * 1024 + n) = make_float4(x4.x + g4.x * v[0], x4.y + g4.y * v[1], x4.z + g4.z * v[2], x4.w + g4.w * v[3]);
  } else {
    float4 x4 = *(const float4*)(xmid + (size_t)m * 1024 + n);
    float* yo = m < TP ? p.out + OFF_Y_P + (size_t)m * 1024 : p.out + OFF_Y_S + (size_t)(m - TP) * 1024;
    *(float4*)(yo + n) = make_float4(x4.x + g4.x * v[0], x4.y + g4.y * v[1], x4.z + g4.z * v[2], x4.w + g4.w * v[3]);
  }
}

template <int LAYER>
DEV void phase_outproj_main(const Params& p, char* smem) {
  const int tid = threadIdx.x, lane = tid & 63, wid = tid >> 6, wr = wid >> 2, wc = wid & 3, fr = lane & 15, fq = lane >> 4;
  char* ws = p.ws;
  const u16* A = (const u16*)(ws + 6 * SLOT);
  const u16* Bt = (const u16*)(ws + (LAYER == 0 ? WS_WT_OUTA : WS_WT_OUTB));
  const float* mod = (const float*)(ws + WS_MOD) + (size_t)LAYER * 24 * 3072;
  float* xmid = (float*)(ws + 0 * SLOT);
  f32x4 acc[8][4];
  const int xcc0 = xcc_id();
  int nxt;
  for (int ls = 0; ls < 8; ++ls) {
    const int xcd = (xcc0 + ls) & 7;
    unsigned* ctr = sched_ctr(p, LAYER == 0 ? 1 : 3, xcd);
    for (int li = sched_first(ctr, smem); li < 64; li = sched_commit(nxt, smem)) {
      nxt = sched_prefetch(ctr);
      const int item = 64 * xcd + li;
      const int m0 = (item >> 2) * 256, n0 = (item & 3) * 256;
      gemm_main256_dma(acc, A, 2048, Bt, 2048, 32, m0, n0, smem);
#pragma unroll
      for (int i = 0; i < 8; ++i)
#pragma unroll
        for (int j = 0; j < 4; ++j)
          outproj_store<LAYER>(p, mod, xmid, m0 + wr * 128 + i * 16 + fr, n0 + wc * 64 + j * 16 + fq * 4, acc[i][j]);
    }
  }
}

template <int LAYER>
DEV void phase_outproj_tail(const Params& p, char* smem) {
  const int tid = threadIdx.x, lane = tid & 63, wid = tid >> 6, wr = wid >> 1, wc = wid & 1, fr = lane & 15, fq = lane >> 4;
  char* ws = p.ws;
  const u16* A = (const u16*)(ws + 6 * SLOT);
  const u16* Bt = (const u16*)(ws + (LAYER == 0 ? WS_WT_OUTA : WS_WT_OUTB));
  const float* mod = (const float*)(ws + WS_MOD) + (size_t)LAYER * 24 * 3072;
  float* xmid = (float*)(ws + 0 * SLOT);
  f32x4 acc[4][4];
  const int xcc0 = xcc_id();
  int nxt;
  for (int ls = 0; ls < 8; ++ls) {
    const int xcd = (xcc0 + ls) & 7;
    unsigned* ctr = sched_ctr(p, LAYER == 0 ? 5 : 6, xcd);
    for (int li = sched_first(ctr, smem); li < 2; li = sched_commit(nxt, smem)) {
      nxt = sched_prefetch(ctr);
      const int item = 2 * xcd + li;
      const int m0 = (128 + (item >> 3)) * 256, n0 = (item & 7) * 128;
      gemm_main<0>(acc, A, 2048, Bt, 2048, 32, m0, n0, nullptr, nullptr, smem);
#pragma unroll
      for (int i = 0; i < 4; ++i)
#pragma unroll
        for (int j = 0; j < 4; ++j)
          outproj_store<LAYER>(p, mod, xmid, m0 + wr * 64 + i * 16 + fr, n0 + wc * 64 + j * 16 + fq * 4, acc[i][j]);
    }
  }
}

template <int LAYER>
DEV void phase_outproj(const Params& p, char* smem) {
  phase_outproj_tail<LAYER>(p, smem);
  phase_outproj_main<LAYER>(p, smem);
}

DEV void phase_norm1(const Params& p) {
  const int lane = threadIdx.x & 63, wid = threadIdx.x >> 6;
  const float* mod = (const float*)(p.ws + WS_MOD) + (size_t)24 * 3072;
  const float* xmid = (const float*)(p.ws + 0 * SLOT);
  u16* AKV = (u16*)(p.ws + 1 * SLOT);
  u16* AQ = AKV + (size_t)NTOK * 1024;
  const float* gkv = p.in[I_KVNG];
  const float* gb = p.in[I_BNG];
  for (int t = blockIdx.x * 8 + wid; t < NTOK; t += gridDim.x * 8) {
    const float* x = xmid + (size_t)t * 1024;
    const float* md = mod + (size_t)seq_of(t) * 3072;
    float4 v[4];
    float ss = 0.f;
#pragma unroll
    for (int i = 0; i < 4; ++i) {
      v[i] = *(const float4*)(x + lane * 4 + 256 * i);
      ss += v[i].x * v[i].x + v[i].y * v[i].y + v[i].z * v[i].z + v[i].w * v[i].w;
    }
    ss = wave_sum(ss);
    const float rstd = rsqrtf(ss * (1.0f / 1024.0f) + 1e-6f);
#pragma unroll
    for (int i = 0; i < 4; ++i) {
      const int c = lane * 4 + 256 * i;
      float4 g1 = *(const float4*)(gkv + c), g2 = *(const float4*)(gb + c), sh = *(const float4*)(md + c), sc = *(const float4*)(md + 1024 + c);
      float xn0 = v[i].x * rstd, xn1 = v[i].y * rstd, xn2 = v[i].z * rstd, xn3 = v[i].w * rstd;
      uint2 o;
      o.x = pack2(xn0 * g1.x, xn1 * g1.y); o.y = pack2(xn2 * g1.z, xn3 * g1.w);
      *(uint2*)(AKV + (size_t)t * 1024 + c) = o;
      o.x = pack2(xn0 * g2.x * (1.f + sc.x) + sh.x, xn1 * g2.y * (1.f + sc.y) + sh.y);
      o.y = pack2(xn2 * g2.z * (1.f + sc.z) + sh.z, xn3 * g2.w * (1.f + sc.w) + sh.w);
      *(uint2*)(AQ + (size_t)t * 1024 + c) = o;
    }
  }
}

#define QSCALE (0.08838834764831845f * 1.4426950408889634f)
DEV void phase_proj1(const Params& p, char* smem) {
  const int tid = threadIdx.x, lane = tid & 63, wid = tid >> 6, wr = wid >> 2, wc = wid & 3, fr = lane & 15, fq = lane >> 4;
  char* ws = p.ws;
  const u16* AKV = (const u16*)(ws + 1 * SLOT);
  const u16* AQ = AKV + (size_t)NTOK * 1024;
  u16* KB = (u16*)(ws + 2 * SLOT);
  u16* VB = (u16*)(ws + 3 * SLOT);
  u16* QB = (u16*)(ws + 4 * SLOT);
  u16* ZS = (u16*)(ws + 5 * SLOT);
  f32x4 acc[8][4];
  float* red = (float*)smem;
  const int xcc0 = xcc_id();
  int nxt;
  for (int ls = 0; ls < 8; ++ls) {
  const int xcd = (xcc0 + ls) & 7;
  unsigned* ctr = sched_ctr(p, 2, xcd);
  for (int li = sched_first(ctr, smem); li < 520; li = sched_commit(nxt, smem)) {
    nxt = sched_prefetch(ctr);
    const int mt = li >> 2, t = 4 * xcd + (li & 3);
    const int isq = t >> 4, nt = t & 15;
    const int m0 = mt * 256, n0 = nt * 256;
    gemm_main256_dma(acc, isq ? AQ : AKV, 1024, (const u16*)(ws + (isq ? WS_WT_INB : WS_WT_KV)), 1024, 16, m0, n0, smem);
    if (nt < 8) {
#pragma unroll
      for (int i = 0; i < 8; ++i) {
        float ss = 0.f;
#pragma unroll
        for (int j = 0; j < 4; ++j) ss += acc[i][j][0] * acc[i][j][0] + acc[i][j][1] * acc[i][j][1] + acc[i][j][2] * acc[i][j][2] + acc[i][j][3] * acc[i][j][3];
        red[(wr * 128 + i * 16 + fr) * 16 + wc * 4 + fq] = ss;
      }
      __syncthreads();
      const float* gain = isq ? p.in[I_BQG] : p.in[I_KGAIN];
#pragma unroll
      for (int i = 0; i < 8; ++i) {
        const int row = wr * 128 + i * 16 + fr, m = m0 + row;
        float4 ra = *(const float4*)(red + row * 16 + (wc >> 1) * 8), rb = *(const float4*)(red + row * 16 + (wc >> 1) * 8 + 4);
        float tot = ra.x + ra.y + ra.z + ra.w + rb.x + rb.y + rb.z + rb.w;
        float rs = rsqrtf(tot * (1.f / 128.f) + 1e-6f);
        if (isq) rs *= QSCALE;
#pragma unroll
        for (int j = 0; j < 4; ++j) {
          const int d = (wc & 1) * 64 + j * 16 + fq * 4, n = n0 + wc * 64 + j * 16 + fq * 4;
          float4 g4 = *(const float4*)(gain + d);
          f32x4 v = acc[i][j];
          float o0 = v[0] * rs * g4.x, o1 = v[1] * rs * g4.y, o2 = v[2] * rs * g4.z, o3 = v[3] * rs * g4.w;
          uint2 o; o.x = pack2(o0, o1); o.y = pack2(o2, o3);
          if (isq) {
            *(uint2*)(QB + (size_t)m * 2048 + n) = o;
          } else {
            *(uint2*)(KB + (size_t)m * 2048 + n) = o;
            float* ko = m < TP ? p.out + OFF_K_P + (size_t)m * 2048 : p.out + OFF_K_S + (size_t)(m - TP) * 2048;
            *(float4*)(ko + n) = make_float4(o0, o1, o2, o3);
          }
        }
      }
      __syncthreads();
    } else {
#pragma unroll
      for (int i = 0; i < 8; ++i) {
        const int m = m0 + wr * 128 + i * 16 + fr;
#pragma unroll
        for (int j = 0; j < 4; ++j) {
          const int n = n0 - 2048 + wc * 64 + j * 16 + fq * 4;
          f32x4 v = acc[i][j];
          if (isq) {
            float o0 = v[0] * sigmoidf_(v[0]), o1 = v[1] * sigmoidf_(v[1]), o2 = v[2] * sigmoidf_(v[2]), o3 = v[3] * sigmoidf_(v[3]);
            uint2 o; o.x = pack2(o0, o1); o.y = pack2(o2, o3);
            *(uint2*)(ZS + (size_t)m * 2048 + n) = o;
          } else {
            uint2 o; o.x = pack2(v[0], v[1]); o.y = pack2(v[2], v[3]);
            *(uint2*)(VB + (size_t)m * 2048 + n) = o;
            float* vo = m < TP ? p.out + OFF_V_P + (size_t)m * 2048 : p.out + OFF_V_S + (size_t)(m - TP) * 2048;
            *(float4*)(vo + n) = make_float4(v[0], v[1], v[2], v[3]);
          }
        }
      }
    }
  }
}
}

DEV unsigned off_b(unsigned row, unsigned ch) { return 256u * row + 16u * (ch ^ (((row & 3) << 2) | ((row >> 2) & 3))); }

DEV void phase_attn(const Params& p, char* smem) {
  const int tid = threadIdx.x, lane = tid & 63, w = tid >> 6, fr = lane & 15, fq = lane >> 4;
  char* ws = p.ws;
  const u16* KB = (const u16*)(ws + 2 * SLOT);
  const u16* VB = (const u16*)(ws + 3 * SLOT);
  const u16* QB = (const u16*)(ws + 4 * SLOT);
  const u16* ZS = (const u16*)(ws + 5 * SLOT);
  u16* OG = (u16*)(ws + 6 * SLOT);
  const int lrow = tid >> 4, lch = tid & 15;
  const unsigned lw0 = off_b(lrow, lch), lw1 = off_b(lrow + 32, lch);
  const int tq = (lane & 15) >> 2, tp = lane & 3;

  for (int item = blockIdx.x; item < 4096 + 256; item += gridDim.x) {
    int b, h, nq, qpos0, tokq0, ntiles, nkeys, tokk0; bool sample;
    if (item < 4096) {
      const int qblk = 31 - (item >> 7), bh = item & 127;
      b = bh >> 4; h = bh & 15; nq = 128; qpos0 = qblk * 128; tokq0 = b * 4096 + qpos0; ntiles = 2 * qblk + 2; nkeys = qpos0 + 128; tokk0 = b * 4096; sample = false;
    } else {
      const int bh = item - 4096;
      b = bh >> 4; h = bh & 15; nq = 32; qpos0 = 1024; tokq0 = TP + b * 32; ntiles = 17; nkeys = 1056; tokk0 = TP + b * 32 - 1024; sample = true;
    }
    const bool wactive = (w * 16) < nq;
    int* dflag = (int*)(smem + 65536);
    __syncthreads();
    if (lane == 0) dflag[w] = wactive ? 0 : 1;
    bool wdone = !wactive;
    const int qp = qpos0 + w * 16 + fr;
    const int qwmax = qpos0 + w * 16 + 15;
    bf16x8 qf[4];
#pragma unroll
    for (int ks = 0; ks < 4; ++ks) {
      if (wactive) qf[ks] = *(const bf16x8*)(QB + (size_t)(tokq0 + w * 16 + fr) * 2048 + h * 128 + ks * 32 + fq * 8);
      else qf[ks] = (bf16x8){0, 0, 0, 0, 0, 0, 0, 0};
    }
    f32x4 O[8];
#pragma unroll
    for (int dt = 0; dt < 8; ++dt) O[dt] = (f32x4){0, 0, 0, 0};
    float carry = 0.f;

    uint4 lk0, lk1, lv0, lv1;
#define ATT_LOAD(kb)                                                                                  \
    {                                                                                                 \
      const int kx0_ = (kb) * 64 + lrow, kx1_ = kx0_ + 32;                                            \
      if (sample && (kb) < 16) {                                                                      \
        const float* ck_ = p.in[I_CK] + ((size_t)(b * 1024 + kx0_) * 16 + h) * 128 + lch * 8;         \
        const float* cv_ = p.in[I_CV] + ((size_t)(b * 1024 + kx0_) * 16 + h) * 128 + lch * 8;         \
        float4 a_ = *(const float4*)ck_, b_ = *(const float4*)(ck_ + 4);                              \
        float4 c_ = *(const float4*)(ck_ + 32 * 2048), d_ = *(const float4*)(ck_ + 32 * 2048 + 4);    \
        lk0 = make_uint4(pack2(a_.x, a_.y), pack2(a_.z, a_.w), pack2(b_.x, b_.y), pack2(b_.z, b_.w)); \
        lk1 = make_uint4(pack2(c_.x, c_.y), pack2(c_.z, c_.w), pack2(d_.x, d_.y), pack2(d_.z, d_.w)); \
        a_ = *(const float4*)cv_; b_ = *(const float4*)(cv_ + 4);                                     \
        c_ = *(const float4*)(cv_ + 32 * 2048); d_ = *(const float4*)(cv_ + 32 * 2048 + 4);           \
        lv0 = make_uint4(pack2(a_.x, a_.y), pack2(a_.z, a_.w), pack2(b_.x, b_.y), pack2(b_.z, b_.w)); \
        lv1 = make_uint4(pack2(c_.x, c_.y), pack2(c_.z, c_.w), pack2(d_.x, d_.y), pack2(d_.z, d_.w)); \
      } else {                                                                                        \
        const size_t o0_ = (size_t)(tokk0 + kx0_) * 2048 + h * 128 + lch * 8;                         \
        const size_t o1_ = o0_ + (size_t)32 * 2048;                                                   \
        if (kx0_ < nkeys) { lk0 = *(const uint4*)(KB + o0_); lv0 = *(const uint4*)(VB + o0_); }       \
        else { lk0 = make_uint4(0, 0, 0, 0); lv0 = lk0; }                                             \
        if (kx1_ < nkeys) { lk1 = *(const uint4*)(KB + o1_); lv1 = *(const uint4*)(VB + o1_); }       \
        else { lk1 = make_uint4(0, 0, 0, 0); lv1 = lk1; }                                             \
      }                                                                                               \
    }
#define ATT_STORE(st)                                                                                 \
    {                                                                                                 \
      char* sK_ = smem + (st) * 32768; char* sV_ = sK_ + 16384;                                       \
      *(uint4*)(sK_ + lw0) = lk0; *(uint4*)(sK_ + lw1) = lk1;                                         \
      *(uint4*)(sV_ + lw0) = lv0; *(uint4*)(sV_ + lw1) = lv1;                                         \
    }
    ATT_LOAD(ntiles - 1);
    ATT_STORE(0);
    __syncthreads();
    for (int it = 0; it < ntiles; ++it) {
      const int kb = ntiles - 1 - it, st = it & 1;
      if (it + 1 < ntiles) ATT_LOAD(kb - 1);
      if (!wdone && kb * 64 < qwmax) {
        const char* sK = smem + st * 32768;
        const char* sV = sK + 16384;
        f32x4 S[4];
#pragma unroll
        for (int mt = 0; mt < 4; ++mt) S[mt] = (f32x4){0, 0, 0, 0};
#pragma unroll
        for (int ks = 0; ks < 4; ++ks)
#pragma unroll
          for (int mt = 0; mt < 4; ++mt) {
            bf16x8 a = *(const bf16x8*)(sK + off_b(mt * 16 + fr, ks * 4 + fq));
            S[mt] = __builtin_amdgcn_mfma_f32_16x16x32_bf16(a, qf[ks], S[mt], 0, 0, 0);
          }
        bf16x8 wf[2];
        {
          float ee[4][4], tot[4], hi[4];
#pragma unroll
          for (int mt = 0; mt < 4; ++mt) {
            const int kbase = kb * 64 + mt * 16 + fq * 4;
            float ls[4];
#pragma unroll
            for (int jj = 0; jj < 4; ++jj) {
              const float u = S[mt][jj];
              const bool valid = (kbase + jj) < qp;
              const float l = -__builtin_amdgcn_logf(1.0f + __builtin_amdgcn_exp2f(u));
              ls[jj] = valid ? l : 0.f;
              ee[mt][jj] = valid ? (u + l) : -1e30f;
            }
            const float x3 = ls[3], x2 = x3 + ls[2], x1 = x2 + ls[1], seg = x1 + ls[0];
            ee[mt][2] += x3; ee[mt][1] += x2; ee[mt][0] += x1;
            const float t1 = __shfl_xor(seg, 16), t2 = __shfl_xor(seg, 32), t3 = __shfl_xor(t1, 32);
            tot[mt] = seg + t1 + t2 + t3;
            hi[mt] = fq == 0 ? (t1 + t2 + t3) : fq == 1 ? (t2 + t3) : fq == 2 ? t1 : 0.f;
          }
          float run = carry;
          float wv[4][4];
#pragma unroll
          for (int mt = 3; mt >= 0; --mt) {
            const float base = run + hi[mt];
            run += tot[mt];
#pragma unroll
            for (int jj = 0; jj < 4; ++jj) wv[mt][jj] = __builtin_amdgcn_exp2f(ee[mt][jj] + base);
          }
          carry = run;
          if (__all(carry < -150.0f)) { wdone = true; if (lane == 0) dflag[w] = 1; }
#pragma unroll
          for (int p2 = 0; p2 < 2; ++p2) {
            uint4 pk;
            pk.x = pack2(wv[2 * p2][0], wv[2 * p2][1]); pk.y = pack2(wv[2 * p2][2], wv[2 * p2][3]);
            pk.z = pack2(wv[2 * p2 + 1][0], wv[2 * p2 + 1][1]); pk.w = pack2(wv[2 * p2 + 1][2], wv[2 * p2 + 1][3]);
            wf[p2] = *(bf16x8*)&pk;
          }
        }
#pragma unroll
        for (int p2 = 0; p2 < 2; ++p2)
#pragma unroll
          for (int dt = 0; dt < 8; ++dt) {
            const unsigned r0 = 32 * p2 + 4 * fq + tq, r1 = r0 + 16;
            const unsigned ch = 2 * dt + (tp >> 1);
            const char* a0 = sV + off_b(r0, ch) + 8 * (tp & 1);
            const char* a1 = sV + off_b(r1, ch) + 8 * (tp & 1);
            s16x4 lo = __builtin_amdgcn_ds_read_tr16_b64_v4i16((s16x4 __attribute__((address_space(3)))*)(a0));
            s16x4 hi4 = __builtin_amdgcn_ds_read_tr16_b64_v4i16((s16x4 __attribute__((address_space(3)))*)(a1));
            bf16x8 a = {lo[0], lo[1], lo[2], lo[3], hi4[0], hi4[1], hi4[2], hi4[3]};
            O[dt] = __builtin_amdgcn_mfma_f32_16x16x32_bf16(a, wf[p2], O[dt], 0, 0, 0);
          }
      }
      if (it + 1 < ntiles) ATT_STORE(st ^ 1);
      __syncthreads();
      {
        const int4 f0 = *(const int4*)dflag, f1 = *(const int4*)(dflag + 4);
        if (f0.x & f0.y & f0.z & f0.w & f1.x & f1.y & f1.z & f1.w) break;
      }
    }
#undef ATT_LOAD
#undef ATT_STORE
    if (wactive) {
      const size_t rowoff = (size_t)(tokq0 + w * 16 + fr) * 2048 + h * 128;
#pragma unroll
      for (int dt = 0; dt < 8; ++dt) {
        const int d = dt * 16 + fq * 4;
        uint2 z = *(const uint2*)(ZS + rowoff + d);
        f32x4 v = O[dt];
        uint2 o;
        o.x = pack2(v[0] * bflo(z.x), v[1] * bfhi(z.x)); o.y = pack2(v[2] * bflo(z.y), v[3] * bfhi(z.y));
        *(uint2*)(OG + rowoff + d) = o;
      }
    }
  }
}


DEV void grid_barrier(unsigned* bar, unsigned target) {
  __syncthreads();
  if (threadIdx.x == 0) {
    __builtin_amdgcn_fence(__ATOMIC_RELEASE, "agent");
    asm volatile("s_waitcnt vmcnt(0)" ::: "memory");
    __hip_atomic_fetch_add(bar, 1u, __ATOMIC_RELAXED, __HIP_MEMORY_SCOPE_AGENT);
    while (__hip_atomic_load(bar, __ATOMIC_RELAXED, __HIP_MEMORY_SCOPE_AGENT) < target) __builtin_amdgcn_s_sleep(1);
    __builtin_amdgcn_fence(__ATOMIC_ACQUIRE, "agent");
    asm volatile("s_waitcnt vmcnt(0)" ::: "memory");
  }
  __syncthreads();
}

__global__ void __launch_bounds__(NTHREADS) __attribute__((target("no-packed-fp32-ops"))) mega(Params p, int lo, int hi) {
  __shared__ __attribute__((aligned(16))) char smem[147456];
  cg::grid_group grid = cg::this_grid();
#ifndef PROBE_DOUBLE
#define PROBE_DOUBLE -1
#endif
#define RUN_PHASE(k, call) if ((k) >= lo && (k) < hi) { if ((k) > lo) { if ((k) == lo + 1) grid.sync(); else grid_barrier((unsigned*)(p.ws + WS_BAR), (unsigned)((k) - lo - 1) * gridDim.x); } call; }
  RUN_PHASE(0, phase_prep(p, smem))
  RUN_PHASE(1, phase_norm0(p))
  RUN_PHASE(2, phase_proj0(p, smem))
  RUN_PHASE(3, phase_scan(p, smem))
  RUN_PHASE(4, phase_outproj<0>(p, smem))
  RUN_PHASE(5, phase_norm1(p))
  RUN_PHASE(6, phase_proj1(p, smem))
  RUN_PHASE(7, phase_attn(p, smem))
  RUN_PHASE(8, phase_outproj<1>(p, smem))
}

#ifndef N_LAUNCH_MODE
#define N_LAUNCH_MODE 1
#endif

extern "C" void kernel_launch(void* const* d_in, const int* in_sizes, int n_in, void* d_out, int out_size, void* d_ws, size_t ws_size,
                              hipStream_t stream) {
  Params p{};
  for (int i = 0; i < 36; ++i) p.in[i] = (const float*)d_in[i];
  p.out = (float*)d_out;
  p.ws = (char*)d_ws;
  static int grid_blocks = 0;
  if (!grid_blocks) {
    int dev = 0, cus = 0, per_cu = 0;
    hipGetDevice(&dev);
    hipDeviceGetAttribute(&cus, hipDeviceAttributeMultiprocessorCount, dev);
    hipOccupancyMaxActiveBlocksPerMultiprocessor(&per_cu, mega, NTHREADS, 0);
    if (per_cu < 1) per_cu = 1;
    grid_blocks = cus * per_cu;
  }
  if (ws_size < WS_END) { fprintf(stderr, "workspace too small: %zu < %llu\n", ws_size, (unsigned long long)WS_END); return; }
#if N_LAUNCH_MODE == 1
  int lo = 0, hi = 9;
  hipMemsetAsync((char*)d_ws + WS_BAR, 0, 256, stream);
  void* args[] = {&p, &lo, &hi};
  hipError_t e = hipLaunchCooperativeKernel((void*)mega, dim3(grid_blocks), dim3(NTHREADS), args, 0, stream);
  if (e != hipSuccess) fprintf(stderr, "cooperative launch failed: %s (grid %d)\n", hipGetErrorString(e), grid_blocks);
#else
  for (int ph = 0; ph < 9; ++ph) hipLaunchKernelGGL(mega, dim3(grid_blocks), dim3(NTHREADS), 0, stream, p, ph, ph + 1);
#endif
}
```

```cpp
#include <hip/hip_runtime.h>
#include <hip/hip_cooperative_groups.h>
#include <cstdio>
namespace cg = cooperative_groups;

typedef unsigned short u16;
typedef short bf16x8 __attribute__((ext_vector_type(8)));
typedef short s16x4 __attribute__((ext_vector_type(4)));
typedef float f32x4 __attribute__((ext_vector_type(4)));
typedef float f32x2 __attribute__((ext_vector_type(2)));
typedef __bf16 bf16x2_t __attribute__((ext_vector_type(2)));

#define DEV __device__ __forceinline__

#define NTOK 33280
#define TP 32768
#define NTHREADS 512

#define OFF_Y_P 0
#define OFF_Y_S 33554432
#define OFF_K_P 34078720
#define OFF_V_P 101187584
#define OFF_WKV_P 168296448
#define OFF_SH_P 169345024
#define OFF_K_S 169353216
#define OFF_V_S 170401792
#define OFF_WKV_S 171450368
#define OFF_SH_S 173547520

#define SLOT 136314880ull
#define WS_W (7ull * SLOT)
#define WS_WT_IN (WS_W)
#define WS_WT_OUTA (WS_WT_IN + 16777216ull)
#define WS_WT_KV (WS_WT_OUTA + 4194304ull)
#define WS_WT_INB (WS_WT_KV + 8388608ull)
#define WS_WT_OUTB (WS_WT_INB + 8388608ull)
#define WS_W2T (WS_WT_OUTB + 4194304ull)
#define WS_A2T (WS_W2T + 262144ull)
#define WS_L1T (WS_A2T + 262144ull)
#define WS_MOD (WS_L1T + 524288ull)
#define WS_SH (WS_MOD + 589824ull)
#define WS_CTR (WS_SH + 49152ull)
#define WS_BAR (WS_CTR + 4096ull)
#define WS_END (WS_BAR + 256ull)
#define WS_H0 (6ull * SLOT)
#define WS_T (6ull * SLOT + 68157440ull)

struct Params {
  const float* in[36];
  float* out;
  char* ws;
};

enum { I_XP = 0, I_XS, I_CK, I_CV, I_SWKV, I_SSH, I_CP, I_CS, I_ANG, I_AADAW, I_AADAB, I_AWIN, I_AMUIN, I_AMUW, I_AMUA,
       I_AW0, I_AW1, I_AW2, I_AA0, I_AA1, I_AA2, I_AKK, I_AKA, I_ARK, I_ALNG, I_ALNB, I_AWOUT, I_KVNG, I_KVW, I_KGAIN,
       I_BNG, I_BADAW, I_BADAB, I_BWIN, I_BQG, I_BWOUT };

DEV int seq_of(int t) { return t < TP ? (t >> 12) : 8 + ((t - TP) >> 5); }
DEV bool seq_start(int t) { return t < TP ? ((t & 4095) == 0) : (((t - TP) & 31) == 0); }

DEV unsigned pack2(float a, float b) {
  f32x2 v = {a, b};
  bf16x2_t r = __builtin_convertvector(v, bf16x2_t);
  return *(unsigned*)&r;
}
DEV float bflo(unsigned w) { return __uint_as_float(w << 16); }
DEV float bfhi(unsigned w) { return __uint_as_float(w & 0xffff0000u); }
DEV void unpack8(const uint4& x, float* f) {
  f[0] = bflo(x.x); f[1] = bfhi(x.x); f[2] = bflo(x.y); f[3] = bfhi(x.y);
  f[4] = bflo(x.z); f[5] = bfhi(x.z); f[6] = bflo(x.w); f[7] = bfhi(x.w);
}
DEV float sigmoidf_(float x) { return 1.0f / (1.0f + __expf(-x)); }

template <int CTRL>
DEV float dppf(float x) {
  return __int_as_float(__builtin_amdgcn_update_dpp(0, __float_as_int(x), CTRL, 0xf, 0xf, true));
}
DEV float red4(float x) { x += dppf<0xB1>(x); x += dppf<0x4E>(x); return x; }
DEV float red8(float x) { x = red4(x); x += dppf<0x141>(x); return x; }
DEV float red16(float x) { x = red8(x); x += dppf<0x140>(x); return x; }
DEV float wave_sum(float x) {
#pragma unroll
  for (int o = 32; o >= 1; o >>= 1) x += __shfl_xor(x, o);
  return x;
}


#define SCHED_SLOT_OFF 147440
DEV int xcc_id() { return (int)(__builtin_amdgcn_s_getreg((3 << 11) | 20) & 0x7u); }
DEV unsigned* sched_ctr(const Params& p, int phase_slot, int list) { return (unsigned*)(p.ws + WS_CTR) + (phase_slot * 8 + list) * 16; }
DEV int sched_first(unsigned* ctr, char* smem) {
  int* slot = (int*)(smem + SCHED_SLOT_OFF);
  __syncthreads();
  if (threadIdx.x == 0) *slot = (int)atomicAdd(ctr, 1u);
  __syncthreads();
  return *slot;
}

DEV void group_sync(unsigned* bar, unsigned target) {
  __syncthreads();
  if (threadIdx.x == 0) {
    __hip_atomic_fetch_add(bar, 1u, __ATOMIC_RELAXED, __HIP_MEMORY_SCOPE_AGENT);
    while (__hip_atomic_load(bar, __ATOMIC_RELAXED, __HIP_MEMORY_SCOPE_AGENT) < target) __builtin_amdgcn_s_sleep(2);
  }
  __syncthreads();
}
DEV int sched_prefetch(unsigned* ctr) { return threadIdx.x == 0 ? (int)atomicAdd(ctr, 1u) : 0; }
DEV int sched_commit(int nxt, char* smem) {
  int* slot = (int*)(smem + SCHED_SLOT_OFF);
  __syncthreads();
  if (threadIdx.x == 0) *slot = nxt;
  __syncthreads();
  return *slot;
}

#define GEMM_STAGE_BYTES 49152

template <int AMODE>
DEV void gemm_main(f32x4 (&acc)[4][4], const u16* __restrict__ A, int lda, const u16* __restrict__ Bt, int ldb, int nk,
                   int m0, int n0, const float* __restrict__ mu, const u16* __restrict__ SH, char* smem) {
  const int tid = threadIdx.x, lane = tid & 63, wid = tid >> 6, wr = wid >> 1, wc = wid & 1, fr = lane & 15, fq = lane >> 4;
  const int lrow = tid >> 3, lch = tid & 7;
#pragma unroll
  for (int i = 0; i < 4; ++i)
#pragma unroll
    for (int j = 0; j < 4; ++j) acc[i][j] = (f32x4){0.f, 0.f, 0.f, 0.f};

  const u16* pa0; const u16* pa1; const u16* pa2; const u16* pa3;
  const u16* pp0 = nullptr;
  const int arow = 4 * lrow;
  {
    int m = m0 + arow;
    pa0 = A + (size_t)m * lda + lch * 8;
    pa1 = pa0 + lda; pa2 = pa1 + lda; pa3 = pa2 + lda;
    if (AMODE != 0) pp0 = seq_start(m) ? SH + seq_of(m) * 1024 + lch * 8 : pa0 - lda;
  }
  const u16* pb0 = Bt + (size_t)(n0 + lrow) * ldb + lch * 8;
  const u16* pb1 = pb0 + (size_t)64 * ldb;
  const int woffB = lrow * 128 + ((lch ^ ((lrow >> 1) & 7)) << 4);
  const int woffA0 = (arow + 0) * 128 + ((lch ^ (((arow + 0) >> 1) & 7)) << 4);
  const int woffA1 = (arow + 1) * 128 + ((lch ^ (((arow + 1) >> 1) & 7)) << 4);
  const int woffA2 = (arow + 2) * 128 + ((lch ^ (((arow + 2) >> 1) & 7)) << 4);
  const int woffA3 = (arow + 3) * 128 + ((lch ^ (((arow + 3) >> 1) & 7)) << 4);

  uint4 ra0, ra1, ra2, ra3, rp0, rb0, rb1;
  float4 mu0, mu1;
  rp0 = make_uint4(0, 0, 0, 0);
  mu0 = mu1 = make_float4(0, 0, 0, 0);

#define G_LOAD(kt)                                                                     \
  {                                                                                    \
    const int k0_ = (kt) * 64;                                                         \
    if (AMODE == 0) {                                                                  \
      ra0 = *(const uint4*)(pa0 + k0_); ra1 = *(const uint4*)(pa1 + k0_);              \
      ra2 = *(const uint4*)(pa2 + k0_); ra3 = *(const uint4*)(pa3 + k0_);              \
    } else if (AMODE == 1) {                                                           \
      ra0 = *(const uint4*)(pa0 + k0_); ra1 = *(const uint4*)(pa1 + k0_);              \
      ra2 = *(const uint4*)(pa2 + k0_); ra3 = *(const uint4*)(pa3 + k0_);              \
      rp0 = *(const uint4*)(pp0 + k0_);                                                \
      mu0 = *(const float4*)(mu + k0_ + lch * 8); mu1 = *(const float4*)(mu + k0_ + lch * 8 + 4); \
    } else {                                                                           \
      const int kk_ = k0_ & 1023;                                                      \
      ra0 = *(const uint4*)(pa0 + kk_); ra1 = *(const uint4*)(pa1 + kk_);              \
      ra2 = *(const uint4*)(pa2 + kk_); ra3 = *(const uint4*)(pa3 + kk_);              \
      if (k0_ >= 1024) rp0 = *(const uint4*)(pp0 + kk_);                               \
    }                                                                                  \
    rb0 = *(const uint4*)(pb0 + k0_); rb1 = *(const uint4*)(pb1 + k0_);                \
  }

#define G_XFORM(dst, a_, p_, kt)                                                       \
  {                                                                                    \
    if (AMODE == 0) dst = a_;                                                          \
    else if (AMODE == 1) {                                                             \
      float h_[8], q_[8]; unpack8(a_, h_); unpack8(p_, q_);                            \
      dst.x = pack2(h_[0] + mu0.x * (q_[0] - h_[0]), h_[1] + mu0.y * (q_[1] - h_[1])); \
      dst.y = pack2(h_[2] + mu0.z * (q_[2] - h_[2]), h_[3] + mu0.w * (q_[3] - h_[3])); \
      dst.z = pack2(h_[4] + mu1.x * (q_[4] - h_[4]), h_[5] + mu1.y * (q_[5] - h_[5])); \
      dst.w = pack2(h_[6] + mu1.z * (q_[6] - h_[6]), h_[7] + mu1.w * (q_[7] - h_[7])); \
    } else {                                                                           \
      if ((kt) * 64 >= 1024) {                                                         \
        float h_[8], q_[8]; unpack8(a_, h_); unpack8(p_, q_);                          \
        dst.x = pack2(q_[0] - h_[0], q_[1] - h_[1]); dst.y = pack2(q_[2] - h_[2], q_[3] - h_[3]); \
        dst.z = pack2(q_[4] - h_[4], q_[5] - h_[5]); dst.w = pack2(q_[6] - h_[6], q_[7] - h_[7]); \
      } else dst = a_;                                                                 \
    }                                                                                  \
  }

#define G_STORE(stage, kt)                                                             \
  {                                                                                    \
    char* sA_ = smem + (stage) * GEMM_STAGE_BYTES; char* sB_ = sA_ + 32768;            \
    uint4 v_;                                                                          \
    G_XFORM(v_, ra0, rp0, kt); *(uint4*)(sA_ + woffA0) = v_;                           \
    G_XFORM(v_, ra1, ra0, kt); *(uint4*)(sA_ + woffA1) = v_;                           \
    G_XFORM(v_, ra2, ra1, kt); *(uint4*)(sA_ + woffA2) = v_;                           \
    G_XFORM(v_, ra3, ra2, kt); *(uint4*)(sA_ + woffA3) = v_;                           \
    *(uint4*)(sB_ + woffB) = rb0; *(uint4*)(sB_ + woffB + 64 * 128) = rb1;             \
  }

  G_LOAD(0);
  G_STORE(0, 0);
  __syncthreads();
  const int rsw = (fr >> 1) & 7;
  for (int kt = 0; kt < nk; ++kt) {
    const int st = kt & 1;
    if (kt + 1 < nk) G_LOAD(kt + 1);
    __builtin_amdgcn_sched_barrier(0);
    {
      const char* sA = smem + st * GEMM_STAGE_BYTES;
      const char* sB = sA + 32768;
#pragma unroll
      for (int kk = 0; kk < 2; ++kk) {
        bf16x8 af[4], bfr[4];
        const int cho = ((kk * 4 + fq) ^ rsw) << 4;
#pragma unroll
        for (int i = 0; i < 4; ++i) af[i] = *(const bf16x8*)(sA + (wr * 64 + i * 16 + fr) * 128 + cho);
#pragma unroll
        for (int j = 0; j < 4; ++j) bfr[j] = *(const bf16x8*)(sB + (wc * 64 + j * 16 + fr) * 128 + cho);
#pragma unroll
        for (int i = 0; i < 4; ++i)
#pragma unroll
          for (int j = 0; j < 4; ++j) acc[i][j] = __builtin_amdgcn_mfma_f32_16x16x32_bf16(bfr[j], af[i], acc[i][j], 0, 0, 0);
      }
    }
    if (kt + 1 < nk) G_STORE(st ^ 1, kt + 1);
    __syncthreads();
  }
#undef G_LOAD
#undef G_XFORM
#undef G_STORE
}


#define G2_STAGE_BYTES 32768
#define G2_MU_OFF (3 * G2_STAGE_BYTES)
DEV int g2_swz(int row) { return (0x78 >> (2 * ((row >> 2) & 3))) & 3; }
template <int AMODE>
DEV void gemm_main256(f32x4 (&acc)[8][4], const u16* __restrict__ A, int lda, const u16* __restrict__ Bt, int ldb, int nk64,
                      int m0, int n0, const float* __restrict__ mu, const u16* __restrict__ SH, char* smem) {
  const int tid = threadIdx.x, lane = tid & 63, wid = tid >> 6, wr = wid >> 2, wc = wid & 3, fr = lane & 15, fq = lane >> 4;
  const int nk = nk64 * 2;
  const int lrow2 = 2 * (tid >> 2), lch = tid & 3;
#pragma unroll
  for (int i = 0; i < 8; ++i)
#pragma unroll
    for (int j = 0; j < 4; ++j) acc[i][j] = (f32x4){0.f, 0.f, 0.f, 0.f};
  const u16* pa0 = A + (size_t)(m0 + lrow2) * lda + lch * 8;
  const u16* pp0 = nullptr;
  if (AMODE != 0) pp0 = seq_start(m0 + lrow2) ? SH + seq_of(m0 + lrow2) * 1024 + lch * 8 : pa0 - lda;
  const u16* pb0 = Bt + (size_t)(n0 + lrow2) * ldb + lch * 8;
  const int woff0 = (lrow2 + 0) * 64 + ((lch ^ g2_swz(lrow2 + 0)) << 4);
  const int woff1 = (lrow2 + 1) * 64 + ((lch ^ g2_swz(lrow2 + 1)) << 4);
  const float* muL = (const float*)(smem + G2_MU_OFF);
  if (AMODE == 1) {
    if (tid < 256) *(float4*)(smem + G2_MU_OFF + tid * 16) = *(const float4*)(mu + tid * 4);
  }
  uint4 xa0, xa1, xp, xb0, xb1;
  uint4 ya0, ya1, yp, yb0, yb1;
  xp = yp = make_uint4(0, 0, 0, 0);

#define K_LOAD(S, kt)                                                                  \
  {                                                                                    \
    const int k0_ = (kt) * 32;                                                         \
    S##a0 = *(const uint4*)(pa0 + k0_); S##a1 = *(const uint4*)(pa0 + lda + k0_);      \
    if (AMODE == 1) S##p = *(const uint4*)(pp0 + k0_);                                 \
    S##b0 = *(const uint4*)(pb0 + k0_); S##b1 = *(const uint4*)(pb0 + ldb + k0_);      \
  }
#define K_XFORM(dst, a_, p_)                                                           \
  {                                                                                    \
    if (AMODE == 0) dst = a_;                                                          \
    else {                                                                             \
      float h_[8], q_[8]; unpack8(a_, h_); unpack8(p_, q_);                            \
      dst.x = pack2(h_[0] + mu0.x * (q_[0] - h_[0]), h_[1] + mu0.y * (q_[1] - h_[1])); \
      dst.y = pack2(h_[2] + mu0.z * (q_[2] - h_[2]), h_[3] + mu0.w * (q_[3] - h_[3])); \
      dst.z = pack2(h_[4] + mu1.x * (q_[4] - h_[4]), h_[5] + mu1.y * (q_[5] - h_[5])); \
      dst.w = pack2(h_[6] + mu1.z * (q_[6] - h_[6]), h_[7] + mu1.w * (q_[7] - h_[7])); \
    }                                                                                  \
  }
#define K_STORE(S, stage, kt)                                                          \
  {                                                                                    \
    char* sA_ = smem + (stage) * G2_STAGE_BYTES; char* sB_ = sA_ + 16384;              \
    uint4 v_; float4 mu0, mu1;                                                         \
    if (AMODE == 1) { mu0 = *(const float4*)(muL + (kt) * 32 + lch * 8); mu1 = *(const float4*)(muL + (kt) * 32 + lch * 8 + 4); } \
    K_XFORM(v_, S##a0, S##p); *(uint4*)(sA_ + woff0) = v_;                             \
    K_XFORM(v_, S##a1, S##a0); *(uint4*)(sA_ + woff1) = v_;                            \
    *(uint4*)(sB_ + woff0) = S##b0; *(uint4*)(sB_ + woff1) = S##b1;                    \
  }
#define K_COMPUTE_HALF(stage, i0)                                                      \
  {                                                                                    \
    const char* sA_ = smem + (stage) * G2_STAGE_BYTES;                                 \
    _Pragma("unroll") for (int i = (i0); i < (i0) + 4; ++i) {                          \
      const bf16x8 af = *(const bf16x8*)(sA_ + (wr * 128 + i * 16 + fr) * 64 + cho);   \
      _Pragma("unroll") for (int j = 0; j < 4; ++j) acc[i][j] = __builtin_amdgcn_mfma_f32_16x16x32_bf16(bfr[j], af, acc[i][j], 0, 0, 0); \
    }                                                                                  \
  }
#define K_LOAD_B(stage)                                                                \
  {                                                                                    \
    const char* sB_ = smem + (stage) * G2_STAGE_BYTES + 16384;                         \
    _Pragma("unroll") for (int j = 0; j < 4; ++j) bfr[j] = *(const bf16x8*)(sB_ + (wc * 64 + j * 16 + fr) * 64 + cho); \
  }
#define K_ITER(kt, L, S)                                                               \
  {                                                                                    \
    K_LOAD(L, min((kt) + 2, nk - 1));                                                  \
    __builtin_amdgcn_sched_barrier(0);                                                 \
    bf16x8 bfr[4];                                                                     \
    K_LOAD_B(cu);                                                                      \
    K_COMPUTE_HALF(cu, 0);                                                             \
    __builtin_amdgcn_sched_barrier(0);                                                 \
    K_STORE(S, nx, min((kt) + 1, nk - 1));                                             \
    __builtin_amdgcn_sched_barrier(0);                                                 \
    if (AMODE == 1) K_LOAD_B(cu);                                                      \
    K_COMPUTE_HALF(cu, 4);                                                             \
    __syncthreads();                                                                   \
    cu = nx; nx = (nx == 2) ? 0 : nx + 1;                                              \
  }
  const int cho = (fq ^ g2_swz(fr)) << 4;
  if (AMODE == 1) __syncthreads();
  K_LOAD(x, 0);
  K_LOAD(y, 1);
  K_STORE(x, 0, 0);
  __syncthreads();
  int cu = 0, nx = 1;
  for (int kt = 0; kt < nk; kt += 2) {
    K_ITER(kt, x, y);
    K_ITER(kt + 1, y, x);
  }
#undef K_LOAD
#undef K_XFORM
#undef K_STORE
#undef K_COMPUTE_HALF
#undef K_LOAD_B
#undef K_ITER
}


#define GD_NST 4
DEV void gemm_main256_dma(f32x4 (&acc)[8][4], const u16* __restrict__ A, int lda, const u16* __restrict__ Bt, int ldb, int nk64,
                          int m0, int n0, char* smem) {
  const int tid = threadIdx.x, lane = tid & 63, wid = tid >> 6, wr = wid >> 2, wc = wid & 3, fr = lane & 15, fq = lane >> 4;
  const int nk = nk64 * 2;
#pragma unroll
  for (int i = 0; i < 8; ++i)
#pragma unroll
    for (int j = 0; j < 4; ++j) acc[i][j] = (f32x4){0.f, 0.f, 0.f, 0.f};
  const int prow = 16 * wid + (lane >> 2);
  const int pch = (lane & 3) ^ g2_swz(prow);
  const u16* srcA = A + (size_t)(m0 + prow) * lda + pch * 8;
  const u16* srcB = Bt + (size_t)(n0 + prow) * ldb + pch * 8;
  const size_t a128 = (size_t)128 * lda, b128 = (size_t)128 * ldb;
  char* ldsw = smem + (16 * wid) * 64;
#define D_FILL(kt, stage)                                                              \
  {                                                                                    \
    const int k0_ = (kt) * 32;                                                         \
    char* d_ = ldsw + (stage) * G2_STAGE_BYTES;                                        \
    __builtin_amdgcn_global_load_lds((const unsigned*)(srcA + k0_), (unsigned*)(d_), 16, 0, 0);               \
    __builtin_amdgcn_global_load_lds((const unsigned*)(srcA + a128 + k0_), (unsigned*)(d_ + 8192), 16, 0, 0); \
    __builtin_amdgcn_global_load_lds((const unsigned*)(srcB + k0_), (unsigned*)(d_ + 16384), 16, 0, 0);       \
    __builtin_amdgcn_global_load_lds((const unsigned*)(srcB + b128 + k0_), (unsigned*)(d_ + 16384 + 8192), 16, 0, 0); \
  }
  const int cho = (fq ^ g2_swz(fr)) << 4;
  __syncthreads();
  D_FILL(0, 0);
  D_FILL(min(1, nk - 1), 1);
  D_FILL(min(2, nk - 1), 2);
  int cu = 0, fill = 3;
  for (int kt = 0; kt < nk; ++kt) {
    asm volatile("s_waitcnt vmcnt(8)" ::: "memory");
    asm volatile("s_waitcnt lgkmcnt(0)" ::: "memory");
    __builtin_amdgcn_s_barrier();
    D_FILL(min(kt + 3, nk - 1), fill);
    {
      const char* sA_ = smem + cu * G2_STAGE_BYTES;
      const char* sB_ = sA_ + 16384;
      bf16x8 bfr[4];
#pragma unroll
      for (int j = 0; j < 4; ++j) bfr[j] = *(const bf16x8*)(sB_ + (wc * 64 + j * 16 + fr) * 64 + cho);
#pragma unroll
      for (int i = 0; i < 8; ++i) {
        const bf16x8 af = *(const bf16x8*)(sA_ + (wr * 128 + i * 16 + fr) * 64 + cho);
#pragma unroll
        for (int j = 0; j < 4; ++j) acc[i][j] = __builtin_amdgcn_mfma_f32_16x16x32_bf16(bfr[j], af, acc[i][j], 0, 0, 0);
      }
    }
    cu = (cu == GD_NST - 1) ? 0 : cu + 1;
    fill = (fill == GD_NST - 1) ? 0 : fill + 1;
  }
  asm volatile("s_waitcnt vmcnt(0)" ::: "memory");
  asm volatile("s_waitcnt lgkmcnt(0)" ::: "memory");
  __builtin_amdgcn_s_barrier();
#undef D_FILL
}

DEV void transpose_tile(const float* __restrict__ src, int N, int k0, int n0, const float* __restrict__ scale, u16* __restrict__ dst,
                        int dstride, int drow0, int dcol0, char* smem) {
  float* tile = (float*)smem;
  const int tid = threadIdx.x;
#pragma unroll
  for (int i = 0; i < 2; ++i) {
    int kl = (tid >> 4) + 32 * i, n4 = (tid & 15) * 4;
    float4 v = *(const float4*)(src + (size_t)(k0 + kl) * N + n0 + n4);
    float s = scale ? scale[k0 + kl] : 1.0f;
    tile[kl * 65 + n4 + 0] = v.x * s; tile[kl * 65 + n4 + 1] = v.y * s;
    tile[kl * 65 + n4 + 2] = v.z * s; tile[kl * 65 + n4 + 3] = v.w * s;
  }
  __syncthreads();
  {
    int nl = tid >> 3, k8 = (tid & 7) * 8;
    uint4 o;
    o.x = pack2(tile[(k8 + 0) * 65 + nl], tile[(k8 + 1) * 65 + nl]);
    o.y = pack2(tile[(k8 + 2) * 65 + nl], tile[(k8 + 3) * 65 + nl]);
    o.z = pack2(tile[(k8 + 4) * 65 + nl], tile[(k8 + 5) * 65 + nl]);
    o.w = pack2(tile[(k8 + 6) * 65 + nl], tile[(k8 + 7) * 65 + nl]);
    *(uint4*)(dst + (size_t)(drow0 + n0 + nl) * dstride + dcol0 + k0 + k8) = o;
  }
  __syncthreads();
}

DEV void phase_prep(const Params& p, char* smem) {
  const int tid = threadIdx.x;
  char* ws = p.ws;
  if (blockIdx.x < 96) {
    float* cL = (float*)smem;
    float* red = (float*)(smem + 98304);
    for (int e = tid; e < 24 * 256; e += NTHREADS) {
      int s = e >> 8, k4 = (e & 255) * 4;
      float4 v = s < 8 ? *(const float4*)(p.in[I_CP] + s * 1024 + k4) : *(const float4*)(p.in[I_CS] + (s - 8) * 1024 + k4);
      *(float4*)(cL + s * 1024 + k4) = v;
    }
    __syncthreads();
    for (int item = blockIdx.x; item < 96; item += gridDim.x) {
      const int l = item / 48, j0 = (item % 48) * 64;
      const float* W = (l == 0 ? p.in[I_AADAW] : p.in[I_BADAW]);
      const float* bias = (l == 0 ? p.in[I_AADAB] : p.in[I_BADAB]);
      const int col = tid & 63, kg = tid >> 6;
      float acc[24];
#pragma unroll
      for (int s = 0; s < 24; ++s) acc[s] = 0.f;
      for (int k = kg * 128; k < kg * 128 + 128; ++k) {
        float w = W[(size_t)k * 3072 + j0 + col];
#pragma unroll
        for (int s = 0; s < 24; ++s) acc[s] += cL[s * 1024 + k] * w;
      }
#pragma unroll
      for (int s = 0; s < 24; ++s) red[(kg * 24 + s) * 64 + col] = acc[s];
      __syncthreads();
      float* mod = (float*)(ws + WS_MOD);
      for (int e = tid; e < 24 * 64; e += NTHREADS) {
        int s = e >> 6, c = e & 63;
        float t = bias[j0 + c];
#pragma unroll
        for (int g = 0; g < 8; ++g) t += red[(g * 24 + s) * 64 + c];
        mod[(size_t)(l * 24 + s) * 3072 + j0 + c] = t;
      }
      __syncthreads();
    }
  }
  if (blockIdx.x == 0) for (int e = tid; e < 1024; e += NTHREADS) ((unsigned*)(ws + WS_CTR))[e] = 0u;
  if (blockIdx.x == gridDim.x - 1) {
    u16* SH = (u16*)(ws + WS_SH);
    for (int e = tid; e < 24 * 1024; e += NTHREADS) {
      int s = e >> 10, k = e & 1023;
      float v = s < 8 ? 0.f : p.in[I_SSH][(s - 8) * 1024 + k];
      SH[e] = (u16)(pack2(v, 0.f) & 0xffff);
    }
  }
  const int NT_TOTAL = 2048 + 512 + 1024 + 1024 + 512 + 32 + 32 + 64;
  for (int t = blockIdx.x; t < NT_TOTAL; t += gridDim.x) {
    const float* src; int K, N; u16* dst; int dstride, drow0 = 0, dcol0 = 0; const float* scale = nullptr; int tt = t;
    if (tt < 2048) { src = p.in[I_AWIN]; K = 1024; N = 8192; dst = (u16*)(ws + WS_WT_IN); dstride = 1024; }
    else if ((tt -= 2048) < 512) { src = p.in[I_AWOUT]; K = 2048; N = 1024; dst = (u16*)(ws + WS_WT_OUTA); dstride = 2048; }
    else if ((tt -= 512) < 1024) { src = p.in[I_KVW]; K = 1024; N = 4096; dst = (u16*)(ws + WS_WT_KV); dstride = 1024; }
    else if ((tt -= 1024) < 1024) { src = p.in[I_BWIN]; K = 1024; N = 4096; dst = (u16*)(ws + WS_WT_INB); dstride = 1024; }
    else if ((tt -= 1024) < 512) { src = p.in[I_BWOUT]; K = 2048; N = 1024; dst = (u16*)(ws + WS_WT_OUTB); dstride = 2048; }
    else if ((tt -= 512) < 32) { src = p.in[I_AW2]; K = 64; N = 2048; dst = (u16*)(ws + WS_W2T); dstride = 64; }
    else if ((tt -= 32) < 32) { src = p.in[I_AA2]; K = 64; N = 2048; dst = (u16*)(ws + WS_A2T); dstride = 64; }
    else {
      tt -= 32;
      int job = tt >> 4; tt &= 15;
      K = 1024; N = 64; dst = (u16*)(ws + WS_L1T); dstride = 2048;
      src = (job < 2) ? p.in[I_AW1] : p.in[I_AA1];
      drow0 = (job < 2) ? 0 : 64;
      if (job & 1) { dcol0 = 1024; scale = (job < 2) ? p.in[I_AMUW] : p.in[I_AMUA]; }
    }
    const int ntn = N / 64;
    const int kt = tt / ntn, nt = tt % ntn;
    transpose_tile(src, N, kt * 64, nt * 64, scale, dst, dstride, drow0, dcol0, smem);
  }
}

DEV void phase_norm0(const Params& p) {
  const int lane = threadIdx.x & 63, wid = threadIdx.x >> 6;
  const float* mod = (const float*)(p.ws + WS_MOD);
  u16* H0 = (u16*)(p.ws + WS_H0);
  const float* g = p.in[I_ANG];
  for (int t = blockIdx.x * 8 + wid; t < NTOK; t += gridDim.x * 8) {
    const float* x = t < TP ? p.in[I_XP] + (size_t)t * 1024 : p.in[I_XS] + (size_t)(t - TP) * 1024;
    const int s = seq_of(t);
    const float* md = mod + (size_t)s * 3072;
    float4 v[4];
    float ss = 0.f;
#pragma unroll
    for (int i = 0; i < 4; ++i) {
      v[i] = *(const float4*)(x + lane * 4 + 256 * i);
      ss += v[i].x * v[i].x + v[i].y * v[i].y + v[i].z * v[i].z + v[i].w * v[i].w;
    }
    ss = wave_sum(ss);
    const float rstd = rsqrtf(ss * (1.0f / 1024.0f) + 1e-6f);
    bool last = t < TP ? ((t & 4095) == 4095) : (((t - TP) & 31) == 31);
    float* so = t < TP ? p.out + OFF_SH_P + (t >> 12) * 1024 : p.out + OFF_SH_S + ((t - TP) >> 5) * 1024;
#pragma unroll
    for (int i = 0; i < 4; ++i) {
      const int c = lane * 4 + 256 * i;
      float4 gg = *(const float4*)(g + c), sh = *(const float4*)(md + c), sc = *(const float4*)(md + 1024 + c);
      float4 h;
      h.x = v[i].x * rstd * gg.x * (1.f + sc.x) + sh.x;
      h.y = v[i].y * rstd * gg.y * (1.f + sc.y) + sh.y;
      h.z = v[i].z * rstd * gg.z * (1.f + sc.z) + sh.z;
      h.w = v[i].w * rstd * gg.w * (1.f + sc.w) + sh.w;
      uint2 o; o.x = pack2(h.x, h.y); o.y = pack2(h.z, h.w);
      *(uint2*)(H0 + (size_t)t * 1024 + c) = o;
      if (last) *(float4*)(so + c) = h;
    }
  }
}

DEV void phase_proj0_lora(const Params& p, char* smem) {
  const int tid = threadIdx.x, lane = tid & 63, wid = tid >> 6, fr = lane & 15, fq = lane >> 4;
  const int wr = wid >> 1, wc = wid & 1;
  char* ws = p.ws;
  const u16* H0 = (const u16*)(ws + WS_H0);
  const u16* SH = (const u16*)(ws + WS_SH);
  u16* T = (u16*)(ws + WS_T);
  const int xcc0 = xcc_id();
  int nxt;
  f32x4 acc[4][4];
  for (int ls = 0; ls < 8; ++ls) {
  const int xcd = (xcc0 + ls) & 7;
  unsigned* ctr = sched_ctr(p, 0, xcd);
  for (int li = sched_first(ctr, smem); li < 17; li = sched_commit(nxt, smem)) {
    nxt = sched_prefetch(ctr);
    const int lmt = xcd + 8 * li;
    if (lmt >= 130) continue;
    const int m0 = lmt * 256;
    gemm_main<2>(acc, H0, 1024, (const u16*)(ws + WS_L1T), 2048, 32, m0, 0, nullptr, SH, smem);
#pragma unroll
    for (int i = 0; i < 4; ++i)
#pragma unroll
      for (int j = 0; j < 4; ++j) {
        const int m = m0 + wr * 64 + i * 16 + fr, n = wc * 64 + j * 16 + fq * 4;
        f32x4 v = acc[i][j];
        if (wc == 0) { v[0] = tanhf(v[0]); v[1] = tanhf(v[1]); v[2] = tanhf(v[2]); v[3] = tanhf(v[3]); }
        uint2 o; o.x = pack2(v[0], v[1]); o.y = pack2(v[2], v[3]);
        *(uint2*)(T + (size_t)m * 128 + n) = o;
      }
    __threadfence_block();
    __syncthreads();
    for (int nt = 0; nt < 32; ++nt) {
      const int which = nt >> 4, n0 = (nt & 15) * 128;
      gemm_main<0>(acc, T + which * 64, 128, (const u16*)(ws + (which ? WS_A2T : WS_W2T)), 64, 1, m0, n0, nullptr, nullptr, smem);
      const float* bias = which ? p.in[I_AA0] : p.in[I_AW0];
      u16* dst = (u16*)(ws + (which ? 5ull : 4ull) * SLOT);
      const float sc = which ? 1.0f : -0.60653066f;
#pragma unroll
      for (int i = 0; i < 4; ++i)
#pragma unroll
        for (int j = 0; j < 4; ++j) {
          const int m = m0 + wr * 64 + i * 16 + fr, n = n0 + wc * 64 + j * 16 + fq * 4;
          float4 b4 = *(const float4*)(bias + n);
          f32x4 v = acc[i][j];
          float s0 = sc * sigmoidf_(v[0] + b4.x), s1 = sc * sigmoidf_(v[1] + b4.y), s2 = sc * sigmoidf_(v[2] + b4.z), s3 = sc * sigmoidf_(v[3] + b4.w);
          uint2 o; o.x = pack2(s0, s1); o.y = pack2(s2, s3);
          *(uint2*)(dst + (size_t)m * 2048 + n) = o;
        }
    }
  }
  }
}

DEV void phase_proj0_main(const Params& p, char* smem) {
  const int tid = threadIdx.x, lane = tid & 63, wid = tid >> 6, fr = lane & 15, fq = lane >> 4;
  const int wr = wid >> 2, wc = wid & 3;
  char* ws = p.ws;
  const u16* H0 = (const u16*)(ws + WS_H0);
  const u16* SH = (const u16*)(ws + WS_SH);
  const int xcc0 = xcc_id();
  int nxt;
  f32x4 acc[8][4];
  for (int ls = 0; ls < 8; ++ls) {
  const int xcd = (xcc0 + ls) & 7;
  unsigned* ctr = sched_ctr(p, 4, xcd);
  for (int q = sched_first(ctr, smem); q < 520; q = sched_commit(nxt, smem)) {
    nxt = sched_prefetch(ctr);
    const int mt = q >> 2, nt = 4 * xcd + (q & 3);
    const int part = nt >> 3;
    const int m0 = mt * 256, n0 = nt * 256;
    gemm_main256<1>(acc, H0, 1024, (const u16*)(ws + WS_WT_IN), 1024, 16, m0, n0, p.in[I_AMUIN] + part * 1024, SH, smem);
    u16* dst = (u16*)(ws + (size_t)part * SLOT);
    const int nb = n0 - part * 2048;
#pragma unroll
    for (int i = 0; i < 8; ++i)
#pragma unroll
      for (int j = 0; j < 4; ++j) {
        const int m = m0 + wr * 128 + i * 16 + fr, n = nb + wc * 64 + j * 16 + fq * 4;
        f32x4 v = acc[i][j];
        uint2 o; o.x = pack2(v[0], v[1]); o.y = pack2(v[2], v[3]);
        *(uint2*)(dst + (size_t)m * 2048 + n) = o;
      }
  }
  }
}

DEV void phase_proj0(const Params& p, char* smem) {
  phase_proj0_lora(p, smem);
  phase_proj0_main(p, smem);
}

DEV void phase_scan(const Params& p, char* smem) {
  const int tid = threadIdx.x, lane = tid & 63, wid = tid >> 6;
  float* Lkk = (float*)smem;
  float* Lw = Lkk + 4096;
  float* Lb = Lw + 4096;
  float* Lk = Lb + 4096;
  float* Lwr = Lk + 4096;
  float* Lv = Lwr + 4096;
  float* LY = Lv + 4096;
  float* Lbon = LY + 8192;
  float* Lsc = Lbon + 64;
  char* ws = p.ws;
  const u16* gR = (const u16*)(ws + 0 * SLOT);
  const u16* gK = (const u16*)(ws + 1 * SLOT);
  const u16* gV = (const u16*)(ws + 2 * SLOT);
  const u16* gZ = (const u16*)(ws + 3 * SLOT);
  const u16* gW = (const u16*)(ws + 4 * SLOT);
  const u16* gA = (const u16*)(ws + 5 * SLOT);
  u16* YG = (u16*)(ws + 6 * SLOT);
  const int tt = tid >> 3, c8 = (tid & 7) * 8;
  const int rp = wid * 4 + (lane >> 4), kc = lane & 15;

  for (int item = blockIdx.x; item < 768; item += gridDim.x) {
    int h, tok0, nsteps; const float* sinit; float* sout;
    if (item < 256) { h = item & 31; tok0 = (item >> 5) * 4096; nsteps = 4096; sinit = nullptr; sout = p.out + OFF_WKV_P + (size_t)item * 4096; }
    else { int it = item - 256; h = it & 31; tok0 = TP + (it >> 5) * 32; nsteps = 32; sinit = p.in[I_SWKV] + (size_t)it * 4096; sout = p.out + OFF_WKV_S + (size_t)it * 4096; }
    const int nch = (nsteps + 63) >> 6;
    const int col0 = h * 64 + c8;
    float ckk[8], cka[8], crk[8], clg[8], clb[8];
    {
      float4 t0, t1;
      t0 = *(const float4*)(p.in[I_AKK] + col0); t1 = *(const float4*)(p.in[I_AKK] + col0 + 4);
      ckk[0] = t0.x; ckk[1] = t0.y; ckk[2] = t0.z; ckk[3] = t0.w; ckk[4] = t1.x; ckk[5] = t1.y; ckk[6] = t1.z; ckk[7] = t1.w;
      t0 = *(const float4*)(p.in[I_AKA] + col0); t1 = *(const float4*)(p.in[I_AKA] + col0 + 4);
      cka[0] = t0.x; cka[1] = t0.y; cka[2] = t0.z; cka[3] = t0.w; cka[4] = t1.x; cka[5] = t1.y; cka[6] = t1.z; cka[7] = t1.w;
      t0 = *(const float4*)(p.in[I_ARK] + col0); t1 = *(const float4*)(p.in[I_ARK] + col0 + 4);
      crk[0] = t0.x; crk[1] = t0.y; crk[2] = t0.z; crk[3] = t0.w; crk[4] = t1.x; crk[5] = t1.y; crk[6] = t1.z; crk[7] = t1.w;
      t0 = *(const float4*)(p.in[I_ALNG] + col0); t1 = *(const float4*)(p.in[I_ALNG] + col0 + 4);
      clg[0] = t0.x; clg[1] = t0.y; clg[2] = t0.z; clg[3] = t0.w; clg[4] = t1.x; clg[5] = t1.y; clg[6] = t1.z; clg[7] = t1.w;
      t0 = *(const float4*)(p.in[I_ALNB] + col0); t1 = *(const float4*)(p.in[I_ALNB] + col0 + 4);
      clb[0] = t0.x; clb[1] = t0.y; clb[2] = t0.z; clb[3] = t0.w; clb[4] = t1.x; clb[5] = t1.y; clb[6] = t1.z; clb[7] = t1.w;
    }
    float s0[4], s1[4];
    if (sinit) {
      float4 a = *(const float4*)(sinit + (2 * rp) * 64 + kc * 4), b = *(const float4*)(sinit + (2 * rp + 1) * 64 + kc * 4);
      s0[0] = a.x; s0[1] = a.y; s0[2] = a.z; s0[3] = a.w; s1[0] = b.x; s1[1] = b.y; s1[2] = b.z; s1[3] = b.w;
    } else {
#pragma unroll
      for (int j = 0; j < 4; ++j) { s0[j] = 0.f; s1[j] = 0.f; }
    }
    uint4 cr, ck, cv, cz, cw, ca;
#define SCAN_LOAD(c)                                                                   \
    {                                                                                  \
      const int tl_ = (c) * 64 + tt;                                                   \
      if (tl_ < nsteps) {                                                              \
        const size_t o_ = (size_t)(tok0 + tl_) * 2048 + col0;                          \
        cr = *(const uint4*)(gR + o_); ck = *(const uint4*)(gK + o_); cv = *(const uint4*)(gV + o_); \
        cz = *(const uint4*)(gZ + o_); cw = *(const uint4*)(gW + o_); ca = *(const uint4*)(gA + o_); \
      } else { cr = ck = cv = cz = cw = ca = make_uint4(0, 0, 0, 0); }                 \
    }
    SCAN_LOAD(0);
    for (int c = 0; c < nch; ++c) {
      uint4 zc = cz;
      {
        float r[8], k[8], v[8], lw[8], a[8];
        unpack8(cr, r); unpack8(ck, k); unpack8(cv, v); unpack8(cw, lw); unpack8(ca, a);
        float kkv[8], kp[8], w[8], bon = 0.f, ss = 0.f, kr = 0.f;
#pragma unroll
        for (int j = 0; j < 8; ++j) {
          kkv[j] = k[j] * ckk[j]; ss += kkv[j] * kkv[j];
          kp[j] = k[j] * (1.f + (a[j] - 1.f) * cka[j]);
          bon += r[j] * kp[j] * crk[j];
          kr += r[j] * kp[j];
          w[j] = __expf(lw[j]);
        }
        ss = red8(ss); bon = red8(bon); kr = red8(kr);
        const float inv = rsqrtf(ss + 1e-12f);
        float bb[8], br = 0.f;
#pragma unroll
        for (int j = 0; j < 8; ++j) { kkv[j] *= inv; bb[j] = kkv[j] * a[j]; br += bb[j] * r[j]; }
        br = red8(br);
        float* d;
        d = Lkk + tt * 64 + c8;
        *(float4*)d = make_float4(kkv[0], kkv[1], kkv[2], kkv[3]); *(float4*)(d + 4) = make_float4(kkv[4], kkv[5], kkv[6], kkv[7]);
        d = Lb + tt * 64 + c8;
        *(float4*)d = make_float4(bb[0], bb[1], bb[2], bb[3]); *(float4*)(d + 4) = make_float4(bb[4], bb[5], bb[6], bb[7]);
        d = Lw + tt * 64 + c8;
        *(float4*)d = make_float4(w[0], w[1], w[2], w[3]); *(float4*)(d + 4) = make_float4(w[4], w[5], w[6], w[7]);
        d = Lk + tt * 64 + c8;
        *(float4*)d = make_float4(kp[0], kp[1], kp[2], kp[3]); *(float4*)(d + 4) = make_float4(kp[4], kp[5], kp[6], kp[7]);
        d = Lwr + tt * 64 + c8;
        *(float4*)d = make_float4(w[0] * r[0], w[1] * r[1], w[2] * r[2], w[3] * r[3]);
        *(float4*)(d + 4) = make_float4(w[4] * r[4], w[5] * r[5], w[6] * r[6], w[7] * r[7]);
        d = Lv + tt * 64 + c8;
        *(float4*)d = make_float4(v[0], v[1], v[2], v[3]); *(float4*)(d + 4) = make_float4(v[4], v[5], v[6], v[7]);
        if ((tid & 7) == 0) { Lbon[tt] = bon; *(float2*)(Lsc + tt * 2) = make_float2(br, kr); }
      }
      __syncthreads();
      if (c + 1 < nch) SCAN_LOAD(c + 1);
      {
        const int nT = min(64, nsteps - c * 64);
        const float* pk = Lkk + kc * 4; const float* pw = Lw + kc * 4; const float* pb = Lb + kc * 4;
        const float* pkp = Lk + kc * 4; const float* pwr = Lwr + kc * 4; const float* pv = Lv + rp * 2;
        float* py = LY + rp * 4;
#define SCAN_LD(S, o)                                                                  \
        S##kk = *(const float4*)(pk + (o)); S##w = *(const float4*)(pw + (o)); S##b = *(const float4*)(pb + (o)); \
        S##k = *(const float4*)(pkp + (o)); S##wr = *(const float4*)(pwr + (o)); S##v = *(const float2*)(pv + (o)); \

#define SCAN_STEP(S, o)                                                                \
        {                                                                              \
          float d0 = s0[0] * S##kk.x + s0[1] * S##kk.y + s0[2] * S##kk.z + s0[3] * S##kk.w;  \
          float d1 = s1[0] * S##kk.x + s1[1] * S##kk.y + s1[2] * S##kk.z + s1[3] * S##kk.w;  \
          float e0 = s0[0] * S##wr.x + s0[1] * S##wr.y + s0[2] * S##wr.z + s0[3] * S##wr.w;  \
          float e1 = s1[0] * S##wr.x + s1[1] * S##wr.y + s1[2] * S##wr.z + s1[3] * S##wr.w;  \
          d0 += dppf<0xB1>(d0); d1 += dppf<0xB1>(d1); e0 += dppf<0xB1>(e0); e1 += dppf<0xB1>(e1);       \
          d0 += dppf<0x4E>(d0); d1 += dppf<0x4E>(d1); e0 += dppf<0x4E>(e0); e1 += dppf<0x4E>(e1);       \
          d0 += dppf<0x141>(d0); d1 += dppf<0x141>(d1); e0 += dppf<0x141>(e0); e1 += dppf<0x141>(e1);   \
          d0 += dppf<0x140>(d0); d1 += dppf<0x140>(d1); e0 += dppf<0x140>(e0); e1 += dppf<0x140>(e1);   \
          s0[0] = s0[0] * S##w.x + (S##v.x * S##k.x - d0 * S##b.x);                    \
          s0[1] = s0[1] * S##w.y + (S##v.x * S##k.y - d0 * S##b.y);                    \
          s0[2] = s0[2] * S##w.z + (S##v.x * S##k.z - d0 * S##b.z);                    \
          s0[3] = s0[3] * S##w.w + (S##v.x * S##k.w - d0 * S##b.w);                    \
          s1[0] = s1[0] * S##w.x + (S##v.y * S##k.x - d1 * S##b.x);                    \
          s1[1] = s1[1] * S##w.y + (S##v.y * S##k.y - d1 * S##b.y);                    \
          s1[2] = s1[2] * S##w.z + (S##v.y * S##k.z - d1 * S##b.z);                    \
          s1[3] = s1[3] * S##w.w + (S##v.y * S##k.w - d1 * S##b.w);                    \
          if (kc == 0) *(float4*)(py + 2 * (o)) = make_float4(e0, e1, d0, d1);             \
        }
        float4 Akk, Aw, Ab, Ak, Awr, Bkk, Bw, Bb, Bk, Bwr; float2 Av, Bv;
        SCAN_LD(A, 0);
        for (int t = 0; t < nT; t += 2) {
          SCAN_LD(B, (t + 1) * 64);
          SCAN_STEP(A, t * 64);
          SCAN_LD(A, (t + 2) * 64);
          SCAN_STEP(B, (t + 1) * 64);
        }
#undef SCAN_LD
#undef SCAN_STEP
      }
      __syncthreads();
      {
        const int tl = c * 64 + tt;
        if (tl < nsteps) {
          float y[8], z[8];
          const float2 sc = *(const float2*)(Lsc + tt * 2);
          float4 va = *(const float4*)(Lv + tt * 64 + c8), vb = *(const float4*)(Lv + tt * 64 + c8 + 4);
          float vv[8] = {va.x, va.y, va.z, va.w, vb.x, vb.y, vb.z, vb.w};
#pragma unroll
          for (int q = 0; q < 4; ++q) {
            const float4 ed = *(const float4*)(LY + tt * 128 + (c8 / 2 + q) * 4);
            y[2 * q] = ed.x - ed.z * sc.x + vv[2 * q] * sc.y;
            y[2 * q + 1] = ed.y - ed.w * sc.x + vv[2 * q + 1] * sc.y;
          }
          float sm = y[0] + y[1] + y[2] + y[3] + y[4] + y[5] + y[6] + y[7];
          sm = red8(sm);
          const float mean = sm * (1.f / 64.f);
          float vs = 0.f;
#pragma unroll
          for (int j = 0; j < 8; ++j) { y[j] -= mean; vs += y[j] * y[j]; }
          vs = red8(vs);
          const float rstd = rsqrtf(vs * (1.f / 64.f) + 64e-5f);
          const float bon = Lbon[tt];
          unpack8(zc, z);
          float o[8];
#pragma unroll
          for (int j = 0; j < 8; ++j) {
            float t = y[j] * rstd * clg[j] + clb[j] + bon * vv[j];
            o[j] = t * z[j] * sigmoidf_(z[j]);
          }
          uint4 ov; ov.x = pack2(o[0], o[1]); ov.y = pack2(o[2], o[3]); ov.z = pack2(o[4], o[5]); ov.w = pack2(o[6], o[7]);
          *(uint4*)(YG + (size_t)(tok0 + tl) * 2048 + col0) = ov;
        }
      }
      __syncthreads();
    }
#undef SCAN_LOAD
    *(float4*)(sout + (2 * rp) * 64 + kc * 4) = make_float4(s0[0], s0[1], s0[2], s0[3]);
    *(float4*)(sout + (2 * rp + 1) * 64 + kc * 4) = make_float4(s1[0], s1[1], s1[2], s1[3]);
  }
}

template <int LAYER>
DEV void outproj_store(const Params& p, const float* mod, float* xmid, int m, int n, f32x4 v) {
  const float* gate = mod + (size_t)seq_of(m) * 3072 + 2048;
  float4 g4 = *(const float4*)(gate + n);
  if (LAYER == 0) {
    const float* xr = m < TP ? p.in[I_XP] + (size_t)m * 1024 : p.in[I_XS] + (size_t)(m - TP) * 1024;
    float4 x4 = *(const float4*)(xr + n);
    *(float4*)(xmid + (size_t)m * 1024 + n) = make_float4(x4.x + g4.x * v[0], x4.y + g4.y * v[1], x4.z + g4.z * v[2], x4.w + g4.w * v[3]);
  } else {
    float4 x4 = *(const float4*)(xmid + (size_t)m * 1024 + n);
    float* yo = m < TP ? p.out + OFF_Y_P + (size_t)m * 1024 : p.out + OFF_Y_S + (size_t)(m - TP) * 1024;
    *(float4*)(yo + n) = make_float4(x4.x + g4.x * v[0], x4.y + g4.y * v[1], x4.z + g4.z * v[2], x4.w + g4.w * v[3]);
  }
}

template <int LAYER>
DEV void phase_outproj_main(const Params& p, char* smem) {
  const int tid = threadIdx.x, lane = tid & 63, wid = tid >> 6, wr = wid >> 2, wc = wid & 3, fr = lane & 15, fq = lane >> 4;
  char* ws = p.ws;
  const u16* A = (const u16*)(ws + 6 * SLOT);
  const u16* Bt = (const u16*)(ws + (LAYER == 0 ? WS_WT_OUTA : WS_WT_OUTB));
  const float* mod = (const float*)(ws + WS_MOD) + (size_t)LAYER * 24 * 3072;
  float* xmid = (float*)(ws + 0 * SLOT);
  f32x4 acc[8][4];
  const int xcc0 = xcc_id();
  int nxt;
  for (int ls = 0; ls < 8; ++ls) {
    const int xcd = (xcc0 + ls) & 7;
    unsigned* ctr = sched_ctr(p, LAYER == 0 ? 1 : 3, xcd);
    for (int li = sched_first(ctr, smem); li < 64; li = sched_commit(nxt, smem)) {
      nxt = sched_prefetch(ctr);
      const int item = 64 * xcd + li;
      const int m0 = (item >> 2) * 256, n0 = (item & 3) * 256;
      gemm_main256_dma(acc, A, 2048, Bt, 2048, 32, m0, n0, smem);
#pragma unroll
      for (int i = 0; i < 8; ++i)
#pragma unroll
        for (int j = 0; j < 4; ++j)
          outproj_store<LAYER>(p, mod, xmid, m0 + wr * 128 + i * 16 + fr, n0 + wc * 64 + j * 16 + fq * 4, acc[i][j]);
    }
  }
}

template <int LAYER>
DEV void phase_outproj_tail(const Params& p, char* smem) {
  const int tid = threadIdx.x, lane = tid & 63, wid = tid >> 6, wr = wid >> 1, wc = wid & 1, fr = lane & 15, fq = lane >> 4;
  char* ws = p.ws;
  const u16* A = (const u16*)(ws + 6 * SLOT);
  const u16* Bt = (const u16*)(ws + (LAYER == 0 ? WS_WT_OUTA : WS_WT_OUTB));
  const float* mod = (const float*)(ws + WS_MOD) + (size_t)LAYER * 24 * 3072;
  float* xmid = (float*)(ws + 0 * SLOT);
  f32x4 acc[4][4];
  const int xcc0 = xcc_id();
  int nxt;
  for (int ls = 0; ls < 8; ++ls) {
    const int xcd = (xcc0 + ls) & 7;
    unsigned* ctr = sched_ctr(p, LAYER == 0 ? 5 : 6, xcd);
    for (int li = sched_first(ctr, smem); li < 2; li = sched_commit(nxt, smem)) {
      nxt = sched_prefetch(ctr);
      const int item = 2 * xcd + li;
      const int m0 = (128 + (item >> 3)) * 256, n0 = (item & 7) * 128;
      gemm_main<0>(acc, A, 2048, Bt, 2048, 32, m0, n0, nullptr, nullptr, smem);
#pragma unroll
      for (int i = 0; i < 4; ++i)
#pragma unroll
        for (int j = 0; j < 4; ++j)
          outproj_store<LAYER>(p, mod, xmid, m0 + wr * 64 + i * 16 + fr, n0 + wc * 64 + j * 16 + fq * 4, acc[i][j]);
    }
  }
}

template <int LAYER>
DEV void phase_outproj(const Params& p, char* smem) {
  phase_outproj_tail<LAYER>(p, smem);
  phase_outproj_main<LAYER>(p, smem);
}

DEV void phase_norm1(const Params& p) {
  const int lane = threadIdx.x & 63, wid = threadIdx.x >> 6;
  const float* mod = (const float*)(p.ws + WS_MOD) + (size_t)24 * 3072;
  const float* xmid = (const float*)(p.ws + 0 * SLOT);
  u16* AKV = (u16*)(p.ws + 1 * SLOT);
  u16* AQ = AKV + (size_t)NTOK * 1024;
  const float* gkv = p.in[I_KVNG];
  const float* gb = p.in[I_BNG];
  for (int t = blockIdx.x * 8 + wid; t < NTOK; t += gridDim.x * 8) {
    const float* x = xmid + (size_t)t * 1024;
    const float* md = mod + (size_t)seq_of(t) * 3072;
    float4 v[4];
    float ss = 0.f;
#pragma unroll
    for (int i = 0; i < 4; ++i) {
      v[i] = *(const float4*)(x + lane * 4 + 256 * i);
      ss += v[i].x * v[i].x + v[i].y * v[i].y + v[i].z * v[i].z + v[i].w * v[i].w;
    }
    ss = wave_sum(ss);
    const float rstd = rsqrtf(ss * (1.0f / 1024.0f) + 1e-6f);
#pragma unroll
    for (int i = 0; i < 4; ++i) {
      const int c = lane * 4 + 256 * i;
      float4 g1 = *(const float4*)(gkv + c), g2 = *(const float4*)(gb + c), sh = *(const float4*)(md + c), sc = *(const float4*)(md + 1024 + c);
      float xn0 = v[i].x * rstd, xn1 = v[i].y * rstd, xn2 = v[i].z * rstd, xn3 = v[i].w * rstd;
      uint2 o;
      o.x = pack2(xn0 * g1.x, xn1 * g1.y); o.y = pack2(xn2 * g1.z, xn3 * g1.w);
      *(uint2*)(AKV + (size_t)t * 1024 + c) = o;
      o.x = pack2(xn0 * g2.x * (1.f + sc.x) + sh.x, xn1 * g2.y * (1.f + sc.y) + sh.y);
      o.y = pack2(xn2 * g2.z * (1.f + sc.z) + sh.z, xn3 * g2.w * (1.f + sc.w) + sh.w);
      *(uint2*)(AQ + (size_t)t * 1024 + c) = o;
    }
  }
}

#define QSCALE (0.08838834764831845f * 1.4426950408889634f)
DEV void phase_proj1(const Params& p, char* smem) {
  const int tid = threadIdx.x, lane = tid & 63, wid = tid >> 6, wr = wid >> 2, wc = wid & 3, fr = lane & 15, fq = lane >> 4;
  char* ws = p.ws;
  const u16* AKV = (const u16*)(ws + 1 * SLOT);
  const u16* AQ = AKV + (size_t)NTOK * 1024;
  u16* KB = (u16*)(ws + 2 * SLOT);
  u16* VB = (u16*)(ws + 3 * SLOT);
  u16* QB = (u16*)(ws + 4 * SLOT);
  u16* ZS = (u16*)(ws + 5 * SLOT);
  f32x4 acc[8][4];
  float* red = (float*)smem;
  const int xcc0 = xcc_id();
  int nxt;
  for (int ls = 0; ls < 8; ++ls) {
  const int xcd = (xcc0 + ls) & 7;
  unsigned* ctr = sched_ctr(p, 2, xcd);
  for (int li = sched_first(ctr, smem); li < 520; li = sched_commit(nxt, smem)) {
    nxt = sched_prefetch(ctr);
    const int mt = li >> 2, t = 4 * xcd + (li & 3);
    const int isq = t >> 4, nt = t & 15;
    const int m0 = mt * 256, n0 = nt * 256;
    gemm_main256_dma(acc, isq ? AQ : AKV, 1024, (const u16*)(ws + (isq ? WS_WT_INB : WS_WT_KV)), 1024, 16, m0, n0, smem);
    if (nt < 8) {
#pragma unroll
      for (int i = 0; i < 8; ++i) {
        float ss = 0.f;
#pragma unroll
        for (int j = 0; j < 4; ++j) ss += acc[i][j][0] * acc[i][j][0] + acc[i][j][1] * acc[i][j][1] + acc[i][j][2] * acc[i][j][2] + acc[i][j][3] * acc[i][j][3];
        red[(wr * 128 + i * 16 + fr) * 16 + wc * 4 + fq] = ss;
      }
      __syncthreads();
      const float* gain = isq ? p.in[I_BQG] : p.in[I_KGAIN];
#pragma unroll
      for (int i = 0; i < 8; ++i) {
        const int row = wr * 128 + i * 16 + fr, m = m0 + row;
        float4 ra = *(const float4*)(red + row * 16 + (wc >> 1) * 8), rb = *(const float4*)(red + row * 16 + (wc >> 1) * 8 + 4);
        float tot = ra.x + ra.y + ra.z + ra.w + rb.x + rb.y + rb.z + rb.w;
        float rs = rsqrtf(tot * (1.f / 128.f) + 1e-6f);
        if (isq) rs *= QSCALE;
#pragma unroll
        for (int j = 0; j < 4; ++j) {
          const int d = (wc & 1) * 64 + j * 16 + fq * 4, n = n0 + wc * 64 + j * 16 + fq * 4;
          float4 g4 = *(const float4*)(gain + d);
          f32x4 v = acc[i][j];
          float o0 = v[0] * rs * g4.x, o1 = v[1] * rs * g4.y, o2 = v[2] * rs * g4.z, o3 = v[3] * rs * g4.w;
          uint2 o; o.x = pack2(o0, o1); o.y = pack2(o2, o3);
          if (isq) {
            *(uint2*)(QB + (size_t)m * 2048 + n) = o;
          } else {
            *(uint2*)(KB + (size_t)m * 2048 + n) = o;
            float* ko = m < TP ? p.out + OFF_K_P + (size_t)m * 2048 : p.out + OFF_K_S + (size_t)(m - TP) * 2048;
            *(float4*)(ko + n) = make_float4(o0, o1, o2, o3);
          }
        }
      }
      __syncthreads();
    } else {
#pragma unroll
      for (int i = 0; i < 8; ++i) {
        const int m = m0 + wr * 128 + i * 16 + fr;
#pragma unroll
        for (int j = 0; j < 4; ++j) {
          const int n = n0 - 2048 + wc * 64 + j * 16 + fq * 4;
          f32x4 v = acc[i][j];
          if (isq) {
            float o0 = v[0] * sigmoidf_(v[0]), o1 = v[1] * sigmoidf_(v[1]), o2 = v[2] * sigmoidf_(v[2]), o3 = v[3] * sigmoidf_(v[3]);
            uint2 o; o.x = pack2(o0, o1); o.y = pack2(o2, o3);
            *(uint2*)(ZS + (size_t)m * 2048 + n) = o;
          } else {
            uint2 o; o.x = pack2(v[0], v[1]); o.y = pack2(v[2], v[3]);
            *(uint2*)(VB + (size_t)m * 2048 + n) = o;
            float* vo = m < TP ? p.out + OFF_V_P + (size_t)m * 2048 : p.out + OFF_V_S + (size_t)(m - TP) * 2048;
            *(float4*)(vo + n) = make_float4(v[0], v[1], v[2], v[3]);
          }
        }
      }
    }
  }
}
}

DEV unsigned off_b(unsigned row, unsigned ch) { return 256u * row + 16u * (ch ^ (((row & 3) << 2) | ((row >> 2) & 3))); }

DEV void phase_attn(const Params& p, char* smem) {
  const int tid = threadIdx.x, lane = tid & 63, w = tid >> 6, fr = lane & 15, fq = lane >> 4;
  char* ws = p.ws;
  const u16* KB = (const u16*)(ws + 2 * SLOT);
  const u16* VB = (const u16*)(ws + 3 * SLOT);
  const u16* QB = (const u16*)(ws + 4 * SLOT);
  const u16* ZS = (const u16*)(ws + 5 * SLOT);
  u16* OG = (u16*)(ws + 6 * SLOT);
  const int lrow = tid >> 4, lch = tid & 15;
  const unsigned lw0 = off_b(lrow, lch), lw1 = off_b(lrow + 32, lch);
  const int tq = (lane & 15) >> 2, tp = lane & 3;

  for (int item = blockIdx.x; item < 4096 + 256; item += gridDim.x) {
    int b, h, nq, qpos0, tokq0, ntiles, nkeys, tokk0; bool sample;
    if (item < 4096) {
      const int qblk = 31 - (item >> 7), bh = item & 127;
      b = bh >> 4; h = bh & 15; nq = 128; qpos0 = qblk * 128; tokq0 = b * 4096 + qpos0; ntiles = 2 * qblk + 2; nkeys = qpos0 + 128; tokk0 = b * 4096; sample = false;
    } else {
      const int bh = item - 4096;
      b = bh >> 4; h = bh & 15; nq = 32; qpos0 = 1024; tokq0 = TP + b * 32; ntiles = 17; nkeys = 1056; tokk0 = TP + b * 32 - 1024; sample = true;
    }
    const bool wactive = (w * 16) < nq;
    int* dflag = (int*)(smem + 65536);
    __syncthreads();
    if (lane == 0) dflag[w] = wactive ? 0 : 1;
    bool wdone = !wactive;
    const int qp = qpos0 + w * 16 + fr;
    const int qwmax = qpos0 + w * 16 + 15;
    bf16x8 qf[4];
#pragma unroll
    for (int ks = 0; ks < 4; ++ks) {
      if (wactive) qf[ks] = *(const bf16x8*)(QB + (size_t)(tokq0 + w * 16 + fr) * 2048 + h * 128 + ks * 32 + fq * 8);
      else qf[ks] = (bf16x8){0, 0, 0, 0, 0, 0, 0, 0};
    }
    f32x4 O[8];
#pragma unroll
    for (int dt = 0; dt < 8; ++dt) O[dt] = (f32x4){0, 0, 0, 0};
    float carry = 0.f;

    uint4 lk0, lk1, lv0, lv1;
#define ATT_LOAD(kb)                                                                                  \
    {                                                                                                 \
      const int kx0_ = (kb) * 64 + lrow, kx1_ = kx0_ + 32;                                            \
      if (sample && (kb) < 16) {                                                                      \
        const float* ck_ = p.in[I_CK] + ((size_t)(b * 1024 + kx0_) * 16 + h) * 128 + lch * 8;         \
        const float* cv_ = p.in[I_CV] + ((size_t)(b * 1024 + kx0_) * 16 + h) * 128 + lch * 8;         \
        float4 a_ = *(const float4*)ck_, b_ = *(const float4*)(ck_ + 4);                              \
        float4 c_ = *(const float4*)(ck_ + 32 * 2048), d_ = *(const float4*)(ck_ + 32 * 2048 + 4);    \
        lk0 = make_uint4(pack2(a_.x, a_.y), pack2(a_.z, a_.w), pack2(b_.x, b_.y), pack2(b_.z, b_.w)); \
        lk1 = make_uint4(pack2(c_.x, c_.y), pack2(c_.z, c_.w), pack2(d_.x, d_.y), pack2(d_.z, d_.w)); \
        a_ = *(const float4*)cv_; b_ = *(const float4*)(cv_ + 4);                                     \
        c_ = *(const float4*)(cv_ + 32 * 2048); d_ = *(const float4*)(cv_ + 32 * 2048 + 4);           \
        lv0 = make_uint4(pack2(a_.x, a_.y), pack2(a_.z, a_.w), pack2(b_.x, b_.y), pack2(b_.z, b_.w)); \
        lv1 = make_uint4(pack2(c_.x, c_.y), pack2(c_.z, c_.w), pack2(d_.x, d_.y), pack2(d_.z, d_.w)); \
      } else {                                                                                        \
        const size_t o0_ = (size_t)(tokk0 + kx0_) * 2048 + h * 128 + lch * 8;                         \
        const size_t o1_ = o0_ + (size_t)32 * 2048;                                                   \
        if (kx0_ < nkeys) { lk0 = *(const uint4*)(KB + o0_); lv0 = *(const uint4*)(VB + o0_); }       \
        else { lk0 = make_uint4(0, 0, 0, 0); lv0 = lk0; }                                             \
        if (kx1_ < nkeys) { lk1 = *(const uint4*)(KB + o1_); lv1 = *(const uint4*)(VB + o1_); }       \
        else { lk1 = make_uint4(0, 0, 0, 0); lv1 = lk1; }                                             \
      }                                                                                               \
    }
#define ATT_STORE(st)                                                                                 \
    {                                                                                                 \
      char* sK_ = smem + (st) * 32768; char* sV_ = sK_ + 16384;                                       \
      *(uint4*)(sK_ + lw0) = lk0; *(uint4*)(sK_ + lw1) = lk1;                                         \
      *(uint4*)(sV_ + lw0) = lv0; *(uint4*)(sV_ + lw1) = lv1;                                         \
    }
    ATT_LOAD(ntiles - 1);
    ATT_STORE(0);
    __syncthreads();
    for (int it = 0; it < ntiles; ++it) {
      const int kb = ntiles - 1 - it, st = it & 1;
      if (it + 1 < ntiles) ATT_LOAD(kb - 1);
      if (!wdone && kb * 64 < qwmax) {
        const char* sK = smem + st * 32768;
        const char* sV = sK + 16384;
        f32x4 S[4];
#pragma unroll
        for (int mt = 0; mt < 4; ++mt) S[mt] = (f32x4){0, 0, 0, 0};
#pragma unroll
        for (int ks = 0; ks < 4; ++ks)
#pragma unroll
          for (int mt = 0; mt < 4; ++mt) {
            bf16x8 a = *(const bf16x8*)(sK + off_b(mt * 16 + fr, ks * 4 + fq));
            S[mt] = __builtin_amdgcn_mfma_f32_16x16x32_bf16(a, qf[ks], S[mt], 0, 0, 0);
          }
        bf16x8 wf[2];
        {
          float ee[4][4], tot[4], hi[4];
#pragma unroll
          for (int mt = 0; mt < 4; ++mt) {
            const int kbase = kb * 64 + mt * 16 + fq * 4;
            float ls[4];
#pragma unroll
            for (int jj = 0; jj < 4; ++jj) {
              const float u = S[mt][jj];
              const bool valid = (kbase + jj) < qp;
              const float l = -__builtin_amdgcn_logf(1.0f + __builtin_amdgcn_exp2f(u));
              ls[jj] = valid ? l : 0.f;
              ee[mt][jj] = valid ? (u + l) : -1e30f;
            }
            const float x3 = ls[3], x2 = x3 + ls[2], x1 = x2 + ls[1], seg = x1 + ls[0];
            ee[mt][2] += x3; ee[mt][1] += x2; ee[mt][0] += x1;
            const float t1 = __shfl_xor(seg, 16), t2 = __shfl_xor(seg, 32), t3 = __shfl_xor(t1, 32);
            tot[mt] = seg + t1 + t2 + t3;
            hi[mt] = fq == 0 ? (t1 + t2 + t3) : fq == 1 ? (t2 + t3) : fq == 2 ? t1 : 0.f;
          }
          float run = carry;
          float wv[4][4];
#pragma unroll
          for (int mt = 3; mt >= 0; --mt) {
            const float base = run + hi[mt];
            run += tot[mt];
#pragma unroll
            for (int jj = 0; jj < 4; ++jj) wv[mt][jj] = __builtin_amdgcn_exp2f(ee[mt][jj] + base);
          }
          carry = run;
          if (__all(carry < -150.0f)) { wdone = true; if (lane == 0) dflag[w] = 1; }
#pragma unroll
          for (int p2 = 0; p2 < 2; ++p2) {
            uint4 pk;
            pk.x = pack2(wv[2 * p2][0], wv[2 * p2][1]); pk.y = pack2(wv[2 * p2][2], wv[2 * p2][3]);
            pk.z = pack2(wv[2 * p2 + 1][0], wv[2 * p2 + 1][1]); pk.w = pack2(wv[2 * p2 + 1][2], wv[2 * p2 + 1][3]);
            wf[p2] = *(bf16x8*)&pk;
          }
        }
#pragma unroll
        for (int p2 = 0; p2 < 2; ++p2)
#pragma unroll
          for (int dt = 0; dt < 8; ++dt) {
            const unsigned r0 = 32 * p2 + 4 * fq + tq, r1 = r0 + 16;
            const unsigned ch = 2 * dt + (tp >> 1);
            const char* a0 = sV + off_b(r0, ch) + 8 * (tp & 1);
            const char* a1 = sV + off_b(r1, ch) + 8 * (tp & 1);
            s16x4 lo = __builtin_amdgcn_ds_read_tr16_b64_v4i16((s16x4 __attribute__((address_space(3)))*)(a0));
            s16x4 hi4 = __builtin_amdgcn_ds_read_tr16_b64_v4i16((s16x4 __attribute__((address_space(3)))*)(a1));
            bf16x8 a = {lo[0], lo[1], lo[2], lo[3], hi4[0], hi4[1], hi4[2], hi4[3]};
            O[dt] = __builtin_amdgcn_mfma_f32_16x16x32_bf16(a, wf[p2], O[dt], 0, 0, 0);
          }
      }
      if (it + 1 < ntiles) ATT_STORE(st ^ 1);
      __syncthreads();
      {
        const int4 f0 = *(const int4*)dflag, f1 = *(const int4*)(dflag + 4);
        if (f0.x & f0.y & f0.z & f0.w & f1.x & f1.y & f1.z & f1.w) break;
      }
    }
#undef ATT_LOAD
#undef ATT_STORE
    if (wactive) {
      const size_t rowoff = (size_t)(tokq0 + w * 16 + fr) * 2048 + h * 128;
#pragma unroll
      for (int dt = 0; dt < 8; ++dt) {
        const int d = dt * 16 + fq * 4;
        uint2 z = *(const uint2*)(ZS + rowoff + d);
        f32x4 v = O[dt];
        uint2 o;
        o.x = pack2(v[0] * bflo(z.x), v[1] * bfhi(z.x)); o.y = pack2(v[2] * bflo(z.y), v[3] * bfhi(z.y));
        *(uint2*)(OG + rowoff + d) = o;
      }
    }
  }
}


DEV void grid_barrier(unsigned* bar, unsigned target) {
  __syncthreads();
  if (threadIdx.x == 0) {
    __builtin_amdgcn_fence(__ATOMIC_RELEASE, "agent");
    asm volatile("s_waitcnt vmcnt(0)" ::: "memory");
    __hip_atomic_fetch_add(bar, 1u, __ATOMIC_RELAXED, __HIP_MEMORY_SCOPE_AGENT);
    while (__hip_atomic_load(bar, __ATOMIC_RELAXED, __HIP_MEMORY_SCOPE_AGENT) < target) __builtin_amdgcn_s_sleep(1);
    __builtin_amdgcn_fence(__ATOMIC_ACQUIRE, "agent");
    asm volatile("s_waitcnt vmcnt(0)" ::: "memory");
  }
  __syncthreads();
}

__global__ void __launch_bounds__(NTHREADS) __attribute__((target("no-packed-fp32-ops"))) mega(Params p, int lo, int hi) {
  __shared__ __attribute__((aligned(16))) char smem[147456];
  cg::grid_group grid = cg::this_grid();
#ifndef PROBE_DOUBLE
#define PROBE_DOUBLE -1
#endif
#define RUN_PHASE(k, call) if ((k) >= lo && (k) < hi) { if ((k) > lo) { if ((k) == lo + 1) grid.sync(); else grid_barrier((unsigned*)(p.ws + WS_BAR), (unsigned)((k) - lo - 1) * gridDim.x); } call; }
  RUN_PHASE(0, phase_prep(p, smem))
  RUN_PHASE(1, phase_norm0(p))
  RUN_PHASE(2, phase_proj0(p, smem))
  RUN_PHASE(3, phase_scan(p, smem))
  RUN_PHASE(4, phase_outproj<0>(p, smem))
  RUN_PHASE(5, phase_norm1(p))
  RUN_PHASE(6, phase_proj1(p, smem))
  RUN_PHASE(7, phase_attn(p, smem))
  RUN_PHASE(8, phase_outproj<1>(p, smem))
}

#ifndef N_LAUNCH_MODE
#define N_LAUNCH_MODE 1
#endif

extern "C" void kernel_launch(void* const* d_in, const int* in_sizes, int n_in, void* d_out, int out_size, void* d_ws, size_t ws_size,
                              hipStream_t stream) {
  Params p{};
  for (int i = 0; i < 36; ++i) p.in[i] = (const float*)d_in[i];
  p.out = (float*)d_out;
  p.ws = (char*)d_ws;
  static int grid_blocks = 0;
  if (!grid_blocks) {
    int dev = 0, cus = 0, per_cu = 0;
    hipGetDevice(&dev);
    hipDeviceGetAttribute(&cus, hipDeviceAttributeMultiprocessorCount, dev);
    hipOccupancyMaxActiveBlocksPerMultiprocessor(&per_cu, mega, NTHREADS, 0);
    if (per_cu < 1) per_cu = 1;
    grid_blocks = cus * per_cu;
  }
  if (ws_size < WS_END) { fprintf(stderr, "workspace too small: %zu < %llu\n", ws_size, (unsigned long long)WS_END); return; }
#if N_LAUNCH_MODE == 1
  int lo = 0, hi = 9;
  hipMemsetAsync((char*)d_ws + WS_BAR, 0, 256, stream);
  void* args[] = {&p, &lo, &hi};
  hipError_t e = hipLaunchCooperativeKernel((void*)mega, dim3(grid_blocks), dim3(NTHREADS), args, 0, stream);
  if (e != hipSuccess) fprintf(stderr, "cooperative launch failed: %s (grid %d)\n", hipGetErrorString(e), grid_blocks);
#else
  for (int ph = 0; ph < 9; ++ph) hipLaunchKernelGGL(mega, dim3(grid_blocks), dim3(NTHREADS), 0, stream, p, ph, ph + 1);
#endif
}
```

```cpp
#include <hip/hip_runtime.h>
#include <hip/hip_cooperative_groups.h>
#include <cstdio>
namespace cg = cooperative_groups;

typedef unsigned short u16;
typedef short bf16x8 __attribute__((ext_vector_type(8)));
typedef short s16x4 __attribute__((ext_vector_type(4)));
typedef float f32x4 __attribute__((ext_vector_type(4)));
typedef float f32x2 __attribute__((ext_vector_type(2)));
typedef __bf16 bf16x2_t __attribute__((ext_vector_type(2)));
typedef _Float16 h2_t __attribute__((ext_vector_type(2)));

#define DEV __device__ __forceinline__

#define NTOK 33280
#define TP 32768
#define NTHREADS 512

#define OFF_Y_P 0
#define OFF_Y_S 33554432
#define OFF_K_P 34078720
#define OFF_V_P 101187584
#define OFF_WKV_P 168296448
#define OFF_SH_P 169345024
#define OFF_K_S 169353216
#define OFF_V_S 170401792
#define OFF_WKV_S 171450368
#define OFF_SH_S 173547520

#define SLOT 136314880ull
#define WS_W (7ull * SLOT)
#define WS_WT_IN (WS_W)
#define WS_WT_OUTA (WS_WT_IN + 16777216ull)
#define WS_WT_KV (WS_WT_OUTA + 4194304ull)
#define WS_WT_INB (WS_WT_KV + 8388608ull)
#define WS_WT_OUTB (WS_WT_INB + 8388608ull)
#define WS_W2T (WS_WT_OUTB + 4194304ull)
#define WS_A2T (WS_W2T + 262144ull)
#define WS_L1T (WS_A2T + 262144ull)
#define WS_MOD (WS_L1T + 524288ull)
#define WS_SH (WS_MOD + 589824ull)
#define WS_CTR (WS_SH + 49152ull)
#define WS_BAR (WS_CTR + 4096ull)
#define WS_END (WS_BAR + 256ull)
#define WS_H0 (6ull * SLOT)
#define WS_T (6ull * SLOT + 68157440ull)

struct Params {
  const float* in[36];
  float* out;
  char* ws;
};

enum { I_XP = 0, I_XS, I_CK, I_CV, I_SWKV, I_SSH, I_CP, I_CS, I_ANG, I_AADAW, I_AADAB, I_AWIN, I_AMUIN, I_AMUW, I_AMUA,
       I_AW0, I_AW1, I_AW2, I_AA0, I_AA1, I_AA2, I_AKK, I_AKA, I_ARK, I_ALNG, I_ALNB, I_AWOUT, I_KVNG, I_KVW, I_KGAIN,
       I_BNG, I_BADAW, I_BADAB, I_BWIN, I_BQG, I_BWOUT };

DEV int seq_of(int t) { return t < TP ? (t >> 12) : 8 + ((t - TP) >> 5); }
DEV bool seq_start(int t) { return t < TP ? ((t & 4095) == 0) : (((t - TP) & 31) == 0); }

DEV unsigned pack2(float a, float b) {
  f32x2 v = {a, b};
  bf16x2_t r = __builtin_convertvector(v, bf16x2_t);
  return *(unsigned*)&r;
}
DEV unsigned packh2(float a, float b) {
  f32x2 v = {a, b};
  h2_t r = __builtin_convertvector(v, h2_t);
  return *(unsigned*)&r;
}
DEV float bflo(unsigned w) { return __uint_as_float(w << 16); }
DEV float bfhi(unsigned w) { return __uint_as_float(w & 0xffff0000u); }
DEV void unpack8(const uint4& x, float* f) {
  f[0] = bflo(x.x); f[1] = bfhi(x.x); f[2] = bflo(x.y); f[3] = bfhi(x.y);
  f[4] = bflo(x.z); f[5] = bfhi(x.z); f[6] = bflo(x.w); f[7] = bfhi(x.w);
}
DEV float sigmoidf_(float x) { return 1.0f / (1.0f + __expf(-x)); }

template <int CTRL>
DEV float dppf(float x) {
  return __int_as_float(__builtin_amdgcn_update_dpp(0, __float_as_int(x), CTRL, 0xf, 0xf, true));
}
DEV float red4(float x) { x += dppf<0xB1>(x); x += dppf<0x4E>(x); return x; }
DEV float red8(float x) { x = red4(x); x += dppf<0x141>(x); return x; }
DEV float red16(float x) { x = red8(x); x += dppf<0x140>(x); return x; }
DEV float wave_sum(float x) {
#pragma unroll
  for (int o = 32; o >= 1; o >>= 1) x += __shfl_xor(x, o);
  return x;
}


#define SCHED_SLOT_OFF 147440
DEV int xcc_id() { return (int)(__builtin_amdgcn_s_getreg((3 << 11) | 20) & 0x7u); }
DEV unsigned* sched_ctr(const Params& p, int phase_slot, int list) { return (unsigned*)(p.ws + WS_CTR) + (phase_slot * 8 + list) * 16; }
DEV int sched_first(unsigned* ctr, char* smem) {
  int* slot = (int*)(smem + SCHED_SLOT_OFF);
  __syncthreads();
  if (threadIdx.x == 0) *slot = (int)atomicAdd(ctr, 1u);
  __syncthreads();
  return *slot;
}

DEV void group_sync(unsigned* bar, unsigned target) {
  __syncthreads();
  if (threadIdx.x == 0) {
    __hip_atomic_fetch_add(bar, 1u, __ATOMIC_RELAXED, __HIP_MEMORY_SCOPE_AGENT);
    while (__hip_atomic_load(bar, __ATOMIC_RELAXED, __HIP_MEMORY_SCOPE_AGENT) < target) __builtin_amdgcn_s_sleep(2);
  }
  __syncthreads();
}
DEV int sched_prefetch(unsigned* ctr) { return threadIdx.x == 0 ? (int)atomicAdd(ctr, 1u) : 0; }
DEV int sched_commit(int nxt, char* smem) {
  int* slot = (int*)(smem + SCHED_SLOT_OFF);
  __syncthreads();
  if (threadIdx.x == 0) *slot = nxt;
  __syncthreads();
  return *slot;
}

#define GEMM_STAGE_BYTES 49152

template <int AMODE>
DEV void gemm_main(f32x4 (&acc)[4][4], const u16* __restrict__ A, int lda, const u16* __restrict__ Bt, int ldb, int nk,
                   int m0, int n0, const float* __restrict__ mu, const u16* __restrict__ SH, char* smem) {
  const int tid = threadIdx.x, lane = tid & 63, wid = tid >> 6, wr = wid >> 1, wc = wid & 1, fr = lane & 15, fq = lane >> 4;
  const int lrow = tid >> 3, lch = tid & 7;
#pragma unroll
  for (int i = 0; i < 4; ++i)
#pragma unroll
    for (int j = 0; j < 4; ++j) acc[i][j] = (f32x4){0.f, 0.f, 0.f, 0.f};

  const u16* pa0; const u16* pa1; const u16* pa2; const u16* pa3;
  const u16* pp0 = nullptr;
  const int arow = 4 * lrow;
  {
    int m = m0 + arow;
    pa0 = A + (size_t)m * lda + lch * 8;
    pa1 = pa0 + lda; pa2 = pa1 + lda; pa3 = pa2 + lda;
    if (AMODE != 0) pp0 = seq_start(m) ? SH + seq_of(m) * 1024 + lch * 8 : pa0 - lda;
  }
  const u16* pb0 = Bt + (size_t)(n0 + lrow) * ldb + lch * 8;
  const u16* pb1 = pb0 + (size_t)64 * ldb;
  const int woffB = lrow * 128 + ((lch ^ ((lrow >> 1) & 7)) << 4);
  const int woffA0 = (arow + 0) * 128 + ((lch ^ (((arow + 0) >> 1) & 7)) << 4);
  const int woffA1 = (arow + 1) * 128 + ((lch ^ (((arow + 1) >> 1) & 7)) << 4);
  const int woffA2 = (arow + 2) * 128 + ((lch ^ (((arow + 2) >> 1) & 7)) << 4);
  const int woffA3 = (arow + 3) * 128 + ((lch ^ (((arow + 3) >> 1) & 7)) << 4);

  uint4 ra0, ra1, ra2, ra3, rp0, rb0, rb1;
  float4 mu0, mu1;
  rp0 = make_uint4(0, 0, 0, 0);
  mu0 = mu1 = make_float4(0, 0, 0, 0);

#define G_LOAD(kt)                                                                     \
  {                                                                                    \
    const int k0_ = (kt) * 64;                                                         \
    if (AMODE == 0) {                                                                  \
      ra0 = *(const uint4*)(pa0 + k0_); ra1 = *(const uint4*)(pa1 + k0_);              \
      ra2 = *(const uint4*)(pa2 + k0_); ra3 = *(const uint4*)(pa3 + k0_);              \
    } else if (AMODE == 1) {                                                           \
      ra0 = *(const uint4*)(pa0 + k0_); ra1 = *(const uint4*)(pa1 + k0_);              \
      ra2 = *(const uint4*)(pa2 + k0_); ra3 = *(const uint4*)(pa3 + k0_);              \
      rp0 = *(const uint4*)(pp0 + k0_);                                                \
      mu0 = *(const float4*)(mu + k0_ + lch * 8); mu1 = *(const float4*)(mu + k0_ + lch * 8 + 4); \
    } else {                                                                           \
      const int kk_ = k0_ & 1023;                                                      \
      ra0 = *(const uint4*)(pa0 + kk_); ra1 = *(const uint4*)(pa1 + kk_);              \
      ra2 = *(const uint4*)(pa2 + kk_); ra3 = *(const uint4*)(pa3 + kk_);              \
      if (k0_ >= 1024) rp0 = *(const uint4*)(pp0 + kk_);                               \
    }                                                                                  \
    rb0 = *(const uint4*)(pb0 + k0_); rb1 = *(const uint4*)(pb1 + k0_);                \
  }

#define G_XFORM(dst, a_, p_, kt)                                                       \
  {                                                                                    \
    if (AMODE == 0) dst = a_;                                                          \
    else if (AMODE == 1) {                                                             \
      float h_[8], q_[8]; unpack8(a_, h_); unpack8(p_, q_);                            \
      dst.x = pack2(h_[0] + mu0.x * (q_[0] - h_[0]), h_[1] + mu0.y * (q_[1] - h_[1])); \
      dst.y = pack2(h_[2] + mu0.z * (q_[2] - h_[2]), h_[3] + mu0.w * (q_[3] - h_[3])); \
      dst.z = pack2(h_[4] + mu1.x * (q_[4] - h_[4]), h_[5] + mu1.y * (q_[5] - h_[5])); \
      dst.w = pack2(h_[6] + mu1.z * (q_[6] - h_[6]), h_[7] + mu1.w * (q_[7] - h_[7])); \
    } else {                                                                           \
      if ((kt) * 64 >= 1024) {                                                         \
        float h_[8], q_[8]; unpack8(a_, h_); unpack8(p_, q_);                          \
        dst.x = pack2(q_[0] - h_[0], q_[1] - h_[1]); dst.y = pack2(q_[2] - h_[2], q_[3] - h_[3]); \
        dst.z = pack2(q_[4] - h_[4], q_[5] - h_[5]); dst.w = pack2(q_[6] - h_[6], q_[7] - h_[7]); \
      } else dst = a_;                                                                 \
    }                                                                                  \
  }

#define G_STORE(stage, kt)                                                             \
  {                                                                                    \
    char* sA_ = smem + (stage) * GEMM_STAGE_BYTES; char* sB_ = sA_ + 32768;            \
    uint4 v_;                                                                          \
    G_XFORM(v_, ra0, rp0, kt); *(uint4*)(sA_ + woffA0) = v_;                           \
    G_XFORM(v_, ra1, ra0, kt); *(uint4*)(sA_ + woffA1) = v_;                           \
    G_XFORM(v_, ra2, ra1, kt); *(uint4*)(sA_ + woffA2) = v_;                           \
    G_XFORM(v_, ra3, ra2, kt); *(uint4*)(sA_ + woffA3) = v_;                           \
    *(uint4*)(sB_ + woffB) = rb0; *(uint4*)(sB_ + woffB + 64 * 128) = rb1;             \
  }

  G_LOAD(0);
  G_STORE(0, 0);
  __syncthreads();
  const int rsw = (fr >> 1) & 7;
  for (int kt = 0; kt < nk; ++kt) {
    const int st = kt & 1;
    if (kt + 1 < nk) G_LOAD(kt + 1);
    __builtin_amdgcn_sched_barrier(0);
    {
      const char* sA = smem + st * GEMM_STAGE_BYTES;
      const char* sB = sA + 32768;
#pragma unroll
      for (int kk = 0; kk < 2; ++kk) {
        bf16x8 af[4], bfr[4];
        const int cho = ((kk * 4 + fq) ^ rsw) << 4;
#pragma unroll
        for (int i = 0; i < 4; ++i) af[i] = *(const bf16x8*)(sA + (wr * 64 + i * 16 + fr) * 128 + cho);
#pragma unroll
        for (int j = 0; j < 4; ++j) bfr[j] = *(const bf16x8*)(sB + (wc * 64 + j * 16 + fr) * 128 + cho);
#pragma unroll
        for (int i = 0; i < 4; ++i)
#pragma unroll
          for (int j = 0; j < 4; ++j) acc[i][j] = __builtin_amdgcn_mfma_f32_16x16x32_bf16(bfr[j], af[i], acc[i][j], 0, 0, 0);
      }
    }
    if (kt + 1 < nk) G_STORE(st ^ 1, kt + 1);
    __syncthreads();
  }
#undef G_LOAD
#undef G_XFORM
#undef G_STORE
}


#define G2_STAGE_BYTES 32768
#define G2_MU_OFF (3 * G2_STAGE_BYTES)
DEV int g2_swz(int row) { return (0x78 >> (2 * ((row >> 2) & 3))) & 3; }
template <int AMODE>
DEV void gemm_main256(f32x4 (&acc)[8][4], const u16* __restrict__ A, int lda, const u16* __restrict__ Bt, int ldb, int nk64,
                      int m0, int n0, const float* __restrict__ mu, const u16* __restrict__ SH, char* smem) {
  const int tid = threadIdx.x, lane = tid & 63, wid = tid >> 6, wr = wid >> 2, wc = wid & 3, fr = lane & 15, fq = lane >> 4;
  const int nk = nk64 * 2;
  const int lrow2 = 2 * (tid >> 2), lch = tid & 3;
#pragma unroll
  for (int i = 0; i < 8; ++i)
#pragma unroll
    for (int j = 0; j < 4; ++j) acc[i][j] = (f32x4){0.f, 0.f, 0.f, 0.f};
  const u16* pa0 = A + (size_t)(m0 + lrow2) * lda + lch * 8;
  const u16* pp0 = nullptr;
  if (AMODE != 0) pp0 = seq_start(m0 + lrow2) ? SH + seq_of(m0 + lrow2) * 1024 + lch * 8 : pa0 - lda;
  const u16* pb0 = Bt + (size_t)(n0 + lrow2) * ldb + lch * 8;
  const int woff0 = (lrow2 + 0) * 64 + ((lch ^ g2_swz(lrow2 + 0)) << 4);
  const int woff1 = (lrow2 + 1) * 64 + ((lch ^ g2_swz(lrow2 + 1)) << 4);
  const float* muL = (const float*)(smem + G2_MU_OFF);
  if (AMODE == 1) {
    if (tid < 256) *(float4*)(smem + G2_MU_OFF + tid * 16) = *(const float4*)(mu + tid * 4);
  }
  uint4 xa0, xa1, xp, xb0, xb1;
  uint4 ya0, ya1, yp, yb0, yb1;
  xp = yp = make_uint4(0, 0, 0, 0);

#define K_LOAD(S, kt)                                                                  \
  {                                                                                    \
    const int k0_ = (kt) * 32;                                                         \
    S##a0 = *(const uint4*)(pa0 + k0_); S##a1 = *(const uint4*)(pa0 + lda + k0_);      \
    if (AMODE == 1) S##p = *(const uint4*)(pp0 + k0_);                                 \
    S##b0 = *(const uint4*)(pb0 + k0_); S##b1 = *(const uint4*)(pb0 + ldb + k0_);      \
  }
#define K_XFORM(dst, a_, p_)                                                           \
  {                                                                                    \
    if (AMODE == 0) dst = a_;                                                          \
    else {                                                                             \
      float h_[8], q_[8]; unpack8(a_, h_); unpack8(p_, q_);                            \
      dst.x = pack2(h_[0] + mu0.x * (q_[0] - h_[0]), h_[1] + mu0.y * (q_[1] - h_[1])); \
      dst.y = pack2(h_[2] + mu0.z * (q_[2] - h_[2]), h_[3] + mu0.w * (q_[3] - h_[3])); \
      dst.z = pack2(h_[4] + mu1.x * (q_[4] - h_[4]), h_[5] + mu1.y * (q_[5] - h_[5])); \
      dst.w = pack2(h_[6] + mu1.z * (q_[6] - h_[6]), h_[7] + mu1.w * (q_[7] - h_[7])); \
    }                                                                                  \
  }
#define K_STORE(S, stage, kt)                                                          \
  {                                                                                    \
    char* sA_ = smem + (stage) * G2_STAGE_BYTES; char* sB_ = sA_ + 16384;              \
    uint4 v_; float4 mu0, mu1;                                                         \
    if (AMODE == 1) { mu0 = *(const float4*)(muL + (kt) * 32 + lch * 8); mu1 = *(const float4*)(muL + (kt) * 32 + lch * 8 + 4); } \
    K_XFORM(v_, S##a0, S##p); *(uint4*)(sA_ + woff0) = v_;                             \
    K_XFORM(v_, S##a1, S##a0); *(uint4*)(sA_ + woff1) = v_;                            \
    *(uint4*)(sB_ + woff0) = S##b0; *(uint4*)(sB_ + woff1) = S##b1;                    \
  }
#define K_COMPUTE_HALF(stage, i0)                                                      \
  {                                                                                    \
    const char* sA_ = smem + (stage) * G2_STAGE_BYTES;                                 \
    _Pragma("unroll") for (int i = (i0); i < (i0) + 4; ++i) {                          \
      const bf16x8 af = *(const bf16x8*)(sA_ + (wr * 128 + i * 16 + fr) * 64 + cho);   \
      _Pragma("unroll") for (int j = 0; j < 4; ++j) acc[i][j] = __builtin_amdgcn_mfma_f32_16x16x32_bf16(bfr[j], af, acc[i][j], 0, 0, 0); \
    }                                                                                  \
  }
#define K_LOAD_B(stage)                                                                \
  {                                                                                    \
    const char* sB_ = smem + (stage) * G2_STAGE_BYTES + 16384;                         \
    _Pragma("unroll") for (int j = 0; j < 4; ++j) bfr[j] = *(const bf16x8*)(sB_ + (wc * 64 + j * 16 + fr) * 64 + cho); \
  }
#define K_ITER(kt, L, S)                                                               \
  {                                                                                    \
    K_LOAD(L, min((kt) + 2, nk - 1));                                                  \
    __builtin_amdgcn_sched_barrier(0);                                                 \
    bf16x8 bfr[4];                                                                     \
    K_LOAD_B(cu);                                                                      \
    K_COMPUTE_HALF(cu, 0);                                                             \
    __builtin_amdgcn_sched_barrier(0);                                                 \
    K_STORE(S, nx, min((kt) + 1, nk - 1));                                             \
    __builtin_amdgcn_sched_barrier(0);                                                 \
    if (AMODE == 1) K_LOAD_B(cu);                                                      \
    K_COMPUTE_HALF(cu, 4);                                                             \
    __syncthreads();                                                                   \
    cu = nx; nx = (nx == 2) ? 0 : nx + 1;                                              \
  }
  const int cho = (fq ^ g2_swz(fr)) << 4;
  if (AMODE == 1) __syncthreads();
  K_LOAD(x, 0);
  K_LOAD(y, 1);
  K_STORE(x, 0, 0);
  __syncthreads();
  int cu = 0, nx = 1;
  for (int kt = 0; kt < nk; kt += 2) {
    K_ITER(kt, x, y);
    K_ITER(kt + 1, y, x);
  }
#undef K_LOAD
#undef K_XFORM
#undef K_STORE
#undef K_COMPUTE_HALF
#undef K_LOAD_B
#undef K_ITER
}


#define GD_NST 4
DEV void gemm_main256_dma(f32x4 (&acc)[8][4], const u16* __restrict__ A, int lda, const u16* __restrict__ Bt, int ldb, int nk64,
                          int m0, int n0, char* smem) {
  const int tid = threadIdx.x, lane = tid & 63, wid = tid >> 6, wr = wid >> 2, wc = wid & 3, fr = lane & 15, fq = lane >> 4;
  const int nk = nk64 * 2;
#pragma unroll
  for (int i = 0; i < 8; ++i)
#pragma unroll
    for (int j = 0; j < 4; ++j) acc[i][j] = (f32x4){0.f, 0.f, 0.f, 0.f};
  const int prow = 16 * wid + (lane >> 2);
  const int pch = (lane & 3) ^ g2_swz(prow);
  const u16* srcA = A + (size_t)(m0 + prow) * lda + pch * 8;
  const u16* srcB = Bt + (size_t)(n0 + prow) * ldb + pch * 8;
  const size_t a128 = (size_t)128 * lda, b128 = (size_t)128 * ldb;
  char* ldsw = smem + (16 * wid) * 64;
#define D_FILL(kt, stage)                                                              \
  {                                                                                    \
    const int k0_ = (kt) * 32;                                                         \
    char* d_ = ldsw + (stage) * G2_STAGE_BYTES;                                        \
    __builtin_amdgcn_global_load_lds((const unsigned*)(srcA + k0_), (unsigned*)(d_), 16, 0, 0);               \
    __builtin_amdgcn_global_load_lds((const unsigned*)(srcA + a128 + k0_), (unsigned*)(d_ + 8192), 16, 0, 0); \
    __builtin_amdgcn_global_load_lds((const unsigned*)(srcB + k0_), (unsigned*)(d_ + 16384), 16, 0, 0);       \
    __builtin_amdgcn_global_load_lds((const unsigned*)(srcB + b128 + k0_), (unsigned*)(d_ + 16384 + 8192), 16, 0, 0); \
  }
  const int cho = (fq ^ g2_swz(fr)) << 4;
  __syncthreads();
  D_FILL(0, 0);
  D_FILL(min(1, nk - 1), 1);
  D_FILL(min(2, nk - 1), 2);
  int cu = 0, fill = 3;
  for (int kt = 0; kt < nk; ++kt) {
    asm volatile("s_waitcnt vmcnt(8)" ::: "memory");
    asm volatile("s_waitcnt lgkmcnt(0)" ::: "memory");
    __builtin_amdgcn_s_barrier();
    D_FILL(min(kt + 3, nk - 1), fill);
    {
      const char* sA_ = smem + cu * G2_STAGE_BYTES;
      const char* sB_ = sA_ + 16384;
      bf16x8 bfr[4];
#pragma unroll
      for (int j = 0; j < 4; ++j) bfr[j] = *(const bf16x8*)(sB_ + (wc * 64 + j * 16 + fr) * 64 + cho);
#pragma unroll
      for (int i = 0; i < 8; ++i) {
        const bf16x8 af = *(const bf16x8*)(sA_ + (wr * 128 + i * 16 + fr) * 64 + cho);
#pragma unroll
        for (int j = 0; j < 4; ++j) acc[i][j] = __builtin_amdgcn_mfma_f32_16x16x32_bf16(bfr[j], af, acc[i][j], 0, 0, 0);
      }
    }
    cu = (cu == GD_NST - 1) ? 0 : cu + 1;
    fill = (fill == GD_NST - 1) ? 0 : fill + 1;
  }
  asm volatile("s_waitcnt vmcnt(0)" ::: "memory");
  asm volatile("s_waitcnt lgkmcnt(0)" ::: "memory");
  __builtin_amdgcn_s_barrier();
#undef D_FILL
}

DEV void transpose_tile(const float* __restrict__ src, int N, int k0, int n0, const float* __restrict__ scale, u16* __restrict__ dst,
                        int dstride, int drow0, int dcol0, char* smem) {
  float* tile = (float*)smem;
  const int tid = threadIdx.x;
#pragma unroll
  for (int i = 0; i < 2; ++i) {
    int kl = (tid >> 4) + 32 * i, n4 = (tid & 15) * 4;
    float4 v = *(const float4*)(src + (size_t)(k0 + kl) * N + n0 + n4);
    float s = scale ? scale[k0 + kl] : 1.0f;
    tile[kl * 65 + n4 + 0] = v.x * s; tile[kl * 65 + n4 + 1] = v.y * s;
    tile[kl * 65 + n4 + 2] = v.z * s; tile[kl * 65 + n4 + 3] = v.w * s;
  }
  __syncthreads();
  {
    int nl = tid >> 3, k8 = (tid & 7) * 8;
    uint4 o;
    o.x = pack2(tile[(k8 + 0) * 65 + nl], tile[(k8 + 1) * 65 + nl]);
    o.y = pack2(tile[(k8 + 2) * 65 + nl], tile[(k8 + 3) * 65 + nl]);
    o.z = pack2(tile[(k8 + 4) * 65 + nl], tile[(k8 + 5) * 65 + nl]);
    o.w = pack2(tile[(k8 + 6) * 65 + nl], tile[(k8 + 7) * 65 + nl]);
    *(uint4*)(dst + (size_t)(drow0 + n0 + nl) * dstride + dcol0 + k0 + k8) = o;
  }
  __syncthreads();
}

DEV void phase_prep(const Params& p, char* smem) {
  const int tid = threadIdx.x;
  char* ws = p.ws;
  if (blockIdx.x < 96) {
    float* cL = (float*)smem;
    float* red = (float*)(smem + 98304);
    for (int e = tid; e < 24 * 256; e += NTHREADS) {
      int s = e >> 8, k4 = (e & 255) * 4;
      float4 v = s < 8 ? *(const float4*)(p.in[I_CP] + s * 1024 + k4) : *(const float4*)(p.in[I_CS] + (s - 8) * 1024 + k4);
      *(float4*)(cL + s * 1024 + k4) = v;
    }
    __syncthreads();
    for (int item = blockIdx.x; item < 96; item += gridDim.x) {
      const int l = item / 48, j0 = (item % 48) * 64;
      const float* W = (l == 0 ? p.in[I_AADAW] : p.in[I_BADAW]);
      const float* bias = (l == 0 ? p.in[I_AADAB] : p.in[I_BADAB]);
      const int col = tid & 63, kg = tid >> 6;
      float acc[24];
#pragma unroll
      for (int s = 0; s < 24; ++s) acc[s] = 0.f;
      for (int k = kg * 128; k < kg * 128 + 128; ++k) {
        float w = W[(size_t)k * 3072 + j0 + col];
#pragma unroll
        for (int s = 0; s < 24; ++s) acc[s] += cL[s * 1024 + k] * w;
      }
#pragma unroll
      for (int s = 0; s < 24; ++s) red[(kg * 24 + s) * 64 + col] = acc[s];
      __syncthreads();
      float* mod = (float*)(ws + WS_MOD);
      for (int e = tid; e < 24 * 64; e += NTHREADS) {
        int s = e >> 6, c = e & 63;
        float t = bias[j0 + c];
#pragma unroll
        for (int g = 0; g < 8; ++g) t += red[(g * 24 + s) * 64 + c];
        mod[(size_t)(l * 24 + s) * 3072 + j0 + c] = t;
      }
      __syncthreads();
    }
  }
  if (blockIdx.x == 0) for (int e = tid; e < 1024; e += NTHREADS) ((unsigned*)(ws + WS_CTR))[e] = 0u;
  if (blockIdx.x == gridDim.x - 1) {
    u16* SH = (u16*)(ws + WS_SH);
    for (int e = tid; e < 24 * 1024; e += NTHREADS) {
      int s = e >> 10, k = e & 1023;
      float v = s < 8 ? 0.f : p.in[I_SSH][(s - 8) * 1024 + k];
      SH[e] = (u16)(pack2(v, 0.f) & 0xffff);
    }
  }
  const int NT_TOTAL = 2048 + 512 + 1024 + 1024 + 512 + 32 + 32 + 64;
  for (int t = blockIdx.x; t < NT_TOTAL; t += gridDim.x) {
    const float* src; int K, N; u16* dst; int dstride, drow0 = 0, dcol0 = 0; const float* scale = nullptr; int tt = t;
    if (tt < 2048) { src = p.in[I_AWIN]; K = 1024; N = 8192; dst = (u16*)(ws + WS_WT_IN); dstride = 1024; }
    else if ((tt -= 2048) < 512) { src = p.in[I_AWOUT]; K = 2048; N = 1024; dst = (u16*)(ws + WS_WT_OUTA); dstride = 2048; }
    else if ((tt -= 512) < 1024) { src = p.in[I_KVW]; K = 1024; N = 4096; dst = (u16*)(ws + WS_WT_KV); dstride = 1024; }
    else if ((tt -= 1024) < 1024) { src = p.in[I_BWIN]; K = 1024; N = 4096; dst = (u16*)(ws + WS_WT_INB); dstride = 1024; }
    else if ((tt -= 1024) < 512) { src = p.in[I_BWOUT]; K = 2048; N = 1024; dst = (u16*)(ws + WS_WT_OUTB); dstride = 2048; }
    else if ((tt -= 512) < 32) { src = p.in[I_AW2]; K = 64; N = 2048; dst = (u16*)(ws + WS_W2T); dstride = 64; }
    else if ((tt -= 32) < 32) { src = p.in[I_AA2]; K = 64; N = 2048; dst = (u16*)(ws + WS_A2T); dstride = 64; }
    else {
      tt -= 32;
      int job = tt >> 4; tt &= 15;
      K = 1024; N = 64; dst = (u16*)(ws + WS_L1T); dstride = 2048;
      src = (job < 2) ? p.in[I_AW1] : p.in[I_AA1];
      drow0 = (job < 2) ? 0 : 64;
      if (job & 1) { dcol0 = 1024; scale = (job < 2) ? p.in[I_AMUW] : p.in[I_AMUA]; }
    }
    const int ntn = N / 64;
    const int kt = tt / ntn, nt = tt % ntn;
    transpose_tile(src, N, kt * 64, nt * 64, scale, dst, dstride, drow0, dcol0, smem);
  }
}

DEV void phase_norm0(const Params& p) {
  const int lane = threadIdx.x & 63, wid = threadIdx.x >> 6;
  const float* mod = (const float*)(p.ws + WS_MOD);
  u16* H0 = (u16*)(p.ws + WS_H0);
  const float* g = p.in[I_ANG];
  for (int t = blockIdx.x * 8 + wid; t < NTOK; t += gridDim.x * 8) {
    const float* x = t < TP ? p.in[I_XP] + (size_t)t * 1024 : p.in[I_XS] + (size_t)(t - TP) * 1024;
    const int s = seq_of(t);
    const float* md = mod + (size_t)s * 3072;
    float4 v[4];
    float ss = 0.f;
#pragma unroll
    for (int i = 0; i < 4; ++i) {
      v[i] = *(const float4*)(x + lane * 4 + 256 * i);
      ss += v[i].x * v[i].x + v[i].y * v[i].y + v[i].z * v[i].z + v[i].w * v[i].w;
    }
    ss = wave_sum(ss);
    const float rstd = rsqrtf(ss * (1.0f / 1024.0f) + 1e-6f);
    bool last = t < TP ? ((t & 4095) == 4095) : (((t - TP) & 31) == 31);
    float* so = t < TP ? p.out + OFF_SH_P + (t >> 12) * 1024 : p.out + OFF_SH_S + ((t - TP) >> 5) * 1024;
#pragma unroll
    for (int i = 0; i < 4; ++i) {
      const int c = lane * 4 + 256 * i;
      float4 gg = *(const float4*)(g + c), sh = *(const float4*)(md + c), sc = *(const float4*)(md + 1024 + c);
      float4 h;
      h.x = v[i].x * rstd * gg.x * (1.f + sc.x) + sh.x;
      h.y = v[i].y * rstd * gg.y * (1.f + sc.y) + sh.y;
      h.z = v[i].z * rstd * gg.z * (1.f + sc.z) + sh.z;
      h.w = v[i].w * rstd * gg.w * (1.f + sc.w) + sh.w;
      uint2 o; o.x = pack2(h.x, h.y); o.y = pack2(h.z, h.w);
      *(uint2*)(H0 + (size_t)t * 1024 + c) = o;
      if (last) *(float4*)(so + c) = h;
    }
  }
}

DEV void phase_proj0_lora(const Params& p, char* smem) {
  const int tid = threadIdx.x, lane = tid & 63, wid = tid >> 6, fr = lane & 15, fq = lane >> 4;
  const int wr = wid >> 1, wc = wid & 1;
  char* ws = p.ws;
  const u16* H0 = (const u16*)(ws + WS_H0);
  const u16* SH = (const u16*)(ws + WS_SH);
  u16* T = (u16*)(ws + WS_T);
  const int xcc0 = xcc_id();
  int nxt;
  f32x4 acc[4][4];
  for (int ls = 0; ls < 8; ++ls) {
  const int xcd = (xcc0 + ls) & 7;
  unsigned* ctr = sched_ctr(p, 0, xcd);
  for (int li = sched_first(ctr, smem); li < 17; li = sched_commit(nxt, smem)) {
    nxt = sched_prefetch(ctr);
    const int lmt = xcd + 8 * li;
    if (lmt >= 130) continue;
    const int m0 = lmt * 256;
    gemm_main<2>(acc, H0, 1024, (const u16*)(ws + WS_L1T), 2048, 32, m0, 0, nullptr, SH, smem);
#pragma unroll
    for (int i = 0; i < 4; ++i)
#pragma unroll
      for (int j = 0; j < 4; ++j) {
        const int m = m0 + wr * 64 + i * 16 + fr, n = wc * 64 + j * 16 + fq * 4;
        f32x4 v = acc[i][j];
        if (wc == 0) { v[0] = tanhf(v[0]); v[1] = tanhf(v[1]); v[2] = tanhf(v[2]); v[3] = tanhf(v[3]); }
        uint2 o; o.x = pack2(v[0], v[1]); o.y = pack2(v[2], v[3]);
        *(uint2*)(T + (size_t)m * 128 + n) = o;
      }
    __threadfence_block();
    __syncthreads();
    for (int nt = 0; nt < 32; ++nt) {
      const int which = nt >> 4, n0 = (nt & 15) * 128;
      gemm_main<0>(acc, T + which * 64, 128, (const u16*)(ws + (which ? WS_A2T : WS_W2T)), 64, 1, m0, n0, nullptr, nullptr, smem);
      const float* bias = which ? p.in[I_AA0] : p.in[I_AW0];
      u16* dst = (u16*)(ws + (which ? 5ull : 4ull) * SLOT);
      const float sc = which ? 1.0f : -0.60653066f;
#pragma unroll
      for (int i = 0; i < 4; ++i)
#pragma unroll
        for (int j = 0; j < 4; ++j) {
          const int m = m0 + wr * 64 + i * 16 + fr, n = n0 + wc * 64 + j * 16 + fq * 4;
          float4 b4 = *(const float4*)(bias + n);
          f32x4 v = acc[i][j];
          float s0 = sc * sigmoidf_(v[0] + b4.x), s1 = sc * sigmoidf_(v[1] + b4.y), s2 = sc * sigmoidf_(v[2] + b4.z), s3 = sc * sigmoidf_(v[3] + b4.w);
          uint2 o; o.x = pack2(s0, s1); o.y = pack2(s2, s3);
          *(uint2*)(dst + (size_t)m * 2048 + n) = o;
        }
    }
  }
  }
}

DEV void phase_proj0_main(const Params& p, char* smem) {
  const int tid = threadIdx.x, lane = tid & 63, wid = tid >> 6, fr = lane & 15, fq = lane >> 4;
  const int wr = wid >> 2, wc = wid & 3;
  char* ws = p.ws;
  const u16* H0 = (const u16*)(ws + WS_H0);
  const u16* SH = (const u16*)(ws + WS_SH);
  const int xcc0 = xcc_id();
  int nxt;
  f32x4 acc[8][4];
  for (int ls = 0; ls < 8; ++ls) {
  const int xcd = (xcc0 + ls) & 7;
  unsigned* ctr = sched_ctr(p, 4, xcd);
  for (int q = sched_first(ctr, smem); q < 520; q = sched_commit(nxt, smem)) {
    nxt = sched_prefetch(ctr);
    const int mt = q >> 2, nt = 4 * xcd + (q & 3);
    const int part = nt >> 3;
    const int m0 = mt * 256, n0 = nt * 256;
    gemm_main256<1>(acc, H0, 1024, (const u16*)(ws + WS_WT_IN), 1024, 16, m0, n0, p.in[I_AMUIN] + part * 1024, SH, smem);
    u16* dst = (u16*)(ws + (size_t)part * SLOT);
    const int nb = n0 - part * 2048;
#pragma unroll
    for (int i = 0; i < 8; ++i)
#pragma unroll
      for (int j = 0; j < 4; ++j) {
        const int m = m0 + wr * 128 + i * 16 + fr, n = nb + wc * 64 + j * 16 + fq * 4;
        f32x4 v = acc[i][j];
        uint2 o; o.x = pack2(v[0], v[1]); o.y = pack2(v[2], v[3]);
        *(uint2*)(dst + (size_t)m * 2048 + n) = o;
      }
  }
  }
}

DEV void phase_proj0(const Params& p, char* smem) {
  phase_proj0_lora(p, smem);
  phase_proj0_main(p, smem);
}

DEV void phase_scan(const Params& p, char* smem) {
  const int tid = threadIdx.x, lane = tid & 63, wid = tid >> 6;
  u16* Hkk = (u16*)smem;
  u16* Hw = Hkk + 4096;
  u16* Hb = Hw + 4096;
  u16* Hk = Hb + 4096;
  u16* Hwr = Hk + 4096;
  unsigned* Hv2 = (unsigned*)(smem + 40960);
  float* LY = (float*)(smem + 57344);
  float* Lbon = LY + 8192;
  float* Lsc = Lbon + 64;
  char* ws = p.ws;
  const u16* gR = (const u16*)(ws + 0 * SLOT);
  const u16* gK = (const u16*)(ws + 1 * SLOT);
  const u16* gV = (const u16*)(ws + 2 * SLOT);
  const u16* gZ = (const u16*)(ws + 3 * SLOT);
  const u16* gW = (const u16*)(ws + 4 * SLOT);
  const u16* gA = (const u16*)(ws + 5 * SLOT);
  u16* YG = (u16*)(ws + 6 * SLOT);
  const int tt = tid >> 3, c8 = (tid & 7) * 8;
  const int rp = wid * 4 + (lane >> 4), kc = lane & 15;

  for (int item = blockIdx.x; item < 768; item += gridDim.x) {
    int h, tok0, nsteps; const float* sinit; float* sout;
    if (item < 256) { h = item & 31; tok0 = (item >> 5) * 4096; nsteps = 4096; sinit = nullptr; sout = p.out + OFF_WKV_P + (size_t)item * 4096; }
    else { int it = item - 256; h = it & 31; tok0 = TP + (it >> 5) * 32; nsteps = 32; sinit = p.in[I_SWKV] + (size_t)it * 4096; sout = p.out + OFF_WKV_S + (size_t)it * 4096; }
    const int nch = (nsteps + 63) >> 6;
    const int col0 = h * 64 + c8;
    float ckk[8], cka[8], crk[8], clg[8], clb[8];
    {
      float4 t0, t1;
      t0 = *(const float4*)(p.in[I_AKK] + col0); t1 = *(const float4*)(p.in[I_AKK] + col0 + 4);
      ckk[0] = t0.x; ckk[1] = t0.y; ckk[2] = t0.z; ckk[3] = t0.w; ckk[4] = t1.x; ckk[5] = t1.y; ckk[6] = t1.z; ckk[7] = t1.w;
      t0 = *(const float4*)(p.in[I_AKA] + col0); t1 = *(const float4*)(p.in[I_AKA] + col0 + 4);
      cka[0] = t0.x; cka[1] = t0.y; cka[2] = t0.z; cka[3] = t0.w; cka[4] = t1.x; cka[5] = t1.y; cka[6] = t1.z; cka[7] = t1.w;
      t0 = *(const float4*)(p.in[I_ARK] + col0); t1 = *(const float4*)(p.in[I_ARK] + col0 + 4);
      crk[0] = t0.x; crk[1] = t0.y; crk[2] = t0.z; crk[3] = t0.w; crk[4] = t1.x; crk[5] = t1.y; crk[6] = t1.z; crk[7] = t1.w;
      t0 = *(const float4*)(p.in[I_ALNG] + col0); t1 = *(const float4*)(p.in[I_ALNG] + col0 + 4);
      clg[0] = t0.x; clg[1] = t0.y; clg[2] = t0.z; clg[3] = t0.w; clg[4] = t1.x; clg[5] = t1.y; clg[6] = t1.z; clg[7] = t1.w;
      t0 = *(const float4*)(p.in[I_ALNB] + col0); t1 = *(const float4*)(p.in[I_ALNB] + col0 + 4);
      clb[0] = t0.x; clb[1] = t0.y; clb[2] = t0.z; clb[3] = t0.w; clb[4] = t1.x; clb[5] = t1.y; clb[6] = t1.z; clb[7] = t1.w;
    }
    h2_t s0a, s0b, s1a, s1b;
    if (sinit) {
      float4 a = *(const float4*)(sinit + (2 * rp) * 64 + kc * 4), b = *(const float4*)(sinit + (2 * rp + 1) * 64 + kc * 4);
      s0a = (h2_t){(_Float16)a.x, (_Float16)a.y}; s0b = (h2_t){(_Float16)a.z, (_Float16)a.w};
      s1a = (h2_t){(_Float16)b.x, (_Float16)b.y}; s1b = (h2_t){(_Float16)b.z, (_Float16)b.w};
    } else {
      s0a = s0b = s1a = s1b = (h2_t){(_Float16)0.f, (_Float16)0.f};
    }
    uint4 cr, ck, cv, cz, cw, ca;
#define SCAN_LOAD(c)                                                                   \
    {                                                                                  \
      const int tl_ = (c) * 64 + tt;                                                   \
      if (tl_ < nsteps) {                                                              \
        const size_t o_ = (size_t)(tok0 + tl_) * 2048 + col0;                          \
        cr = *(const uint4*)(gR + o_); ck = *(const uint4*)(gK + o_); cv = *(const uint4*)(gV + o_); \
        cz = *(const uint4*)(gZ + o_); cw = *(const uint4*)(gW + o_); ca = *(const uint4*)(gA + o_); \
      } else { cr = ck = cv = cz = cw = ca = make_uint4(0, 0, 0, 0); }                 \
    }
    SCAN_LOAD(0);
    for (int c = 0; c < nch; ++c) {
      uint4 zc = cz;
      {
        float r[8], k[8], v[8], lw[8], a[8];
        unpack8(cr, r); unpack8(ck, k); unpack8(cv, v); unpack8(cw, lw); unpack8(ca, a);
        float kkv[8], kp[8], w[8], bon = 0.f, ss = 0.f, kr = 0.f;
#pragma unroll
        for (int j = 0; j < 8; ++j) {
          kkv[j] = k[j] * ckk[j]; ss += kkv[j] * kkv[j];
          kp[j] = k[j] * (1.f + (a[j] - 1.f) * cka[j]);
          bon += r[j] * kp[j] * crk[j];
          kr += r[j] * kp[j];
          w[j] = __expf(lw[j]);
        }
        ss = red8(ss); bon = red8(bon); kr = red8(kr);
        const float inv = rsqrtf(ss + 1e-12f);
        float bb[8], br = 0.f;
#pragma unroll
        for (int j = 0; j < 8; ++j) { kkv[j] *= inv; bb[j] = kkv[j] * a[j]; br += bb[j] * r[j]; }
        br = red8(br);
        const int ho = tt * 64 + c8;
        *(uint4*)(Hkk + ho) = make_uint4(packh2(kkv[0], kkv[1]), packh2(kkv[2], kkv[3]), packh2(kkv[4], kkv[5]), packh2(kkv[6], kkv[7]));
        *(uint4*)(Hb + ho) = make_uint4(packh2(bb[0], bb[1]), packh2(bb[2], bb[3]), packh2(bb[4], bb[5]), packh2(bb[6], bb[7]));
        *(uint4*)(Hw + ho) = make_uint4(packh2(w[0], w[1]), packh2(w[2], w[3]), packh2(w[4], w[5]), packh2(w[6], w[7]));
        *(uint4*)(Hk + ho) = make_uint4(packh2(kp[0], kp[1]), packh2(kp[2], kp[3]), packh2(kp[4], kp[5]), packh2(kp[6], kp[7]));
        *(uint4*)(Hwr + ho) = make_uint4(packh2(w[0] * r[0], w[1] * r[1]), packh2(w[2] * r[2], w[3] * r[3]), packh2(w[4] * r[4], w[5] * r[5]), packh2(w[6] * r[6], w[7] * r[7]));
        *(uint4*)(Hv2 + ho) = make_uint4(packh2(v[0], v[0]), packh2(v[1], v[1]), packh2(v[2], v[2]), packh2(v[3], v[3]));
        *(uint4*)(Hv2 + ho + 4) = make_uint4(packh2(v[4], v[4]), packh2(v[5], v[5]), packh2(v[6], v[6]), packh2(v[7], v[7]));
        if ((tid & 7) == 0) { Lbon[tt] = bon; *(float2*)(Lsc + tt * 2) = make_float2(br, kr); }
      }
      __syncthreads();
      if (c + 1 < nch) SCAN_LOAD(c + 1);
      {
        const int nT = min(64, nsteps - c * 64);
        const u16* pk = Hkk + kc * 4; const u16* pw = Hw + kc * 4; const u16* pb = Hb + kc * 4;
        const u16* pkp = Hk + kc * 4; const u16* pwr = Hwr + kc * 4; const unsigned* pv = Hv2 + rp * 2;
        float* py = LY + rp * 4;
#define SCAN_LD(S, o)                                                                  \
        S##kk = *(const uint2*)(pk + (o)); S##w = *(const uint2*)(pw + (o)); S##b = *(const uint2*)(pb + (o)); \
        S##k = *(const uint2*)(pkp + (o)); S##wr = *(const uint2*)(pwr + (o)); S##v = *(const uint2*)(pv + (o));
#define H2(x) (*(const h2_t*)&(x))
#define SCAN_STEP(S, o)                                                                \
        {                                                                              \
          float d0 = __builtin_amdgcn_fdot2(s0a, H2(S##kk.x), __builtin_amdgcn_fdot2(s0b, H2(S##kk.y), 0.f, false), false); \
          float d1 = __builtin_amdgcn_fdot2(s1a, H2(S##kk.x), __builtin_amdgcn_fdot2(s1b, H2(S##kk.y), 0.f, false), false); \
          float e0 = __builtin_amdgcn_fdot2(s0a, H2(S##wr.x), __builtin_amdgcn_fdot2(s0b, H2(S##wr.y), 0.f, false), false); \
          float e1 = __builtin_amdgcn_fdot2(s1a, H2(S##wr.x), __builtin_amdgcn_fdot2(s1b, H2(S##wr.y), 0.f, false), false); \
          d0 += dppf<0xB1>(d0); d1 += dppf<0xB1>(d1); e0 += dppf<0xB1>(e0); e1 += dppf<0xB1>(e1);       \
          d0 += dppf<0x4E>(d0); d1 += dppf<0x4E>(d1); e0 += dppf<0x4E>(e0); e1 += dppf<0x4E>(e1);       \
          d0 += dppf<0x141>(d0); d1 += dppf<0x141>(d1); e0 += dppf<0x141>(e0); e1 += dppf<0x141>(e1);   \
          d0 += dppf<0x140>(d0); d1 += dppf<0x140>(d1); e0 += dppf<0x140>(e0); e1 += dppf<0x140>(e1);   \
          const unsigned n0u_ = packh2(-d0, -d0), n1u_ = packh2(-d1, -d1);             \
          const h2_t n0_ = H2(n0u_), n1_ = H2(n1u_);                                   \
          s0a = __builtin_elementwise_fma(s0a, H2(S##w.x), __builtin_elementwise_fma(n0_, H2(S##b.x), H2(S##v.x) * H2(S##k.x))); \
          s0b = __builtin_elementwise_fma(s0b, H2(S##w.y), __builtin_elementwise_fma(n0_, H2(S##b.y), H2(S##v.x) * H2(S##k.y))); \
          s1a = __builtin_elementwise_fma(s1a, H2(S##w.x), __builtin_elementwise_fma(n1_, H2(S##b.x), H2(S##v.y) * H2(S##k.x))); \
          s1b = __builtin_elementwise_fma(s1b, H2(S##w.y), __builtin_elementwise_fma(n1_, H2(S##b.y), H2(S##v.y) * H2(S##k.y))); \
          if (kc == 0) *(float4*)(py + 2 * (o)) = make_float4(e0, e1, d0, d1);             \
        }
        uint2 Akk, Aw, Ab, Ak, Awr, Av, Bkk, Bw, Bb, Bk, Bwr, Bv;
        SCAN_LD(A, 0);
        for (int t = 0; t < nT; t += 2) {
          SCAN_LD(B, (t + 1) * 64);
          SCAN_STEP(A, t * 64);
          SCAN_LD(A, (t + 2) * 64);
          SCAN_STEP(B, (t + 1) * 64);
        }
#undef H2
#undef SCAN_LD
#undef SCAN_STEP
      }
      __syncthreads();
      {
        const int tl = c * 64 + tt;
        if (tl < nsteps) {
          float y[8], z[8];
          const float2 sc = *(const float2*)(Lsc + tt * 2);
          const uint4 va = *(const uint4*)(Hv2 + tt * 64 + c8), vb = *(const uint4*)(Hv2 + tt * 64 + c8 + 4);
          float vv[8];
          { const unsigned vu[8] = {va.x, va.y, va.z, va.w, vb.x, vb.y, vb.z, vb.w};
#pragma unroll
            for (int j = 0; j < 8; ++j) { h2_t t_ = *(const h2_t*)&vu[j]; vv[j] = (float)t_[0]; } }
#pragma unroll
          for (int q = 0; q < 4; ++q) {
            const float4 ed = *(const float4*)(LY + tt * 128 + (c8 / 2 + q) * 4);
            y[2 * q] = ed.x - ed.z * sc.x + vv[2 * q] * sc.y;
            y[2 * q + 1] = ed.y - ed.w * sc.x + vv[2 * q + 1] * sc.y;
          }
          float sm = y[0] + y[1] + y[2] + y[3] + y[4] + y[5] + y[6] + y[7];
          sm = red8(sm);
          const float mean = sm * (1.f / 64.f);
          float vs = 0.f;
#pragma unroll
          for (int j = 0; j < 8; ++j) { y[j] -= mean; vs += y[j] * y[j]; }
          vs = red8(vs);
          const float rstd = rsqrtf(vs * (1.f / 64.f) + 64e-5f);
          const float bon = Lbon[tt];
          unpack8(zc, z);
          float o[8];
#pragma unroll
          for (int j = 0; j < 8; ++j) {
            float t = y[j] * rstd * clg[j] + clb[j] + bon * vv[j];
            o[j] = t * z[j] * sigmoidf_(z[j]);
          }
          uint4 ov; ov.x = pack2(o[0], o[1]); ov.y = pack2(o[2], o[3]); ov.z = pack2(o[4], o[5]); ov.w = pack2(o[6], o[7]);
          *(uint4*)(YG + (size_t)(tok0 + tl) * 2048 + col0) = ov;
        }
      }
      __syncthreads();
    }
#undef SCAN_LOAD
    *(float4*)(sout + (2 * rp) * 64 + kc * 4) = make_float4((float)s0a[0], (float)s0a[1], (float)s0b[0], (float)s0b[1]);
    *(float4*)(sout + (2 * rp + 1) * 64 + kc * 4) = make_float4((float)s1a[0], (float)s1a[1], (float)s1b[0], (float)s1b[1]);
  }
}

template <int LAYER>
DEV void outproj_store(const Params& p, const float* mod, float* xmid, int m, int n, f32x4 v) {
  const float* gate = mod + (size_t)seq_of(m) * 3072 + 2048;
  float4 g4 = *(const float4*)(gate + n);
  if (LAYER == 0) {
    const float* xr = m < TP ? p.in[I_XP] + (size_t)m * 1024 : p.in[I_XS] + (size_t)(m - TP) * 1024;
    float4 x4 = *(const float4*)(xr + n);
    *(float4*)(xmid + (size_t)m * 1024 + n) = make_float4(x4.x + g4.x * v[0], x4.y + g4.y * v[1], x4.z + g4.z * v[2], x4.w + g4.w * v[3]);
  } else {
    float4 x4 = *(const float4*)(xmid + (size_t)m * 1024 + n);
    float* yo = m < TP ? p.out + OFF_Y_P + (size_t)m * 1024 : p.out + OFF_Y_S + (size_t)(m - TP) * 1024;
    *(float4*)(yo + n) = make_float4(x4.x + g4.x * v[0], x4.y + g4.y * v[1], x4.z + g4.z * v[2], x4.w + g4.w * v[3]);
  }
}

template <int LAYER>
DEV void phase_outproj_main(const Params& p, char* smem) {
  const int tid = threadIdx.x, lane = tid & 63, wid = tid >> 6, wr = wid >> 2, wc = wid & 3, fr = lane & 15, fq = lane >> 4;
  char* ws = p.ws;
  const u16* A = (const u16*)(ws + 6 * SLOT);
  const u16* Bt = (const u16*)(ws + (LAYER == 0 ? WS_WT_OUTA : WS_WT_OUTB));
  const float* mod = (const float*)(ws + WS_MOD) + (size_t)LAYER * 24 * 3072;
  float* xmid = (float*)(ws + 0 * SLOT);
  f32x4 acc[8][4];
  const int xcc0 = xcc_id();
  int nxt;
  for (int ls = 0; ls < 8; ++ls) {
    const int xcd = (xcc0 + ls) & 7;
    unsigned* ctr = sched_ctr(p, LAYER == 0 ? 1 : 3, xcd);
    for (int li = sched_first(ctr, smem); li < 64; li = sched_commit(nxt, smem)) {
      nxt = sched_prefetch(ctr);
      const int item = 64 * xcd + li;
      const int m0 = (item >> 2) * 256, n0 = (item & 3) * 256;
      gemm_main256_dma(acc, A, 2048, Bt, 2048, 32, m0, n0, smem);
#pragma unroll
      for (int i = 0; i < 8; ++i)
#pragma unroll
        for (int j = 0; j < 4; ++j)
          outproj_store<LAYER>(p, mod, xmid, m0 + wr * 128 + i * 16 + fr, n0 + wc * 64 + j * 16 + fq * 4, acc[i][j]);
    }
  }
}

template <int LAYER>
DEV void phase_outproj_tail(const Params& p, char* smem) {
  const int tid = threadIdx.x, lane = tid & 63, wid = tid >> 6, wr = wid >> 1, wc = wid & 1, fr = lane & 15, fq = lane >> 4;
  char* ws = p.ws;
  const u16* A = (const u16*)(ws + 6 * SLOT);
  const u16* Bt = (const u16*)(ws + (LAYER == 0 ? WS_WT_OUTA : WS_WT_OUTB));
  const float* mod = (const float*)(ws + WS_MOD) + (size_t)LAYER * 24 * 3072;
  float* xmid = (float*)(ws + 0 * SLOT);
  f32x4 acc[4][4];
  const int xcc0 = xcc_id();
  int nxt;
  for (int ls = 0; ls < 8; ++ls) {
    const int xcd = (xcc0 + ls) & 7;
    unsigned* ctr = sched_ctr(p, LAYER == 0 ? 5 : 6, xcd);
    for (int li = sched_first(ctr, smem); li < 2; li = sched_commit(nxt, smem)) {
      nxt = sched_prefetch(ctr);
      const int item = 2 * xcd + li;
      const int m0 = (128 + (item >> 3)) * 256, n0 = (item & 7) * 128;
      gemm_main<0>(acc, A, 2048, Bt, 2048, 32, m0, n0, nullptr, nullptr, smem);
#pragma unroll
      for (int i = 0; i < 4; ++i)
#pragma unroll
        for (int j = 0; j < 4; ++j)
          outproj_store<LAYER>(p, mod, xmid, m0 + wr * 64 + i * 16 + fr, n0 + wc * 64 + j * 16 + fq * 4, acc[i][j]);
    }
  }
}

template <int LAYER>
DEV void phase_outproj(const Params& p, char* smem) {
  phase_outproj_tail<LAYER>(p, smem);
  phase_outproj_main<LAYER>(p, smem);
}

DEV void phase_norm1(const Params& p) {
  const int lane = threadIdx.x & 63, wid = threadIdx.x >> 6;
  const float* mod = (const float*)(p.ws + WS_MOD) + (size_t)24 * 3072;
  const float* xmid = (const float*)(p.ws + 0 * SLOT);
  u16* AKV = (u16*)(p.ws + 1 * SLOT);
  u16* AQ = AKV + (size_t)NTOK * 1024;
  const float* gkv = p.in[I_KVNG];
  const float* gb = p.in[I_BNG];
  for (int t = blockIdx.x * 8 + wid; t < NTOK; t += gridDim.x * 8) {
    const float* x = xmid + (size_t)t * 1024;
    const float* md = mod + (size_t)seq_of(t) * 3072;
    float4 v[4];
    float ss = 0.f;
#pragma unroll
    for (int i = 0; i < 4; ++i) {
      v[i] = *(const float4*)(x + lane * 4 + 256 * i);
      ss += v[i].x * v[i].x + v[i].y * v[i].y + v[i].z * v[i].z + v[i].w * v[i].w;
    }
    ss = wave_sum(ss);
    const float rstd = rsqrtf(ss * (1.0f / 1024.0f) + 1e-6f);
#pragma unroll
    for (int i = 0; i < 4; ++i) {
      const int c = lane * 4 + 256 * i;
      float4 g1 = *(const float4*)(gkv + c), g2 = *(const float4*)(gb + c), sh = *(const float4*)(md + c), sc = *(const float4*)(md + 1024 + c);
      float xn0 = v[i].x * rstd, xn1 = v[i].y * rstd, xn2 = v[i].z * rstd, xn3 = v[i].w * rstd;
      uint2 o;
      o.x = pack2(xn0 * g1.x, xn1 * g1.y); o.y = pack2(xn2 * g1.z, xn3 * g1.w);
      *(uint2*)(AKV + (size_t)t * 1024 + c) = o;
      o.x = pack2(xn0 * g2.x * (1.f + sc.x) + sh.x, xn1 * g2.y * (1.f + sc.y) + sh.y);
      o.y = pack2(xn2 * g2.z * (1.f + sc.z) + sh.z, xn3 * g2.w * (1.f + sc.w) + sh.w);
      *(uint2*)(AQ + (size_t)t * 1024 + c) = o;
    }
  }
}

#define QSCALE (0.08838834764831845f * 1.4426950408889634f)
DEV void phase_proj1(const Params& p, char* smem) {
  const int tid = threadIdx.x, lane = tid & 63, wid = tid >> 6, wr = wid >> 2, wc = wid & 3, fr = lane & 15, fq = lane >> 4;
  char* ws = p.ws;
  const u16* AKV = (const u16*)(ws + 1 * SLOT);
  const u16* AQ = AKV + (size_t)NTOK * 1024;
  u16* KB = (u16*)(ws + 2 * SLOT);
  u16* VB = (u16*)(ws + 3 * SLOT);
  u16* QB = (u16*)(ws + 4 * SLOT);
  u16* ZS = (u16*)(ws + 5 * SLOT);
  f32x4 acc[8][4];
  float* red = (float*)smem;
  const int xcc0 = xcc_id();
  int nxt;
  for (int ls = 0; ls < 8; ++ls) {
  const int xcd = (xcc0 + ls) & 7;
  unsigned* ctr = sched_ctr(p, 2, xcd);
  for (int li = sched_first(ctr, smem); li < 520; li = sched_commit(nxt, smem)) {
    nxt = sched_prefetch(ctr);
    const int mt = li >> 2, t = 4 * xcd + (li & 3);
    const int isq = t >> 4, nt = t & 15;
    const int m0 = mt * 256, n0 = nt * 256;
    gemm_main256_dma(acc, isq ? AQ : AKV, 1024, (const u16*)(ws + (isq ? WS_WT_INB : WS_WT_KV)), 1024, 16, m0, n0, smem);
    if (nt < 8) {
#pragma unroll
      for (int i = 0; i < 8; ++i) {
        float ss = 0.f;
#pragma unroll
        for (int j = 0; j < 4; ++j) ss += acc[i][j][0] * acc[i][j][0] + acc[i][j][1] * acc[i][j][1] + acc[i][j][2] * acc[i][j][2] + acc[i][j][3] * acc[i][j][3];
        red[(wr * 128 + i * 16 + fr) * 16 + wc * 4 + fq] = ss;
      }
      __syncthreads();
      const float* gain = isq ? p.in[I_BQG] : p.in[I_KGAIN];
#pragma unroll
      for (int i = 0; i < 8; ++i) {
        const int row = wr * 128 + i * 16 + fr, m = m0 + row;
        float4 ra = *(const float4*)(red + row * 16 + (wc >> 1) * 8), rb = *(const float4*)(red + row * 16 + (wc >> 1) * 8 + 4);
        float tot = ra.x + ra.y + ra.z + ra.w + rb.x + rb.y + rb.z + rb.w;
        float rs = rsqrtf(tot * (1.f / 128.f) + 1e-6f);
        if (isq) rs *= QSCALE;
#pragma unroll
        for (int j = 0; j < 4; ++j) {
          const int d = (wc & 1) * 64 + j * 16 + fq * 4, n = n0 + wc * 64 + j * 16 + fq * 4;
          float4 g4 = *(const float4*)(gain + d);
          f32x4 v = acc[i][j];
          float o0 = v[0] * rs * g4.x, o1 = v[1] * rs * g4.y, o2 = v[2] * rs * g4.z, o3 = v[3] * rs * g4.w;
          uint2 o; o.x = pack2(o0, o1); o.y = pack2(o2, o3);
          if (isq) {
            *(uint2*)(QB + (size_t)m * 2048 + n) = o;
          } else {
            *(uint2*)(KB + (size_t)m * 2048 + n) = o;
            float* ko = m < TP ? p.out + OFF_K_P + (size_t)m * 2048 : p.out + OFF_K_S + (size_t)(m - TP) * 2048;
            *(float4*)(ko + n) = make_float4(o0, o1, o2, o3);
          }
        }
      }
      __syncthreads();
    } else {
#pragma unroll
      for (int i = 0; i < 8; ++i) {
        const int m = m0 + wr * 128 + i * 16 + fr;
#pragma unroll
        for (int j = 0; j < 4; ++j) {
          const int n = n0 - 2048 + wc * 64 + j * 16 + fq * 4;
          f32x4 v = acc[i][j];
          if (isq) {
            float o0 = v[0] * sigmoidf_(v[0]), o1 = v[1] * sigmoidf_(v[1]), o2 = v[2] * sigmoidf_(v[2]), o3 = v[3] * sigmoidf_(v[3]);
            uint2 o; o.x = pack2(o0, o1); o.y = pack2(o2, o3);
            *(uint2*)(ZS + (size_t)m * 2048 + n) = o;
          } else {
            uint2 o; o.x = pack2(v[0], v[1]); o.y = pack2(v[2], v[3]);
            *(uint2*)(VB + (size_t)m * 2048 + n) = o;
            float* vo = m < TP ? p.out + OFF_V_P + (size_t)m * 2048 : p.out + OFF_V_S + (size_t)(m - TP) * 2048;
            *(float4*)(vo + n) = make_float4(v[0], v[1], v[2], v[3]);
          }
        }
      }
    }
  }
}
}

DEV unsigned off_b(unsigned row, unsigned ch) { return 256u * row + 16u * (ch ^ (((row & 3) << 2) | ((row >> 2) & 3))); }

DEV void phase_attn(const Params& p, char* smem) {
  const int tid = threadIdx.x, lane = tid & 63, w = tid >> 6, fr = lane & 15, fq = lane >> 4;
  char* ws = p.ws;
  const u16* KB = (const u16*)(ws + 2 * SLOT);
  const u16* VB = (const u16*)(ws + 3 * SLOT);
  const u16* QB = (const u16*)(ws + 4 * SLOT);
  const u16* ZS = (const u16*)(ws + 5 * SLOT);
  u16* OG = (u16*)(ws + 6 * SLOT);
  const int lrow = tid >> 4, lch = tid & 15;
  const unsigned lw0 = off_b(lrow, lch), lw1 = off_b(lrow + 32, lch);
  const int tq = (lane & 15) >> 2, tp = lane & 3;

  for (int item = blockIdx.x; item < 4096 + 256; item += gridDim.x) {
    int b, h, nq, qpos0, tokq0, ntiles, nkeys, tokk0; bool sample;
    if (item < 4096) {
      const int qblk = 31 - (item >> 7), bh = item & 127;
      b = bh >> 4; h = bh & 15; nq = 128; qpos0 = qblk * 128; tokq0 = b * 4096 + qpos0; ntiles = 2 * qblk + 2; nkeys = qpos0 + 128; tokk0 = b * 4096; sample = false;
    } else {
      const int bh = item - 4096;
      b = bh >> 4; h = bh & 15; nq = 32; qpos0 = 1024; tokq0 = TP + b * 32; ntiles = 17; nkeys = 1056; tokk0 = TP + b * 32 - 1024; sample = true;
    }
    const bool wactive = (w * 16) < nq;
    int* dflag = (int*)(smem + 65536);
    __syncthreads();
    if (lane == 0) dflag[w] = wactive ? 0 : 1;
    bool wdone = !wactive;
    const int qp = qpos0 + w * 16 + fr;
    const int qwmax = qpos0 + w * 16 + 15;
    bf16x8 qf[4];
#pragma unroll
    for (int ks = 0; ks < 4; ++ks) {
      if (wactive) qf[ks] = *(const bf16x8*)(QB + (size_t)(tokq0 + w * 16 + fr) * 2048 + h * 128 + ks * 32 + fq * 8);
      else qf[ks] = (bf16x8){0, 0, 0, 0, 0, 0, 0, 0};
    }
    f32x4 O[8];
#pragma unroll
    for (int dt = 0; dt < 8; ++dt) O[dt] = (f32x4){0, 0, 0, 0};
    float carry = 0.f;

    uint4 lk0, lk1, lv0, lv1;
#define ATT_LOAD(kb)                                                                                  \
    {                                                                                                 \
      const int kx0_ = (kb) * 64 + lrow, kx1_ = kx0_ + 32;                                            \
      if (sample && (kb) < 16) {                                                                      \
        const float* ck_ = p.in[I_CK] + ((size_t)(b * 1024 + kx0_) * 16 + h) * 128 + lch * 8;         \
        const float* cv_ = p.in[I_CV] + ((size_t)(b * 1024 + kx0_) * 16 + h) * 128 + lch * 8;         \
        float4 a_ = *(const float4*)ck_, b_ = *(const float4*)(ck_ + 4);                              \
        float4 c_ = *(const float4*)(ck_ + 32 * 2048), d_ = *(const float4*)(ck_ + 32 * 2048 + 4);    \
        lk0 = make_uint4(pack2(a_.x, a_.y), pack2(a_.z, a_.w), pack2(b_.x, b_.y), pack2(b_.z, b_.w)); \
        lk1 = make_uint4(pack2(c_.x, c_.y), pack2(c_.z, c_.w), pack2(d_.x, d_.y), pack2(d_.z, d_.w)); \
        a_ = *(const float4*)cv_; b_ = *(const float4*)(cv_ + 4);                                     \
        c_ = *(const float4*)(cv_ + 32 * 2048); d_ = *(const float4*)(cv_ + 32 * 2048 + 4);           \
        lv0 = make_uint4(pack2(a_.x, a_.y), pack2(a_.z, a_.w), pack2(b_.x, b_.y), pack2(b_.z, b_.w)); \
        lv1 = make_uint4(pack2(c_.x, c_.y), pack2(c_.z, c_.w), pack2(d_.x, d_.y), pack2(d_.z, d_.w)); \
      } else {                                                                                        \
        const size_t o0_ = (size_t)(tokk0 + kx0_) * 2048 + h * 128 + lch * 8;                         \
        const size_t o1_ = o0_ + (size_t)32 * 2048;                                                   \
        if (kx0_ < nkeys) { lk0 = *(const uint4*)(KB + o0_); lv0 = *(const uint4*)(VB + o0_); }       \
        else { lk0 = make_uint4(0, 0, 0, 0); lv0 = lk0; }                                             \
        if (kx1_ < nkeys) { lk1 = *(const uint4*)(KB + o1_); lv1 = *(const uint4*)(VB + o1_); }       \
        else { lk1 = make_uint4(0, 0, 0, 0); lv1 = lk1; }                                             \
      }                                                                                               \
    }
#define ATT_STORE(st)                                                                                 \
    {                                                                                                 \
      char* sK_ = smem + (st) * 32768; char* sV_ = sK_ + 16384;                                       \
      *(uint4*)(sK_ + lw0) = lk0; *(uint4*)(sK_ + lw1) = lk1;                                         \
      *(uint4*)(sV_ + lw0) = lv0; *(uint4*)(sV_ + lw1) = lv1;                                         \
    }
    ATT_LOAD(ntiles - 1);
    ATT_STORE(0);
    __syncthreads();
    for (int it = 0; it < ntiles; ++it) {
      const int kb = ntiles - 1 - it, st = it & 1;
      if (it + 1 < ntiles) ATT_LOAD(kb - 1);
      if (!wdone && kb * 64 < qwmax) {
        const char* sK = smem + st * 32768;
        const char* sV = sK + 16384;
        f32x4 S[4];
#pragma unroll
        for (int mt = 0; mt < 4; ++mt) S[mt] = (f32x4){0, 0, 0, 0};
#pragma unroll
        for (int ks = 0; ks < 4; ++ks)
#pragma unroll
          for (int mt = 0; mt < 4; ++mt) {
            bf16x8 a = *(const bf16x8*)(sK + off_b(mt * 16 + fr, ks * 4 + fq));
            S[mt] = __builtin_amdgcn_mfma_f32_16x16x32_bf16(a, qf[ks], S[mt], 0, 0, 0);
          }
        bf16x8 wf[2];
        {
          float ee[4][4], tot[4], hi[4];
#pragma unroll
          for (int mt = 0; mt < 4; ++mt) {
            const int kbase = kb * 64 + mt * 16 + fq * 4;
            float ls[4];
#pragma unroll
            for (int jj = 0; jj < 4; ++jj) {
              const float u = S[mt][jj];
              const bool valid = (kbase + jj) < qp;
              const float l = -__builtin_amdgcn_logf(1.0f + __builtin_amdgcn_exp2f(u));
              ls[jj] = valid ? l : 0.f;
              ee[mt][jj] = valid ? (u + l) : -1e30f;
            }
            const float x3 = ls[3], x2 = x3 + ls[2], x1 = x2 + ls[1], seg = x1 + ls[0];
            ee[mt][2] += x3; ee[mt][1] += x2; ee[mt][0] += x1;
            const float t1 = __shfl_xor(seg, 16), t2 = __shfl_xor(seg, 32), t3 = __shfl_xor(t1, 32);
            tot[mt] = seg + t1 + t2 + t3;
            hi[mt] = fq == 0 ? (t1 + t2 + t3) : fq == 1 ? (t2 + t3) : fq == 2 ? t1 : 0.f;
          }
          float run = carry;
          float wv[4][4];
#pragma unroll
          for (int mt = 3; mt >= 0; --mt) {
            const float base = run + hi[mt];
            run += tot[mt];
#pragma unroll
            for (int jj = 0; jj < 4; ++jj) wv[mt][jj] = __builtin_amdgcn_exp2f(ee[mt][jj] + base);
          }
          carry = run;
          if (__all(carry < -150.0f)) { wdone = true; if (lane == 0) dflag[w] = 1; }
#pragma unroll
          for (int p2 = 0; p2 < 2; ++p2) {
            uint4 pk;
            pk.x = pack2(wv[2 * p2][0], wv[2 * p2][1]); pk.y = pack2(wv[2 * p2][2], wv[2 * p2][3]);
            pk.z = pack2(wv[2 * p2 + 1][0], wv[2 * p2 + 1][1]); pk.w = pack2(wv[2 * p2 + 1][2], wv[2 * p2 + 1][3]);
            wf[p2] = *(bf16x8*)&pk;
          }
        }
#pragma unroll
        for (int p2 = 0; p2 < 2; ++p2)
#pragma unroll
          for (int dt = 0; dt < 8; ++dt) {
            const unsigned r0 = 32 * p2 + 4 * fq + tq, r1 = r0 + 16;
            const unsigned ch = 2 * dt + (tp >> 1);
            const char* a0 = sV + off_b(r0, ch) + 8 * (tp & 1);
            const char* a1 = sV + off_b(r1, ch) + 8 * (tp & 1);
            s16x4 lo = __builtin_amdgcn_ds_read_tr16_b64_v4i16((s16x4 __attribute__((address_space(3)))*)(a0));
            s16x4 hi4 = __builtin_amdgcn_ds_read_tr16_b64_v4i16((s16x4 __attribute__((address_space(3)))*)(a1));
            bf16x8 a = {lo[0], lo[1], lo[2], lo[3], hi4[0], hi4[1], hi4[2], hi4[3]};
            O[dt] = __builtin_amdgcn_mfma_f32_16x16x32_bf16(a, wf[p2], O[dt], 0, 0, 0);
          }
      }
      if (it + 1 < ntiles) ATT_STORE(st ^ 1);
      __syncthreads();
      {
        const int4 f0 = *(const int4*)dflag, f1 = *(const int4*)(dflag + 4);
        if (f0.x & f0.y & f0.z & f0.w & f1.x & f1.y & f1.z & f1.w) break;
      }
    }
#undef ATT_LOAD
#undef ATT_STORE
    if (wactive) {
      const size_t rowoff = (size_t)(tokq0 + w * 16 + fr) * 2048 + h * 128;
#pragma unroll
      for (int dt = 0; dt < 8; ++dt) {
        const int d = dt * 16 + fq * 4;
        uint2 z = *(const uint2*)(ZS + rowoff + d);
        f32x4 v = O[dt];
        uint2 o;
        o.x = pack2(v[0] * bflo(z.x), v[1] * bfhi(z.x)); o.y = pack2(v[2] * bflo(z.y), v[3] * bfhi(z.y));
        *(uint2*)(OG + rowoff + d) = o;
      }
    }
  }
}


DEV void grid_barrier(unsigned* bar, unsigned target) {
  __syncthreads();
  if (threadIdx.x == 0) {
    __builtin_amdgcn_fence(__ATOMIC_RELEASE, "agent");
    asm volatile("s_waitcnt vmcnt(0)" ::: "memory");
    __hip_atomic_fetch_add(bar, 1u, __ATOMIC_RELAXED, __HIP_MEMORY_SCOPE_AGENT);
    while (__hip_atomic_load(bar, __ATOMIC_RELAXED, __HIP_MEMORY_SCOPE_AGENT) < target) __builtin_amdgcn_s_sleep(1);
    __builtin_amdgcn_fence(__ATOMIC_ACQUIRE, "agent");
    asm volatile("s_waitcnt vmcnt(0)" ::: "memory");
  }
  __syncthreads();
}

__global__ void __launch_bounds__(NTHREADS) __attribute__((target("no-packed-fp32-ops"))) mega(Params p, int lo, int hi) {
  __shared__ __attribute__((aligned(16))) char smem[147456];
  cg::grid_group grid = cg::this_grid();
#ifndef PROBE_DOUBLE
#define PROBE_DOUBLE -1
#endif
#define RUN_PHASE(k, call) if ((k) >= lo && (k) < hi) { if ((k) > lo) { if ((k) == lo + 1) grid.sync(); else grid_barrier((unsigned*)(p.ws + WS_BAR), (unsigned)((k) - lo - 1) * gridDim.x); } call; }
  RUN_PHASE(0, phase_prep(p, smem))
  RUN_PHASE(1, phase_norm0(p))
  RUN_PHASE(2, phase_proj0(p, smem))
  RUN_PHASE(3, phase_scan(p, smem))
  RUN_PHASE(4, phase_outproj<0>(p, smem))
  RUN_PHASE(5, phase_norm1(p))
  RUN_PHASE(6, phase_proj1(p, smem))
  RUN_PHASE(7, phase_attn(p, smem))
  RUN_PHASE(8, phase_outproj<1>(p, smem))
}

#ifndef N_LAUNCH_MODE
#define N_LAUNCH_MODE 1
#endif

extern "C" void kernel_launch(void* const* d_in, const int* in_sizes, int n_in, void* d_out, int out_size, void* d_ws, size_t ws_size,
                              hipStream_t stream) {
  Params p{};
  for (int i = 0; i < 36; ++i) p.in[i] = (const float*)d_in[i];
  p.out = (float*)d_out;
  p.ws = (char*)d_ws;
  static int grid_blocks = 0;
  if (!grid_blocks) {
    int dev = 0, cus = 0, per_cu = 0;
    hipGetDevice(&dev);
    hipDeviceGetAttribute(&cus, hipDeviceAttributeMultiprocessorCount, dev);
    hipOccupancyMaxActiveBlocksPerMultiprocessor(&per_cu, mega, NTHREADS, 0);
    if (per_cu < 1) per_cu = 1;
    grid_blocks = cus * per_cu;
  }
  if (ws_size < WS_END) { fprintf(stderr, "workspace too small: %zu < %llu\n", ws_size, (unsigned long long)WS_END); return; }
#if N_LAUNCH_MODE == 1
  int lo = 0, hi = 9;
  hipMemsetAsync((char*)d_ws + WS_BAR, 0, 256, stream);
  void* args[] = {&p, &lo, &hi};
  hipError_t e = hipLaunchCooperativeKernel((void*)mega, dim3(grid_blocks), dim3(NTHREADS), args, 0, stream);
  if (e != hipSuccess) fprintf(stderr, "cooperative launch failed: %s (grid %d)\n", hipGetErrorString(e), grid_blocks);
#else
  for (int ph = 0; ph < 9; ++ph) hipLaunchKernelGGL(mega, dim3(grid_blocks), dim3(NTHREADS), 0, stream, p, ph, ph + 1);
#endif
}
```

```cpp
#include <hip/hip_runtime.h>
#include <hip/hip_cooperative_groups.h>
#include <cstdio>
namespace cg = cooperative_groups;

typedef unsigned short u16;
typedef short bf16x8 __attribute__((ext_vector_type(8)));
typedef short s16x4 __attribute__((ext_vector_type(4)));
typedef float f32x4 __attribute__((ext_vector_type(4)));
typedef float f32x2 __attribute__((ext_vector_type(2)));
typedef __bf16 bf16x2_t __attribute__((ext_vector_type(2)));
typedef _Float16 h2_t __attribute__((ext_vector_type(2)));

#define DEV __device__ __forceinline__

#define NTOK 33280
#define TP 32768
#define NTHREADS 512

#define OFF_Y_P 0
#define OFF_Y_S 33554432
#define OFF_K_P 34078720
#define OFF_V_P 101187584
#define OFF_WKV_P 168296448
#define OFF_SH_P 169345024
#define OFF_K_S 169353216
#define OFF_V_S 170401792
#define OFF_WKV_S 171450368
#define OFF_SH_S 173547520

#define SLOT 136314880ull
#define WS_W (7ull * SLOT)
#define WS_WT_IN (WS_W)
#define WS_WT_OUTA (WS_WT_IN + 16777216ull)
#define WS_WT_KV (WS_WT_OUTA + 4194304ull)
#define WS_WT_INB (WS_WT_KV + 8388608ull)
#define WS_WT_OUTB (WS_WT_INB + 8388608ull)
#define WS_W2T (WS_WT_OUTB + 4194304ull)
#define WS_A2T (WS_W2T + 262144ull)
#define WS_L1T (WS_A2T + 262144ull)
#define WS_MOD (WS_L1T + 524288ull)
#define WS_SH (WS_MOD + 589824ull)
#define WS_CTR (WS_SH + 49152ull)
#define WS_BAR (WS_CTR + 4096ull)
#define WS_END (WS_BAR + 256ull)
#define WS_H0 (6ull * SLOT)
#define WS_T (6ull * SLOT + 68157440ull)

struct Params {
  const float* in[36];
  float* out;
  char* ws;
};

enum { I_XP = 0, I_XS, I_CK, I_CV, I_SWKV, I_SSH, I_CP, I_CS, I_ANG, I_AADAW, I_AADAB, I_AWIN, I_AMUIN, I_AMUW, I_AMUA,
       I_AW0, I_AW1, I_AW2, I_AA0, I_AA1, I_AA2, I_AKK, I_AKA, I_ARK, I_ALNG, I_ALNB, I_AWOUT, I_KVNG, I_KVW, I_KGAIN,
       I_BNG, I_BADAW, I_BADAB, I_BWIN, I_BQG, I_BWOUT };

DEV int seq_of(int t) { return t < TP ? (t >> 12) : 8 + ((t - TP) >> 5); }
DEV bool seq_start(int t) { return t < TP ? ((t & 4095) == 0) : (((t - TP) & 31) == 0); }

DEV unsigned pack2(float a, float b) {
  f32x2 v = {a, b};
  bf16x2_t r = __builtin_convertvector(v, bf16x2_t);
  return *(unsigned*)&r;
}
DEV unsigned packh2(float a, float b) {
  f32x2 v = {a, b};
  h2_t r = __builtin_convertvector(v, h2_t);
  return *(unsigned*)&r;
}
DEV float bflo(unsigned w) { return __uint_as_float(w << 16); }
DEV float bfhi(unsigned w) { return __uint_as_float(w & 0xffff0000u); }
DEV void unpack8(const uint4& x, float* f) {
  f[0] = bflo(x.x); f[1] = bfhi(x.x); f[2] = bflo(x.y); f[3] = bfhi(x.y);
  f[4] = bflo(x.z); f[5] = bfhi(x.z); f[6] = bflo(x.w); f[7] = bfhi(x.w);
}
DEV float sigmoidf_(float x) { return 1.0f / (1.0f + __expf(-x)); }

template <int CTRL>
DEV float dppf(float x) {
  return __int_as_float(__builtin_amdgcn_update_dpp(0, __float_as_int(x), CTRL, 0xf, 0xf, true));
}
DEV float red4(float x) { x += dppf<0xB1>(x); x += dppf<0x4E>(x); return x; }
DEV float red8(float x) { x = red4(x); x += dppf<0x141>(x); return x; }
DEV float red16(float x) { x = red8(x); x += dppf<0x140>(x); return x; }
DEV float wave_sum(float x) {
#pragma unroll
  for (int o = 32; o >= 1; o >>= 1) x += __shfl_xor(x, o);
  return x;
}


#define SCHED_SLOT_OFF 147440
DEV int xcc_id() { return (int)(__builtin_amdgcn_s_getreg((3 << 11) | 20) & 0x7u); }
DEV unsigned* sched_ctr(const Params& p, int phase_slot, int list) { return (unsigned*)(p.ws + WS_CTR) + (phase_slot * 8 + list) * 16; }
DEV int sched_first(unsigned* ctr, char* smem) {
  int* slot = (int*)(smem + SCHED_SLOT_OFF);
  __syncthreads();
  if (threadIdx.x == 0) *slot = (int)atomicAdd(ctr, 1u);
  __syncthreads();
  return *slot;
}

DEV void group_sync(unsigned* bar, unsigned target) {
  __syncthreads();
  if (threadIdx.x == 0) {
    __hip_atomic_fetch_add(bar, 1u, __ATOMIC_RELAXED, __HIP_MEMORY_SCOPE_AGENT);
    while (__hip_atomic_load(bar, __ATOMIC_RELAXED, __HIP_MEMORY_SCOPE_AGENT) < target) __builtin_amdgcn_s_sleep(2);
  }
  __syncthreads();
}
DEV int sched_prefetch(unsigned* ctr) { return threadIdx.x == 0 ? (int)atomicAdd(ctr, 1u) : 0; }
DEV int sched_commit(int nxt, char* smem) {
  int* slot = (int*)(smem + SCHED_SLOT_OFF);
  __syncthreads();
  if (threadIdx.x == 0) *slot = nxt;
  __syncthreads();
  return *slot;
}

#define GEMM_STAGE_BYTES 49152

template <int AMODE>
DEV void gemm_main(f32x4 (&acc)[4][4], const u16* __restrict__ A, int lda, const u16* __restrict__ Bt, int ldb, int nk,
                   int m0, int n0, const float* __restrict__ mu, const u16* __restrict__ SH, char* smem) {
  const int tid = threadIdx.x, lane = tid & 63, wid = tid >> 6, wr = wid >> 1, wc = wid & 1, fr = lane & 15, fq = lane >> 4;
  const int lrow = tid >> 3, lch = tid & 7;
#pragma unroll
  for (int i = 0; i < 4; ++i)
#pragma unroll
    for (int j = 0; j < 4; ++j) acc[i][j] = (f32x4){0.f, 0.f, 0.f, 0.f};

  const u16* pa0; const u16* pa1; const u16* pa2; const u16* pa3;
  const u16* pp0 = nullptr;
  const int arow = 4 * lrow;
  {
    int m = m0 + arow;
    pa0 = A + (size_t)m * lda + lch * 8;
    pa1 = pa0 + lda; pa2 = pa1 + lda; pa3 = pa2 + lda;
    if (AMODE != 0) pp0 = seq_start(m) ? SH + seq_of(m) * 1024 + lch * 8 : pa0 - lda;
  }
  const u16* pb0 = Bt + (size_t)(n0 + lrow) * ldb + lch * 8;
  const u16* pb1 = pb0 + (size_t)64 * ldb;
  const int woffB = lrow * 128 + ((lch ^ ((lrow >> 1) & 7)) << 4);
  const int woffA0 = (arow + 0) * 128 + ((lch ^ (((arow + 0) >> 1) & 7)) << 4);
  const int woffA1 = (arow + 1) * 128 + ((lch ^ (((arow + 1) >> 1) & 7)) << 4);
  const int woffA2 = (arow + 2) * 128 + ((lch ^ (((arow + 2) >> 1) & 7)) << 4);
  const int woffA3 = (arow + 3) * 128 + ((lch ^ (((arow + 3) >> 1) & 7)) << 4);

  uint4 ra0, ra1, ra2, ra3, rp0, rb0, rb1;
  float4 mu0, mu1;
  rp0 = make_uint4(0, 0, 0, 0);
  mu0 = mu1 = make_float4(0, 0, 0, 0);

#define G_LOAD(kt)                                                                     \
  {                                                                                    \
    const int k0_ = (kt) * 64;                                                         \
    if (AMODE == 0) {                                                                  \
      ra0 = *(const uint4*)(pa0 + k0_); ra1 = *(const uint4*)(pa1 + k0_);              \
      ra2 = *(const uint4*)(pa2 + k0_); ra3 = *(const uint4*)(pa3 + k0_);              \
    } else if (AMODE == 1) {                                                           \
      ra0 = *(const uint4*)(pa0 + k0_); ra1 = *(const uint4*)(pa1 + k0_);              \
      ra2 = *(const uint4*)(pa2 + k0_); ra3 = *(const uint4*)(pa3 + k0_);              \
      rp0 = *(const uint4*)(pp0 + k0_);                                                \
      mu0 = *(const float4*)(mu + k0_ + lch * 8); mu1 = *(const float4*)(mu + k0_ + lch * 8 + 4); \
    } else {                                                                           \
      const int kk_ = k0_ & 1023;                                                      \
      ra0 = *(const uint4*)(pa0 + kk_); ra1 = *(const uint4*)(pa1 + kk_);              \
      ra2 = *(const uint4*)(pa2 + kk_); ra3 = *(const uint4*)(pa3 + kk_);              \
      if (k0_ >= 1024) rp0 = *(const uint4*)(pp0 + kk_);                               \
    }                                                                                  \
    rb0 = *(const uint4*)(pb0 + k0_); rb1 = *(const uint4*)(pb1 + k0_);                \
  }

#define G_XFORM(dst, a_, p_, kt)                                                       \
  {                                                                                    \
    if (AMODE == 0) dst = a_;                                                          \
    else if (AMODE == 1) {                                                             \
      float h_[8], q_[8]; unpack8(a_, h_); unpack8(p_, q_);                            \
      dst.x = pack2(h_[0] + mu0.x * (q_[0] - h_[0]), h_[1] + mu0.y * (q_[1] - h_[1])); \
      dst.y = pack2(h_[2] + mu0.z * (q_[2] - h_[2]), h_[3] + mu0.w * (q_[3] - h_[3])); \
      dst.z = pack2(h_[4] + mu1.x * (q_[4] - h_[4]), h_[5] + mu1.y * (q_[5] - h_[5])); \
      dst.w = pack2(h_[6] + mu1.z * (q_[6] - h_[6]), h_[7] + mu1.w * (q_[7] - h_[7])); \
    } else {                                                                           \
      if ((kt) * 64 >= 1024) {                                                         \
        float h_[8], q_[8]; unpack8(a_, h_); unpack8(p_, q_);                          \
        dst.x = pack2(q_[0] - h_[0], q_[1] - h_[1]); dst.y = pack2(q_[2] - h_[2], q_[3] - h_[3]); \
        dst.z = pack2(q_[4] - h_[4], q_[5] - h_[5]); dst.w = pack2(q_[6] - h_[6], q_[7] - h_[7]); \
      } else dst = a_;                                                                 \
    }                                                                                  \
  }

#define G_STORE(stage, kt)                                                             \
  {                                                                                    \
    char* sA_ = smem + (stage) * GEMM_STAGE_BYTES; char* sB_ = sA_ + 32768;            \
    uint4 v_;                                                                          \
    G_XFORM(v_, ra0, rp0, kt); *(uint4*)(sA_ + woffA0) = v_;                           \
    G_XFORM(v_, ra1, ra0, kt); *(uint4*)(sA_ + woffA1) = v_;                           \
    G_XFORM(v_, ra2, ra1, kt); *(uint4*)(sA_ + woffA2) = v_;                           \
    G_XFORM(v_, ra3, ra2, kt); *(uint4*)(sA_ + woffA3) = v_;                           \
    *(uint4*)(sB_ + woffB) = rb0; *(uint4*)(sB_ + woffB + 64 * 128) = rb1;             \
  }

  G_LOAD(0);
  G_STORE(0, 0);
  __syncthreads();
  const int rsw = (fr >> 1) & 7;
  for (int kt = 0; kt < nk; ++kt) {
    const int st = kt & 1;
    if (kt + 1 < nk) G_LOAD(kt + 1);
    __builtin_amdgcn_sched_barrier(0);
    {
      const char* sA = smem + st * GEMM_STAGE_BYTES;
      const char* sB = sA + 32768;
#pragma unroll
      for (int kk = 0; kk < 2; ++kk) {
        bf16x8 af[4], bfr[4];
        const int cho = ((kk * 4 + fq) ^ rsw) << 4;
#pragma unroll
        for (int i = 0; i < 4; ++i) af[i] = *(const bf16x8*)(sA + (wr * 64 + i * 16 + fr) * 128 + cho);
#pragma unroll
        for (int j = 0; j < 4; ++j) bfr[j] = *(const bf16x8*)(sB + (wc * 64 + j * 16 + fr) * 128 + cho);
#pragma unroll
        for (int i = 0; i < 4; ++i)
#pragma unroll
          for (int j = 0; j < 4; ++j) acc[i][j] = __builtin_amdgcn_mfma_f32_16x16x32_bf16(bfr[j], af[i], acc[i][j], 0, 0, 0);
      }
    }
    if (kt + 1 < nk) G_STORE(st ^ 1, kt + 1);
    __syncthreads();
  }
#undef G_LOAD
#undef G_XFORM
#undef G_STORE
}


#define G2_STAGE_BYTES 32768
#define G2_MU_OFF (3 * G2_STAGE_BYTES)
DEV int g2_swz(int row) { return (0x78 >> (2 * ((row >> 2) & 3))) & 3; }
template <int AMODE>
DEV void gemm_main256(f32x4 (&acc)[8][4], const u16* __restrict__ A, int lda, const u16* __restrict__ Bt, int ldb, int nk64,
                      int m0, int n0, const float* __restrict__ mu, const u16* __restrict__ SH, char* smem) {
  const int tid = threadIdx.x, lane = tid & 63, wid = tid >> 6, wr = wid >> 2, wc = wid & 3, fr = lane & 15, fq = lane >> 4;
  const int nk = nk64 * 2;
  const int lrow2 = 2 * (tid >> 2), lch = tid & 3;
#pragma unroll
  for (int i = 0; i < 8; ++i)
#pragma unroll
    for (int j = 0; j < 4; ++j) acc[i][j] = (f32x4){0.f, 0.f, 0.f, 0.f};
  const u16* pa0 = A + (size_t)(m0 + lrow2) * lda + lch * 8;
  const u16* pp0 = nullptr;
  if (AMODE != 0) pp0 = seq_start(m0 + lrow2) ? SH + seq_of(m0 + lrow2) * 1024 + lch * 8 : pa0 - lda;
  const u16* pb0 = Bt + (size_t)(n0 + lrow2) * ldb + lch * 8;
  const int woff0 = (lrow2 + 0) * 64 + ((lch ^ g2_swz(lrow2 + 0)) << 4);
  const int woff1 = (lrow2 + 1) * 64 + ((lch ^ g2_swz(lrow2 + 1)) << 4);
  const float* muL = (const float*)(smem + G2_MU_OFF);
  if (AMODE == 1) {
    if (tid < 256) *(float4*)(smem + G2_MU_OFF + tid * 16) = *(const float4*)(mu + tid * 4);
  }
  uint4 xa0, xa1, xp, xb0, xb1;
  uint4 ya0, ya1, yp, yb0, yb1;
  xp = yp = make_uint4(0, 0, 0, 0);

#define K_LOAD(S, kt)                                                                  \
  {                                                                                    \
    const int k0_ = (kt) * 32;                                                         \
    S##a0 = *(const uint4*)(pa0 + k0_); S##a1 = *(const uint4*)(pa0 + lda + k0_);      \
    if (AMODE == 1) S##p = *(const uint4*)(pp0 + k0_);                                 \
    S##b0 = *(const uint4*)(pb0 + k0_); S##b1 = *(const uint4*)(pb0 + ldb + k0_);      \
  }
#define K_XFORM(dst, a_, p_)                                                           \
  {                                                                                    \
    if (AMODE == 0) dst = a_;                                                          \
    else {                                                                             \
      float h_[8], q_[8]; unpack8(a_, h_); unpack8(p_, q_);                            \
      dst.x = pack2(h_[0] + mu0.x * (q_[0] - h_[0]), h_[1] + mu0.y * (q_[1] - h_[1])); \
      dst.y = pack2(h_[2] + mu0.z * (q_[2] - h_[2]), h_[3] + mu0.w * (q_[3] - h_[3])); \
      dst.z = pack2(h_[4] + mu1.x * (q_[4] - h_[4]), h_[5] + mu1.y * (q_[5] - h_[5])); \
      dst.w = pack2(h_[6] + mu1.z * (q_[6] - h_[6]), h_[7] + mu1.w * (q_[7] - h_[7])); \
    }                                                                                  \
  }
#define K_STORE(S, stage, kt)                                                          \
  {                                                                                    \
    char* sA_ = smem + (stage) * G2_STAGE_BYTES; char* sB_ = sA_ + 16384;              \
    uint4 v_; float4 mu0, mu1;                                                         \
    if (AMODE == 1) { mu0 = *(const float4*)(muL + (kt) * 32 + lch * 8); mu1 = *(const float4*)(muL + (kt) * 32 + lch * 8 + 4); } \
    K_XFORM(v_, S##a0, S##p); *(uint4*)(sA_ + woff0) = v_;                             \
    K_XFORM(v_, S##a1, S##a0); *(uint4*)(sA_ + woff1) = v_;                            \
    *(uint4*)(sB_ + woff0) = S##b0; *(uint4*)(sB_ + woff1) = S##b1;                    \
  }
#define K_COMPUTE_HALF(stage, i0)                                                      \
  {                                                                                    \
    const char* sA_ = smem + (stage) * G2_STAGE_BYTES;                                 \
    _Pragma("unroll") for (int i = (i0); i < (i0) + 4; ++i) {                          \
      const bf16x8 af = *(const bf16x8*)(sA_ + (wr * 128 + i * 16 + fr) * 64 + cho);   \
      _Pragma("unroll") for (int j = 0; j < 4; ++j) acc[i][j] = __builtin_amdgcn_mfma_f32_16x16x32_bf16(bfr[j], af, acc[i][j], 0, 0, 0); \
    }                                                                                  \
  }
#define K_LOAD_B(stage)                                                                \
  {                                                                                    \
    const char* sB_ = smem + (stage) * G2_STAGE_BYTES + 16384;                         \
    _Pragma("unroll") for (int j = 0; j < 4; ++j) bfr[j] = *(const bf16x8*)(sB_ + (wc * 64 + j * 16 + fr) * 64 + cho); \
  }
#define K_ITER(kt, L, S)                                                               \
  {                                                                                    \
    K_LOAD(L, min((kt) + 2, nk - 1));                                                  \
    __builtin_amdgcn_sched_barrier(0);                                                 \
    bf16x8 bfr[4];                                                                     \
    K_LOAD_B(cu);                                                                      \
    K_COMPUTE_HALF(cu, 0);                                                             \
    __builtin_amdgcn_sched_barrier(0);                                                 \
    K_STORE(S, nx, min((kt) + 1, nk - 1));                                             \
    __builtin_amdgcn_sched_barrier(0);                                                 \
    if (AMODE == 1) K_LOAD_B(cu);                                                      \
    K_COMPUTE_HALF(cu, 4);                                                             \
    __syncthreads();                                                                   \
    cu = nx; nx = (nx == 2) ? 0 : nx + 1;                                              \
  }
  const int cho = (fq ^ g2_swz(fr)) << 4;
  if (AMODE == 1) __syncthreads();
  K_LOAD(x, 0);
  K_LOAD(y, 1);
  K_STORE(x, 0, 0);
  __syncthreads();
  int cu = 0, nx = 1;
  for (int kt = 0; kt < nk; kt += 2) {
    K_ITER(kt, x, y);
    K_ITER(kt + 1, y, x);
  }
#undef K_LOAD
#undef K_XFORM
#undef K_STORE
#undef K_COMPUTE_HALF
#undef K_LOAD_B
#undef K_ITER
}


#define GD_NST 4
DEV void gemm_main256_dma(f32x4 (&acc)[8][4], const u16* __restrict__ A, int lda, const u16* __restrict__ Bt, int ldb, int nk64,
                          int m0, int n0, char* smem) {
  const int tid = threadIdx.x, lane = tid & 63, wid = tid >> 6, wr = wid >> 2, wc = wid & 3, fr = lane & 15, fq = lane >> 4;
  const int nk = nk64 * 2;
#pragma unroll
  for (int i = 0; i < 8; ++i)
#pragma unroll
    for (int j = 0; j < 4; ++j) acc[i][j] = (f32x4){0.f, 0.f, 0.f, 0.f};
  const int prow = 16 * wid + (lane >> 2);
  const int pch = (lane & 3) ^ g2_swz(prow);
  const u16* srcA = A + (size_t)(m0 + prow) * lda + pch * 8;
  const u16* srcB = Bt + (size_t)(n0 + prow) * ldb + pch * 8;
  const size_t a128 = (size_t)128 * lda, b128 = (size_t)128 * ldb;
  char* ldsw = smem + (16 * wid) * 64;
#define D_FILL(kt, stage)                                                              \
  {                                                                                    \
    const int k0_ = (kt) * 32;                                                         \
    char* d_ = ldsw + (stage) * G2_STAGE_BYTES;                                        \
    __builtin_amdgcn_global_load_lds((const unsigned*)(srcA + k0_), (unsigned*)(d_), 16, 0, 0);               \
    __builtin_amdgcn_global_load_lds((const unsigned*)(srcA + a128 + k0_), (unsigned*)(d_ + 8192), 16, 0, 0); \
    __builtin_amdgcn_global_load_lds((const unsigned*)(srcB + k0_), (unsigned*)(d_ + 16384), 16, 0, 0);       \
    __builtin_amdgcn_global_load_lds((const unsigned*)(srcB + b128 + k0_), (unsigned*)(d_ + 16384 + 8192), 16, 0, 0); \
  }
  const int cho = (fq ^ g2_swz(fr)) << 4;
  __syncthreads();
  D_FILL(0, 0);
  D_FILL(min(1, nk - 1), 1);
  D_FILL(min(2, nk - 1), 2);
  int cu = 0, fill = 3;
  for (int kt = 0; kt < nk; ++kt) {
    asm volatile("s_waitcnt vmcnt(8)" ::: "memory");
    asm volatile("s_waitcnt lgkmcnt(0)" ::: "memory");
    __builtin_amdgcn_s_barrier();
    D_FILL(min(kt + 3, nk - 1), fill);
    {
      const char* sA_ = smem + cu * G2_STAGE_BYTES;
      const char* sB_ = sA_ + 16384;
      bf16x8 bfr[4];
#pragma unroll
      for (int j = 0; j < 4; ++j) bfr[j] = *(const bf16x8*)(sB_ + (wc * 64 + j * 16 + fr) * 64 + cho);
#pragma unroll
      for (int i = 0; i < 8; ++i) {
        const bf16x8 af = *(const bf16x8*)(sA_ + (wr * 128 + i * 16 + fr) * 64 + cho);
#pragma unroll
        for (int j = 0; j < 4; ++j) acc[i][j] = __builtin_amdgcn_mfma_f32_16x16x32_bf16(bfr[j], af, acc[i][j], 0, 0, 0);
      }
    }
    cu = (cu == GD_NST - 1) ? 0 : cu + 1;
    fill = (fill == GD_NST - 1) ? 0 : fill + 1;
  }
  asm volatile("s_waitcnt vmcnt(0)" ::: "memory");
  asm volatile("s_waitcnt lgkmcnt(0)" ::: "memory");
  __builtin_amdgcn_s_barrier();
#undef D_FILL
}

DEV void transpose_tile(const float* __restrict__ src, int N, int k0, int n0, const float* __restrict__ scale, u16* __restrict__ dst,
                        int dstride, int drow0, int dcol0, char* smem) {
  float* tile = (float*)smem;
  const int tid = threadIdx.x;
#pragma unroll
  for (int i = 0; i < 2; ++i) {
    int kl = (tid >> 4) + 32 * i, n4 = (tid & 15) * 4;
    float4 v = *(const float4*)(src + (size_t)(k0 + kl) * N + n0 + n4);
    float s = scale ? scale[k0 + kl] : 1.0f;
    tile[kl * 65 + n4 + 0] = v.x * s; tile[kl * 65 + n4 + 1] = v.y * s;
    tile[kl * 65 + n4 + 2] = v.z * s; tile[kl * 65 + n4 + 3] = v.w * s;
  }
  __syncthreads();
  {
    int nl = tid >> 3, k8 = (tid & 7) * 8;
    uint4 o;
    o.x = pack2(tile[(k8 + 0) * 65 + nl], tile[(k8 + 1) * 65 + nl]);
    o.y = pack2(tile[(k8 + 2) * 65 + nl], tile[(k8 + 3) * 65 + nl]);
    o.z = pack2(tile[(k8 + 4) * 65 + nl], tile[(k8 + 5) * 65 + nl]);
    o.w = pack2(tile[(k8 + 6) * 65 + nl], tile[(k8 + 7) * 65 + nl]);
    *(uint4*)(dst + (size_t)(drow0 + n0 + nl) * dstride + dcol0 + k0 + k8) = o;
  }
  __syncthreads();
}

DEV void phase_prep(const Params& p, char* smem) {
  const int tid = threadIdx.x;
  char* ws = p.ws;
  if (blockIdx.x < 96) {
    float* cL = (float*)smem;
    float* red = (float*)(smem + 98304);
    for (int e = tid; e < 24 * 256; e += NTHREADS) {
      int s = e >> 8, k4 = (e & 255) * 4;
      float4 v = s < 8 ? *(const float4*)(p.in[I_CP] + s * 1024 + k4) : *(const float4*)(p.in[I_CS] + (s - 8) * 1024 + k4);
      *(float4*)(cL + s * 1024 + k4) = v;
    }
    __syncthreads();
    for (int item = blockIdx.x; item < 96; item += gridDim.x) {
      const int l = item / 48, j0 = (item % 48) * 64;
      const float* W = (l == 0 ? p.in[I_AADAW] : p.in[I_BADAW]);
      const float* bias = (l == 0 ? p.in[I_AADAB] : p.in[I_BADAB]);
      const int col = tid & 63, kg = tid >> 6;
      float acc[24];
#pragma unroll
      for (int s = 0; s < 24; ++s) acc[s] = 0.f;
      for (int k = kg * 128; k < kg * 128 + 128; ++k) {
        float w = W[(size_t)k * 3072 + j0 + col];
#pragma unroll
        for (int s = 0; s < 24; ++s) acc[s] += cL[s * 1024 + k] * w;
      }
#pragma unroll
      for (int s = 0; s < 24; ++s) red[(kg * 24 + s) * 64 + col] = acc[s];
      __syncthreads();
      float* mod = (float*)(ws + WS_MOD);
      for (int e = tid; e < 24 * 64; e += NTHREADS) {
        int s = e >> 6, c = e & 63;
        float t = bias[j0 + c];
#pragma unroll
        for (int g = 0; g < 8; ++g) t += red[(g * 24 + s) * 64 + c];
        mod[(size_t)(l * 24 + s) * 3072 + j0 + c] = t;
      }
      __syncthreads();
    }
  }
  if (blockIdx.x == 0) for (int e = tid; e < 1024; e += NTHREADS) ((unsigned*)(ws + WS_CTR))[e] = 0u;
  if (blockIdx.x == gridDim.x - 1) {
    u16* SH = (u16*)(ws + WS_SH);
    for (int e = tid; e < 24 * 1024; e += NTHREADS) {
      int s = e >> 10, k = e & 1023;
      float v = s < 8 ? 0.f : p.in[I_SSH][(s - 8) * 1024 + k];
      SH[e] = (u16)(pack2(v, 0.f) & 0xffff);
    }
  }
  const int NT_TOTAL = 2048 + 512 + 1024 + 1024 + 512 + 32 + 32 + 64;
  for (int t = blockIdx.x; t < NT_TOTAL; t += gridDim.x) {
    const float* src; int K, N; u16* dst; int dstride, drow0 = 0, dcol0 = 0; const float* scale = nullptr; int tt = t;
    if (tt < 2048) { src = p.in[I_AWIN]; K = 1024; N = 8192; dst = (u16*)(ws + WS_WT_IN); dstride = 1024; }
    else if ((tt -= 2048) < 512) { src = p.in[I_AWOUT]; K = 2048; N = 1024; dst = (u16*)(ws + WS_WT_OUTA); dstride = 2048; }
    else if ((tt -= 512) < 1024) { src = p.in[I_KVW]; K = 1024; N = 4096; dst = (u16*)(ws + WS_WT_KV); dstride = 1024; }
    else if ((tt -= 1024) < 1024) { src = p.in[I_BWIN]; K = 1024; N = 4096; dst = (u16*)(ws + WS_WT_INB); dstride = 1024; }
    else if ((tt -= 1024) < 512) { src = p.in[I_BWOUT]; K = 2048; N = 1024; dst = (u16*)(ws + WS_WT_OUTB); dstride = 2048; }
    else if ((tt -= 512) < 32) { src = p.in[I_AW2]; K = 64; N = 2048; dst = (u16*)(ws + WS_W2T); dstride = 64; }
    else if ((tt -= 32) < 32) { src = p.in[I_AA2]; K = 64; N = 2048; dst = (u16*)(ws + WS_A2T); dstride = 64; }
    else {
      tt -= 32;
      int job = tt >> 4; tt &= 15;
      K = 1024; N = 64; dst = (u16*)(ws + WS_L1T); dstride = 2048;
      src = (job < 2) ? p.in[I_AW1] : p.in[I_AA1];
      drow0 = (job < 2) ? 0 : 64;
      if (job & 1) { dcol0 = 1024; scale = (job < 2) ? p.in[I_AMUW] : p.in[I_AMUA]; }
    }
    const int ntn = N / 64;
    const int kt = tt / ntn, nt = tt % ntn;
    transpose_tile(src, N, kt * 64, nt * 64, scale, dst, dstride, drow0, dcol0, smem);
  }
}

DEV void phase_norm0(const Params& p) {
  const int lane = threadIdx.x & 63, wid = threadIdx.x >> 6;
  const float* mod = (const float*)(p.ws + WS_MOD);
  u16* H0 = (u16*)(p.ws + WS_H0);
  const float* g = p.in[I_ANG];
  for (int t = blockIdx.x * 8 + wid; t < NTOK; t += gridDim.x * 8) {
    const float* x = t < TP ? p.in[I_XP] + (size_t)t * 1024 : p.in[I_XS] + (size_t)(t - TP) * 1024;
    const int s = seq_of(t);
    const float* md = mod + (size_t)s * 3072;
    float4 v[4];
    float ss = 0.f;
#pragma unroll
    for (int i = 0; i < 4; ++i) {
      v[i] = *(const float4*)(x + lane * 4 + 256 * i);
      ss += v[i].x * v[i].x + v[i].y * v[i].y + v[i].z * v[i].z + v[i].w * v[i].w;
    }
    ss = wave_sum(ss);
    const float rstd = rsqrtf(ss * (1.0f / 1024.0f) + 1e-6f);
    bool last = t < TP ? ((t & 4095) == 4095) : (((t - TP) & 31) == 31);
    float* so = t < TP ? p.out + OFF_SH_P + (t >> 12) * 1024 : p.out + OFF_SH_S + ((t - TP) >> 5) * 1024;
#pragma unroll
    for (int i = 0; i < 4; ++i) {
      const int c = lane * 4 + 256 * i;
      float4 gg = *(const float4*)(g + c), sh = *(const float4*)(md + c), sc = *(const float4*)(md + 1024 + c);
      float4 h;
      h.x = v[i].x * rstd * gg.x * (1.f + sc.x) + sh.x;
      h.y = v[i].y * rstd * gg.y * (1.f + sc.y) + sh.y;
      h.z = v[i].z * rstd * gg.z * (1.f + sc.z) + sh.z;
      h.w = v[i].w * rstd * gg.w * (1.f + sc.w) + sh.w;
      uint2 o; o.x = pack2(h.x, h.y); o.y = pack2(h.z, h.w);
      *(uint2*)(H0 + (size_t)t * 1024 + c) = o;
      if (last) *(float4*)(so + c) = h;
    }
  }
}

DEV void phase_proj0_lora(const Params& p, char* smem) {
  const int tid = threadIdx.x, lane = tid & 63, wid = tid >> 6, fr = lane & 15, fq = lane >> 4;
  const int wr = wid >> 1, wc = wid & 1;
  char* ws = p.ws;
  const u16* H0 = (const u16*)(ws + WS_H0);
  const u16* SH = (const u16*)(ws + WS_SH);
  u16* T = (u16*)(ws + WS_T);
  const int xcc0 = xcc_id();
  int nxt;
  f32x4 acc[4][4];
  for (int ls = 0; ls < 8; ++ls) {
  const int xcd = (xcc0 + ls) & 7;
  unsigned* ctr = sched_ctr(p, 0, xcd);
  for (int li = sched_first(ctr, smem); li < 17; li = sched_commit(nxt, smem)) {
    nxt = sched_prefetch(ctr);
    const int lmt = xcd + 8 * li;
    if (lmt >= 130) continue;
    const int m0 = lmt * 256;
    gemm_main<2>(acc, H0, 1024, (const u16*)(ws + WS_L1T), 2048, 32, m0, 0, nullptr, SH, smem);
#pragma unroll
    for (int i = 0; i < 4; ++i)
#pragma unroll
      for (int j = 0; j < 4; ++j) {
        const int m = m0 + wr * 64 + i * 16 + fr, n = wc * 64 + j * 16 + fq * 4;
        f32x4 v = acc[i][j];
        if (wc == 0) { v[0] = tanhf(v[0]); v[1] = tanhf(v[1]); v[2] = tanhf(v[2]); v[3] = tanhf(v[3]); }
        uint2 o; o.x = pack2(v[0], v[1]); o.y = pack2(v[2], v[3]);
        *(uint2*)(T + (size_t)m * 128 + n) = o;
      }
    __threadfence_block();
    __syncthreads();
    for (int nt = 0; nt < 32; ++nt) {
      const int which = nt >> 4, n0 = (nt & 15) * 128;
      gemm_main<0>(acc, T + which * 64, 128, (const u16*)(ws + (which ? WS_A2T : WS_W2T)), 64, 1, m0, n0, nullptr, nullptr, smem);
      const float* bias = which ? p.in[I_AA0] : p.in[I_AW0];
      u16* dst = (u16*)(ws + (which ? 5ull : 4ull) * SLOT);
      const float sc = which ? 1.0f : -0.60653066f;
#pragma unroll
      for (int i = 0; i < 4; ++i)
#pragma unroll
        for (int j = 0; j < 4; ++j) {
          const int m = m0 + wr * 64 + i * 16 + fr, n = n0 + wc * 64 + j * 16 + fq * 4;
          float4 b4 = *(const float4*)(bias + n);
          f32x4 v = acc[i][j];
          float s0 = sc * sigmoidf_(v[0] + b4.x), s1 = sc * sigmoidf_(v[1] + b4.y), s2 = sc * sigmoidf_(v[2] + b4.z), s3 = sc * sigmoidf_(v[3] + b4.w);
          uint2 o; o.x = pack2(s0, s1); o.y = pack2(s2, s3);
          *(uint2*)(dst + (size_t)m * 2048 + n) = o;
        }
    }
  }
  }
}

DEV void phase_proj0_main(const Params& p, char* smem) {
  const int tid = threadIdx.x, lane = tid & 63, wid = tid >> 6, fr = lane & 15, fq = lane >> 4;
  const int wr = wid >> 2, wc = wid & 3;
  char* ws = p.ws;
  const u16* H0 = (const u16*)(ws + WS_H0);
  const u16* SH = (const u16*)(ws + WS_SH);
  const int xcc0 = xcc_id();
  int nxt;
  f32x4 acc[8][4];
  for (int ls = 0; ls < 8; ++ls) {
  const int xcd = (xcc0 + ls) & 7;
  unsigned* ctr = sched_ctr(p, 4, xcd);
  for (int q = sched_first(ctr, smem); q < 520; q = sched_commit(nxt, smem)) {
    nxt = sched_prefetch(ctr);
    const int mt = q >> 2, nt = 4 * xcd + (q & 3);
    const int part = nt >> 3;
    const int m0 = mt * 256, n0 = nt * 256;
    gemm_main256<1>(acc, H0, 1024, (const u16*)(ws + WS_WT_IN), 1024, 16, m0, n0, p.in[I_AMUIN] + part * 1024, SH, smem);
    u16* dst = (u16*)(ws + (size_t)part * SLOT);
    const int nb = n0 - part * 2048;
#pragma unroll
    for (int i = 0; i < 8; ++i)
#pragma unroll
      for (int j = 0; j < 4; ++j) {
        const int m = m0 + wr * 128 + i * 16 + fr, n = nb + wc * 64 + j * 16 + fq * 4;
        f32x4 v = acc[i][j];
        uint2 o; o.x = pack2(v[0], v[1]); o.y = pack2(v[2], v[3]);
        *(uint2*)(dst + (size_t)m * 2048 + n) = o;
      }
  }
  }
}

DEV void phase_proj0(const Params& p, char* smem) {
  phase_proj0_lora(p, smem);
  phase_proj0_main(p, smem);
}

DEV void phase_scan(const Params& p, char* smem) {
  const int tid = threadIdx.x, lane = tid & 63, wid = tid >> 6;
  u16* Hkk = (u16*)smem;
  u16* Hw = Hkk + 4096;
  u16* Hb = Hw + 4096;
  u16* Hk = Hb + 4096;
  u16* Hwr = Hk + 4096;
  unsigned* Hv2 = (unsigned*)(smem + 40960);
  float* LY = (float*)(smem + 57344);
  float* Lbon = LY + 8192;
  float* Lsc = Lbon + 64;
  char* ws = p.ws;
  const u16* gR = (const u16*)(ws + 0 * SLOT);
  const u16* gK = (const u16*)(ws + 1 * SLOT);
  const u16* gV = (const u16*)(ws + 2 * SLOT);
  const u16* gZ = (const u16*)(ws + 3 * SLOT);
  const u16* gW = (const u16*)(ws + 4 * SLOT);
  const u16* gA = (const u16*)(ws + 5 * SLOT);
  u16* YG = (u16*)(ws + 6 * SLOT);
  const int tt = tid >> 3, c8 = (tid & 7) * 8;
  const int srow = tid >> 3, kc = tid & 7;

  for (int item = blockIdx.x; item < 768; item += gridDim.x) {
    int h, tok0, nsteps; const float* sinit; float* sout;
    if (item < 256) { h = item & 31; tok0 = (item >> 5) * 4096; nsteps = 4096; sinit = nullptr; sout = p.out + OFF_WKV_P + (size_t)item * 4096; }
    else { int it = item - 256; h = it & 31; tok0 = TP + (it >> 5) * 32; nsteps = 32; sinit = p.in[I_SWKV] + (size_t)it * 4096; sout = p.out + OFF_WKV_S + (size_t)it * 4096; }
    const int nch = (nsteps + 63) >> 6;
    const int col0 = h * 64 + c8;
    float ckk[8], cka[8], crk[8], clg[8], clb[8];
    {
      float4 t0, t1;
      t0 = *(const float4*)(p.in[I_AKK] + col0); t1 = *(const float4*)(p.in[I_AKK] + col0 + 4);
      ckk[0] = t0.x; ckk[1] = t0.y; ckk[2] = t0.z; ckk[3] = t0.w; ckk[4] = t1.x; ckk[5] = t1.y; ckk[6] = t1.z; ckk[7] = t1.w;
      t0 = *(const float4*)(p.in[I_AKA] + col0); t1 = *(const float4*)(p.in[I_AKA] + col0 + 4);
      cka[0] = t0.x; cka[1] = t0.y; cka[2] = t0.z; cka[3] = t0.w; cka[4] = t1.x; cka[5] = t1.y; cka[6] = t1.z; cka[7] = t1.w;
      t0 = *(const float4*)(p.in[I_ARK] + col0); t1 = *(const float4*)(p.in[I_ARK] + col0 + 4);
      crk[0] = t0.x; crk[1] = t0.y; crk[2] = t0.z; crk[3] = t0.w; crk[4] = t1.x; crk[5] = t1.y; crk[6] = t1.z; crk[7] = t1.w;
      t0 = *(const float4*)(p.in[I_ALNG] + col0); t1 = *(const float4*)(p.in[I_ALNG] + col0 + 4);
      clg[0] = t0.x; clg[1] = t0.y; clg[2] = t0.z; clg[3] = t0.w; clg[4] = t1.x; clg[5] = t1.y; clg[6] = t1.z; clg[7] = t1.w;
      t0 = *(const float4*)(p.in[I_ALNB] + col0); t1 = *(const float4*)(p.in[I_ALNB] + col0 + 4);
      clb[0] = t0.x; clb[1] = t0.y; clb[2] = t0.z; clb[3] = t0.w; clb[4] = t1.x; clb[5] = t1.y; clb[6] = t1.z; clb[7] = t1.w;
    }
    h2_t sa_, sb_, sc_, sd_;
    if (sinit) {
      float4 a = *(const float4*)(sinit + srow * 64 + kc * 8), b = *(const float4*)(sinit + srow * 64 + kc * 8 + 4);
      sa_ = (h2_t){(_Float16)a.x, (_Float16)a.y}; sb_ = (h2_t){(_Float16)a.z, (_Float16)a.w};
      sc_ = (h2_t){(_Float16)b.x, (_Float16)b.y}; sd_ = (h2_t){(_Float16)b.z, (_Float16)b.w};
    } else {
      sa_ = sb_ = sc_ = sd_ = (h2_t){(_Float16)0.f, (_Float16)0.f};
    }
    uint4 cr, ck, cv, cz, cw, ca;
#define SCAN_LOAD(c)                                                                   \
    {                                                                                  \
      const int tl_ = (c) * 64 + tt;                                                   \
      if (tl_ < nsteps) {                                                              \
        const size_t o_ = (size_t)(tok0 + tl_) * 2048 + col0;                          \
        cr = *(const uint4*)(gR + o_); ck = *(const uint4*)(gK + o_); cv = *(const uint4*)(gV + o_); \
        cz = *(const uint4*)(gZ + o_); cw = *(const uint4*)(gW + o_); ca = *(const uint4*)(gA + o_); \
      } else { cr = ck = cv = cz = cw = ca = make_uint4(0, 0, 0, 0); }                 \
    }
    SCAN_LOAD(0);
    for (int c = 0; c < nch; ++c) {
      uint4 zc = cz;
      {
        float r[8], k[8], v[8], lw[8], a[8];
        unpack8(cr, r); unpack8(ck, k); unpack8(cv, v); unpack8(cw, lw); unpack8(ca, a);
        float kkv[8], kp[8], w[8], bon = 0.f, ss = 0.f, kr = 0.f;
#pragma unroll
        for (int j = 0; j < 8; ++j) {
          kkv[j] = k[j] * ckk[j]; ss += kkv[j] * kkv[j];
          kp[j] = k[j] * (1.f + (a[j] - 1.f) * cka[j]);
          bon += r[j] * kp[j] * crk[j];
          kr += r[j] * kp[j];
          w[j] = __expf(lw[j]);
        }
        ss = red8(ss); bon = red8(bon); kr = red8(kr);
        const float inv = rsqrtf(ss + 1e-12f);
        float bb[8], br = 0.f;
#pragma unroll
        for (int j = 0; j < 8; ++j) { kkv[j] *= inv; bb[j] = kkv[j] * a[j]; br += bb[j] * r[j]; }
        br = red8(br);
        const int ho = tt * 64 + c8;
        *(uint4*)(Hkk + ho) = make_uint4(packh2(kkv[0], kkv[1]), packh2(kkv[2], kkv[3]), packh2(kkv[4], kkv[5]), packh2(kkv[6], kkv[7]));
        *(uint4*)(Hb + ho) = make_uint4(packh2(bb[0], bb[1]), packh2(bb[2], bb[3]), packh2(bb[4], bb[5]), packh2(bb[6], bb[7]));
        *(uint4*)(Hw + ho) = make_uint4(packh2(w[0], w[1]), packh2(w[2], w[3]), packh2(w[4], w[5]), packh2(w[6], w[7]));
        *(uint4*)(Hk + ho) = make_uint4(packh2(kp[0], kp[1]), packh2(kp[2], kp[3]), packh2(kp[4], kp[5]), packh2(kp[6], kp[7]));
        *(uint4*)(Hwr + ho) = make_uint4(packh2(w[0] * r[0], w[1] * r[1]), packh2(w[2] * r[2], w[3] * r[3]), packh2(w[4] * r[4], w[5] * r[5]), packh2(w[6] * r[6], w[7] * r[7]));
        *(uint4*)(Hv2 + ho) = make_uint4(packh2(v[0], v[0]), packh2(v[1], v[1]), packh2(v[2], v[2]), packh2(v[3], v[3]));
        *(uint4*)(Hv2 + ho + 4) = make_uint4(packh2(v[4], v[4]), packh2(v[5], v[5]), packh2(v[6], v[6]), packh2(v[7], v[7]));
        if ((tid & 7) == 0) { Lbon[tt] = bon; *(float2*)(Lsc + tt * 2) = make_float2(br, kr); }
      }
      __syncthreads();
      if (c + 1 < nch) SCAN_LOAD(c + 1);
      {
        const int nT = min(64, nsteps - c * 64);
        const u16* pk = Hkk + kc * 8; const u16* pw = Hw + kc * 8; const u16* pb = Hb + kc * 8;
        const u16* pkp = Hk + kc * 8; const u16* pwr = Hwr + kc * 8; const unsigned* pv = Hv2 + srow;
        float* py = LY + srow * 2;
#define SCAN_LD(S, o)                                                                  \
        S##kk = *(const uint4*)(pk + (o)); S##w = *(const uint4*)(pw + (o)); S##b = *(const uint4*)(pb + (o)); \
        S##k = *(const uint4*)(pkp + (o)); S##wr = *(const uint4*)(pwr + (o)); S##v = pv[(o)];
#define H2(x) (*(const h2_t*)&(x))
#define SCAN_UPD(sreg, S, c)                                                           \
        sreg = __builtin_elementwise_fma(sreg, H2(S##w.c), __builtin_elementwise_fma(-n_, H2(S##b.c), H2(S##v) * H2(S##k.c)));
#define SCAN_STEP(S, o)                                                                \
        {                                                                              \
          float d = __builtin_amdgcn_fdot2(sa_, H2(S##kk.x), 0.f, false);              \
          float e = __builtin_amdgcn_fdot2(sa_, H2(S##wr.x), 0.f, false);              \
          d = __builtin_amdgcn_fdot2(sb_, H2(S##kk.y), d, false); e = __builtin_amdgcn_fdot2(sb_, H2(S##wr.y), e, false); \
          d = __builtin_amdgcn_fdot2(sc_, H2(S##kk.z), d, false); e = __builtin_amdgcn_fdot2(sc_, H2(S##wr.z), e, false); \
          d = __builtin_amdgcn_fdot2(sd_, H2(S##kk.w), d, false); e = __builtin_amdgcn_fdot2(sd_, H2(S##wr.w), e, false); \
          d += dppf<0xB1>(d); e += dppf<0xB1>(e);                                      \
          d += dppf<0x4E>(d); e += dppf<0x4E>(e);                                      \
          d += dppf<0x141>(d); e += dppf<0x141>(e);                                    \
          const unsigned nu_ = packh2(d, d);                                           \
          const h2_t n_ = H2(nu_);                                                     \
          SCAN_UPD(sa_, S, x) SCAN_UPD(sb_, S, y) SCAN_UPD(sc_, S, z) SCAN_UPD(sd_, S, w) \
          if (kc == 0) *(float2*)(py + 2 * (o)) = make_float2(e, d);                   \
        }
        uint4 Akk, Aw, Ab, Ak, Awr, Bkk, Bw, Bb, Bk, Bwr; unsigned Av, Bv;
        SCAN_LD(A, 0);
        for (int t = 0; t < nT; t += 2) {
          SCAN_LD(B, (t + 1) * 64);
          SCAN_STEP(A, t * 64);
          SCAN_LD(A, (t + 2) * 64);
          SCAN_STEP(B, (t + 1) * 64);
        }
#undef SCAN_UPD
#undef H2
#undef SCAN_LD
#undef SCAN_STEP
      }
      __syncthreads();
      {
        const int tl = c * 64 + tt;
        if (tl < nsteps) {
          float y[8], z[8];
          const float2 sc = *(const float2*)(Lsc + tt * 2);
          const uint4 va = *(const uint4*)(Hv2 + tt * 64 + c8), vb = *(const uint4*)(Hv2 + tt * 64 + c8 + 4);
          float vv[8];
          { const unsigned vu[8] = {va.x, va.y, va.z, va.w, vb.x, vb.y, vb.z, vb.w};
#pragma unroll
            for (int j = 0; j < 8; ++j) { h2_t t_ = *(const h2_t*)&vu[j]; vv[j] = (float)t_[0]; } }
#pragma unroll
          for (int q = 0; q < 4; ++q) {
            const float4 ed = *(const float4*)(LY + tt * 128 + (c8 + 2 * q) * 2);
            y[2 * q] = ed.x - ed.y * sc.x + vv[2 * q] * sc.y;
            y[2 * q + 1] = ed.z - ed.w * sc.x + vv[2 * q + 1] * sc.y;
          }
          float sm = y[0] + y[1] + y[2] + y[3] + y[4] + y[5] + y[6] + y[7];
          sm = red8(sm);
          const float mean = sm * (1.f / 64.f);
          float vs = 0.f;
#pragma unroll
          for (int j = 0; j < 8; ++j) { y[j] -= mean; vs += y[j] * y[j]; }
          vs = red8(vs);
          const float rstd = rsqrtf(vs * (1.f / 64.f) + 64e-5f);
          const float bon = Lbon[tt];
          unpack8(zc, z);
          float o[8];
#pragma unroll
          for (int j = 0; j < 8; ++j) {
            float t = y[j] * rstd * clg[j] + clb[j] + bon * vv[j];
            o[j] = t * z[j] * sigmoidf_(z[j]);
          }
          uint4 ov; ov.x = pack2(o[0], o[1]); ov.y = pack2(o[2], o[3]); ov.z = pack2(o[4], o[5]); ov.w = pack2(o[6], o[7]);
          *(uint4*)(YG + (size_t)(tok0 + tl) * 2048 + col0) = ov;
        }
      }
      __syncthreads();
    }
#undef SCAN_LOAD
    *(float4*)(sout + srow * 64 + kc * 8) = make_float4((float)sa_[0], (float)sa_[1], (float)sb_[0], (float)sb_[1]);
    *(float4*)(sout + srow * 64 + kc * 8 + 4) = make_float4((float)sc_[0], (float)sc_[1], (float)sd_[0], (float)sd_[1]);
  }
}

template <int LAYER>
DEV void outproj_store(const Params& p, const float* mod, float* xmid, int m, int n, f32x4 v) {
  const float* gate = mod + (size_t)seq_of(m) * 3072 + 2048;
  float4 g4 = *(const float4*)(gate + n);
  if (LAYER == 0) {
    const float* xr = m < TP ? p.in[I_XP] + (size_t)m * 1024 : p.in[I_XS] + (size_t)(m - TP) * 1024;
    float4 x4 = *(const float4*)(xr + n);
    *(float4*)(xmid + (size_t)m * 1024 + n) = make_float4(x4.x + g4.x * v[0], x4.y + g4.y * v[1], x4.z + g4.z * v[2], x4.w + g4.w * v[3]);
  } else {
    float4 x4 = *(const float4*)(xmid + (size_t)m * 1024 + n);
    float* yo = m < TP ? p.out + OFF_Y_P + (size_t)m * 1024 : p.out + OFF_Y_S + (size_t)(m - TP) * 1024;
    *(float4*)(yo + n) = make_float4(x4.x + g4.x * v[0], x4.y + g4.y * v[1], x4.z + g4.z * v[2], x4.w + g4.w * v[3]);
  }
}

template <int LAYER>
DEV void phase_outproj_main(const Params& p, char* smem) {
  const int tid = threadIdx.x, lane = tid & 63, wid = tid >> 6, wr = wid >> 2, wc = wid & 3, fr = lane & 15, fq = lane >> 4;
  char* ws = p.ws;
  const u16* A = (const u16*)(ws + 6 * SLOT);
  const u16* Bt = (const u16*)(ws + (LAYER == 0 ? WS_WT_OUTA : WS_WT_OUTB));
  const float* mod = (const float*)(ws + WS_MOD) + (size_t)LAYER * 24 * 3072;
  float* xmid = (float*)(ws + 0 * SLOT);
  f32x4 acc[8][4];
  const int xcc0 = xcc_id();
  int nxt;
  for (int ls = 0; ls < 8; ++ls) {
    const int xcd = (xcc0 + ls) & 7;
    unsigned* ctr = sched_ctr(p, LAYER == 0 ? 1 : 3, xcd);
    for (int li = sched_first(ctr, smem); li < 64; li = sched_commit(nxt, smem)) {
      nxt = sched_prefetch(ctr);
      const int item = 64 * xcd + li;
      const int m0 = (item >> 2) * 256, n0 = (item & 3) * 256;
      gemm_main256_dma(acc, A, 2048, Bt, 2048, 32, m0, n0, smem);
#pragma unroll
      for (int i = 0; i < 8; ++i)
#pragma unroll
        for (int j = 0; j < 4; ++j)
          outproj_store<LAYER>(p, mod, xmid, m0 + wr * 128 + i * 16 + fr, n0 + wc * 64 + j * 16 + fq * 4, acc[i][j]);
    }
  }
}

template <int LAYER>
DEV void phase_outproj_tail(const Params& p, char* smem) {
  const int tid = threadIdx.x, lane = tid & 63, wid = tid >> 6, wr = wid >> 1, wc = wid & 1, fr = lane & 15, fq = lane >> 4;
  char* ws = p.ws;
  const u16* A = (const u16*)(ws + 6 * SLOT);
  const u16* Bt = (const u16*)(ws + (LAYER == 0 ? WS_WT_OUTA : WS_WT_OUTB));
  const float* mod = (const float*)(ws + WS_MOD) + (size_t)LAYER * 24 * 3072;
  float* xmid = (float*)(ws + 0 * SLOT);
  f32x4 acc[4][4];
  const int xcc0 = xcc_id();
  int nxt;
  for (int ls = 0; ls < 8; ++ls) {
    const int xcd = (xcc0 + ls) & 7;
    unsigned* ctr = sched_ctr(p, LAYER == 0 ? 5 : 6, xcd);
    for (int li = sched_first(ctr, smem); li < 2; li = sched_commit(nxt, smem)) {
      nxt = sched_prefetch(ctr);
      const int item = 2 * xcd + li;
      const int m0 = (128 + (item >> 3)) * 256, n0 = (item & 7) * 128;
      gemm_main<0>(acc, A, 2048, Bt, 2048, 32, m0, n0, nullptr, nullptr, smem);
#pragma unroll
      for (int i = 0; i < 4; ++i)
#pragma unroll
        for (int j = 0; j < 4; ++j)
          outproj_store<LAYER>(p, mod, xmid, m0 + wr * 64 + i * 16 + fr, n0 + wc * 64 + j * 16 + fq * 4, acc[i][j]);
    }
  }
}

template <int LAYER>
DEV void phase_outproj(const Params& p, char* smem) {
  phase_outproj_tail<LAYER>(p, smem);
  phase_outproj_main<LAYER>(p, smem);
}

DEV void phase_norm1(const Params& p) {
  const int lane = threadIdx.x & 63, wid = threadIdx.x >> 6;
  const float* mod = (const float*)(p.ws + WS_MOD) + (size_t)24 * 3072;
  const float* xmid = (const float*)(p.ws + 0 * SLOT);
  u16* AKV = (u16*)(p.ws + 1 * SLOT);
  u16* AQ = AKV + (size_t)NTOK * 1024;
  const float* gkv = p.in[I_KVNG];
  const float* gb = p.in[I_BNG];
  for (int t = blockIdx.x * 8 + wid; t < NTOK; t += gridDim.x * 8) {
    const float* x = xmid + (size_t)t * 1024;
    const float* md = mod + (size_t)seq_of(t) * 3072;
    float4 v[4];
    float ss = 0.f;
#pragma unroll
    for (int i = 0; i < 4; ++i) {
      v[i] = *(const float4*)(x + lane * 4 + 256 * i);
      ss += v[i].x * v[i].x + v[i].y * v[i].y + v[i].z * v[i].z + v[i].w * v[i].w;
    }
    ss = wave_sum(ss);
    const float rstd = rsqrtf(ss * (1.0f / 1024.0f) + 1e-6f);
#pragma unroll
    for (int i = 0; i < 4; ++i) {
      const int c = lane * 4 + 256 * i;
      float4 g1 = *(const float4*)(gkv + c), g2 = *(const float4*)(gb + c), sh = *(const float4*)(md + c), sc = *(const float4*)(md + 1024 + c);
      float xn0 = v[i].x * rstd, xn1 = v[i].y * rstd, xn2 = v[i].z * rstd, xn3 = v[i].w * rstd;
      uint2 o;
      o.x = pack2(xn0 * g1.x, xn1 * g1.y); o.y = pack2(xn2 * g1.z, xn3 * g1.w);
      *(uint2*)(AKV + (size_t)t * 1024 + c) = o;
      o.x = pack2(xn0 * g2.x * (1.f + sc.x) + sh.x, xn1 * g2.y * (1.f + sc.y) + sh.y);
      o.y = pack2(xn2 * g2.z * (1.f + sc.z) + sh.z, xn3 * g2.w * (1.f + sc.w) + sh.w);
      *(uint2*)(AQ + (size_t)t * 1024 + c) = o;
    }
  }
}

#define QSCALE (0.08838834764831845f * 1.4426950408889634f)
DEV void phase_proj1(const Params& p, char* smem) {
  const int tid = threadIdx.x, lane = tid & 63, wid = tid >> 6, wr = wid >> 2, wc = wid & 3, fr = lane & 15, fq = lane >> 4;
  char* ws = p.ws;
  const u16* AKV = (const u16*)(ws + 1 * SLOT);
  const u16* AQ = AKV + (size_t)NTOK * 1024;
  u16* KB = (u16*)(ws + 2 * SLOT);
  u16* VB = (u16*)(ws + 3 * SLOT);
  u16* QB = (u16*)(ws + 4 * SLOT);
  u16* ZS = (u16*)(ws + 5 * SLOT);
  f32x4 acc[8][4];
  float* red = (float*)smem;
  const int xcc0 = xcc_id();
  int nxt;
  for (int ls = 0; ls < 8; ++ls) {
  const int xcd = (xcc0 + ls) & 7;
  unsigned* ctr = sched_ctr(p, 2, xcd);
  for (int li = sched_first(ctr, smem); li < 520; li = sched_commit(nxt, smem)) {
    nxt = sched_prefetch(ctr);
    const int mt = li >> 2, t = 4 * xcd + (li & 3);
    const int isq = t >> 4, nt = t & 15;
    const int m0 = mt * 256, n0 = nt * 256;
    gemm_main256_dma(acc, isq ? AQ : AKV, 1024, (const u16*)(ws + (isq ? WS_WT_INB : WS_WT_KV)), 1024, 16, m0, n0, smem);
    if (nt < 8) {
#pragma unroll
      for (int i = 0; i < 8; ++i) {
        float ss = 0.f;
#pragma unroll
        for (int j = 0; j < 4; ++j) ss += acc[i][j][0] * acc[i][j][0] + acc[i][j][1] * acc[i][j][1] + acc[i][j][2] * acc[i][j][2] + acc[i][j][3] * acc[i][j][3];
        red[(wr * 128 + i * 16 + fr) * 16 + wc * 4 + fq] = ss;
      }
      __syncthreads();
      const float* gain = isq ? p.in[I_BQG] : p.in[I_KGAIN];
#pragma unroll
      for (int i = 0; i < 8; ++i) {
        const int row = wr * 128 + i * 16 + fr, m = m0 + row;
        float4 ra = *(const float4*)(red + row * 16 + (wc >> 1) * 8), rb = *(const float4*)(red + row * 16 + (wc >> 1) * 8 + 4);
        float tot = ra.x + ra.y + ra.z + ra.w + rb.x + rb.y + rb.z + rb.w;
        float rs = rsqrtf(tot * (1.f / 128.f) + 1e-6f);
        if (isq) rs *= QSCALE;
#pragma unroll
        for (int j = 0; j < 4; ++j) {
          const int d = (wc & 1) * 64 + j * 16 + fq * 4, n = n0 + wc * 64 + j * 16 + fq * 4;
          float4 g4 = *(const float4*)(gain + d);
          f32x4 v = acc[i][j];
          float o0 = v[0] * rs * g4.x, o1 = v[1] * rs * g4.y, o2 = v[2] * rs * g4.z, o3 = v[3] * rs * g4.w;
          uint2 o; o.x = pack2(o0, o1); o.y = pack2(o2, o3);
          if (isq) {
            *(uint2*)(QB + (size_t)m * 2048 + n) = o;
          } else {
            *(uint2*)(KB + (size_t)m * 2048 + n) = o;
            float* ko = m < TP ? p.out + OFF_K_P + (size_t)m * 2048 : p.out + OFF_K_S + (size_t)(m - TP) * 2048;
            *(float4*)(ko + n) = make_float4(o0, o1, o2, o3);
          }
        }
      }
      __syncthreads();
    } else {
#pragma unroll
      for (int i = 0; i < 8; ++i) {
        const int m = m0 + wr * 128 + i * 16 + fr;
#pragma unroll
        for (int j = 0; j < 4; ++j) {
          const int n = n0 - 2048 + wc * 64 + j * 16 + fq * 4;
          f32x4 v = acc[i][j];
          if (isq) {
            float o0 = v[0] * sigmoidf_(v[0]), o1 = v[1] * sigmoidf_(v[1]), o2 = v[2] * sigmoidf_(v[2]), o3 = v[3] * sigmoidf_(v[3]);
            uint2 o; o.x = pack2(o0, o1); o.y = pack2(o2, o3);
            *(uint2*)(ZS + (size_t)m * 2048 + n) = o;
          } else {
            uint2 o; o.x = pack2(v[0], v[1]); o.y = pack2(v[2], v[3]);
            *(uint2*)(VB + (size_t)m * 2048 + n) = o;
            float* vo = m < TP ? p.out + OFF_V_P + (size_t)m * 2048 : p.out + OFF_V_S + (size_t)(m - TP) * 2048;
            *(float4*)(vo + n) = make_float4(v[0], v[1], v[2], v[3]);
          }
        }
      }
    }
  }
}
}

DEV unsigned off_b(unsigned row, unsigned ch) { return 256u * row + 16u * (ch ^ (((row & 3) << 2) | ((row >> 2) & 3))); }

DEV void phase_attn(const Params& p, char* smem) {
  const int tid = threadIdx.x, lane = tid & 63, w = tid >> 6, fr = lane & 15, fq = lane >> 4;
  char* ws = p.ws;
  const u16* KB = (const u16*)(ws + 2 * SLOT);
  const u16* VB = (const u16*)(ws + 3 * SLOT);
  const u16* QB = (const u16*)(ws + 4 * SLOT);
  const u16* ZS = (const u16*)(ws + 5 * SLOT);
  u16* OG = (u16*)(ws + 6 * SLOT);
  const int lrow = tid >> 4, lch = tid & 15;
  const unsigned lw0 = off_b(lrow, lch), lw1 = off_b(lrow + 32, lch);
  const int tq = (lane & 15) >> 2, tp = lane & 3;

  for (int item = blockIdx.x; item < 4096 + 256; item += gridDim.x) {
    int b, h, nq, qpos0, tokq0, ntiles, nkeys, tokk0; bool sample;
    if (item < 4096) {
      const int qblk = 31 - (item >> 7), bh = item & 127;
      b = bh >> 4; h = bh & 15; nq = 128; qpos0 = qblk * 128; tokq0 = b * 4096 + qpos0; ntiles = 2 * qblk + 2; nkeys = qpos0 + 128; tokk0 = b * 4096; sample = false;
    } else {
      const int bh = item - 4096;
      b = bh >> 4; h = bh & 15; nq = 32; qpos0 = 1024; tokq0 = TP + b * 32; ntiles = 17; nkeys = 1056; tokk0 = TP + b * 32 - 1024; sample = true;
    }
    const bool wactive = (w * 16) < nq;
    int* dflag = (int*)(smem + 65536);
    __syncthreads();
    if (lane == 0) dflag[w] = wactive ? 0 : 1;
    bool wdone = !wactive;
    const int qp = qpos0 + w * 16 + fr;
    const int qwmax = qpos0 + w * 16 + 15;
    bf16x8 qf[4];
#pragma unroll
    for (int ks = 0; ks < 4; ++ks) {
      if (wactive) qf[ks] = *(const bf16x8*)(QB + (size_t)(tokq0 + w * 16 + fr) * 2048 + h * 128 + ks * 32 + fq * 8);
      else qf[ks] = (bf16x8){0, 0, 0, 0, 0, 0, 0, 0};
    }
    f32x4 O[8];
#pragma unroll
    for (int dt = 0; dt < 8; ++dt) O[dt] = (f32x4){0, 0, 0, 0};
    float carry = 0.f;

    uint4 lk0, lk1, lv0, lv1;
#define ATT_LOAD(kb)                                                                                  \
    {                                                                                                 \
      const int kx0_ = (kb) * 64 + lrow, kx1_ = kx0_ + 32;                                            \
      if (sample && (kb) < 16) {                                                                      \
        const float* ck_ = p.in[I_CK] + ((size_t)(b * 1024 + kx0_) * 16 + h) * 128 + lch * 8;         \
        const float* cv_ = p.in[I_CV] + ((size_t)(b * 1024 + kx0_) * 16 + h) * 128 + lch * 8;         \
        float4 a_ = *(const float4*)ck_, b_ = *(const float4*)(ck_ + 4);                              \
        float4 c_ = *(const float4*)(ck_ + 32 * 2048), d_ = *(const float4*)(ck_ + 32 * 2048 + 4);    \
        lk0 = make_uint4(pack2(a_.x, a_.y), pack2(a_.z, a_.w), pack2(b_.x, b_.y), pack2(b_.z, b_.w)); \
        lk1 = make_uint4(pack2(c_.x, c_.y), pack2(c_.z, c_.w), pack2(d_.x, d_.y), pack2(d_.z, d_.w)); \
        a_ = *(const float4*)cv_; b_ = *(const float4*)(cv_ + 4);                                     \
        c_ = *(const float4*)(cv_ + 32 * 2048); d_ = *(const float4*)(cv_ + 32 * 2048 + 4);           \
        lv0 = make_uint4(pack2(a_.x, a_.y), pack2(a_.z, a_.w), pack2(b_.x, b_.y), pack2(b_.z, b_.w)); \
        lv1 = make_uint4(pack2(c_.x, c_.y), pack2(c_.z, c_.w), pack2(d_.x, d_.y), pack2(d_.z, d_.w)); \
      } else {                                                                                        \
        const size_t o0_ = (size_t)(tokk0 + kx0_) * 2048 + h * 128 + lch * 8;                         \
        const size_t o1_ = o0_ + (size_t)32 * 2048;                                                   \
        if (kx0_ < nkeys) { lk0 = *(const uint4*)(KB + o0_); lv0 = *(const uint4*)(VB + o0_); }       \
        else { lk0 = make_uint4(0, 0, 0, 0); lv0 = lk0; }                                             \
        if (kx1_ < nkeys) { lk1 = *(const uint4*)(KB + o1_); lv1 = *(const uint4*)(VB + o1_); }       \
        else { lk1 = make_uint4(0, 0, 0, 0); lv1 = lk1; }                                             \
      }                                                                                               \
    }
#define ATT_STORE(st)                                                                                 \
    {                                                                                                 \
      char* sK_ = smem + (st) * 32768; char* sV_ = sK_ + 16384;                                       \
      *(uint4*)(sK_ + lw0) = lk0; *(uint4*)(sK_ + lw1) = lk1;                                         \
      *(uint4*)(sV_ + lw0) = lv0; *(uint4*)(sV_ + lw1) = lv1;                                         \
    }
    ATT_LOAD(ntiles - 1);
    ATT_STORE(0);
    __syncthreads();
    for (int it = 0; it < ntiles; ++it) {
      const int kb = ntiles - 1 - it, st = it & 1;
      if (it + 1 < ntiles) ATT_LOAD(kb - 1);
      if (!wdone && kb * 64 < qwmax) {
        const char* sK = smem + st * 32768;
        const char* sV = sK + 16384;
        f32x4 S[4];
#pragma unroll
        for (int mt = 0; mt < 4; ++mt) S[mt] = (f32x4){0, 0, 0, 0};
#pragma unroll
        for (int ks = 0; ks < 4; ++ks)
#pragma unroll
          for (int mt = 0; mt < 4; ++mt) {
            bf16x8 a = *(const bf16x8*)(sK + off_b(mt * 16 + fr, ks * 4 + fq));
            S[mt] = __builtin_amdgcn_mfma_f32_16x16x32_bf16(a, qf[ks], S[mt], 0, 0, 0);
          }
        bf16x8 wf[2];
        {
          float ee[4][4], tot[4], hi[4];
#pragma unroll
          for (int mt = 0; mt < 4; ++mt) {
            const int kbase = kb * 64 + mt * 16 + fq * 4;
            float ls[4];
#pragma unroll
            for (int jj = 0; jj < 4; ++jj) {
              const float u = S[mt][jj];
              const bool valid = (kbase + jj) < qp;
              const float l = -__builtin_amdgcn_logf(1.0f + __builtin_amdgcn_exp2f(u));
              ls[jj] = valid ? l : 0.f;
              ee[mt][jj] = valid ? (u + l) : -1e30f;
            }
            const float x3 = ls[3], x2 = x3 + ls[2], x1 = x2 + ls[1], seg = x1 + ls[0];
            ee[mt][2] += x3; ee[mt][1] += x2; ee[mt][0] += x1;
            const float t1 = __shfl_xor(seg, 16), t2 = __shfl_xor(seg, 32), t3 = __shfl_xor(t1, 32);
            tot[mt] = seg + t1 + t2 + t3;
            hi[mt] = fq == 0 ? (t1 + t2 + t3) : fq == 1 ? (t2 + t3) : fq == 2 ? t1 : 0.f;
          }
          float run = carry;
          float wv[4][4];
#pragma unroll
          for (int mt = 3; mt >= 0; --mt) {
            const float base = run + hi[mt];
            run += tot[mt];
#pragma unroll
            for (int jj = 0; jj < 4; ++jj) wv[mt][jj] = __builtin_amdgcn_exp2f(ee[mt][jj] + base);
          }
          carry = run;
          if (__all(carry < -150.0f)) { wdone = true; if (lane == 0) dflag[w] = 1; }
#pragma unroll
          for (int p2 = 0; p2 < 2; ++p2) {
            uint4 pk;
            pk.x = pack2(wv[2 * p2][0], wv[2 * p2][1]); pk.y = pack2(wv[2 * p2][2], wv[2 * p2][3]);
            pk.z = pack2(wv[2 * p2 + 1][0], wv[2 * p2 + 1][1]); pk.w = pack2(wv[2 * p2 + 1][2], wv[2 * p2 + 1][3]);
            wf[p2] = *(bf16x8*)&pk;
          }
        }
#pragma unroll
        for (int p2 = 0; p2 < 2; ++p2)
#pragma unroll
          for (int dt = 0; dt < 8; ++dt) {
            const unsigned r0 = 32 * p2 + 4 * fq + tq, r1 = r0 + 16;
            const unsigned ch = 2 * dt + (tp >> 1);
            const char* a0 = sV + off_b(r0, ch) + 8 * (tp & 1);
            const char* a1 = sV + off_b(r1, ch) + 8 * (tp & 1);
            s16x4 lo = __builtin_amdgcn_ds_read_tr16_b64_v4i16((s16x4 __attribute__((address_space(3)))*)(a0));
            s16x4 hi4 = __builtin_amdgcn_ds_read_tr16_b64_v4i16((s16x4 __attribute__((address_space(3)))*)(a1));
            bf16x8 a = {lo[0], lo[1], lo[2], lo[3], hi4[0], hi4[1], hi4[2], hi4[3]};
            O[dt] = __builtin_amdgcn_mfma_f32_16x16x32_bf16(a, wf[p2], O[dt], 0, 0, 0);
          }
      }
      if (it + 1 < ntiles) ATT_STORE(st ^ 1);
      __syncthreads();
      {
        const int4 f0 = *(const int4*)dflag, f1 = *(const int4*)(dflag + 4);
        if (f0.x & f0.y & f0.z & f0.w & f1.x & f1.y & f1.z & f1.w) break;
      }
    }
#undef ATT_LOAD
#undef ATT_STORE
    if (wactive) {
      const size_t rowoff = (size_t)(tokq0 + w * 16 + fr) * 2048 + h * 128;
#pragma unroll
      for (int dt = 0; dt < 8; ++dt) {
        const int d = dt * 16 + fq * 4;
        uint2 z = *(const uint2*)(ZS + rowoff + d);
        f32x4 v = O[dt];
        uint2 o;
        o.x = pack2(v[0] * bflo(z.x), v[1] * bfhi(z.x)); o.y = pack2(v[2] * bflo(z.y), v[3] * bfhi(z.y));
        *(uint2*)(OG + rowoff + d) = o;
      }
    }
  }
}


DEV void grid_barrier(unsigned* bar, unsigned target) {
  __syncthreads();
  if (threadIdx.x == 0) {
    __builtin_amdgcn_fence(__ATOMIC_RELEASE, "agent");
    asm volatile("s_waitcnt vmcnt(0)" ::: "memory");
    __hip_atomic_fetch_add(bar, 1u, __ATOMIC_RELAXED, __HIP_MEMORY_SCOPE_AGENT);
    while (__hip_atomic_load(bar, __ATOMIC_RELAXED, __HIP_MEMORY_SCOPE_AGENT) < target) __builtin_amdgcn_s_sleep(1);
    __builtin_amdgcn_fence(__ATOMIC_ACQUIRE, "agent");
    asm volatile("s_waitcnt vmcnt(0)" ::: "memory");
  }
  __syncthreads();
}

__global__ void __launch_bounds__(NTHREADS) __attribute__((target("no-packed-fp32-ops"))) mega(Params p, int lo, int hi) {
  __shared__ __attribute__((aligned(16))) char smem[147456];
  cg::grid_group grid = cg::this_grid();
#ifndef PROBE_DOUBLE
#define PROBE_DOUBLE -1
#endif
#define RUN_PHASE(k, call) if ((k) >= lo && (k) < hi) { if ((k) > lo) { if ((k) == lo + 1) grid.sync(); else grid_barrier((unsigned*)(p.ws + WS_BAR), (unsigned)((k) - lo - 1) * gridDim.x); } call; }
  RUN_PHASE(0, phase_prep(p, smem))
  RUN_PHASE(1, phase_norm0(p))
  RUN_PHASE(2, phase_proj0(p, smem))
  RUN_PHASE(3, phase_scan(p, smem))
  RUN_PHASE(4, phase_outproj<0>(p, smem))
  RUN_PHASE(5, phase_norm1(p))
  RUN_PHASE(6, phase_proj1(p, smem))
  RUN_PHASE(7, phase_attn(p, smem))
  RUN_PHASE(8, phase_outproj<1>(p, smem))
}

#ifndef N_LAUNCH_MODE
#define N_LAUNCH_MODE 1
#endif

extern "C" void kernel_launch(void* const* d_in, const int* in_sizes, int n_in, void* d_out, int out_size, void* d_ws, size_t ws_size,
                              hipStream_t stream) {
  Params p{};
  for (int i = 0; i < 36; ++i) p.in[i] = (const float*)d_in[i];
  p.out = (float*)d_out;
  p.ws = (char*)d_ws;
  static int grid_blocks = 0;
  if (!grid_blocks) {
    int dev = 0, cus = 0, per_cu = 0;
    hipGetDevice(&dev);
    hipDeviceGetAttribute(&cus, hipDeviceAttributeMultiprocessorCount, dev);
    hipOccupancyMaxActiveBlocksPerMultiprocessor(&per_cu, mega, NTHREADS, 0);
    if (per_cu < 1) per_cu = 1;
    grid_blocks = cus * per_cu;
  }
  if (ws_size < WS_END) { fprintf(stderr, "workspace too small: %zu < %llu\n", ws_size, (unsigned long long)WS_END); return; }
#if N_LAUNCH_MODE == 1
  int lo = 0, hi = 9;
  hipMemsetAsync((char*)d_ws + WS_BAR, 0, 256, stream);
  void* args[] = {&p, &lo, &hi};
  hipError_t e = hipLaunchCooperativeKernel((void*)mega, dim3(grid_blocks), dim3(NTHREADS), args, 0, stream);
  if (e != hipSuccess) fprintf(stderr, "cooperative launch failed: %s (grid %d)\n", hipGetErrorString(e), grid_blocks);
#else
  for (int ph = 0; ph < 9; ++ph) hipLaunchKernelGGL(mega, dim3(grid_blocks), dim3(NTHREADS), 0, stream, p, ph, ph + 1);
#endif
}
```

```cpp
#include <hip/hip_runtime.h>
#include <hip/hip_cooperative_groups.h>
#include <cstdio>
namespace cg = cooperative_groups;

typedef unsigned short u16;
typedef short bf16x8 __attribute__((ext_vector_type(8)));
typedef short s16x4 __attribute__((ext_vector_type(4)));
typedef float f32x4 __attribute__((ext_vector_type(4)));
typedef float f32x2 __attribute__((ext_vector_type(2)));
typedef __bf16 bf16x2_t __attribute__((ext_vector_type(2)));
typedef _Float16 h2_t __attribute__((ext_vector_type(2)));

#define DEV __device__ __forceinline__

#define NTOK 33280
#define TP 32768
#define NTHREADS 512

#define OFF_Y_P 0
#define OFF_Y_S 33554432
#define OFF_K_P 34078720
#define OFF_V_P 101187584
#define OFF_WKV_P 168296448
#define OFF_SH_P 169345024
#define OFF_K_S 169353216
#define OFF_V_S 170401792
#define OFF_WKV_S 171450368
#define OFF_SH_S 173547520

#define SLOT 136314880ull
#define WS_W (7ull * SLOT)
#define WS_WT_IN (WS_W)
#define WS_WT_OUTA (WS_WT_IN + 16777216ull)
#define WS_WT_KV (WS_WT_OUTA + 4194304ull)
#define WS_WT_INB (WS_WT_KV + 8388608ull)
#define WS_WT_OUTB (WS_WT_INB + 8388608ull)
#define WS_W2T (WS_WT_OUTB + 4194304ull)
#define WS_A2T (WS_W2T + 262144ull)
#define WS_L1T (WS_A2T + 262144ull)
#define WS_MOD (WS_L1T + 524288ull)
#define WS_SH (WS_MOD + 589824ull)
#define WS_CTR (WS_SH + 49152ull)
#define WS_BAR (WS_CTR + 4096ull)
#define WS_END (WS_BAR + 256ull)
#define WS_H0 (6ull * SLOT)
#define WS_T (4ull * SLOT)

struct Params {
  const float* in[36];
  float* out;
  char* ws;
};

enum { I_XP = 0, I_XS, I_CK, I_CV, I_SWKV, I_SSH, I_CP, I_CS, I_ANG, I_AADAW, I_AADAB, I_AWIN, I_AMUIN, I_AMUW, I_AMUA,
       I_AW0, I_AW1, I_AW2, I_AA0, I_AA1, I_AA2, I_AKK, I_AKA, I_ARK, I_ALNG, I_ALNB, I_AWOUT, I_KVNG, I_KVW, I_KGAIN,
       I_BNG, I_BADAW, I_BADAB, I_BWIN, I_BQG, I_BWOUT };

DEV int seq_of(int t) { return t < TP ? (t >> 12) : 8 + ((t - TP) >> 5); }
DEV bool seq_start(int t) { return t < TP ? ((t & 4095) == 0) : (((t - TP) & 31) == 0); }

DEV unsigned pack2(float a, float b) {
  f32x2 v = {a, b};
  bf16x2_t r = __builtin_convertvector(v, bf16x2_t);
  return *(unsigned*)&r;
}
DEV unsigned packh2(float a, float b) {
  f32x2 v = {a, b};
  h2_t r = __builtin_convertvector(v, h2_t);
  return *(unsigned*)&r;
}
DEV float bflo(unsigned w) { return __uint_as_float(w << 16); }
DEV float bfhi(unsigned w) { return __uint_as_float(w & 0xffff0000u); }
DEV void unpack8(const uint4& x, float* f) {
  f[0] = bflo(x.x); f[1] = bfhi(x.x); f[2] = bflo(x.y); f[3] = bfhi(x.y);
  f[4] = bflo(x.z); f[5] = bfhi(x.z); f[6] = bflo(x.w); f[7] = bfhi(x.w);
}
DEV float sigmoidf_(float x) { return 1.0f / (1.0f + __expf(-x)); }

template <int CTRL>
DEV float dppf(float x) {
  return __int_as_float(__builtin_amdgcn_update_dpp(0, __float_as_int(x), CTRL, 0xf, 0xf, true));
}
DEV float red4(float x) { x += dppf<0xB1>(x); x += dppf<0x4E>(x); return x; }
DEV float red8(float x) { x = red4(x); x += dppf<0x141>(x); return x; }
DEV float red16(float x) { x = red8(x); x += dppf<0x140>(x); return x; }
DEV float wave_sum(float x) {
#pragma unroll
  for (int o = 32; o >= 1; o >>= 1) x += __shfl_xor(x, o);
  return x;
}


#define SCHED_SLOT_OFF 147440
DEV int xcc_id() { return (int)(__builtin_amdgcn_s_getreg((3 << 11) | 20) & 0x7u); }
DEV unsigned* sched_ctr(const Params& p, int phase_slot, int list) { return (unsigned*)(p.ws + WS_CTR) + (phase_slot * 8 + list) * 16; }
DEV int sched_first(unsigned* ctr, char* smem) {
  int* slot = (int*)(smem + SCHED_SLOT_OFF);
  __syncthreads();
  if (threadIdx.x == 0) *slot = (int)atomicAdd(ctr, 1u);
  __syncthreads();
  return *slot;
}

DEV void group_sync(unsigned* bar, unsigned target) {
  __syncthreads();
  if (threadIdx.x == 0) {
    __hip_atomic_fetch_add(bar, 1u, __ATOMIC_RELAXED, __HIP_MEMORY_SCOPE_AGENT);
    while (__hip_atomic_load(bar, __ATOMIC_RELAXED, __HIP_MEMORY_SCOPE_AGENT) < target) __builtin_amdgcn_s_sleep(2);
  }
  __syncthreads();
}
DEV int sched_prefetch(unsigned* ctr) { return threadIdx.x == 0 ? (int)atomicAdd(ctr, 1u) : 0; }
DEV int sched_commit(int nxt, char* smem) {
  int* slot = (int*)(smem + SCHED_SLOT_OFF);
  __syncthreads();
  if (threadIdx.x == 0) *slot = nxt;
  __syncthreads();
  return *slot;
}

#define GEMM_STAGE_BYTES 49152

template <int AMODE>
DEV void gemm_main(f32x4 (&acc)[4][4], const u16* __restrict__ A, int lda, const u16* __restrict__ Bt, int ldb, int nk,
                   int m0, int n0, const float* __restrict__ mu, const u16* __restrict__ SH, char* smem) {
  const int tid = threadIdx.x, lane = tid & 63, wid = tid >> 6, wr = wid >> 1, wc = wid & 1, fr = lane & 15, fq = lane >> 4;
  const int lrow = tid >> 3, lch = tid & 7;
#pragma unroll
  for (int i = 0; i < 4; ++i)
#pragma unroll
    for (int j = 0; j < 4; ++j) acc[i][j] = (f32x4){0.f, 0.f, 0.f, 0.f};

  const u16* pa0; const u16* pa1; const u16* pa2; const u16* pa3;
  const u16* pp0 = nullptr;
  const int arow = 4 * lrow;
  {
    int m = m0 + arow;
    pa0 = A + (size_t)m * lda + lch * 8;
    pa1 = pa0 + lda; pa2 = pa1 + lda; pa3 = pa2 + lda;
    if (AMODE != 0) pp0 = seq_start(m) ? SH + seq_of(m) * 1024 + lch * 8 : pa0 - lda;
  }
  const u16* pb0 = Bt + (size_t)(n0 + lrow) * ldb + lch * 8;
  const u16* pb1 = pb0 + (size_t)64 * ldb;
  const int woffB = lrow * 128 + ((lch ^ ((lrow >> 1) & 7)) << 4);
  const int woffA0 = (arow + 0) * 128 + ((lch ^ (((arow + 0) >> 1) & 7)) << 4);
  const int woffA1 = (arow + 1) * 128 + ((lch ^ (((arow + 1) >> 1) & 7)) << 4);
  const int woffA2 = (arow + 2) * 128 + ((lch ^ (((arow + 2) >> 1) & 7)) << 4);
  const int woffA3 = (arow + 3) * 128 + ((lch ^ (((arow + 3) >> 1) & 7)) << 4);

  uint4 ra0, ra1, ra2, ra3, rp0, rb0, rb1;
  float4 mu0, mu1;
  rp0 = make_uint4(0, 0, 0, 0);
  mu0 = mu1 = make_float4(0, 0, 0, 0);

#define G_LOAD(kt)                                                                     \
  {                                                                                    \
    const int k0_ = (kt) * 64;                                                         \
    if (AMODE == 0) {                                                                  \
      ra0 = *(const uint4*)(pa0 + k0_); ra1 = *(const uint4*)(pa1 + k0_);              \
      ra2 = *(const uint4*)(pa2 + k0_); ra3 = *(const uint4*)(pa3 + k0_);              \
    } else if (AMODE == 1) {                                                           \
      ra0 = *(const uint4*)(pa0 + k0_); ra1 = *(const uint4*)(pa1 + k0_);              \
      ra2 = *(const uint4*)(pa2 + k0_); ra3 = *(const uint4*)(pa3 + k0_);              \
      rp0 = *(const uint4*)(pp0 + k0_);                                                \
      mu0 = *(const float4*)(mu + k0_ + lch * 8); mu1 = *(const float4*)(mu + k0_ + lch * 8 + 4); \
    } else {                                                                           \
      const int kk_ = k0_ & 1023;                                                      \
      ra0 = *(const uint4*)(pa0 + kk_); ra1 = *(const uint4*)(pa1 + kk_);              \
      ra2 = *(const uint4*)(pa2 + kk_); ra3 = *(const uint4*)(pa3 + kk_);              \
      if (k0_ >= 1024) rp0 = *(const uint4*)(pp0 + kk_);                               \
    }                                                                                  \
    rb0 = *(const uint4*)(pb0 + k0_); rb1 = *(const uint4*)(pb1 + k0_);                \
  }

#define G_XFORM(dst, a_, p_, kt)                                                       \
  {                                                                                    \
    if (AMODE == 0) dst = a_;                                                          \
    else if (AMODE == 1) {                                                             \
      float h_[8], q_[8]; unpack8(a_, h_); unpack8(p_, q_);                            \
      dst.x = pack2(h_[0] + mu0.x * (q_[0] - h_[0]), h_[1] + mu0.y * (q_[1] - h_[1])); \
      dst.y = pack2(h_[2] + mu0.z * (q_[2] - h_[2]), h_[3] + mu0.w * (q_[3] - h_[3])); \
      dst.z = pack2(h_[4] + mu1.x * (q_[4] - h_[4]), h_[5] + mu1.y * (q_[5] - h_[5])); \
      dst.w = pack2(h_[6] + mu1.z * (q_[6] - h_[6]), h_[7] + mu1.w * (q_[7] - h_[7])); \
    } else {                                                                           \
      if ((kt) * 64 >= 1024) {                                                         \
        float h_[8], q_[8]; unpack8(a_, h_); unpack8(p_, q_);                          \
        dst.x = pack2(q_[0] - h_[0], q_[1] - h_[1]); dst.y = pack2(q_[2] - h_[2], q_[3] - h_[3]); \
        dst.z = pack2(q_[4] - h_[4], q_[5] - h_[5]); dst.w = pack2(q_[6] - h_[6], q_[7] - h_[7]); \
      } else dst = a_;                                                                 \
    }                                                                                  \
  }

#define G_STORE(stage, kt)                                                             \
  {                                                                                    \
    char* sA_ = smem + (stage) * GEMM_STAGE_BYTES; char* sB_ = sA_ + 32768;            \
    uint4 v_;                                                                          \
    G_XFORM(v_, ra0, rp0, kt); *(uint4*)(sA_ + woffA0) = v_;                           \
    G_XFORM(v_, ra1, ra0, kt); *(uint4*)(sA_ + woffA1) = v_;                           \
    G_XFORM(v_, ra2, ra1, kt); *(uint4*)(sA_ + woffA2) = v_;                           \
    G_XFORM(v_, ra3, ra2, kt); *(uint4*)(sA_ + woffA3) = v_;                           \
    *(uint4*)(sB_ + woffB) = rb0; *(uint4*)(sB_ + woffB + 64 * 128) = rb1;             \
  }

  G_LOAD(0);
  G_STORE(0, 0);
  __syncthreads();
  const int rsw = (fr >> 1) & 7;
  for (int kt = 0; kt < nk; ++kt) {
    const int st = kt & 1;
    if (kt + 1 < nk) G_LOAD(kt + 1);
    __builtin_amdgcn_sched_barrier(0);
    {
      const char* sA = smem + st * GEMM_STAGE_BYTES;
      const char* sB = sA + 32768;
#pragma unroll
      for (int kk = 0; kk < 2; ++kk) {
        bf16x8 af[4], bfr[4];
        const int cho = ((kk * 4 + fq) ^ rsw) << 4;
#pragma unroll
        for (int i = 0; i < 4; ++i) af[i] = *(const bf16x8*)(sA + (wr * 64 + i * 16 + fr) * 128 + cho);
#pragma unroll
        for (int j = 0; j < 4; ++j) bfr[j] = *(const bf16x8*)(sB + (wc * 64 + j * 16 + fr) * 128 + cho);
#pragma unroll
        for (int i = 0; i < 4; ++i)
#pragma unroll
          for (int j = 0; j < 4; ++j) acc[i][j] = __builtin_amdgcn_mfma_f32_16x16x32_bf16(bfr[j], af[i], acc[i][j], 0, 0, 0);
      }
    }
    if (kt + 1 < nk) G_STORE(st ^ 1, kt + 1);
    __syncthreads();
  }
#undef G_LOAD
#undef G_XFORM
#undef G_STORE
}


#define G2_STAGE_BYTES 32768
#define G2_MU_OFF (3 * G2_STAGE_BYTES)
DEV int g2_swz(int row) { return (0x78 >> (2 * ((row >> 2) & 3))) & 3; }
template <int AMODE>
DEV void gemm_main256(f32x4 (&acc)[8][4], const u16* __restrict__ A, int lda, const u16* __restrict__ Bt, int ldb, int nk64,
                      int m0, int n0, const float* __restrict__ mu, const u16* __restrict__ SH, char* smem) {
  const int tid = threadIdx.x, lane = tid & 63, wid = tid >> 6, wr = wid >> 2, wc = wid & 3, fr = lane & 15, fq = lane >> 4;
  const int nk = nk64 * 2;
  const int lrow2 = 2 * (tid >> 2), lch = tid & 3;
#pragma unroll
  for (int i = 0; i < 8; ++i)
#pragma unroll
    for (int j = 0; j < 4; ++j) acc[i][j] = (f32x4){0.f, 0.f, 0.f, 0.f};
  const u16* pa0 = A + (size_t)(m0 + lrow2) * lda + lch * 8;
  const u16* pp0 = nullptr;
  if (AMODE != 0) pp0 = seq_start(m0 + lrow2) ? SH + seq_of(m0 + lrow2) * 1024 + lch * 8 : pa0 - lda;
  const u16* pb0 = Bt + (size_t)(n0 + lrow2) * ldb + lch * 8;
  const int woff0 = (lrow2 + 0) * 64 + ((lch ^ g2_swz(lrow2 + 0)) << 4);
  const int woff1 = (lrow2 + 1) * 64 + ((lch ^ g2_swz(lrow2 + 1)) << 4);
  const float* muL = (const float*)(smem + G2_MU_OFF);
  if (AMODE == 1) {
    if (tid < 256) *(float4*)(smem + G2_MU_OFF + tid * 16) = *(const float4*)(mu + tid * 4);
  }
  uint4 xa0, xa1, xp, xb0, xb1;
  uint4 ya0, ya1, yp, yb0, yb1;
  xp = yp = make_uint4(0, 0, 0, 0);

#define K_LOAD(S, kt)                                                                  \
  {                                                                                    \
    const int k0_ = (kt) * 32;                                                         \
    S##a0 = *(const uint4*)(pa0 + k0_); S##a1 = *(const uint4*)(pa0 + lda + k0_);      \
    if (AMODE == 1) S##p = *(const uint4*)(pp0 + k0_);                                 \
    S##b0 = *(const uint4*)(pb0 + k0_); S##b1 = *(const uint4*)(pb0 + ldb + k0_);      \
  }
#define K_XFORM(dst, a_, p_)                                                           \
  {                                                                                    \
    if (AMODE == 0) dst = a_;                                                          \
    else {                                                                             \
      float h_[8], q_[8]; unpack8(a_, h_); unpack8(p_, q_);                            \
      dst.x = pack2(h_[0] + mu0.x * (q_[0] - h_[0]), h_[1] + mu0.y * (q_[1] - h_[1])); \
      dst.y = pack2(h_[2] + mu0.z * (q_[2] - h_[2]), h_[3] + mu0.w * (q_[3] - h_[3])); \
      dst.z = pack2(h_[4] + mu1.x * (q_[4] - h_[4]), h_[5] + mu1.y * (q_[5] - h_[5])); \
      dst.w = pack2(h_[6] + mu1.z * (q_[6] - h_[6]), h_[7] + mu1.w * (q_[7] - h_[7])); \
    }                                                                                  \
  }
#define K_STORE(S, stage, kt)                                                          \
  {                                                                                    \
    char* sA_ = smem + (stage) * G2_STAGE_BYTES; char* sB_ = sA_ + 16384;              \
    uint4 v_; float4 mu0, mu1;                                                         \
    if (AMODE == 1) { mu0 = *(const float4*)(muL + (kt) * 32 + lch * 8); mu1 = *(const float4*)(muL + (kt) * 32 + lch * 8 + 4); } \
    K_XFORM(v_, S##a0, S##p); *(uint4*)(sA_ + woff0) = v_;                             \
    K_XFORM(v_, S##a1, S##a0); *(uint4*)(sA_ + woff1) = v_;                            \
    *(uint4*)(sB_ + woff0) = S##b0; *(uint4*)(sB_ + woff1) = S##b1;                    \
  }
#define K_COMPUTE_HALF(stage, i0)                                                      \
  {                                                                                    \
    const char* sA_ = smem + (stage) * G2_STAGE_BYTES;                                 \
    _Pragma("unroll") for (int i = (i0); i < (i0) + 4; ++i) {                          \
      const bf16x8 af = *(const bf16x8*)(sA_ + (wr * 128 + i * 16 + fr) * 64 + cho);   \
      _Pragma("unroll") for (int j = 0; j < 4; ++j) acc[i][j] = __builtin_amdgcn_mfma_f32_16x16x32_bf16(bfr[j], af, acc[i][j], 0, 0, 0); \
    }                                                                                  \
  }
#define K_LOAD_B(stage)                                                                \
  {                                                                                    \
    const char* sB_ = smem + (stage) * G2_STAGE_BYTES + 16384;                         \
    _Pragma("unroll") for (int j = 0; j < 4; ++j) bfr[j] = *(const bf16x8*)(sB_ + (wc * 64 + j * 16 + fr) * 64 + cho); \
  }
#define K_ITER(kt, L, S)                                                               \
  {                                                                                    \
    K_LOAD(L, min((kt) + 2, nk - 1));                                                  \
    __builtin_amdgcn_sched_barrier(0);                                                 \
    bf16x8 bfr[4];                                                                     \
    K_LOAD_B(cu);                                                                      \
    K_COMPUTE_HALF(cu, 0);                                                             \
    __builtin_amdgcn_sched_barrier(0);                                                 \
    K_STORE(S, nx, min((kt) + 1, nk - 1));                                             \
    __builtin_amdgcn_sched_barrier(0);                                                 \
    if (AMODE == 1) K_LOAD_B(cu);                                                      \
    K_COMPUTE_HALF(cu, 4);                                                             \
    __syncthreads();                                                                   \
    cu = nx; nx = (nx == 2) ? 0 : nx + 1;                                              \
  }
  const int cho = (fq ^ g2_swz(fr)) << 4;
  if (AMODE == 1) __syncthreads();
  K_LOAD(x, 0);
  K_LOAD(y, 1);
  K_STORE(x, 0, 0);
  __syncthreads();
  int cu = 0, nx = 1;
  for (int kt = 0; kt < nk; kt += 2) {
    K_ITER(kt, x, y);
    K_ITER(kt + 1, y, x);
  }
#undef K_LOAD
#undef K_XFORM
#undef K_STORE
#undef K_COMPUTE_HALF
#undef K_LOAD_B
#undef K_ITER
}


#define GD_NST 4
DEV void gemm_main256_dma(f32x4 (&acc)[8][4], const u16* __restrict__ A, int lda, const u16* __restrict__ Bt, int ldb, int nk64,
                          int m0, int n0, char* smem) {
  const int tid = threadIdx.x, lane = tid & 63, wid = tid >> 6, wr = wid >> 2, wc = wid & 3, fr = lane & 15, fq = lane >> 4;
  const int nk = nk64 * 2;
#pragma unroll
  for (int i = 0; i < 8; ++i)
#pragma unroll
    for (int j = 0; j < 4; ++j) acc[i][j] = (f32x4){0.f, 0.f, 0.f, 0.f};
  const int prow = 16 * wid + (lane >> 2);
  const int pch = (lane & 3) ^ g2_swz(prow);
  const u16* srcA = A + (size_t)(m0 + prow) * lda + pch * 8;
  const u16* srcB = Bt + (size_t)(n0 + prow) * ldb + pch * 8;
  const size_t a128 = (size_t)128 * lda, b128 = (size_t)128 * ldb;
  char* ldsw = smem + (16 * wid) * 64;
#define D_FILL(kt, stage)                                                              \
  {                                                                                    \
    const int k0_ = (kt) * 32;                                                         \
    char* d_ = ldsw + (stage) * G2_STAGE_BYTES;                                        \
    __builtin_amdgcn_global_load_lds((const unsigned*)(srcA + k0_), (unsigned*)(d_), 16, 0, 0);               \
    __builtin_amdgcn_global_load_lds((const unsigned*)(srcA + a128 + k0_), (unsigned*)(d_ + 8192), 16, 0, 0); \
    __builtin_amdgcn_global_load_lds((const unsigned*)(srcB + k0_), (unsigned*)(d_ + 16384), 16, 0, 0);       \
    __builtin_amdgcn_global_load_lds((const unsigned*)(srcB + b128 + k0_), (unsigned*)(d_ + 16384 + 8192), 16, 0, 0); \
  }
  const int cho = (fq ^ g2_swz(fr)) << 4;
  __syncthreads();
  D_FILL(0, 0);
  D_FILL(min(1, nk - 1), 1);
  D_FILL(min(2, nk - 1), 2);
  int cu = 0, fill = 3;
  for (int kt = 0; kt < nk; ++kt) {
    asm volatile("s_waitcnt vmcnt(8)" ::: "memory");
    asm volatile("s_waitcnt lgkmcnt(0)" ::: "memory");
    __builtin_amdgcn_s_barrier();
    D_FILL(min(kt + 3, nk - 1), fill);
    {
      const char* sA_ = smem + cu * G2_STAGE_BYTES;
      const char* sB_ = sA_ + 16384;
      bf16x8 bfr[4];
#pragma unroll
      for (int j = 0; j < 4; ++j) bfr[j] = *(const bf16x8*)(sB_ + (wc * 64 + j * 16 + fr) * 64 + cho);
#pragma unroll
      for (int i = 0; i < 8; ++i) {
        const bf16x8 af = *(const bf16x8*)(sA_ + (wr * 128 + i * 16 + fr) * 64 + cho);
#pragma unroll
        for (int j = 0; j < 4; ++j) acc[i][j] = __builtin_amdgcn_mfma_f32_16x16x32_bf16(bfr[j], af, acc[i][j], 0, 0, 0);
      }
    }
    cu = (cu == GD_NST - 1) ? 0 : cu + 1;
    fill = (fill == GD_NST - 1) ? 0 : fill + 1;
  }
  asm volatile("s_waitcnt vmcnt(0)" ::: "memory");
  asm volatile("s_waitcnt lgkmcnt(0)" ::: "memory");
  __builtin_amdgcn_s_barrier();
#undef D_FILL
}

DEV void transpose_tile(const float* __restrict__ src, int N, int k0, int n0, const float* __restrict__ scale, u16* __restrict__ dst,
                        int dstride, int drow0, int dcol0, char* smem) {
  float* tile = (float*)smem;
  const int tid = threadIdx.x;
#pragma unroll
  for (int i = 0; i < 2; ++i) {
    int kl = (tid >> 4) + 32 * i, n4 = (tid & 15) * 4;
    float4 v = *(const float4*)(src + (size_t)(k0 + kl) * N + n0 + n4);
    float s = scale ? scale[k0 + kl] : 1.0f;
    tile[kl * 65 + n4 + 0] = v.x * s; tile[kl * 65 + n4 + 1] = v.y * s;
    tile[kl * 65 + n4 + 2] = v.z * s; tile[kl * 65 + n4 + 3] = v.w * s;
  }
  __syncthreads();
  {
    int nl = tid >> 3, k8 = (tid & 7) * 8;
    uint4 o;
    o.x = pack2(tile[(k8 + 0) * 65 + nl], tile[(k8 + 1) * 65 + nl]);
    o.y = pack2(tile[(k8 + 2) * 65 + nl], tile[(k8 + 3) * 65 + nl]);
    o.z = pack2(tile[(k8 + 4) * 65 + nl], tile[(k8 + 5) * 65 + nl]);
    o.w = pack2(tile[(k8 + 6) * 65 + nl], tile[(k8 + 7) * 65 + nl]);
    *(uint4*)(dst + (size_t)(drow0 + n0 + nl) * dstride + dcol0 + k0 + k8) = o;
  }
  __syncthreads();
}

DEV void phase_prep(const Params& p, char* smem) {
  const int tid = threadIdx.x;
  char* ws = p.ws;
  if (blockIdx.x < 96) {
    float* cL = (float*)smem;
    float* red = (float*)(smem + 98304);
    for (int e = tid; e < 24 * 256; e += NTHREADS) {
      int s = e >> 8, k4 = (e & 255) * 4;
      float4 v = s < 8 ? *(const float4*)(p.in[I_CP] + s * 1024 + k4) : *(const float4*)(p.in[I_CS] + (s - 8) * 1024 + k4);
      *(float4*)(cL + s * 1024 + k4) = v;
    }
    __syncthreads();
    for (int item = blockIdx.x; item < 96; item += gridDim.x) {
      const int l = item / 48, j0 = (item % 48) * 64;
      const float* W = (l == 0 ? p.in[I_AADAW] : p.in[I_BADAW]);
      const float* bias = (l == 0 ? p.in[I_AADAB] : p.in[I_BADAB]);
      const int col = tid & 63, kg = tid >> 6;
      float acc[24];
#pragma unroll
      for (int s = 0; s < 24; ++s) acc[s] = 0.f;
      for (int k = kg * 128; k < kg * 128 + 128; ++k) {
        float w = W[(size_t)k * 3072 + j0 + col];
#pragma unroll
        for (int s = 0; s < 24; ++s) acc[s] += cL[s * 1024 + k] * w;
      }
#pragma unroll
      for (int s = 0; s < 24; ++s) red[(kg * 24 + s) * 64 + col] = acc[s];
      __syncthreads();
      float* mod = (float*)(ws + WS_MOD);
      for (int e = tid; e < 24 * 64; e += NTHREADS) {
        int s = e >> 6, c = e & 63;
        float t = bias[j0 + c];
#pragma unroll
        for (int g = 0; g < 8; ++g) t += red[(g * 24 + s) * 64 + c];
        mod[(size_t)(l * 24 + s) * 3072 + j0 + c] = t;
      }
      __syncthreads();
    }
  }
  if (blockIdx.x == 0) for (int e = tid; e < 1024; e += NTHREADS) ((unsigned*)(ws + WS_CTR))[e] = 0u;
  if (blockIdx.x == gridDim.x - 1) {
    u16* SH = (u16*)(ws + WS_SH);
    for (int e = tid; e < 24 * 1024; e += NTHREADS) {
      int s = e >> 10, k = e & 1023;
      float v = s < 8 ? 0.f : p.in[I_SSH][(s - 8) * 1024 + k];
      SH[e] = (u16)(pack2(v, 0.f) & 0xffff);
    }
  }
  const int NT_TOTAL = 2048 + 512 + 1024 + 1024 + 512 + 32 + 32 + 64;
  for (int t = blockIdx.x; t < NT_TOTAL; t += gridDim.x) {
    const float* src; int K, N; u16* dst; int dstride, drow0 = 0, dcol0 = 0; const float* scale = nullptr; int tt = t;
    if (tt < 2048) { src = p.in[I_AWIN]; K = 1024; N = 8192; dst = (u16*)(ws + WS_WT_IN); dstride = 1024; }
    else if ((tt -= 2048) < 512) { src = p.in[I_AWOUT]; K = 2048; N = 1024; dst = (u16*)(ws + WS_WT_OUTA); dstride = 2048; }
    else if ((tt -= 512) < 1024) { src = p.in[I_KVW]; K = 1024; N = 4096; dst = (u16*)(ws + WS_WT_KV); dstride = 1024; }
    else if ((tt -= 1024) < 1024) { src = p.in[I_BWIN]; K = 1024; N = 4096; dst = (u16*)(ws + WS_WT_INB); dstride = 1024; }
    else if ((tt -= 1024) < 512) { src = p.in[I_BWOUT]; K = 2048; N = 1024; dst = (u16*)(ws + WS_WT_OUTB); dstride = 2048; }
    else if ((tt -= 512) < 32) { src = p.in[I_AW2]; K = 64; N = 2048; dst = (u16*)(ws + WS_W2T); dstride = 64; }
    else if ((tt -= 32) < 32) { src = p.in[I_AA2]; K = 64; N = 2048; dst = (u16*)(ws + WS_A2T); dstride = 64; }
    else {
      tt -= 32;
      int job = tt >> 4; tt &= 15;
      K = 1024; N = 64; dst = (u16*)(ws + WS_L1T); dstride = 2048;
      src = (job < 2) ? p.in[I_AW1] : p.in[I_AA1];
      drow0 = (job < 2) ? 0 : 64;
      if (job & 1) { dcol0 = 1024; scale = (job < 2) ? p.in[I_AMUW] : p.in[I_AMUA]; }
    }
    const int ntn = N / 64;
    const int kt = tt / ntn, nt = tt % ntn;
    transpose_tile(src, N, kt * 64, nt * 64, scale, dst, dstride, drow0, dcol0, smem);
  }
}

DEV void phase_norm0(const Params& p) {
  const int lane = threadIdx.x & 63, wid = threadIdx.x >> 6;
  const float* mod = (const float*)(p.ws + WS_MOD);
  u16* H0 = (u16*)(p.ws + WS_H0);
  const float* g = p.in[I_ANG];
  for (int t = blockIdx.x * 8 + wid; t < NTOK; t += gridDim.x * 8) {
    const float* x = t < TP ? p.in[I_XP] + (size_t)t * 1024 : p.in[I_XS] + (size_t)(t - TP) * 1024;
    const int s = seq_of(t);
    const float* md = mod + (size_t)s * 3072;
    float4 v[4];
    float ss = 0.f;
#pragma unroll
    for (int i = 0; i < 4; ++i) {
      v[i] = *(const float4*)(x + lane * 4 + 256 * i);
      ss += v[i].x * v[i].x + v[i].y * v[i].y + v[i].z * v[i].z + v[i].w * v[i].w;
    }
    ss = wave_sum(ss);
    const float rstd = rsqrtf(ss * (1.0f / 1024.0f) + 1e-6f);
    bool last = t < TP ? ((t & 4095) == 4095) : (((t - TP) & 31) == 31);
    float* so = t < TP ? p.out + OFF_SH_P + (t >> 12) * 1024 : p.out + OFF_SH_S + ((t - TP) >> 5) * 1024;
#pragma unroll
    for (int i = 0; i < 4; ++i) {
      const int c = lane * 4 + 256 * i;
      float4 gg = *(const float4*)(g + c), sh = *(const float4*)(md + c), sc = *(const float4*)(md + 1024 + c);
      float4 h;
      h.x = v[i].x * rstd * gg.x * (1.f + sc.x) + sh.x;
      h.y = v[i].y * rstd * gg.y * (1.f + sc.y) + sh.y;
      h.z = v[i].z * rstd * gg.z * (1.f + sc.z) + sh.z;
      h.w = v[i].w * rstd * gg.w * (1.f + sc.w) + sh.w;
      uint2 o; o.x = pack2(h.x, h.y); o.y = pack2(h.z, h.w);
      *(uint2*)(H0 + (size_t)t * 1024 + c) = o;
      if (last) *(float4*)(so + c) = h;
    }
  }
}

DEV void phase_proj0_lora(const Params& p, char* smem) {
  const int tid = threadIdx.x, lane = tid & 63, wid = tid >> 6, fr = lane & 15, fq = lane >> 4;
  const int wr = wid >> 1, wc = wid & 1;
  char* ws = p.ws;
  const u16* H0 = (const u16*)(ws + WS_H0);
  const u16* SH = (const u16*)(ws + WS_SH);
  u16* T = (u16*)(ws + WS_T);
  const int xcc0 = xcc_id();
  int nxt;
  f32x4 acc[4][4];
  for (int ls = 0; ls < 8; ++ls) {
  const int xcd = (xcc0 + ls) & 7;
  unsigned* ctr = sched_ctr(p, 0, xcd);
  for (int li = sched_first(ctr, smem); li < 17; li = sched_commit(nxt, smem)) {
    nxt = sched_prefetch(ctr);
    const int lmt = xcd + 8 * li;
    if (lmt >= 130) continue;
    const int m0 = lmt * 256;
    gemm_main<2>(acc, H0, 1024, (const u16*)(ws + WS_L1T), 2048, 32, m0, 0, nullptr, SH, smem);
#pragma unroll
    for (int i = 0; i < 4; ++i)
#pragma unroll
      for (int j = 0; j < 4; ++j) {
        const int m = m0 + wr * 64 + i * 16 + fr, n = wc * 64 + j * 16 + fq * 4;
        f32x4 v = acc[i][j];
        if (wc == 0) { v[0] = tanhf(v[0]); v[1] = tanhf(v[1]); v[2] = tanhf(v[2]); v[3] = tanhf(v[3]); }
        uint2 o; o.x = pack2(v[0], v[1]); o.y = pack2(v[2], v[3]);
        *(uint2*)(T + (size_t)m * 128 + n) = o;
      }
  }
  }
}

DEV void phase_proj0_main(const Params& p, char* smem) {
  const int tid = threadIdx.x, lane = tid & 63, wid = tid >> 6, fr = lane & 15, fq = lane >> 4;
  const int wr = wid >> 2, wc = wid & 3;
  char* ws = p.ws;
  const u16* H0 = (const u16*)(ws + WS_H0);
  const u16* SH = (const u16*)(ws + WS_SH);
  const int xcc0 = xcc_id();
  int nxt;
  f32x4 acc[8][4];
  for (int ls = 0; ls < 8; ++ls) {
  const int xcd = (xcc0 + ls) & 7;
  unsigned* ctr = sched_ctr(p, 4, xcd);
  for (int q = sched_first(ctr, smem); q < 520; q = sched_commit(nxt, smem)) {
    nxt = sched_prefetch(ctr);
    const int mt = q >> 2, nt = 4 * xcd + (q & 3);
    const int part = nt >> 3;
    const int m0 = mt * 256, n0 = nt * 256;
    gemm_main256<1>(acc, H0, 1024, (const u16*)(ws + WS_WT_IN), 1024, 16, m0, n0, p.in[I_AMUIN] + part * 1024, SH, smem);
    u16* dst = (u16*)(ws + (size_t)part * SLOT);
    const int nb = n0 - part * 2048;
#pragma unroll
    for (int i = 0; i < 8; ++i)
#pragma unroll
      for (int j = 0; j < 4; ++j) {
        const int m = m0 + wr * 128 + i * 16 + fr, n = nb + wc * 64 + j * 16 + fq * 4;
        f32x4 v = acc[i][j];
        uint2 o; o.x = pack2(v[0], v[1]); o.y = pack2(v[2], v[3]);
        *(uint2*)(dst + (size_t)m * 2048 + n) = o;
      }
  }
  }
}

DEV void phase_proj0(const Params& p, char* smem) {
  phase_proj0_lora(p, smem);
  phase_proj0_main(p, smem);
}

DEV void phase_scan(const Params& p, char* smem) {
  const int tid = threadIdx.x, lane = tid & 63, wid = tid >> 6;
  u16* Hkk = (u16*)smem;
  u16* Hw = Hkk + 4096;
  u16* Hb = Hw + 4096;
  u16* Hk = Hb + 4096;
  u16* Hwr = Hk + 4096;
  unsigned* Hv2 = (unsigned*)(smem + 40960);
  float* LY = (float*)(smem + 57344);
  float* Lbon = LY + 8192;
  float* Lsc = Lbon + 64;
  float* Lwa = Lsc + 128;
  char* ws = p.ws;
  const u16* gR = (const u16*)(ws + 0 * SLOT);
  const u16* gK = (const u16*)(ws + 1 * SLOT);
  const u16* gV = (const u16*)(ws + 2 * SLOT);
  const u16* gZ = (const u16*)(ws + 3 * SLOT);
  const u16* gT = (const u16*)(ws + WS_T);
  const u16* W2T = (const u16*)(ws + WS_W2T);
  const u16* A2T = (const u16*)(ws + WS_A2T);
  const int fr = lane & 15, fq = lane >> 4, lmt = wid & 3, lnh = wid >> 2;
  u16* YG = (u16*)(ws + 6 * SLOT);
  const int tt = tid >> 3, c8 = (tid & 7) * 8;
  const int srow = tid >> 3, kc = tid & 7;

  for (int item = blockIdx.x; item < 768; item += gridDim.x) {
    int h, tok0, nsteps; const float* sinit; float* sout;
    if (item < 256) { h = item & 31; tok0 = (item >> 5) * 4096; nsteps = 4096; sinit = nullptr; sout = p.out + OFF_WKV_P + (size_t)item * 4096; }
    else { int it = item - 256; h = it & 31; tok0 = TP + (it >> 5) * 32; nsteps = 32; sinit = p.in[I_SWKV] + (size_t)it * 4096; sout = p.out + OFF_WKV_S + (size_t)it * 4096; }
    const int nch = (nsteps + 63) >> 6;
    const int col0 = h * 64 + c8;
    float ckk[8], cka[8], crk[8], clg[8], clb[8];
    {
      float4 t0, t1;
      t0 = *(const float4*)(p.in[I_AKK] + col0); t1 = *(const float4*)(p.in[I_AKK] + col0 + 4);
      ckk[0] = t0.x; ckk[1] = t0.y; ckk[2] = t0.z; ckk[3] = t0.w; ckk[4] = t1.x; ckk[5] = t1.y; ckk[6] = t1.z; ckk[7] = t1.w;
      t0 = *(const float4*)(p.in[I_AKA] + col0); t1 = *(const float4*)(p.in[I_AKA] + col0 + 4);
      cka[0] = t0.x; cka[1] = t0.y; cka[2] = t0.z; cka[3] = t0.w; cka[4] = t1.x; cka[5] = t1.y; cka[6] = t1.z; cka[7] = t1.w;
      t0 = *(const float4*)(p.in[I_ARK] + col0); t1 = *(const float4*)(p.in[I_ARK] + col0 + 4);
      crk[0] = t0.x; crk[1] = t0.y; crk[2] = t0.z; crk[3] = t0.w; crk[4] = t1.x; crk[5] = t1.y; crk[6] = t1.z; crk[7] = t1.w;
      t0 = *(const float4*)(p.in[I_ALNG] + col0); t1 = *(const float4*)(p.in[I_ALNG] + col0 + 4);
      clg[0] = t0.x; clg[1] = t0.y; clg[2] = t0.z; clg[3] = t0.w; clg[4] = t1.x; clg[5] = t1.y; clg[6] = t1.z; clg[7] = t1.w;
      t0 = *(const float4*)(p.in[I_ALNB] + col0); t1 = *(const float4*)(p.in[I_ALNB] + col0 + 4);
      clb[0] = t0.x; clb[1] = t0.y; clb[2] = t0.z; clb[3] = t0.w; clb[4] = t1.x; clb[5] = t1.y; clb[6] = t1.z; clb[7] = t1.w;
    }
    float cw0[8], ca0[8];
    {
      float4 t0 = *(const float4*)(p.in[I_AW0] + col0), t1 = *(const float4*)(p.in[I_AW0] + col0 + 4);
      cw0[0] = t0.x; cw0[1] = t0.y; cw0[2] = t0.z; cw0[3] = t0.w; cw0[4] = t1.x; cw0[5] = t1.y; cw0[6] = t1.z; cw0[7] = t1.w;
      t0 = *(const float4*)(p.in[I_AA0] + col0); t1 = *(const float4*)(p.in[I_AA0] + col0 + 4);
      ca0[0] = t0.x; ca0[1] = t0.y; ca0[2] = t0.z; ca0[3] = t0.w; ca0[4] = t1.x; ca0[5] = t1.y; ca0[6] = t1.z; ca0[7] = t1.w;
    }
    bf16x8 w2f[2][2], a2f[2][2];
#pragma unroll
    for (int n2 = 0; n2 < 2; ++n2)
#pragma unroll
      for (int ks = 0; ks < 2; ++ks) {
        const size_t o_ = (size_t)(h * 64 + lnh * 32 + n2 * 16 + fr) * 64 + ks * 32 + fq * 8;
        w2f[n2][ks] = *(const bf16x8*)(W2T + o_);
        a2f[n2][ks] = *(const bf16x8*)(A2T + o_);
      }
    h2_t sa_, sb_, sc_, sd_;
    if (sinit) {
      float4 a = *(const float4*)(sinit + srow * 64 + kc * 8), b = *(const float4*)(sinit + srow * 64 + kc * 8 + 4);
      sa_ = (h2_t){(_Float16)a.x, (_Float16)a.y}; sb_ = (h2_t){(_Float16)a.z, (_Float16)a.w};
      sc_ = (h2_t){(_Float16)b.x, (_Float16)b.y}; sd_ = (h2_t){(_Float16)b.z, (_Float16)b.w};
    } else {
      sa_ = sb_ = sc_ = sd_ = (h2_t){(_Float16)0.f, (_Float16)0.f};
    }
    uint4 cr, ck, cv, cz;
    bf16x8 t1f[2], t2f[2];
#define SCAN_LOAD(c)                                                                   \
    {                                                                                  \
      const int tl_ = (c) * 64 + tt;                                                   \
      if (tl_ < nsteps) {                                                              \
        const size_t o_ = (size_t)(tok0 + tl_) * 2048 + col0;                          \
        cr = *(const uint4*)(gR + o_); ck = *(const uint4*)(gK + o_); cv = *(const uint4*)(gV + o_); \
        cz = *(const uint4*)(gZ + o_);                                                 \
      } else { cr = ck = cv = cz = make_uint4(0, 0, 0, 0); }                           \
      const int tm_ = (c) * 64 + lmt * 16 + fr;                                        \
      if (tm_ < nsteps) {                                                              \
        const u16* tp_ = gT + (size_t)(tok0 + tm_) * 128 + fq * 8;                     \
        t1f[0] = *(const bf16x8*)(tp_); t1f[1] = *(const bf16x8*)(tp_ + 32);           \
        t2f[0] = *(const bf16x8*)(tp_ + 64); t2f[1] = *(const bf16x8*)(tp_ + 96);      \
      } else { t1f[0] = t1f[1] = t2f[0] = t2f[1] = (bf16x8){0, 0, 0, 0, 0, 0, 0, 0}; } \
    }
    SCAN_LOAD(0);
    for (int c = 0; c < nch; ++c) {
      {
#pragma unroll
        for (int n2 = 0; n2 < 2; ++n2) {
          f32x4 xw = {0.f, 0.f, 0.f, 0.f}, xa = {0.f, 0.f, 0.f, 0.f};
          xw = __builtin_amdgcn_mfma_f32_16x16x32_bf16(w2f[n2][0], t1f[0], xw, 0, 0, 0);
          xw = __builtin_amdgcn_mfma_f32_16x16x32_bf16(w2f[n2][1], t1f[1], xw, 0, 0, 0);
          xa = __builtin_amdgcn_mfma_f32_16x16x32_bf16(a2f[n2][0], t2f[0], xa, 0, 0, 0);
          xa = __builtin_amdgcn_mfma_f32_16x16x32_bf16(a2f[n2][1], t2f[1], xa, 0, 0, 0);
          const int o_ = (lmt * 16 + fr) * 64 + lnh * 32 + n2 * 16 + fq * 4;
          *(float4*)(Lwa + o_) = make_float4(xw[0], xw[1], xw[2], xw[3]);
          *(float4*)(Lwa + 4096 + o_) = make_float4(xa[0], xa[1], xa[2], xa[3]);
        }
      }
      __syncthreads();
      uint4 zc = cz;
      {
        float r[8], k[8], v[8], lw[8], a[8];
        unpack8(cr, r); unpack8(ck, k); unpack8(cv, v);
        {
          const float4 x0 = *(const float4*)(Lwa + tt * 64 + c8), x1 = *(const float4*)(Lwa + tt * 64 + c8 + 4);
          const float4 y0 = *(const float4*)(Lwa + 4096 + tt * 64 + c8), y1 = *(const float4*)(Lwa + 4096 + tt * 64 + c8 + 4);
          const float xw_[8] = {x0.x, x0.y, x0.z, x0.w, x1.x, x1.y, x1.z, x1.w};
          const float xa_[8] = {y0.x, y0.y, y0.z, y0.w, y1.x, y1.y, y1.z, y1.w};
#pragma unroll
          for (int j = 0; j < 8; ++j) {
            lw[j] = -0.60653066f * sigmoidf_(cw0[j] + xw_[j]);
            a[j] = sigmoidf_(ca0[j] + xa_[j]);
          }
        }
        float kkv[8], kp[8], w[8], bon = 0.f, ss = 0.f, kr = 0.f;
#pragma unroll
        for (int j = 0; j < 8; ++j) {
          kkv[j] = k[j] * ckk[j]; ss += kkv[j] * kkv[j];
          kp[j] = k[j] * (1.f + (a[j] - 1.f) * cka[j]);
          bon += r[j] * kp[j] * crk[j];
          kr += r[j] * kp[j];
          w[j] = __expf(lw[j]);
        }
        ss = red8(ss); bon = red8(bon); kr = red8(kr);
        const float inv = rsqrtf(ss + 1e-12f);
        float bb[8], br = 0.f;
#pragma unroll
        for (int j = 0; j < 8; ++j) { kkv[j] *= inv; bb[j] = kkv[j] * a[j]; br += bb[j] * r[j]; }
        br = red8(br);
        const int ho = tt * 64 + c8;
        *(uint4*)(Hkk + ho) = make_uint4(packh2(kkv[0], kkv[1]), packh2(kkv[2], kkv[3]), packh2(kkv[4], kkv[5]), packh2(kkv[6], kkv[7]));
        *(uint4*)(Hb + ho) = make_uint4(packh2(bb[0], bb[1]), packh2(bb[2], bb[3]), packh2(bb[4], bb[5]), packh2(bb[6], bb[7]));
        *(uint4*)(Hw + ho) = make_uint4(packh2(w[0], w[1]), packh2(w[2], w[3]), packh2(w[4], w[5]), packh2(w[6], w[7]));
        *(uint4*)(Hk + ho) = make_uint4(packh2(kp[0], kp[1]), packh2(kp[2], kp[3]), packh2(kp[4], kp[5]), packh2(kp[6], kp[7]));
        *(uint4*)(Hwr + ho) = make_uint4(packh2(w[0] * r[0], w[1] * r[1]), packh2(w[2] * r[2], w[3] * r[3]), packh2(w[4] * r[4], w[5] * r[5]), packh2(w[6] * r[6], w[7] * r[7]));
        *(uint4*)(Hv2 + ho) = make_uint4(packh2(v[0], v[0]), packh2(v[1], v[1]), packh2(v[2], v[2]), packh2(v[3], v[3]));
        *(uint4*)(Hv2 + ho + 4) = make_uint4(packh2(v[4], v[4]), packh2(v[5], v[5]), packh2(v[6], v[6]), packh2(v[7], v[7]));
        if ((tid & 7) == 0) { Lbon[tt] = bon; *(float2*)(Lsc + tt * 2) = make_float2(br, kr); }
      }
      __syncthreads();
      if (c + 1 < nch) SCAN_LOAD(c + 1);
      {
        const int nT = min(64, nsteps - c * 64);
        const u16* pk = Hkk + kc * 8; const u16* pw = Hw + kc * 8; const u16* pb = Hb + kc * 8;
        const u16* pkp = Hk + kc * 8; const u16* pwr = Hwr + kc * 8; const unsigned* pv = Hv2 + srow;
        float* py = LY + srow * 2;
#define SCAN_LD(S, o)                                                                  \
        S##kk = *(const uint4*)(pk + (o)); S##w = *(const uint4*)(pw + (o)); S##b = *(const uint4*)(pb + (o)); \
        S##k = *(const uint4*)(pkp + (o)); S##wr = *(const uint4*)(pwr + (o)); S##v = pv[(o)];
#define H2(x) (*(const h2_t*)&(x))
#define SCAN_UPD(sreg, S, c)                                                           \
        sreg = __builtin_elementwise_fma(sreg, H2(S##w.c), __builtin_elementwise_fma(-n_, H2(S##b.c), H2(S##v) * H2(S##k.c)));
#define SCAN_STEP(S, o)                                                                \
        {                                                                              \
          float d = __builtin_amdgcn_fdot2(sa_, H2(S##kk.x), 0.f, false);              \
          float e = __builtin_amdgcn_fdot2(sa_, H2(S##wr.x), 0.f, false);              \
          d = __builtin_amdgcn_fdot2(sb_, H2(S##kk.y), d, false); e = __builtin_amdgcn_fdot2(sb_, H2(S##wr.y), e, false); \
          d = __builtin_amdgcn_fdot2(sc_, H2(S##kk.z), d, false); e = __builtin_amdgcn_fdot2(sc_, H2(S##wr.z), e, false); \
          d = __builtin_amdgcn_fdot2(sd_, H2(S##kk.w), d, false); e = __builtin_amdgcn_fdot2(sd_, H2(S##wr.w), e, false); \
          d += dppf<0xB1>(d); e += dppf<0xB1>(e);                                      \
          d += dppf<0x4E>(d); e += dppf<0x4E>(e);                                      \
          d += dppf<0x141>(d); e += dppf<0x141>(e);                                    \
          const unsigned nu_ = packh2(d, d);                                           \
          const h2_t n_ = H2(nu_);                                                     \
          SCAN_UPD(sa_, S, x) SCAN_UPD(sb_, S, y) SCAN_UPD(sc_, S, z) SCAN_UPD(sd_, S, w) \
          if (kc == 0) *(float2*)(py + 2 * (o)) = make_float2(e, d);                   \
        }
        uint4 Akk, Aw, Ab, Ak, Awr, Bkk, Bw, Bb, Bk, Bwr; unsigned Av, Bv;
        SCAN_LD(A, 0);
        for (int t = 0; t < nT; t += 2) {
          SCAN_LD(B, (t + 1) * 64);
          SCAN_STEP(A, t * 64);
          SCAN_LD(A, (t + 2) * 64);
          SCAN_STEP(B, (t + 1) * 64);
        }
#undef SCAN_UPD
#undef H2
#undef SCAN_LD
#undef SCAN_STEP
      }
      __syncthreads();
      {
        const int tl = c * 64 + tt;
        if (tl < nsteps) {
          float y[8], z[8];
          const float2 sc = *(const float2*)(Lsc + tt * 2);
          const uint4 va = *(const uint4*)(Hv2 + tt * 64 + c8), vb = *(const uint4*)(Hv2 + tt * 64 + c8 + 4);
          float vv[8];
          { const unsigned vu[8] = {va.x, va.y, va.z, va.w, vb.x, vb.y, vb.z, vb.w};
#pragma unroll
            for (int j = 0; j < 8; ++j) { h2_t t_ = *(const h2_t*)&vu[j]; vv[j] = (float)t_[0]; } }
#pragma unroll
          for (int q = 0; q < 4; ++q) {
            const float4 ed = *(const float4*)(LY + tt * 128 + (c8 + 2 * q) * 2);
            y[2 * q] = ed.x - ed.y * sc.x + vv[2 * q] * sc.y;
            y[2 * q + 1] = ed.z - ed.w * sc.x + vv[2 * q + 1] * sc.y;
          }
          float sm = y[0] + y[1] + y[2] + y[3] + y[4] + y[5] + y[6] + y[7];
          sm = red8(sm);
          const float mean = sm * (1.f / 64.f);
          float vs = 0.f;
#pragma unroll
          for (int j = 0; j < 8; ++j) { y[j] -= mean; vs += y[j] * y[j]; }
          vs = red8(vs);
          const float rstd = rsqrtf(vs * (1.f / 64.f) + 64e-5f);
          const float bon = Lbon[tt];
          unpack8(zc, z);
          float o[8];
#pragma unroll
          for (int j = 0; j < 8; ++j) {
            float t = y[j] * rstd * clg[j] + clb[j] + bon * vv[j];
            o[j] = t * z[j] * sigmoidf_(z[j]);
          }
          uint4 ov; ov.x = pack2(o[0], o[1]); ov.y = pack2(o[2], o[3]); ov.z = pack2(o[4], o[5]); ov.w = pack2(o[6], o[7]);
          *(uint4*)(YG + (size_t)(tok0 + tl) * 2048 + col0) = ov;
        }
      }
      __syncthreads();
    }
#undef SCAN_LOAD
    *(float4*)(sout + srow * 64 + kc * 8) = make_float4((float)sa_[0], (float)sa_[1], (float)sb_[0], (float)sb_[1]);
    *(float4*)(sout + srow * 64 + kc * 8 + 4) = make_float4((float)sc_[0], (float)sc_[1], (float)sd_[0], (float)sd_[1]);
  }
}

template <int LAYER>
DEV void outproj_store(const Params& p, const float* mod, float* xmid, int m, int n, f32x4 v) {
  const float* gate = mod + (size_t)seq_of(m) * 3072 + 2048;
  float4 g4 = *(const float4*)(gate + n);
  if (LAYER == 0) {
    const float* xr = m < TP ? p.in[I_XP] + (size_t)m * 1024 : p.in[I_XS] + (size_t)(m - TP) * 1024;
    float4 x4 = *(const float4*)(xr + n);
    *(float4*)(xmid + (size_t)m * 1024 + n) = make_float4(x4.x + g4.x * v[0], x4.y + g4.y * v[1], x4.z + g4.z * v[2], x4.w + g4.w * v[3]);
  } else {
    float4 x4 = *(const float4*)(xmid + (size_t)m * 1024 + n);
    float* yo = m < TP ? p.out + OFF_Y_P + (size_t)m * 1024 : p.out + OFF_Y_S + (size_t)(m - TP) * 1024;
    *(float4*)(yo + n) = make_float4(x4.x + g4.x * v[0], x4.y + g4.y * v[1], x4.z + g4.z * v[2], x4.w + g4.w * v[3]);
  }
}

template <int LAYER>
DEV void phase_outproj_main(const Params& p, char* smem) {
  const int tid = threadIdx.x, lane = tid & 63, wid = tid >> 6, wr = wid >> 2, wc = wid & 3, fr = lane & 15, fq = lane >> 4;
  char* ws = p.ws;
  const u16* A = (const u16*)(ws + 6 * SLOT);
  const u16* Bt = (const u16*)(ws + (LAYER == 0 ? WS_WT_OUTA : WS_WT_OUTB));
  const float* mod = (const float*)(ws + WS_MOD) + (size_t)LAYER * 24 * 3072;
  float* xmid = (float*)(ws + 0 * SLOT);
  f32x4 acc[8][4];
  const int xcc0 = xcc_id();
  int nxt;
  for (int ls = 0; ls < 8; ++ls) {
    const int xcd = (xcc0 + ls) & 7;
    unsigned* ctr = sched_ctr(p, LAYER == 0 ? 1 : 3, xcd);
    for (int li = sched_first(ctr, smem); li < 64; li = sched_commit(nxt, smem)) {
      nxt = sched_prefetch(ctr);
      const int item = 64 * xcd + li;
      const int m0 = (item >> 2) * 256, n0 = (item & 3) * 256;
      gemm_main256_dma(acc, A, 2048, Bt, 2048, 32, m0, n0, smem);
#pragma unroll
      for (int i = 0; i < 8; ++i)
#pragma unroll
        for (int j = 0; j < 4; ++j)
          outproj_store<LAYER>(p, mod, xmid, m0 + wr * 128 + i * 16 + fr, n0 + wc * 64 + j * 16 + fq * 4, acc[i][j]);
    }
  }
}

template <int LAYER>
DEV void phase_outproj_tail(const Params& p, char* smem) {
  const int tid = threadIdx.x, lane = tid & 63, wid = tid >> 6, wr = wid >> 1, wc = wid & 1, fr = lane & 15, fq = lane >> 4;
  char* ws = p.ws;
  const u16* A = (const u16*)(ws + 6 * SLOT);
  const u16* Bt = (const u16*)(ws + (LAYER == 0 ? WS_WT_OUTA : WS_WT_OUTB));
  const float* mod = (const float*)(ws + WS_MOD) + (size_t)LAYER * 24 * 3072;
  float* xmid = (float*)(ws + 0 * SLOT);
  f32x4 acc[4][4];
  const int xcc0 = xcc_id();
  int nxt;
  for (int ls = 0; ls < 8; ++ls) {
    const int xcd = (xcc0 + ls) & 7;
    unsigned* ctr = sched_ctr(p, LAYER == 0 ? 5 : 6, xcd);
    for (int li = sched_first(ctr, smem); li < 2; li = sched_commit(nxt, smem)) {
      nxt = sched_prefetch(ctr);
      const int item = 2 * xcd + li;
      const int m0 = (128 + (item >> 3)) * 256, n0 = (item & 7) * 128;
      gemm_main<0>(acc, A, 2048, Bt, 2048, 32, m0, n0, nullptr, nullptr, smem);
#pragma unroll
      for (int i = 0; i < 4; ++i)
#pragma unroll
        for (int j = 0; j < 4; ++j)
          outproj_store<LAYER>(p, mod, xmid, m0 + wr * 64 + i * 16 + fr, n0 + wc * 64 + j * 16 + fq * 4, acc[i][j]);
    }
  }
}

template <int LAYER>
DEV void phase_outproj(const Params& p, char* smem) {
  phase_outproj_tail<LAYER>(p, smem);
  phase_outproj_main<LAYER>(p, smem);
}

DEV void phase_norm1(const Params& p) {
  const int lane = threadIdx.x & 63, wid = threadIdx.x >> 6;
  const float* mod = (const float*)(p.ws + WS_MOD) + (size_t)24 * 3072;
  const float* xmid = (const float*)(p.ws + 0 * SLOT);
  u16* AKV = (u16*)(p.ws + 1 * SLOT);
  u16* AQ = AKV + (size_t)NTOK * 1024;
  const float* gkv = p.in[I_KVNG];
  const float* gb = p.in[I_BNG];
  for (int t = blockIdx.x * 8 + wid; t < NTOK; t += gridDim.x * 8) {
    const float* x = xmid + (size_t)t * 1024;
    const float* md = mod + (size_t)seq_of(t) * 3072;
    float4 v[4];
    float ss = 0.f;
#pragma unroll
    for (int i = 0; i < 4; ++i) {
      v[i] = *(const float4*)(x + lane * 4 + 256 * i);
      ss += v[i].x * v[i].x + v[i].y * v[i].y + v[i].z * v[i].z + v[i].w * v[i].w;
    }
    ss = wave_sum(ss);
    const float rstd = rsqrtf(ss * (1.0f / 1024.0f) + 1e-6f);
#pragma unroll
    for (int i = 0; i < 4; ++i) {
      const int c = lane * 4 + 256 * i;
      float4 g1 = *(const float4*)(gkv + c), g2 = *(const float4*)(gb + c), sh = *(const float4*)(md + c), sc = *(const float4*)(md + 1024 + c);
      float xn0 = v[i].x * rstd, xn1 = v[i].y * rstd, xn2 = v[i].z * rstd, xn3 = v[i].w * rstd;
      uint2 o;
      o.x = pack2(xn0 * g1.x, xn1 * g1.y); o.y = pack2(xn2 * g1.z, xn3 * g1.w);
      *(uint2*)(AKV + (size_t)t * 1024 + c) = o;
      o.x = pack2(xn0 * g2.x * (1.f + sc.x) + sh.x, xn1 * g2.y * (1.f + sc.y) + sh.y);
      o.y = pack2(xn2 * g2.z * (1.f + sc.z) + sh.z, xn3 * g2.w * (1.f + sc.w) + sh.w);
      *(uint2*)(AQ + (size_t)t * 1024 + c) = o;
    }
  }
}

#define QSCALE (0.08838834764831845f * 1.4426950408889634f)
DEV void phase_proj1(const Params& p, char* smem) {
  const int tid = threadIdx.x, lane = tid & 63, wid = tid >> 6, wr = wid >> 2, wc = wid & 3, fr = lane & 15, fq = lane >> 4;
  char* ws = p.ws;
  const u16* AKV = (const u16*)(ws + 1 * SLOT);
  const u16* AQ = AKV + (size_t)NTOK * 1024;
  u16* KB = (u16*)(ws + 2 * SLOT);
  u16* VB = (u16*)(ws + 3 * SLOT);
  u16* QB = (u16*)(ws + 4 * SLOT);
  u16* ZS = (u16*)(ws + 5 * SLOT);
  f32x4 acc[8][4];
  float* red = (float*)smem;
  const int xcc0 = xcc_id();
  int nxt;
  for (int ls = 0; ls < 8; ++ls) {
  const int xcd = (xcc0 + ls) & 7;
  unsigned* ctr = sched_ctr(p, 2, xcd);
  for (int li = sched_first(ctr, smem); li < 520; li = sched_commit(nxt, smem)) {
    nxt = sched_prefetch(ctr);
    const int mt = li >> 2, t = 4 * xcd + (li & 3);
    const int isq = t >> 4, nt = t & 15;
    const int m0 = mt * 256, n0 = nt * 256;
    gemm_main256_dma(acc, isq ? AQ : AKV, 1024, (const u16*)(ws + (isq ? WS_WT_INB : WS_WT_KV)), 1024, 16, m0, n0, smem);
    if (nt < 8) {
#pragma unroll
      for (int i = 0; i < 8; ++i) {
        float ss = 0.f;
#pragma unroll
        for (int j = 0; j < 4; ++j) ss += acc[i][j][0] * acc[i][j][0] + acc[i][j][1] * acc[i][j][1] + acc[i][j][2] * acc[i][j][2] + acc[i][j][3] * acc[i][j][3];
        red[(wr * 128 + i * 16 + fr) * 16 + wc * 4 + fq] = ss;
      }
      __syncthreads();
      const float* gain = isq ? p.in[I_BQG] : p.in[I_KGAIN];
#pragma unroll
      for (int i = 0; i < 8; ++i) {
        const int row = wr * 128 + i * 16 + fr, m = m0 + row;
        float4 ra = *(const float4*)(red + row * 16 + (wc >> 1) * 8), rb = *(const float4*)(red + row * 16 + (wc >> 1) * 8 + 4);
        float tot = ra.x + ra.y + ra.z + ra.w + rb.x + rb.y + rb.z + rb.w;
        float rs = rsqrtf(tot * (1.f / 128.f) + 1e-6f);
        if (isq) rs *= QSCALE;
#pragma unroll
        for (int j = 0; j < 4; ++j) {
          const int d = (wc & 1) * 64 + j * 16 + fq * 4, n = n0 + wc * 64 + j * 16 + fq * 4;
          float4 g4 = *(const float4*)(gain + d);
          f32x4 v = acc[i][j];
          float o0 = v[0] * rs * g4.x, o1 = v[1] * rs * g4.y, o2 = v[2] * rs * g4.z, o3 = v[3] * rs * g4.w;
          uint2 o; o.x = pack2(o0, o1); o.y = pack2(o2, o3);
          if (isq) {
            *(uint2*)(QB + (size_t)m * 2048 + n) = o;
          } else {
            *(uint2*)(KB + (size_t)m * 2048 + n) = o;
            float* ko = m < TP ? p.out + OFF_K_P + (size_t)m * 2048 : p.out + OFF_K_S + (size_t)(m - TP) * 2048;
            *(float4*)(ko + n) = make_float4(o0, o1, o2, o3);
          }
        }
      }
      __syncthreads();
    } else {
#pragma unroll
      for (int i = 0; i < 8; ++i) {
        const int m = m0 + wr * 128 + i * 16 + fr;
#pragma unroll
        for (int j = 0; j < 4; ++j) {
          const int n = n0 - 2048 + wc * 64 + j * 16 + fq * 4;
          f32x4 v = acc[i][j];
          if (isq) {
            float o0 = v[0] * sigmoidf_(v[0]), o1 = v[1] * sigmoidf_(v[1]), o2 = v[2] * sigmoidf_(v[2]), o3 = v[3] * sigmoidf_(v[3]);
            uint2 o; o.x = pack2(o0, o1); o.y = pack2(o2, o3);
            *(uint2*)(ZS + (size_t)m * 2048 + n) = o;
          } else {
            uint2 o; o.x = pack2(v[0], v[1]); o.y = pack2(v[2], v[3]);
            *(uint2*)(VB + (size_t)m * 2048 + n) = o;
            float* vo = m < TP ? p.out + OFF_V_P + (size_t)m * 2048 : p.out + OFF_V_S + (size_t)(m - TP) * 2048;
            *(float4*)(vo + n) = make_float4(v[0], v[1], v[2], v[3]);
          }
        }
      }
    }
  }
}
}

DEV unsigned off_b(unsigned row, unsigned ch) { return 256u * row + 16u * (ch ^ (((row & 3) << 2) | ((row >> 2) & 3))); }

DEV void phase_attn(const Params& p, char* smem) {
  const int tid = threadIdx.x, lane = tid & 63, w = tid >> 6, fr = lane & 15, fq = lane >> 4;
  char* ws = p.ws;
  const u16* KB = (const u16*)(ws + 2 * SLOT);
  const u16* VB = (const u16*)(ws + 3 * SLOT);
  const u16* QB = (const u16*)(ws + 4 * SLOT);
  const u16* ZS = (const u16*)(ws + 5 * SLOT);
  u16* OG = (u16*)(ws + 6 * SLOT);
  const int lrow = tid >> 4, lch = tid & 15;
  const unsigned lw0 = off_b(lrow, lch), lw1 = off_b(lrow + 32, lch);
  const int tq = (lane & 15) >> 2, tp = lane & 3;

  for (int item = blockIdx.x; item < 4096 + 256; item += gridDim.x) {
    int b, h, nq, qpos0, tokq0, ntiles, nkeys, tokk0; bool sample;
    if (item < 4096) {
      const int qblk = 31 - (item >> 7), bh = item & 127;
      b = bh >> 4; h = bh & 15; nq = 128; qpos0 = qblk * 128; tokq0 = b * 4096 + qpos0; ntiles = 2 * qblk + 2; nkeys = qpos0 + 128; tokk0 = b * 4096; sample = false;
    } else {
      const int bh = item - 4096;
      b = bh >> 4; h = bh & 15; nq = 32; qpos0 = 1024; tokq0 = TP + b * 32; ntiles = 17; nkeys = 1056; tokk0 = TP + b * 32 - 1024; sample = true;
    }
    const bool wactive = (w * 16) < nq;
    int* dflag = (int*)(smem + 65536);
    __syncthreads();
    if (lane == 0) dflag[w] = wactive ? 0 : 1;
    bool wdone = !wactive;
    const int qp = qpos0 + w * 16 + fr;
    const int qwmax = qpos0 + w * 16 + 15;
    bf16x8 qf[4];
#pragma unroll
    for (int ks = 0; ks < 4; ++ks) {
      if (wactive) qf[ks] = *(const bf16x8*)(QB + (size_t)(tokq0 + w * 16 + fr) * 2048 + h * 128 + ks * 32 + fq * 8);
      else qf[ks] = (bf16x8){0, 0, 0, 0, 0, 0, 0, 0};
    }
    f32x4 O[8];
#pragma unroll
    for (int dt = 0; dt < 8; ++dt) O[dt] = (f32x4){0, 0, 0, 0};
    float carry = 0.f;

    uint4 lk0, lk1, lv0, lv1;
#define ATT_LOAD(kb)                                                                                  \
    {                                                                                                 \
      const int kx0_ = (kb) * 64 + lrow, kx1_ = kx0_ + 32;                                            \
      if (sample && (kb) < 16) {                                                                      \
        const float* ck_ = p.in[I_CK] + ((size_t)(b * 1024 + kx0_) * 16 + h) * 128 + lch * 8;         \
        const float* cv_ = p.in[I_CV] + ((size_t)(b * 1024 + kx0_) * 16 + h) * 128 + lch * 8;         \
        float4 a_ = *(const float4*)ck_, b_ = *(const float4*)(ck_ + 4);                              \
        float4 c_ = *(const float4*)(ck_ + 32 * 2048), d_ = *(const float4*)(ck_ + 32 * 2048 + 4);    \
        lk0 = make_uint4(pack2(a_.x, a_.y), pack2(a_.z, a_.w), pack2(b_.x, b_.y), pack2(b_.z, b_.w)); \
        lk1 = make_uint4(pack2(c_.x, c_.y), pack2(c_.z, c_.w), pack2(d_.x, d_.y), pack2(d_.z, d_.w)); \
        a_ = *(const float4*)cv_; b_ = *(const float4*)(cv_ + 4);                                     \
        c_ = *(const float4*)(cv_ + 32 * 2048); d_ = *(const float4*)(cv_ + 32 * 2048 + 4);           \
        lv0 = make_uint4(pack2(a_.x, a_.y), pack2(a_.z, a_.w), pack2(b_.x, b_.y), pack2(b_.z, b_.w)); \
        lv1 = make_uint4(pack2(c_.x, c_.y), pack2(c_.z, c_.w), pack2(d_.x, d_.y), pack2(d_.z, d_.w)); \
      } else {                                                                                        \
        const size_t o0_ = (size_t)(tokk0 + kx0_) * 2048 + h * 128 + lch * 8;                         \
        const size_t o1_ = o0_ + (size_t)32 * 2048;                                                   \
        if (kx0_ < nkeys) { lk0 = *(const uint4*)(KB + o0_); lv0 = *(const uint4*)(VB + o0_); }       \
        else { lk0 = make_uint4(0, 0, 0, 0); lv0 = lk0; }                                             \
        if (kx1_ < nkeys) { lk1 = *(const uint4*)(KB + o1_); lv1 = *(const uint4*)(VB + o1_); }       \
        else { lk1 = make_uint4(0, 0, 0, 0); lv1 = lk1; }                                             \
      }                                                                                               \
    }
#define ATT_STORE(st)                                                                                 \
    {                                                                                                 \
      char* sK_ = smem + (st) * 32768; char* sV_ = sK_ + 16384;                                       \
      *(uint4*)(sK_ + lw0) = lk0; *(uint4*)(sK_ + lw1) = lk1;                                         \
      *(uint4*)(sV_ + lw0) = lv0; *(uint4*)(sV_ + lw1) = lv1;                                         \
    }
    ATT_LOAD(ntiles - 1);
    ATT_STORE(0);
    __syncthreads();
    for (int it = 0; it < ntiles; ++it) {
      const int kb = ntiles - 1 - it, st = it & 1;
      if (it + 1 < ntiles) ATT_LOAD(kb - 1);
      if (!wdone && kb * 64 < qwmax) {
        const char* sK = smem + st * 32768;
        const char* sV = sK + 16384;
        f32x4 S[4];
#pragma unroll
        for (int mt = 0; mt < 4; ++mt) S[mt] = (f32x4){0, 0, 0, 0};
#pragma unroll
        for (int ks = 0; ks < 4; ++ks)
#pragma unroll
          for (int mt = 0; mt < 4; ++mt) {
            bf16x8 a = *(const bf16x8*)(sK + off_b(mt * 16 + fr, ks * 4 + fq));
            S[mt] = __builtin_amdgcn_mfma_f32_16x16x32_bf16(a, qf[ks], S[mt], 0, 0, 0);
          }
        bf16x8 wf[2];
        {
          float ee[4][4], tot[4], hi[4];
#pragma unroll
          for (int mt = 0; mt < 4; ++mt) {
            const int kbase = kb * 64 + mt * 16 + fq * 4;
            float ls[4];
#pragma unroll
            for (int jj = 0; jj < 4; ++jj) {
              const float u = S[mt][jj];
              const bool valid = (kbase + jj) < qp;
              const float l = -__builtin_amdgcn_logf(1.0f + __builtin_amdgcn_exp2f(u));
              ls[jj] = valid ? l : 0.f;
              ee[mt][jj] = valid ? (u + l) : -1e30f;
            }
            const float x3 = ls[3], x2 = x3 + ls[2], x1 = x2 + ls[1], seg = x1 + ls[0];
            ee[mt][2] += x3; ee[mt][1] += x2; ee[mt][0] += x1;
            const float t1 = __shfl_xor(seg, 16), t2 = __shfl_xor(seg, 32), t3 = __shfl_xor(t1, 32);
            tot[mt] = seg + t1 + t2 + t3;
            hi[mt] = fq == 0 ? (t1 + t2 + t3) : fq == 1 ? (t2 + t3) : fq == 2 ? t1 : 0.f;
          }
          float run = carry;
          float wv[4][4];
#pragma unroll
          for (int mt = 3; mt >= 0; --mt) {
            const float base = run + hi[mt];
            run += tot[mt];
#pragma unroll
            for (int jj = 0; jj < 4; ++jj) wv[mt][jj] = __builtin_amdgcn_exp2f(ee[mt][jj] + base);
          }
          carry = run;
          if (__all(carry < -150.0f)) { wdone = true; if (lane == 0) dflag[w] = 1; }
#pragma unroll
          for (int p2 = 0; p2 < 2; ++p2) {
            uint4 pk;
            pk.x = pack2(wv[2 * p2][0], wv[2 * p2][1]); pk.y = pack2(wv[2 * p2][2], wv[2 * p2][3]);
            pk.z = pack2(wv[2 * p2 + 1][0], wv[2 * p2 + 1][1]); pk.w = pack2(wv[2 * p2 + 1][2], wv[2 * p2 + 1][3]);
            wf[p2] = *(bf16x8*)&pk;
          }
        }
#pragma unroll
        for (int p2 = 0; p2 < 2; ++p2)
#pragma unroll
          for (int dt = 0; dt < 8; ++dt) {
            const unsigned r0 = 32 * p2 + 4 * fq + tq, r1 = r0 + 16;
            const unsigned ch = 2 * dt + (tp >> 1);
            const char* a0 = sV + off_b(r0, ch) + 8 * (tp & 1);
            const char* a1 = sV + off_b(r1, ch) + 8 * (tp & 1);
            s16x4 lo = __builtin_amdgcn_ds_read_tr16_b64_v4i16((s16x4 __attribute__((address_space(3)))*)(a0));
            s16x4 hi4 = __builtin_amdgcn_ds_read_tr16_b64_v4i16((s16x4 __attribute__((address_space(3)))*)(a1));
            bf16x8 a = {lo[0], lo[1], lo[2], lo[3], hi4[0], hi4[1], hi4[2], hi4[3]};
            O[dt] = __builtin_amdgcn_mfma_f32_16x16x32_bf16(a, wf[p2], O[dt], 0, 0, 0);
          }
      }
      if (it + 1 < ntiles) ATT_STORE(st ^ 1);
      __syncthreads();
      {
        const int4 f0 = *(const int4*)dflag, f1 = *(const int4*)(dflag + 4);
        if (f0.x & f0.y & f0.z & f0.w & f1.x & f1.y & f1.z & f1.w) break;
      }
    }
#undef ATT_LOAD
#undef ATT_STORE
    if (wactive) {
      const size_t rowoff = (size_t)(tokq0 + w * 16 + fr) * 2048 + h * 128;
#pragma unroll
      for (int dt = 0; dt < 8; ++dt) {
        const int d = dt * 16 + fq * 4;
        uint2 z = *(const uint2*)(ZS + rowoff + d);
        f32x4 v = O[dt];
        uint2 o;
        o.x = pack2(v[0] * bflo(z.x), v[1] * bfhi(z.x)); o.y = pack2(v[2] * bflo(z.y), v[3] * bfhi(z.y));
        *(uint2*)(OG + rowoff + d) = o;
      }
    }
  }
}


DEV void grid_barrier(unsigned* bar, unsigned target) {
  __syncthreads();
  if (threadIdx.x == 0) {
    __builtin_amdgcn_fence(__ATOMIC_RELEASE, "agent");
    asm volatile("s_waitcnt vmcnt(0)" ::: "memory");
    __hip_atomic_fetch_add(bar, 1u, __ATOMIC_RELAXED, __HIP_MEMORY_SCOPE_AGENT);
    while (__hip_atomic_load(bar, __ATOMIC_RELAXED, __HIP_MEMORY_SCOPE_AGENT) < target) __builtin_amdgcn_s_sleep(1);
    __builtin_amdgcn_fence(__ATOMIC_ACQUIRE, "agent");
    asm volatile("s_waitcnt vmcnt(0)" ::: "memory");
  }
  __syncthreads();
}

__global__ void __launch_bounds__(NTHREADS) __attribute__((target("no-packed-fp32-ops"))) mega(Params p, int lo, int hi) {
  __shared__ __attribute__((aligned(16))) char smem[147456];
  cg::grid_group grid = cg::this_grid();
#ifndef PROBE_DOUBLE
#define PROBE_DOUBLE -1
#endif
#define RUN_PHASE(k, call) if ((k) >= lo && (k) < hi) { if ((k) > lo) { if ((k) == lo + 1) grid.sync(); else grid_barrier((unsigned*)(p.ws + WS_BAR), (unsigned)((k) - lo - 1) * gridDim.x); } call; }
  RUN_PHASE(0, phase_prep(p, smem))
  RUN_PHASE(1, phase_norm0(p))
  RUN_PHASE(2, phase_proj0(p, smem))
  RUN_PHASE(3, phase_scan(p, smem))
  RUN_PHASE(4, phase_outproj<0>(p, smem))
  RUN_PHASE(5, phase_norm1(p))
  RUN_PHASE(6, phase_proj1(p, smem))
  RUN_PHASE(7, phase_attn(p, smem))
  RUN_PHASE(8, phase_outproj<1>(p, smem))
}

#ifndef N_LAUNCH_MODE
#define N_LAUNCH_MODE 1
#endif

extern "C" void kernel_launch(void* const* d_in, const int* in_sizes, int n_in, void* d_out, int out_size, void* d_ws, size_t ws_size,
                              hipStream_t stream) {
  Params p{};
  for (int i = 0; i < 36; ++i) p.in[i] = (const float*)d_in[i];
  p.out = (float*)d_out;
  p.ws = (char*)d_ws;
  static int grid_blocks = 0;
  if (!grid_blocks) {
    int dev = 0, cus = 0, per_cu = 0;
    hipGetDevice(&dev);
    hipDeviceGetAttribute(&cus, hipDeviceAttributeMultiprocessorCount, dev);
    hipOccupancyMaxActiveBlocksPerMultiprocessor(&per_cu, mega, NTHREADS, 0);
    if (per_cu < 1) per_cu = 1;
    grid_blocks = cus * per_cu;
  }
  if (ws_size < WS_END) { fprintf(stderr, "workspace too small: %zu < %llu\n", ws_size, (unsigned long long)WS_END); return; }
#if N_LAUNCH_MODE == 1
  int lo = 0, hi = 9;
  hipMemsetAsync((char*)d_ws + WS_BAR, 0, 256, stream);
  void* args[] = {&p, &lo, &hi};
  hipError_t e = hipLaunchCooperativeKernel((void*)mega, dim3(grid_blocks), dim3(NTHREADS), args, 0, stream);
  if (e != hipSuccess) fprintf(stderr, "cooperative launch failed: %s (grid %d)\n", hipGetErrorString(e), grid_blocks);
#else
  for (int ph = 0; ph < 9; ++ph) hipLaunchKernelGGL(mega, dim3(grid_blocks), dim3(NTHREADS), 0, stream, p, ph, ph + 1);
#endif
}
```

```cpp
#include <hip/hip_runtime.h>
#include <hip/hip_cooperative_groups.h>
#include <cstdio>
namespace cg = cooperative_groups;

typedef unsigned short u16;
typedef short bf16x8 __attribute__((ext_vector_type(8)));
typedef short s16x4 __attribute__((ext_vector_type(4)));
typedef float f32x4 __attribute__((ext_vector_type(4)));
typedef float f32x2 __attribute__((ext_vector_type(2)));
typedef __bf16 bf16x2_t __attribute__((ext_vector_type(2)));
typedef _Float16 h2_t __attribute__((ext_vector_type(2)));

#define DEV __device__ __forceinline__

#define NTOK 33280
#define TP 32768
#define NTHREADS 512

#define OFF_Y_P 0
#define OFF_Y_S 33554432
#define OFF_K_P 34078720
#define OFF_V_P 101187584
#define OFF_WKV_P 168296448
#define OFF_SH_P 169345024
#define OFF_K_S 169353216
#define OFF_V_S 170401792
#define OFF_WKV_S 171450368
#define OFF_SH_S 173547520

#define SLOT 136314880ull
#define WS_W (7ull * SLOT)
#define WS_WT_IN (WS_W)
#define WS_WT_OUTA (WS_WT_IN + 16777216ull)
#define WS_WT_KV (WS_WT_OUTA + 4194304ull)
#define WS_WT_INB (WS_WT_KV + 8388608ull)
#define WS_WT_OUTB (WS_WT_INB + 8388608ull)
#define WS_W2T (WS_WT_OUTB + 4194304ull)
#define WS_A2T (WS_W2T + 262144ull)
#define WS_L1T (WS_A2T + 262144ull)
#define WS_MOD (WS_L1T + 524288ull)
#define WS_SH (WS_MOD + 589824ull)
#define WS_CTR (WS_SH + 49152ull)
#define WS_BAR (WS_CTR + 4096ull)
#define WS_END (WS_BAR + 256ull)
#define WS_H0 (6ull * SLOT)
#define WS_T (4ull * SLOT)

struct Params {
  const float* in[36];
  float* out;
  char* ws;
};

enum { I_XP = 0, I_XS, I_CK, I_CV, I_SWKV, I_SSH, I_CP, I_CS, I_ANG, I_AADAW, I_AADAB, I_AWIN, I_AMUIN, I_AMUW, I_AMUA,
       I_AW0, I_AW1, I_AW2, I_AA0, I_AA1, I_AA2, I_AKK, I_AKA, I_ARK, I_ALNG, I_ALNB, I_AWOUT, I_KVNG, I_KVW, I_KGAIN,
       I_BNG, I_BADAW, I_BADAB, I_BWIN, I_BQG, I_BWOUT };

DEV int seq_of(int t) { return t < TP ? (t >> 12) : 8 + ((t - TP) >> 5); }
DEV bool seq_start(int t) { return t < TP ? ((t & 4095) == 0) : (((t - TP) & 31) == 0); }

DEV unsigned pack2(float a, float b) {
  f32x2 v = {a, b};
  bf16x2_t r = __builtin_convertvector(v, bf16x2_t);
  return *(unsigned*)&r;
}
DEV unsigned packh2(float a, float b) {
  f32x2 v = {a, b};
  h2_t r = __builtin_convertvector(v, h2_t);
  return *(unsigned*)&r;
}
DEV float bflo(unsigned w) { return __uint_as_float(w << 16); }
DEV float bfhi(unsigned w) { return __uint_as_float(w & 0xffff0000u); }
DEV void unpack8(const uint4& x, float* f) {
  f[0] = bflo(x.x); f[1] = bfhi(x.x); f[2] = bflo(x.y); f[3] = bfhi(x.y);
  f[4] = bflo(x.z); f[5] = bfhi(x.z); f[6] = bflo(x.w); f[7] = bfhi(x.w);
}
DEV float sigmoidf_(float x) { return 1.0f / (1.0f + __expf(-x)); }

template <int CTRL>
DEV float dppf(float x) {
  return __int_as_float(__builtin_amdgcn_update_dpp(0, __float_as_int(x), CTRL, 0xf, 0xf, true));
}
DEV float red4(float x) { x += dppf<0xB1>(x); x += dppf<0x4E>(x); return x; }
DEV float red8(float x) { x = red4(x); x += dppf<0x141>(x); return x; }
DEV float red16(float x) { x = red8(x); x += dppf<0x140>(x); return x; }
DEV float wave_sum(float x) {
#pragma unroll
  for (int o = 32; o >= 1; o >>= 1) x += __shfl_xor(x, o);
  return x;
}


#define SCHED_SLOT_OFF 147440
DEV int xcc_id() { return (int)(__builtin_amdgcn_s_getreg((3 << 11) | 20) & 0x7u); }
DEV unsigned* sched_ctr(const Params& p, int phase_slot, int list) { return (unsigned*)(p.ws + WS_CTR) + (phase_slot * 8 + list) * 16; }
DEV int sched_first(unsigned* ctr, char* smem) {
  int* slot = (int*)(smem + SCHED_SLOT_OFF);
  __syncthreads();
  if (threadIdx.x == 0) *slot = (int)atomicAdd(ctr, 1u);
  __syncthreads();
  return *slot;
}

DEV void group_sync(unsigned* bar, unsigned target) {
  __syncthreads();
  if (threadIdx.x == 0) {
    __hip_atomic_fetch_add(bar, 1u, __ATOMIC_RELAXED, __HIP_MEMORY_SCOPE_AGENT);
    while (__hip_atomic_load(bar, __ATOMIC_RELAXED, __HIP_MEMORY_SCOPE_AGENT) < target) __builtin_amdgcn_s_sleep(2);
  }
  __syncthreads();
}
DEV int sched_prefetch(unsigned* ctr) { return threadIdx.x == 0 ? (int)atomicAdd(ctr, 1u) : 0; }
DEV int sched_commit(int nxt, char* smem) {
  int* slot = (int*)(smem + SCHED_SLOT_OFF);
  __syncthreads();
  if (threadIdx.x == 0) *slot = nxt;
  __syncthreads();
  return *slot;
}

#define GEMM_STAGE_BYTES 49152

template <int AMODE>
DEV void gemm_main(f32x4 (&acc)[4][4], const u16* __restrict__ A, int lda, const u16* __restrict__ Bt, int ldb, int nk,
                   int m0, int n0, const float* __restrict__ mu, const u16* __restrict__ SH, char* smem) {
  const int tid = threadIdx.x, lane = tid & 63, wid = tid >> 6, wr = wid >> 1, wc = wid & 1, fr = lane & 15, fq = lane >> 4;
  const int lrow = tid >> 3, lch = tid & 7;
#pragma unroll
  for (int i = 0; i < 4; ++i)
#pragma unroll
    for (int j = 0; j < 4; ++j) acc[i][j] = (f32x4){0.f, 0.f, 0.f, 0.f};

  const u16* pa0; const u16* pa1; const u16* pa2; const u16* pa3;
  const u16* pp0 = nullptr;
  const int arow = 4 * lrow;
  {
    int m = m0 + arow;
    pa0 = A + (size_t)m * lda + lch * 8;
    pa1 = pa0 + lda; pa2 = pa1 + lda; pa3 = pa2 + lda;
    if (AMODE != 0) pp0 = seq_start(m) ? SH + seq_of(m) * 1024 + lch * 8 : pa0 - lda;
  }
  const u16* pb0 = Bt + (size_t)(n0 + lrow) * ldb + lch * 8;
  const u16* pb1 = pb0 + (size_t)64 * ldb;
  const int woffB = lrow * 128 + ((lch ^ ((lrow >> 1) & 7)) << 4);
  const int woffA0 = (arow + 0) * 128 + ((lch ^ (((arow + 0) >> 1) & 7)) << 4);
  const int woffA1 = (arow + 1) * 128 + ((lch ^ (((arow + 1) >> 1) & 7)) << 4);
  const int woffA2 = (arow + 2) * 128 + ((lch ^ (((arow + 2) >> 1) & 7)) << 4);
  const int woffA3 = (arow + 3) * 128 + ((lch ^ (((arow + 3) >> 1) & 7)) << 4);

  uint4 ra0, ra1, ra2, ra3, rp0, rb0, rb1;
  float4 mu0, mu1;
  rp0 = make_uint4(0, 0, 0, 0);
  mu0 = mu1 = make_float4(0, 0, 0, 0);

#define G_LOAD(kt)                                                                     \
  {                                                                                    \
    const int k0_ = (kt) * 64;                                                         \
    if (AMODE == 0) {                                                                  \
      ra0 = *(const uint4*)(pa0 + k0_); ra1 = *(const uint4*)(pa1 + k0_);              \
      ra2 = *(const uint4*)(pa2 + k0_); ra3 = *(const uint4*)(pa3 + k0_);              \
    } else if (AMODE == 1) {                                                           \
      ra0 = *(const uint4*)(pa0 + k0_); ra1 = *(const uint4*)(pa1 + k0_);              \
      ra2 = *(const uint4*)(pa2 + k0_); ra3 = *(const uint4*)(pa3 + k0_);              \
      rp0 = *(const uint4*)(pp0 + k0_);                                                \
      mu0 = *(const float4*)(mu + k0_ + lch * 8); mu1 = *(const float4*)(mu + k0_ + lch * 8 + 4); \
    } else {                                                                           \
      const int kk_ = k0_ & 1023;                                                      \
      ra0 = *(const uint4*)(pa0 + kk_); ra1 = *(const uint4*)(pa1 + kk_);              \
      ra2 = *(const uint4*)(pa2 + kk_); ra3 = *(const uint4*)(pa3 + kk_);              \
      if (k0_ >= 1024) rp0 = *(const uint4*)(pp0 + kk_);                               \
    }                                                                                  \
    rb0 = *(const uint4*)(pb0 + k0_); rb1 = *(const uint4*)(pb1 + k0_);                \
  }

#define G_XFORM(dst, a_, p_, kt)                                                       \
  {                                                                                    \
    if (AMODE == 0) dst = a_;                                                          \
    else if (AMODE == 1) {                                                             \
      float h_[8], q_[8]; unpack8(a_, h_); unpack8(p_, q_);                            \
      dst.x = pack2(h_[0] + mu0.x * (q_[0] - h_[0]), h_[1] + mu0.y * (q_[1] - h_[1])); \
      dst.y = pack2(h_[2] + mu0.z * (q_[2] - h_[2]), h_[3] + mu0.w * (q_[3] - h_[3])); \
      dst.z = pack2(h_[4] + mu1.x * (q_[4] - h_[4]), h_[5] + mu1.y * (q_[5] - h_[5])); \
      dst.w = pack2(h_[6] + mu1.z * (q_[6] - h_[6]), h_[7] + mu1.w * (q_[7] - h_[7])); \
    } else {                                                                           \
      if ((kt) * 64 >= 1024) {                                                         \
        float h_[8], q_[8]; unpack8(a_, h_); unpack8(p_, q_);                          \
        dst.x = pack2(q_[0] - h_[0], q_[1] - h_[1]); dst.y = pack2(q_[2] - h_[2], q_[3] - h_[3]); \
        dst.z = pack2(q_[4] - h_[4], q_[5] - h_[5]); dst.w = pack2(q_[6] - h_[6], q_[7] - h_[7]); \
      } else dst = a_;                                                                 \
    }                                                                                  \
  }

#define G_STORE(stage, kt)                                                             \
  {                                                                                    \
    char* sA_ = smem + (stage) * GEMM_STAGE_BYTES; char* sB_ = sA_ + 32768;            \
    uint4 v_;                                                                          \
    G_XFORM(v_, ra0, rp0, kt); *(uint4*)(sA_ + woffA0) = v_;                           \
    G_XFORM(v_, ra1, ra0, kt); *(uint4*)(sA_ + woffA1) = v_;                           \
    G_XFORM(v_, ra2, ra1, kt); *(uint4*)(sA_ + woffA2) = v_;                           \
    G_XFORM(v_, ra3, ra2, kt); *(uint4*)(sA_ + woffA3) = v_;                           \
    *(uint4*)(sB_ + woffB) = rb0; *(uint4*)(sB_ + woffB + 64 * 128) = rb1;             \
  }

  G_LOAD(0);
  G_STORE(0, 0);
  __syncthreads();
  const int rsw = (fr >> 1) & 7;
  for (int kt = 0; kt < nk; ++kt) {
    const int st = kt & 1;
    if (kt + 1 < nk) G_LOAD(kt + 1);
    __builtin_amdgcn_sched_barrier(0);
    {
      const char* sA = smem + st * GEMM_STAGE_BYTES;
      const char* sB = sA + 32768;
#pragma unroll
      for (int kk = 0; kk < 2; ++kk) {
        bf16x8 af[4], bfr[4];
        const int cho = ((kk * 4 + fq) ^ rsw) << 4;
#pragma unroll
        for (int i = 0; i < 4; ++i) af[i] = *(const bf16x8*)(sA + (wr * 64 + i * 16 + fr) * 128 + cho);
#pragma unroll
        for (int j = 0; j < 4; ++j) bfr[j] = *(const bf16x8*)(sB + (wc * 64 + j * 16 + fr) * 128 + cho);
#pragma unroll
        for (int i = 0; i < 4; ++i)
#pragma unroll
          for (int j = 0; j < 4; ++j) acc[i][j] = __builtin_amdgcn_mfma_f32_16x16x32_bf16(bfr[j], af[i], acc[i][j], 0, 0, 0);
      }
    }
    if (kt + 1 < nk) G_STORE(st ^ 1, kt + 1);
    __syncthreads();
  }
#undef G_LOAD
#undef G_XFORM
#undef G_STORE
}


#define G2_STAGE_BYTES 32768
#define G2_MU_OFF (3 * G2_STAGE_BYTES)
DEV int g2_swz(int row) { return (0x78 >> (2 * ((row >> 2) & 3))) & 3; }
template <int AMODE>
DEV void gemm_main256(f32x4 (&acc)[8][4], const u16* __restrict__ A, int lda, const u16* __restrict__ Bt, int ldb, int nk64,
                      int m0, int n0, const float* __restrict__ mu, const u16* __restrict__ SH, char* smem) {
  const int tid = threadIdx.x, lane = tid & 63, wid = tid >> 6, wr = wid >> 2, wc = wid & 3, fr = lane & 15, fq = lane >> 4;
  const int nk = nk64 * 2;
  const int lrow2 = 2 * (tid >> 2), lch = tid & 3;
#pragma unroll
  for (int i = 0; i < 8; ++i)
#pragma unroll
    for (int j = 0; j < 4; ++j) acc[i][j] = (f32x4){0.f, 0.f, 0.f, 0.f};
  const u16* pa0 = A + (size_t)(m0 + lrow2) * lda + lch * 8;
  const u16* pp0 = nullptr;
  if (AMODE != 0) pp0 = seq_start(m0 + lrow2) ? SH + seq_of(m0 + lrow2) * 1024 + lch * 8 : pa0 - lda;
  const u16* pb0 = Bt + (size_t)(n0 + lrow2) * ldb + lch * 8;
  const int woff0 = (lrow2 + 0) * 64 + ((lch ^ g2_swz(lrow2 + 0)) << 4);
  const int woff1 = (lrow2 + 1) * 64 + ((lch ^ g2_swz(lrow2 + 1)) << 4);
  const float* muL = (const float*)(smem + G2_MU_OFF);
  if (AMODE == 1) {
    if (tid < 256) *(float4*)(smem + G2_MU_OFF + tid * 16) = *(const float4*)(mu + tid * 4);
  }
  uint4 xa0, xa1, xp, xb0, xb1;
  uint4 ya0, ya1, yp, yb0, yb1;
  xp = yp = make_uint4(0, 0, 0, 0);

#define K_LOAD(S, kt)                                                                  \
  {                                                                                    \
    const int k0_ = (kt) * 32;                                                         \
    S##a0 = *(const uint4*)(pa0 + k0_); S##a1 = *(const uint4*)(pa0 + lda + k0_);      \
    if (AMODE == 1) S##p = *(const uint4*)(pp0 + k0_);                                 \
    S##b0 = *(const uint4*)(pb0 + k0_); S##b1 = *(const uint4*)(pb0 + ldb + k0_);      \
  }
#define K_XFORM(dst, a_, p_)                                                           \
  {                                                                                    \
    if (AMODE == 0) dst = a_;                                                          \
    else {                                                                             \
      float h_[8], q_[8]; unpack8(a_, h_); unpack8(p_, q_);                            \
      dst.x = pack2(h_[0] + mu0.x * (q_[0] - h_[0]), h_[1] + mu0.y * (q_[1] - h_[1])); \
      dst.y = pack2(h_[2] + mu0.z * (q_[2] - h_[2]), h_[3] + mu0.w * (q_[3] - h_[3])); \
      dst.z = pack2(h_[4] + mu1.x * (q_[4] - h_[4]), h_[5] + mu1.y * (q_[5] - h_[5])); \
      dst.w = pack2(h_[6] + mu1.z * (q_[6] - h_[6]), h_[7] + mu1.w * (q_[7] - h_[7])); \
    }                                                                                  \
  }
#define K_STORE(S, stage, kt)                                                          \
  {                                                                                    \
    char* sA_ = smem + (stage) * G2_STAGE_BYTES; char* sB_ = sA_ + 16384;              \
    uint4 v_; float4 mu0, mu1;                                                         \
    if (AMODE == 1) { mu0 = *(const float4*)(muL + (kt) * 32 + lch * 8); mu1 = *(const float4*)(muL + (kt) * 32 + lch * 8 + 4); } \
    K_XFORM(v_, S##a0, S##p); *(uint4*)(sA_ + woff0) = v_;                             \
    K_XFORM(v_, S##a1, S##a0); *(uint4*)(sA_ + woff1) = v_;                            \
    *(uint4*)(sB_ + woff0) = S##b0; *(uint4*)(sB_ + woff1) = S##b1;                    \
  }
#define K_COMPUTE_HALF(stage, i0)                                                      \
  {                                                                                    \
    const char* sA_ = smem + (stage) * G2_STAGE_BYTES;                                 \
    _Pragma("unroll") for (int i = (i0); i < (i0) + 4; ++i) {                          \
      const bf16x8 af = *(const bf16x8*)(sA_ + (wr * 128 + i * 16 + fr) * 64 + cho);   \
      _Pragma("unroll") for (int j = 0; j < 4; ++j) acc[i][j] = __builtin_amdgcn_mfma_f32_16x16x32_bf16(bfr[j], af, acc[i][j], 0, 0, 0); \
    }                                                                                  \
  }
#define K_LOAD_B(stage)                                                                \
  {                                                                                    \
    const char* sB_ = smem + (stage) * G2_STAGE_BYTES + 16384;                         \
    _Pragma("unroll") for (int j = 0; j < 4; ++j) bfr[j] = *(const bf16x8*)(sB_ + (wc * 64 + j * 16 + fr) * 64 + cho); \
  }
#define K_ITER(kt, L, S)                                                               \
  {                                                                                    \
    K_LOAD(L, min((kt) + 2, nk - 1));                                                  \
    __builtin_amdgcn_sched_barrier(0);                                                 \
    bf16x8 bfr[4];                                                                     \
    K_LOAD_B(cu);                                                                      \
    K_COMPUTE_HALF(cu, 0);                                                             \
    __builtin_amdgcn_sched_barrier(0);                                                 \
    K_STORE(S, nx, min((kt) + 1, nk - 1));                                             \
    __builtin_amdgcn_sched_barrier(0);                                                 \
    if (AMODE == 1) K_LOAD_B(cu);                                                      \
    K_COMPUTE_HALF(cu, 4);                                                             \
    __syncthreads();                                                                   \
    cu = nx; nx = (nx == 2) ? 0 : nx + 1;                                              \
  }
  const int cho = (fq ^ g2_swz(fr)) << 4;
  if (AMODE == 1) __syncthreads();
  K_LOAD(x, 0);
  K_LOAD(y, 1);
  K_STORE(x, 0, 0);
  __syncthreads();
  int cu = 0, nx = 1;
  for (int kt = 0; kt < nk; kt += 2) {
    K_ITER(kt, x, y);
    K_ITER(kt + 1, y, x);
  }
#undef K_LOAD
#undef K_XFORM
#undef K_STORE
#undef K_COMPUTE_HALF
#undef K_LOAD_B
#undef K_ITER
}


#define GD_NST 4
DEV void gemm_main256_dma(f32x4 (&acc)[8][4], const u16* __restrict__ A, int lda, const u16* __restrict__ Bt, int ldb, int nk64,
                          int m0, int n0, char* smem) {
  const int tid = threadIdx.x, lane = tid & 63, wid = tid >> 6, wr = wid >> 2, wc = wid & 3, fr = lane & 15, fq = lane >> 4;
  const int nk = nk64 * 2;
#pragma unroll
  for (int i = 0; i < 8; ++i)
#pragma unroll
    for (int j = 0; j < 4; ++j) acc[i][j] = (f32x4){0.f, 0.f, 0.f, 0.f};
  const int prow = 16 * wid + (lane >> 2);
  const int pch = (lane & 3) ^ g2_swz(prow);
  const u16* srcA = A + (size_t)(m0 + prow) * lda + pch * 8;
  const u16* srcB = Bt + (size_t)(n0 + prow) * ldb + pch * 8;
  const size_t a128 = (size_t)128 * lda, b128 = (size_t)128 * ldb;
  char* ldsw = smem + (16 * wid) * 64;
#define D_FILL(kt, stage)                                                              \
  {                                                                                    \
    const int k0_ = (kt) * 32;                                                         \
    char* d_ = ldsw + (stage) * G2_STAGE_BYTES;                                        \
    __builtin_amdgcn_global_load_lds((const unsigned*)(srcA + k0_), (unsigned*)(d_), 16, 0, 0);               \
    __builtin_amdgcn_global_load_lds((const unsigned*)(srcA + a128 + k0_), (unsigned*)(d_ + 8192), 16, 0, 0); \
    __builtin_amdgcn_global_load_lds((const unsigned*)(srcB + k0_), (unsigned*)(d_ + 16384), 16, 0, 0);       \
    __builtin_amdgcn_global_load_lds((const unsigned*)(srcB + b128 + k0_), (unsigned*)(d_ + 16384 + 8192), 16, 0, 0); \
  }
  const int cho = (fq ^ g2_swz(fr)) << 4;
  __syncthreads();
  D_FILL(0, 0);
  D_FILL(min(1, nk - 1), 1);
  D_FILL(min(2, nk - 1), 2);
  int cu = 0, fill = 3;
  for (int kt = 0; kt < nk; ++kt) {
    asm volatile("s_waitcnt vmcnt(8)" ::: "memory");
    asm volatile("s_waitcnt lgkmcnt(0)" ::: "memory");
    __builtin_amdgcn_s_barrier();
    D_FILL(min(kt + 3, nk - 1), fill);
    {
      const char* sA_ = smem + cu * G2_STAGE_BYTES;
      const char* sB_ = sA_ + 16384;
      bf16x8 bfr[4];
#pragma unroll
      for (int j = 0; j < 4; ++j) bfr[j] = *(const bf16x8*)(sB_ + (wc * 64 + j * 16 + fr) * 64 + cho);
#pragma unroll
      for (int i = 0; i < 8; ++i) {
        const bf16x8 af = *(const bf16x8*)(sA_ + (wr * 128 + i * 16 + fr) * 64 + cho);
#pragma unroll
        for (int j = 0; j < 4; ++j) acc[i][j] = __builtin_amdgcn_mfma_f32_16x16x32_bf16(bfr[j], af, acc[i][j], 0, 0, 0);
      }
    }
    cu = (cu == GD_NST - 1) ? 0 : cu + 1;
    fill = (fill == GD_NST - 1) ? 0 : fill + 1;
  }
  asm volatile("s_waitcnt vmcnt(0)" ::: "memory");
  asm volatile("s_waitcnt lgkmcnt(0)" ::: "memory");
  __builtin_amdgcn_s_barrier();
#undef D_FILL
}

DEV void transpose_tile(const float* __restrict__ src, int N, int k0, int n0, const float* __restrict__ scale, u16* __restrict__ dst,
                        int dstride, int drow0, int dcol0, char* smem) {
  float* tile = (float*)smem;
  const int tid = threadIdx.x;
#pragma unroll
  for (int i = 0; i < 2; ++i) {
    int kl = (tid >> 4) + 32 * i, n4 = (tid & 15) * 4;
    float4 v = *(const float4*)(src + (size_t)(k0 + kl) * N + n0 + n4);
    float s = scale ? scale[k0 + kl] : 1.0f;
    tile[kl * 65 + n4 + 0] = v.x * s; tile[kl * 65 + n4 + 1] = v.y * s;
    tile[kl * 65 + n4 + 2] = v.z * s; tile[kl * 65 + n4 + 3] = v.w * s;
  }
  __syncthreads();
  {
    int nl = tid >> 3, k8 = (tid & 7) * 8;
    uint4 o;
    o.x = pack2(tile[(k8 + 0) * 65 + nl], tile[(k8 + 1) * 65 + nl]);
    o.y = pack2(tile[(k8 + 2) * 65 + nl], tile[(k8 + 3) * 65 + nl]);
    o.z = pack2(tile[(k8 + 4) * 65 + nl], tile[(k8 + 5) * 65 + nl]);
    o.w = pack2(tile[(k8 + 6) * 65 + nl], tile[(k8 + 7) * 65 + nl]);
    *(uint4*)(dst + (size_t)(drow0 + n0 + nl) * dstride + dcol0 + k0 + k8) = o;
  }
  __syncthreads();
}

DEV void phase_prep(const Params& p, char* smem) {
  const int tid = threadIdx.x;
  char* ws = p.ws;
  if (blockIdx.x < 96) {
    float* cL = (float*)smem;
    float* red = (float*)(smem + 98304);
    for (int e = tid; e < 24 * 256; e += NTHREADS) {
      int s = e >> 8, k4 = (e & 255) * 4;
      float4 v = s < 8 ? *(const float4*)(p.in[I_CP] + s * 1024 + k4) : *(const float4*)(p.in[I_CS] + (s - 8) * 1024 + k4);
      *(float4*)(cL + s * 1024 + k4) = v;
    }
    __syncthreads();
    for (int item = blockIdx.x; item < 96; item += gridDim.x) {
      const int l = item / 48, j0 = (item % 48) * 64;
      const float* W = (l == 0 ? p.in[I_AADAW] : p.in[I_BADAW]);
      const float* bias = (l == 0 ? p.in[I_AADAB] : p.in[I_BADAB]);
      const int col = tid & 63, kg = tid >> 6;
      float acc[24];
#pragma unroll
      for (int s = 0; s < 24; ++s) acc[s] = 0.f;
      for (int k = kg * 128; k < kg * 128 + 128; ++k) {
        float w = W[(size_t)k * 3072 + j0 + col];
#pragma unroll
        for (int s = 0; s < 24; ++s) acc[s] += cL[s * 1024 + k] * w;
      }
#pragma unroll
      for (int s = 0; s < 24; ++s) red[(kg * 24 + s) * 64 + col] = acc[s];
      __syncthreads();
      float* mod = (float*)(ws + WS_MOD);
      for (int e = tid; e < 24 * 64; e += NTHREADS) {
        int s = e >> 6, c = e & 63;
        float t = bias[j0 + c];
#pragma unroll
        for (int g = 0; g < 8; ++g) t += red[(g * 24 + s) * 64 + c];
        mod[(size_t)(l * 24 + s) * 3072 + j0 + c] = t;
      }
      __syncthreads();
    }
  }
  if (blockIdx.x == 0) for (int e = tid; e < 1024; e += NTHREADS) ((unsigned*)(ws + WS_CTR))[e] = 0u;
  if (blockIdx.x == gridDim.x - 1) {
    u16* SH = (u16*)(ws + WS_SH);
    for (int e = tid; e < 24 * 1024; e += NTHREADS) {
      int s = e >> 10, k = e & 1023;
      float v = s < 8 ? 0.f : p.in[I_SSH][(s - 8) * 1024 + k];
      SH[e] = (u16)(pack2(v, 0.f) & 0xffff);
    }
  }
  const int NT_TOTAL = 2048 + 512 + 1024 + 1024 + 512 + 32 + 32 + 64;
  for (int t = blockIdx.x; t < NT_TOTAL; t += gridDim.x) {
    const float* src; int K, N; u16* dst; int dstride, drow0 = 0, dcol0 = 0; const float* scale = nullptr; int tt = t;
    if (tt < 2048) { src = p.in[I_AWIN]; K = 1024; N = 8192; dst = (u16*)(ws + WS_WT_IN); dstride = 1024; }
    else if ((tt -= 2048) < 512) { src = p.in[I_AWOUT]; K = 2048; N = 1024; dst = (u16*)(ws + WS_WT_OUTA); dstride = 2048; }
    else if ((tt -= 512) < 1024) { src = p.in[I_KVW]; K = 1024; N = 4096; dst = (u16*)(ws + WS_WT_KV); dstride = 1024; }
    else if ((tt -= 1024) < 1024) { src = p.in[I_BWIN]; K = 1024; N = 4096; dst = (u16*)(ws + WS_WT_INB); dstride = 1024; }
    else if ((tt -= 1024) < 512) { src = p.in[I_BWOUT]; K = 2048; N = 1024; dst = (u16*)(ws + WS_WT_OUTB); dstride = 2048; }
    else if ((tt -= 512) < 32) { src = p.in[I_AW2]; K = 64; N = 2048; dst = (u16*)(ws + WS_W2T); dstride = 64; }
    else if ((tt -= 32) < 32) { src = p.in[I_AA2]; K = 64; N = 2048; dst = (u16*)(ws + WS_A2T); dstride = 64; }
    else {
      tt -= 32;
      int job = tt >> 4; tt &= 15;
      K = 1024; N = 64; dst = (u16*)(ws + WS_L1T); dstride = 2048;
      src = (job < 2) ? p.in[I_AW1] : p.in[I_AA1];
      drow0 = (job < 2) ? 0 : 64;
      if (job & 1) { dcol0 = 1024; scale = (job < 2) ? p.in[I_AMUW] : p.in[I_AMUA]; }
    }
    const int ntn = N / 64;
    const int kt = tt / ntn, nt = tt % ntn;
    transpose_tile(src, N, kt * 64, nt * 64, scale, dst, dstride, drow0, dcol0, smem);
  }
}

DEV void phase_norm0(const Params& p) {
  const int lane = threadIdx.x & 63, wid = threadIdx.x >> 6;
  const float* mod = (const float*)(p.ws + WS_MOD);
  u16* H0 = (u16*)(p.ws + WS_H0);
  const float* g = p.in[I_ANG];
  for (int t = blockIdx.x * 8 + wid; t < NTOK; t += gridDim.x * 8) {
    const float* x = t < TP ? p.in[I_XP] + (size_t)t * 1024 : p.in[I_XS] + (size_t)(t - TP) * 1024;
    const int s = seq_of(t);
    const float* md = mod + (size_t)s * 3072;
    float4 v[4];
    float ss = 0.f;
#pragma unroll
    for (int i = 0; i < 4; ++i) {
      v[i] = *(const float4*)(x + lane * 4 + 256 * i);
      ss += v[i].x * v[i].x + v[i].y * v[i].y + v[i].z * v[i].z + v[i].w * v[i].w;
    }
    ss = wave_sum(ss);
    const float rstd = rsqrtf(ss * (1.0f / 1024.0f) + 1e-6f);
    bool last = t < TP ? ((t & 4095) == 4095) : (((t - TP) & 31) == 31);
    float* so = t < TP ? p.out + OFF_SH_P + (t >> 12) * 1024 : p.out + OFF_SH_S + ((t - TP) >> 5) * 1024;
#pragma unroll
    for (int i = 0; i < 4; ++i) {
      const int c = lane * 4 + 256 * i;
      float4 gg = *(const float4*)(g + c), sh = *(const float4*)(md + c), sc = *(const float4*)(md + 1024 + c);
      float4 h;
      h.x = v[i].x * rstd * gg.x * (1.f + sc.x) + sh.x;
      h.y = v[i].y * rstd * gg.y * (1.f + sc.y) + sh.y;
      h.z = v[i].z * rstd * gg.z * (1.f + sc.z) + sh.z;
      h.w = v[i].w * rstd * gg.w * (1.f + sc.w) + sh.w;
      uint2 o; o.x = pack2(h.x, h.y); o.y = pack2(h.z, h.w);
      *(uint2*)(H0 + (size_t)t * 1024 + c) = o;
      if (last) *(float4*)(so + c) = h;
    }
  }
}

DEV void phase_proj0_lora(const Params& p, char* smem) {
  const int tid = threadIdx.x, lane = tid & 63, wid = tid >> 6, fr = lane & 15, fq = lane >> 4;
  const int wr = wid >> 1, wc = wid & 1;
  char* ws = p.ws;
  const u16* H0 = (const u16*)(ws + WS_H0);
  const u16* SH = (const u16*)(ws + WS_SH);
  u16* T = (u16*)(ws + WS_T);
  const int xcc0 = xcc_id();
  int nxt;
  f32x4 acc[4][4];
  for (int ls = 0; ls < 8; ++ls) {
  const int xcd = (xcc0 + ls) & 7;
  unsigned* ctr = sched_ctr(p, 0, xcd);
  for (int li = sched_first(ctr, smem); li < 17; li = sched_commit(nxt, smem)) {
    nxt = sched_prefetch(ctr);
    const int lmt = xcd + 8 * li;
    if (lmt >= 130) continue;
    const int m0 = lmt * 256;
    gemm_main<2>(acc, H0, 1024, (const u16*)(ws + WS_L1T), 2048, 32, m0, 0, nullptr, SH, smem);
#pragma unroll
    for (int i = 0; i < 4; ++i)
#pragma unroll
      for (int j = 0; j < 4; ++j) {
        const int m = m0 + wr * 64 + i * 16 + fr, n = wc * 64 + j * 16 + fq * 4;
        f32x4 v = acc[i][j];
        if (wc == 0) { v[0] = tanhf(v[0]); v[1] = tanhf(v[1]); v[2] = tanhf(v[2]); v[3] = tanhf(v[3]); }
        uint2 o; o.x = pack2(v[0], v[1]); o.y = pack2(v[2], v[3]);
        *(uint2*)(T + (size_t)m * 128 + n) = o;
      }
  }
  }
}

DEV void phase_proj0_main(const Params& p, char* smem) {
  const int tid = threadIdx.x, lane = tid & 63, wid = tid >> 6, fr = lane & 15, fq = lane >> 4;
  const int wr = wid >> 2, wc = wid & 3;
  char* ws = p.ws;
  const u16* H0 = (const u16*)(ws + WS_H0);
  const u16* SH = (const u16*)(ws + WS_SH);
  const int xcc0 = xcc_id();
  int nxt;
  f32x4 acc[8][4];
  for (int ls = 0; ls < 8; ++ls) {
  const int xcd = (xcc0 + ls) & 7;
  unsigned* ctr = sched_ctr(p, 4, xcd);
  for (int q = sched_first(ctr, smem); q < 520; q = sched_commit(nxt, smem)) {
    nxt = sched_prefetch(ctr);
    const int mt = q >> 2, nt = 4 * xcd + (q & 3);
    const int part = nt >> 3;
    const int m0 = mt * 256, n0 = nt * 256;
    gemm_main256<1>(acc, H0, 1024, (const u16*)(ws + WS_WT_IN), 1024, 16, m0, n0, p.in[I_AMUIN] + part * 1024, SH, smem);
    u16* dst = (u16*)(ws + (size_t)part * SLOT);
    const int nb = n0 - part * 2048;
#pragma unroll
    for (int i = 0; i < 8; ++i)
#pragma unroll
      for (int j = 0; j < 4; ++j) {
        const int m = m0 + wr * 128 + i * 16 + fr, n = nb + wc * 64 + j * 16 + fq * 4;
        f32x4 v = acc[i][j];
        uint2 o; o.x = pack2(v[0], v[1]); o.y = pack2(v[2], v[3]);
        *(uint2*)(dst + (size_t)m * 2048 + n) = o;
      }
  }
  }
}

DEV void phase_proj0(const Params& p, char* smem) {
  phase_proj0_lora(p, smem);
  phase_proj0_main(p, smem);
}

DEV void phase_scan(const Params& p, char* smem) {
  const int tid = threadIdx.x, lane = tid & 63, wid = tid >> 6;
  u16* Hkk = (u16*)smem;
  u16* Hw = Hkk + 4096;
  u16* Hb = Hw + 4096;
  u16* Hk = Hb + 4096;
  u16* Hwr = Hk + 4096;
  unsigned* Hv2 = (unsigned*)(smem + 40960);
  float* LY = (float*)(smem + 57344);
  float* Lbon = LY + 8192;
  float* Lsc = Lbon + 64;
  float* Lwa = Lsc + 128;
  char* ws = p.ws;
  const u16* gR = (const u16*)(ws + 0 * SLOT);
  const u16* gK = (const u16*)(ws + 1 * SLOT);
  const u16* gV = (const u16*)(ws + 2 * SLOT);
  const u16* gZ = (const u16*)(ws + 3 * SLOT);
  const u16* gT = (const u16*)(ws + WS_T);
  const u16* W2T = (const u16*)(ws + WS_W2T);
  const u16* A2T = (const u16*)(ws + WS_A2T);
  const int fr = lane & 15, fq = lane >> 4, lmt = wid & 3, lnh = wid >> 2;
  u16* YG = (u16*)(ws + 6 * SLOT);
  const int tt = tid >> 3, c8 = (tid & 7) * 8;
  const int srow = tid >> 3, kc = tid & 7;

  for (int item = blockIdx.x; item < 768; item += gridDim.x) {
    int h, tok0, nsteps; const float* sinit; float* sout;
    if (item < 256) { h = item & 31; tok0 = (item >> 5) * 4096; nsteps = 4096; sinit = nullptr; sout = p.out + OFF_WKV_P + (size_t)item * 4096; }
    else { int it = item - 256; h = it & 31; tok0 = TP + (it >> 5) * 32; nsteps = 32; sinit = p.in[I_SWKV] + (size_t)it * 4096; sout = p.out + OFF_WKV_S + (size_t)it * 4096; }
    const int nch = (nsteps + 63) >> 6;
    const int col0 = h * 64 + c8;
    float ckk[8], cka[8], crk[8], clg[8], clb[8];
    {
      float4 t0, t1;
      t0 = *(const float4*)(p.in[I_AKK] + col0); t1 = *(const float4*)(p.in[I_AKK] + col0 + 4);
      ckk[0] = t0.x; ckk[1] = t0.y; ckk[2] = t0.z; ckk[3] = t0.w; ckk[4] = t1.x; ckk[5] = t1.y; ckk[6] = t1.z; ckk[7] = t1.w;
      t0 = *(const float4*)(p.in[I_AKA] + col0); t1 = *(const float4*)(p.in[I_AKA] + col0 + 4);
      cka[0] = t0.x; cka[1] = t0.y; cka[2] = t0.z; cka[3] = t0.w; cka[4] = t1.x; cka[5] = t1.y; cka[6] = t1.z; cka[7] = t1.w;
      t0 = *(const float4*)(p.in[I_ARK] + col0); t1 = *(const float4*)(p.in[I_ARK] + col0 + 4);
      crk[0] = t0.x; crk[1] = t0.y; crk[2] = t0.z; crk[3] = t0.w; crk[4] = t1.x; crk[5] = t1.y; crk[6] = t1.z; crk[7] = t1.w;
      t0 = *(const float4*)(p.in[I_ALNG] + col0); t1 = *(const float4*)(p.in[I_ALNG] + col0 + 4);
      clg[0] = t0.x; clg[1] = t0.y; clg[2] = t0.z; clg[3] = t0.w; clg[4] = t1.x; clg[5] = t1.y; clg[6] = t1.z; clg[7] = t1.w;
      t0 = *(const float4*)(p.in[I_ALNB] + col0); t1 = *(const float4*)(p.in[I_ALNB] + col0 + 4);
      clb[0] = t0.x; clb[1] = t0.y; clb[2] = t0.z; clb[3] = t0.w; clb[4] = t1.x; clb[5] = t1.y; clb[6] = t1.z; clb[7] = t1.w;
    }
    float cw0[8], ca0[8];
    {
      float4 t0 = *(const float4*)(p.in[I_AW0] + col0), t1 = *(const float4*)(p.in[I_AW0] + col0 + 4);
      cw0[0] = t0.x; cw0[1] = t0.y; cw0[2] = t0.z; cw0[3] = t0.w; cw0[4] = t1.x; cw0[5] = t1.y; cw0[6] = t1.z; cw0[7] = t1.w;
      t0 = *(const float4*)(p.in[I_AA0] + col0); t1 = *(const float4*)(p.in[I_AA0] + col0 + 4);
      ca0[0] = t0.x; ca0[1] = t0.y; ca0[2] = t0.z; ca0[3] = t0.w; ca0[4] = t1.x; ca0[5] = t1.y; ca0[6] = t1.z; ca0[7] = t1.w;
    }
    bf16x8 w2f[2][2], a2f[2][2];
#pragma unroll
    for (int n2 = 0; n2 < 2; ++n2)
#pragma unroll
      for (int ks = 0; ks < 2; ++ks) {
        const size_t o_ = (size_t)(h * 64 + lnh * 32 + n2 * 16 + fr) * 64 + ks * 32 + fq * 8;
        w2f[n2][ks] = *(const bf16x8*)(W2T + o_);
        a2f[n2][ks] = *(const bf16x8*)(A2T + o_);
      }
    h2_t sa_, sb_, sc_, sd_;
    if (sinit) {
      float4 a = *(const float4*)(sinit + srow * 64 + kc * 8), b = *(const float4*)(sinit + srow * 64 + kc * 8 + 4);
      sa_ = (h2_t){(_Float16)a.x, (_Float16)a.y}; sb_ = (h2_t){(_Float16)a.z, (_Float16)a.w};
      sc_ = (h2_t){(_Float16)b.x, (_Float16)b.y}; sd_ = (h2_t){(_Float16)b.z, (_Float16)b.w};
    } else {
      sa_ = sb_ = sc_ = sd_ = (h2_t){(_Float16)0.f, (_Float16)0.f};
    }
    uint4 cr, ck, cv, cz;
    bf16x8 t1f[2], t2f[2];
#define SCAN_LOAD(c)                                                                   \
    {                                                                                  \
      const int tl_ = (c) * 64 + tt;                                                   \
      if (tl_ < nsteps) {                                                              \
        const size_t o_ = (size_t)(tok0 + tl_) * 2048 + col0;                          \
        cr = *(const uint4*)(gR + o_); ck = *(const uint4*)(gK + o_); cv = *(const uint4*)(gV + o_); \
        cz = *(const uint4*)(gZ + o_);                                                 \
      } else { cr = ck = cv = cz = make_uint4(0, 0, 0, 0); }                           \
      const int tm_ = (c) * 64 + lmt * 16 + fr;                                        \
      if (tm_ < nsteps) {                                                              \
        const u16* tp_ = gT + (size_t)(tok0 + tm_) * 128 + fq * 8;                     \
        t1f[0] = *(const bf16x8*)(tp_); t1f[1] = *(const bf16x8*)(tp_ + 32);           \
        t2f[0] = *(const bf16x8*)(tp_ + 64); t2f[1] = *(const bf16x8*)(tp_ + 96);      \
      } else { t1f[0] = t1f[1] = t2f[0] = t2f[1] = (bf16x8){0, 0, 0, 0, 0, 0, 0, 0}; } \
    }
    SCAN_LOAD(0);
    for (int c = 0; c < nch; ++c) {
      {
#pragma unroll
        for (int n2 = 0; n2 < 2; ++n2) {
          f32x4 xw = {0.f, 0.f, 0.f, 0.f}, xa = {0.f, 0.f, 0.f, 0.f};
          xw = __builtin_amdgcn_mfma_f32_16x16x32_bf16(w2f[n2][0], t1f[0], xw, 0, 0, 0);
          xw = __builtin_amdgcn_mfma_f32_16x16x32_bf16(w2f[n2][1], t1f[1], xw, 0, 0, 0);
          xa = __builtin_amdgcn_mfma_f32_16x16x32_bf16(a2f[n2][0], t2f[0], xa, 0, 0, 0);
          xa = __builtin_amdgcn_mfma_f32_16x16x32_bf16(a2f[n2][1], t2f[1], xa, 0, 0, 0);
          const int o_ = (lmt * 16 + fr) * 64 + lnh * 32 + n2 * 16 + fq * 4;
          *(float4*)(Lwa + o_) = make_float4(xw[0], xw[1], xw[2], xw[3]);
          *(float4*)(Lwa + 4096 + o_) = make_float4(xa[0], xa[1], xa[2], xa[3]);
        }
      }
      __syncthreads();
      uint4 zc = cz;
      {
        float r[8], k[8], v[8], lw[8], a[8];
        unpack8(cr, r); unpack8(ck, k); unpack8(cv, v);
        {
          const float4 x0 = *(const float4*)(Lwa + tt * 64 + c8), x1 = *(const float4*)(Lwa + tt * 64 + c8 + 4);
          const float4 y0 = *(const float4*)(Lwa + 4096 + tt * 64 + c8), y1 = *(const float4*)(Lwa + 4096 + tt * 64 + c8 + 4);
          const float xw_[8] = {x0.x, x0.y, x0.z, x0.w, x1.x, x1.y, x1.z, x1.w};
          const float xa_[8] = {y0.x, y0.y, y0.z, y0.w, y1.x, y1.y, y1.z, y1.w};
#pragma unroll
          for (int j = 0; j < 8; ++j) {
            lw[j] = -0.60653066f * sigmoidf_(cw0[j] + xw_[j]);
            a[j] = sigmoidf_(ca0[j] + xa_[j]);
          }
        }
        float kkv[8], kp[8], w[8], bon = 0.f, ss = 0.f, kr = 0.f;
#pragma unroll
        for (int j = 0; j < 8; ++j) {
          kkv[j] = k[j] * ckk[j]; ss += kkv[j] * kkv[j];
          kp[j] = k[j] * (1.f + (a[j] - 1.f) * cka[j]);
          bon += r[j] * kp[j] * crk[j];
          kr += r[j] * kp[j];
          w[j] = __expf(lw[j]);
        }
        ss = red8(ss); bon = red8(bon); kr = red8(kr);
        const float inv = rsqrtf(ss + 1e-12f);
        float bb[8], br = 0.f;
#pragma unroll
        for (int j = 0; j < 8; ++j) { kkv[j] *= inv; bb[j] = kkv[j] * a[j]; br += bb[j] * r[j]; }
        br = red8(br);
        const int ho = tt * 64 + c8;
        *(uint4*)(Hkk + ho) = make_uint4(packh2(kkv[0], kkv[1]), packh2(kkv[2], kkv[3]), packh2(kkv[4], kkv[5]), packh2(kkv[6], kkv[7]));
        *(uint4*)(Hb + ho) = make_uint4(packh2(bb[0], bb[1]), packh2(bb[2], bb[3]), packh2(bb[4], bb[5]), packh2(bb[6], bb[7]));
        *(uint4*)(Hw + ho) = make_uint4(packh2(w[0], w[1]), packh2(w[2], w[3]), packh2(w[4], w[5]), packh2(w[6], w[7]));
        *(uint4*)(Hk + ho) = make_uint4(packh2(kp[0], kp[1]), packh2(kp[2], kp[3]), packh2(kp[4], kp[5]), packh2(kp[6], kp[7]));
        *(uint4*)(Hwr + ho) = make_uint4(packh2(w[0] * r[0], w[1] * r[1]), packh2(w[2] * r[2], w[3] * r[3]), packh2(w[4] * r[4], w[5] * r[5]), packh2(w[6] * r[6], w[7] * r[7]));
        *(uint4*)(Hv2 + ho) = make_uint4(packh2(v[0], v[0]), packh2(v[1], v[1]), packh2(v[2], v[2]), packh2(v[3], v[3]));
        *(uint4*)(Hv2 + ho + 4) = make_uint4(packh2(v[4], v[4]), packh2(v[5], v[5]), packh2(v[6], v[6]), packh2(v[7], v[7]));
        if ((tid & 7) == 0) { Lbon[tt] = bon; *(float2*)(Lsc + tt * 2) = make_float2(br, kr); }
      }
      __syncthreads();
      if (c + 1 < nch) SCAN_LOAD(c + 1);
      {
        const int nT = min(64, nsteps - c * 64);
        const u16* pk = Hkk + kc * 8; const u16* pw = Hw + kc * 8; const u16* pb = Hb + kc * 8;
        const u16* pkp = Hk + kc * 8; const u16* pwr = Hwr + kc * 8; const unsigned* pv = Hv2 + srow;
        float* py = LY + srow * 2;
#define SCAN_LD(S, o)                                                                  \
        S##kk = *(const uint4*)(pk + (o)); S##w = *(const uint4*)(pw + (o)); S##b = *(const uint4*)(pb + (o)); \
        S##k = *(const uint4*)(pkp + (o)); S##wr = *(const uint4*)(pwr + (o)); S##v = pv[(o)];
#define H2(x) (*(const h2_t*)&(x))
#define SCAN_UPD(sreg, S, c)                                                           \
        sreg = __builtin_elementwise_fma(sreg, H2(S##w.c), __builtin_elementwise_fma(-n_, H2(S##b.c), H2(S##v) * H2(S##k.c)));
#define SCAN_STEP(S, o)                                                                \
        {                                                                              \
          float d = __builtin_amdgcn_fdot2(sa_, H2(S##kk.x), 0.f, false);              \
          float e = __builtin_amdgcn_fdot2(sa_, H2(S##wr.x), 0.f, false);              \
          d = __builtin_amdgcn_fdot2(sb_, H2(S##kk.y), d, false); e = __builtin_amdgcn_fdot2(sb_, H2(S##wr.y), e, false); \
          d = __builtin_amdgcn_fdot2(sc_, H2(S##kk.z), d, false); e = __builtin_amdgcn_fdot2(sc_, H2(S##wr.z), e, false); \
          d = __builtin_amdgcn_fdot2(sd_, H2(S##kk.w), d, false); e = __builtin_amdgcn_fdot2(sd_, H2(S##wr.w), e, false); \
          d += dppf<0xB1>(d); e += dppf<0xB1>(e);                                      \
          d += dppf<0x4E>(d); e += dppf<0x4E>(e);                                      \
          d += dppf<0x141>(d); e += dppf<0x141>(e);                                    \
          const unsigned nu_ = packh2(d, d);                                           \
          const h2_t n_ = H2(nu_);                                                     \
          SCAN_UPD(sa_, S, x) SCAN_UPD(sb_, S, y) SCAN_UPD(sc_, S, z) SCAN_UPD(sd_, S, w) \
          if (kc == 0) *(float2*)(py + 2 * (o)) = make_float2(e, d);                   \
        }
        uint4 Akk, Aw, Ab, Ak, Awr, Bkk, Bw, Bb, Bk, Bwr; unsigned Av, Bv;
        SCAN_LD(A, 0);
        for (int t = 0; t < nT; t += 2) {
          SCAN_LD(B, (t + 1) * 64);
          SCAN_STEP(A, t * 64);
          SCAN_LD(A, (t + 2) * 64);
          SCAN_STEP(B, (t + 1) * 64);
        }
#undef SCAN_UPD
#undef H2
#undef SCAN_LD
#undef SCAN_STEP
      }
      __syncthreads();
      {
        const int tl = c * 64 + tt;
        if (tl < nsteps) {
          float y[8], z[8];
          const float2 sc = *(const float2*)(Lsc + tt * 2);
          const uint4 va = *(const uint4*)(Hv2 + tt * 64 + c8), vb = *(const uint4*)(Hv2 + tt * 64 + c8 + 4);
          float vv[8];
          { const unsigned vu[8] = {va.x, va.y, va.z, va.w, vb.x, vb.y, vb.z, vb.w};
#pragma unroll
            for (int j = 0; j < 8; ++j) { h2_t t_ = *(const h2_t*)&vu[j]; vv[j] = (float)t_[0]; } }
#pragma unroll
          for (int q = 0; q < 4; ++q) {
            const float4 ed = *(const float4*)(LY + tt * 128 + (c8 + 2 * q) * 2);
            y[2 * q] = ed.x - ed.y * sc.x + vv[2 * q] * sc.y;
            y[2 * q + 1] = ed.z - ed.w * sc.x + vv[2 * q + 1] * sc.y;
          }
          float sm = y[0] + y[1] + y[2] + y[3] + y[4] + y[5] + y[6] + y[7];
          sm = red8(sm);
          const float mean = sm * (1.f / 64.f);
          float vs = 0.f;
#pragma unroll
          for (int j = 0; j < 8; ++j) { y[j] -= mean; vs += y[j] * y[j]; }
          vs = red8(vs);
          const float rstd = rsqrtf(vs * (1.f / 64.f) + 64e-5f);
          const float bon = Lbon[tt];
          unpack8(zc, z);
          float o[8];
#pragma unroll
          for (int j = 0; j < 8; ++j) {
            float t = y[j] * rstd * clg[j] + clb[j] + bon * vv[j];
            o[j] = t * z[j] * sigmoidf_(z[j]);
          }
          uint4 ov; ov.x = pack2(o[0], o[1]); ov.y = pack2(o[2], o[3]); ov.z = pack2(o[4], o[5]); ov.w = pack2(o[6], o[7]);
          *(uint4*)(YG + (size_t)(tok0 + tl) * 2048 + col0) = ov;
        }
      }
      __syncthreads();
    }
#undef SCAN_LOAD
    *(float4*)(sout + srow * 64 + kc * 8) = make_float4((float)sa_[0], (float)sa_[1], (float)sb_[0], (float)sb_[1]);
    *(float4*)(sout + srow * 64 + kc * 8 + 4) = make_float4((float)sc_[0], (float)sc_[1], (float)sd_[0], (float)sd_[1]);
  }
}

template <int LAYER>
DEV void outproj_store(const Params& p, const float* mod, float* xmid, int m, int n, f32x4 v) {
  const float* gate = mod + (size_t)seq_of(m) * 3072 + 2048;
  float4 g4 = *(const float4*)(gate + n);
  if (LAYER == 0) {
    const float* xr = m < TP ? p.in[I_XP] + (size_t)m * 1024 : p.in[I_XS] + (size_t)(m - TP) * 1024;
    float4 x4 = *(const float4*)(xr + n);
    *(float4*)(xmid + (size_t)m * 1024 + n) = make_float4(x4.x + g4.x * v[0], x4.y + g4.y * v[1], x4.z + g4.z * v[2], x4.w + g4.w * v[3]);
  } else {
    float4 x4 = *(const float4*)(xmid + (size_t)m * 1024 + n);
    float* yo = m < TP ? p.out + OFF_Y_P + (size_t)m * 1024 : p.out + OFF_Y_S + (size_t)(m - TP) * 1024;
    *(float4*)(yo + n) = make_float4(x4.x + g4.x * v[0], x4.y + g4.y * v[1], x4.z + g4.z * v[2], x4.w + g4.w * v[3]);
  }
}

template <int LAYER>
DEV void phase_outproj_main(const Params& p, char* smem) {
  const int tid = threadIdx.x, lane = tid & 63, wid = tid >> 6, wr = wid >> 2, wc = wid & 3, fr = lane & 15, fq = lane >> 4;
  char* ws = p.ws;
  const u16* A = (const u16*)(ws + 6 * SLOT);
  const u16* Bt = (const u16*)(ws + (LAYER == 0 ? WS_WT_OUTA : WS_WT_OUTB));
  const float* mod = (const float*)(ws + WS_MOD) + (size_t)LAYER * 24 * 3072;
  float* xmid = (float*)(ws + 0 * SLOT);
  f32x4 acc[8][4];
  const int xcc0 = xcc_id();
  int nxt;
  for (int ls = 0; ls < 8; ++ls) {
    const int xcd = (xcc0 + ls) & 7;
    unsigned* ctr = sched_ctr(p, LAYER == 0 ? 1 : 3, xcd);
    for (int li = sched_first(ctr, smem); li < 64; li = sched_commit(nxt, smem)) {
      nxt = sched_prefetch(ctr);
      const int item = 64 * xcd + li;
      const int m0 = (item >> 2) * 256, n0 = (item & 3) * 256;
      gemm_main256_dma(acc, A, 2048, Bt, 2048, 32, m0, n0, smem);
#pragma unroll
      for (int i = 0; i < 8; ++i)
#pragma unroll
        for (int j = 0; j < 4; ++j)
          outproj_store<LAYER>(p, mod, xmid, m0 + wr * 128 + i * 16 + fr, n0 + wc * 64 + j * 16 + fq * 4, acc[i][j]);
    }
  }
}

template <int LAYER>
DEV void phase_outproj_tail(const Params& p, char* smem) {
  const int tid = threadIdx.x, lane = tid & 63, wid = tid >> 6, wr = wid >> 1, wc = wid & 1, fr = lane & 15, fq = lane >> 4;
  char* ws = p.ws;
  const u16* A = (const u16*)(ws + 6 * SLOT);
  const u16* Bt = (const u16*)(ws + (LAYER == 0 ? WS_WT_OUTA : WS_WT_OUTB));
  const float* mod = (const float*)(ws + WS_MOD) + (size_t)LAYER * 24 * 3072;
  float* xmid = (float*)(ws + 0 * SLOT);
  f32x4 acc[4][4];
  const int xcc0 = xcc_id();
  int nxt;
  for (int ls = 0; ls < 8; ++ls) {
    const int xcd = (xcc0 + ls) & 7;
    unsigned* ctr = sched_ctr(p, LAYER == 0 ? 5 : 6, xcd);
    for (int li = sched_first(ctr, smem); li < 2; li = sched_commit(nxt, smem)) {
      nxt = sched_prefetch(ctr);
      const int item = 2 * xcd + li;
      const int m0 = (128 + (item >> 3)) * 256, n0 = (item & 7) * 128;
      gemm_main<0>(acc, A, 2048, Bt, 2048, 32, m0, n0, nullptr, nullptr, smem);
#pragma unroll
      for (int i = 0; i < 4; ++i)
#pragma unroll
        for (int j = 0; j < 4; ++j)
          outproj_store<LAYER>(p, mod, xmid, m0 + wr * 64 + i * 16 + fr, n0 + wc * 64 + j * 16 + fq * 4, acc[i][j]);
    }
  }
}

template <int LAYER>
DEV void phase_outproj(const Params& p, char* smem) {
  phase_outproj_tail<LAYER>(p, smem);
  phase_outproj_main<LAYER>(p, smem);
}

DEV void phase_norm1(const Params& p) {
  const int lane = threadIdx.x & 63, wid = threadIdx.x >> 6;
  const float* mod = (const float*)(p.ws + WS_MOD) + (size_t)24 * 3072;
  const float* xmid = (const float*)(p.ws + 0 * SLOT);
  u16* AKV = (u16*)(p.ws + 1 * SLOT);
  u16* AQ = AKV + (size_t)NTOK * 1024;
  const float* gkv = p.in[I_KVNG];
  const float* gb = p.in[I_BNG];
  for (int t = blockIdx.x * 8 + wid; t < NTOK; t += gridDim.x * 8) {
    const float* x = xmid + (size_t)t * 1024;
    const float* md = mod + (size_t)seq_of(t) * 3072;
    float4 v[4];
    float ss = 0.f;
#pragma unroll
    for (int i = 0; i < 4; ++i) {
      v[i] = *(const float4*)(x + lane * 4 + 256 * i);
      ss += v[i].x * v[i].x + v[i].y * v[i].y + v[i].z * v[i].z + v[i].w * v[i].w;
    }
    ss = wave_sum(ss);
    const float rstd = rsqrtf(ss * (1.0f / 1024.0f) + 1e-6f);
#pragma unroll
    for (int i = 0; i < 4; ++i) {
      const int c = lane * 4 + 256 * i;
      float4 g1 = *(const float4*)(gkv + c), g2 = *(const float4*)(gb + c), sh = *(const float4*)(md + c), sc = *(const float4*)(md + 1024 + c);
      float xn0 = v[i].x * rstd, xn1 = v[i].y * rstd, xn2 = v[i].z * rstd, xn3 = v[i].w * rstd;
      uint2 o;
      o.x = pack2(xn0 * g1.x, xn1 * g1.y); o.y = pack2(xn2 * g1.z, xn3 * g1.w);
      *(uint2*)(AKV + (size_t)t * 1024 + c) = o;
      o.x = pack2(xn0 * g2.x * (1.f + sc.x) + sh.x, xn1 * g2.y * (1.f + sc.y) + sh.y);
      o.y = pack2(xn2 * g2.z * (1.f + sc.z) + sh.z, xn3 * g2.w * (1.f + sc.w) + sh.w);
      *(uint2*)(AQ + (size_t)t * 1024 + c) = o;
    }
  }
}

#define QSCALE (0.08838834764831845f * 1.4426950408889634f)
DEV void phase_proj1(const Params& p, char* smem) {
  const int tid = threadIdx.x, lane = tid & 63, wid = tid >> 6, wr = wid >> 2, wc = wid & 3, fr = lane & 15, fq = lane >> 4;
  char* ws = p.ws;
  const u16* AKV = (const u16*)(ws + 1 * SLOT);
  const u16* AQ = AKV + (size_t)NTOK * 1024;
  u16* KB = (u16*)(ws + 2 * SLOT);
  u16* VB = (u16*)(ws + 3 * SLOT);
  u16* QB = (u16*)(ws + 4 * SLOT);
  u16* ZS = (u16*)(ws + 5 * SLOT);
  f32x4 acc[8][4];
  float* red = (float*)smem;
  const int xcc0 = xcc_id();
  int nxt;
  for (int ls = 0; ls < 8; ++ls) {
  const int xcd = (xcc0 + ls) & 7;
  unsigned* ctr = sched_ctr(p, 2, xcd);
  for (int li = sched_first(ctr, smem); li < 520; li = sched_commit(nxt, smem)) {
    nxt = sched_prefetch(ctr);
    const int mt = li >> 2, t = 4 * xcd + (li & 3);
    const int isq = t >> 4, nt = t & 15;
    const int m0 = mt * 256, n0 = nt * 256;
    gemm_main256_dma(acc, isq ? AQ : AKV, 1024, (const u16*)(ws + (isq ? WS_WT_INB : WS_WT_KV)), 1024, 16, m0, n0, smem);
    if (nt < 8) {
#pragma unroll
      for (int i = 0; i < 8; ++i) {
        float ss = 0.f;
#pragma unroll
        for (int j = 0; j < 4; ++j) ss += acc[i][j][0] * acc[i][j][0] + acc[i][j][1] * acc[i][j][1] + acc[i][j][2] * acc[i][j][2] + acc[i][j][3] * acc[i][j][3];
        red[(wr * 128 + i * 16 + fr) * 16 + wc * 4 + fq] = ss;
      }
      __syncthreads();
      const float* gain = isq ? p.in[I_BQG] : p.in[I_KGAIN];
#pragma unroll
      for (int i = 0; i < 8; ++i) {
        const int row = wr * 128 + i * 16 + fr, m = m0 + row;
        float4 ra = *(const float4*)(red + row * 16 + (wc >> 1) * 8), rb = *(const float4*)(red + row * 16 + (wc >> 1) * 8 + 4);
        float tot = ra.x + ra.y + ra.z + ra.w + rb.x + rb.y + rb.z + rb.w;
        float rs = rsqrtf(tot * (1.f / 128.f) + 1e-6f);
        if (isq) rs *= QSCALE;
#pragma unroll
        for (int j = 0; j < 4; ++j) {
          const int d = (wc & 1) * 64 + j * 16 + fq * 4, n = n0 + wc * 64 + j * 16 + fq * 4;
          float4 g4 = *(const float4*)(gain + d);
          f32x4 v = acc[i][j];
          float o0 = v[0] * rs * g4.x, o1 = v[1] * rs * g4.y, o2 = v[2] * rs * g4.z, o3 = v[3] * rs * g4.w;
          uint2 o; o.x = pack2(o0, o1); o.y = pack2(o2, o3);
          if (isq) {
            *(uint2*)(QB + (size_t)m * 2048 + n) = o;
          } else {
            *(uint2*)(KB + (size_t)m * 2048 + n) = o;
            float* ko = m < TP ? p.out + OFF_K_P + (size_t)m * 2048 : p.out + OFF_K_S + (size_t)(m - TP) * 2048;
            *(float4*)(ko + n) = make_float4(o0, o1, o2, o3);
          }
        }
      }
      __syncthreads();
    } else {
#pragma unroll
      for (int i = 0; i < 8; ++i) {
        const int m = m0 + wr * 128 + i * 16 + fr;
#pragma unroll
        for (int j = 0; j < 4; ++j) {
          const int n = n0 - 2048 + wc * 64 + j * 16 + fq * 4;
          f32x4 v = acc[i][j];
          if (isq) {
            float o0 = v[0] * sigmoidf_(v[0]), o1 = v[1] * sigmoidf_(v[1]), o2 = v[2] * sigmoidf_(v[2]), o3 = v[3] * sigmoidf_(v[3]);
            uint2 o; o.x = pack2(o0, o1); o.y = pack2(o2, o3);
            *(uint2*)(ZS + (size_t)m * 2048 + n) = o;
          } else {
            uint2 o; o.x = pack2(v[0], v[1]); o.y = pack2(v[2], v[3]);
            *(uint2*)(VB + (size_t)m * 2048 + n) = o;
            float* vo = m < TP ? p.out + OFF_V_P + (size_t)m * 2048 : p.out + OFF_V_S + (size_t)(m - TP) * 2048;
            *(float4*)(vo + n) = make_float4(v[0], v[1], v[2], v[3]);
          }
        }
      }
    }
  }
}
}

DEV unsigned off_b(unsigned row, unsigned ch) { return 256u * row + 16u * (ch ^ (((row & 3) << 2) | ((row >> 2) & 3))); }

DEV void phase_attn(const Params& p, char* smem) {
  const int tid = threadIdx.x, lane = tid & 63, w = tid >> 6, fr = lane & 15, fq = lane >> 4;
  char* ws = p.ws;
  const u16* KB = (const u16*)(ws + 2 * SLOT);
  const u16* VB = (const u16*)(ws + 3 * SLOT);
  const u16* QB = (const u16*)(ws + 4 * SLOT);
  const u16* ZS = (const u16*)(ws + 5 * SLOT);
  u16* OG = (u16*)(ws + 6 * SLOT);
  const int lrow = tid >> 4, lch = tid & 15;
  const unsigned lw0 = off_b(lrow, lch), lw1 = off_b(lrow + 32, lch);
  const int tq = (lane & 15) >> 2, tp = lane & 3;

  for (int item = blockIdx.x; item < 4096 + 256; item += gridDim.x) {
    int b, h, nq, qpos0, tokq0, ntiles, nkeys, tokk0; bool sample;
    if (item < 4096) {
      const int qblk = 31 - (item >> 7), bh = item & 127;
      b = bh >> 4; h = bh & 15; nq = 128; qpos0 = qblk * 128; tokq0 = b * 4096 + qpos0; ntiles = 2 * qblk + 2; nkeys = qpos0 + 128; tokk0 = b * 4096; sample = false;
    } else {
      const int bh = item - 4096;
      b = bh >> 4; h = bh & 15; nq = 32; qpos0 = 1024; tokq0 = TP + b * 32; ntiles = 17; nkeys = 1056; tokk0 = TP + b * 32 - 1024; sample = true;
    }
    const bool wactive = (w * 16) < nq;
    int* dflag = (int*)(smem + 65536);
    __syncthreads();
    if (lane == 0) dflag[w] = wactive ? 0 : 1;
    bool wdone = !wactive;
    const int qp = qpos0 + w * 16 + fr;
    const int qwmax = qpos0 + w * 16 + 15;
    bf16x8 qf[4];
#pragma unroll
    for (int ks = 0; ks < 4; ++ks) {
      if (wactive) qf[ks] = *(const bf16x8*)(QB + (size_t)(tokq0 + w * 16 + fr) * 2048 + h * 128 + ks * 32 + fq * 8);
      else qf[ks] = (bf16x8){0, 0, 0, 0, 0, 0, 0, 0};
    }
    f32x4 O[8];
#pragma unroll
    for (int dt = 0; dt < 8; ++dt) O[dt] = (f32x4){0, 0, 0, 0};
    float carry = 0.f;

    uint4 lk0, lk1, lv0, lv1;
#define ATT_LOAD(kb)                                                                                  \
    {                                                                                                 \
      const int kx0_ = (kb) * 64 + lrow, kx1_ = kx0_ + 32;                                            \
      if (sample && (kb) < 16) {                                                                      \
        const float* ck_ = p.in[I_CK] + ((size_t)(b * 1024 + kx0_) * 16 + h) * 128 + lch * 8;         \
        const float* cv_ = p.in[I_CV] + ((size_t)(b * 1024 + kx0_) * 16 + h) * 128 + lch * 8;         \
        float4 a_ = *(const float4*)ck_, b_ = *(const float4*)(ck_ + 4);                              \
        float4 c_ = *(const float4*)(ck_ + 32 * 2048), d_ = *(const float4*)(ck_ + 32 * 2048 + 4);    \
        lk0 = make_uint4(pack2(a_.x, a_.y), pack2(a_.z, a_.w), pack2(b_.x, b_.y), pack2(b_.z, b_.w)); \
        lk1 = make_uint4(pack2(c_.x, c_.y), pack2(c_.z, c_.w), pack2(d_.x, d_.y), pack2(d_.z, d_.w)); \
        a_ = *(const float4*)cv_; b_ = *(const float4*)(cv_ + 4);                                     \
        c_ = *(const float4*)(cv_ + 32 * 2048); d_ = *(const float4*)(cv_ + 32 * 2048 + 4);           \
        lv0 = make_uint4(pack2(a_.x, a_.y), pack2(a_.z, a_.w), pack2(b_.x, b_.y), pack2(b_.z, b_.w)); \
        lv1 = make_uint4(pack2(c_.x, c_.y), pack2(c_.z, c_.w), pack2(d_.x, d_.y), pack2(d_.z, d_.w)); \
      } else {                                                                                        \
        const size_t o0_ = (size_t)(tokk0 + kx0_) * 2048 + h * 128 + lch * 8;                         \
        const size_t o1_ = o0_ + (size_t)32 * 2048;                                                   \
        if (kx0_ < nkeys) { lk0 = *(const uint4*)(KB + o0_); lv0 = *(const uint4*)(VB + o0_); }       \
        else { lk0 = make_uint4(0, 0, 0, 0); lv0 = lk0; }                                             \
        if (kx1_ < nkeys) { lk1 = *(const uint4*)(KB + o1_); lv1 = *(const uint4*)(VB + o1_); }       \
        else { lk1 = make_uint4(0, 0, 0, 0); lv1 = lk1; }                                             \
      }                                                                                               \
    }
#define ATT_STORE(st)                                                                                 \
    {                                                                                                 \
      char* sK_ = smem + (st) * 32768; char* sV_ = sK_ + 16384;                                       \
      *(uint4*)(sK_ + lw0) = lk0; *(uint4*)(sK_ + lw1) = lk1;                                         \
      *(uint4*)(sV_ + lw0) = lv0; *(uint4*)(sV_ + lw1) = lv1;                                         \
    }
    ATT_LOAD(ntiles - 1);
    ATT_STORE(0);
    __syncthreads();
    for (int it = 0; it < ntiles; ++it) {
      const int kb = ntiles - 1 - it, st = it & 1;
      if (it + 1 < ntiles) ATT_LOAD(kb - 1);
      if (!wdone && kb * 64 < qwmax) {
        const char* sK = smem + st * 32768;
        const char* sV = sK + 16384;
        f32x4 S[4];
#pragma unroll
        for (int mt = 0; mt < 4; ++mt) S[mt] = (f32x4){0, 0, 0, 0};
#pragma unroll
        for (int ks = 0; ks < 4; ++ks)
#pragma unroll
          for (int mt = 0; mt < 4; ++mt) {
            bf16x8 a = *(const bf16x8*)(sK + off_b(mt * 16 + fr, ks * 4 + fq));
            S[mt] = __builtin_amdgcn_mfma_f32_16x16x32_bf16(a, qf[ks], S[mt], 0, 0, 0);
          }
        bf16x8 wf[2];
#define ATT_ELEM(MASKED) \
        { \
          float ee[4][4], tot[4], hi[4]; \
_Pragma("unroll") \
          for (int mt = 0; mt < 4; ++mt) { \
            const int kbase = kb * 64 + mt * 16 + fq * 4; \
            float ls[4]; \
_Pragma("unroll") \
            for (int jj = 0; jj < 4; ++jj) { \
              const float u = S[mt][jj]; \
              const bool valid = !(MASKED) || ((kbase + jj) < qp); \
              const float l = -__builtin_amdgcn_logf(1.0f + __builtin_amdgcn_exp2f(u)); \
              ls[jj] = valid ? l : 0.f; \
              ee[mt][jj] = valid ? (u + l) : -1e30f; \
            } \
            const float x3 = ls[3], x2 = x3 + ls[2], x1 = x2 + ls[1], seg = x1 + ls[0]; \
            ee[mt][2] += x3; ee[mt][1] += x2; ee[mt][0] += x1; \
            const float t1 = __shfl_xor(seg, 16), t2 = __shfl_xor(seg, 32), t3 = __shfl_xor(t1, 32); \
            tot[mt] = seg + t1 + t2 + t3; \
            hi[mt] = fq == 0 ? (t1 + t2 + t3) : fq == 1 ? (t2 + t3) : fq == 2 ? t1 : 0.f; \
          } \
          float run = carry; \
          float wv[4][4]; \
_Pragma("unroll") \
          for (int mt = 3; mt >= 0; --mt) { \
            const float base = run + hi[mt]; \
            run += tot[mt]; \
_Pragma("unroll") \
            for (int jj = 0; jj < 4; ++jj) wv[mt][jj] = __builtin_amdgcn_exp2f(ee[mt][jj] + base); \
          } \
          carry = run; \
          if (__all(carry < -150.0f)) { wdone = true; if (lane == 0) dflag[w] = 1; } \
_Pragma("unroll") \
          for (int p2 = 0; p2 < 2; ++p2) { \
            uint4 pk; \
            pk.x = pack2(wv[2 * p2][0], wv[2 * p2][1]); pk.y = pack2(wv[2 * p2][2], wv[2 * p2][3]); \
            pk.z = pack2(wv[2 * p2 + 1][0], wv[2 * p2 + 1][1]); pk.w = pack2(wv[2 * p2 + 1][2], wv[2 * p2 + 1][3]); \
            wf[p2] = *(bf16x8*)&pk; \
          } \
        }
        if (kb * 64 + 63 < qpos0 + w * 16) { ATT_ELEM(0) } else { ATT_ELEM(1) }
#undef ATT_ELEM
#pragma unroll
        for (int p2 = 0; p2 < 2; ++p2)
#pragma unroll
          for (int dt = 0; dt < 8; ++dt) {
            const unsigned r0 = 32 * p2 + 4 * fq + tq, r1 = r0 + 16;
            const unsigned ch = 2 * dt + (tp >> 1);
            const char* a0 = sV + off_b(r0, ch) + 8 * (tp & 1);
            const char* a1 = sV + off_b(r1, ch) + 8 * (tp & 1);
            s16x4 lo = __builtin_amdgcn_ds_read_tr16_b64_v4i16((s16x4 __attribute__((address_space(3)))*)(a0));
            s16x4 hi4 = __builtin_amdgcn_ds_read_tr16_b64_v4i16((s16x4 __attribute__((address_space(3)))*)(a1));
            bf16x8 a = {lo[0], lo[1], lo[2], lo[3], hi4[0], hi4[1], hi4[2], hi4[3]};
            O[dt] = __builtin_amdgcn_mfma_f32_16x16x32_bf16(a, wf[p2], O[dt], 0, 0, 0);
          }
      }
      if (it + 1 < ntiles) ATT_STORE(st ^ 1);
      __syncthreads();
      {
        const int4 f0 = *(const int4*)dflag, f1 = *(const int4*)(dflag + 4);
        if (f0.x & f0.y & f0.z & f0.w & f1.x & f1.y & f1.z & f1.w) break;
      }
    }
#undef ATT_LOAD
#undef ATT_STORE
    if (wactive) {
      const size_t rowoff = (size_t)(tokq0 + w * 16 + fr) * 2048 + h * 128;
#pragma unroll
      for (int dt = 0; dt < 8; ++dt) {
        const int d = dt * 16 + fq * 4;
        uint2 z = *(const uint2*)(ZS + rowoff + d);
        f32x4 v = O[dt];
        uint2 o;
        o.x = pack2(v[0] * bflo(z.x), v[1] * bfhi(z.x)); o.y = pack2(v[2] * bflo(z.y), v[3] * bfhi(z.y));
        *(uint2*)(OG + rowoff + d) = o;
      }
    }
  }
}


DEV void grid_barrier(unsigned* bar, unsigned target) {
  __syncthreads();
  if (threadIdx.x == 0) {
    __builtin_amdgcn_fence(__ATOMIC_RELEASE, "agent");
    asm volatile("s_waitcnt vmcnt(0)" ::: "memory");
    __hip_atomic_fetch_add(bar, 1u, __ATOMIC_RELAXED, __HIP_MEMORY_SCOPE_AGENT);
    while (__hip_atomic_load(bar, __ATOMIC_RELAXED, __HIP_MEMORY_SCOPE_AGENT) < target) __builtin_amdgcn_s_sleep(1);
    __builtin_amdgcn_fence(__ATOMIC_ACQUIRE, "agent");
    asm volatile("s_waitcnt vmcnt(0)" ::: "memory");
  }
  __syncthreads();
}

__global__ void __launch_bounds__(NTHREADS) __attribute__((target("no-packed-fp32-ops"))) mega(Params p, int lo, int hi) {
  __shared__ __attribute__((aligned(16))) char smem[147456];
  cg::grid_group grid = cg::this_grid();
#ifndef PROBE_DOUBLE
#define PROBE_DOUBLE -1
#endif
#define RUN_PHASE(k, call) if ((k) >= lo && (k) < hi) { if ((k) > lo) { if ((k) == lo + 1) grid.sync(); else grid_barrier((unsigned*)(p.ws + WS_BAR), (unsigned)((k) - lo - 1) * gridDim.x); } call; }
  RUN_PHASE(0, phase_prep(p, smem))
  RUN_PHASE(1, phase_norm0(p))
  RUN_PHASE(2, phase_proj0(p, smem))
  RUN_PHASE(3, phase_scan(p, smem))
  RUN_PHASE(4, phase_outproj<0>(p, smem))
  RUN_PHASE(5, phase_norm1(p))
  RUN_PHASE(6, phase_proj1(p, smem))
  RUN_PHASE(7, phase_attn(p, smem))
  RUN_PHASE(8, phase_outproj<1>(p, smem))
}

#ifndef N_LAUNCH_MODE
#define N_LAUNCH_MODE 1
#endif

extern "C" void kernel_launch(void* const* d_in, const int* in_sizes, int n_in, void* d_out, int out_size, void* d_ws, size_t ws_size,
                              hipStream_t stream) {
  Params p{};
  for (int i = 0; i < 36; ++i) p.in[i] = (const float*)d_in[i];
  p.out = (float*)d_out;
  p.ws = (char*)d_ws;
  static int grid_blocks = 0;
  if (!grid_blocks) {
    int dev = 0, cus = 0, per_cu = 0;
    hipGetDevice(&dev);
    hipDeviceGetAttribute(&cus, hipDeviceAttributeMultiprocessorCount, dev);
    hipOccupancyMaxActiveBlocksPerMultiprocessor(&per_cu, mega, NTHREADS, 0);
    if (per_cu < 1) per_cu = 1;
    grid_blocks = cus * per_cu;
  }
  if (ws_size < WS_END) { fprintf(stderr, "workspace too small: %zu < %llu\n", ws_size, (unsigned long long)WS_END); return; }
#if N_LAUNCH_MODE == 1
  int lo = 0, hi = 9;
  hipMemsetAsync((char*)d_ws + WS_BAR, 0, 256, stream);
  void* args[] = {&p, &lo, &hi};
  hipError_t e = hipLaunchCooperativeKernel((void*)mega, dim3(grid_blocks), dim3(NTHREADS), args, 0, stream);
  if (e != hipSuccess) fprintf(stderr, "cooperative launch failed: %s (grid %d)\n", hipGetErrorString(e), grid_blocks);
#else
  for (int ph = 0; ph < 9; ++ph) hipLaunchKernelGGL(mega, dim3(grid_blocks), dim3(NTHREADS), 0, stream, p, ph, ph + 1);
#endif
}
```

```cpp
#include <hip/hip_runtime.h>
#include <hip/hip_cooperative_groups.h>
#include <cstdio>
namespace cg = cooperative_groups;

typedef unsigned short u16;
typedef short bf16x8 __attribute__((ext_vector_type(8)));
typedef short s16x4 __attribute__((ext_vector_type(4)));
typedef float f32x4 __attribute__((ext_vector_type(4)));
typedef float f32x2 __attribute__((ext_vector_type(2)));
typedef __bf16 bf16x2_t __attribute__((ext_vector_type(2)));
typedef _Float16 h2_t __attribute__((ext_vector_type(2)));

#define DEV __device__ __forceinline__

#define NTOK 33280
#define TP 32768
#define NTHREADS 512

#define OFF_Y_P 0
#define OFF_Y_S 33554432
#define OFF_K_P 34078720
#define OFF_V_P 101187584
#define OFF_WKV_P 168296448
#define OFF_SH_P 169345024
#define OFF_K_S 169353216
#define OFF_V_S 170401792
#define OFF_WKV_S 171450368
#define OFF_SH_S 173547520

#define SLOT 136314880ull
#define WS_W (7ull * SLOT)
#define WS_WT_IN (WS_W)
#define WS_WT_OUTA (WS_WT_IN + 16777216ull)
#define WS_WT_KV (WS_WT_OUTA + 4194304ull)
#define WS_WT_INB (WS_WT_KV + 8388608ull)
#define WS_WT_OUTB (WS_WT_INB + 8388608ull)
#define WS_W2T (WS_WT_OUTB + 4194304ull)
#define WS_A2T (WS_W2T + 262144ull)
#define WS_L1T (WS_A2T + 262144ull)
#define WS_MOD (WS_L1T + 524288ull)
#define WS_SH (WS_MOD + 589824ull)
#define WS_CTR (WS_SH + 49152ull)
#define WS_BAR (WS_CTR + 4096ull)
#define WS_END (WS_BAR + 256ull)
#define WS_H0 (6ull * SLOT)
#define WS_T (4ull * SLOT)

struct Params {
  const float* in[36];
  float* out;
  char* ws;
};

enum { I_XP = 0, I_XS, I_CK, I_CV, I_SWKV, I_SSH, I_CP, I_CS, I_ANG, I_AADAW, I_AADAB, I_AWIN, I_AMUIN, I_AMUW, I_AMUA,
       I_AW0, I_AW1, I_AW2, I_AA0, I_AA1, I_AA2, I_AKK, I_AKA, I_ARK, I_ALNG, I_ALNB, I_AWOUT, I_KVNG, I_KVW, I_KGAIN,
       I_BNG, I_BADAW, I_BADAB, I_BWIN, I_BQG, I_BWOUT };

DEV int seq_of(int t) { return t < TP ? (t >> 12) : 8 + ((t - TP) >> 5); }
DEV bool seq_start(int t) { return t < TP ? ((t & 4095) == 0) : (((t - TP) & 31) == 0); }

DEV unsigned pack2(float a, float b) {
  f32x2 v = {a, b};
  bf16x2_t r = __builtin_convertvector(v, bf16x2_t);
  return *(unsigned*)&r;
}
DEV unsigned packh2(float a, float b) {
  f32x2 v = {a, b};
  h2_t r = __builtin_convertvector(v, h2_t);
  return *(unsigned*)&r;
}
DEV float bflo(unsigned w) { return __uint_as_float(w << 16); }
DEV float bfhi(unsigned w) { return __uint_as_float(w & 0xffff0000u); }
DEV void unpack8(const uint4& x, float* f) {
  f[0] = bflo(x.x); f[1] = bfhi(x.x); f[2] = bflo(x.y); f[3] = bfhi(x.y);
  f[4] = bflo(x.z); f[5] = bfhi(x.z); f[6] = bflo(x.w); f[7] = bfhi(x.w);
}
DEV float sigmoidf_(float x) { return 1.0f / (1.0f + __expf(-x)); }

template <int CTRL>
DEV float dppf(float x) {
  return __int_as_float(__builtin_amdgcn_update_dpp(0, __float_as_int(x), CTRL, 0xf, 0xf, true));
}
DEV float red4(float x) { x += dppf<0xB1>(x); x += dppf<0x4E>(x); return x; }
DEV float red8(float x) { x = red4(x); x += dppf<0x141>(x); return x; }
DEV float red16(float x) { x = red8(x); x += dppf<0x140>(x); return x; }
DEV float wave_sum(float x) {
#pragma unroll
  for (int o = 32; o >= 1; o >>= 1) x += __shfl_xor(x, o);
  return x;
}


#define SCHED_SLOT_OFF 147440
DEV int xcc_id() { return (int)(__builtin_amdgcn_s_getreg((3 << 11) | 20) & 0x7u); }
DEV unsigned* sched_ctr(const Params& p, int phase_slot, int list) { return (unsigned*)(p.ws + WS_CTR) + (phase_slot * 8 + list) * 16; }
DEV int sched_first(unsigned* ctr, char* smem) {
  int* slot = (int*)(smem + SCHED_SLOT_OFF);
  __syncthreads();
  if (threadIdx.x == 0) *slot = (int)atomicAdd(ctr, 1u);
  __syncthreads();
  return *slot;
}

DEV void group_sync(unsigned* bar, unsigned target) {
  __syncthreads();
  if (threadIdx.x == 0) {
    __hip_atomic_fetch_add(bar, 1u, __ATOMIC_RELAXED, __HIP_MEMORY_SCOPE_AGENT);
    while (__hip_atomic_load(bar, __ATOMIC_RELAXED, __HIP_MEMORY_SCOPE_AGENT) < target) __builtin_amdgcn_s_sleep(2);
  }
  __syncthreads();
}
DEV int sched_prefetch(unsigned* ctr) { return threadIdx.x == 0 ? (int)atomicAdd(ctr, 1u) : 0; }
DEV int sched_commit(int nxt, char* smem) {
  int* slot = (int*)(smem + SCHED_SLOT_OFF);
  __syncthreads();
  if (threadIdx.x == 0) *slot = nxt;
  __syncthreads();
  return *slot;
}

#define GEMM_STAGE_BYTES 49152

template <int AMODE>
DEV void gemm_main(f32x4 (&acc)[4][4], const u16* __restrict__ A, int lda, const u16* __restrict__ Bt, int ldb, int nk,
                   int m0, int n0, const float* __restrict__ mu, const u16* __restrict__ SH, char* smem) {
  const int tid = threadIdx.x, lane = tid & 63, wid = tid >> 6, wr = wid >> 1, wc = wid & 1, fr = lane & 15, fq = lane >> 4;
  const int lrow = tid >> 3, lch = tid & 7;
#pragma unroll
  for (int i = 0; i < 4; ++i)
#pragma unroll
    for (int j = 0; j < 4; ++j) acc[i][j] = (f32x4){0.f, 0.f, 0.f, 0.f};

  const u16* pa0; const u16* pa1; const u16* pa2; const u16* pa3;
  const u16* pp0 = nullptr;
  const int arow = 4 * lrow;
  {
    int m = m0 + arow;
    pa0 = A + (size_t)m * lda + lch * 8;
    pa1 = pa0 + lda; pa2 = pa1 + lda; pa3 = pa2 + lda;
    if (AMODE != 0) pp0 = seq_start(m) ? SH + seq_of(m) * 1024 + lch * 8 : pa0 - lda;
  }
  const u16* pb0 = Bt + (size_t)(n0 + lrow) * ldb + lch * 8;
  const u16* pb1 = pb0 + (size_t)64 * ldb;
  const int woffB = lrow * 128 + ((lch ^ ((lrow >> 1) & 7)) << 4);
  const int woffA0 = (arow + 0) * 128 + ((lch ^ (((arow + 0) >> 1) & 7)) << 4);
  const int woffA1 = (arow + 1) * 128 + ((lch ^ (((arow + 1) >> 1) & 7)) << 4);
  const int woffA2 = (arow + 2) * 128 + ((lch ^ (((arow + 2) >> 1) & 7)) << 4);
  const int woffA3 = (arow + 3) * 128 + ((lch ^ (((arow + 3) >> 1) & 7)) << 4);

  uint4 ra0, ra1, ra2, ra3, rp0, rb0, rb1;
  float4 mu0, mu1;
  rp0 = make_uint4(0, 0, 0, 0);
  mu0 = mu1 = make_float4(0, 0, 0, 0);

#define G_LOAD(kt)                                                                     \
  {                                                                                    \
    const int k0_ = (kt) * 64;                                                         \
    if (AMODE == 0) {                                                                  \
      ra0 = *(const uint4*)(pa0 + k0_); ra1 = *(const uint4*)(pa1 + k0_);              \
      ra2 = *(const uint4*)(pa2 + k0_); ra3 = *(const uint4*)(pa3 + k0_);              \
    } else if (AMODE == 1) {                                                           \
      ra0 = *(const uint4*)(pa0 + k0_); ra1 = *(const uint4*)(pa1 + k0_);              \
      ra2 = *(const uint4*)(pa2 + k0_); ra3 = *(const uint4*)(pa3 + k0_);              \
      rp0 = *(const uint4*)(pp0 + k0_);                                                \
      mu0 = *(const float4*)(mu + k0_ + lch * 8); mu1 = *(const float4*)(mu + k0_ + lch * 8 + 4); \
    } else {                                                                           \
      const int kk_ = k0_ & 1023;                                                      \
      ra0 = *(const uint4*)(pa0 + kk_); ra1 = *(const uint4*)(pa1 + kk_);              \
      ra2 = *(const uint4*)(pa2 + kk_); ra3 = *(const uint4*)(pa3 + kk_);              \
      if (k0_ >= 1024) rp0 = *(const uint4*)(pp0 + kk_);                               \
    }                                                                                  \
    rb0 = *(const uint4*)(pb0 + k0_); rb1 = *(const uint4*)(pb1 + k0_);                \
  }

#define G_XFORM(dst, a_, p_, kt)                                                       \
  {                                                                                    \
    if (AMODE == 0) dst = a_;                                                          \
    else if (AMODE == 1) {                                                             \
      float h_[8], q_[8]; unpack8(a_, h_); unpack8(p_, q_);                            \
      dst.x = pack2(h_[0] + mu0.x * (q_[0] - h_[0]), h_[1] + mu0.y * (q_[1] - h_[1])); \
      dst.y = pack2(h_[2] + mu0.z * (q_[2] - h_[2]), h_[3] + mu0.w * (q_[3] - h_[3])); \
      dst.z = pack2(h_[4] + mu1.x * (q_[4] - h_[4]), h_[5] + mu1.y * (q_[5] - h_[5])); \
      dst.w = pack2(h_[6] + mu1.z * (q_[6] - h_[6]), h_[7] + mu1.w * (q_[7] - h_[7])); \
    } else {                                                                           \
      if ((kt) * 64 >= 1024) {                                                         \
        float h_[8], q_[8]; unpack8(a_, h_); unpack8(p_, q_);                          \
        dst.x = pack2(q_[0] - h_[0], q_[1] - h_[1]); dst.y = pack2(q_[2] - h_[2], q_[3] - h_[3]); \
        dst.z = pack2(q_[4] - h_[4], q_[5] - h_[5]); dst.w = pack2(q_[6] - h_[6], q_[7] - h_[7]); \
      } else dst = a_;                                                                 \
    }                                                                                  \
  }

#define G_STORE(stage, kt)                                                             \
  {                                                                                    \
    char* sA_ = smem + (stage) * GEMM_STAGE_BYTES; char* sB_ = sA_ + 32768;            \
    uint4 v_;                                                                          \
    G_XFORM(v_, ra0, rp0, kt); *(uint4*)(sA_ + woffA0) = v_;                           \
    G_XFORM(v_, ra1, ra0, kt); *(uint4*)(sA_ + woffA1) = v_;                           \
    G_XFORM(v_, ra2, ra1, kt); *(uint4*)(sA_ + woffA2) = v_;                           \
    G_XFORM(v_, ra3, ra2, kt); *(uint4*)(sA_ + woffA3) = v_;                           \
    *(uint4*)(sB_ + woffB) = rb0; *(uint4*)(sB_ + woffB + 64 * 128) = rb1;             \
  }

  G_LOAD(0);
  G_STORE(0, 0);
  __syncthreads();
  const int rsw = (fr >> 1) & 7;
  for (int kt = 0; kt < nk; ++kt) {
    const int st = kt & 1;
    if (kt + 1 < nk) G_LOAD(kt + 1);
    __builtin_amdgcn_sched_barrier(0);
    {
      const char* sA = smem + st * GEMM_STAGE_BYTES;
      const char* sB = sA + 32768;
#pragma unroll
      for (int kk = 0; kk < 2; ++kk) {
        bf16x8 af[4], bfr[4];
        const int cho = ((kk * 4 + fq) ^ rsw) << 4;
#pragma unroll
        for (int i = 0; i < 4; ++i) af[i] = *(const bf16x8*)(sA + (wr * 64 + i * 16 + fr) * 128 + cho);
#pragma unroll
        for (int j = 0; j < 4; ++j) bfr[j] = *(const bf16x8*)(sB + (wc * 64 + j * 16 + fr) * 128 + cho);
#pragma unroll
        for (int i = 0; i < 4; ++i)
#pragma unroll
          for (int j = 0; j < 4; ++j) acc[i][j] = __builtin_amdgcn_mfma_f32_16x16x32_bf16(bfr[j], af[i], acc[i][j], 0, 0, 0);
      }
    }
    if (kt + 1 < nk) G_STORE(st ^ 1, kt + 1);
    __syncthreads();
  }
#undef G_LOAD
#undef G_XFORM
#undef G_STORE
}


#define G2_STAGE_BYTES 32768
#define G2_MU_OFF (3 * G2_STAGE_BYTES)
DEV int g2_swz(int row) { return (0x78 >> (2 * ((row >> 2) & 3))) & 3; }
template <int AMODE>
DEV void gemm_main256(f32x4 (&acc)[8][4], const u16* __restrict__ A, int lda, const u16* __restrict__ Bt, int ldb, int nk64,
                      int m0, int n0, const float* __restrict__ mu, const u16* __restrict__ SH, char* smem) {
  const int tid = threadIdx.x, lane = tid & 63, wid = tid >> 6, wr = wid >> 2, wc = wid & 3, fr = lane & 15, fq = lane >> 4;
  const int nk = nk64 * 2;
  const int lrow2 = 2 * (tid >> 2), lch = tid & 3;
#pragma unroll
  for (int i = 0; i < 8; ++i)
#pragma unroll
    for (int j = 0; j < 4; ++j) acc[i][j] = (f32x4){0.f, 0.f, 0.f, 0.f};
  const u16* pa0 = A + (size_t)(m0 + lrow2) * lda + lch * 8;
  const u16* pp0 = nullptr;
  if (AMODE != 0) pp0 = seq_start(m0 + lrow2) ? SH + seq_of(m0 + lrow2) * 1024 + lch * 8 : pa0 - lda;
  const u16* pb0 = Bt + (size_t)(n0 + lrow2) * ldb + lch * 8;
  const int woff0 = (lrow2 + 0) * 64 + ((lch ^ g2_swz(lrow2 + 0)) << 4);
  const int woff1 = (lrow2 + 1) * 64 + ((lch ^ g2_swz(lrow2 + 1)) << 4);
  const float* muL = (const float*)(smem + G2_MU_OFF);
  if (AMODE == 1) {
    if (tid < 256) *(float4*)(smem + G2_MU_OFF + tid * 16) = *(const float4*)(mu + tid * 4);
  }
  uint4 xa0, xa1, xp, xb0, xb1;
  uint4 ya0, ya1, yp, yb0, yb1;
  xp = yp = make_uint4(0, 0, 0, 0);

#define K_LOAD(S, kt)                                                                  \
  {                                                                                    \
    const int k0_ = (kt) * 32;                                                         \
    S##a0 = *(const uint4*)(pa0 + k0_); S##a1 = *(const uint4*)(pa0 + lda + k0_);      \
    if (AMODE == 1) S##p = *(const uint4*)(pp0 + k0_);                                 \
    S##b0 = *(const uint4*)(pb0 + k0_); S##b1 = *(const uint4*)(pb0 + ldb + k0_);      \
  }
#define K_XFORM(dst, a_, p_)                                                           \
  {                                                                                    \
    if (AMODE == 0) dst = a_;                                                          \
    else {                                                                             \
      float h_[8], q_[8]; unpack8(a_, h_); unpack8(p_, q_);                            \
      dst.x = pack2(h_[0] + mu0.x * (q_[0] - h_[0]), h_[1] + mu0.y * (q_[1] - h_[1])); \
      dst.y = pack2(h_[2] + mu0.z * (q_[2] - h_[2]), h_[3] + mu0.w * (q_[3] - h_[3])); \
      dst.z = pack2(h_[4] + mu1.x * (q_[4] - h_[4]), h_[5] + mu1.y * (q_[5] - h_[5])); \
      dst.w = pack2(h_[6] + mu1.z * (q_[6] - h_[6]), h_[7] + mu1.w * (q_[7] - h_[7])); \
    }                                                                                  \
  }
#define K_STORE(S, stage, kt)                                                          \
  {                                                                                    \
    char* sA_ = smem + (stage) * G2_STAGE_BYTES; char* sB_ = sA_ + 16384;              \
    uint4 v_; float4 mu0, mu1;                                                         \
    if (AMODE == 1) { mu0 = *(const float4*)(muL + (kt) * 32 + lch * 8); mu1 = *(const float4*)(muL + (kt) * 32 + lch * 8 + 4); } \
    K_XFORM(v_, S##a0, S##p); *(uint4*)(sA_ + woff0) = v_;                             \
    K_XFORM(v_, S##a1, S##a0); *(uint4*)(sA_ + woff1) = v_;                            \
    *(uint4*)(sB_ + woff0) = S##b0; *(uint4*)(sB_ + woff1) = S##b1;                    \
  }
#define K_COMPUTE_HALF(stage, i0)                                                      \
  {                                                                                    \
    const char* sA_ = smem + (stage) * G2_STAGE_BYTES;                                 \
    _Pragma("unroll") for (int i = (i0); i < (i0) + 4; ++i) {                          \
      const bf16x8 af = *(const bf16x8*)(sA_ + (wr * 128 + i * 16 + fr) * 64 + cho);   \
      _Pragma("unroll") for (int j = 0; j < 4; ++j) acc[i][j] = __builtin_amdgcn_mfma_f32_16x16x32_bf16(bfr[j], af, acc[i][j], 0, 0, 0); \
    }                                                                                  \
  }
#define K_LOAD_B(stage)                                                                \
  {                                                                                    \
    const char* sB_ = smem + (stage) * G2_STAGE_BYTES + 16384;                         \
    _Pragma("unroll") for (int j = 0; j < 4; ++j) bfr[j] = *(const bf16x8*)(sB_ + (wc * 64 + j * 16 + fr) * 64 + cho); \
  }
#define K_ITER(kt, L, S)                                                               \
  {                                                                                    \
    K_LOAD(L, min((kt) + 2, nk - 1));                                                  \
    __builtin_amdgcn_sched_barrier(0);                                                 \
    bf16x8 bfr[4];                                                                     \
    K_LOAD_B(cu);                                                                      \
    K_COMPUTE_HALF(cu, 0);                                                             \
    __builtin_amdgcn_sched_barrier(0);                                                 \
    K_STORE(S, nx, min((kt) + 1, nk - 1));                                             \
    __builtin_amdgcn_sched_barrier(0);                                                 \
    if (AMODE == 1) K_LOAD_B(cu);                                                      \
    K_COMPUTE_HALF(cu, 4);                                                             \
    __syncthreads();                                                                   \
    cu = nx; nx = (nx == 2) ? 0 : nx + 1;                                              \
  }
  const int cho = (fq ^ g2_swz(fr)) << 4;
  if (AMODE == 1) __syncthreads();
  K_LOAD(x, 0);
  K_LOAD(y, 1);
  K_STORE(x, 0, 0);
  __syncthreads();
  int cu = 0, nx = 1;
  for (int kt = 0; kt < nk; kt += 2) {
    K_ITER(kt, x, y);
    K_ITER(kt + 1, y, x);
  }
#undef K_LOAD
#undef K_XFORM
#undef K_STORE
#undef K_COMPUTE_HALF
#undef K_LOAD_B
#undef K_ITER
}


#define GD_NST 4
DEV void gemm_main256_dma(f32x4 (&acc)[8][4], const u16* __restrict__ A, int lda, const u16* __restrict__ Bt, int ldb, int nk64,
                          int m0, int n0, char* smem) {
  const int tid = threadIdx.x, lane = tid & 63, wid = tid >> 6, wr = wid >> 2, wc = wid & 3, fr = lane & 15, fq = lane >> 4;
  const int nk = nk64 * 2;
#pragma unroll
  for (int i = 0; i < 8; ++i)
#pragma unroll
    for (int j = 0; j < 4; ++j) acc[i][j] = (f32x4){0.f, 0.f, 0.f, 0.f};
  const int prow = 16 * wid + (lane >> 2);
  const int pch = (lane & 3) ^ g2_swz(prow);
  const u16* srcA = A + (size_t)(m0 + prow) * lda + pch * 8;
  const u16* srcB = Bt + (size_t)(n0 + prow) * ldb + pch * 8;
  const size_t a128 = (size_t)128 * lda, b128 = (size_t)128 * ldb;
  char* ldsw = smem + (16 * wid) * 64;
#define D_FILL(kt, stage)                                                              \
  {                                                                                    \
    const int k0_ = (kt) * 32;                                                         \
    char* d_ = ldsw + (stage) * G2_STAGE_BYTES;                                        \
    __builtin_amdgcn_global_load_lds((const unsigned*)(srcA + k0_), (unsigned*)(d_), 16, 0, 0);               \
    __builtin_amdgcn_global_load_lds((const unsigned*)(srcA + a128 + k0_), (unsigned*)(d_ + 8192), 16, 0, 0); \
    __builtin_amdgcn_global_load_lds((const unsigned*)(srcB + k0_), (unsigned*)(d_ + 16384), 16, 0, 0);       \
    __builtin_amdgcn_global_load_lds((const unsigned*)(srcB + b128 + k0_), (unsigned*)(d_ + 16384 + 8192), 16, 0, 0); \
  }
  const int cho = (fq ^ g2_swz(fr)) << 4;
  __syncthreads();
  D_FILL(0, 0);
  D_FILL(min(1, nk - 1), 1);
  D_FILL(min(2, nk - 1), 2);
  int cu = 0, fill = 3;
  for (int kt = 0; kt < nk; ++kt) {
    asm volatile("s_waitcnt vmcnt(8)" ::: "memory");
    asm volatile("s_waitcnt lgkmcnt(0)" ::: "memory");
    __builtin_amdgcn_s_barrier();
    D_FILL(min(kt + 3, nk - 1), fill);
    {
      const char* sA_ = smem + cu * G2_STAGE_BYTES;
      const char* sB_ = sA_ + 16384;
      bf16x8 bfr[4];
#pragma unroll
      for (int j = 0; j < 4; ++j) bfr[j] = *(const bf16x8*)(sB_ + (wc * 64 + j * 16 + fr) * 64 + cho);
#pragma unroll
      for (int i = 0; i < 8; ++i) {
        const bf16x8 af = *(const bf16x8*)(sA_ + (wr * 128 + i * 16 + fr) * 64 + cho);
#pragma unroll
        for (int j = 0; j < 4; ++j) acc[i][j] = __builtin_amdgcn_mfma_f32_16x16x32_bf16(bfr[j], af, acc[i][j], 0, 0, 0);
      }
    }
    cu = (cu == GD_NST - 1) ? 0 : cu + 1;
    fill = (fill == GD_NST - 1) ? 0 : fill + 1;
  }
  asm volatile("s_waitcnt vmcnt(0)" ::: "memory");
  asm volatile("s_waitcnt lgkmcnt(0)" ::: "memory");
  __builtin_amdgcn_s_barrier();
#undef D_FILL
}

DEV void transpose_tile(const float* __restrict__ src, int N, int k0, int n0, const float* __restrict__ scale, u16* __restrict__ dst,
                        int dstride, int drow0, int dcol0, char* smem) {
  float* tile = (float*)smem;
  const int tid = threadIdx.x;
#pragma unroll
  for (int i = 0; i < 2; ++i) {
    int kl = (tid >> 4) + 32 * i, n4 = (tid & 15) * 4;
    float4 v = *(const float4*)(src + (size_t)(k0 + kl) * N + n0 + n4);
    float s = scale ? scale[k0 + kl] : 1.0f;
    tile[kl * 65 + n4 + 0] = v.x * s; tile[kl * 65 + n4 + 1] = v.y * s;
    tile[kl * 65 + n4 + 2] = v.z * s; tile[kl * 65 + n4 + 3] = v.w * s;
  }
  __syncthreads();
  {
    int nl = tid >> 3, k8 = (tid & 7) * 8;
    uint4 o;
    o.x = pack2(tile[(k8 + 0) * 65 + nl], tile[(k8 + 1) * 65 + nl]);
    o.y = pack2(tile[(k8 + 2) * 65 + nl], tile[(k8 + 3) * 65 + nl]);
    o.z = pack2(tile[(k8 + 4) * 65 + nl], tile[(k8 + 5) * 65 + nl]);
    o.w = pack2(tile[(k8 + 6) * 65 + nl], tile[(k8 + 7) * 65 + nl]);
    *(uint4*)(dst + (size_t)(drow0 + n0 + nl) * dstride + dcol0 + k0 + k8) = o;
  }
  __syncthreads();
}

DEV void phase_prep(const Params& p, char* smem) {
  const int tid = threadIdx.x;
  char* ws = p.ws;
  if (blockIdx.x < 96) {
    float* cL = (float*)smem;
    float* red = (float*)(smem + 98304);
    for (int e = tid; e < 24 * 256; e += NTHREADS) {
      int s = e >> 8, k4 = (e & 255) * 4;
      float4 v = s < 8 ? *(const float4*)(p.in[I_CP] + s * 1024 + k4) : *(const float4*)(p.in[I_CS] + (s - 8) * 1024 + k4);
      *(float4*)(cL + s * 1024 + k4) = v;
    }
    __syncthreads();
    for (int item = blockIdx.x; item < 96; item += gridDim.x) {
      const int l = item / 48, j0 = (item % 48) * 64;
      const float* W = (l == 0 ? p.in[I_AADAW] : p.in[I_BADAW]);
      const float* bias = (l == 0 ? p.in[I_AADAB] : p.in[I_BADAB]);
      const int col = tid & 63, kg = tid >> 6;
      float acc[24];
#pragma unroll
      for (int s = 0; s < 24; ++s) acc[s] = 0.f;
      for (int k = kg * 128; k < kg * 128 + 128; ++k) {
        float w = W[(size_t)k * 3072 + j0 + col];
#pragma unroll
        for (int s = 0; s < 24; ++s) acc[s] += cL[s * 1024 + k] * w;
      }
#pragma unroll
      for (int s = 0; s < 24; ++s) red[(kg * 24 + s) * 64 + col] = acc[s];
      __syncthreads();
      float* mod = (float*)(ws + WS_MOD);
      for (int e = tid; e < 24 * 64; e += NTHREADS) {
        int s = e >> 6, c = e & 63;
        float t = bias[j0 + c];
#pragma unroll
        for (int g = 0; g < 8; ++g) t += red[(g * 24 + s) * 64 + c];
        mod[(size_t)(l * 24 + s) * 3072 + j0 + c] = t;
      }
      __syncthreads();
    }
  }
  if (blockIdx.x == 0) for (int e = tid; e < 1024; e += NTHREADS) ((unsigned*)(ws + WS_CTR))[e] = 0u;
  if (blockIdx.x == gridDim.x - 1) {
    u16* SH = (u16*)(ws + WS_SH);
    for (int e = tid; e < 24 * 1024; e += NTHREADS) {
      int s = e >> 10, k = e & 1023;
      float v = s < 8 ? 0.f : p.in[I_SSH][(s - 8) * 1024 + k];
      SH[e] = (u16)(pack2(v, 0.f) & 0xffff);
    }
  }
  const int NT_TOTAL = 2048 + 512 + 1024 + 1024 + 512 + 32 + 32 + 64;
  for (int t = blockIdx.x; t < NT_TOTAL; t += gridDim.x) {
    const float* src; int K, N; u16* dst; int dstride, drow0 = 0, dcol0 = 0; const float* scale = nullptr; int tt = t;
    if (tt < 2048) { src = p.in[I_AWIN]; K = 1024; N = 8192; dst = (u16*)(ws + WS_WT_IN); dstride = 1024; }
    else if ((tt -= 2048) < 512) { src = p.in[I_AWOUT]; K = 2048; N = 1024; dst = (u16*)(ws + WS_WT_OUTA); dstride = 2048; }
    else if ((tt -= 512) < 1024) { src = p.in[I_KVW]; K = 1024; N = 4096; dst = (u16*)(ws + WS_WT_KV); dstride = 1024; }
    else if ((tt -= 1024) < 1024) { src = p.in[I_BWIN]; K = 1024; N = 4096; dst = (u16*)(ws + WS_WT_INB); dstride = 1024; }
    else if ((tt -= 1024) < 512) { src = p.in[I_BWOUT]; K = 2048; N = 1024; dst = (u16*)(ws + WS_WT_OUTB); dstride = 2048; }
    else if ((tt -= 512) < 32) { src = p.in[I_AW2]; K = 64; N = 2048; dst = (u16*)(ws + WS_W2T); dstride = 64; }
    else if ((tt -= 32) < 32) { src = p.in[I_AA2]; K = 64; N = 2048; dst = (u16*)(ws + WS_A2T); dstride = 64; }
    else {
      tt -= 32;
      int job = tt >> 4; tt &= 15;
      K = 1024; N = 64; dst = (u16*)(ws + WS_L1T); dstride = 2048;
      src = (job < 2) ? p.in[I_AW1] : p.in[I_AA1];
      drow0 = (job < 2) ? 0 : 64;
      if (job & 1) { dcol0 = 1024; scale = (job < 2) ? p.in[I_AMUW] : p.in[I_AMUA]; }
    }
    const int ntn = N / 64;
    const int kt = tt / ntn, nt = tt % ntn;
    transpose_tile(src, N, kt * 64, nt * 64, scale, dst, dstride, drow0, dcol0, smem);
  }
}

DEV void phase_norm0(const Params& p) {
  const int lane = threadIdx.x & 63, wid = threadIdx.x >> 6;
  const float* mod = (const float*)(p.ws + WS_MOD);
  u16* H0 = (u16*)(p.ws + WS_H0);
  const float* g = p.in[I_ANG];
  for (int t = blockIdx.x * 8 + wid; t < NTOK; t += gridDim.x * 8) {
    const float* x = t < TP ? p.in[I_XP] + (size_t)t * 1024 : p.in[I_XS] + (size_t)(t - TP) * 1024;
    const int s = seq_of(t);
    const float* md = mod + (size_t)s * 3072;
    float4 v[4];
    float ss = 0.f;
#pragma unroll
    for (int i = 0; i < 4; ++i) {
      v[i] = *(const float4*)(x + lane * 4 + 256 * i);
      ss += v[i].x * v[i].x + v[i].y * v[i].y + v[i].z * v[i].z + v[i].w * v[i].w;
    }
    ss = wave_sum(ss);
    const float rstd = rsqrtf(ss * (1.0f / 1024.0f) + 1e-6f);
    bool last = t < TP ? ((t & 4095) == 4095) : (((t - TP) & 31) == 31);
    float* so = t < TP ? p.out + OFF_SH_P + (t >> 12) * 1024 : p.out + OFF_SH_S + ((t - TP) >> 5) * 1024;
#pragma unroll
    for (int i = 0; i < 4; ++i) {
      const int c = lane * 4 + 256 * i;
      float4 gg = *(const float4*)(g + c), sh = *(const float4*)(md + c), sc = *(const float4*)(md + 1024 + c);
      float4 h;
      h.x = v[i].x * rstd * gg.x * (1.f + sc.x) + sh.x;
      h.y = v[i].y * rstd * gg.y * (1.f + sc.y) + sh.y;
      h.z = v[i].z * rstd * gg.z * (1.f + sc.z) + sh.z;
      h.w = v[i].w * rstd * gg.w * (1.f + sc.w) + sh.w;
      uint2 o; o.x = pack2(h.x, h.y); o.y = pack2(h.z, h.w);
      *(uint2*)(H0 + (size_t)t * 1024 + c) = o;
      if (last) *(float4*)(so + c) = h;
    }
  }
}

DEV void phase_proj0_lora(const Params& p, char* smem) {
  const int tid = threadIdx.x, lane = tid & 63, wid = tid >> 6, fr = lane & 15, fq = lane >> 4;
  const int wr = wid >> 1, wc = wid & 1;
  char* ws = p.ws;
  const u16* H0 = (const u16*)(ws + WS_H0);
  const u16* SH = (const u16*)(ws + WS_SH);
  u16* T = (u16*)(ws + WS_T);
  const int xcc0 = xcc_id();
  int nxt;
  f32x4 acc[4][4];
  for (int ls = 0; ls < 8; ++ls) {
  const int xcd = (xcc0 + ls) & 7;
  unsigned* ctr = sched_ctr(p, 0, xcd);
  for (int li = sched_first(ctr, smem); li < 17; li = sched_commit(nxt, smem)) {
    nxt = sched_prefetch(ctr);
    const int lmt = xcd + 8 * li;
    if (lmt >= 130) continue;
    const int m0 = lmt * 256;
    gemm_main<2>(acc, H0, 1024, (const u16*)(ws + WS_L1T), 2048, 32, m0, 0, nullptr, SH, smem);
#pragma unroll
    for (int i = 0; i < 4; ++i)
#pragma unroll
      for (int j = 0; j < 4; ++j) {
        const int m = m0 + wr * 64 + i * 16 + fr, n = wc * 64 + j * 16 + fq * 4;
        f32x4 v = acc[i][j];
        if (wc == 0) { v[0] = tanhf(v[0]); v[1] = tanhf(v[1]); v[2] = tanhf(v[2]); v[3] = tanhf(v[3]); }
        uint2 o; o.x = pack2(v[0], v[1]); o.y = pack2(v[2], v[3]);
        *(uint2*)(T + (size_t)m * 128 + n) = o;
      }
  }
  }
}

DEV void phase_proj0_main(const Params& p, char* smem) {
  const int tid = threadIdx.x, lane = tid & 63, wid = tid >> 6, fr = lane & 15, fq = lane >> 4;
  const int wr = wid >> 2, wc = wid & 3;
  char* ws = p.ws;
  const u16* H0 = (const u16*)(ws + WS_H0);
  const u16* SH = (const u16*)(ws + WS_SH);
  const int xcc0 = xcc_id();
  int nxt;
  f32x4 acc[8][4];
  for (int ls = 0; ls < 8; ++ls) {
  const int xcd = (xcc0 + ls) & 7;
  unsigned* ctr = sched_ctr(p, 4, xcd);
  for (int q = sched_first(ctr, smem); q < 520; q = sched_commit(nxt, smem)) {
    nxt = sched_prefetch(ctr);
    const int mt = q >> 2, nt = 4 * xcd + (q & 3);
    const int part = nt >> 3;
    const int m0 = mt * 256, n0 = nt * 256;
    gemm_main256<1>(acc, H0, 1024, (const u16*)(ws + WS_WT_IN), 1024, 16, m0, n0, p.in[I_AMUIN] + part * 1024, SH, smem);
    u16* dst = (u16*)(ws + (size_t)part * SLOT);
    const int nb = n0 - part * 2048;
#pragma unroll
    for (int i = 0; i < 8; ++i)
#pragma unroll
      for (int j = 0; j < 4; ++j) {
        const int row = wr * 128 + i * 16 + fr, col = wc * 64 + j * 16 + fq * 4;
        f32x4 v = acc[i][j];
        uint2 o; o.x = pack2(v[0], v[1]); o.y = pack2(v[2], v[3]);
        *(uint2*)(smem + row * 528 + col * 2) = o;
      }
    __syncthreads();
#pragma unroll
    for (int qq = 0; qq < 16; ++qq) {
      const int c = tid + 512 * qq, row = c >> 5, ch = c & 31;
      const uint4 v = *(const uint4*)(smem + row * 528 + ch * 16);
      *(uint4*)(dst + (size_t)(m0 + row) * 2048 + nb + ch * 8) = v;
    }
    __syncthreads();
  }
  }
}

DEV void phase_proj0(const Params& p, char* smem) {
  phase_proj0_lora(p, smem);
  phase_proj0_main(p, smem);
}

DEV void phase_scan(const Params& p, char* smem) {
  const int tid = threadIdx.x, lane = tid & 63, wid = tid >> 6;
  u16* Hkk = (u16*)smem;
  u16* Hw = Hkk + 4096;
  u16* Hb = Hw + 4096;
  u16* Hk = Hb + 4096;
  u16* Hwr = Hk + 4096;
  unsigned* Hv2 = (unsigned*)(smem + 40960);
  float* LY = (float*)(smem + 57344);
  float* Lbon = LY + 8192;
  float* Lsc = Lbon + 64;
  float* Lwa = Lsc + 128;
  char* ws = p.ws;
  const u16* gR = (const u16*)(ws + 0 * SLOT);
  const u16* gK = (const u16*)(ws + 1 * SLOT);
  const u16* gV = (const u16*)(ws + 2 * SLOT);
  const u16* gZ = (const u16*)(ws + 3 * SLOT);
  const u16* gT = (const u16*)(ws + WS_T);
  const u16* W2T = (const u16*)(ws + WS_W2T);
  const u16* A2T = (const u16*)(ws + WS_A2T);
  const int fr = lane & 15, fq = lane >> 4, lmt = wid & 3, lnh = wid >> 2;
  u16* YG = (u16*)(ws + 6 * SLOT);
  const int tt = tid >> 3, c8 = (tid & 7) * 8;
  const int srow = tid >> 3, kc = tid & 7;

  for (int item = blockIdx.x; item < 768; item += gridDim.x) {
    int h, tok0, nsteps; const float* sinit; float* sout;
    if (item < 256) { h = item & 31; tok0 = (item >> 5) * 4096; nsteps = 4096; sinit = nullptr; sout = p.out + OFF_WKV_P + (size_t)item * 4096; }
    else { int it = item - 256; h = it & 31; tok0 = TP + (it >> 5) * 32; nsteps = 32; sinit = p.in[I_SWKV] + (size_t)it * 4096; sout = p.out + OFF_WKV_S + (size_t)it * 4096; }
    const int nch = (nsteps + 63) >> 6;
    const int col0 = h * 64 + c8;
    float ckk[8], cka[8], crk[8], clg[8], clb[8];
    {
      float4 t0, t1;
      t0 = *(const float4*)(p.in[I_AKK] + col0); t1 = *(const float4*)(p.in[I_AKK] + col0 + 4);
      ckk[0] = t0.x; ckk[1] = t0.y; ckk[2] = t0.z; ckk[3] = t0.w; ckk[4] = t1.x; ckk[5] = t1.y; ckk[6] = t1.z; ckk[7] = t1.w;
      t0 = *(const float4*)(p.in[I_AKA] + col0); t1 = *(const float4*)(p.in[I_AKA] + col0 + 4);
      cka[0] = t0.x; cka[1] = t0.y; cka[2] = t0.z; cka[3] = t0.w; cka[4] = t1.x; cka[5] = t1.y; cka[6] = t1.z; cka[7] = t1.w;
      t0 = *(const float4*)(p.in[I_ARK] + col0); t1 = *(const float4*)(p.in[I_ARK] + col0 + 4);
      crk[0] = t0.x; crk[1] = t0.y; crk[2] = t0.z; crk[3] = t0.w; crk[4] = t1.x; crk[5] = t1.y; crk[6] = t1.z; crk[7] = t1.w;
      t0 = *(const float4*)(p.in[I_ALNG] + col0); t1 = *(const float4*)(p.in[I_ALNG] + col0 + 4);
      clg[0] = t0.x; clg[1] = t0.y; clg[2] = t0.z; clg[3] = t0.w; clg[4] = t1.x; clg[5] = t1.y; clg[6] = t1.z; clg[7] = t1.w;
      t0 = *(const float4*)(p.in[I_ALNB] + col0); t1 = *(const float4*)(p.in[I_ALNB] + col0 + 4);
      clb[0] = t0.x; clb[1] = t0.y; clb[2] = t0.z; clb[3] = t0.w; clb[4] = t1.x; clb[5] = t1.y; clb[6] = t1.z; clb[7] = t1.w;
    }
    float cw0[8], ca0[8];
    {
      float4 t0 = *(const float4*)(p.in[I_AW0] + col0), t1 = *(const float4*)(p.in[I_AW0] + col0 + 4);
      cw0[0] = t0.x; cw0[1] = t0.y; cw0[2] = t0.z; cw0[3] = t0.w; cw0[4] = t1.x; cw0[5] = t1.y; cw0[6] = t1.z; cw0[7] = t1.w;
      t0 = *(const float4*)(p.in[I_AA0] + col0); t1 = *(const float4*)(p.in[I_AA0] + col0 + 4);
      ca0[0] = t0.x; ca0[1] = t0.y; ca0[2] = t0.z; ca0[3] = t0.w; ca0[4] = t1.x; ca0[5] = t1.y; ca0[6] = t1.z; ca0[7] = t1.w;
    }
    bf16x8 w2f[2][2], a2f[2][2];
#pragma unroll
    for (int n2 = 0; n2 < 2; ++n2)
#pragma unroll
      for (int ks = 0; ks < 2; ++ks) {
        const size_t o_ = (size_t)(h * 64 + lnh * 32 + n2 * 16 + fr) * 64 + ks * 32 + fq * 8;
        w2f[n2][ks] = *(const bf16x8*)(W2T + o_);
        a2f[n2][ks] = *(const bf16x8*)(A2T + o_);
      }
    h2_t sa_, sb_, sc_, sd_;
    if (sinit) {
      float4 a = *(const float4*)(sinit + srow * 64 + kc * 8), b = *(const float4*)(sinit + srow * 64 + kc * 8 + 4);
      sa_ = (h2_t){(_Float16)a.x, (_Float16)a.y}; sb_ = (h2_t){(_Float16)a.z, (_Float16)a.w};
      sc_ = (h2_t){(_Float16)b.x, (_Float16)b.y}; sd_ = (h2_t){(_Float16)b.z, (_Float16)b.w};
    } else {
      sa_ = sb_ = sc_ = sd_ = (h2_t){(_Float16)0.f, (_Float16)0.f};
    }
    uint4 cr, ck, cv, cz;
    bf16x8 t1f[2], t2f[2];
#define SCAN_LOAD(c)                                                                   \
    {                                                                                  \
      const int tl_ = (c) * 64 + tt;                                                   \
      if (tl_ < nsteps) {                                                              \
        const size_t o_ = (size_t)(tok0 + tl_) * 2048 + col0;                          \
        cr = *(const uint4*)(gR + o_); ck = *(const uint4*)(gK + o_); cv = *(const uint4*)(gV + o_); \
        cz = *(const uint4*)(gZ + o_);                                                 \
      } else { cr = ck = cv = cz = make_uint4(0, 0, 0, 0); }                           \
      const int tm_ = (c) * 64 + lmt * 16 + fr;                                        \
      if (tm_ < nsteps) {                                                              \
        const u16* tp_ = gT + (size_t)(tok0 + tm_) * 128 + fq * 8;                     \
        t1f[0] = *(const bf16x8*)(tp_); t1f[1] = *(const bf16x8*)(tp_ + 32);           \
        t2f[0] = *(const bf16x8*)(tp_ + 64); t2f[1] = *(const bf16x8*)(tp_ + 96);      \
      } else { t1f[0] = t1f[1] = t2f[0] = t2f[1] = (bf16x8){0, 0, 0, 0, 0, 0, 0, 0}; } \
    }
    SCAN_LOAD(0);
    for (int c = 0; c < nch; ++c) {
      {
#pragma unroll
        for (int n2 = 0; n2 < 2; ++n2) {
          f32x4 xw = {0.f, 0.f, 0.f, 0.f}, xa = {0.f, 0.f, 0.f, 0.f};
          xw = __builtin_amdgcn_mfma_f32_16x16x32_bf16(w2f[n2][0], t1f[0], xw, 0, 0, 0);
          xw = __builtin_amdgcn_mfma_f32_16x16x32_bf16(w2f[n2][1], t1f[1], xw, 0, 0, 0);
          xa = __builtin_amdgcn_mfma_f32_16x16x32_bf16(a2f[n2][0], t2f[0], xa, 0, 0, 0);
          xa = __builtin_amdgcn_mfma_f32_16x16x32_bf16(a2f[n2][1], t2f[1], xa, 0, 0, 0);
          const int o_ = (lmt * 16 + fr) * 64 + lnh * 32 + n2 * 16 + fq * 4;
          *(float4*)(Lwa + o_) = make_float4(xw[0], xw[1], xw[2], xw[3]);
          *(float4*)(Lwa + 4096 + o_) = make_float4(xa[0], xa[1], xa[2], xa[3]);
        }
      }
      __syncthreads();
      uint4 zc = cz;
      {
        float r[8], k[8], v[8], lw[8], a[8];
        unpack8(cr, r); unpack8(ck, k); unpack8(cv, v);
        {
          const float4 x0 = *(const float4*)(Lwa + tt * 64 + c8), x1 = *(const float4*)(Lwa + tt * 64 + c8 + 4);
          const float4 y0 = *(const float4*)(Lwa + 4096 + tt * 64 + c8), y1 = *(const float4*)(Lwa + 4096 + tt * 64 + c8 + 4);
          const float xw_[8] = {x0.x, x0.y, x0.z, x0.w, x1.x, x1.y, x1.z, x1.w};
          const float xa_[8] = {y0.x, y0.y, y0.z, y0.w, y1.x, y1.y, y1.z, y1.w};
#pragma unroll
          for (int j = 0; j < 8; ++j) {
            lw[j] = -0.60653066f * sigmoidf_(cw0[j] + xw_[j]);
            a[j] = sigmoidf_(ca0[j] + xa_[j]);
          }
        }
        float kkv[8], kp[8], w[8], bon = 0.f, ss = 0.f, kr = 0.f;
#pragma unroll
        for (int j = 0; j < 8; ++j) {
          kkv[j] = k[j] * ckk[j]; ss += kkv[j] * kkv[j];
          kp[j] = k[j] * (1.f + (a[j] - 1.f) * cka[j]);
          bon += r[j] * kp[j] * crk[j];
          kr += r[j] * kp[j];
          w[j] = __expf(lw[j]);
        }
        ss = red8(ss); bon = red8(bon); kr = red8(kr);
        const float inv = rsqrtf(ss + 1e-12f);
        float bb[8], br = 0.f;
#pragma unroll
        for (int j = 0; j < 8; ++j) { kkv[j] *= inv; bb[j] = kkv[j] * a[j]; br += bb[j] * r[j]; }
        br = red8(br);
        const int ho = tt * 64 + c8;
        *(uint4*)(Hkk + ho) = make_uint4(packh2(kkv[0], kkv[1]), packh2(kkv[2], kkv[3]), packh2(kkv[4], kkv[5]), packh2(kkv[6], kkv[7]));
        *(uint4*)(Hb + ho) = make_uint4(packh2(bb[0], bb[1]), packh2(bb[2], bb[3]), packh2(bb[4], bb[5]), packh2(bb[6], bb[7]));
        *(uint4*)(Hw + ho) = make_uint4(packh2(w[0], w[1]), packh2(w[2], w[3]), packh2(w[4], w[5]), packh2(w[6], w[7]));
        *(uint4*)(Hk + ho) = make_uint4(packh2(kp[0], kp[1]), packh2(kp[2], kp[3]), packh2(kp[4], kp[5]), packh2(kp[6], kp[7]));
        *(uint4*)(Hwr + ho) = make_uint4(packh2(w[0] * r[0], w[1] * r[1]), packh2(w[2] * r[2], w[3] * r[3]), packh2(w[4] * r[4], w[5] * r[5]), packh2(w[6] * r[6], w[7] * r[7]));
        *(uint4*)(Hv2 + ho) = make_uint4(packh2(v[0], v[0]), packh2(v[1], v[1]), packh2(v[2], v[2]), packh2(v[3], v[3]));
        *(uint4*)(Hv2 + ho + 4) = make_uint4(packh2(v[4], v[4]), packh2(v[5], v[5]), packh2(v[6], v[6]), packh2(v[7], v[7]));
        if ((tid & 7) == 0) { Lbon[tt] = bon; *(float2*)(Lsc + tt * 2) = make_float2(br, kr); }
      }
      __syncthreads();
      if (c + 1 < nch) SCAN_LOAD(c + 1);
      {
        const int nT = min(64, nsteps - c * 64);
        const u16* pk = Hkk + kc * 8; const u16* pw = Hw + kc * 8; const u16* pb = Hb + kc * 8;
        const u16* pkp = Hk + kc * 8; const u16* pwr = Hwr + kc * 8; const unsigned* pv = Hv2 + srow;
        float* py = LY + srow * 2;
#define SCAN_LD(S, o)                                                                  \
        S##kk = *(const uint4*)(pk + (o)); S##w = *(const uint4*)(pw + (o)); S##b = *(const uint4*)(pb + (o)); \
        S##k = *(const uint4*)(pkp + (o)); S##wr = *(const uint4*)(pwr + (o)); S##v = pv[(o)];
#define H2(x) (*(const h2_t*)&(x))
#define SCAN_UPD(sreg, S, c)                                                           \
        sreg = __builtin_elementwise_fma(sreg, H2(S##w.c), __builtin_elementwise_fma(-n_, H2(S##b.c), H2(S##v) * H2(S##k.c)));
#define SCAN_STEP(S, o)                                                                \
        {                                                                              \
          float d = __builtin_amdgcn_fdot2(sa_, H2(S##kk.x), 0.f, false);              \
          float e = __builtin_amdgcn_fdot2(sa_, H2(S##wr.x), 0.f, false);              \
          d = __builtin_amdgcn_fdot2(sb_, H2(S##kk.y), d, false); e = __builtin_amdgcn_fdot2(sb_, H2(S##wr.y), e, false); \
          d = __builtin_amdgcn_fdot2(sc_, H2(S##kk.z), d, false); e = __builtin_amdgcn_fdot2(sc_, H2(S##wr.z), e, false); \
          d = __builtin_amdgcn_fdot2(sd_, H2(S##kk.w), d, false); e = __builtin_amdgcn_fdot2(sd_, H2(S##wr.w), e, false); \
          d += dppf<0xB1>(d); e += dppf<0xB1>(e);                                      \
          d += dppf<0x4E>(d); e += dppf<0x4E>(e);                                      \
          d += dppf<0x141>(d); e += dppf<0x141>(e);                                    \
          const unsigned nu_ = packh2(d, d);                                           \
          const h2_t n_ = H2(nu_);                                                     \
          SCAN_UPD(sa_, S, x) SCAN_UPD(sb_, S, y) SCAN_UPD(sc_, S, z) SCAN_UPD(sd_, S, w) \
          if (kc == 0) *(float2*)(py + 2 * (o)) = make_float2(e, d);                   \
        }
        uint4 Akk, Aw, Ab, Ak, Awr, Bkk, Bw, Bb, Bk, Bwr; unsigned Av, Bv;
        SCAN_LD(A, 0);
        for (int t = 0; t < nT; t += 2) {
          SCAN_LD(B, (t + 1) * 64);
          SCAN_STEP(A, t * 64);
          SCAN_LD(A, (t + 2) * 64);
          SCAN_STEP(B, (t + 1) * 64);
        }
#undef SCAN_UPD
#undef H2
#undef SCAN_LD
#undef SCAN_STEP
      }
      __syncthreads();
      {
        const int tl = c * 64 + tt;
        if (tl < nsteps) {
          float y[8], z[8];
          const float2 sc = *(const float2*)(Lsc + tt * 2);
          const uint4 va = *(const uint4*)(Hv2 + tt * 64 + c8), vb = *(const uint4*)(Hv2 + tt * 64 + c8 + 4);
          float vv[8];
          { const unsigned vu[8] = {va.x, va.y, va.z, va.w, vb.x, vb.y, vb.z, vb.w};
#pragma unroll
            for (int j = 0; j < 8; ++j) { h2_t t_ = *(const h2_t*)&vu[j]; vv[j] = (float)t_[0]; } }
#pragma unroll
          for (int q = 0; q < 4; ++q) {
            const float4 ed = *(const float4*)(LY + tt * 128 + (c8 + 2 * q) * 2);
            y[2 * q] = ed.x - ed.y * sc.x + vv[2 * q] * sc.y;
            y[2 * q + 1] = ed.z - ed.w * sc.x + vv[2 * q + 1] * sc.y;
          }
          float sm = y[0] + y[1] + y[2] + y[3] + y[4] + y[5] + y[6] + y[7];
          sm = red8(sm);
          const float mean = sm * (1.f / 64.f);
          float vs = 0.f;
#pragma unroll
          for (int j = 0; j < 8; ++j) { y[j] -= mean; vs += y[j] * y[j]; }
          vs = red8(vs);
          const float rstd = rsqrtf(vs * (1.f / 64.f) + 64e-5f);
          const float bon = Lbon[tt];
          unpack8(zc, z);
          float o[8];
#pragma unroll
          for (int j = 0; j < 8; ++j) {
            float t = y[j] * rstd * clg[j] + clb[j] + bon * vv[j];
            o[j] = t * z[j] * sigmoidf_(z[j]);
          }
          uint4 ov; ov.x = pack2(o[0], o[1]); ov.y = pack2(o[2], o[3]); ov.z = pack2(o[4], o[5]); ov.w = pack2(o[6], o[7]);
          *(uint4*)(YG + (size_t)(tok0 + tl) * 2048 + col0) = ov;
        }
      }
      __syncthreads();
    }
#undef SCAN_LOAD
    *(float4*)(sout + srow * 64 + kc * 8) = make_float4((float)sa_[0], (float)sa_[1], (float)sb_[0], (float)sb_[1]);
    *(float4*)(sout + srow * 64 + kc * 8 + 4) = make_float4((float)sc_[0], (float)sc_[1], (float)sd_[0], (float)sd_[1]);
  }
}

template <int LAYER>
DEV void outproj_store(const Params& p, const float* mod, float* xmid, int m, int n, f32x4 v) {
  const float* gate = mod + (size_t)seq_of(m) * 3072 + 2048;
  float4 g4 = *(const float4*)(gate + n);
  if (LAYER == 0) {
    const float* xr = m < TP ? p.in[I_XP] + (size_t)m * 1024 : p.in[I_XS] + (size_t)(m - TP) * 1024;
    float4 x4 = *(const float4*)(xr + n);
    *(float4*)(xmid + (size_t)m * 1024 + n) = make_float4(x4.x + g4.x * v[0], x4.y + g4.y * v[1], x4.z + g4.z * v[2], x4.w + g4.w * v[3]);
  } else {
    float4 x4 = *(const float4*)(xmid + (size_t)m * 1024 + n);
    float* yo = m < TP ? p.out + OFF_Y_P + (size_t)m * 1024 : p.out + OFF_Y_S + (size_t)(m - TP) * 1024;
    *(float4*)(yo + n) = make_float4(x4.x + g4.x * v[0], x4.y + g4.y * v[1], x4.z + g4.z * v[2], x4.w + g4.w * v[3]);
  }
}

template <int LAYER>
DEV void phase_outproj_main(const Params& p, char* smem) {
  const int tid = threadIdx.x, lane = tid & 63, wid = tid >> 6, wr = wid >> 2, wc = wid & 3, fr = lane & 15, fq = lane >> 4;
  char* ws = p.ws;
  const u16* A = (const u16*)(ws + 6 * SLOT);
  const u16* Bt = (const u16*)(ws + (LAYER == 0 ? WS_WT_OUTA : WS_WT_OUTB));
  const float* mod = (const float*)(ws + WS_MOD) + (size_t)LAYER * 24 * 3072;
  float* xmid = (float*)(ws + 0 * SLOT);
  f32x4 acc[8][4];
  const int xcc0 = xcc_id();
  int nxt;
  for (int ls = 0; ls < 8; ++ls) {
    const int xcd = (xcc0 + ls) & 7;
    unsigned* ctr = sched_ctr(p, LAYER == 0 ? 1 : 3, xcd);
    for (int li = sched_first(ctr, smem); li < 64; li = sched_commit(nxt, smem)) {
      nxt = sched_prefetch(ctr);
      const int item = 64 * xcd + li;
      const int m0 = (item >> 2) * 256, n0 = (item & 3) * 256;
      gemm_main256_dma(acc, A, 2048, Bt, 2048, 32, m0, n0, smem);
#pragma unroll
      for (int i = 0; i < 8; ++i)
#pragma unroll
        for (int j = 0; j < 4; ++j)
          outproj_store<LAYER>(p, mod, xmid, m0 + wr * 128 + i * 16 + fr, n0 + wc * 64 + j * 16 + fq * 4, acc[i][j]);
    }
  }
}

template <int LAYER>
DEV void phase_outproj_tail(const Params& p, char* smem) {
  const int tid = threadIdx.x, lane = tid & 63, wid = tid >> 6, wr = wid >> 1, wc = wid & 1, fr = lane & 15, fq = lane >> 4;
  char* ws = p.ws;
  const u16* A = (const u16*)(ws + 6 * SLOT);
  const u16* Bt = (const u16*)(ws + (LAYER == 0 ? WS_WT_OUTA : WS_WT_OUTB));
  const float* mod = (const float*)(ws + WS_MOD) + (size_t)LAYER * 24 * 3072;
  float* xmid = (float*)(ws + 0 * SLOT);
  f32x4 acc[4][4];
  const int xcc0 = xcc_id();
  int nxt;
  for (int ls = 0; ls < 8; ++ls) {
    const int xcd = (xcc0 + ls) & 7;
    unsigned* ctr = sched_ctr(p, LAYER == 0 ? 5 : 6, xcd);
    for (int li = sched_first(ctr, smem); li < 2; li = sched_commit(nxt, smem)) {
      nxt = sched_prefetch(ctr);
      const int item = 2 * xcd + li;
      const int m0 = (128 + (item >> 3)) * 256, n0 = (item & 7) * 128;
      gemm_main<0>(acc, A, 2048, Bt, 2048, 32, m0, n0, nullptr, nullptr, smem);
#pragma unroll
      for (int i = 0; i < 4; ++i)
#pragma unroll
        for (int j = 0; j < 4; ++j)
          outproj_store<LAYER>(p, mod, xmid, m0 + wr * 64 + i * 16 + fr, n0 + wc * 64 + j * 16 + fq * 4, acc[i][j]);
    }
  }
}

template <int LAYER>
DEV void phase_outproj(const Params& p, char* smem) {
  phase_outproj_tail<LAYER>(p, smem);
  phase_outproj_main<LAYER>(p, smem);
}

DEV void phase_norm1(const Params& p) {
  const int lane = threadIdx.x & 63, wid = threadIdx.x >> 6;
  const float* mod = (const float*)(p.ws + WS_MOD) + (size_t)24 * 3072;
  const float* xmid = (const float*)(p.ws + 0 * SLOT);
  u16* AKV = (u16*)(p.ws + 1 * SLOT);
  u16* AQ = AKV + (size_t)NTOK * 1024;
  const float* gkv = p.in[I_KVNG];
  const float* gb = p.in[I_BNG];
  for (int t = blockIdx.x * 8 + wid; t < NTOK; t += gridDim.x * 8) {
    const float* x = xmid + (size_t)t * 1024;
    const float* md = mod + (size_t)seq_of(t) * 3072;
    float4 v[4];
    float ss = 0.f;
#pragma unroll
    for (int i = 0; i < 4; ++i) {
      v[i] = *(const float4*)(x + lane * 4 + 256 * i);
      ss += v[i].x * v[i].x + v[i].y * v[i].y + v[i].z * v[i].z + v[i].w * v[i].w;
    }
    ss = wave_sum(ss);
    const float rstd = rsqrtf(ss * (1.0f / 1024.0f) + 1e-6f);
#pragma unroll
    for (int i = 0; i < 4; ++i) {
      const int c = lane * 4 + 256 * i;
      float4 g1 = *(const float4*)(gkv + c), g2 = *(const float4*)(gb + c), sh = *(const float4*)(md + c), sc = *(const float4*)(md + 1024 + c);
      float xn0 = v[i].x * rstd, xn1 = v[i].y * rstd, xn2 = v[i].z * rstd, xn3 = v[i].w * rstd;
      uint2 o;
      o.x = pack2(xn0 * g1.x, xn1 * g1.y); o.y = pack2(xn2 * g1.z, xn3 * g1.w);
      *(uint2*)(AKV + (size_t)t * 1024 + c) = o;
      o.x = pack2(xn0 * g2.x * (1.f + sc.x) + sh.x, xn1 * g2.y * (1.f + sc.y) + sh.y);
      o.y = pack2(xn2 * g2.z * (1.f + sc.z) + sh.z, xn3 * g2.w * (1.f + sc.w) + sh.w);
      *(uint2*)(AQ + (size_t)t * 1024 + c) = o;
    }
  }
}

#define QSCALE (0.08838834764831845f * 1.4426950408889634f)
DEV void phase_proj1(const Params& p, char* smem) {
  const int tid = threadIdx.x, lane = tid & 63, wid = tid >> 6, wr = wid >> 2, wc = wid & 3, fr = lane & 15, fq = lane >> 4;
  char* ws = p.ws;
  const u16* AKV = (const u16*)(ws + 1 * SLOT);
  const u16* AQ = AKV + (size_t)NTOK * 1024;
  u16* KB = (u16*)(ws + 2 * SLOT);
  u16* VB = (u16*)(ws + 3 * SLOT);
  u16* QB = (u16*)(ws + 4 * SLOT);
  u16* ZS = (u16*)(ws + 5 * SLOT);
  f32x4 acc[8][4];
  float* red = (float*)smem;
  const int xcc0 = xcc_id();
  int nxt;
  for (int ls = 0; ls < 8; ++ls) {
  const int xcd = (xcc0 + ls) & 7;
  unsigned* ctr = sched_ctr(p, 2, xcd);
  for (int li = sched_first(ctr, smem); li < 520; li = sched_commit(nxt, smem)) {
    nxt = sched_prefetch(ctr);
    const int mt = li >> 2, t = 4 * xcd + (li & 3);
    const int isq = t >> 4, nt = t & 15;
    const int m0 = mt * 256, n0 = nt * 256;
    gemm_main256_dma(acc, isq ? AQ : AKV, 1024, (const u16*)(ws + (isq ? WS_WT_INB : WS_WT_KV)), 1024, 16, m0, n0, smem);
    if (nt < 8) {
#pragma unroll
      for (int i = 0; i < 8; ++i) {
        float ss = 0.f;
#pragma unroll
        for (int j = 0; j < 4; ++j) ss += acc[i][j][0] * acc[i][j][0] + acc[i][j][1] * acc[i][j][1] + acc[i][j][2] * acc[i][j][2] + acc[i][j][3] * acc[i][j][3];
        red[(wr * 128 + i * 16 + fr) * 16 + wc * 4 + fq] = ss;
      }
      __syncthreads();
      const float* gain = isq ? p.in[I_BQG] : p.in[I_KGAIN];
#pragma unroll
      for (int i = 0; i < 8; ++i) {
        const int row = wr * 128 + i * 16 + fr, m = m0 + row;
        float4 ra = *(const float4*)(red + row * 16 + (wc >> 1) * 8), rb = *(const float4*)(red + row * 16 + (wc >> 1) * 8 + 4);
        float tot = ra.x + ra.y + ra.z + ra.w + rb.x + rb.y + rb.z + rb.w;
        float rs = rsqrtf(tot * (1.f / 128.f) + 1e-6f);
        if (isq) rs *= QSCALE;
#pragma unroll
        for (int j = 0; j < 4; ++j) {
          const int d = (wc & 1) * 64 + j * 16 + fq * 4, n = n0 + wc * 64 + j * 16 + fq * 4;
          float4 g4 = *(const float4*)(gain + d);
          f32x4 v = acc[i][j];
          float o0 = v[0] * rs * g4.x, o1 = v[1] * rs * g4.y, o2 = v[2] * rs * g4.z, o3 = v[3] * rs * g4.w;
          uint2 o; o.x = pack2(o0, o1); o.y = pack2(o2, o3);
          if (isq) {
            *(uint2*)(QB + (size_t)m * 2048 + n) = o;
          } else {
            *(uint2*)(KB + (size_t)m * 2048 + n) = o;
            float* ko = m < TP ? p.out + OFF_K_P + (size_t)m * 2048 : p.out + OFF_K_S + (size_t)(m - TP) * 2048;
            *(float4*)(ko + n) = make_float4(o0, o1, o2, o3);
          }
        }
      }
      __syncthreads();
    } else {
#pragma unroll
      for (int i = 0; i < 8; ++i) {
        const int m = m0 + wr * 128 + i * 16 + fr;
#pragma unroll
        for (int j = 0; j < 4; ++j) {
          const int n = n0 - 2048 + wc * 64 + j * 16 + fq * 4;
          f32x4 v = acc[i][j];
          if (isq) {
            float o0 = v[0] * sigmoidf_(v[0]), o1 = v[1] * sigmoidf_(v[1]), o2 = v[2] * sigmoidf_(v[2]), o3 = v[3] * sigmoidf_(v[3]);
            uint2 o; o.x = pack2(o0, o1); o.y = pack2(o2, o3);
            *(uint2*)(ZS + (size_t)m * 2048 + n) = o;
          } else {
            uint2 o; o.x = pack2(v[0], v[1]); o.y = pack2(v[2], v[3]);
            *(uint2*)(VB + (size_t)m * 2048 + n) = o;
            float* vo = m < TP ? p.out + OFF_V_P + (size_t)m * 2048 : p.out + OFF_V_S + (size_t)(m - TP) * 2048;
            *(float4*)(vo + n) = make_float4(v[0], v[1], v[2], v[3]);
          }
        }
      }
    }
  }
}
}

DEV unsigned off_b(unsigned row, unsigned ch) { return 256u * row + 16u * (ch ^ (((row & 3) << 2) | ((row >> 2) & 3))); }

DEV void phase_attn(const Params& p, char* smem) {
  const int tid = threadIdx.x, lane = tid & 63, w = tid >> 6, fr = lane & 15, fq = lane >> 4;
  char* ws = p.ws;
  const u16* KB = (const u16*)(ws + 2 * SLOT);
  const u16* VB = (const u16*)(ws + 3 * SLOT);
  const u16* QB = (const u16*)(ws + 4 * SLOT);
  const u16* ZS = (const u16*)(ws + 5 * SLOT);
  u16* OG = (u16*)(ws + 6 * SLOT);
  const int lrow = tid >> 4, lch = tid & 15;
  const unsigned lw0 = off_b(lrow, lch), lw1 = off_b(lrow + 32, lch);
  const int tq = (lane & 15) >> 2, tp = lane & 3;

  for (int item = blockIdx.x; item < 4096 + 256; item += gridDim.x) {
    int b, h, nq, qpos0, tokq0, ntiles, nkeys, tokk0; bool sample;
    if (item < 4096) {
      const int qblk = 31 - (item >> 7), bh = item & 127;
      b = bh >> 4; h = bh & 15; nq = 128; qpos0 = qblk * 128; tokq0 = b * 4096 + qpos0; ntiles = 2 * qblk + 2; nkeys = qpos0 + 128; tokk0 = b * 4096; sample = false;
    } else {
      const int bh = item - 4096;
      b = bh >> 4; h = bh & 15; nq = 32; qpos0 = 1024; tokq0 = TP + b * 32; ntiles = 17; nkeys = 1056; tokk0 = TP + b * 32 - 1024; sample = true;
    }
    const bool wactive = (w * 16) < nq;
    int* dflag = (int*)(smem + 65536);
    __syncthreads();
    if (lane == 0) dflag[w] = wactive ? 0 : 1;
    bool wdone = !wactive;
    const int qp = qpos0 + w * 16 + fr;
    const int qwmax = qpos0 + w * 16 + 15;
    bf16x8 qf[4];
#pragma unroll
    for (int ks = 0; ks < 4; ++ks) {
      if (wactive) qf[ks] = *(const bf16x8*)(QB + (size_t)(tokq0 + w * 16 + fr) * 2048 + h * 128 + ks * 32 + fq * 8);
      else qf[ks] = (bf16x8){0, 0, 0, 0, 0, 0, 0, 0};
    }
    f32x4 O[8];
#pragma unroll
    for (int dt = 0; dt < 8; ++dt) O[dt] = (f32x4){0, 0, 0, 0};
    float carry = 0.f;

    uint4 lk0, lk1, lv0, lv1;
#define ATT_LOAD(kb)                                                                                  \
    {                                                                                                 \
      const int kx0_ = (kb) * 64 + lrow, kx1_ = kx0_ + 32;                                            \
      if (sample && (kb) < 16) {                                                                      \
        const float* ck_ = p.in[I_CK] + ((size_t)(b * 1024 + kx0_) * 16 + h) * 128 + lch * 8;         \
        const float* cv_ = p.in[I_CV] + ((size_t)(b * 1024 + kx0_) * 16 + h) * 128 + lch * 8;         \
        float4 a_ = *(const float4*)ck_, b_ = *(const float4*)(ck_ + 4);                              \
        float4 c_ = *(const float4*)(ck_ + 32 * 2048), d_ = *(const float4*)(ck_ + 32 * 2048 + 4);    \
        lk0 = make_uint4(pack2(a_.x, a_.y), pack2(a_.z, a_.w), pack2(b_.x, b_.y), pack2(b_.z, b_.w)); \
        lk1 = make_uint4(pack2(c_.x, c_.y), pack2(c_.z, c_.w), pack2(d_.x, d_.y), pack2(d_.z, d_.w)); \
        a_ = *(const float4*)cv_; b_ = *(const float4*)(cv_ + 4);                                     \
        c_ = *(const float4*)(cv_ + 32 * 2048); d_ = *(const float4*)(cv_ + 32 * 2048 + 4);           \
        lv0 = make_uint4(pack2(a_.x, a_.y), pack2(a_.z, a_.w), pack2(b_.x, b_.y), pack2(b_.z, b_.w)); \
        lv1 = make_uint4(pack2(c_.x, c_.y), pack2(c_.z, c_.w), pack2(d_.x, d_.y), pack2(d_.z, d_.w)); \
      } else {                                                                                        \
        const size_t o0_ = (size_t)(tokk0 + kx0_) * 2048 + h * 128 + lch * 8;                         \
        const size_t o1_ = o0_ + (size_t)32 * 2048;                                                   \
        if (kx0_ < nkeys) { lk0 = *(const uint4*)(KB + o0_); lv0 = *(const uint4*)(VB + o0_); }       \
        else { lk0 = make_uint4(0, 0, 0, 0); lv0 = lk0; }                                             \
        if (kx1_ < nkeys) { lk1 = *(const uint4*)(KB + o1_); lv1 = *(const uint4*)(VB + o1_); }       \
        else { lk1 = make_uint4(0, 0, 0, 0); lv1 = lk1; }                                             \
      }                                                                                               \
    }
#define ATT_STORE(st)                                                                                 \
    {                                                                                                 \
      char* sK_ = smem + (st) * 32768; char* sV_ = sK_ + 16384;                                       \
      *(uint4*)(sK_ + lw0) = lk0; *(uint4*)(sK_ + lw1) = lk1;                                         \
      *(uint4*)(sV_ + lw0) = lv0; *(uint4*)(sV_ + lw1) = lv1;                                         \
    }
    ATT_LOAD(ntiles - 1);
    ATT_STORE(0);
    __syncthreads();
    for (int it = 0; it < ntiles; ++it) {
      const int kb = ntiles - 1 - it, st = it & 1;
      if (it + 1 < ntiles) ATT_LOAD(kb - 1);
      if (!wdone && kb * 64 < qwmax) {
        const char* sK = smem + st * 32768;
        const char* sV = sK + 16384;
        f32x4 S[4];
#pragma unroll
        for (int mt = 0; mt < 4; ++mt) S[mt] = (f32x4){0, 0, 0, 0};
#pragma unroll
        for (int ks = 0; ks < 4; ++ks)
#pragma unroll
          for (int mt = 0; mt < 4; ++mt) {
            bf16x8 a = *(const bf16x8*)(sK + off_b(mt * 16 + fr, ks * 4 + fq));
            S[mt] = __builtin_amdgcn_mfma_f32_16x16x32_bf16(a, qf[ks], S[mt], 0, 0, 0);
          }
        bf16x8 wf[2];
#define ATT_ELEM(MASKED) \
        { \
          float ee[4][4], tot[4], hi[4]; \
_Pragma("unroll") \
          for (int mt = 0; mt < 4; ++mt) { \
            const int kbase = kb * 64 + mt * 16 + fq * 4; \
            float ls[4]; \
_Pragma("unroll") \
            for (int jj = 0; jj < 4; ++jj) { \
              const float u = S[mt][jj]; \
              const bool valid = !(MASKED) || ((kbase + jj) < qp); \
              const float l = -__builtin_amdgcn_logf(1.0f + __builtin_amdgcn_exp2f(u)); \
              ls[jj] = valid ? l : 0.f; \
              ee[mt][jj] = valid ? (u + l) : -1e30f; \
            } \
            const float x3 = ls[3], x2 = x3 + ls[2], x1 = x2 + ls[1], seg = x1 + ls[0]; \
            ee[mt][2] += x3; ee[mt][1] += x2; ee[mt][0] += x1; \
            const float t1 = __shfl_xor(seg, 16), t2 = __shfl_xor(seg, 32), t3 = __shfl_xor(t1, 32); \
            tot[mt] = seg + t1 + t2 + t3; \
            hi[mt] = fq == 0 ? (t1 + t2 + t3) : fq == 1 ? (t2 + t3) : fq == 2 ? t1 : 0.f; \
          } \
          float run = carry; \
          float wv[4][4]; \
_Pragma("unroll") \
          for (int mt = 3; mt >= 0; --mt) { \
            const float base = run + hi[mt]; \
            run += tot[mt]; \
_Pragma("unroll") \
            for (int jj = 0; jj < 4; ++jj) wv[mt][jj] = __builtin_amdgcn_exp2f(ee[mt][jj] + base); \
          } \
          carry = run; \
          if (__all(carry < -150.0f)) { wdone = true; if (lane == 0) dflag[w] = 1; } \
_Pragma("unroll") \
          for (int p2 = 0; p2 < 2; ++p2) { \
            uint4 pk; \
            pk.x = pack2(wv[2 * p2][0], wv[2 * p2][1]); pk.y = pack2(wv[2 * p2][2], wv[2 * p2][3]); \
            pk.z = pack2(wv[2 * p2 + 1][0], wv[2 * p2 + 1][1]); pk.w = pack2(wv[2 * p2 + 1][2], wv[2 * p2 + 1][3]); \
            wf[p2] = *(bf16x8*)&pk; \
          } \
        }
        if (kb * 64 + 63 < qpos0 + w * 16) { ATT_ELEM(0) } else { ATT_ELEM(1) }
#undef ATT_ELEM
#pragma unroll
        for (int p2 = 0; p2 < 2; ++p2)
#pragma unroll
          for (int dt = 0; dt < 8; ++dt) {
            const unsigned r0 = 32 * p2 + 4 * fq + tq, r1 = r0 + 16;
            const unsigned ch = 2 * dt + (tp >> 1);
            const char* a0 = sV + off_b(r0, ch) + 8 * (tp & 1);
            const char* a1 = sV + off_b(r1, ch) + 8 * (tp & 1);
            s16x4 lo = __builtin_amdgcn_ds_read_tr16_b64_v4i16((s16x4 __attribute__((address_space(3)))*)(a0));
            s16x4 hi4 = __builtin_amdgcn_ds_read_tr16_b64_v4i16((s16x4 __attribute__((address_space(3)))*)(a1));
            bf16x8 a = {lo[0], lo[1], lo[2], lo[3], hi4[0], hi4[1], hi4[2], hi4[3]};
            O[dt] = __builtin_amdgcn_mfma_f32_16x16x32_bf16(a, wf[p2], O[dt], 0, 0, 0);
          }
      }
      if (it + 1 < ntiles) ATT_STORE(st ^ 1);
      __syncthreads();
      {
        const int4 f0 = *(const int4*)dflag, f1 = *(const int4*)(dflag + 4);
        if (f0.x & f0.y & f0.z & f0.w & f1.x & f1.y & f1.z & f1.w) break;
      }
    }
#undef ATT_LOAD
#undef ATT_STORE
    if (wactive) {
      const size_t rowoff = (size_t)(tokq0 + w * 16 + fr) * 2048 + h * 128;
#pragma unroll
      for (int dt = 0; dt < 8; ++dt) {
        const int d = dt * 16 + fq * 4;
        uint2 z = *(const uint2*)(ZS + rowoff + d);
        f32x4 v = O[dt];
        uint2 o;
        o.x = pack2(v[0] * bflo(z.x), v[1] * bfhi(z.x)); o.y = pack2(v[2] * bflo(z.y), v[3] * bfhi(z.y));
        *(uint2*)(OG + rowoff + d) = o;
      }
    }
  }
}


DEV void grid_barrier(unsigned* bar, unsigned target) {
  __syncthreads();
  if (threadIdx.x == 0) {
    __builtin_amdgcn_fence(__ATOMIC_RELEASE, "agent");
    asm volatile("s_waitcnt vmcnt(0)" ::: "memory");
    __hip_atomic_fetch_add(bar, 1u, __ATOMIC_RELAXED, __HIP_MEMORY_SCOPE_AGENT);
    while (__hip_atomic_load(bar, __ATOMIC_RELAXED, __HIP_MEMORY_SCOPE_AGENT) < target) __builtin_amdgcn_s_sleep(1);
    __builtin_amdgcn_fence(__ATOMIC_ACQUIRE, "agent");
    asm volatile("s_waitcnt vmcnt(0)" ::: "memory");
  }
  __syncthreads();
}

__global__ void __launch_bounds__(NTHREADS) __attribute__((target("no-packed-fp32-ops"))) mega(Params p, int lo, int hi) {
  __shared__ __attribute__((aligned(16))) char smem[147456];
  cg::grid_group grid = cg::this_grid();
#ifndef PROBE_DOUBLE
#define PROBE_DOUBLE -1
#endif
#define RUN_PHASE(k, call) if ((k) >= lo && (k) < hi) { if ((k) > lo) { if ((k) == lo + 1) grid.sync(); else grid_barrier((unsigned*)(p.ws + WS_BAR), (unsigned)((k) - lo - 1) * gridDim.x); } call; }
  RUN_PHASE(0, phase_prep(p, smem))
  RUN_PHASE(1, phase_norm0(p))
  RUN_PHASE(2, phase_proj0(p, smem))
  RUN_PHASE(3, phase_scan(p, smem))
  RUN_PHASE(4, phase_outproj<0>(p, smem))
  RUN_PHASE(5, phase_norm1(p))
  RUN_PHASE(6, phase_proj1(p, smem))
  RUN_PHASE(7, phase_attn(p, smem))
  RUN_PHASE(8, phase_outproj<1>(p, smem))
}

#ifndef N_LAUNCH_MODE
#define N_LAUNCH_MODE 1
#endif

extern "C" void kernel_launch(void* const* d_in, const int* in_sizes, int n_in, void* d_out, int out_size, void* d_ws, size_t ws_size,
                              hipStream_t stream) {
  Params p{};
  for (int i = 0; i < 36; ++i) p.in[i] = (const float*)d_in[i];
  p.out = (float*)d_out;
  p.ws = (char*)d_ws;
  static int grid_blocks = 0;
  if (!grid_blocks) {
    int dev = 0, cus = 0, per_cu = 0;
    hipGetDevice(&dev);
    hipDeviceGetAttribute(&cus, hipDeviceAttributeMultiprocessorCount, dev);
    hipOccupancyMaxActiveBlocksPerMultiprocessor(&per_cu, mega, NTHREADS, 0);
    if (per_cu < 1) per_cu = 1;
    grid_blocks = cus * per_cu;
  }
  if (ws_size < WS_END) { fprintf(stderr, "workspace too small: %zu < %llu\n", ws_size, (unsigned long long)WS_END); return; }
#if N_LAUNCH_MODE == 1
  int lo = 0, hi = 9;
  hipMemsetAsync((char*)d_ws + WS_BAR, 0, 256, stream);
  void* args[] = {&p, &lo, &hi};
  hipError_t e = hipLaunchCooperativeKernel((void*)mega, dim3(grid_blocks), dim3(NTHREADS), args, 0, stream);
  if (e != hipSuccess) fprintf(stderr, "cooperative launch failed: %s (grid %d)\n", hipGetErrorString(e), grid_blocks);
#else
  for (int ph = 0; ph < 9; ++ph) hipLaunchKernelGGL(mega, dim3(grid_blocks), dim3(NTHREADS), 0, stream, p, ph, ph + 1);
#endif
}
```

```cpp
#include <hip/hip_runtime.h>
#include <hip/hip_cooperative_groups.h>
#include <cstdio>
namespace cg = cooperative_groups;

typedef unsigned short u16;
typedef short bf16x8 __attribute__((ext_vector_type(8)));
typedef short s16x4 __attribute__((ext_vector_type(4)));
typedef float f32x4 __attribute__((ext_vector_type(4)));
typedef float f32x2 __attribute__((ext_vector_type(2)));
typedef __bf16 bf16x2_t __attribute__((ext_vector_type(2)));
typedef _Float16 h2_t __attribute__((ext_vector_type(2)));

#define DEV __device__ __forceinline__

#define NTOK 33280
#define TP 32768
#define NTHREADS 512

#define OFF_Y_P 0
#define OFF_Y_S 33554432
#define OFF_K_P 34078720
#define OFF_V_P 101187584
#define OFF_WKV_P 168296448
#define OFF_SH_P 169345024
#define OFF_K_S 169353216
#define OFF_V_S 170401792
#define OFF_WKV_S 171450368
#define OFF_SH_S 173547520

#define SLOT 136314880ull
#define WS_W (7ull * SLOT)
#define WS_WT_IN (WS_W)
#define WS_WT_OUTA (WS_WT_IN + 16777216ull)
#define WS_WT_KV (WS_WT_OUTA + 4194304ull)
#define WS_WT_INB (WS_WT_KV + 8388608ull)
#define WS_WT_OUTB (WS_WT_INB + 8388608ull)
#define WS_W2T (WS_WT_OUTB + 4194304ull)
#define WS_A2T (WS_W2T + 262144ull)
#define WS_L1T (WS_A2T + 262144ull)
#define WS_MOD (WS_L1T + 524288ull)
#define WS_SH (WS_MOD + 589824ull)
#define WS_CTR (WS_SH + 49152ull)
#define WS_BAR (WS_CTR + 4096ull)
#define WS_END (WS_BAR + 256ull)
#define WS_H0 (6ull * SLOT)
#define WS_T (4ull * SLOT)

struct Params {
  const float* in[36];
  float* out;
  char* ws;
};

enum { I_XP = 0, I_XS, I_CK, I_CV, I_SWKV, I_SSH, I_CP, I_CS, I_ANG, I_AADAW, I_AADAB, I_AWIN, I_AMUIN, I_AMUW, I_AMUA,
       I_AW0, I_AW1, I_AW2, I_AA0, I_AA1, I_AA2, I_AKK, I_AKA, I_ARK, I_ALNG, I_ALNB, I_AWOUT, I_KVNG, I_KVW, I_KGAIN,
       I_BNG, I_BADAW, I_BADAB, I_BWIN, I_BQG, I_BWOUT };

DEV int seq_of(int t) { return t < TP ? (t >> 12) : 8 + ((t - TP) >> 5); }
DEV bool seq_start(int t) { return t < TP ? ((t & 4095) == 0) : (((t - TP) & 31) == 0); }

DEV unsigned pack2(float a, float b) {
  f32x2 v = {a, b};
  bf16x2_t r = __builtin_convertvector(v, bf16x2_t);
  return *(unsigned*)&r;
}
DEV unsigned packh2(float a, float b) {
  f32x2 v = {a, b};
  h2_t r = __builtin_convertvector(v, h2_t);
  return *(unsigned*)&r;
}
DEV float bflo(unsigned w) { return __uint_as_float(w << 16); }
DEV float bfhi(unsigned w) { return __uint_as_float(w & 0xffff0000u); }
DEV void unpack8(const uint4& x, float* f) {
  f[0] = bflo(x.x); f[1] = bfhi(x.x); f[2] = bflo(x.y); f[3] = bfhi(x.y);
  f[4] = bflo(x.z); f[5] = bfhi(x.z); f[6] = bflo(x.w); f[7] = bfhi(x.w);
}
DEV float sigmoidf_(float x) { return 1.0f / (1.0f + __expf(-x)); }

template <int CTRL>
DEV float dppf(float x) {
  return __int_as_float(__builtin_amdgcn_update_dpp(0, __float_as_int(x), CTRL, 0xf, 0xf, true));
}
DEV float red4(float x) { x += dppf<0xB1>(x); x += dppf<0x4E>(x); return x; }
DEV float red8(float x) { x = red4(x); x += dppf<0x141>(x); return x; }
DEV float red16(float x) { x = red8(x); x += dppf<0x140>(x); return x; }
DEV float wave_sum(float x) {
#pragma unroll
  for (int o = 32; o >= 1; o >>= 1) x += __shfl_xor(x, o);
  return x;
}


#define SCHED_SLOT_OFF 147440
DEV int xcc_id() { return (int)(__builtin_amdgcn_s_getreg((3 << 11) | 20) & 0x7u); }
DEV unsigned* sched_ctr(const Params& p, int phase_slot, int list) { return (unsigned*)(p.ws + WS_CTR) + (phase_slot * 8 + list) * 16; }
DEV int sched_first(unsigned* ctr, char* smem) {
  int* slot = (int*)(smem + SCHED_SLOT_OFF);
  __syncthreads();
  if (threadIdx.x == 0) *slot = (int)atomicAdd(ctr, 1u);
  __syncthreads();
  return *slot;
}

DEV void group_sync(unsigned* bar, unsigned target) {
  __syncthreads();
  if (threadIdx.x == 0) {
    __hip_atomic_fetch_add(bar, 1u, __ATOMIC_RELAXED, __HIP_MEMORY_SCOPE_AGENT);
    while (__hip_atomic_load(bar, __ATOMIC_RELAXED, __HIP_MEMORY_SCOPE_AGENT) < target) __builtin_amdgcn_s_sleep(2);
  }
  __syncthreads();
}
DEV int sched_prefetch(unsigned* ctr) { return threadIdx.x == 0 ? (int)atomicAdd(ctr, 1u) : 0; }
DEV int sched_commit(int nxt, char* smem) {
  int* slot = (int*)(smem + SCHED_SLOT_OFF);
  __syncthreads();
  if (threadIdx.x == 0) *slot = nxt;
  __syncthreads();
  return *slot;
}

#define GEMM_STAGE_BYTES 49152

template <int AMODE>
DEV void gemm_main(f32x4 (&acc)[4][4], const u16* __restrict__ A, int lda, const u16* __restrict__ Bt, int ldb, int nk,
                   int m0, int n0, const float* __restrict__ mu, const u16* __restrict__ SH, char* smem) {
  const int tid = threadIdx.x, lane = tid & 63, wid = tid >> 6, wr = wid >> 1, wc = wid & 1, fr = lane & 15, fq = lane >> 4;
  const int lrow = tid >> 3, lch = tid & 7;
#pragma unroll
  for (int i = 0; i < 4; ++i)
#pragma unroll
    for (int j = 0; j < 4; ++j) acc[i][j] = (f32x4){0.f, 0.f, 0.f, 0.f};

  const u16* pa0; const u16* pa1; const u16* pa2; const u16* pa3;
  const u16* pp0 = nullptr;
  const int arow = 4 * lrow;
  {
    int m = m0 + arow;
    pa0 = A + (size_t)m * lda + lch * 8;
    pa1 = pa0 + lda; pa2 = pa1 + lda; pa3 = pa2 + lda;
    if (AMODE != 0) pp0 = seq_start(m) ? SH + seq_of(m) * 1024 + lch * 8 : pa0 - lda;
  }
  const u16* pb0 = Bt + (size_t)(n0 + lrow) * ldb + lch * 8;
  const u16* pb1 = pb0 + (size_t)64 * ldb;
  const int woffB = lrow * 128 + ((lch ^ ((lrow >> 1) & 7)) << 4);
  const int woffA0 = (arow + 0) * 128 + ((lch ^ (((arow + 0) >> 1) & 7)) << 4);
  const int woffA1 = (arow + 1) * 128 + ((lch ^ (((arow + 1) >> 1) & 7)) << 4);
  const int woffA2 = (arow + 2) * 128 + ((lch ^ (((arow + 2) >> 1) & 7)) << 4);
  const int woffA3 = (arow + 3) * 128 + ((lch ^ (((arow + 3) >> 1) & 7)) << 4);

  uint4 ra0, ra1, ra2, ra3, rp0, rb0, rb1;
  float4 mu0, mu1;
  rp0 = make_uint4(0, 0, 0, 0);
  mu0 = mu1 = make_float4(0, 0, 0, 0);

#define G_LOAD(kt)                                                                     \
  {                                                                                    \
    const int k0_ = (kt) * 64;                                                         \
    if (AMODE == 0) {                                                                  \
      ra0 = *(const uint4*)(pa0 + k0_); ra1 = *(const uint4*)(pa1 + k0_);              \
      ra2 = *(const uint4*)(pa2 + k0_); ra3 = *(const uint4*)(pa3 + k0_);              \
    } else if (AMODE == 1) {                                                           \
      ra0 = *(const uint4*)(pa0 + k0_); ra1 = *(const uint4*)(pa1 + k0_);              \
      ra2 = *(const uint4*)(pa2 + k0_); ra3 = *(const uint4*)(pa3 + k0_);              \
      rp0 = *(const uint4*)(pp0 + k0_);                                                \
      mu0 = *(const float4*)(mu + k0_ + lch * 8); mu1 = *(const float4*)(mu + k0_ + lch * 8 + 4); \
    } else {                                                                           \
      const int kk_ = k0_ & 1023;                                                      \
      ra0 = *(const uint4*)(pa0 + kk_); ra1 = *(const uint4*)(pa1 + kk_);              \
      ra2 = *(const uint4*)(pa2 + kk_); ra3 = *(const uint4*)(pa3 + kk_);              \
      if (k0_ >= 1024) rp0 = *(const uint4*)(pp0 + kk_);                               \
    }                                                                                  \
    rb0 = *(const uint4*)(pb0 + k0_); rb1 = *(const uint4*)(pb1 + k0_);                \
  }

#define G_XFORM(dst, a_, p_, kt)                                                       \
  {                                                                                    \
    if (AMODE == 0) dst = a_;                                                          \
    else if (AMODE == 1) {                                                             \
      float h_[8], q_[8]; unpack8(a_, h_); unpack8(p_, q_);                            \
      dst.x = pack2(h_[0] + mu0.x * (q_[0] - h_[0]), h_[1] + mu0.y * (q_[1] - h_[1])); \
      dst.y = pack2(h_[2] + mu0.z * (q_[2] - h_[2]), h_[3] + mu0.w * (q_[3] - h_[3])); \
      dst.z = pack2(h_[4] + mu1.x * (q_[4] - h_[4]), h_[5] + mu1.y * (q_[5] - h_[5])); \
      dst.w = pack2(h_[6] + mu1.z * (q_[6] - h_[6]), h_[7] + mu1.w * (q_[7] - h_[7])); \
    } else {                                                                           \
      if ((kt) * 64 >= 1024) {                                                         \
        float h_[8], q_[8]; unpack8(a_, h_); unpack8(p_, q_);                          \
        dst.x = pack2(q_[0] - h_[0], q_[1] - h_[1]); dst.y = pack2(q_[2] - h_[2], q_[3] - h_[3]); \
        dst.z = pack2(q_[4] - h_[4], q_[5] - h_[5]); dst.w = pack2(q_[6] - h_[6], q_[7] - h_[7]); \
      } else dst = a_;                                                                 \
    }                                                                                  \
  }

#define G_STORE(stage, kt)                                                             \
  {                                                                                    \
    char* sA_ = smem + (stage) * GEMM_STAGE_BYTES; char* sB_ = sA_ + 32768;            \
    uint4 v_;                                                                          \
    G_XFORM(v_, ra0, rp0, kt); *(uint4*)(sA_ + woffA0) = v_;                           \
    G_XFORM(v_, ra1, ra0, kt); *(uint4*)(sA_ + woffA1) = v_;                           \
    G_XFORM(v_, ra2, ra1, kt); *(uint4*)(sA_ + woffA2) = v_;                           \
    G_XFORM(v_, ra3, ra2, kt); *(uint4*)(sA_ + woffA3) = v_;                           \
    *(uint4*)(sB_ + woffB) = rb0; *(uint4*)(sB_ + woffB + 64 * 128) = rb1;             \
  }

  G_LOAD(0);
  G_STORE(0, 0);
  __syncthreads();
  const int rsw = (fr >> 1) & 7;
  for (int kt = 0; kt < nk; ++kt) {
    const int st = kt & 1;
    if (kt + 1 < nk) G_LOAD(kt + 1);
    __builtin_amdgcn_sched_barrier(0);
    {
      const char* sA = smem + st * GEMM_STAGE_BYTES;
      const char* sB = sA + 32768;
#pragma unroll
      for (int kk = 0; kk < 2; ++kk) {
        bf16x8 af[4], bfr[4];
        const int cho = ((kk * 4 + fq) ^ rsw) << 4;
#pragma unroll
        for (int i = 0; i < 4; ++i) af[i] = *(const bf16x8*)(sA + (wr * 64 + i * 16 + fr) * 128 + cho);
#pragma unroll
        for (int j = 0; j < 4; ++j) bfr[j] = *(const bf16x8*)(sB + (wc * 64 + j * 16 + fr) * 128 + cho);
#pragma unroll
        for (int i = 0; i < 4; ++i)
#pragma unroll
          for (int j = 0; j < 4; ++j) acc[i][j] = __builtin_amdgcn_mfma_f32_16x16x32_bf16(bfr[j], af[i], acc[i][j], 0, 0, 0);
      }
    }
    if (kt + 1 < nk) G_STORE(st ^ 1, kt + 1);
    __syncthreads();
  }
#undef G_LOAD
#undef G_XFORM
#undef G_STORE
}


#define G2_STAGE_BYTES 32768
#define G2_MU_OFF (3 * G2_STAGE_BYTES)
DEV int g2_swz(int row) { return (0x78 >> (2 * ((row >> 2) & 3))) & 3; }
template <int AMODE>
DEV void gemm_main256(f32x4 (&acc)[8][4], const u16* __restrict__ A, int lda, const u16* __restrict__ Bt, int ldb, int nk64,
                      int m0, int n0, const float* __restrict__ mu, const u16* __restrict__ SH, char* smem) {
  const int tid = threadIdx.x, lane = tid & 63, wid = tid >> 6, wr = wid >> 2, wc = wid & 3, fr = lane & 15, fq = lane >> 4;
  const int nk = nk64 * 2;
  const int lrow2 = 2 * (tid >> 2), lch = tid & 3;
#pragma unroll
  for (int i = 0; i < 8; ++i)
#pragma unroll
    for (int j = 0; j < 4; ++j) acc[i][j] = (f32x4){0.f, 0.f, 0.f, 0.f};
  const u16* pa0 = A + (size_t)(m0 + lrow2) * lda + lch * 8;
  const u16* pp0 = nullptr;
  if (AMODE != 0) pp0 = seq_start(m0 + lrow2) ? SH + seq_of(m0 + lrow2) * 1024 + lch * 8 : pa0 - lda;
  const u16* pb0 = Bt + (size_t)(n0 + lrow2) * ldb + lch * 8;
  const int woff0 = (lrow2 + 0) * 64 + ((lch ^ g2_swz(lrow2 + 0)) << 4);
  const int woff1 = (lrow2 + 1) * 64 + ((lch ^ g2_swz(lrow2 + 1)) << 4);
  const float* muL = (const float*)(smem + G2_MU_OFF);
  if (AMODE == 1) {
    if (tid < 256) *(float4*)(smem + G2_MU_OFF + tid * 16) = *(const float4*)(mu + tid * 4);
  }
  uint4 xa0, xa1, xp, xb0, xb1;
  uint4 ya0, ya1, yp, yb0, yb1;
  xp = yp = make_uint4(0, 0, 0, 0);

#define K_LOAD(S, kt)                                                                  \
  {                                                                                    \
    const int k0_ = (kt) * 32;                                                         \
    S##a0 = *(const uint4*)(pa0 + k0_); S##a1 = *(const uint4*)(pa0 + lda + k0_);      \
    if (AMODE == 1) S##p = *(const uint4*)(pp0 + k0_);                                 \
    S##b0 = *(const uint4*)(pb0 + k0_); S##b1 = *(const uint4*)(pb0 + ldb + k0_);      \
  }
#define K_XFORM(dst, a_, p_)                                                           \
  {                                                                                    \
    if (AMODE == 0) dst = a_;                                                          \
    else {                                                                             \
      float h_[8], q_[8]; unpack8(a_, h_); unpack8(p_, q_);                            \
      dst.x = pack2(h_[0] + mu0.x * (q_[0] - h_[0]), h_[1] + mu0.y * (q_[1] - h_[1])); \
      dst.y = pack2(h_[2] + mu0.z * (q_[2] - h_[2]), h_[3] + mu0.w * (q_[3] - h_[3])); \
      dst.z = pack2(h_[4] + mu1.x * (q_[4] - h_[4]), h_[5] + mu1.y * (q_[5] - h_[5])); \
      dst.w = pack2(h_[6] + mu1.z * (q_[6] - h_[6]), h_[7] + mu1.w * (q_[7] - h_[7])); \
    }                                                                                  \
  }
#define K_STORE(S, stage, kt)                                                          \
  {                                                                                    \
    char* sA_ = smem + (stage) * G2_STAGE_BYTES; char* sB_ = sA_ + 16384;              \
    uint4 v_; float4 mu0, mu1;                                                         \
    if (AMODE == 1) { mu0 = *(const float4*)(muL + (kt) * 32 + lch * 8); mu1 = *(const float4*)(muL + (kt) * 32 + lch * 8 + 4); } \
    K_XFORM(v_, S##a0, S##p); *(uint4*)(sA_ + woff0) = v_;                             \
    K_XFORM(v_, S##a1, S##a0); *(uint4*)(sA_ + woff1) = v_;                            \
    *(uint4*)(sB_ + woff0) = S##b0; *(uint4*)(sB_ + woff1) = S##b1;                    \
  }
#define K_COMPUTE_HALF(stage, i0)                                                      \
  {                                                                                    \
    const char* sA_ = smem + (stage) * G2_STAGE_BYTES;                                 \
    _Pragma("unroll") for (int i = (i0); i < (i0) + 4; ++i) {                          \
      const bf16x8 af = *(const bf16x8*)(sA_ + (wr * 128 + i * 16 + fr) * 64 + cho);   \
      _Pragma("unroll") for (int j = 0; j < 4; ++j) acc[i][j] = __builtin_amdgcn_mfma_f32_16x16x32_bf16(bfr[j], af, acc[i][j], 0, 0, 0); \
    }                                                                                  \
  }
#define K_LOAD_B(stage)                                                                \
  {                                                                                    \
    const char* sB_ = smem + (stage) * G2_STAGE_BYTES + 16384;                         \
    _Pragma("unroll") for (int j = 0; j < 4; ++j) bfr[j] = *(const bf16x8*)(sB_ + (wc * 64 + j * 16 + fr) * 64 + cho); \
  }
#define K_ITER(kt, L, S)                                                               \
  {                                                                                    \
    K_LOAD(L, min((kt) + 2, nk - 1));                                                  \
    __builtin_amdgcn_sched_barrier(0);                                                 \
    bf16x8 bfr[4];                                                                     \
    K_LOAD_B(cu);                                                                      \
    K_COMPUTE_HALF(cu, 0);                                                             \
    __builtin_amdgcn_sched_barrier(0);                                                 \
    K_STORE(S, nx, min((kt) + 1, nk - 1));                                             \
    __builtin_amdgcn_sched_barrier(0);                                                 \
    if (AMODE == 1) K_LOAD_B(cu);                                                      \
    K_COMPUTE_HALF(cu, 4);                                                             \
    __syncthreads();                                                                   \
    cu = nx; nx = (nx == 2) ? 0 : nx + 1;                                              \
  }
  const int cho = (fq ^ g2_swz(fr)) << 4;
  if (AMODE == 1) __syncthreads();
  K_LOAD(x, 0);
  K_LOAD(y, 1);
  K_STORE(x, 0, 0);
  __syncthreads();
  int cu = 0, nx = 1;
  for (int kt = 0; kt < nk; kt += 2) {
    K_ITER(kt, x, y);
    K_ITER(kt + 1, y, x);
  }
#undef K_LOAD
#undef K_XFORM
#undef K_STORE
#undef K_COMPUTE_HALF
#undef K_LOAD_B
#undef K_ITER
}


#define GD_NST 4
DEV void gemm_main256_dma(f32x4 (&acc)[8][4], const u16* __restrict__ A, int lda, const u16* __restrict__ Bt, int ldb, int nk64,
                          int m0, int n0, char* smem) {
  const int tid = threadIdx.x, lane = tid & 63, wid = tid >> 6, wr = wid >> 2, wc = wid & 3, fr = lane & 15, fq = lane >> 4;
  const int nk = nk64 * 2;
#pragma unroll
  for (int i = 0; i < 8; ++i)
#pragma unroll
    for (int j = 0; j < 4; ++j) acc[i][j] = (f32x4){0.f, 0.f, 0.f, 0.f};
  const int prow = 16 * wid + (lane >> 2);
  const int pch = (lane & 3) ^ g2_swz(prow);
  const u16* srcA = A + (size_t)(m0 + prow) * lda + pch * 8;
  const u16* srcB = Bt + (size_t)(n0 + prow) * ldb + pch * 8;
  const size_t a128 = (size_t)128 * lda, b128 = (size_t)128 * ldb;
  char* ldsw = smem + (16 * wid) * 64;
#define D_FILL(kt, stage)                                                              \
  {                                                                                    \
    const int k0_ = (kt) * 32;                                                         \
    char* d_ = ldsw + (stage) * G2_STAGE_BYTES;                                        \
    __builtin_amdgcn_global_load_lds((const unsigned*)(srcA + k0_), (unsigned*)(d_), 16, 0, 0);               \
    __builtin_amdgcn_global_load_lds((const unsigned*)(srcA + a128 + k0_), (unsigned*)(d_ + 8192), 16, 0, 0); \
    __builtin_amdgcn_global_load_lds((const unsigned*)(srcB + k0_), (unsigned*)(d_ + 16384), 16, 0, 0);       \
    __builtin_amdgcn_global_load_lds((const unsigned*)(srcB + b128 + k0_), (unsigned*)(d_ + 16384 + 8192), 16, 0, 0); \
  }
  const int cho = (fq ^ g2_swz(fr)) << 4;
  __syncthreads();
  D_FILL(0, 0);
  D_FILL(min(1, nk - 1), 1);
  D_FILL(min(2, nk - 1), 2);
  int cu = 0, fill = 3;
  for (int kt = 0; kt < nk; ++kt) {
    asm volatile("s_waitcnt vmcnt(8)" ::: "memory");
    asm volatile("s_waitcnt lgkmcnt(0)" ::: "memory");
    __builtin_amdgcn_s_barrier();
    D_FILL(min(kt + 3, nk - 1), fill);
    {
      const char* sA_ = smem + cu * G2_STAGE_BYTES;
      const char* sB_ = sA_ + 16384;
      bf16x8 bfr[4];
#pragma unroll
      for (int j = 0; j < 4; ++j) bfr[j] = *(const bf16x8*)(sB_ + (wc * 64 + j * 16 + fr) * 64 + cho);
#pragma unroll
      for (int i = 0; i < 8; ++i) {
        const bf16x8 af = *(const bf16x8*)(sA_ + (wr * 128 + i * 16 + fr) * 64 + cho);
#pragma unroll
        for (int j = 0; j < 4; ++j) acc[i][j] = __builtin_amdgcn_mfma_f32_16x16x32_bf16(bfr[j], af, acc[i][j], 0, 0, 0);
      }
    }
    cu = (cu == GD_NST - 1) ? 0 : cu + 1;
    fill = (fill == GD_NST - 1) ? 0 : fill + 1;
  }
  asm volatile("s_waitcnt vmcnt(0)" ::: "memory");
  asm volatile("s_waitcnt lgkmcnt(0)" ::: "memory");
  __builtin_amdgcn_s_barrier();
#undef D_FILL
}

DEV void transpose_tile(const float* __restrict__ src, int N, int k0, int n0, const float* __restrict__ scale, u16* __restrict__ dst,
                        int dstride, int drow0, int dcol0, char* smem) {
  float* tile = (float*)smem;
  const int tid = threadIdx.x;
#pragma unroll
  for (int i = 0; i < 2; ++i) {
    int kl = (tid >> 4) + 32 * i, n4 = (tid & 15) * 4;
    float4 v = *(const float4*)(src + (size_t)(k0 + kl) * N + n0 + n4);
    float s = scale ? scale[k0 + kl] : 1.0f;
    tile[kl * 65 + n4 + 0] = v.x * s; tile[kl * 65 + n4 + 1] = v.y * s;
    tile[kl * 65 + n4 + 2] = v.z * s; tile[kl * 65 + n4 + 3] = v.w * s;
  }
  __syncthreads();
  {
    int nl = tid >> 3, k8 = (tid & 7) * 8;
    uint4 o;
    o.x = pack2(tile[(k8 + 0) * 65 + nl], tile[(k8 + 1) * 65 + nl]);
    o.y = pack2(tile[(k8 + 2) * 65 + nl], tile[(k8 + 3) * 65 + nl]);
    o.z = pack2(tile[(k8 + 4) * 65 + nl], tile[(k8 + 5) * 65 + nl]);
    o.w = pack2(tile[(k8 + 6) * 65 + nl], tile[(k8 + 7) * 65 + nl]);
    *(uint4*)(dst + (size_t)(drow0 + n0 + nl) * dstride + dcol0 + k0 + k8) = o;
  }
  __syncthreads();
}

DEV void phase_prep(const Params& p, char* smem) {
  const int tid = threadIdx.x;
  char* ws = p.ws;
  if (blockIdx.x < 96) {
    float* cL = (float*)smem;
    float* red = (float*)(smem + 98304);
    for (int e = tid; e < 24 * 256; e += NTHREADS) {
      int s = e >> 8, k4 = (e & 255) * 4;
      float4 v = s < 8 ? *(const float4*)(p.in[I_CP] + s * 1024 + k4) : *(const float4*)(p.in[I_CS] + (s - 8) * 1024 + k4);
      *(float4*)(cL + s * 1024 + k4) = v;
    }
    __syncthreads();
    for (int item = blockIdx.x; item < 96; item += gridDim.x) {
      const int l = item / 48, j0 = (item % 48) * 64;
      const float* W = (l == 0 ? p.in[I_AADAW] : p.in[I_BADAW]);
      const float* bias = (l == 0 ? p.in[I_AADAB] : p.in[I_BADAB]);
      const int col = tid & 63, kg = tid >> 6;
      float acc[24];
#pragma unroll
      for (int s = 0; s < 24; ++s) acc[s] = 0.f;
      for (int k = kg * 128; k < kg * 128 + 128; ++k) {
        float w = W[(size_t)k * 3072 + j0 + col];
#pragma unroll
        for (int s = 0; s < 24; ++s) acc[s] += cL[s * 1024 + k] * w;
      }
#pragma unroll
      for (int s = 0; s < 24; ++s) red[(kg * 24 + s) * 64 + col] = acc[s];
      __syncthreads();
      float* mod = (float*)(ws + WS_MOD);
      for (int e = tid; e < 24 * 64; e += NTHREADS) {
        int s = e >> 6, c = e & 63;
        float t = bias[j0 + c];
#pragma unroll
        for (int g = 0; g < 8; ++g) t += red[(g * 24 + s) * 64 + c];
        mod[(size_t)(l * 24 + s) * 3072 + j0 + c] = t;
      }
      __syncthreads();
    }
  }
  if (blockIdx.x == 0) for (int e = tid; e < 1024; e += NTHREADS) ((unsigned*)(ws + WS_CTR))[e] = 0u;
  if (blockIdx.x == gridDim.x - 1) {
    u16* SH = (u16*)(ws + WS_SH);
    for (int e = tid; e < 24 * 1024; e += NTHREADS) {
      int s = e >> 10, k = e & 1023;
      float v = s < 8 ? 0.f : p.in[I_SSH][(s - 8) * 1024 + k];
      SH[e] = (u16)(pack2(v, 0.f) & 0xffff);
    }
  }
  const int NT_TOTAL = 2048 + 512 + 1024 + 1024 + 512 + 32 + 32 + 64;
  for (int t = blockIdx.x; t < NT_TOTAL; t += gridDim.x) {
    const float* src; int K, N; u16* dst; int dstride, drow0 = 0, dcol0 = 0; const float* scale = nullptr; int tt = t;
    if (tt < 2048) { src = p.in[I_AWIN]; K = 1024; N = 8192; dst = (u16*)(ws + WS_WT_IN); dstride = 1024; }
    else if ((tt -= 2048) < 512) { src = p.in[I_AWOUT]; K = 2048; N = 1024; dst = (u16*)(ws + WS_WT_OUTA); dstride = 2048; }
    else if ((tt -= 512) < 1024) { src = p.in[I_KVW]; K = 1024; N = 4096; dst = (u16*)(ws + WS_WT_KV); dstride = 1024; }
    else if ((tt -= 1024) < 1024) { src = p.in[I_BWIN]; K = 1024; N = 4096; dst = (u16*)(ws + WS_WT_INB); dstride = 1024; }
    else if ((tt -= 1024) < 512) { src = p.in[I_BWOUT]; K = 2048; N = 1024; dst = (u16*)(ws + WS_WT_OUTB); dstride = 2048; }
    else if ((tt -= 512) < 32) { src = p.in[I_AW2]; K = 64; N = 2048; dst = (u16*)(ws + WS_W2T); dstride = 64; }
    else if ((tt -= 32) < 32) { src = p.in[I_AA2]; K = 64; N = 2048; dst = (u16*)(ws + WS_A2T); dstride = 64; }
    else {
      tt -= 32;
      int job = tt >> 4; tt &= 15;
      K = 1024; N = 64; dst = (u16*)(ws + WS_L1T); dstride = 2048;
      src = (job < 2) ? p.in[I_AW1] : p.in[I_AA1];
      drow0 = (job < 2) ? 0 : 64;
      if (job & 1) { dcol0 = 1024; scale = (job < 2) ? p.in[I_AMUW] : p.in[I_AMUA]; }
    }
    const int ntn = N / 64;
    const int kt = tt / ntn, nt = tt % ntn;
    transpose_tile(src, N, kt * 64, nt * 64, scale, dst, dstride, drow0, dcol0, smem);
  }
}

DEV void phase_norm0(const Params& p) {
  const int lane = threadIdx.x & 63, wid = threadIdx.x >> 6;
  const float* mod = (const float*)(p.ws + WS_MOD);
  u16* H0 = (u16*)(p.ws + WS_H0);
  const float* g = p.in[I_ANG];
  for (int t = blockIdx.x * 8 + wid; t < NTOK; t += gridDim.x * 8) {
    const float* x = t < TP ? p.in[I_XP] + (size_t)t * 1024 : p.in[I_XS] + (size_t)(t - TP) * 1024;
    const int s = seq_of(t);
    const float* md = mod + (size_t)s * 3072;
    float4 v[4];
    float ss = 0.f;
#pragma unroll
    for (int i = 0; i < 4; ++i) {
      v[i] = *(const float4*)(x + lane * 4 + 256 * i);
      ss += v[i].x * v[i].x + v[i].y * v[i].y + v[i].z * v[i].z + v[i].w * v[i].w;
    }
    ss = wave_sum(ss);
    const float rstd = rsqrtf(ss * (1.0f / 1024.0f) + 1e-6f);
    bool last = t < TP ? ((t & 4095) == 4095) : (((t - TP) & 31) == 31);
    float* so = t < TP ? p.out + OFF_SH_P + (t >> 12) * 1024 : p.out + OFF_SH_S + ((t - TP) >> 5) * 1024;
#pragma unroll
    for (int i = 0; i < 4; ++i) {
      const int c = lane * 4 + 256 * i;
      float4 gg = *(const float4*)(g + c), sh = *(const float4*)(md + c), sc = *(const float4*)(md + 1024 + c);
      float4 h;
      h.x = v[i].x * rstd * gg.x * (1.f + sc.x) + sh.x;
      h.y = v[i].y * rstd * gg.y * (1.f + sc.y) + sh.y;
      h.z = v[i].z * rstd * gg.z * (1.f + sc.z) + sh.z;
      h.w = v[i].w * rstd * gg.w * (1.f + sc.w) + sh.w;
      uint2 o; o.x = pack2(h.x, h.y); o.y = pack2(h.z, h.w);
      *(uint2*)(H0 + (size_t)t * 1024 + c) = o;
      if (last) *(float4*)(so + c) = h;
    }
  }
}

DEV void phase_proj0_lora(const Params& p, char* smem) {
  const int tid = threadIdx.x, lane = tid & 63, wid = tid >> 6, fr = lane & 15, fq = lane >> 4;
  const int wr = wid >> 1, wc = wid & 1;
  char* ws = p.ws;
  const u16* H0 = (const u16*)(ws + WS_H0);
  const u16* SH = (const u16*)(ws + WS_SH);
  u16* T = (u16*)(ws + WS_T);
  const int xcc0 = xcc_id();
  int nxt;
  f32x4 acc[4][4];
  for (int ls = 0; ls < 8; ++ls) {
  const int xcd = (xcc0 + ls) & 7;
  unsigned* ctr = sched_ctr(p, 0, xcd);
  for (int li = sched_first(ctr, smem); li < 17; li = sched_commit(nxt, smem)) {
    nxt = sched_prefetch(ctr);
    const int lmt = xcd + 8 * li;
    if (lmt >= 130) continue;
    const int m0 = lmt * 256;
    gemm_main<2>(acc, H0, 1024, (const u16*)(ws + WS_L1T), 2048, 32, m0, 0, nullptr, SH, smem);
#pragma unroll
    for (int i = 0; i < 4; ++i)
#pragma unroll
      for (int j = 0; j < 4; ++j) {
        const int m = m0 + wr * 64 + i * 16 + fr, n = wc * 64 + j * 16 + fq * 4;
        f32x4 v = acc[i][j];
        if (wc == 0) { v[0] = tanhf(v[0]); v[1] = tanhf(v[1]); v[2] = tanhf(v[2]); v[3] = tanhf(v[3]); }
        uint2 o; o.x = pack2(v[0], v[1]); o.y = pack2(v[2], v[3]);
        *(uint2*)(T + (size_t)m * 128 + n) = o;
      }
  }
  }
}

DEV void phase_proj0_main(const Params& p, char* smem) {
  const int tid = threadIdx.x, lane = tid & 63, wid = tid >> 6, fr = lane & 15, fq = lane >> 4;
  const int wr = wid >> 2, wc = wid & 3;
  char* ws = p.ws;
  const u16* H0 = (const u16*)(ws + WS_H0);
  const u16* SH = (const u16*)(ws + WS_SH);
  const int xcc0 = xcc_id();
  int nxt;
  f32x4 acc[8][4];
  for (int ls = 0; ls < 8; ++ls) {
  const int xcd = (xcc0 + ls) & 7;
  unsigned* ctr = sched_ctr(p, 4, xcd);
  for (int q = sched_first(ctr, smem); q < 520; q = sched_commit(nxt, smem)) {
    nxt = sched_prefetch(ctr);
    const int mt = q >> 2, nt = 4 * xcd + (q & 3);
    const int part = nt >> 3;
    const int m0 = mt * 256, n0 = nt * 256;
    gemm_main256<1>(acc, H0, 1024, (const u16*)(ws + WS_WT_IN), 1024, 16, m0, n0, p.in[I_AMUIN] + part * 1024, SH, smem);
    u16* dst = (u16*)(ws + (size_t)part * SLOT);
    const int nb = n0 - part * 2048;
#pragma unroll
    for (int i = 0; i < 8; ++i)
#pragma unroll
      for (int j = 0; j < 4; ++j) {
        const int row = wr * 128 + i * 16 + fr, col = wc * 64 + j * 16 + fq * 4;
        f32x4 v = acc[i][j];
        uint2 o; o.x = pack2(v[0], v[1]); o.y = pack2(v[2], v[3]);
        *(uint2*)(smem + row * 528 + col * 2) = o;
      }
    __syncthreads();
#pragma unroll
    for (int qq = 0; qq < 16; ++qq) {
      const int c = tid + 512 * qq, row = c >> 5, ch = c & 31;
      const uint4 v = *(const uint4*)(smem + row * 528 + ch * 16);
      *(uint4*)(dst + (size_t)(m0 + row) * 2048 + nb + ch * 8) = v;
    }
    __syncthreads();
  }
  }
}

DEV void phase_proj0(const Params& p, char* smem) {
  phase_proj0_lora(p, smem);
  phase_proj0_main(p, smem);
}

DEV void phase_scan(const Params& p, char* smem) {
  const int tid = threadIdx.x, lane = tid & 63, wid = tid >> 6;
  u16* Hkk = (u16*)smem;
  u16* Hw = Hkk + 4096;
  u16* Hb = Hw + 4096;
  u16* Hk = Hb + 4096;
  u16* Hwr = Hk + 4096;
  unsigned* Hv2 = (unsigned*)(smem + 40960);
  float* LY = (float*)(smem + 57344);
  float* Lbon = LY + 8192;
  float* Lsc = Lbon + 64;
  float* Lwa = Lsc + 128;
  char* ws = p.ws;
  const u16* gR = (const u16*)(ws + 0 * SLOT);
  const u16* gK = (const u16*)(ws + 1 * SLOT);
  const u16* gV = (const u16*)(ws + 2 * SLOT);
  const u16* gZ = (const u16*)(ws + 3 * SLOT);
  const u16* gT = (const u16*)(ws + WS_T);
  const u16* W2T = (const u16*)(ws + WS_W2T);
  const u16* A2T = (const u16*)(ws + WS_A2T);
  const int fr = lane & 15, fq = lane >> 4, lmt = wid & 3, lnh = wid >> 2;
  u16* YG = (u16*)(ws + 6 * SLOT);
  const int tt = tid >> 3, c8 = (tid & 7) * 8;
  const int srow = tid >> 3, kc = tid & 7;

  for (int item = blockIdx.x; item < 768; item += gridDim.x) {
    int h, tok0, nsteps; const float* sinit; float* sout;
    if (item < 256) { h = item & 31; tok0 = (item >> 5) * 4096; nsteps = 4096; sinit = nullptr; sout = p.out + OFF_WKV_P + (size_t)item * 4096; }
    else { int it = item - 256; h = it & 31; tok0 = TP + (it >> 5) * 32; nsteps = 32; sinit = p.in[I_SWKV] + (size_t)it * 4096; sout = p.out + OFF_WKV_S + (size_t)it * 4096; }
    const int nch = (nsteps + 63) >> 6;
    const int col0 = h * 64 + c8;
    float ckk[8], cka[8], crk[8], clg[8], clb[8];
    {
      float4 t0, t1;
      t0 = *(const float4*)(p.in[I_AKK] + col0); t1 = *(const float4*)(p.in[I_AKK] + col0 + 4);
      ckk[0] = t0.x; ckk[1] = t0.y; ckk[2] = t0.z; ckk[3] = t0.w; ckk[4] = t1.x; ckk[5] = t1.y; ckk[6] = t1.z; ckk[7] = t1.w;
      t0 = *(const float4*)(p.in[I_AKA] + col0); t1 = *(const float4*)(p.in[I_AKA] + col0 + 4);
      cka[0] = t0.x; cka[1] = t0.y; cka[2] = t0.z; cka[3] = t0.w; cka[4] = t1.x; cka[5] = t1.y; cka[6] = t1.z; cka[7] = t1.w;
      t0 = *(const float4*)(p.in[I_ARK] + col0); t1 = *(const float4*)(p.in[I_ARK] + col0 + 4);
      crk[0] = t0.x; crk[1] = t0.y; crk[2] = t0.z; crk[3] = t0.w; crk[4] = t1.x; crk[5] = t1.y; crk[6] = t1.z; crk[7] = t1.w;
      t0 = *(const float4*)(p.in[I_ALNG] + col0); t1 = *(const float4*)(p.in[I_ALNG] + col0 + 4);
      clg[0] = t0.x; clg[1] = t0.y; clg[2] = t0.z; clg[3] = t0.w; clg[4] = t1.x; clg[5] = t1.y; clg[6] = t1.z; clg[7] = t1.w;
      t0 = *(const float4*)(p.in[I_ALNB] + col0); t1 = *(const float4*)(p.in[I_ALNB] + col0 + 4);
      clb[0] = t0.x; clb[1] = t0.y; clb[2] = t0.z; clb[3] = t0.w; clb[4] = t1.x; clb[5] = t1.y; clb[6] = t1.z; clb[7] = t1.w;
    }
    float cw0[8], ca0[8];
    {
      float4 t0 = *(const float4*)(p.in[I_AW0] + col0), t1 = *(const float4*)(p.in[I_AW0] + col0 + 4);
      cw0[0] = t0.x; cw0[1] = t0.y; cw0[2] = t0.z; cw0[3] = t0.w; cw0[4] = t1.x; cw0[5] = t1.y; cw0[6] = t1.z; cw0[7] = t1.w;
      t0 = *(const float4*)(p.in[I_AA0] + col0); t1 = *(const float4*)(p.in[I_AA0] + col0 + 4);
      ca0[0] = t0.x; ca0[1] = t0.y; ca0[2] = t0.z; ca0[3] = t0.w; ca0[4] = t1.x; ca0[5] = t1.y; ca0[6] = t1.z; ca0[7] = t1.w;
    }
    bf16x8 w2f[2][2], a2f[2][2];
#pragma unroll
    for (int n2 = 0; n2 < 2; ++n2)
#pragma unroll
      for (int ks = 0; ks < 2; ++ks) {
        const size_t o_ = (size_t)(h * 64 + lnh * 32 + n2 * 16 + fr) * 64 + ks * 32 + fq * 8;
        w2f[n2][ks] = *(const bf16x8*)(W2T + o_);
        a2f[n2][ks] = *(const bf16x8*)(A2T + o_);
      }
    h2_t sa_, sb_, sc_, sd_;
    if (sinit) {
      float4 a = *(const float4*)(sinit + srow * 64 + kc * 8), b = *(const float4*)(sinit + srow * 64 + kc * 8 + 4);
      sa_ = (h2_t){(_Float16)a.x, (_Float16)a.y}; sb_ = (h2_t){(_Float16)a.z, (_Float16)a.w};
      sc_ = (h2_t){(_Float16)b.x, (_Float16)b.y}; sd_ = (h2_t){(_Float16)b.z, (_Float16)b.w};
    } else {
      sa_ = sb_ = sc_ = sd_ = (h2_t){(_Float16)0.f, (_Float16)0.f};
    }
    uint4 cr, ck, cv, cz;
    bf16x8 t1f[2], t2f[2];
#define SCAN_LOAD(c)                                                                   \
    {                                                                                  \
      const int tl_ = (c) * 64 + tt;                                                   \
      if (tl_ < nsteps) {                                                              \
        const size_t o_ = (size_t)(tok0 + tl_) * 2048 + col0;                          \
        cr = *(const uint4*)(gR + o_); ck = *(const uint4*)(gK + o_); cv = *(const uint4*)(gV + o_); \
        cz = *(const uint4*)(gZ + o_);                                                 \
      } else { cr = ck = cv = cz = make_uint4(0, 0, 0, 0); }                           \
      const int tm_ = (c) * 64 + lmt * 16 + fr;                                        \
      if (tm_ < nsteps) {                                                              \
        const u16* tp_ = gT + (size_t)(tok0 + tm_) * 128 + fq * 8;                     \
        t1f[0] = *(const bf16x8*)(tp_); t1f[1] = *(const bf16x8*)(tp_ + 32);           \
        t2f[0] = *(const bf16x8*)(tp_ + 64); t2f[1] = *(const bf16x8*)(tp_ + 96);      \
      } else { t1f[0] = t1f[1] = t2f[0] = t2f[1] = (bf16x8){0, 0, 0, 0, 0, 0, 0, 0}; } \
    }
    SCAN_LOAD(0);
    for (int c = 0; c < nch; ++c) {
      {
#pragma unroll
        for (int n2 = 0; n2 < 2; ++n2) {
          f32x4 xw = {0.f, 0.f, 0.f, 0.f}, xa = {0.f, 0.f, 0.f, 0.f};
          xw = __builtin_amdgcn_mfma_f32_16x16x32_bf16(w2f[n2][0], t1f[0], xw, 0, 0, 0);
          xw = __builtin_amdgcn_mfma_f32_16x16x32_bf16(w2f[n2][1], t1f[1], xw, 0, 0, 0);
          xa = __builtin_amdgcn_mfma_f32_16x16x32_bf16(a2f[n2][0], t2f[0], xa, 0, 0, 0);
          xa = __builtin_amdgcn_mfma_f32_16x16x32_bf16(a2f[n2][1], t2f[1], xa, 0, 0, 0);
          const int o_ = (lmt * 16 + fr) * 64 + lnh * 32 + n2 * 16 + fq * 4;
          *(float4*)(Lwa + o_) = make_float4(xw[0], xw[1], xw[2], xw[3]);
          *(float4*)(Lwa + 4096 + o_) = make_float4(xa[0], xa[1], xa[2], xa[3]);
        }
      }
      __syncthreads();
      uint4 zc = cz;
      {
        float r[8], k[8], v[8], lw[8], a[8];
        unpack8(cr, r); unpack8(ck, k); unpack8(cv, v);
        {
          const float4 x0 = *(const float4*)(Lwa + tt * 64 + c8), x1 = *(const float4*)(Lwa + tt * 64 + c8 + 4);
          const float4 y0 = *(const float4*)(Lwa + 4096 + tt * 64 + c8), y1 = *(const float4*)(Lwa + 4096 + tt * 64 + c8 + 4);
          const float xw_[8] = {x0.x, x0.y, x0.z, x0.w, x1.x, x1.y, x1.z, x1.w};
          const float xa_[8] = {y0.x, y0.y, y0.z, y0.w, y1.x, y1.y, y1.z, y1.w};
#pragma unroll
          for (int j = 0; j < 8; ++j) {
            lw[j] = -0.60653066f * sigmoidf_(cw0[j] + xw_[j]);
            a[j] = sigmoidf_(ca0[j] + xa_[j]);
          }
        }
        float kkv[8], kp[8], w[8], bon = 0.f, ss = 0.f, kr = 0.f;
#pragma unroll
        for (int j = 0; j < 8; ++j) {
          kkv[j] = k[j] * ckk[j]; ss += kkv[j] * kkv[j];
          kp[j] = k[j] * (1.f + (a[j] - 1.f) * cka[j]);
          bon += r[j] * kp[j] * crk[j];
          kr += r[j] * kp[j];
          w[j] = __expf(lw[j]);
        }
        ss = red8(ss); bon = red8(bon); kr = red8(kr);
        const float inv = rsqrtf(ss + 1e-12f);
        float bb[8], br = 0.f;
#pragma unroll
        for (int j = 0; j < 8; ++j) { kkv[j] *= inv; bb[j] = kkv[j] * a[j]; br += bb[j] * r[j]; }
        br = red8(br);
        const int ho = tt * 64 + c8;
        *(uint4*)(Hkk + ho) = make_uint4(packh2(kkv[0], kkv[1]), packh2(kkv[2], kkv[3]), packh2(kkv[4], kkv[5]), packh2(kkv[6], kkv[7]));
        *(uint4*)(Hb + ho) = make_uint4(packh2(bb[0], bb[1]), packh2(bb[2], bb[3]), packh2(bb[4], bb[5]), packh2(bb[6], bb[7]));
        *(uint4*)(Hw + ho) = make_uint4(packh2(w[0], w[1]), packh2(w[2], w[3]), packh2(w[4], w[5]), packh2(w[6], w[7]));
        *(uint4*)(Hk + ho) = make_uint4(packh2(kp[0], kp[1]), packh2(kp[2], kp[3]), packh2(kp[4], kp[5]), packh2(kp[6], kp[7]));
        *(uint4*)(Hwr + ho) = make_uint4(packh2(w[0] * r[0], w[1] * r[1]), packh2(w[2] * r[2], w[3] * r[3]), packh2(w[4] * r[4], w[5] * r[5]), packh2(w[6] * r[6], w[7] * r[7]));
        *(uint4*)(Hv2 + ho) = make_uint4(packh2(v[0], v[0]), packh2(v[1], v[1]), packh2(v[2], v[2]), packh2(v[3], v[3]));
        *(uint4*)(Hv2 + ho + 4) = make_uint4(packh2(v[4], v[4]), packh2(v[5], v[5]), packh2(v[6], v[6]), packh2(v[7], v[7]));
        if ((tid & 7) == 0) { Lbon[tt] = bon; *(float2*)(Lsc + tt * 2) = make_float2(br, kr); }
      }
      __syncthreads();
      if (c + 1 < nch) SCAN_LOAD(c + 1);
      {
        const int nT = min(64, nsteps - c * 64);
        const u16* pk = Hkk + kc * 8; const u16* pw = Hw + kc * 8; const u16* pb = Hb + kc * 8;
        const u16* pkp = Hk + kc * 8; const u16* pwr = Hwr + kc * 8; const unsigned* pv = Hv2 + srow;
        float* py = LY + srow * 2;
#define SCAN_LD(S, o)                                                                  \
        S##kk = *(const uint4*)(pk + (o)); S##w = *(const uint4*)(pw + (o)); S##b = *(const uint4*)(pb + (o)); \
        S##k = *(const uint4*)(pkp + (o)); S##wr = *(const uint4*)(pwr + (o)); S##v = pv[(o)];
#define H2(x) (*(const h2_t*)&(x))
#define SCAN_UPD(sreg, S, c)                                                           \
        sreg = __builtin_elementwise_fma(sreg, H2(S##w.c), __builtin_elementwise_fma(-n_, H2(S##b.c), H2(S##v) * H2(S##k.c)));
#define SCAN_STEP(S, o)                                                                \
        {                                                                              \
          float d = __builtin_amdgcn_fdot2(sa_, H2(S##kk.x), 0.f, false);              \
          float e = __builtin_amdgcn_fdot2(sa_, H2(S##wr.x), 0.f, false);              \
          d = __builtin_amdgcn_fdot2(sb_, H2(S##kk.y), d, false); e = __builtin_amdgcn_fdot2(sb_, H2(S##wr.y), e, false); \
          d = __builtin_amdgcn_fdot2(sc_, H2(S##kk.z), d, false); e = __builtin_amdgcn_fdot2(sc_, H2(S##wr.z), e, false); \
          d = __builtin_amdgcn_fdot2(sd_, H2(S##kk.w), d, false); e = __builtin_amdgcn_fdot2(sd_, H2(S##wr.w), e, false); \
          d += dppf<0xB1>(d); e += dppf<0xB1>(e);                                      \
          d += dppf<0x4E>(d); e += dppf<0x4E>(e);                                      \
          d += dppf<0x141>(d); e += dppf<0x141>(e);                                    \
          const unsigned nu_ = packh2(d, d);                                           \
          const h2_t n_ = H2(nu_);                                                     \
          SCAN_UPD(sa_, S, x) SCAN_UPD(sb_, S, y) SCAN_UPD(sc_, S, z) SCAN_UPD(sd_, S, w) \
          if (kc == 0) *(float2*)(py + 2 * (o)) = make_float2(e, d);                   \
        }
        uint4 Akk, Aw, Ab, Ak, Awr, Bkk, Bw, Bb, Bk, Bwr; unsigned Av, Bv;
        SCAN_LD(A, 0);
        for (int t = 0; t < nT; t += 2) {
          SCAN_LD(B, (t + 1) * 64);
          SCAN_STEP(A, t * 64);
          SCAN_LD(A, (t + 2) * 64);
          SCAN_STEP(B, (t + 1) * 64);
        }
#undef SCAN_UPD
#undef H2
#undef SCAN_LD
#undef SCAN_STEP
      }
      __syncthreads();
      {
        const int tl = c * 64 + tt;
        if (tl < nsteps) {
          float y[8], z[8];
          const float2 sc = *(const float2*)(Lsc + tt * 2);
          const uint4 va = *(const uint4*)(Hv2 + tt * 64 + c8), vb = *(const uint4*)(Hv2 + tt * 64 + c8 + 4);
          float vv[8];
          { const unsigned vu[8] = {va.x, va.y, va.z, va.w, vb.x, vb.y, vb.z, vb.w};
#pragma unroll
            for (int j = 0; j < 8; ++j) { h2_t t_ = *(const h2_t*)&vu[j]; vv[j] = (float)t_[0]; } }
#pragma unroll
          for (int q = 0; q < 4; ++q) {
            const float4 ed = *(const float4*)(LY + tt * 128 + (c8 + 2 * q) * 2);
            y[2 * q] = ed.x - ed.y * sc.x + vv[2 * q] * sc.y;
            y[2 * q + 1] = ed.z - ed.w * sc.x + vv[2 * q + 1] * sc.y;
          }
          float sm = y[0] + y[1] + y[2] + y[3] + y[4] + y[5] + y[6] + y[7];
          sm = red8(sm);
          const float mean = sm * (1.f / 64.f);
          float vs = 0.f;
#pragma unroll
          for (int j = 0; j < 8; ++j) { y[j] -= mean; vs += y[j] * y[j]; }
          vs = red8(vs);
          const float rstd = rsqrtf(vs * (1.f / 64.f) + 64e-5f);
          const float bon = Lbon[tt];
          unpack8(zc, z);
          float o[8];
#pragma unroll
          for (int j = 0; j < 8; ++j) {
            float t = y[j] * rstd * clg[j] + clb[j] + bon * vv[j];
            o[j] = t * z[j] * sigmoidf_(z[j]);
          }
          uint4 ov; ov.x = pack2(o[0], o[1]); ov.y = pack2(o[2], o[3]); ov.z = pack2(o[4], o[5]); ov.w = pack2(o[6], o[7]);
          *(uint4*)(YG + (size_t)(tok0 + tl) * 2048 + col0) = ov;
        }
      }
      __syncthreads();
    }
#undef SCAN_LOAD
    *(float4*)(sout + srow * 64 + kc * 8) = make_float4((float)sa_[0], (float)sa_[1], (float)sb_[0], (float)sb_[1]);
    *(float4*)(sout + srow * 64 + kc * 8 + 4) = make_float4((float)sc_[0], (float)sc_[1], (float)sd_[0], (float)sd_[1]);
  }
}

template <int LAYER>
DEV void outproj_store(const Params& p, const float* mod, float* xmid, int m, int n, f32x4 v) {
  const float* gate = mod + (size_t)seq_of(m) * 3072 + 2048;
  float4 g4 = *(const float4*)(gate + n);
  if (LAYER == 0) {
    const float* xr = m < TP ? p.in[I_XP] + (size_t)m * 1024 : p.in[I_XS] + (size_t)(m - TP) * 1024;
    float4 x4 = *(const float4*)(xr + n);
    *(float4*)(xmid + (size_t)m * 1024 + n) = make_float4(x4.x + g4.x * v[0], x4.y + g4.y * v[1], x4.z + g4.z * v[2], x4.w + g4.w * v[3]);
  } else {
    float4 x4 = *(const float4*)(xmid + (size_t)m * 1024 + n);
    float* yo = m < TP ? p.out + OFF_Y_P + (size_t)m * 1024 : p.out + OFF_Y_S + (size_t)(m - TP) * 1024;
    *(float4*)(yo + n) = make_float4(x4.x + g4.x * v[0], x4.y + g4.y * v[1], x4.z + g4.z * v[2], x4.w + g4.w * v[3]);
  }
}

template <int LAYER>
DEV void phase_outproj_main(const Params& p, char* smem) {
  const int tid = threadIdx.x, lane = tid & 63, wid = tid >> 6, wr = wid >> 2, wc = wid & 3, fr = lane & 15, fq = lane >> 4;
  char* ws = p.ws;
  const u16* A = (const u16*)(ws + 6 * SLOT);
  const u16* Bt = (const u16*)(ws + (LAYER == 0 ? WS_WT_OUTA : WS_WT_OUTB));
  const float* mod = (const float*)(ws + WS_MOD) + (size_t)LAYER * 24 * 3072;
  float* xmid = (float*)(ws + 0 * SLOT);
  f32x4 acc[8][4];
  const int xcc0 = xcc_id();
  int nxt;
  for (int ls = 0; ls < 8; ++ls) {
    const int xcd = (xcc0 + ls) & 7;
    unsigned* ctr = sched_ctr(p, LAYER == 0 ? 1 : 3, xcd);
    for (int li = sched_first(ctr, smem); li < 64; li = sched_commit(nxt, smem)) {
      nxt = sched_prefetch(ctr);
      const int item = 64 * xcd + li;
      const int m0 = (item >> 2) * 256, n0 = (item & 3) * 256;
      gemm_main256_dma(acc, A, 2048, Bt, 2048, 32, m0, n0, smem);
#pragma unroll
      for (int i = 0; i < 8; ++i)
#pragma unroll
        for (int j = 0; j < 4; ++j)
          outproj_store<LAYER>(p, mod, xmid, m0 + wr * 128 + i * 16 + fr, n0 + wc * 64 + j * 16 + fq * 4, acc[i][j]);
    }
  }
}

template <int LAYER>
DEV void phase_outproj_tail(const Params& p, char* smem) {
  const int tid = threadIdx.x, lane = tid & 63, wid = tid >> 6, wr = wid >> 1, wc = wid & 1, fr = lane & 15, fq = lane >> 4;
  char* ws = p.ws;
  const u16* A = (const u16*)(ws + 6 * SLOT);
  const u16* Bt = (const u16*)(ws + (LAYER == 0 ? WS_WT_OUTA : WS_WT_OUTB));
  const float* mod = (const float*)(ws + WS_MOD) + (size_t)LAYER * 24 * 3072;
  float* xmid = (float*)(ws + 0 * SLOT);
  f32x4 acc[4][4];
  const int xcc0 = xcc_id();
  int nxt;
  for (int ls = 0; ls < 8; ++ls) {
    const int xcd = (xcc0 + ls) & 7;
    unsigned* ctr = sched_ctr(p, LAYER == 0 ? 5 : 6, xcd);
    for (int li = sched_first(ctr, smem); li < 2; li = sched_commit(nxt, smem)) {
      nxt = sched_prefetch(ctr);
      const int item = 2 * xcd + li;
      const int m0 = (128 + (item >> 3)) * 256, n0 = (item & 7) * 128;
      gemm_main<0>(acc, A, 2048, Bt, 2048, 32, m0, n0, nullptr, nullptr, smem);
#pragma unroll
      for (int i = 0; i < 4; ++i)
#pragma unroll
        for (int j = 0; j < 4; ++j)
          outproj_store<LAYER>(p, mod, xmid, m0 + wr * 64 + i * 16 + fr, n0 + wc * 64 + j * 16 + fq * 4, acc[i][j]);
    }
  }
}

template <int LAYER>
DEV void phase_outproj(const Params& p, char* smem) {
  phase_outproj_tail<LAYER>(p, smem);
  phase_outproj_main<LAYER>(p, smem);
}

DEV void phase_norm1(const Params& p) {
  const int lane = threadIdx.x & 63, wid = threadIdx.x >> 6;
  const float* mod = (const float*)(p.ws + WS_MOD) + (size_t)24 * 3072;
  const float* xmid = (const float*)(p.ws + 0 * SLOT);
  u16* AKV = (u16*)(p.ws + 1 * SLOT);
  u16* AQ = AKV + (size_t)NTOK * 1024;
  const float* gkv = p.in[I_KVNG];
  const float* gb = p.in[I_BNG];
  for (int t = blockIdx.x * 8 + wid; t < NTOK; t += gridDim.x * 8) {
    const float* x = xmid + (size_t)t * 1024;
    const float* md = mod + (size_t)seq_of(t) * 3072;
    float4 v[4];
    float ss = 0.f;
#pragma unroll
    for (int i = 0; i < 4; ++i) {
      v[i] = *(const float4*)(x + lane * 4 + 256 * i);
      ss += v[i].x * v[i].x + v[i].y * v[i].y + v[i].z * v[i].z + v[i].w * v[i].w;
    }
    ss = wave_sum(ss);
    const float rstd = rsqrtf(ss * (1.0f / 1024.0f) + 1e-6f);
#pragma unroll
    for (int i = 0; i < 4; ++i) {
      const int c = lane * 4 + 256 * i;
      float4 g1 = *(const float4*)(gkv + c), g2 = *(const float4*)(gb + c), sh = *(const float4*)(md + c), sc = *(const float4*)(md + 1024 + c);
      float xn0 = v[i].x * rstd, xn1 = v[i].y * rstd, xn2 = v[i].z * rstd, xn3 = v[i].w * rstd;
      uint2 o;
      o.x = pack2(xn0 * g1.x, xn1 * g1.y); o.y = pack2(xn2 * g1.z, xn3 * g1.w);
      *(uint2*)(AKV + (size_t)t * 1024 + c) = o;
      o.x = pack2(xn0 * g2.x * (1.f + sc.x) + sh.x, xn1 * g2.y * (1.f + sc.y) + sh.y);
      o.y = pack2(xn2 * g2.z * (1.f + sc.z) + sh.z, xn3 * g2.w * (1.f + sc.w) + sh.w);
      *(uint2*)(AQ + (size_t)t * 1024 + c) = o;
    }
  }
}

#define QSCALE (0.08838834764831845f * 1.4426950408889634f)
DEV void phase_proj1(const Params& p, char* smem) {
  const int tid = threadIdx.x, lane = tid & 63, wid = tid >> 6, wr = wid >> 2, wc = wid & 3, fr = lane & 15, fq = lane >> 4;
  char* ws = p.ws;
  const u16* AKV = (const u16*)(ws + 1 * SLOT);
  const u16* AQ = AKV + (size_t)NTOK * 1024;
  u16* KB = (u16*)(ws + 2 * SLOT);
  u16* VB = (u16*)(ws + 3 * SLOT);
  u16* QB = (u16*)(ws + 4 * SLOT);
  u16* ZS = (u16*)(ws + 5 * SLOT);
  f32x4 acc[8][4];
  float* red = (float*)smem;
  const int xcc0 = xcc_id();
  int nxt;
  for (int ls = 0; ls < 8; ++ls) {
  const int xcd = (xcc0 + ls) & 7;
  unsigned* ctr = sched_ctr(p, 2, xcd);
  for (int li = sched_first(ctr, smem); li < 520; li = sched_commit(nxt, smem)) {
    nxt = sched_prefetch(ctr);
    const int mt = li >> 2, t = 4 * xcd + (li & 3);
    const int isq = t >> 4, nt = t & 15;
    const int m0 = mt * 256, n0 = nt * 256;
    gemm_main256_dma(acc, isq ? AQ : AKV, 1024, (const u16*)(ws + (isq ? WS_WT_INB : WS_WT_KV)), 1024, 16, m0, n0, smem);
    if (nt < 8) {
#pragma unroll
      for (int i = 0; i < 8; ++i) {
        float ss = 0.f;
#pragma unroll
        for (int j = 0; j < 4; ++j) ss += acc[i][j][0] * acc[i][j][0] + acc[i][j][1] * acc[i][j][1] + acc[i][j][2] * acc[i][j][2] + acc[i][j][3] * acc[i][j][3];
        red[(wr * 128 + i * 16 + fr) * 16 + wc * 4 + fq] = ss;
      }
      __syncthreads();
      float rsv[8];
#pragma unroll
      for (int i = 0; i < 8; ++i) {
        const int row = wr * 128 + i * 16 + fr;
        float4 ra = *(const float4*)(red + row * 16 + (wc >> 1) * 8), rb = *(const float4*)(red + row * 16 + (wc >> 1) * 8 + 4);
        float tot = ra.x + ra.y + ra.z + ra.w + rb.x + rb.y + rb.z + rb.w;
        rsv[i] = rsqrtf(tot * (1.f / 128.f) + 1e-6f) * (isq ? QSCALE : 1.0f);
      }
      __syncthreads();
      const float* gain = isq ? p.in[I_BQG] : p.in[I_KGAIN];
#pragma unroll
      for (int i = 0; i < 8; ++i) {
        const int row = wr * 128 + i * 16 + fr, m = m0 + row;
        const float rs = rsv[i];
#pragma unroll
        for (int j = 0; j < 4; ++j) {
          const int d = (wc & 1) * 64 + j * 16 + fq * 4, col = wc * 64 + j * 16 + fq * 4, n = n0 + col;
          float4 g4 = *(const float4*)(gain + d);
          f32x4 v = acc[i][j];
          float o0 = v[0] * rs * g4.x, o1 = v[1] * rs * g4.y, o2 = v[2] * rs * g4.z, o3 = v[3] * rs * g4.w;
          uint2 o; o.x = pack2(o0, o1); o.y = pack2(o2, o3);
          *(uint2*)(smem + row * 528 + col * 2) = o;
          if (!isq) {
            float* ko = m < TP ? p.out + OFF_K_P + (size_t)m * 2048 : p.out + OFF_K_S + (size_t)(m - TP) * 2048;
            *(float4*)(ko + n) = make_float4(o0, o1, o2, o3);
          }
        }
      }
    } else {
#pragma unroll
      for (int i = 0; i < 8; ++i) {
        const int row = wr * 128 + i * 16 + fr, m = m0 + row;
#pragma unroll
        for (int j = 0; j < 4; ++j) {
          const int col = wc * 64 + j * 16 + fq * 4, n = n0 - 2048 + col;
          f32x4 v = acc[i][j];
          if (isq) {
            float o0 = v[0] * sigmoidf_(v[0]), o1 = v[1] * sigmoidf_(v[1]), o2 = v[2] * sigmoidf_(v[2]), o3 = v[3] * sigmoidf_(v[3]);
            uint2 o; o.x = pack2(o0, o1); o.y = pack2(o2, o3);
            *(uint2*)(smem + row * 528 + col * 2) = o;
          } else {
            uint2 o; o.x = pack2(v[0], v[1]); o.y = pack2(v[2], v[3]);
            *(uint2*)(smem + row * 528 + col * 2) = o;
            float* vo = m < TP ? p.out + OFF_V_P + (size_t)m * 2048 : p.out + OFF_V_S + (size_t)(m - TP) * 2048;
            *(float4*)(vo + n) = make_float4(v[0], v[1], v[2], v[3]);
          }
        }
      }
    }
    __syncthreads();
    {
      u16* bdst = isq ? (nt < 8 ? QB : ZS) : (nt < 8 ? KB : VB);
      const int nb = n0 - (nt < 8 ? 0 : 2048);
#pragma unroll 4
      for (int qq = 0; qq < 16; ++qq) {
        const int c = tid + 512 * qq, row = c >> 5, ch = c & 31;
        const uint4 v = *(const uint4*)(smem + row * 528 + ch * 16);
        *(uint4*)(bdst + (size_t)(m0 + row) * 2048 + nb + ch * 8) = v;
      }
    }
    __syncthreads();
  }
  }
}

DEV unsigned off_b(unsigned row, unsigned ch) { return 256u * row + 16u * (ch ^ (((row & 3) << 2) | ((row >> 2) & 3))); }

DEV void phase_attn(const Params& p, char* smem) {
  const int tid = threadIdx.x, lane = tid & 63, w = tid >> 6, fr = lane & 15, fq = lane >> 4;
  char* ws = p.ws;
  const u16* KB = (const u16*)(ws + 2 * SLOT);
  const u16* VB = (const u16*)(ws + 3 * SLOT);
  const u16* QB = (const u16*)(ws + 4 * SLOT);
  const u16* ZS = (const u16*)(ws + 5 * SLOT);
  u16* OG = (u16*)(ws + 6 * SLOT);
  const int lrow = tid >> 4, lch = tid & 15;
  const unsigned lw0 = off_b(lrow, lch), lw1 = off_b(lrow + 32, lch);
  const int tq = (lane & 15) >> 2, tp = lane & 3;

  for (int item = blockIdx.x; item < 4096 + 256; item += gridDim.x) {
    int b, h, nq, qpos0, tokq0, ntiles, nkeys, tokk0; bool sample;
    if (item < 4096) {
      const int qblk = 31 - (item >> 7), bh = item & 127;
      b = bh >> 4; h = bh & 15; nq = 128; qpos0 = qblk * 128; tokq0 = b * 4096 + qpos0; ntiles = 2 * qblk + 2; nkeys = qpos0 + 128; tokk0 = b * 4096; sample = false;
    } else {
      const int bh = item - 4096;
      b = bh >> 4; h = bh & 15; nq = 32; qpos0 = 1024; tokq0 = TP + b * 32; ntiles = 17; nkeys = 1056; tokk0 = TP + b * 32 - 1024; sample = true;
    }
    const bool wactive = (w * 16) < nq;
    int* dflag = (int*)(smem + 65536);
    __syncthreads();
    if (lane == 0) dflag[w] = wactive ? 0 : 1;
    bool wdone = !wactive;
    const int qp = qpos0 + w * 16 + fr;
    const int qwmax = qpos0 + w * 16 + 15;
    bf16x8 qf[4];
#pragma unroll
    for (int ks = 0; ks < 4; ++ks) {
      if (wactive) qf[ks] = *(const bf16x8*)(QB + (size_t)(tokq0 + w * 16 + fr) * 2048 + h * 128 + ks * 32 + fq * 8);
      else qf[ks] = (bf16x8){0, 0, 0, 0, 0, 0, 0, 0};
    }
    f32x4 O[8];
#pragma unroll
    for (int dt = 0; dt < 8; ++dt) O[dt] = (f32x4){0, 0, 0, 0};
    float carry = 0.f;

    uint4 lk0, lk1, lv0, lv1;
#define ATT_LOAD(kb)                                                                                  \
    {                                                                                                 \
      const int kx0_ = (kb) * 64 + lrow, kx1_ = kx0_ + 32;                                            \
      if (sample && (kb) < 16) {                                                                      \
        const float* ck_ = p.in[I_CK] + ((size_t)(b * 1024 + kx0_) * 16 + h) * 128 + lch * 8;         \
        const float* cv_ = p.in[I_CV] + ((size_t)(b * 1024 + kx0_) * 16 + h) * 128 + lch * 8;         \
        float4 a_ = *(const float4*)ck_, b_ = *(const float4*)(ck_ + 4);                              \
        float4 c_ = *(const float4*)(ck_ + 32 * 2048), d_ = *(const float4*)(ck_ + 32 * 2048 + 4);    \
        lk0 = make_uint4(pack2(a_.x, a_.y), pack2(a_.z, a_.w), pack2(b_.x, b_.y), pack2(b_.z, b_.w)); \
        lk1 = make_uint4(pack2(c_.x, c_.y), pack2(c_.z, c_.w), pack2(d_.x, d_.y), pack2(d_.z, d_.w)); \
        a_ = *(const float4*)cv_; b_ = *(const float4*)(cv_ + 4);                                     \
        c_ = *(const float4*)(cv_ + 32 * 2048); d_ = *(const float4*)(cv_ + 32 * 2048 + 4);           \
        lv0 = make_uint4(pack2(a_.x, a_.y), pack2(a_.z, a_.w), pack2(b_.x, b_.y), pack2(b_.z, b_.w)); \
        lv1 = make_uint4(pack2(c_.x, c_.y), pack2(c_.z, c_.w), pack2(d_.x, d_.y), pack2(d_.z, d_.w)); \
      } else {                                                                                        \
        const size_t o0_ = (size_t)(tokk0 + kx0_) * 2048 + h * 128 + lch * 8;                         \
        const size_t o1_ = o0_ + (size_t)32 * 2048;                                                   \
        if (kx0_ < nkeys) { lk0 = *(const uint4*)(KB + o0_); lv0 = *(const uint4*)(VB + o0_); }       \
        else { lk0 = make_uint4(0, 0, 0, 0); lv0 = lk0; }                                             \
        if (kx1_ < nkeys) { lk1 = *(const uint4*)(KB + o1_); lv1 = *(const uint4*)(VB + o1_); }       \
        else { lk1 = make_uint4(0, 0, 0, 0); lv1 = lk1; }                                             \
      }                                                                                               \
    }
#define ATT_STORE(st)                                                                                 \
    {                                                                                                 \
      char* sK_ = smem + (st) * 32768; char* sV_ = sK_ + 16384;                                       \
      *(uint4*)(sK_ + lw0) = lk0; *(uint4*)(sK_ + lw1) = lk1;                                         \
      *(uint4*)(sV_ + lw0) = lv0; *(uint4*)(sV_ + lw1) = lv1;                                         \
    }
    ATT_LOAD(ntiles - 1);
    ATT_STORE(0);
    __syncthreads();
    for (int it = 0; it < ntiles; ++it) {
      const int kb = ntiles - 1 - it, st = it & 1;
      if (it + 1 < ntiles) ATT_LOAD(kb - 1);
      if (!wdone && kb * 64 < qwmax) {
        const char* sK = smem + st * 32768;
        const char* sV = sK + 16384;
        f32x4 S[4];
#pragma unroll
        for (int mt = 0; mt < 4; ++mt) S[mt] = (f32x4){0, 0, 0, 0};
#pragma unroll
        for (int ks = 0; ks < 4; ++ks)
#pragma unroll
          for (int mt = 0; mt < 4; ++mt) {
            bf16x8 a = *(const bf16x8*)(sK + off_b(mt * 16 + fr, ks * 4 + fq));
            S[mt] = __builtin_amdgcn_mfma_f32_16x16x32_bf16(a, qf[ks], S[mt], 0, 0, 0);
          }
        bf16x8 wf[2];
#define ATT_ELEM(MASKED) \
        { \
          float ee[4][4], tot[4], hi[4]; \
_Pragma("unroll") \
          for (int mt = 0; mt < 4; ++mt) { \
            const int kbase = kb * 64 + mt * 16 + fq * 4; \
            float ls[4]; \
_Pragma("unroll") \
            for (int jj = 0; jj < 4; ++jj) { \
              const float u = S[mt][jj]; \
              const bool valid = !(MASKED) || ((kbase + jj) < qp); \
              const float l = -__builtin_amdgcn_logf(1.0f + __builtin_amdgcn_exp2f(u)); \
              ls[jj] = valid ? l : 0.f; \
              ee[mt][jj] = valid ? (u + l) : -1e30f; \
            } \
            const float x3 = ls[3], x2 = x3 + ls[2], x1 = x2 + ls[1], seg = x1 + ls[0]; \
            ee[mt][2] += x3; ee[mt][1] += x2; ee[mt][0] += x1; \
            const float t1 = __shfl_xor(seg, 16), t2 = __shfl_xor(seg, 32), t3 = __shfl_xor(t1, 32); \
            tot[mt] = seg + t1 + t2 + t3; \
            hi[mt] = fq == 0 ? (t1 + t2 + t3) : fq == 1 ? (t2 + t3) : fq == 2 ? t1 : 0.f; \
          } \
          float run = carry; \
          float wv[4][4]; \
_Pragma("unroll") \
          for (int mt = 3; mt >= 0; --mt) { \
            const float base = run + hi[mt]; \
            run += tot[mt]; \
_Pragma("unroll") \
            for (int jj = 0; jj < 4; ++jj) wv[mt][jj] = __builtin_amdgcn_exp2f(ee[mt][jj] + base); \
          } \
          carry = run; \
          if (__all(carry < -150.0f)) { wdone = true; if (lane == 0) dflag[w] = 1; } \
_Pragma("unroll") \
          for (int p2 = 0; p2 < 2; ++p2) { \
            uint4 pk; \
            pk.x = pack2(wv[2 * p2][0], wv[2 * p2][1]); pk.y = pack2(wv[2 * p2][2], wv[2 * p2][3]); \
            pk.z = pack2(wv[2 * p2 + 1][0], wv[2 * p2 + 1][1]); pk.w = pack2(wv[2 * p2 + 1][2], wv[2 * p2 + 1][3]); \
            wf[p2] = *(bf16x8*)&pk; \
          } \
        }
        if (kb * 64 + 63 < qpos0 + w * 16) { ATT_ELEM(0) } else { ATT_ELEM(1) }
#undef ATT_ELEM
#pragma unroll
        for (int p2 = 0; p2 < 2; ++p2)
#pragma unroll
          for (int dt = 0; dt < 8; ++dt) {
            const unsigned r0 = 32 * p2 + 4 * fq + tq, r1 = r0 + 16;
            const unsigned ch = 2 * dt + (tp >> 1);
            const char* a0 = sV + off_b(r0, ch) + 8 * (tp & 1);
            const char* a1 = sV + off_b(r1, ch) + 8 * (tp & 1);
            s16x4 lo = __builtin_amdgcn_ds_read_tr16_b64_v4i16((s16x4 __attribute__((address_space(3)))*)(a0));
            s16x4 hi4 = __builtin_amdgcn_ds_read_tr16_b64_v4i16((s16x4 __attribute__((address_space(3)))*)(a1));
            bf16x8 a = {lo[0], lo[1], lo[2], lo[3], hi4[0], hi4[1], hi4[2], hi4[3]};
            O[dt] = __builtin_amdgcn_mfma_f32_16x16x32_bf16(a, wf[p2], O[dt], 0, 0, 0);
          }
      }
      if (it + 1 < ntiles) ATT_STORE(st ^ 1);
      __syncthreads();
      {
        const int4 f0 = *(const int4*)dflag, f1 = *(const int4*)(dflag + 4);
        if (f0.x & f0.y & f0.z & f0.w & f1.x & f1.y & f1.z & f1.w) break;
      }
    }
#undef ATT_LOAD
#undef ATT_STORE
    if (wactive) {
      const size_t rowoff = (size_t)(tokq0 + w * 16 + fr) * 2048 + h * 128;
#pragma unroll
      for (int dt = 0; dt < 8; ++dt) {
        const int d = dt * 16 + fq * 4;
        uint2 z = *(const uint2*)(ZS + rowoff + d);
        f32x4 v = O[dt];
        uint2 o;
        o.x = pack2(v[0] * bflo(z.x), v[1] * bfhi(z.x)); o.y = pack2(v[2] * bflo(z.y), v[3] * bfhi(z.y));
        *(uint2*)(OG + rowoff + d) = o;
      }
    }
  }
}


DEV void grid_barrier(unsigned* bar, unsigned target) {
  __syncthreads();
  if (threadIdx.x == 0) {
    __builtin_amdgcn_fence(__ATOMIC_RELEASE, "agent");
    asm volatile("s_waitcnt vmcnt(0)" ::: "memory");
    __hip_atomic_fetch_add(bar, 1u, __ATOMIC_RELAXED, __HIP_MEMORY_SCOPE_AGENT);
    while (__hip_atomic_load(bar, __ATOMIC_RELAXED, __HIP_MEMORY_SCOPE_AGENT) < target) __builtin_amdgcn_s_sleep(1);
    __builtin_amdgcn_fence(__ATOMIC_ACQUIRE, "agent");
    asm volatile("s_waitcnt vmcnt(0)" ::: "memory");
  }
  __syncthreads();
}

__global__ void __launch_bounds__(NTHREADS) __attribute__((target("no-packed-fp32-ops"))) mega(Params p, int lo, int hi) {
  __shared__ __attribute__((aligned(16))) char smem[147456];
  cg::grid_group grid = cg::this_grid();
#ifndef PROBE_DOUBLE
#define PROBE_DOUBLE -1
#endif
#define RUN_PHASE(k, call) if ((k) >= lo && (k) < hi) { if ((k) > lo) { if ((k) == lo + 1) grid.sync(); else grid_barrier((unsigned*)(p.ws + WS_BAR), (unsigned)((k) - lo - 1) * gridDim.x); } call; }
  RUN_PHASE(0, phase_prep(p, smem))
  RUN_PHASE(1, phase_norm0(p))
  RUN_PHASE(2, phase_proj0(p, smem))
  RUN_PHASE(3, phase_scan(p, smem))
  RUN_PHASE(4, phase_outproj<0>(p, smem))
  RUN_PHASE(5, phase_norm1(p))
  RUN_PHASE(6, phase_proj1(p, smem))
  RUN_PHASE(7, phase_attn(p, smem))
  RUN_PHASE(8, phase_outproj<1>(p, smem))
}

#ifndef N_LAUNCH_MODE
#define N_LAUNCH_MODE 1
#endif

extern "C" void kernel_launch(void* const* d_in, const int* in_sizes, int n_in, void* d_out, int out_size, void* d_ws, size_t ws_size,
                              hipStream_t stream) {
  Params p{};
  for (int i = 0; i < 36; ++i) p.in[i] = (const float*)d_in[i];
  p.out = (float*)d_out;
  p.ws = (char*)d_ws;
  static int grid_blocks = 0;
  if (!grid_blocks) {
    int dev = 0, cus = 0, per_cu = 0;
    hipGetDevice(&dev);
    hipDeviceGetAttribute(&cus, hipDeviceAttributeMultiprocessorCount, dev);
    hipOccupancyMaxActiveBlocksPerMultiprocessor(&per_cu, mega, NTHREADS, 0);
    if (per_cu < 1) per_cu = 1;
    grid_blocks = cus * per_cu;
  }
  if (ws_size < WS_END) { fprintf(stderr, "workspace too small: %zu < %llu\n", ws_size, (unsigned long long)WS_END); return; }
#if N_LAUNCH_MODE == 1
  int lo = 0, hi = 9;
  hipMemsetAsync((char*)d_ws + WS_BAR, 0, 256, stream);
  void* args[] = {&p, &lo, &hi};
  hipError_t e = hipLaunchCooperativeKernel((void*)mega, dim3(grid_blocks), dim3(NTHREADS), args, 0, stream);
  if (e != hipSuccess) fprintf(stderr, "cooperative launch failed: %s (grid %d)\n", hipGetErrorString(e), grid_blocks);
#else
  for (int ph = 0; ph < 9; ++ph) hipLaunchKernelGGL(mega, dim3(grid_blocks), dim3(NTHREADS), 0, stream, p, ph, ph + 1);
#endif
}
```

```cpp
#include <hip/hip_runtime.h>
#include <hip/hip_cooperative_groups.h>
#include <cstdio>
namespace cg = cooperative_groups;

typedef unsigned short u16;
typedef short bf16x8 __attribute__((ext_vector_type(8)));
typedef short s16x4 __attribute__((ext_vector_type(4)));
typedef float f32x4 __attribute__((ext_vector_type(4)));
typedef float f32x2 __attribute__((ext_vector_type(2)));
typedef __bf16 bf16x2_t __attribute__((ext_vector_type(2)));
typedef _Float16 h2_t __attribute__((ext_vector_type(2)));

#define DEV __device__ __forceinline__

#define NTOK 33280
#define TP 32768
#define NTHREADS 512

#define OFF_Y_P 0
#define OFF_Y_S 33554432
#define OFF_K_P 34078720
#define OFF_V_P 101187584
#define OFF_WKV_P 168296448
#define OFF_SH_P 169345024
#define OFF_K_S 169353216
#define OFF_V_S 170401792
#define OFF_WKV_S 171450368
#define OFF_SH_S 173547520

#define SLOT 136314880ull
#define WS_W (7ull * SLOT)
#define WS_WT_IN (WS_W)
#define WS_WT_OUTA (WS_WT_IN + 16777216ull)
#define WS_WT_KV (WS_WT_OUTA + 4194304ull)
#define WS_WT_INB (WS_WT_KV + 8388608ull)
#define WS_WT_OUTB (WS_WT_INB + 8388608ull)
#define WS_W2T (WS_WT_OUTB + 4194304ull)
#define WS_A2T (WS_W2T + 262144ull)
#define WS_L1T (WS_A2T + 262144ull)
#define WS_MOD (WS_L1T + 524288ull)
#define WS_SH (WS_MOD + 589824ull)
#define WS_CTR (WS_SH + 49152ull)
#define WS_BAR (WS_CTR + 4096ull)
#define WS_END (WS_BAR + 256ull)
#define WS_H0 (6ull * SLOT)
#define WS_T (4ull * SLOT)

struct Params {
  const float* in[36];
  float* out;
  char* ws;
};

enum { I_XP = 0, I_XS, I_CK, I_CV, I_SWKV, I_SSH, I_CP, I_CS, I_ANG, I_AADAW, I_AADAB, I_AWIN, I_AMUIN, I_AMUW, I_AMUA,
       I_AW0, I_AW1, I_AW2, I_AA0, I_AA1, I_AA2, I_AKK, I_AKA, I_ARK, I_ALNG, I_ALNB, I_AWOUT, I_KVNG, I_KVW, I_KGAIN,
       I_BNG, I_BADAW, I_BADAB, I_BWIN, I_BQG, I_BWOUT };

DEV int seq_of(int t) { return t < TP ? (t >> 12) : 8 + ((t - TP) >> 5); }
DEV bool seq_start(int t) { return t < TP ? ((t & 4095) == 0) : (((t - TP) & 31) == 0); }

DEV unsigned pack2(float a, float b) {
  f32x2 v = {a, b};
  bf16x2_t r = __builtin_convertvector(v, bf16x2_t);
  return *(unsigned*)&r;
}
DEV unsigned packh2(float a, float b) {
  f32x2 v = {a, b};
  h2_t r = __builtin_convertvector(v, h2_t);
  return *(unsigned*)&r;
}
DEV float bflo(unsigned w) { return __uint_as_float(w << 16); }
DEV float bfhi(unsigned w) { return __uint_as_float(w & 0xffff0000u); }
DEV void unpack8(const uint4& x, float* f) {
  f[0] = bflo(x.x); f[1] = bfhi(x.x); f[2] = bflo(x.y); f[3] = bfhi(x.y);
  f[4] = bflo(x.z); f[5] = bfhi(x.z); f[6] = bflo(x.w); f[7] = bfhi(x.w);
}
DEV float sigmoidf_(float x) { return 1.0f / (1.0f + __expf(-x)); }

template <int CTRL>
DEV float dppf(float x) {
  return __int_as_float(__builtin_amdgcn_update_dpp(0, __float_as_int(x), CTRL, 0xf, 0xf, true));
}
DEV float red4(float x) { x += dppf<0xB1>(x); x += dppf<0x4E>(x); return x; }
DEV float red8(float x) { x = red4(x); x += dppf<0x141>(x); return x; }
DEV float red16(float x) { x = red8(x); x += dppf<0x140>(x); return x; }
DEV float wave_sum(float x) {
#pragma unroll
  for (int o = 32; o >= 1; o >>= 1) x += __shfl_xor(x, o);
  return x;
}


#define SCHED_SLOT_OFF 147440
DEV int xcc_id() { return (int)(__builtin_amdgcn_s_getreg((3 << 11) | 20) & 0x7u); }
DEV unsigned* sched_ctr(const Params& p, int phase_slot, int list) { return (unsigned*)(p.ws + WS_CTR) + (phase_slot * 8 + list) * 16; }
DEV int sched_first(unsigned* ctr, char* smem) {
  int* slot = (int*)(smem + SCHED_SLOT_OFF);
  __syncthreads();
  if (threadIdx.x == 0) *slot = (int)atomicAdd(ctr, 1u);
  __syncthreads();
  return *slot;
}

DEV void group_sync(unsigned* bar, unsigned target) {
  __syncthreads();
  if (threadIdx.x == 0) {
    __hip_atomic_fetch_add(bar, 1u, __ATOMIC_RELAXED, __HIP_MEMORY_SCOPE_AGENT);
    while (__hip_atomic_load(bar, __ATOMIC_RELAXED, __HIP_MEMORY_SCOPE_AGENT) < target) __builtin_amdgcn_s_sleep(2);
  }
  __syncthreads();
}
DEV int sched_prefetch(unsigned* ctr) { return threadIdx.x == 0 ? (int)atomicAdd(ctr, 1u) : 0; }
DEV int sched_commit(int nxt, char* smem) {
  int* slot = (int*)(smem + SCHED_SLOT_OFF);
  __syncthreads();
  if (threadIdx.x == 0) *slot = nxt;
  __syncthreads();
  return *slot;
}

#define GEMM_STAGE_BYTES 49152

template <int AMODE>
DEV void gemm_main(f32x4 (&acc)[4][4], const u16* __restrict__ A, int lda, const u16* __restrict__ Bt, int ldb, int nk,
                   int m0, int n0, const float* __restrict__ mu, const u16* __restrict__ SH, char* smem) {
  const int tid = threadIdx.x, lane = tid & 63, wid = tid >> 6, wr = wid >> 1, wc = wid & 1, fr = lane & 15, fq = lane >> 4;
  const int lrow = tid >> 3, lch = tid & 7;
#pragma unroll
  for (int i = 0; i < 4; ++i)
#pragma unroll
    for (int j = 0; j < 4; ++j) acc[i][j] = (f32x4){0.f, 0.f, 0.f, 0.f};

  const u16* pa0; const u16* pa1; const u16* pa2; const u16* pa3;
  const u16* pp0 = nullptr;
  const int arow = 4 * lrow;
  {
    int m = m0 + arow;
    pa0 = A + (size_t)m * lda + lch * 8;
    pa1 = pa0 + lda; pa2 = pa1 + lda; pa3 = pa2 + lda;
    if (AMODE != 0) pp0 = seq_start(m) ? SH + seq_of(m) * 1024 + lch * 8 : pa0 - lda;
  }
  const u16* pb0 = Bt + (size_t)(n0 + lrow) * ldb + lch * 8;
  const u16* pb1 = pb0 + (size_t)64 * ldb;
  const int woffB = lrow * 128 + ((lch ^ ((lrow >> 1) & 7)) << 4);
  const int woffA0 = (arow + 0) * 128 + ((lch ^ (((arow + 0) >> 1) & 7)) << 4);
  const int woffA1 = (arow + 1) * 128 + ((lch ^ (((arow + 1) >> 1) & 7)) << 4);
  const int woffA2 = (arow + 2) * 128 + ((lch ^ (((arow + 2) >> 1) & 7)) << 4);
  const int woffA3 = (arow + 3) * 128 + ((lch ^ (((arow + 3) >> 1) & 7)) << 4);

  uint4 ra0, ra1, ra2, ra3, rp0, rb0, rb1;
  float4 mu0, mu1;
  rp0 = make_uint4(0, 0, 0, 0);
  mu0 = mu1 = make_float4(0, 0, 0, 0);

#define G_LOAD(kt)                                                                     \
  {                                                                                    \
    const int k0_ = (kt) * 64;                                                         \
    if (AMODE == 0) {                                                                  \
      ra0 = *(const uint4*)(pa0 + k0_); ra1 = *(const uint4*)(pa1 + k0_);              \
      ra2 = *(const uint4*)(pa2 + k0_); ra3 = *(const uint4*)(pa3 + k0_);              \
    } else if (AMODE == 1) {                                                           \
      ra0 = *(const uint4*)(pa0 + k0_); ra1 = *(const uint4*)(pa1 + k0_);              \
      ra2 = *(const uint4*)(pa2 + k0_); ra3 = *(const uint4*)(pa3 + k0_);              \
      rp0 = *(const uint4*)(pp0 + k0_);                                                \
      mu0 = *(const float4*)(mu + k0_ + lch * 8); mu1 = *(const float4*)(mu + k0_ + lch * 8 + 4); \
    } else {                                                                           \
      const int kk_ = k0_ & 1023;                                                      \
      ra0 = *(const uint4*)(pa0 + kk_); ra1 = *(const uint4*)(pa1 + kk_);              \
      ra2 = *(const uint4*)(pa2 + kk_); ra3 = *(const uint4*)(pa3 + kk_);              \
      if (k0_ >= 1024) rp0 = *(const uint4*)(pp0 + kk_);                               \
    }                                                                                  \
    rb0 = *(const uint4*)(pb0 + k0_); rb1 = *(const uint4*)(pb1 + k0_);                \
  }

#define G_XFORM(dst, a_, p_, kt)                                                       \
  {                                                                                    \
    if (AMODE == 0) dst = a_;                                                          \
    else if (AMODE == 1) {                                                             \
      float h_[8], q_[8]; unpack8(a_, h_); unpack8(p_, q_);                            \
      dst.x = pack2(h_[0] + mu0.x * (q_[0] - h_[0]), h_[1] + mu0.y * (q_[1] - h_[1])); \
      dst.y = pack2(h_[2] + mu0.z * (q_[2] - h_[2]), h_[3] + mu0.w * (q_[3] - h_[3])); \
      dst.z = pack2(h_[4] + mu1.x * (q_[4] - h_[4]), h_[5] + mu1.y * (q_[5] - h_[5])); \
      dst.w = pack2(h_[6] + mu1.z * (q_[6] - h_[6]), h_[7] + mu1.w * (q_[7] - h_[7])); \
    } else {                                                                           \
      if ((kt) * 64 >= 1024) {                                                         \
        float h_[8], q_[8]; unpack8(a_, h_); unpack8(p_, q_);                          \
        dst.x = pack2(q_[0] - h_[0], q_[1] - h_[1]); dst.y = pack2(q_[2] - h_[2], q_[3] - h_[3]); \
        dst.z = pack2(q_[4] - h_[4], q_[5] - h_[5]); dst.w = pack2(q_[6] - h_[6], q_[7] - h_[7]); \
      } else dst = a_;                                                                 \
    }                                                                                  \
  }

#define G_STORE(stage, kt)                                                             \
  {                                                                                    \
    char* sA_ = smem + (stage) * GEMM_STAGE_BYTES; char* sB_ = sA_ + 32768;            \
    uint4 v_;                                                                          \
    G_XFORM(v_, ra0, rp0, kt); *(uint4*)(sA_ + woffA0) = v_;                           \
    G_XFORM(v_, ra1, ra0, kt); *(uint4*)(sA_ + woffA1) = v_;                           \
    G_XFORM(v_, ra2, ra1, kt); *(uint4*)(sA_ + woffA2) = v_;                           \
    G_XFORM(v_, ra3, ra2, kt); *(uint4*)(sA_ + woffA3) = v_;                           \
    *(uint4*)(sB_ + woffB) = rb0; *(uint4*)(sB_ + woffB + 64 * 128) = rb1;             \
  }

  G_LOAD(0);
  G_STORE(0, 0);
  __syncthreads();
  const int rsw = (fr >> 1) & 7;
  for (int kt = 0; kt < nk; ++kt) {
    const int st = kt & 1;
    if (kt + 1 < nk) G_LOAD(kt + 1);
    __builtin_amdgcn_sched_barrier(0);
    {
      const char* sA = smem + st * GEMM_STAGE_BYTES;
      const char* sB = sA + 32768;
#pragma unroll
      for (int kk = 0; kk < 2; ++kk) {
        bf16x8 af[4], bfr[4];
        const int cho = ((kk * 4 + fq) ^ rsw) << 4;
#pragma unroll
        for (int i = 0; i < 4; ++i) af[i] = *(const bf16x8*)(sA + (wr * 64 + i * 16 + fr) * 128 + cho);
#pragma unroll
        for (int j = 0; j < 4; ++j) bfr[j] = *(const bf16x8*)(sB + (wc * 64 + j * 16 + fr) * 128 + cho);
#pragma unroll
        for (int i = 0; i < 4; ++i)
#pragma unroll
          for (int j = 0; j < 4; ++j) acc[i][j] = __builtin_amdgcn_mfma_f32_16x16x32_bf16(bfr[j], af[i], acc[i][j], 0, 0, 0);
      }
    }
    if (kt + 1 < nk) G_STORE(st ^ 1, kt + 1);
    __syncthreads();
  }
#undef G_LOAD
#undef G_XFORM
#undef G_STORE
}


#define G2_STAGE_BYTES 32768
#define G2_MU_OFF (3 * G2_STAGE_BYTES)
DEV int g2_swz(int row) { return (0x78 >> (2 * ((row >> 2) & 3))) & 3; }
template <int AMODE>
DEV void gemm_main256(f32x4 (&acc)[8][4], const u16* __restrict__ A, int lda, const u16* __restrict__ Bt, int ldb, int nk64,
                      int m0, int n0, const float* __restrict__ mu, const u16* __restrict__ SH, char* smem) {
  const int tid = threadIdx.x, lane = tid & 63, wid = tid >> 6, wr = wid >> 2, wc = wid & 3, fr = lane & 15, fq = lane >> 4;
  const int nk = nk64 * 2;
  const int lrow2 = 2 * (tid >> 2), lch = tid & 3;
#pragma unroll
  for (int i = 0; i < 8; ++i)
#pragma unroll
    for (int j = 0; j < 4; ++j) acc[i][j] = (f32x4){0.f, 0.f, 0.f, 0.f};
  const u16* pa0 = A + (size_t)(m0 + lrow2) * lda + lch * 8;
  const u16* pp0 = nullptr;
  if (AMODE != 0) pp0 = seq_start(m0 + lrow2) ? SH + seq_of(m0 + lrow2) * 1024 + lch * 8 : pa0 - lda;
  const u16* pb0 = Bt + (size_t)(n0 + lrow2) * ldb + lch * 8;
  const int woff0 = (lrow2 + 0) * 64 + ((lch ^ g2_swz(lrow2 + 0)) << 4);
  const int woff1 = (lrow2 + 1) * 64 + ((lch ^ g2_swz(lrow2 + 1)) << 4);
  const float* muL = (const float*)(smem + G2_MU_OFF);
  if (AMODE == 1) {
    if (tid < 256) *(float4*)(smem + G2_MU_OFF + tid * 16) = *(const float4*)(mu + tid * 4);
  }
  uint4 xa0, xa1, xp, xb0, xb1;
  uint4 ya0, ya1, yp, yb0, yb1;
  xp = yp = make_uint4(0, 0, 0, 0);

#define K_LOAD(S, kt)                                                                  \
  {                                                                                    \
    const int k0_ = (kt) * 32;                                                         \
    S##a0 = *(const uint4*)(pa0 + k0_); S##a1 = *(const uint4*)(pa0 + lda + k0_);      \
    if (AMODE == 1) S##p = *(const uint4*)(pp0 + k0_);                                 \
    S##b0 = *(const uint4*)(pb0 + k0_); S##b1 = *(const uint4*)(pb0 + ldb + k0_);      \
  }
#define K_XFORM(dst, a_, p_)                                                           \
  {                                                                                    \
    if (AMODE == 0) dst = a_;                                                          \
    else {                                                                             \
      float h_[8], q_[8]; unpack8(a_, h_); unpack8(p_, q_);                            \
      dst.x = pack2(h_[0] + mu0.x * (q_[0] - h_[0]), h_[1] + mu0.y * (q_[1] - h_[1])); \
      dst.y = pack2(h_[2] + mu0.z * (q_[2] - h_[2]), h_[3] + mu0.w * (q_[3] - h_[3])); \
      dst.z = pack2(h_[4] + mu1.x * (q_[4] - h_[4]), h_[5] + mu1.y * (q_[5] - h_[5])); \
      dst.w = pack2(h_[6] + mu1.z * (q_[6] - h_[6]), h_[7] + mu1.w * (q_[7] - h_[7])); \
    }                                                                                  \
  }
#define K_STORE(S, stage, kt)                                                          \
  {                                                                                    \
    char* sA_ = smem + (stage) * G2_STAGE_BYTES; char* sB_ = sA_ + 16384;              \
    uint4 v_; float4 mu0, mu1;                                                         \
    if (AMODE == 1) { mu0 = *(const float4*)(muL + (kt) * 32 + lch * 8); mu1 = *(const float4*)(muL + (kt) * 32 + lch * 8 + 4); } \
    K_XFORM(v_, S##a0, S##p); *(uint4*)(sA_ + woff0) = v_;                             \
    K_XFORM(v_, S##a1, S##a0); *(uint4*)(sA_ + woff1) = v_;                            \
    *(uint4*)(sB_ + woff0) = S##b0; *(uint4*)(sB_ + woff1) = S##b1;                    \
  }
#define K_COMPUTE_HALF(stage, i0)                                                      \
  {                                                                                    \
    const char* sA_ = smem + (stage) * G2_STAGE_BYTES;                                 \
    _Pragma("unroll") for (int i = (i0); i < (i0) + 4; ++i) {                          \
      const bf16x8 af = *(const bf16x8*)(sA_ + (wr * 128 + i * 16 + fr) * 64 + cho);   \
      _Pragma("unroll") for (int j = 0; j < 4; ++j) acc[i][j] = __builtin_amdgcn_mfma_f32_16x16x32_bf16(bfr[j], af, acc[i][j], 0, 0, 0); \
    }                                                                                  \
  }
#define K_LOAD_B(stage)                                                                \
  {                                                                                    \
    const char* sB_ = smem + (stage) * G2_STAGE_BYTES + 16384;                         \
    _Pragma("unroll") for (int j = 0; j < 4; ++j) bfr[j] = *(const bf16x8*)(sB_ + (wc * 64 + j * 16 + fr) * 64 + cho); \
  }
#define K_ITER(kt, L, S)                                                               \
  {                                                                                    \
    K_LOAD(L, min((kt) + 2, nk - 1));                                                  \
    __builtin_amdgcn_sched_barrier(0);                                                 \
    bf16x8 bfr[4];                                                                     \
    K_LOAD_B(cu);                                                                      \
    K_COMPUTE_HALF(cu, 0);                                                             \
    __builtin_amdgcn_sched_barrier(0);                                                 \
    K_STORE(S, nx, min((kt) + 1, nk - 1));                                             \
    __builtin_amdgcn_sched_barrier(0);                                                 \
    if (AMODE == 1) K_LOAD_B(cu);                                                      \
    K_COMPUTE_HALF(cu, 4);                                                             \
    __syncthreads();                                                                   \
    cu = nx; nx = (nx == 2) ? 0 : nx + 1;                                              \
  }
  const int cho = (fq ^ g2_swz(fr)) << 4;
  if (AMODE == 1) __syncthreads();
  K_LOAD(x, 0);
  K_LOAD(y, 1);
  K_STORE(x, 0, 0);
  __syncthreads();
  int cu = 0, nx = 1;
  for (int kt = 0; kt < nk; kt += 2) {
    K_ITER(kt, x, y);
    K_ITER(kt + 1, y, x);
  }
#undef K_LOAD
#undef K_XFORM
#undef K_STORE
#undef K_COMPUTE_HALF
#undef K_LOAD_B
#undef K_ITER
}


#define GD_NST 4
DEV void gemm_main256_dma(f32x4 (&acc)[8][4], const u16* __restrict__ A, int lda, const u16* __restrict__ Bt, int ldb, int nk64,
                          int m0, int n0, char* smem) {
  const int tid = threadIdx.x, lane = tid & 63, wid = tid >> 6, wr = wid >> 2, wc = wid & 3, fr = lane & 15, fq = lane >> 4;
  const int nk = nk64 * 2;
#pragma unroll
  for (int i = 0; i < 8; ++i)
#pragma unroll
    for (int j = 0; j < 4; ++j) acc[i][j] = (f32x4){0.f, 0.f, 0.f, 0.f};
  const int prow = 16 * wid + (lane >> 2);
  const int pch = (lane & 3) ^ g2_swz(prow);
  const u16* srcA = A + (size_t)(m0 + prow) * lda + pch * 8;
  const u16* srcB = Bt + (size_t)(n0 + prow) * ldb + pch * 8;
  const size_t a128 = (size_t)128 * lda, b128 = (size_t)128 * ldb;
  char* ldsw = smem + (16 * wid) * 64;
#define D_FILL(kt, stage)                                                              \
  {                                                                                    \
    const int k0_ = (kt) * 32;                                                         \
    char* d_ = ldsw + (stage) * G2_STAGE_BYTES;                                        \
    __builtin_amdgcn_global_load_lds((const unsigned*)(srcA + k0_), (unsigned*)(d_), 16, 0, 0);               \
    __builtin_amdgcn_global_load_lds((const unsigned*)(srcA + a128 + k0_), (unsigned*)(d_ + 8192), 16, 0, 0); \
    __builtin_amdgcn_global_load_lds((const unsigned*)(srcB + k0_), (unsigned*)(d_ + 16384), 16, 0, 0);       \
    __builtin_amdgcn_global_load_lds((const unsigned*)(srcB + b128 + k0_), (unsigned*)(d_ + 16384 + 8192), 16, 0, 0); \
  }
  const int cho = (fq ^ g2_swz(fr)) << 4;
  __syncthreads();
  D_FILL(0, 0);
  D_FILL(min(1, nk - 1), 1);
  D_FILL(min(2, nk - 1), 2);
  int cu = 0, fill = 3;
  for (int kt = 0; kt < nk; ++kt) {
    asm volatile("s_waitcnt vmcnt(8)" ::: "memory");
    asm volatile("s_waitcnt lgkmcnt(0)" ::: "memory");
    __builtin_amdgcn_s_barrier();
    D_FILL(min(kt + 3, nk - 1), fill);
    {
      const char* sA_ = smem + cu * G2_STAGE_BYTES;
      const char* sB_ = sA_ + 16384;
      bf16x8 bfr[4];
#pragma unroll
      for (int j = 0; j < 4; ++j) bfr[j] = *(const bf16x8*)(sB_ + (wc * 64 + j * 16 + fr) * 64 + cho);
#pragma unroll
      for (int i = 0; i < 8; ++i) {
        const bf16x8 af = *(const bf16x8*)(sA_ + (wr * 128 + i * 16 + fr) * 64 + cho);
#pragma unroll
        for (int j = 0; j < 4; ++j) acc[i][j] = __builtin_amdgcn_mfma_f32_16x16x32_bf16(bfr[j], af, acc[i][j], 0, 0, 0);
      }
    }
    cu = (cu == GD_NST - 1) ? 0 : cu + 1;
    fill = (fill == GD_NST - 1) ? 0 : fill + 1;
  }
  asm volatile("s_waitcnt vmcnt(0)" ::: "memory");
  asm volatile("s_waitcnt lgkmcnt(0)" ::: "memory");
  __builtin_amdgcn_s_barrier();
#undef D_FILL
}

DEV void transpose_tile(const float* __restrict__ src, int N, int k0, int n0, const float* __restrict__ scale, u16* __restrict__ dst,
                        int dstride, int drow0, int dcol0, char* smem) {
  float* tile = (float*)smem;
  const int tid = threadIdx.x;
#pragma unroll
  for (int i = 0; i < 2; ++i) {
    int kl = (tid >> 4) + 32 * i, n4 = (tid & 15) * 4;
    float4 v = *(const float4*)(src + (size_t)(k0 + kl) * N + n0 + n4);
    float s = scale ? scale[k0 + kl] : 1.0f;
    tile[kl * 65 + n4 + 0] = v.x * s; tile[kl * 65 + n4 + 1] = v.y * s;
    tile[kl * 65 + n4 + 2] = v.z * s; tile[kl * 65 + n4 + 3] = v.w * s;
  }
  __syncthreads();
  {
    int nl = tid >> 3, k8 = (tid & 7) * 8;
    uint4 o;
    o.x = pack2(tile[(k8 + 0) * 65 + nl], tile[(k8 + 1) * 65 + nl]);
    o.y = pack2(tile[(k8 + 2) * 65 + nl], tile[(k8 + 3) * 65 + nl]);
    o.z = pack2(tile[(k8 + 4) * 65 + nl], tile[(k8 + 5) * 65 + nl]);
    o.w = pack2(tile[(k8 + 6) * 65 + nl], tile[(k8 + 7) * 65 + nl]);
    *(uint4*)(dst + (size_t)(drow0 + n0 + nl) * dstride + dcol0 + k0 + k8) = o;
  }
  __syncthreads();
}

DEV void phase_prep(const Params& p, char* smem) {
  const int tid = threadIdx.x;
  char* ws = p.ws;
  if (blockIdx.x < 96) {
    float* cL = (float*)smem;
    float* red = (float*)(smem + 98304);
    for (int e = tid; e < 24 * 256; e += NTHREADS) {
      int s = e >> 8, k4 = (e & 255) * 4;
      float4 v = s < 8 ? *(const float4*)(p.in[I_CP] + s * 1024 + k4) : *(const float4*)(p.in[I_CS] + (s - 8) * 1024 + k4);
      *(float4*)(cL + s * 1024 + k4) = v;
    }
    __syncthreads();
    for (int item = blockIdx.x; item < 96; item += gridDim.x) {
      const int l = item / 48, j0 = (item % 48) * 64;
      const float* W = (l == 0 ? p.in[I_AADAW] : p.in[I_BADAW]);
      const float* bias = (l == 0 ? p.in[I_AADAB] : p.in[I_BADAB]);
      const int col = tid & 63, kg = tid >> 6;
      float acc[24];
#pragma unroll
      for (int s = 0; s < 24; ++s) acc[s] = 0.f;
      for (int k = kg * 128; k < kg * 128 + 128; ++k) {
        float w = W[(size_t)k * 3072 + j0 + col];
#pragma unroll
        for (int s = 0; s < 24; ++s) acc[s] += cL[s * 1024 + k] * w;
      }
#pragma unroll
      for (int s = 0; s < 24; ++s) red[(kg * 24 + s) * 64 + col] = acc[s];
      __syncthreads();
      float* mod = (float*)(ws + WS_MOD);
      for (int e = tid; e < 24 * 64; e += NTHREADS) {
        int s = e >> 6, c = e & 63;
        float t = bias[j0 + c];
#pragma unroll
        for (int g = 0; g < 8; ++g) t += red[(g * 24 + s) * 64 + c];
        mod[(size_t)(l * 24 + s) * 3072 + j0 + c] = t;
      }
      __syncthreads();
    }
  }
  if (blockIdx.x == 0) for (int e = tid; e < 1024; e += NTHREADS) ((unsigned*)(ws + WS_CTR))[e] = 0u;
  if (blockIdx.x == gridDim.x - 1) {
    u16* SH = (u16*)(ws + WS_SH);
    for (int e = tid; e < 24 * 1024; e += NTHREADS) {
      int s = e >> 10, k = e & 1023;
      float v = s < 8 ? 0.f : p.in[I_SSH][(s - 8) * 1024 + k];
      SH[e] = (u16)(pack2(v, 0.f) & 0xffff);
    }
  }
  const int NT_TOTAL = 2048 + 512 + 1024 + 1024 + 512 + 32 + 32 + 64;
  for (int t = blockIdx.x; t < NT_TOTAL; t += gridDim.x) {
    const float* src; int K, N; u16* dst; int dstride, drow0 = 0, dcol0 = 0; const float* scale = nullptr; int tt = t;
    if (tt < 2048) { src = p.in[I_AWIN]; K = 1024; N = 8192; dst = (u16*)(ws + WS_WT_IN); dstride = 1024; }
    else if ((tt -= 2048) < 512) { src = p.in[I_AWOUT]; K = 2048; N = 1024; dst = (u16*)(ws + WS_WT_OUTA); dstride = 2048; }
    else if ((tt -= 512) < 1024) { src = p.in[I_KVW]; K = 1024; N = 4096; dst = (u16*)(ws + WS_WT_KV); dstride = 1024; }
    else if ((tt -= 1024) < 1024) { src = p.in[I_BWIN]; K = 1024; N = 4096; dst = (u16*)(ws + WS_WT_INB); dstride = 1024; }
    else if ((tt -= 1024) < 512) { src = p.in[I_BWOUT]; K = 2048; N = 1024; dst = (u16*)(ws + WS_WT_OUTB); dstride = 2048; }
    else if ((tt -= 512) < 32) { src = p.in[I_AW2]; K = 64; N = 2048; dst = (u16*)(ws + WS_W2T); dstride = 64; }
    else if ((tt -= 32) < 32) { src = p.in[I_AA2]; K = 64; N = 2048; dst = (u16*)(ws + WS_A2T); dstride = 64; }
    else {
      tt -= 32;
      int job = tt >> 4; tt &= 15;
      K = 1024; N = 64; dst = (u16*)(ws + WS_L1T); dstride = 2048;
      src = (job < 2) ? p.in[I_AW1] : p.in[I_AA1];
      drow0 = (job < 2) ? 0 : 64;
      if (job & 1) { dcol0 = 1024; scale = (job < 2) ? p.in[I_AMUW] : p.in[I_AMUA]; }
    }
    const int ntn = N / 64;
    const int kt = tt / ntn, nt = tt % ntn;
    transpose_tile(src, N, kt * 64, nt * 64, scale, dst, dstride, drow0, dcol0, smem);
  }
}

DEV void phase_norm0(const Params& p) {
  const int lane = threadIdx.x & 63, wid = threadIdx.x >> 6;
  const float* mod = (const float*)(p.ws + WS_MOD);
  u16* H0 = (u16*)(p.ws + WS_H0);
  const float* g = p.in[I_ANG];
  for (int t = blockIdx.x * 8 + wid; t < NTOK; t += gridDim.x * 8) {
    const float* x = t < TP ? p.in[I_XP] + (size_t)t * 1024 : p.in[I_XS] + (size_t)(t - TP) * 1024;
    const int s = seq_of(t);
    const float* md = mod + (size_t)s * 3072;
    float4 v[4];
    float ss = 0.f;
#pragma unroll
    for (int i = 0; i < 4; ++i) {
      v[i] = *(const float4*)(x + lane * 4 + 256 * i);
      ss += v[i].x * v[i].x + v[i].y * v[i].y + v[i].z * v[i].z + v[i].w * v[i].w;
    }
    ss = wave_sum(ss);
    const float rstd = rsqrtf(ss * (1.0f / 1024.0f) + 1e-6f);
    bool last = t < TP ? ((t & 4095) == 4095) : (((t - TP) & 31) == 31);
    float* so = t < TP ? p.out + OFF_SH_P + (t >> 12) * 1024 : p.out + OFF_SH_S + ((t - TP) >> 5) * 1024;
#pragma unroll
    for (int i = 0; i < 4; ++i) {
      const int c = lane * 4 + 256 * i;
      float4 gg = *(const float4*)(g + c), sh = *(const float4*)(md + c), sc = *(const float4*)(md + 1024 + c);
      float4 h;
      h.x = v[i].x * rstd * gg.x * (1.f + sc.x) + sh.x;
      h.y = v[i].y * rstd * gg.y * (1.f + sc.y) + sh.y;
      h.z = v[i].z * rstd * gg.z * (1.f + sc.z) + sh.z;
      h.w = v[i].w * rstd * gg.w * (1.f + sc.w) + sh.w;
      uint2 o; o.x = pack2(h.x, h.y); o.y = pack2(h.z, h.w);
      *(uint2*)(H0 + (size_t)t * 1024 + c) = o;
      if (last) *(float4*)(so + c) = h;
    }
  }
}

DEV void phase_proj0_lora(const Params& p, char* smem) {
  const int tid = threadIdx.x, lane = tid & 63, wid = tid >> 6, fr = lane & 15, fq = lane >> 4;
  const int wr = wid >> 1, wc = wid & 1;
  char* ws = p.ws;
  const u16* H0 = (const u16*)(ws + WS_H0);
  const u16* SH = (const u16*)(ws + WS_SH);
  u16* T = (u16*)(ws + WS_T);
  const int xcc0 = xcc_id();
  int nxt;
  f32x4 acc[4][4];
  for (int ls = 0; ls < 8; ++ls) {
  const int xcd = (xcc0 + ls) & 7;
  unsigned* ctr = sched_ctr(p, 0, xcd);
  for (int li = sched_first(ctr, smem); li < 17; li = sched_commit(nxt, smem)) {
    nxt = sched_prefetch(ctr);
    const int lmt = xcd + 8 * li;
    if (lmt >= 130) continue;
    const int m0 = lmt * 256;
    gemm_main<2>(acc, H0, 1024, (const u16*)(ws + WS_L1T), 2048, 32, m0, 0, nullptr, SH, smem);
#pragma unroll
    for (int i = 0; i < 4; ++i)
#pragma unroll
      for (int j = 0; j < 4; ++j) {
        const int m = m0 + wr * 64 + i * 16 + fr, n = wc * 64 + j * 16 + fq * 4;
        f32x4 v = acc[i][j];
        if (wc == 0) { v[0] = tanhf(v[0]); v[1] = tanhf(v[1]); v[2] = tanhf(v[2]); v[3] = tanhf(v[3]); }
        uint2 o; o.x = pack2(v[0], v[1]); o.y = pack2(v[2], v[3]);
        *(uint2*)(T + (size_t)m * 128 + n) = o;
      }
  }
  }
}

DEV void phase_proj0_main(const Params& p, char* smem) {
  const int tid = threadIdx.x, lane = tid & 63, wid = tid >> 6, fr = lane & 15, fq = lane >> 4;
  const int wr = wid >> 2, wc = wid & 3;
  char* ws = p.ws;
  const u16* H0 = (const u16*)(ws + WS_H0);
  const u16* SH = (const u16*)(ws + WS_SH);
  const int xcc0 = xcc_id();
  int nxt;
  f32x4 acc[8][4];
  for (int ls = 0; ls < 8; ++ls) {
  const int xcd = (xcc0 + ls) & 7;
  unsigned* ctr = sched_ctr(p, 4, xcd);
  for (int q = sched_first(ctr, smem); q < 520; q = sched_commit(nxt, smem)) {
    nxt = sched_prefetch(ctr);
    const int mt = q >> 2, nt = 4 * xcd + (q & 3);
    const int part = nt >> 3;
    const int m0 = mt * 256, n0 = nt * 256;
    gemm_main256<1>(acc, H0, 1024, (const u16*)(ws + WS_WT_IN), 1024, 16, m0, n0, p.in[I_AMUIN] + part * 1024, SH, smem);
    u16* dst = (u16*)(ws + (size_t)part * SLOT);
    const int nb = n0 - part * 2048;
#pragma unroll
    for (int i = 0; i < 8; ++i)
#pragma unroll
      for (int j = 0; j < 4; ++j) {
        const int row = wr * 128 + i * 16 + fr, col = wc * 64 + j * 16 + fq * 4;
        f32x4 v = acc[i][j];
        uint2 o; o.x = pack2(v[0], v[1]); o.y = pack2(v[2], v[3]);
        *(uint2*)(smem + row * 528 + col * 2) = o;
      }
    __syncthreads();
#pragma unroll
    for (int qq = 0; qq < 16; ++qq) {
      const int c = tid + 512 * qq, row = c >> 5, ch = c & 31;
      const uint4 v = *(const uint4*)(smem + row * 528 + ch * 16);
      *(uint4*)(dst + (size_t)(m0 + row) * 2048 + nb + ch * 8) = v;
    }
    __syncthreads();
  }
  }
}

DEV void phase_proj0(const Params& p, char* smem) {
  phase_proj0_lora(p, smem);
  phase_proj0_main(p, smem);
}

DEV void phase_scan(const Params& p, char* smem) {
  const int tid = threadIdx.x, lane = tid & 63, wid = tid >> 6;
  u16* Hkk = (u16*)smem;
  u16* Hw = Hkk + 4096;
  u16* Hb = Hw + 4096;
  u16* Hk = Hb + 4096;
  u16* Hwr = Hk + 4096;
  unsigned* Hv2 = (unsigned*)(smem + 40960);
  float* LY = (float*)(smem + 57344);
  float* Lbon = LY + 8192;
  float* Lsc = Lbon + 64;
  float* Lwa = Lsc + 128;
  char* ws = p.ws;
  const u16* gR = (const u16*)(ws + 0 * SLOT);
  const u16* gK = (const u16*)(ws + 1 * SLOT);
  const u16* gV = (const u16*)(ws + 2 * SLOT);
  const u16* gZ = (const u16*)(ws + 3 * SLOT);
  const u16* gT = (const u16*)(ws + WS_T);
  const u16* W2T = (const u16*)(ws + WS_W2T);
  const u16* A2T = (const u16*)(ws + WS_A2T);
  const int fr = lane & 15, fq = lane >> 4, lmt = wid & 3, lnh = wid >> 2;
  u16* YG = (u16*)(ws + 6 * SLOT);
  const int tt = tid >> 3, c8 = (tid & 7) * 8;
  const int srow = tid >> 3, kc = tid & 7;

  for (int item = blockIdx.x; item < 768; item += gridDim.x) {
    int h, tok0, nsteps; const float* sinit; float* sout;
    if (item < 256) { h = item & 31; tok0 = (item >> 5) * 4096; nsteps = 4096; sinit = nullptr; sout = p.out + OFF_WKV_P + (size_t)item * 4096; }
    else { int it = item - 256; h = it & 31; tok0 = TP + (it >> 5) * 32; nsteps = 32; sinit = p.in[I_SWKV] + (size_t)it * 4096; sout = p.out + OFF_WKV_S + (size_t)it * 4096; }
    const int nch = (nsteps + 63) >> 6;
    const int col0 = h * 64 + c8;
    float ckk[8], cka[8], crk[8], clg[8], clb[8];
    {
      float4 t0, t1;
      t0 = *(const float4*)(p.in[I_AKK] + col0); t1 = *(const float4*)(p.in[I_AKK] + col0 + 4);
      ckk[0] = t0.x; ckk[1] = t0.y; ckk[2] = t0.z; ckk[3] = t0.w; ckk[4] = t1.x; ckk[5] = t1.y; ckk[6] = t1.z; ckk[7] = t1.w;
      t0 = *(const float4*)(p.in[I_AKA] + col0); t1 = *(const float4*)(p.in[I_AKA] + col0 + 4);
      cka[0] = t0.x; cka[1] = t0.y; cka[2] = t0.z; cka[3] = t0.w; cka[4] = t1.x; cka[5] = t1.y; cka[6] = t1.z; cka[7] = t1.w;
      t0 = *(const float4*)(p.in[I_ARK] + col0); t1 = *(const float4*)(p.in[I_ARK] + col0 + 4);
      crk[0] = t0.x; crk[1] = t0.y; crk[2] = t0.z; crk[3] = t0.w; crk[4] = t1.x; crk[5] = t1.y; crk[6] = t1.z; crk[7] = t1.w;
      t0 = *(const float4*)(p.in[I_ALNG] + col0); t1 = *(const float4*)(p.in[I_ALNG] + col0 + 4);
      clg[0] = t0.x; clg[1] = t0.y; clg[2] = t0.z; clg[3] = t0.w; clg[4] = t1.x; clg[5] = t1.y; clg[6] = t1.z; clg[7] = t1.w;
      t0 = *(const float4*)(p.in[I_ALNB] + col0); t1 = *(const float4*)(p.in[I_ALNB] + col0 + 4);
      clb[0] = t0.x; clb[1] = t0.y; clb[2] = t0.z; clb[3] = t0.w; clb[4] = t1.x; clb[5] = t1.y; clb[6] = t1.z; clb[7] = t1.w;
    }
    float cw0[8], ca0[8];
    {
      float4 t0 = *(const float4*)(p.in[I_AW0] + col0), t1 = *(const float4*)(p.in[I_AW0] + col0 + 4);
      cw0[0] = t0.x; cw0[1] = t0.y; cw0[2] = t0.z; cw0[3] = t0.w; cw0[4] = t1.x; cw0[5] = t1.y; cw0[6] = t1.z; cw0[7] = t1.w;
      t0 = *(const float4*)(p.in[I_AA0] + col0); t1 = *(const float4*)(p.in[I_AA0] + col0 + 4);
      ca0[0] = t0.x; ca0[1] = t0.y; ca0[2] = t0.z; ca0[3] = t0.w; ca0[4] = t1.x; ca0[5] = t1.y; ca0[6] = t1.z; ca0[7] = t1.w;
    }
    bf16x8 w2f[2][2], a2f[2][2];
#pragma unroll
    for (int n2 = 0; n2 < 2; ++n2)
#pragma unroll
      for (int ks = 0; ks < 2; ++ks) {
        const size_t o_ = (size_t)(h * 64 + lnh * 32 + n2 * 16 + fr) * 64 + ks * 32 + fq * 8;
        w2f[n2][ks] = *(const bf16x8*)(W2T + o_);
        a2f[n2][ks] = *(const bf16x8*)(A2T + o_);
      }
    h2_t sa_, sb_, sc_, sd_;
    if (sinit) {
      float4 a = *(const float4*)(sinit + srow * 64 + kc * 8), b = *(const float4*)(sinit + srow * 64 + kc * 8 + 4);
      sa_ = (h2_t){(_Float16)a.x, (_Float16)a.y}; sb_ = (h2_t){(_Float16)a.z, (_Float16)a.w};
      sc_ = (h2_t){(_Float16)b.x, (_Float16)b.y}; sd_ = (h2_t){(_Float16)b.z, (_Float16)b.w};
    } else {
      sa_ = sb_ = sc_ = sd_ = (h2_t){(_Float16)0.f, (_Float16)0.f};
    }
    uint4 cr, ck, cv, cz;
    bf16x8 t1f[2], t2f[2];
#define SCAN_LOAD(c)                                                                   \
    {                                                                                  \
      const int tl_ = (c) * 64 + tt;                                                   \
      if (tl_ < nsteps) {                                                              \
        const size_t o_ = (size_t)(tok0 + tl_) * 2048 + col0;                          \
        cr = *(const uint4*)(gR + o_); ck = *(const uint4*)(gK + o_); cv = *(const uint4*)(gV + o_); \
        cz = *(const uint4*)(gZ + o_);                                                 \
      } else { cr = ck = cv = cz = make_uint4(0, 0, 0, 0); }                           \
      const int tm_ = (c) * 64 + lmt * 16 + fr;                                        \
      if (tm_ < nsteps) {                                                              \
        const u16* tp_ = gT + (size_t)(tok0 + tm_) * 128 + fq * 8;                     \
        t1f[0] = *(const bf16x8*)(tp_); t1f[1] = *(const bf16x8*)(tp_ + 32);           \
        t2f[0] = *(const bf16x8*)(tp_ + 64); t2f[1] = *(const bf16x8*)(tp_ + 96);      \
      } else { t1f[0] = t1f[1] = t2f[0] = t2f[1] = (bf16x8){0, 0, 0, 0, 0, 0, 0, 0}; } \
    }
    SCAN_LOAD(0);
    for (int c = 0; c < nch; ++c) {
      {
#pragma unroll
        for (int n2 = 0; n2 < 2; ++n2) {
          f32x4 xw = {0.f, 0.f, 0.f, 0.f}, xa = {0.f, 0.f, 0.f, 0.f};
          xw = __builtin_amdgcn_mfma_f32_16x16x32_bf16(w2f[n2][0], t1f[0], xw, 0, 0, 0);
          xw = __builtin_amdgcn_mfma_f32_16x16x32_bf16(w2f[n2][1], t1f[1], xw, 0, 0, 0);
          xa = __builtin_amdgcn_mfma_f32_16x16x32_bf16(a2f[n2][0], t2f[0], xa, 0, 0, 0);
          xa = __builtin_amdgcn_mfma_f32_16x16x32_bf16(a2f[n2][1], t2f[1], xa, 0, 0, 0);
          const int o_ = (lmt * 16 + fr) * 64 + lnh * 32 + n2 * 16 + fq * 4;
          *(float4*)(Lwa + o_) = make_float4(xw[0], xw[1], xw[2], xw[3]);
          *(float4*)(Lwa + 4096 + o_) = make_float4(xa[0], xa[1], xa[2], xa[3]);
        }
      }
      __syncthreads();
      uint4 zc = cz;
      {
        float r[8], k[8], v[8], lw[8], a[8];
        unpack8(cr, r); unpack8(ck, k); unpack8(cv, v);
        {
          const float4 x0 = *(const float4*)(Lwa + tt * 64 + c8), x1 = *(const float4*)(Lwa + tt * 64 + c8 + 4);
          const float4 y0 = *(const float4*)(Lwa + 4096 + tt * 64 + c8), y1 = *(const float4*)(Lwa + 4096 + tt * 64 + c8 + 4);
          const float xw_[8] = {x0.x, x0.y, x0.z, x0.w, x1.x, x1.y, x1.z, x1.w};
          const float xa_[8] = {y0.x, y0.y, y0.z, y0.w, y1.x, y1.y, y1.z, y1.w};
#pragma unroll
          for (int j = 0; j < 8; ++j) {
            lw[j] = -0.60653066f * sigmoidf_(cw0[j] + xw_[j]);
            a[j] = sigmoidf_(ca0[j] + xa_[j]);
          }
        }
        float kkv[8], kp[8], w[8], bon = 0.f, ss = 0.f, kr = 0.f;
#pragma unroll
        for (int j = 0; j < 8; ++j) {
          kkv[j] = k[j] * ckk[j]; ss += kkv[j] * kkv[j];
          kp[j] = k[j] * (1.f + (a[j] - 1.f) * cka[j]);
          bon += r[j] * kp[j] * crk[j];
          kr += r[j] * kp[j];
          w[j] = __expf(lw[j]);
        }
        ss = red8(ss); bon = red8(bon); kr = red8(kr);
        const float inv = rsqrtf(ss + 1e-12f);
        float bb[8], br = 0.f;
#pragma unroll
        for (int j = 0; j < 8; ++j) { kkv[j] *= inv; bb[j] = kkv[j] * a[j]; br += bb[j] * r[j]; }
        br = red8(br);
        const int ho = tt * 64 + c8;
        *(uint4*)(Hkk + ho) = make_uint4(packh2(kkv[0], kkv[1]), packh2(kkv[2], kkv[3]), packh2(kkv[4], kkv[5]), packh2(kkv[6], kkv[7]));
        *(uint4*)(Hb + ho) = make_uint4(packh2(bb[0], bb[1]), packh2(bb[2], bb[3]), packh2(bb[4], bb[5]), packh2(bb[6], bb[7]));
        *(uint4*)(Hw + ho) = make_uint4(packh2(w[0], w[1]), packh2(w[2], w[3]), packh2(w[4], w[5]), packh2(w[6], w[7]));
        *(uint4*)(Hk + ho) = make_uint4(packh2(kp[0], kp[1]), packh2(kp[2], kp[3]), packh2(kp[4], kp[5]), packh2(kp[6], kp[7]));
        *(uint4*)(Hwr + ho) = make_uint4(packh2(w[0] * r[0], w[1] * r[1]), packh2(w[2] * r[2], w[3] * r[3]), packh2(w[4] * r[4], w[5] * r[5]), packh2(w[6] * r[6], w[7] * r[7]));
        *(uint4*)(Hv2 + ho) = make_uint4(packh2(v[0], v[0]), packh2(v[1], v[1]), packh2(v[2], v[2]), packh2(v[3], v[3]));
        *(uint4*)(Hv2 + ho + 4) = make_uint4(packh2(v[4], v[4]), packh2(v[5], v[5]), packh2(v[6], v[6]), packh2(v[7], v[7]));
        if ((tid & 7) == 0) { Lbon[tt] = bon; *(float2*)(Lsc + tt * 2) = make_float2(br, kr); }
      }
      __syncthreads();
      if (c + 1 < nch) SCAN_LOAD(c + 1);
      {
        const int nT = min(64, nsteps - c * 64);
        const u16* pk = Hkk + kc * 8; const u16* pw = Hw + kc * 8; const u16* pb = Hb + kc * 8;
        const u16* pkp = Hk + kc * 8; const u16* pwr = Hwr + kc * 8; const unsigned* pv = Hv2 + srow;
        float* py = LY + srow * 2;
#define SCAN_LD(S, o)                                                                  \
        S##kk = *(const uint4*)(pk + (o)); S##w = *(const uint4*)(pw + (o)); S##b = *(const uint4*)(pb + (o)); \
        S##k = *(const uint4*)(pkp + (o)); S##wr = *(const uint4*)(pwr + (o)); S##v = pv[(o)];
#define H2(x) (*(const h2_t*)&(x))
#define SCAN_UPD(sreg, S, c)                                                           \
        sreg = __builtin_elementwise_fma(sreg, H2(S##w.c), __builtin_elementwise_fma(-n_, H2(S##b.c), H2(S##v) * H2(S##k.c)));
#define SCAN_STEP(S, o)                                                                \
        {                                                                              \
          float d = __builtin_amdgcn_fdot2(sa_, H2(S##kk.x), 0.f, false);              \
          float e = __builtin_amdgcn_fdot2(sa_, H2(S##wr.x), 0.f, false);              \
          d = __builtin_amdgcn_fdot2(sb_, H2(S##kk.y), d, false); e = __builtin_amdgcn_fdot2(sb_, H2(S##wr.y), e, false); \
          d = __builtin_amdgcn_fdot2(sc_, H2(S##kk.z), d, false); e = __builtin_amdgcn_fdot2(sc_, H2(S##wr.z), e, false); \
          d = __builtin_amdgcn_fdot2(sd_, H2(S##kk.w), d, false); e = __builtin_amdgcn_fdot2(sd_, H2(S##wr.w), e, false); \
          d += dppf<0xB1>(d); e += dppf<0xB1>(e);                                      \
          d += dppf<0x4E>(d); e += dppf<0x4E>(e);                                      \
          d += dppf<0x141>(d); e += dppf<0x141>(e);                                    \
          const unsigned nu_ = packh2(d, d);                                           \
          const h2_t n_ = H2(nu_);                                                     \
          SCAN_UPD(sa_, S, x) SCAN_UPD(sb_, S, y) SCAN_UPD(sc_, S, z) SCAN_UPD(sd_, S, w) \
          if (kc == 0) *(float2*)(py + 2 * (o)) = make_float2(e, d);                   \
        }
        uint4 Akk, Aw, Ab, Ak, Awr, Bkk, Bw, Bb, Bk, Bwr; unsigned Av, Bv;
        SCAN_LD(A, 0);
        for (int t = 0; t < nT; t += 2) {
          SCAN_LD(B, (t + 1) * 64);
          SCAN_STEP(A, t * 64);
          SCAN_LD(A, (t + 2) * 64);
          SCAN_STEP(B, (t + 1) * 64);
        }
#undef SCAN_UPD
#undef H2
#undef SCAN_LD
#undef SCAN_STEP
      }
      __syncthreads();
      {
        const int tl = c * 64 + tt;
        if (tl < nsteps) {
          float y[8], z[8];
          const float2 sc = *(const float2*)(Lsc + tt * 2);
          const uint4 va = *(const uint4*)(Hv2 + tt * 64 + c8), vb = *(const uint4*)(Hv2 + tt * 64 + c8 + 4);
          float vv[8];
          { const unsigned vu[8] = {va.x, va.y, va.z, va.w, vb.x, vb.y, vb.z, vb.w};
#pragma unroll
            for (int j = 0; j < 8; ++j) { h2_t t_ = *(const h2_t*)&vu[j]; vv[j] = (float)t_[0]; } }
#pragma unroll
          for (int q = 0; q < 4; ++q) {
            const float4 ed = *(const float4*)(LY + tt * 128 + (c8 + 2 * q) * 2);
            y[2 * q] = ed.x - ed.y * sc.x + vv[2 * q] * sc.y;
            y[2 * q + 1] = ed.z - ed.w * sc.x + vv[2 * q + 1] * sc.y;
          }
          float sm = y[0] + y[1] + y[2] + y[3] + y[4] + y[5] + y[6] + y[7];
          sm = red8(sm);
          const float mean = sm * (1.f / 64.f);
          float vs = 0.f;
#pragma unroll
          for (int j = 0; j < 8; ++j) { y[j] -= mean; vs += y[j] * y[j]; }
          vs = red8(vs);
          const float rstd = rsqrtf(vs * (1.f / 64.f) + 64e-5f);
          const float bon = Lbon[tt];
          unpack8(zc, z);
          float o[8];
#pragma unroll
          for (int j = 0; j < 8; ++j) {
            float t = y[j] * rstd * clg[j] + clb[j] + bon * vv[j];
            o[j] = t * z[j] * sigmoidf_(z[j]);
          }
          uint4 ov; ov.x = pack2(o[0], o[1]); ov.y = pack2(o[2], o[3]); ov.z = pack2(o[4], o[5]); ov.w = pack2(o[6], o[7]);
          *(uint4*)(YG + (size_t)(tok0 + tl) * 2048 + col0) = ov;
        }
      }
      __syncthreads();
    }
#undef SCAN_LOAD
    *(float4*)(sout + srow * 64 + kc * 8) = make_float4((float)sa_[0], (float)sa_[1], (float)sb_[0], (float)sb_[1]);
    *(float4*)(sout + srow * 64 + kc * 8 + 4) = make_float4((float)sc_[0], (float)sc_[1], (float)sd_[0], (float)sd_[1]);
  }
}

template <int LAYER>
DEV void outproj_store(const Params& p, const float* mod, float* xmid, int m, int n, f32x4 v) {
  const float* gate = mod + (size_t)seq_of(m) * 3072 + 2048;
  float4 g4 = *(const float4*)(gate + n);
  if (LAYER == 0) {
    const float* xr = m < TP ? p.in[I_XP] + (size_t)m * 1024 : p.in[I_XS] + (size_t)(m - TP) * 1024;
    float4 x4 = *(const float4*)(xr + n);
    *(float4*)(xmid + (size_t)m * 1024 + n) = make_float4(x4.x + g4.x * v[0], x4.y + g4.y * v[1], x4.z + g4.z * v[2], x4.w + g4.w * v[3]);
  } else {
    float4 x4 = *(const float4*)(xmid + (size_t)m * 1024 + n);
    float* yo = m < TP ? p.out + OFF_Y_P + (size_t)m * 1024 : p.out + OFF_Y_S + (size_t)(m - TP) * 1024;
    *(float4*)(yo + n) = make_float4(x4.x + g4.x * v[0], x4.y + g4.y * v[1], x4.z + g4.z * v[2], x4.w + g4.w * v[3]);
  }
}

template <int LAYER>
DEV void phase_outproj_main(const Params& p, char* smem) {
  const int tid = threadIdx.x, lane = tid & 63, wid = tid >> 6, wr = wid >> 2, wc = wid & 3, fr = lane & 15, fq = lane >> 4;
  char* ws = p.ws;
  const u16* A = (const u16*)(ws + 6 * SLOT);
  const u16* Bt = (const u16*)(ws + (LAYER == 0 ? WS_WT_OUTA : WS_WT_OUTB));
  const float* mod = (const float*)(ws + WS_MOD) + (size_t)LAYER * 24 * 3072;
  float* xmid = (float*)(ws + 0 * SLOT);
  f32x4 acc[8][4];
  const int xcc0 = xcc_id();
  int nxt;
  for (int ls = 0; ls < 8; ++ls) {
    const int xcd = (xcc0 + ls) & 7;
    unsigned* ctr = sched_ctr(p, LAYER == 0 ? 1 : 3, xcd);
    for (int li = sched_first(ctr, smem); li < 64; li = sched_commit(nxt, smem)) {
      nxt = sched_prefetch(ctr);
      const int item = 64 * xcd + li;
      const int m0 = (item >> 2) * 256, n0 = (item & 3) * 256;
      gemm_main256_dma(acc, A, 2048, Bt, 2048, 32, m0, n0, smem);
#pragma unroll
      for (int i = 0; i < 8; ++i)
#pragma unroll
        for (int j = 0; j < 4; ++j)
          outproj_store<LAYER>(p, mod, xmid, m0 + wr * 128 + i * 16 + fr, n0 + wc * 64 + j * 16 + fq * 4, acc[i][j]);
    }
  }
}

template <int LAYER>
DEV void phase_outproj_tail(const Params& p, char* smem) {
  const int tid = threadIdx.x, lane = tid & 63, wid = tid >> 6, wr = wid >> 1, wc = wid & 1, fr = lane & 15, fq = lane >> 4;
  char* ws = p.ws;
  const u16* A = (const u16*)(ws + 6 * SLOT);
  const u16* Bt = (const u16*)(ws + (LAYER == 0 ? WS_WT_OUTA : WS_WT_OUTB));
  const float* mod = (const float*)(ws + WS_MOD) + (size_t)LAYER * 24 * 3072;
  float* xmid = (float*)(ws + 0 * SLOT);
  f32x4 acc[4][4];
  const int xcc0 = xcc_id();
  int nxt;
  for (int ls = 0; ls < 8; ++ls) {
    const int xcd = (xcc0 + ls) & 7;
    unsigned* ctr = sched_ctr(p, LAYER == 0 ? 5 : 6, xcd);
    for (int li = sched_first(ctr, smem); li < 2; li = sched_commit(nxt, smem)) {
      nxt = sched_prefetch(ctr);
      const int item = 2 * xcd + li;
      const int m0 = (128 + (item >> 3)) * 256, n0 = (item & 7) * 128;
      gemm_main<0>(acc, A, 2048, Bt, 2048, 32, m0, n0, nullptr, nullptr, smem);
#pragma unroll
      for (int i = 0; i < 4; ++i)
#pragma unroll
        for (int j = 0; j < 4; ++j)
          outproj_store<LAYER>(p, mod, xmid, m0 + wr * 64 + i * 16 + fr, n0 + wc * 64 + j * 16 + fq * 4, acc[i][j]);
    }
  }
}

template <int LAYER>
DEV void phase_outproj(const Params& p, char* smem) {
  phase_outproj_tail<LAYER>(p, smem);
  phase_outproj_main<LAYER>(p, smem);
}

DEV void phase_norm1(const Params& p) {
  const int lane = threadIdx.x & 63, wid = threadIdx.x >> 6;
  const float* mod = (const float*)(p.ws + WS_MOD) + (size_t)24 * 3072;
  const float* xmid = (const float*)(p.ws + 0 * SLOT);
  u16* AKV = (u16*)(p.ws + 1 * SLOT);
  u16* AQ = AKV + (size_t)NTOK * 1024;
  const float* gkv = p.in[I_KVNG];
  const float* gb = p.in[I_BNG];
  for (int t = blockIdx.x * 8 + wid; t < NTOK; t += gridDim.x * 8) {
    const float* x = xmid + (size_t)t * 1024;
    const float* md = mod + (size_t)seq_of(t) * 3072;
    float4 v[4];
    float ss = 0.f;
#pragma unroll
    for (int i = 0; i < 4; ++i) {
      v[i] = *(const float4*)(x + lane * 4 + 256 * i);
      ss += v[i].x * v[i].x + v[i].y * v[i].y + v[i].z * v[i].z + v[i].w * v[i].w;
    }
    ss = wave_sum(ss);
    const float rstd = rsqrtf(ss * (1.0f / 1024.0f) + 1e-6f);
#pragma unroll
    for (int i = 0; i < 4; ++i) {
      const int c = lane * 4 + 256 * i;
      float4 g1 = *(const float4*)(gkv + c), g2 = *(const float4*)(gb + c), sh = *(const float4*)(md + c), sc = *(const float4*)(md + 1024 + c);
      float xn0 = v[i].x * rstd, xn1 = v[i].y * rstd, xn2 = v[i].z * rstd, xn3 = v[i].w * rstd;
      uint2 o;
      o.x = pack2(xn0 * g1.x, xn1 * g1.y); o.y = pack2(xn2 * g1.z, xn3 * g1.w);
      *(uint2*)(AKV + (size_t)t * 1024 + c) = o;
      o.x = pack2(xn0 * g2.x * (1.f + sc.x) + sh.x, xn1 * g2.y * (1.f + sc.y) + sh.y);
      o.y = pack2(xn2 * g2.z * (1.f + sc.z) + sh.z, xn3 * g2.w * (1.f + sc.w) + sh.w);
      *(uint2*)(AQ + (size_t)t * 1024 + c) = o;
    }
  }
}

#define QSCALE (0.08838834764831845f * 1.4426950408889634f)
DEV void phase_proj1(const Params& p, char* smem) {
  const int tid = threadIdx.x, lane = tid & 63, wid = tid >> 6, wr = wid >> 2, wc = wid & 3, fr = lane & 15, fq = lane >> 4;
  char* ws = p.ws;
  const u16* AKV = (const u16*)(ws + 1 * SLOT);
  const u16* AQ = AKV + (size_t)NTOK * 1024;
  u16* KB = (u16*)(ws + 2 * SLOT);
  u16* VB = (u16*)(ws + 3 * SLOT);
  u16* QB = (u16*)(ws + 4 * SLOT);
  u16* ZS = (u16*)(ws + 5 * SLOT);
  f32x4 acc[8][4];
  float* red = (float*)smem;
  const int xcc0 = xcc_id();
  int nxt;
  for (int ls = 0; ls < 8; ++ls) {
  const int xcd = (xcc0 + ls) & 7;
  unsigned* ctr = sched_ctr(p, 2, xcd);
  for (int li = sched_first(ctr, smem); li < 520; li = sched_commit(nxt, smem)) {
    nxt = sched_prefetch(ctr);
    const int mt = li >> 2, t = 4 * xcd + (li & 3);
    const int isq = t >> 4, nt = t & 15;
    const int m0 = mt * 256, n0 = nt * 256;
    gemm_main256_dma(acc, isq ? AQ : AKV, 1024, (const u16*)(ws + (isq ? WS_WT_INB : WS_WT_KV)), 1024, 16, m0, n0, smem);
    float rsv[8];
#pragma unroll
    for (int i = 0; i < 8; ++i) rsv[i] = 1.0f;
    if (nt < 8) {
#pragma unroll
      for (int i = 0; i < 8; ++i) {
        float ss = 0.f;
#pragma unroll
        for (int j = 0; j < 4; ++j) ss += acc[i][j][0] * acc[i][j][0] + acc[i][j][1] * acc[i][j][1] + acc[i][j][2] * acc[i][j][2] + acc[i][j][3] * acc[i][j][3];
        red[(wr * 128 + i * 16 + fr) * 16 + wc * 4 + fq] = ss;
      }
      __syncthreads();
#pragma unroll
      for (int i = 0; i < 8; ++i) {
        const int row = wr * 128 + i * 16 + fr;
        float4 ra = *(const float4*)(red + row * 16 + (wc >> 1) * 8), rb = *(const float4*)(red + row * 16 + (wc >> 1) * 8 + 4);
        float tot = ra.x + ra.y + ra.z + ra.w + rb.x + rb.y + rb.z + rb.w;
        rsv[i] = rsqrtf(tot * (1.f / 128.f) + 1e-6f) * (isq ? QSCALE : 1.0f);
      }
      __syncthreads();
      const float* gain = isq ? p.in[I_BQG] : p.in[I_KGAIN];
#pragma unroll
      for (int i = 0; i < 8; ++i) {
        const int row = wr * 128 + i * 16 + fr, m = m0 + row;
        const float rs = rsv[i];
#pragma unroll
        for (int j = 0; j < 4; ++j) {
          const int d = (wc & 1) * 64 + j * 16 + fq * 4, col = wc * 64 + j * 16 + fq * 4, n = n0 + col;
          float4 g4 = *(const float4*)(gain + d);
          f32x4 v = acc[i][j];
          float o0 = v[0] * rs * g4.x, o1 = v[1] * rs * g4.y, o2 = v[2] * rs * g4.z, o3 = v[3] * rs * g4.w;
          uint2 o; o.x = pack2(o0, o1); o.y = pack2(o2, o3);
          *(uint2*)(smem + row * 528 + col * 2) = o;
        }
      }
    } else {
#pragma unroll
      for (int i = 0; i < 8; ++i) {
        const int row = wr * 128 + i * 16 + fr, m = m0 + row;
#pragma unroll
        for (int j = 0; j < 4; ++j) {
          const int col = wc * 64 + j * 16 + fq * 4, n = n0 - 2048 + col;
          f32x4 v = acc[i][j];
          if (isq) {
            float o0 = v[0] * sigmoidf_(v[0]), o1 = v[1] * sigmoidf_(v[1]), o2 = v[2] * sigmoidf_(v[2]), o3 = v[3] * sigmoidf_(v[3]);
            uint2 o; o.x = pack2(o0, o1); o.y = pack2(o2, o3);
            *(uint2*)(smem + row * 528 + col * 2) = o;
          } else {
            uint2 o; o.x = pack2(v[0], v[1]); o.y = pack2(v[2], v[3]);
            *(uint2*)(smem + row * 528 + col * 2) = o;
          }
        }
      }
    }
    __syncthreads();
    {
      u16* bdst = isq ? (nt < 8 ? QB : ZS) : (nt < 8 ? KB : VB);
      const int nb = n0 - (nt < 8 ? 0 : 2048);
#pragma unroll 4
      for (int qq = 0; qq < 16; ++qq) {
        const int c = tid + 512 * qq, row = c >> 5, ch = c & 31;
        const uint4 v = *(const uint4*)(smem + row * 528 + ch * 16);
        *(uint4*)(bdst + (size_t)(m0 + row) * 2048 + nb + ch * 8) = v;
      }
    }
    __syncthreads();
    if (!isq) {
      const int nb = n0 - (nt < 8 ? 0 : 2048);
      float* fo = (m0 < TP) ? p.out + (nt < 8 ? OFF_K_P : OFF_V_P) + (size_t)m0 * 2048 : p.out + (nt < 8 ? OFF_K_S : OFF_V_S) + (size_t)(m0 - TP) * 2048;
      const float* gain = p.in[I_KGAIN];
#pragma unroll
      for (int half = 0; half < 2; ++half) {
        if (wr == half) {
#pragma unroll
          for (int i = 0; i < 8; ++i)
#pragma unroll
            for (int j = 0; j < 4; ++j) {
              const int row = i * 16 + fr, col = wc * 64 + j * 16 + fq * 4;
              float4 g4 = make_float4(1.f, 1.f, 1.f, 1.f);
              if (nt < 8) g4 = *(const float4*)(gain + (wc & 1) * 64 + j * 16 + fq * 4);
              const float rs = rsv[i];
              f32x4 v = acc[i][j];
              *(float4*)(smem + row * 1040 + col * 4) = make_float4(v[0] * rs * g4.x, v[1] * rs * g4.y, v[2] * rs * g4.z, v[3] * rs * g4.w);
            }
        }
        __syncthreads();
#pragma unroll 4
        for (int qq = 0; qq < 16; ++qq) {
          const int c = tid + 512 * qq, row = c >> 6, ch = c & 63;
          const float4 v = *(const float4*)(smem + row * 1040 + ch * 16);
          *(float4*)(fo + (size_t)(half * 128 + row) * 2048 + nb + ch * 4) = v;
        }
        __syncthreads();
      }
    }
  }
  }
}

DEV unsigned off_b(unsigned row, unsigned ch) { return 256u * row + 16u * (ch ^ (((row & 3) << 2) | ((row >> 2) & 3))); }

DEV void phase_attn(const Params& p, char* smem) {
  const int tid = threadIdx.x, lane = tid & 63, w = tid >> 6, fr = lane & 15, fq = lane >> 4;
  char* ws = p.ws;
  const u16* KB = (const u16*)(ws + 2 * SLOT);
  const u16* VB = (const u16*)(ws + 3 * SLOT);
  const u16* QB = (const u16*)(ws + 4 * SLOT);
  const u16* ZS = (const u16*)(ws + 5 * SLOT);
  u16* OG = (u16*)(ws + 6 * SLOT);
  const int lrow = tid >> 4, lch = tid & 15;
  const unsigned lw0 = off_b(lrow, lch), lw1 = off_b(lrow + 32, lch);
  const int tq = (lane & 15) >> 2, tp = lane & 3;

  for (int item = blockIdx.x; item < 4096 + 256; item += gridDim.x) {
    int b, h, nq, qpos0, tokq0, ntiles, nkeys, tokk0; bool sample;
    if (item < 4096) {
      const int qblk = 31 - (item >> 7), bh = item & 127;
      b = bh >> 4; h = bh & 15; nq = 128; qpos0 = qblk * 128; tokq0 = b * 4096 + qpos0; ntiles = 2 * qblk + 2; nkeys = qpos0 + 128; tokk0 = b * 4096; sample = false;
    } else {
      const int bh = item - 4096;
      b = bh >> 4; h = bh & 15; nq = 32; qpos0 = 1024; tokq0 = TP + b * 32; ntiles = 17; nkeys = 1056; tokk0 = TP + b * 32 - 1024; sample = true;
    }
    const bool wactive = (w * 16) < nq;
    int* dflag = (int*)(smem + 65536);
    __syncthreads();
    if (lane == 0) dflag[w] = wactive ? 0 : 1;
    bool wdone = !wactive;
    const int qp = qpos0 + w * 16 + fr;
    const int qwmax = qpos0 + w * 16 + 15;
    bf16x8 qf[4];
#pragma unroll
    for (int ks = 0; ks < 4; ++ks) {
      if (wactive) qf[ks] = *(const bf16x8*)(QB + (size_t)(tokq0 + w * 16 + fr) * 2048 + h * 128 + ks * 32 + fq * 8);
      else qf[ks] = (bf16x8){0, 0, 0, 0, 0, 0, 0, 0};
    }
    f32x4 O[8];
#pragma unroll
    for (int dt = 0; dt < 8; ++dt) O[dt] = (f32x4){0, 0, 0, 0};
    float carry = 0.f;

    uint4 lk0, lk1, lv0, lv1;
#define ATT_LOAD(kb)                                                                                  \
    {                                                                                                 \
      const int kx0_ = (kb) * 64 + lrow, kx1_ = kx0_ + 32;                                            \
      if (sample && (kb) < 16) {                                                                      \
        const float* ck_ = p.in[I_CK] + ((size_t)(b * 1024 + kx0_) * 16 + h) * 128 + lch * 8;         \
        const float* cv_ = p.in[I_CV] + ((size_t)(b * 1024 + kx0_) * 16 + h) * 128 + lch * 8;         \
        float4 a_ = *(const float4*)ck_, b_ = *(const float4*)(ck_ + 4);                              \
        float4 c_ = *(const float4*)(ck_ + 32 * 2048), d_ = *(const float4*)(ck_ + 32 * 2048 + 4);    \
        lk0 = make_uint4(pack2(a_.x, a_.y), pack2(a_.z, a_.w), pack2(b_.x, b_.y), pack2(b_.z, b_.w)); \
        lk1 = make_uint4(pack2(c_.x, c_.y), pack2(c_.z, c_.w), pack2(d_.x, d_.y), pack2(d_.z, d_.w)); \
        a_ = *(const float4*)cv_; b_ = *(const float4*)(cv_ + 4);                                     \
        c_ = *(const float4*)(cv_ + 32 * 2048); d_ = *(const float4*)(cv_ + 32 * 2048 + 4);           \
        lv0 = make_uint4(pack2(a_.x, a_.y), pack2(a_.z, a_.w), pack2(b_.x, b_.y), pack2(b_.z, b_.w)); \
        lv1 = make_uint4(pack2(c_.x, c_.y), pack2(c_.z, c_.w), pack2(d_.x, d_.y), pack2(d_.z, d_.w)); \
      } else {                                                                                        \
        const size_t o0_ = (size_t)(tokk0 + kx0_) * 2048 + h * 128 + lch * 8;                         \
        const size_t o1_ = o0_ + (size_t)32 * 2048;                                                   \
        if (kx0_ < nkeys) { lk0 = *(const uint4*)(KB + o0_); lv0 = *(const uint4*)(VB + o0_); }       \
        else { lk0 = make_uint4(0, 0, 0, 0); lv0 = lk0; }                                             \
        if (kx1_ < nkeys) { lk1 = *(const uint4*)(KB + o1_); lv1 = *(const uint4*)(VB + o1_); }       \
        else { lk1 = make_uint4(0, 0, 0, 0); lv1 = lk1; }                                             \
      }                                                                                               \
    }
#define ATT_STORE(st)                                                                                 \
    {                                                                                                 \
      char* sK_ = smem + (st) * 32768; char* sV_ = sK_ + 16384;                                       \
      *(uint4*)(sK_ + lw0) = lk0; *(uint4*)(sK_ + lw1) = lk1;                                         \
      *(uint4*)(sV_ + lw0) = lv0; *(uint4*)(sV_ + lw1) = lv1;                                         \
    }
    ATT_LOAD(ntiles - 1);
    ATT_STORE(0);
    __syncthreads();
    for (int it = 0; it < ntiles; ++it) {
      const int kb = ntiles - 1 - it, st = it & 1;
      if (it + 1 < ntiles) ATT_LOAD(kb - 1);
      if (!wdone && kb * 64 < qwmax) {
        const char* sK = smem + st * 32768;
        const char* sV = sK + 16384;
        f32x4 S[4];
#pragma unroll
        for (int mt = 0; mt < 4; ++mt) S[mt] = (f32x4){0, 0, 0, 0};
#pragma unroll
        for (int ks = 0; ks < 4; ++ks)
#pragma unroll
          for (int mt = 0; mt < 4; ++mt) {
            bf16x8 a = *(const bf16x8*)(sK + off_b(mt * 16 + fr, ks * 4 + fq));
            S[mt] = __builtin_amdgcn_mfma_f32_16x16x32_bf16(a, qf[ks], S[mt], 0, 0, 0);
          }
        bf16x8 wf[2];
#define ATT_ELEM(MASKED) \
        { \
          float ee[4][4], tot[4], hi[4]; \
_Pragma("unroll") \
          for (int mt = 0; mt < 4; ++mt) { \
            const int kbase = kb * 64 + mt * 16 + fq * 4; \
            float ls[4]; \
_Pragma("unroll") \
            for (int jj = 0; jj < 4; ++jj) { \
              const float u = S[mt][jj]; \
              const bool valid = !(MASKED) || ((kbase + jj) < qp); \
              const float l = -__builtin_amdgcn_logf(1.0f + __builtin_amdgcn_exp2f(u)); \
              ls[jj] = valid ? l : 0.f; \
              ee[mt][jj] = valid ? (u + l) : -1e30f; \
            } \
            const float x3 = ls[3], x2 = x3 + ls[2], x1 = x2 + ls[1], seg = x1 + ls[0]; \
            ee[mt][2] += x3; ee[mt][1] += x2; ee[mt][0] += x1; \
            const float t1 = __shfl_xor(seg, 16), t2 = __shfl_xor(seg, 32), t3 = __shfl_xor(t1, 32); \
            tot[mt] = seg + t1 + t2 + t3; \
            hi[mt] = fq == 0 ? (t1 + t2 + t3) : fq == 1 ? (t2 + t3) : fq == 2 ? t1 : 0.f; \
          } \
          float run = carry; \
          float wv[4][4]; \
_Pragma("unroll") \
          for (int mt = 3; mt >= 0; --mt) { \
            const float base = run + hi[mt]; \
            run += tot[mt]; \
_Pragma("unroll") \
            for (int jj = 0; jj < 4; ++jj) wv[mt][jj] = __builtin_amdgcn_exp2f(ee[mt][jj] + base); \
          } \
          carry = run; \
          if (__all(carry < -150.0f)) { wdone = true; if (lane == 0) dflag[w] = 1; } \
_Pragma("unroll") \
          for (int p2 = 0; p2 < 2; ++p2) { \
            uint4 pk; \
            pk.x = pack2(wv[2 * p2][0], wv[2 * p2][1]); pk.y = pack2(wv[2 * p2][2], wv[2 * p2][3]); \
            pk.z = pack2(wv[2 * p2 + 1][0], wv[2 * p2 + 1][1]); pk.w = pack2(wv[2 * p2 + 1][2], wv[2 * p2 + 1][3]); \
            wf[p2] = *(bf16x8*)&pk; \
          } \
        }
        if (kb * 64 + 63 < qpos0 + w * 16) { ATT_ELEM(0) } else { ATT_ELEM(1) }
#undef ATT_ELEM
#pragma unroll
        for (int p2 = 0; p2 < 2; ++p2)
#pragma unroll
          for (int dt = 0; dt < 8; ++dt) {
            const unsigned r0 = 32 * p2 + 4 * fq + tq, r1 = r0 + 16;
            const unsigned ch = 2 * dt + (tp >> 1);
            const char* a0 = sV + off_b(r0, ch) + 8 * (tp & 1);
            const char* a1 = sV + off_b(r1, ch) + 8 * (tp & 1);
            s16x4 lo = __builtin_amdgcn_ds_read_tr16_b64_v4i16((s16x4 __attribute__((address_space(3)))*)(a0));
            s16x4 hi4 = __builtin_amdgcn_ds_read_tr16_b64_v4i16((s16x4 __attribute__((address_space(3)))*)(a1));
            bf16x8 a = {lo[0], lo[1], lo[2], lo[3], hi4[0], hi4[1], hi4[2], hi4[3]};
            O[dt] = __builtin_amdgcn_mfma_f32_16x16x32_bf16(a, wf[p2], O[dt], 0, 0, 0);
          }
      }
      if (it + 1 < ntiles) ATT_STORE(st ^ 1);
      __syncthreads();
      {
        const int4 f0 = *(const int4*)dflag, f1 = *(const int4*)(dflag + 4);
        if (f0.x & f0.y & f0.z & f0.w & f1.x & f1.y & f1.z & f1.w) break;
      }
    }
#undef ATT_LOAD
#undef ATT_STORE
    if (wactive) {
      const size_t rowoff = (size_t)(tokq0 + w * 16 + fr) * 2048 + h * 128;
#pragma unroll
      for (int dt = 0; dt < 8; ++dt) {
        const int d = dt * 16 + fq * 4;
        uint2 z = *(const uint2*)(ZS + rowoff + d);
        f32x4 v = O[dt];
        uint2 o;
        o.x = pack2(v[0] * bflo(z.x), v[1] * bfhi(z.x)); o.y = pack2(v[2] * bflo(z.y), v[3] * bfhi(z.y));
        *(uint2*)(OG + rowoff + d) = o;
      }
    }
  }
}


DEV void grid_barrier(unsigned* bar, unsigned target) {
  __syncthreads();
  if (threadIdx.x == 0) {
    __builtin_amdgcn_fence(__ATOMIC_RELEASE, "agent");
    asm volatile("s_waitcnt vmcnt(0)" ::: "memory");
    __hip_atomic_fetch_add(bar, 1u, __ATOMIC_RELAXED, __HIP_MEMORY_SCOPE_AGENT);
    while (__hip_atomic_load(bar, __ATOMIC_RELAXED, __HIP_MEMORY_SCOPE_AGENT) < target) __builtin_amdgcn_s_sleep(1);
    __builtin_amdgcn_fence(__ATOMIC_ACQUIRE, "agent");
    asm volatile("s_waitcnt vmcnt(0)" ::: "memory");
  }
  __syncthreads();
}

__global__ void __launch_bounds__(NTHREADS) __attribute__((target("no-packed-fp32-ops"))) mega(Params p, int lo, int hi) {
  __shared__ __attribute__((aligned(16))) char smem[147456];
  cg::grid_group grid = cg::this_grid();
#ifndef PROBE_DOUBLE
#define PROBE_DOUBLE -1
#endif
#define RUN_PHASE(k, call) if ((k) >= lo && (k) < hi) { if ((k) > lo) { if ((k) == lo + 1) grid.sync(); else grid_barrier((unsigned*)(p.ws + WS_BAR), (unsigned)((k) - lo - 1) * gridDim.x); } call; }
  RUN_PHASE(0, phase_prep(p, smem))
  RUN_PHASE(1, phase_norm0(p))
  RUN_PHASE(2, phase_proj0(p, smem))
  RUN_PHASE(3, phase_scan(p, smem))
  RUN_PHASE(4, phase_outproj<0>(p, smem))
  RUN_PHASE(5, phase_norm1(p))
  RUN_PHASE(6, phase_proj1(p, smem))
  RUN_PHASE(7, phase_attn(p, smem))
  RUN_PHASE(8, phase_outproj<1>(p, smem))
}

#ifndef N_LAUNCH_MODE
#define N_LAUNCH_MODE 1
#endif

extern "C" void kernel_launch(void* const* d_in, const int* in_sizes, int n_in, void* d_out, int out_size, void* d_ws, size_t ws_size,
                              hipStream_t stream) {
  Params p{};
  for (int i = 0; i < 36; ++i) p.in[i] = (const float*)d_in[i];
  p.out = (float*)d_out;
  p.ws = (char*)d_ws;
  static int grid_blocks = 0;
  if (!grid_blocks) {
    int dev = 0, cus = 0, per_cu = 0;
    hipGetDevice(&dev);
    hipDeviceGetAttribute(&cus, hipDeviceAttributeMultiprocessorCount, dev);
    hipOccupancyMaxActiveBlocksPerMultiprocessor(&per_cu, mega, NTHREADS, 0);
    if (per_cu < 1) per_cu = 1;
    grid_blocks = cus * per_cu;
  }
  if (ws_size < WS_END) { fprintf(stderr, "workspace too small: %zu < %llu\n", ws_size, (unsigned long long)WS_END); return; }
#if N_LAUNCH_MODE == 1
  int lo = 0, hi = 9;
  hipMemsetAsync((char*)d_ws + WS_BAR, 0, 256, stream);
  void* args[] = {&p, &lo, &hi};
  hipError_t e = hipLaunchCooperativeKernel((void*)mega, dim3(grid_blocks), dim3(NTHREADS), args, 0, stream);
  if (e != hipSuccess) fprintf(stderr, "cooperative launch failed: %s (grid %d)\n", hipGetErrorString(e), grid_blocks);
#else
  for (int ph = 0; ph < 9; ++ph) hipLaunchKernelGGL(mega, dim3(grid_blocks), dim3(NTHREADS), 0, stream, p, ph, ph + 1);
#endif
}
```

```cpp
#include <hip/hip_runtime.h>
#include <hip/hip_cooperative_groups.h>
#include <cstdio>
namespace cg = cooperative_groups;

typedef unsigned short u16;
typedef short bf16x8 __attribute__((ext_vector_type(8)));
typedef short s16x4 __attribute__((ext_vector_type(4)));
typedef float f32x4 __attribute__((ext_vector_type(4)));
typedef float f32x2 __attribute__((ext_vector_type(2)));
typedef __bf16 bf16x2_t __attribute__((ext_vector_type(2)));
typedef _Float16 h2_t __attribute__((ext_vector_type(2)));

#define DEV __device__ __forceinline__

#define NTOK 33280
#define TP 32768
#define NTHREADS 512

#define OFF_Y_P 0
#define OFF_Y_S 33554432
#define OFF_K_P 34078720
#define OFF_V_P 101187584
#define OFF_WKV_P 168296448
#define OFF_SH_P 169345024
#define OFF_K_S 169353216
#define OFF_V_S 170401792
#define OFF_WKV_S 171450368
#define OFF_SH_S 173547520

#define SLOT 136314880ull
#define WS_W (7ull * SLOT)
#define WS_WT_IN (WS_W)
#define WS_WT_OUTA (WS_WT_IN + 16777216ull)
#define WS_WT_KV (WS_WT_OUTA + 4194304ull)
#define WS_WT_INB (WS_WT_KV + 8388608ull)
#define WS_WT_OUTB (WS_WT_INB + 8388608ull)
#define WS_W2T (WS_WT_OUTB + 4194304ull)
#define WS_A2T (WS_W2T + 262144ull)
#define WS_L1T (WS_A2T + 262144ull)
#define WS_MOD (WS_L1T + 524288ull)
#define WS_SH (WS_MOD + 589824ull)
#define WS_CTR (WS_SH + 49152ull)
#define WS_BAR (WS_CTR + 4096ull)
#define WS_END (WS_BAR + 256ull)
#define WS_H0 (6ull * SLOT)
#define WS_T (4ull * SLOT)

struct Params {
  const float* in[36];
  float* out;
  char* ws;
};

enum { I_XP = 0, I_XS, I_CK, I_CV, I_SWKV, I_SSH, I_CP, I_CS, I_ANG, I_AADAW, I_AADAB, I_AWIN, I_AMUIN, I_AMUW, I_AMUA,
       I_AW0, I_AW1, I_AW2, I_AA0, I_AA1, I_AA2, I_AKK, I_AKA, I_ARK, I_ALNG, I_ALNB, I_AWOUT, I_KVNG, I_KVW, I_KGAIN,
       I_BNG, I_BADAW, I_BADAB, I_BWIN, I_BQG, I_BWOUT };

DEV int seq_of(int t) { return t < TP ? (t >> 12) : 8 + ((t - TP) >> 5); }
DEV bool seq_start(int t) { return t < TP ? ((t & 4095) == 0) : (((t - TP) & 31) == 0); }

DEV unsigned pack2(float a, float b) {
  f32x2 v = {a, b};
  bf16x2_t r = __builtin_convertvector(v, bf16x2_t);
  return *(unsigned*)&r;
}
DEV unsigned packh2(float a, float b) {
  f32x2 v = {a, b};
  h2_t r = __builtin_convertvector(v, h2_t);
  return *(unsigned*)&r;
}
DEV float bflo(unsigned w) { return __uint_as_float(w << 16); }
DEV float bfhi(unsigned w) { return __uint_as_float(w & 0xffff0000u); }
DEV void unpack8(const uint4& x, float* f) {
  f[0] = bflo(x.x); f[1] = bfhi(x.x); f[2] = bflo(x.y); f[3] = bfhi(x.y);
  f[4] = bflo(x.z); f[5] = bfhi(x.z); f[6] = bflo(x.w); f[7] = bfhi(x.w);
}
DEV float sigmoidf_(float x) { return 1.0f / (1.0f + __expf(-x)); }

template <int CTRL>
DEV float dppf(float x) {
  return __int_as_float(__builtin_amdgcn_update_dpp(0, __float_as_int(x), CTRL, 0xf, 0xf, true));
}
DEV float red4(float x) { x += dppf<0xB1>(x); x += dppf<0x4E>(x); return x; }
DEV float red8(float x) { x = red4(x); x += dppf<0x141>(x); return x; }
DEV float red16(float x) { x = red8(x); x += dppf<0x140>(x); return x; }
DEV float wave_sum(float x) {
#pragma unroll
  for (int o = 32; o >= 1; o >>= 1) x += __shfl_xor(x, o);
  return x;
}


#define SCHED_SLOT_OFF 147440
DEV int xcc_id() { return (int)(__builtin_amdgcn_s_getreg((3 << 11) | 20) & 0x7u); }
DEV unsigned* sched_ctr(const Params& p, int phase_slot, int list) { return (unsigned*)(p.ws + WS_CTR) + (phase_slot * 8 + list) * 16; }
DEV int sched_first(unsigned* ctr, char* smem) {
  int* slot = (int*)(smem + SCHED_SLOT_OFF);
  __syncthreads();
  if (threadIdx.x == 0) *slot = (int)atomicAdd(ctr, 1u);
  __syncthreads();
  return *slot;
}

DEV void group_sync(unsigned* bar, unsigned target) {
  __syncthreads();
  if (threadIdx.x == 0) {
    __hip_atomic_fetch_add(bar, 1u, __ATOMIC_RELAXED, __HIP_MEMORY_SCOPE_AGENT);
    while (__hip_atomic_load(bar, __ATOMIC_RELAXED, __HIP_MEMORY_SCOPE_AGENT) < target) __builtin_amdgcn_s_sleep(2);
  }
  __syncthreads();
}
DEV int sched_prefetch(unsigned* ctr) { return threadIdx.x == 0 ? (int)atomicAdd(ctr, 1u) : 0; }
DEV int sched_commit(int nxt, char* smem) {
  int* slot = (int*)(smem + SCHED_SLOT_OFF);
  __syncthreads();
  if (threadIdx.x == 0) *slot = nxt;
  __syncthreads();
  return *slot;
}

#define GEMM_STAGE_BYTES 49152

template <int AMODE>
DEV void gemm_main(f32x4 (&acc)[4][4], const u16* __restrict__ A, int lda, const u16* __restrict__ Bt, int ldb, int nk,
                   int m0, int n0, const float* __restrict__ mu, const u16* __restrict__ SH, char* smem) {
  const int tid = threadIdx.x, lane = tid & 63, wid = tid >> 6, wr = wid >> 1, wc = wid & 1, fr = lane & 15, fq = lane >> 4;
  const int lrow = tid >> 3, lch = tid & 7;
#pragma unroll
  for (int i = 0; i < 4; ++i)
#pragma unroll
    for (int j = 0; j < 4; ++j) acc[i][j] = (f32x4){0.f, 0.f, 0.f, 0.f};

  const u16* pa0; const u16* pa1; const u16* pa2; const u16* pa3;
  const u16* pp0 = nullptr;
  const int arow = 4 * lrow;
  {
    int m = m0 + arow;
    pa0 = A + (size_t)m * lda + lch * 8;
    pa1 = pa0 + lda; pa2 = pa1 + lda; pa3 = pa2 + lda;
    if (AMODE != 0) pp0 = seq_start(m) ? SH + seq_of(m) * 1024 + lch * 8 : pa0 - lda;
  }
  const u16* pb0 = Bt + (size_t)(n0 + lrow) * ldb + lch * 8;
  const u16* pb1 = pb0 + (size_t)64 * ldb;
  const int woffB = lrow * 128 + ((lch ^ ((lrow >> 1) & 7)) << 4);
  const int woffA0 = (arow + 0) * 128 + ((lch ^ (((arow + 0) >> 1) & 7)) << 4);
  const int woffA1 = (arow + 1) * 128 + ((lch ^ (((arow + 1) >> 1) & 7)) << 4);
  const int woffA2 = (arow + 2) * 128 + ((lch ^ (((arow + 2) >> 1) & 7)) << 4);
  const int woffA3 = (arow + 3) * 128 + ((lch ^ (((arow + 3) >> 1) & 7)) << 4);

  uint4 ra0, ra1, ra2, ra3, rp0, rb0, rb1;
  float4 mu0, mu1;
  rp0 = make_uint4(0, 0, 0, 0);
  mu0 = mu1 = make_float4(0, 0, 0, 0);

#define G_LOAD(kt)                                                                     \
  {                                                                                    \
    const int k0_ = (kt) * 64;                                                         \
    if (AMODE == 0) {                                                                  \
      ra0 = *(const uint4*)(pa0 + k0_); ra1 = *(const uint4*)(pa1 + k0_);              \
      ra2 = *(const uint4*)(pa2 + k0_); ra3 = *(const uint4*)(pa3 + k0_);              \
    } else if (AMODE == 1) {                                                           \
      ra0 = *(const uint4*)(pa0 + k0_); ra1 = *(const uint4*)(pa1 + k0_);              \
      ra2 = *(const uint4*)(pa2 + k0_); ra3 = *(const uint4*)(pa3 + k0_);              \
      rp0 = *(const uint4*)(pp0 + k0_);                                                \
      mu0 = *(const float4*)(mu + k0_ + lch * 8); mu1 = *(const float4*)(mu + k0_ + lch * 8 + 4); \
    } else {                                                                           \
      const int kk_ = k0_ & 1023;                                                      \
      ra0 = *(const uint4*)(pa0 + kk_); ra1 = *(const uint4*)(pa1 + kk_);              \
      ra2 = *(const uint4*)(pa2 + kk_); ra3 = *(const uint4*)(pa3 + kk_);              \
      if (k0_ >= 1024) rp0 = *(const uint4*)(pp0 + kk_);                               \
    }                                                                                  \
    rb0 = *(const uint4*)(pb0 + k0_); rb1 = *(const uint4*)(pb1 + k0_);                \
  }

#define G_XFORM(dst, a_, p_, kt)                                                       \
  {                                                                                    \
    if (AMODE == 0) dst = a_;                                                          \
    else if (AMODE == 1) {                                                             \
      float h_[8], q_[8]; unpack8(a_, h_); unpack8(p_, q_);                            \
      dst.x = pack2(h_[0] + mu0.x * (q_[0] - h_[0]), h_[1] + mu0.y * (q_[1] - h_[1])); \
      dst.y = pack2(h_[2] + mu0.z * (q_[2] - h_[2]), h_[3] + mu0.w * (q_[3] - h_[3])); \
      dst.z = pack2(h_[4] + mu1.x * (q_[4] - h_[4]), h_[5] + mu1.y * (q_[5] - h_[5])); \
      dst.w = pack2(h_[6] + mu1.z * (q_[6] - h_[6]), h_[7] + mu1.w * (q_[7] - h_[7])); \
    } else {                                                                           \
      if ((kt) * 64 >= 1024) {                                                         \
        float h_[8], q_[8]; unpack8(a_, h_); unpack8(p_, q_);                          \
        dst.x = pack2(q_[0] - h_[0], q_[1] - h_[1]); dst.y = pack2(q_[2] - h_[2], q_[3] - h_[3]); \
        dst.z = pack2(q_[4] - h_[4], q_[5] - h_[5]); dst.w = pack2(q_[6] - h_[6], q_[7] - h_[7]); \
      } else dst = a_;                                                                 \
    }                                                                                  \
  }

#define G_STORE(stage, kt)                                                             \
  {                                                                                    \
    char* sA_ = smem + (stage) * GEMM_STAGE_BYTES; char* sB_ = sA_ + 32768;            \
    uint4 v_;                                                                          \
    G_XFORM(v_, ra0, rp0, kt); *(uint4*)(sA_ + woffA0) = v_;                           \
    G_XFORM(v_, ra1, ra0, kt); *(uint4*)(sA_ + woffA1) = v_;                           \
    G_XFORM(v_, ra2, ra1, kt); *(uint4*)(sA_ + woffA2) = v_;                           \
    G_XFORM(v_, ra3, ra2, kt); *(uint4*)(sA_ + woffA3) = v_;                           \
    *(uint4*)(sB_ + woffB) = rb0; *(uint4*)(sB_ + woffB + 64 * 128) = rb1;             \
  }

  G_LOAD(0);
  G_STORE(0, 0);
  __syncthreads();
  const int rsw = (fr >> 1) & 7;
  for (int kt = 0; kt < nk; ++kt) {
    const int st = kt & 1;
    if (kt + 1 < nk) G_LOAD(kt + 1);
    __builtin_amdgcn_sched_barrier(0);
    {
      const char* sA = smem + st * GEMM_STAGE_BYTES;
      const char* sB = sA + 32768;
#pragma unroll
      for (int kk = 0; kk < 2; ++kk) {
        bf16x8 af[4], bfr[4];
        const int cho = ((kk * 4 + fq) ^ rsw) << 4;
#pragma unroll
        for (int i = 0; i < 4; ++i) af[i] = *(const bf16x8*)(sA + (wr * 64 + i * 16 + fr) * 128 + cho);
#pragma unroll
        for (int j = 0; j < 4; ++j) bfr[j] = *(const bf16x8*)(sB + (wc * 64 + j * 16 + fr) * 128 + cho);
#pragma unroll
        for (int i = 0; i < 4; ++i)
#pragma unroll
          for (int j = 0; j < 4; ++j) acc[i][j] = __builtin_amdgcn_mfma_f32_16x16x32_bf16(bfr[j], af[i], acc[i][j], 0, 0, 0);
      }
    }
    if (kt + 1 < nk) G_STORE(st ^ 1, kt + 1);
    __syncthreads();
  }
#undef G_LOAD
#undef G_XFORM
#undef G_STORE
}


#define G2_STAGE_BYTES 32768
#define G2_MU_OFF (3 * G2_STAGE_BYTES)
DEV int g2_swz(int row) { return (0x78 >> (2 * ((row >> 2) & 3))) & 3; }
template <int AMODE>
DEV void gemm_main256(f32x4 (&acc)[8][4], const u16* __restrict__ A, int lda, const u16* __restrict__ Bt, int ldb, int nk64,
                      int m0, int n0, const float* __restrict__ mu, const u16* __restrict__ SH, char* smem) {
  const int tid = threadIdx.x, lane = tid & 63, wid = tid >> 6, wr = wid >> 2, wc = wid & 3, fr = lane & 15, fq = lane >> 4;
  const int nk = nk64 * 2;
  const int lrow2 = 2 * (tid >> 2), lch = tid & 3;
#pragma unroll
  for (int i = 0; i < 8; ++i)
#pragma unroll
    for (int j = 0; j < 4; ++j) acc[i][j] = (f32x4){0.f, 0.f, 0.f, 0.f};
  const u16* pa0 = A + (size_t)(m0 + lrow2) * lda + lch * 8;
  const u16* pp0 = nullptr;
  if (AMODE != 0) pp0 = seq_start(m0 + lrow2) ? SH + seq_of(m0 + lrow2) * 1024 + lch * 8 : pa0 - lda;
  const u16* pb0 = Bt + (size_t)(n0 + lrow2) * ldb + lch * 8;
  const int woff0 = (lrow2 + 0) * 64 + ((lch ^ g2_swz(lrow2 + 0)) << 4);
  const int woff1 = (lrow2 + 1) * 64 + ((lch ^ g2_swz(lrow2 + 1)) << 4);
  const float* muL = (const float*)(smem + G2_MU_OFF);
  if (AMODE == 1) {
    if (tid < 256) *(float4*)(smem + G2_MU_OFF + tid * 16) = *(const float4*)(mu + tid * 4);
  }
  uint4 xa0, xa1, xp, xb0, xb1;
  uint4 ya0, ya1, yp, yb0, yb1;
  xp = yp = make_uint4(0, 0, 0, 0);

#define K_LOAD(S, kt)                                                                  \
  {                                                                                    \
    const int k0_ = (kt) * 32;                                                         \
    S##a0 = *(const uint4*)(pa0 + k0_); S##a1 = *(const uint4*)(pa0 + lda + k0_);      \
    if (AMODE == 1) S##p = *(const uint4*)(pp0 + k0_);                                 \
    S##b0 = *(const uint4*)(pb0 + k0_); S##b1 = *(const uint4*)(pb0 + ldb + k0_);      \
  }
#define K_XFORM(dst, a_, p_)                                                           \
  {                                                                                    \
    if (AMODE == 0) dst = a_;                                                          \
    else {                                                                             \
      float h_[8], q_[8]; unpack8(a_, h_); unpack8(p_, q_);                            \
      dst.x = pack2(h_[0] + mu0.x * (q_[0] - h_[0]), h_[1] + mu0.y * (q_[1] - h_[1])); \
      dst.y = pack2(h_[2] + mu0.z * (q_[2] - h_[2]), h_[3] + mu0.w * (q_[3] - h_[3])); \
      dst.z = pack2(h_[4] + mu1.x * (q_[4] - h_[4]), h_[5] + mu1.y * (q_[5] - h_[5])); \
      dst.w = pack2(h_[6] + mu1.z * (q_[6] - h_[6]), h_[7] + mu1.w * (q_[7] - h_[7])); \
    }                                                                                  \
  }
#define K_STORE(S, stage, kt)                                                          \
  {                                                                                    \
    char* sA_ = smem + (stage) * G2_STAGE_BYTES; char* sB_ = sA_ + 16384;              \
    uint4 v_; float4 mu0, mu1;                                                         \
    if (AMODE == 1) { mu0 = *(const float4*)(muL + (kt) * 32 + lch * 8); mu1 = *(const float4*)(muL + (kt) * 32 + lch * 8 + 4); } \
    K_XFORM(v_, S##a0, S##p); *(uint4*)(sA_ + woff0) = v_;                             \
    K_XFORM(v_, S##a1, S##a0); *(uint4*)(sA_ + woff1) = v_;                            \
    *(uint4*)(sB_ + woff0) = S##b0; *(uint4*)(sB_ + woff1) = S##b1;                    \
  }
#define K_COMPUTE_HALF(stage, i0)                                                      \
  {                                                                                    \
    const char* sA_ = smem + (stage) * G2_STAGE_BYTES;                                 \
    _Pragma("unroll") for (int i = (i0); i < (i0) + 4; ++i) {                          \
      const bf16x8 af = *(const bf16x8*)(sA_ + (wr * 128 + i * 16 + fr) * 64 + cho);   \
      _Pragma("unroll") for (int j = 0; j < 4; ++j) acc[i][j] = __builtin_amdgcn_mfma_f32_16x16x32_bf16(bfr[j], af, acc[i][j], 0, 0, 0); \
    }                                                                                  \
  }
#define K_LOAD_B(stage)                                                                \
  {                                                                                    \
    const char* sB_ = smem + (stage) * G2_STAGE_BYTES + 16384;                         \
    _Pragma("unroll") for (int j = 0; j < 4; ++j) bfr[j] = *(const bf16x8*)(sB_ + (wc * 64 + j * 16 + fr) * 64 + cho); \
  }
#define K_ITER(kt, L, S)                                                               \
  {                                                                                    \
    K_LOAD(L, min((kt) + 2, nk - 1));                                                  \
    __builtin_amdgcn_sched_barrier(0);                                                 \
    bf16x8 bfr[4];                                                                     \
    K_LOAD_B(cu);                                                                      \
    K_COMPUTE_HALF(cu, 0);                                                             \
    __builtin_amdgcn_sched_barrier(0);                                                 \
    K_STORE(S, nx, min((kt) + 1, nk - 1));                                             \
    __builtin_amdgcn_sched_barrier(0);                                                 \
    if (AMODE == 1) K_LOAD_B(cu);                                                      \
    K_COMPUTE_HALF(cu, 4);                                                             \
    __syncthreads();                                                                   \
    cu = nx; nx = (nx == 2) ? 0 : nx + 1;                                              \
  }
  const int cho = (fq ^ g2_swz(fr)) << 4;
  if (AMODE == 1) __syncthreads();
  K_LOAD(x, 0);
  K_LOAD(y, 1);
  K_STORE(x, 0, 0);
  __syncthreads();
  int cu = 0, nx = 1;
  for (int kt = 0; kt < nk; kt += 2) {
    K_ITER(kt, x, y);
    K_ITER(kt + 1, y, x);
  }
#undef K_LOAD
#undef K_XFORM
#undef K_STORE
#undef K_COMPUTE_HALF
#undef K_LOAD_B
#undef K_ITER
}


#define GD_NST 4
DEV void gemm_main256_dma(f32x4 (&acc)[8][4], const u16* __restrict__ A, int lda, const u16* __restrict__ Bt, int ldb, int nk64,
                          int m0, int n0, char* smem) {
  const int tid = threadIdx.x, lane = tid & 63, wid = tid >> 6, wr = wid >> 2, wc = wid & 3, fr = lane & 15, fq = lane >> 4;
  const int nk = nk64 * 2;
#pragma unroll
  for (int i = 0; i < 8; ++i)
#pragma unroll
    for (int j = 0; j < 4; ++j) acc[i][j] = (f32x4){0.f, 0.f, 0.f, 0.f};
  const int prow = 16 * wid + (lane >> 2);
  const int pch = (lane & 3) ^ g2_swz(prow);
  const u16* srcA = A + (size_t)(m0 + prow) * lda + pch * 8;
  const u16* srcB = Bt + (size_t)(n0 + prow) * ldb + pch * 8;
  const size_t a128 = (size_t)128 * lda, b128 = (size_t)128 * ldb;
  char* ldsw = smem + (16 * wid) * 64;
#define D_FILL(kt, stage)                                                              \
  {                                                                                    \
    const int k0_ = (kt) * 32;                                                         \
    char* d_ = ldsw + (stage) * G2_STAGE_BYTES;                                        \
    __builtin_amdgcn_global_load_lds((const unsigned*)(srcA + k0_), (unsigned*)(d_), 16, 0, 0);               \
    __builtin_amdgcn_global_load_lds((const unsigned*)(srcA + a128 + k0_), (unsigned*)(d_ + 8192), 16, 0, 0); \
    __builtin_amdgcn_global_load_lds((const unsigned*)(srcB + k0_), (unsigned*)(d_ + 16384), 16, 0, 0);       \
    __builtin_amdgcn_global_load_lds((const unsigned*)(srcB + b128 + k0_), (unsigned*)(d_ + 16384 + 8192), 16, 0, 0); \
  }
  const int cho = (fq ^ g2_swz(fr)) << 4;
  __syncthreads();
  D_FILL(0, 0);
  D_FILL(min(1, nk - 1), 1);
  D_FILL(min(2, nk - 1), 2);
  int cu = 0, fill = 3;
  for (int kt = 0; kt < nk; ++kt) {
    asm volatile("s_waitcnt vmcnt(8)" ::: "memory");
    asm volatile("s_waitcnt lgkmcnt(0)" ::: "memory");
    __builtin_amdgcn_s_barrier();
    D_FILL(min(kt + 3, nk - 1), fill);
    {
      const char* sA_ = smem + cu * G2_STAGE_BYTES;
      const char* sB_ = sA_ + 16384;
      bf16x8 bfr[4];
#pragma unroll
      for (int j = 0; j < 4; ++j) bfr[j] = *(const bf16x8*)(sB_ + (wc * 64 + j * 16 + fr) * 64 + cho);
#pragma unroll
      for (int i = 0; i < 8; ++i) {
        const bf16x8 af = *(const bf16x8*)(sA_ + (wr * 128 + i * 16 + fr) * 64 + cho);
#pragma unroll
        for (int j = 0; j < 4; ++j) acc[i][j] = __builtin_amdgcn_mfma_f32_16x16x32_bf16(bfr[j], af, acc[i][j], 0, 0, 0);
      }
    }
    cu = (cu == GD_NST - 1) ? 0 : cu + 1;
    fill = (fill == GD_NST - 1) ? 0 : fill + 1;
  }
  asm volatile("s_waitcnt vmcnt(0)" ::: "memory");
  asm volatile("s_waitcnt lgkmcnt(0)" ::: "memory");
  __builtin_amdgcn_s_barrier();
#undef D_FILL
}

DEV void transpose_tile(const float* __restrict__ src, int N, int k0, int n0, const float* __restrict__ scale, u16* __restrict__ dst,
                        int dstride, int drow0, int dcol0, char* smem) {
  float* tile = (float*)smem;
  const int tid = threadIdx.x;
#pragma unroll
  for (int i = 0; i < 2; ++i) {
    int kl = (tid >> 4) + 32 * i, n4 = (tid & 15) * 4;
    float4 v = *(const float4*)(src + (size_t)(k0 + kl) * N + n0 + n4);
    float s = scale ? scale[k0 + kl] : 1.0f;
    tile[kl * 65 + n4 + 0] = v.x * s; tile[kl * 65 + n4 + 1] = v.y * s;
    tile[kl * 65 + n4 + 2] = v.z * s; tile[kl * 65 + n4 + 3] = v.w * s;
  }
  __syncthreads();
  {
    int nl = tid >> 3, k8 = (tid & 7) * 8;
    uint4 o;
    o.x = pack2(tile[(k8 + 0) * 65 + nl], tile[(k8 + 1) * 65 + nl]);
    o.y = pack2(tile[(k8 + 2) * 65 + nl], tile[(k8 + 3) * 65 + nl]);
    o.z = pack2(tile[(k8 + 4) * 65 + nl], tile[(k8 + 5) * 65 + nl]);
    o.w = pack2(tile[(k8 + 6) * 65 + nl], tile[(k8 + 7) * 65 + nl]);
    *(uint4*)(dst + (size_t)(drow0 + n0 + nl) * dstride + dcol0 + k0 + k8) = o;
  }
  __syncthreads();
}

DEV void transpose_tile_wide(const float* __restrict__ src, int N, int k0, int n0, u16* __restrict__ dst, int dstride, char* smem) {
  float* tile = (float*)smem;
  const int tid = threadIdx.x;
#pragma unroll
  for (int i = 0; i < 8; ++i) {
    const int e = tid + 512 * i, kl = e >> 6, n4 = (e & 63) * 4;
    const float4 v = *(const float4*)(src + (size_t)(k0 + kl) * N + n0 + n4);
    float* t = tile + kl * 257 + n4;
    t[0] = v.x; t[1] = v.y; t[2] = v.z; t[3] = v.w;
  }
  __syncthreads();
#pragma unroll
  for (int i = 0; i < 4; ++i) {
    const int c = tid + 512 * i, nl = c >> 3, k8 = (c & 7) * 8;
    uint4 o;
    o.x = pack2(tile[(k8 + 0) * 257 + nl], tile[(k8 + 1) * 257 + nl]);
    o.y = pack2(tile[(k8 + 2) * 257 + nl], tile[(k8 + 3) * 257 + nl]);
    o.z = pack2(tile[(k8 + 4) * 257 + nl], tile[(k8 + 5) * 257 + nl]);
    o.w = pack2(tile[(k8 + 6) * 257 + nl], tile[(k8 + 7) * 257 + nl]);
    *(uint4*)(dst + (size_t)(n0 + nl) * dstride + k0 + k8) = o;
  }
  __syncthreads();
}

DEV void phase_prep(const Params& p, char* smem) {
  const int tid = threadIdx.x;
  char* ws = p.ws;
  if (blockIdx.x < 96) {
    float* cL = (float*)smem;
    float* red = (float*)(smem + 98304);
    for (int e = tid; e < 24 * 256; e += NTHREADS) {
      int s = e >> 8, k4 = (e & 255) * 4;
      float4 v = s < 8 ? *(const float4*)(p.in[I_CP] + s * 1024 + k4) : *(const float4*)(p.in[I_CS] + (s - 8) * 1024 + k4);
      *(float4*)(cL + s * 1024 + k4) = v;
    }
    __syncthreads();
    for (int item = blockIdx.x; item < 96; item += gridDim.x) {
      const int l = item / 48, j0 = (item % 48) * 64;
      const float* W = (l == 0 ? p.in[I_AADAW] : p.in[I_BADAW]);
      const float* bias = (l == 0 ? p.in[I_AADAB] : p.in[I_BADAB]);
      const int col = tid & 63, kg = tid >> 6;
      float acc[24];
#pragma unroll
      for (int s = 0; s < 24; ++s) acc[s] = 0.f;
      for (int k = kg * 128; k < kg * 128 + 128; ++k) {
        float w = W[(size_t)k * 3072 + j0 + col];
#pragma unroll
        for (int s = 0; s < 24; ++s) acc[s] += cL[s * 1024 + k] * w;
      }
#pragma unroll
      for (int s = 0; s < 24; ++s) red[(kg * 24 + s) * 64 + col] = acc[s];
      __syncthreads();
      float* mod = (float*)(ws + WS_MOD);
      for (int e = tid; e < 24 * 64; e += NTHREADS) {
        int s = e >> 6, c = e & 63;
        float t = bias[j0 + c];
#pragma unroll
        for (int g = 0; g < 8; ++g) t += red[(g * 24 + s) * 64 + c];
        mod[(size_t)(l * 24 + s) * 3072 + j0 + c] = t;
      }
      __syncthreads();
    }
  }
  if (blockIdx.x == 0) for (int e = tid; e < 1024; e += NTHREADS) ((unsigned*)(ws + WS_CTR))[e] = 0u;
  if (blockIdx.x == gridDim.x - 1) {
    u16* SH = (u16*)(ws + WS_SH);
    for (int e = tid; e < 24 * 1024; e += NTHREADS) {
      int s = e >> 10, k = e & 1023;
      float v = s < 8 ? 0.f : p.in[I_SSH][(s - 8) * 1024 + k];
      SH[e] = (u16)(pack2(v, 0.f) & 0xffff);
    }
  }
  const int NW = 512 + 128 + 256 + 256 + 128 + 8 + 8;
  for (int t = blockIdx.x; t < NW + 64; t += gridDim.x) {
    if (t < NW) {
      const float* src; int K, N; u16* dst; int dstride; int tt = t;
      if (tt < 512) { src = p.in[I_AWIN]; K = 1024; N = 8192; dst = (u16*)(ws + WS_WT_IN); dstride = 1024; }
      else if ((tt -= 512) < 128) { src = p.in[I_AWOUT]; K = 2048; N = 1024; dst = (u16*)(ws + WS_WT_OUTA); dstride = 2048; }
      else if ((tt -= 128) < 256) { src = p.in[I_KVW]; K = 1024; N = 4096; dst = (u16*)(ws + WS_WT_KV); dstride = 1024; }
      else if ((tt -= 256) < 256) { src = p.in[I_BWIN]; K = 1024; N = 4096; dst = (u16*)(ws + WS_WT_INB); dstride = 1024; }
      else if ((tt -= 256) < 128) { src = p.in[I_BWOUT]; K = 2048; N = 1024; dst = (u16*)(ws + WS_WT_OUTB); dstride = 2048; }
      else if ((tt -= 128) < 8) { src = p.in[I_AW2]; K = 64; N = 2048; dst = (u16*)(ws + WS_W2T); dstride = 64; }
      else { tt -= 8; src = p.in[I_AA2]; K = 64; N = 2048; dst = (u16*)(ws + WS_A2T); dstride = 64; }
      const int ntn = N / 256;
      (void)K;
      transpose_tile_wide(src, N, (tt / ntn) * 64, (tt % ntn) * 256, dst, dstride, smem);
    } else {
      int tt = t - NW;
      const int job = tt >> 4; tt &= 15;
      const float* src = (job < 2) ? p.in[I_AW1] : p.in[I_AA1];
      const float* scale = nullptr; int dcol0 = 0;
      if (job & 1) { dcol0 = 1024; scale = (job < 2) ? p.in[I_AMUW] : p.in[I_AMUA]; }
      transpose_tile(src, 64, tt * 64, 0, scale, (u16*)(ws + WS_L1T), 2048, (job < 2) ? 0 : 64, dcol0, smem);
    }
  }
}

DEV void phase_norm0(const Params& p) {
  const int lane = threadIdx.x & 63, wid = threadIdx.x >> 6;
  const float* mod = (const float*)(p.ws + WS_MOD);
  u16* H0 = (u16*)(p.ws + WS_H0);
  const float* g = p.in[I_ANG];
  for (int t = blockIdx.x * 8 + wid; t < NTOK; t += gridDim.x * 8) {
    const float* x = t < TP ? p.in[I_XP] + (size_t)t * 1024 : p.in[I_XS] + (size_t)(t - TP) * 1024;
    const int s = seq_of(t);
    const float* md = mod + (size_t)s * 3072;
    float4 v[4];
    float ss = 0.f;
#pragma unroll
    for (int i = 0; i < 4; ++i) {
      v[i] = *(const float4*)(x + lane * 4 + 256 * i);
      ss += v[i].x * v[i].x + v[i].y * v[i].y + v[i].z * v[i].z + v[i].w * v[i].w;
    }
    ss = wave_sum(ss);
    const float rstd = rsqrtf(ss * (1.0f / 1024.0f) + 1e-6f);
    bool last = t < TP ? ((t & 4095) == 4095) : (((t - TP) & 31) == 31);
    float* so = t < TP ? p.out + OFF_SH_P + (t >> 12) * 1024 : p.out + OFF_SH_S + ((t - TP) >> 5) * 1024;
#pragma unroll
    for (int i = 0; i < 4; ++i) {
      const int c = lane * 4 + 256 * i;
      float4 gg = *(const float4*)(g + c), sh = *(const float4*)(md + c), sc = *(const float4*)(md + 1024 + c);
      float4 h;
      h.x = v[i].x * rstd * gg.x * (1.f + sc.x) + sh.x;
      h.y = v[i].y * rstd * gg.y * (1.f + sc.y) + sh.y;
      h.z = v[i].z * rstd * gg.z * (1.f + sc.z) + sh.z;
      h.w = v[i].w * rstd * gg.w * (1.f + sc.w) + sh.w;
      uint2 o; o.x = pack2(h.x, h.y); o.y = pack2(h.z, h.w);
      *(uint2*)(H0 + (size_t)t * 1024 + c) = o;
      if (last) *(float4*)(so + c) = h;
    }
  }
}

DEV void phase_proj0_lora(const Params& p, char* smem) {
  const int tid = threadIdx.x, lane = tid & 63, wid = tid >> 6, fr = lane & 15, fq = lane >> 4;
  const int wr = wid >> 1, wc = wid & 1;
  char* ws = p.ws;
  const u16* H0 = (const u16*)(ws + WS_H0);
  const u16* SH = (const u16*)(ws + WS_SH);
  u16* T = (u16*)(ws + WS_T);
  const int xcc0 = xcc_id();
  int nxt;
  f32x4 acc[4][4];
  for (int ls = 0; ls < 8; ++ls) {
  const int xcd = (xcc0 + ls) & 7;
  unsigned* ctr = sched_ctr(p, 0, xcd);
  for (int li = sched_first(ctr, smem); li < 17; li = sched_commit(nxt, smem)) {
    nxt = sched_prefetch(ctr);
    const int lmt = xcd + 8 * li;
    if (lmt >= 130) continue;
    const int m0 = lmt * 256;
    gemm_main<2>(acc, H0, 1024, (const u16*)(ws + WS_L1T), 2048, 32, m0, 0, nullptr, SH, smem);
#pragma unroll
    for (int i = 0; i < 4; ++i)
#pragma unroll
      for (int j = 0; j < 4; ++j) {
        const int m = m0 + wr * 64 + i * 16 + fr, n = wc * 64 + j * 16 + fq * 4;
        f32x4 v = acc[i][j];
        if (wc == 0) { v[0] = tanhf(v[0]); v[1] = tanhf(v[1]); v[2] = tanhf(v[2]); v[3] = tanhf(v[3]); }
        uint2 o; o.x = pack2(v[0], v[1]); o.y = pack2(v[2], v[3]);
        *(uint2*)(T + (size_t)m * 128 + n) = o;
      }
  }
  }
}

DEV void phase_proj0_main(const Params& p, char* smem) {
  const int tid = threadIdx.x, lane = tid & 63, wid = tid >> 6, fr = lane & 15, fq = lane >> 4;
  const int wr = wid >> 2, wc = wid & 3;
  char* ws = p.ws;
  const u16* H0 = (const u16*)(ws + WS_H0);
  const u16* SH = (const u16*)(ws + WS_SH);
  const int xcc0 = xcc_id();
  int nxt;
  f32x4 acc[8][4];
  for (int ls = 0; ls < 8; ++ls) {
  const int xcd = (xcc0 + ls) & 7;
  unsigned* ctr = sched_ctr(p, 4, xcd);
  for (int q = sched_first(ctr, smem); q < 520; q = sched_commit(nxt, smem)) {
    nxt = sched_prefetch(ctr);
    const int mt = q >> 2, nt = 4 * xcd + (q & 3);
    const int part = nt >> 3;
    const int m0 = mt * 256, n0 = nt * 256;
    gemm_main256<1>(acc, H0, 1024, (const u16*)(ws + WS_WT_IN), 1024, 16, m0, n0, p.in[I_AMUIN] + part * 1024, SH, smem);
    u16* dst = (u16*)(ws + (size_t)part * SLOT);
    const int nb = n0 - part * 2048;
#pragma unroll
    for (int i = 0; i < 8; ++i)
#pragma unroll
      for (int j = 0; j < 4; ++j) {
        const int row = wr * 128 + i * 16 + fr, col = wc * 64 + j * 16 + fq * 4;
        f32x4 v = acc[i][j];
        uint2 o; o.x = pack2(v[0], v[1]); o.y = pack2(v[2], v[3]);
        *(uint2*)(smem + row * 528 + col * 2) = o;
      }
    __syncthreads();
#pragma unroll
    for (int qq = 0; qq < 16; ++qq) {
      const int c = tid + 512 * qq, row = c >> 5, ch = c & 31;
      const uint4 v = *(const uint4*)(smem + row * 528 + ch * 16);
      *(uint4*)(dst + (size_t)(m0 + row) * 2048 + nb + ch * 8) = v;
    }
    __syncthreads();
  }
  }
}

DEV void phase_proj0(const Params& p, char* smem) {
  phase_proj0_lora(p, smem);
  phase_proj0_main(p, smem);
}

DEV void phase_scan(const Params& p, char* smem) {
  const int tid = threadIdx.x, lane = tid & 63, wid = tid >> 6;
  u16* Hkk = (u16*)smem;
  u16* Hw = Hkk + 4096;
  u16* Hb = Hw + 4096;
  u16* Hk = Hb + 4096;
  u16* Hwr = Hk + 4096;
  unsigned* Hv2 = (unsigned*)(smem + 40960);
  float* LY = (float*)(smem + 57344);
  float* Lbon = LY + 8192;
  float* Lsc = Lbon + 64;
  float* Lwa = Lsc + 128;
  char* ws = p.ws;
  const u16* gR = (const u16*)(ws + 0 * SLOT);
  const u16* gK = (const u16*)(ws + 1 * SLOT);
  const u16* gV = (const u16*)(ws + 2 * SLOT);
  const u16* gZ = (const u16*)(ws + 3 * SLOT);
  const u16* gT = (const u16*)(ws + WS_T);
  const u16* W2T = (const u16*)(ws + WS_W2T);
  const u16* A2T = (const u16*)(ws + WS_A2T);
  const int fr = lane & 15, fq = lane >> 4, lmt = wid & 3, lnh = wid >> 2;
  u16* YG = (u16*)(ws + 6 * SLOT);
  const int tt = tid >> 3, c8 = (tid & 7) * 8;
  const int srow = tid >> 3, kc = tid & 7;

  for (int item = blockIdx.x; item < 768; item += gridDim.x) {
    int h, tok0, nsteps; const float* sinit; float* sout;
    if (item < 256) { h = item & 31; tok0 = (item >> 5) * 4096; nsteps = 4096; sinit = nullptr; sout = p.out + OFF_WKV_P + (size_t)item * 4096; }
    else { int it = item - 256; h = it & 31; tok0 = TP + (it >> 5) * 32; nsteps = 32; sinit = p.in[I_SWKV] + (size_t)it * 4096; sout = p.out + OFF_WKV_S + (size_t)it * 4096; }
    const int nch = (nsteps + 63) >> 6;
    const int col0 = h * 64 + c8;
    float ckk[8], cka[8], crk[8], clg[8], clb[8];
    {
      float4 t0, t1;
      t0 = *(const float4*)(p.in[I_AKK] + col0); t1 = *(const float4*)(p.in[I_AKK] + col0 + 4);
      ckk[0] = t0.x; ckk[1] = t0.y; ckk[2] = t0.z; ckk[3] = t0.w; ckk[4] = t1.x; ckk[5] = t1.y; ckk[6] = t1.z; ckk[7] = t1.w;
      t0 = *(const float4*)(p.in[I_AKA] + col0); t1 = *(const float4*)(p.in[I_AKA] + col0 + 4);
      cka[0] = t0.x; cka[1] = t0.y; cka[2] = t0.z; cka[3] = t0.w; cka[4] = t1.x; cka[5] = t1.y; cka[6] = t1.z; cka[7] = t1.w;
      t0 = *(const float4*)(p.in[I_ARK] + col0); t1 = *(const float4*)(p.in[I_ARK] + col0 + 4);
      crk[0] = t0.x; crk[1] = t0.y; crk[2] = t0.z; crk[3] = t0.w; crk[4] = t1.x; crk[5] = t1.y; crk[6] = t1.z; crk[7] = t1.w;
      t0 = *(const float4*)(p.in[I_ALNG] + col0); t1 = *(const float4*)(p.in[I_ALNG] + col0 + 4);
      clg[0] = t0.x; clg[1] = t0.y; clg[2] = t0.z; clg[3] = t0.w; clg[4] = t1.x; clg[5] = t1.y; clg[6] = t1.z; clg[7] = t1.w;
      t0 = *(const float4*)(p.in[I_ALNB] + col0); t1 = *(const float4*)(p.in[I_ALNB] + col0 + 4);
      clb[0] = t0.x; clb[1] = t0.y; clb[2] = t0.z; clb[3] = t0.w; clb[4] = t1.x; clb[5] = t1.y; clb[6] = t1.z; clb[7] = t1.w;
    }
    float cw0[8], ca0[8];
    {
      float4 t0 = *(const float4*)(p.in[I_AW0] + col0), t1 = *(const float4*)(p.in[I_AW0] + col0 + 4);
      cw0[0] = t0.x; cw0[1] = t0.y; cw0[2] = t0.z; cw0[3] = t0.w; cw0[4] = t1.x; cw0[5] = t1.y; cw0[6] = t1.z; cw0[7] = t1.w;
      t0 = *(const float4*)(p.in[I_AA0] + col0); t1 = *(const float4*)(p.in[I_AA0] + col0 + 4);
      ca0[0] = t0.x; ca0[1] = t0.y; ca0[2] = t0.z; ca0[3] = t0.w; ca0[4] = t1.x; ca0[5] = t1.y; ca0[6] = t1.z; ca0[7] = t1.w;
    }
    bf16x8 w2f[2][2], a2f[2][2];
#pragma unroll
    for (int n2 = 0; n2 < 2; ++n2)
#pragma unroll
      for (int ks = 0; ks < 2; ++ks) {
        const size_t o_ = (size_t)(h * 64 + lnh * 32 + n2 * 16 + fr) * 64 + ks * 32 + fq * 8;
        w2f[n2][ks] = *(const bf16x8*)(W2T + o_);
        a2f[n2][ks] = *(const bf16x8*)(A2T + o_);
      }
    h2_t sa_, sb_, sc_, sd_;
    if (sinit) {
      float4 a = *(const float4*)(sinit + srow * 64 + kc * 8), b = *(const float4*)(sinit + srow * 64 + kc * 8 + 4);
      sa_ = (h2_t){(_Float16)a.x, (_Float16)a.y}; sb_ = (h2_t){(_Float16)a.z, (_Float16)a.w};
      sc_ = (h2_t){(_Float16)b.x, (_Float16)b.y}; sd_ = (h2_t){(_Float16)b.z, (_Float16)b.w};
    } else {
      sa_ = sb_ = sc_ = sd_ = (h2_t){(_Float16)0.f, (_Float16)0.f};
    }
    uint4 cr, ck, cv, cz;
    bf16x8 t1f[2], t2f[2];
#define SCAN_LOAD(c)                                                                   \
    {                                                                                  \
      const int tl_ = (c) * 64 + tt;                                                   \
      if (tl_ < nsteps) {                                                              \
        const size_t o_ = (size_t)(tok0 + tl_) * 2048 + col0;                          \
        cr = *(const uint4*)(gR + o_); ck = *(const uint4*)(gK + o_); cv = *(const uint4*)(gV + o_); \
        cz = *(const uint4*)(gZ + o_);                                                 \
      } else { cr = ck = cv = cz = make_uint4(0, 0, 0, 0); }                           \
      const int tm_ = (c) * 64 + lmt * 16 + fr;                                        \
      if (tm_ < nsteps) {                                                              \
        const u16* tp_ = gT + (size_t)(tok0 + tm_) * 128 + fq * 8;                     \
        t1f[0] = *(const bf16x8*)(tp_); t1f[1] = *(const bf16x8*)(tp_ + 32);           \
        t2f[0] = *(const bf16x8*)(tp_ + 64); t2f[1] = *(const bf16x8*)(tp_ + 96);      \
      } else { t1f[0] = t1f[1] = t2f[0] = t2f[1] = (bf16x8){0, 0, 0, 0, 0, 0, 0, 0}; } \
    }
    SCAN_LOAD(0);
    for (int c = 0; c < nch; ++c) {
      {
#pragma unroll
        for (int n2 = 0; n2 < 2; ++n2) {
          f32x4 xw = {0.f, 0.f, 0.f, 0.f}, xa = {0.f, 0.f, 0.f, 0.f};
          xw = __builtin_amdgcn_mfma_f32_16x16x32_bf16(w2f[n2][0], t1f[0], xw, 0, 0, 0);
          xw = __builtin_amdgcn_mfma_f32_16x16x32_bf16(w2f[n2][1], t1f[1], xw, 0, 0, 0);
          xa = __builtin_amdgcn_mfma_f32_16x16x32_bf16(a2f[n2][0], t2f[0], xa, 0, 0, 0);
          xa = __builtin_amdgcn_mfma_f32_16x16x32_bf16(a2f[n2][1], t2f[1], xa, 0, 0, 0);
          const int o_ = (lmt * 16 + fr) * 64 + lnh * 32 + n2 * 16 + fq * 4;
          *(float4*)(Lwa + o_) = make_float4(xw[0], xw[1], xw[2], xw[3]);
          *(float4*)(Lwa + 4096 + o_) = make_float4(xa[0], xa[1], xa[2], xa[3]);
        }
      }
      __syncthreads();
      uint4 zc = cz;
      {
        float r[8], k[8], v[8], lw[8], a[8];
        unpack8(cr, r); unpack8(ck, k); unpack8(cv, v);
        {
          const float4 x0 = *(const float4*)(Lwa + tt * 64 + c8), x1 = *(const float4*)(Lwa + tt * 64 + c8 + 4);
          const float4 y0 = *(const float4*)(Lwa + 4096 + tt * 64 + c8), y1 = *(const float4*)(Lwa + 4096 + tt * 64 + c8 + 4);
          const float xw_[8] = {x0.x, x0.y, x0.z, x0.w, x1.x, x1.y, x1.z, x1.w};
          const float xa_[8] = {y0.x, y0.y, y0.z, y0.w, y1.x, y1.y, y1.z, y1.w};
#pragma unroll
          for (int j = 0; j < 8; ++j) {
            lw[j] = -0.60653066f * sigmoidf_(cw0[j] + xw_[j]);
            a[j] = sigmoidf_(ca0[j] + xa_[j]);
          }
        }
        float kkv[8], kp[8], w[8], bon = 0.f, ss = 0.f, kr = 0.f;
#pragma unroll
        for (int j = 0; j < 8; ++j) {
          kkv[j] = k[j] * ckk[j]; ss += kkv[j] * kkv[j];
          kp[j] = k[j] * (1.f + (a[j] - 1.f) * cka[j]);
          bon += r[j] * kp[j] * crk[j];
          kr += r[j] * kp[j];
          w[j] = __expf(lw[j]);
        }
        ss = red8(ss); bon = red8(bon); kr = red8(kr);
        const float inv = rsqrtf(ss + 1e-12f);
        float bb[8], br = 0.f;
#pragma unroll
        for (int j = 0; j < 8; ++j) { kkv[j] *= inv; bb[j] = kkv[j] * a[j]; br += bb[j] * r[j]; }
        br = red8(br);
        const int ho = tt * 64 + c8;
        *(uint4*)(Hkk + ho) = make_uint4(packh2(kkv[0], kkv[1]), packh2(kkv[2], kkv[3]), packh2(kkv[4], kkv[5]), packh2(kkv[6], kkv[7]));
        *(uint4*)(Hb + ho) = make_uint4(packh2(bb[0], bb[1]), packh2(bb[2], bb[3]), packh2(bb[4], bb[5]), packh2(bb[6], bb[7]));
        *(uint4*)(Hw + ho) = make_uint4(packh2(w[0], w[1]), packh2(w[2], w[3]), packh2(w[4], w[5]), packh2(w[6], w[7]));
        *(uint4*)(Hk + ho) = make_uint4(packh2(kp[0], kp[1]), packh2(kp[2], kp[3]), packh2(kp[4], kp[5]), packh2(kp[6], kp[7]));
        *(uint4*)(Hwr + ho) = make_uint4(packh2(w[0] * r[0], w[1] * r[1]), packh2(w[2] * r[2], w[3] * r[3]), packh2(w[4] * r[4], w[5] * r[5]), packh2(w[6] * r[6], w[7] * r[7]));
        *(uint4*)(Hv2 + ho) = make_uint4(packh2(v[0], v[0]), packh2(v[1], v[1]), packh2(v[2], v[2]), packh2(v[3], v[3]));
        *(uint4*)(Hv2 + ho + 4) = make_uint4(packh2(v[4], v[4]), packh2(v[5], v[5]), packh2(v[6], v[6]), packh2(v[7], v[7]));
        if ((tid & 7) == 0) { Lbon[tt] = bon; *(float2*)(Lsc + tt * 2) = make_float2(br, kr); }
      }
      __syncthreads();
      if (c + 1 < nch) SCAN_LOAD(c + 1);
      {
        const int nT = min(64, nsteps - c * 64);
        const u16* pk = Hkk + kc * 8; const u16* pw = Hw + kc * 8; const u16* pb = Hb + kc * 8;
        const u16* pkp = Hk + kc * 8; const u16* pwr = Hwr + kc * 8; const unsigned* pv = Hv2 + srow;
        float* py = LY + srow * 2;
#define SCAN_LD(S, o)                                                                  \
        S##kk = *(const uint4*)(pk + (o)); S##w = *(const uint4*)(pw + (o)); S##b = *(const uint4*)(pb + (o)); \
        S##k = *(const uint4*)(pkp + (o)); S##wr = *(const uint4*)(pwr + (o)); S##v = pv[(o)];
#define H2(x) (*(const h2_t*)&(x))
#define SCAN_UPD(sreg, S, c)                                                           \
        sreg = __builtin_elementwise_fma(sreg, H2(S##w.c), __builtin_elementwise_fma(-n_, H2(S##b.c), H2(S##v) * H2(S##k.c)));
#define SCAN_STEP(S, o)                                                                \
        {                                                                              \
          float d = __builtin_amdgcn_fdot2(sa_, H2(S##kk.x), 0.f, false);              \
          float e = __builtin_amdgcn_fdot2(sa_, H2(S##wr.x), 0.f, false);              \
          d = __builtin_amdgcn_fdot2(sb_, H2(S##kk.y), d, false); e = __builtin_amdgcn_fdot2(sb_, H2(S##wr.y), e, false); \
          d = __builtin_amdgcn_fdot2(sc_, H2(S##kk.z), d, false); e = __builtin_amdgcn_fdot2(sc_, H2(S##wr.z), e, false); \
          d = __builtin_amdgcn_fdot2(sd_, H2(S##kk.w), d, false); e = __builtin_amdgcn_fdot2(sd_, H2(S##wr.w), e, false); \
          d += dppf<0xB1>(d); e += dppf<0xB1>(e);                                      \
          d += dppf<0x4E>(d); e += dppf<0x4E>(e);                                      \
          d += dppf<0x141>(d); e += dppf<0x141>(e);                                    \
          const unsigned nu_ = packh2(d, d);                                           \
          const h2_t n_ = H2(nu_);                                                     \
          SCAN_UPD(sa_, S, x) SCAN_UPD(sb_, S, y) SCAN_UPD(sc_, S, z) SCAN_UPD(sd_, S, w) \
          if (kc == 0) *(float2*)(py + 2 * (o)) = make_float2(e, d);                   \
        }
        uint4 Akk, Aw, Ab, Ak, Awr, Bkk, Bw, Bb, Bk, Bwr; unsigned Av, Bv;
        SCAN_LD(A, 0);
        for (int t = 0; t < nT; t += 2) {
          SCAN_LD(B, (t + 1) * 64);
          SCAN_STEP(A, t * 64);
          SCAN_LD(A, (t + 2) * 64);
          SCAN_STEP(B, (t + 1) * 64);
        }
#undef SCAN_UPD
#undef H2
#undef SCAN_LD
#undef SCAN_STEP
      }
      __syncthreads();
      {
        const int tl = c * 64 + tt;
        if (tl < nsteps) {
          float y[8], z[8];
          const float2 sc = *(const float2*)(Lsc + tt * 2);
          const uint4 va = *(const uint4*)(Hv2 + tt * 64 + c8), vb = *(const uint4*)(Hv2 + tt * 64 + c8 + 4);
          float vv[8];
          { const unsigned vu[8] = {va.x, va.y, va.z, va.w, vb.x, vb.y, vb.z, vb.w};
#pragma unroll
            for (int j = 0; j < 8; ++j) { h2_t t_ = *(const h2_t*)&vu[j]; vv[j] = (float)t_[0]; } }
#pragma unroll
          for (int q = 0; q < 4; ++q) {
            const float4 ed = *(const float4*)(LY + tt * 128 + (c8 + 2 * q) * 2);
            y[2 * q] = ed.x - ed.y * sc.x + vv[2 * q] * sc.y;
            y[2 * q + 1] = ed.z - ed.w * sc.x + vv[2 * q + 1] * sc.y;
          }
          float sm = y[0] + y[1] + y[2] + y[3] + y[4] + y[5] + y[6] + y[7];
          sm = red8(sm);
          const float mean = sm * (1.f / 64.f);
          float vs = 0.f;
#pragma unroll
          for (int j = 0; j < 8; ++j) { y[j] -= mean; vs += y[j] * y[j]; }
          vs = red8(vs);
          const float rstd = rsqrtf(vs * (1.f / 64.f) + 64e-5f);
          const float bon = Lbon[tt];
          unpack8(zc, z);
          float o[8];
#pragma unroll
          for (int j = 0; j < 8; ++j) {
            float t = y[j] * rstd * clg[j] + clb[j] + bon * vv[j];
            o[j] = t * z[j] * sigmoidf_(z[j]);
          }
          uint4 ov; ov.x = pack2(o[0], o[1]); ov.y = pack2(o[2], o[3]); ov.z = pack2(o[4], o[5]); ov.w = pack2(o[6], o[7]);
          *(uint4*)(YG + (size_t)(tok0 + tl) * 2048 + col0) = ov;
        }
      }
      __syncthreads();
    }
#undef SCAN_LOAD
    *(float4*)(sout + srow * 64 + kc * 8) = make_float4((float)sa_[0], (float)sa_[1], (float)sb_[0], (float)sb_[1]);
    *(float4*)(sout + srow * 64 + kc * 8 + 4) = make_float4((float)sc_[0], (float)sc_[1], (float)sd_[0], (float)sd_[1]);
  }
}

template <int LAYER>
DEV void outproj_store(const Params& p, const float* mod, float* xmid, int m, int n, f32x4 v) {
  const float* gate = mod + (size_t)seq_of(m) * 3072 + 2048;
  float4 g4 = *(const float4*)(gate + n);
  if (LAYER == 0) {
    const float* xr = m < TP ? p.in[I_XP] + (size_t)m * 1024 : p.in[I_XS] + (size_t)(m - TP) * 1024;
    float4 x4 = *(const float4*)(xr + n);
    *(float4*)(xmid + (size_t)m * 1024 + n) = make_float4(x4.x + g4.x * v[0], x4.y + g4.y * v[1], x4.z + g4.z * v[2], x4.w + g4.w * v[3]);
  } else {
    float4 x4 = *(const float4*)(xmid + (size_t)m * 1024 + n);
    float* yo = m < TP ? p.out + OFF_Y_P + (size_t)m * 1024 : p.out + OFF_Y_S + (size_t)(m - TP) * 1024;
    *(float4*)(yo + n) = make_float4(x4.x + g4.x * v[0], x4.y + g4.y * v[1], x4.z + g4.z * v[2], x4.w + g4.w * v[3]);
  }
}

template <int LAYER>
DEV void phase_outproj_main(const Params& p, char* smem) {
  const int tid = threadIdx.x, lane = tid & 63, wid = tid >> 6, wr = wid >> 2, wc = wid & 3, fr = lane & 15, fq = lane >> 4;
  char* ws = p.ws;
  const u16* A = (const u16*)(ws + 6 * SLOT);
  const u16* Bt = (const u16*)(ws + (LAYER == 0 ? WS_WT_OUTA : WS_WT_OUTB));
  const float* mod = (const float*)(ws + WS_MOD) + (size_t)LAYER * 24 * 3072;
  float* xmid = (float*)(ws + 0 * SLOT);
  f32x4 acc[8][4];
  const int xcc0 = xcc_id();
  int nxt;
  for (int ls = 0; ls < 8; ++ls) {
    const int xcd = (xcc0 + ls) & 7;
    unsigned* ctr = sched_ctr(p, LAYER == 0 ? 1 : 3, xcd);
    for (int li = sched_first(ctr, smem); li < 64; li = sched_commit(nxt, smem)) {
      nxt = sched_prefetch(ctr);
      const int item = 64 * xcd + li;
      const int m0 = (item >> 2) * 256, n0 = (item & 3) * 256;
      gemm_main256_dma(acc, A, 2048, Bt, 2048, 32, m0, n0, smem);
#pragma unroll
      for (int i = 0; i < 8; ++i)
#pragma unroll
        for (int j = 0; j < 4; ++j)
          outproj_store<LAYER>(p, mod, xmid, m0 + wr * 128 + i * 16 + fr, n0 + wc * 64 + j * 16 + fq * 4, acc[i][j]);
    }
  }
}

template <int LAYER>
DEV void phase_outproj_tail(const Params& p, char* smem) {
  const int tid = threadIdx.x, lane = tid & 63, wid = tid >> 6, wr = wid >> 1, wc = wid & 1, fr = lane & 15, fq = lane >> 4;
  char* ws = p.ws;
  const u16* A = (const u16*)(ws + 6 * SLOT);
  const u16* Bt = (const u16*)(ws + (LAYER == 0 ? WS_WT_OUTA : WS_WT_OUTB));
  const float* mod = (const float*)(ws + WS_MOD) + (size_t)LAYER * 24 * 3072;
  float* xmid = (float*)(ws + 0 * SLOT);
  f32x4 acc[4][4];
  const int xcc0 = xcc_id();
  int nxt;
  for (int ls = 0; ls < 8; ++ls) {
    const int xcd = (xcc0 + ls) & 7;
    unsigned* ctr = sched_ctr(p, LAYER == 0 ? 5 : 6, xcd);
    for (int li = sched_first(ctr, smem); li < 2; li = sched_commit(nxt, smem)) {
      nxt = sched_prefetch(ctr);
      const int item = 2 * xcd + li;
      const int m0 = (128 + (item >> 3)) * 256, n0 = (item & 7) * 128;
      gemm_main<0>(acc, A, 2048, Bt, 2048, 32, m0, n0, nullptr, nullptr, smem);
#pragma unroll
      for (int i = 0; i < 4; ++i)
#pragma unroll
        for (int j = 0; j < 4; ++j)
          outproj_store<LAYER>(p, mod, xmid, m0 + wr * 64 + i * 16 + fr, n0 + wc * 64 + j * 16 + fq * 4, acc[i][j]);
    }
  }
}

template <int LAYER>
DEV void phase_outproj(const Params& p, char* smem) {
  phase_outproj_tail<LAYER>(p, smem);
  phase_outproj_main<LAYER>(p, smem);
}

DEV void phase_norm1(const Params& p) {
  const int lane = threadIdx.x & 63, wid = threadIdx.x >> 6;
  const float* mod = (const float*)(p.ws + WS_MOD) + (size_t)24 * 3072;
  const float* xmid = (const float*)(p.ws + 0 * SLOT);
  u16* AKV = (u16*)(p.ws + 1 * SLOT);
  u16* AQ = AKV + (size_t)NTOK * 1024;
  const float* gkv = p.in[I_KVNG];
  const float* gb = p.in[I_BNG];
  for (int t = blockIdx.x * 8 + wid; t < NTOK; t += gridDim.x * 8) {
    const float* x = xmid + (size_t)t * 1024;
    const float* md = mod + (size_t)seq_of(t) * 3072;
    float4 v[4];
    float ss = 0.f;
#pragma unroll
    for (int i = 0; i < 4; ++i) {
      v[i] = *(const float4*)(x + lane * 4 + 256 * i);
      ss += v[i].x * v[i].x + v[i].y * v[i].y + v[i].z * v[i].z + v[i].w * v[i].w;
    }
    ss = wave_sum(ss);
    const float rstd = rsqrtf(ss * (1.0f / 1024.0f) + 1e-6f);
#pragma unroll
    for (int i = 0; i < 4; ++i) {
      const int c = lane * 4 + 256 * i;
      float4 g1 = *(const float4*)(gkv + c), g2 = *(const float4*)(gb + c), sh = *(const float4*)(md + c), sc = *(const float4*)(md + 1024 + c);
      float xn0 = v[i].x * rstd, xn1 = v[i].y * rstd, xn2 = v[i].z * rstd, xn3 = v[i].w * rstd;
      uint2 o;
      o.x = pack2(xn0 * g1.x, xn1 * g1.y); o.y = pack2(xn2 * g1.z, xn3 * g1.w);
      *(uint2*)(AKV + (size_t)t * 1024 + c) = o;
      o.x = pack2(xn0 * g2.x * (1.f + sc.x) + sh.x, xn1 * g2.y * (1.f + sc.y) + sh.y);
      o.y = pack2(xn2 * g2.z * (1.f + sc.z) + sh.z, xn3 * g2.w * (1.f + sc.w) + sh.w);
      *(uint2*)(AQ + (size_t)t * 1024 + c) = o;
    }
  }
}

#define QSCALE (0.08838834764831845f * 1.4426950408889634f)
DEV void phase_proj1(const Params& p, char* smem) {
  const int tid = threadIdx.x, lane = tid & 63, wid = tid >> 6, wr = wid >> 2, wc = wid & 3, fr = lane & 15, fq = lane >> 4;
  char* ws = p.ws;
  const u16* AKV = (const u16*)(ws + 1 * SLOT);
  const u16* AQ = AKV + (size_t)NTOK * 1024;
  u16* KB = (u16*)(ws + 2 * SLOT);
  u16* VB = (u16*)(ws + 3 * SLOT);
  u16* QB = (u16*)(ws + 4 * SLOT);
  u16* ZS = (u16*)(ws + 5 * SLOT);
  f32x4 acc[8][4];
  float* red = (float*)smem;
  const int xcc0 = xcc_id();
  int nxt;
  for (int ls = 0; ls < 8; ++ls) {
  const int xcd = (xcc0 + ls) & 7;
  unsigned* ctr = sched_ctr(p, 2, xcd);
  for (int li = sched_first(ctr, smem); li < 520; li = sched_commit(nxt, smem)) {
    nxt = sched_prefetch(ctr);
    const int mt = li >> 2, t = 4 * xcd + (li & 3);
    const int isq = t >> 4, nt = t & 15;
    const int m0 = mt * 256, n0 = nt * 256;
    gemm_main256_dma(acc, isq ? AQ : AKV, 1024, (const u16*)(ws + (isq ? WS_WT_INB : WS_WT_KV)), 1024, 16, m0, n0, smem);
    float rsv[8];
#pragma unroll
    for (int i = 0; i < 8; ++i) rsv[i] = 1.0f;
    if (nt < 8) {
#pragma unroll
      for (int i = 0; i < 8; ++i) {
        float ss = 0.f;
#pragma unroll
        for (int j = 0; j < 4; ++j) ss += acc[i][j][0] * acc[i][j][0] + acc[i][j][1] * acc[i][j][1] + acc[i][j][2] * acc[i][j][2] + acc[i][j][3] * acc[i][j][3];
        red[(wr * 128 + i * 16 + fr) * 16 + wc * 4 + fq] = ss;
      }
      __syncthreads();
#pragma unroll
      for (int i = 0; i < 8; ++i) {
        const int row = wr * 128 + i * 16 + fr;
        float4 ra = *(const float4*)(red + row * 16 + (wc >> 1) * 8), rb = *(const float4*)(red + row * 16 + (wc >> 1) * 8 + 4);
        float tot = ra.x + ra.y + ra.z + ra.w + rb.x + rb.y + rb.z + rb.w;
        rsv[i] = rsqrtf(tot * (1.f / 128.f) + 1e-6f) * (isq ? QSCALE : 1.0f);
      }
      __syncthreads();
      const float* gain = isq ? p.in[I_BQG] : p.in[I_KGAIN];
#pragma unroll
      for (int i = 0; i < 8; ++i) {
        const int row = wr * 128 + i * 16 + fr, m = m0 + row;
        const float rs = rsv[i];
#pragma unroll
        for (int j = 0; j < 4; ++j) {
          const int d = (wc & 1) * 64 + j * 16 + fq * 4, col = wc * 64 + j * 16 + fq * 4, n = n0 + col;
          float4 g4 = *(const float4*)(gain + d);
          f32x4 v = acc[i][j];
          float o0 = v[0] * rs * g4.x, o1 = v[1] * rs * g4.y, o2 = v[2] * rs * g4.z, o3 = v[3] * rs * g4.w;
          uint2 o; o.x = pack2(o0, o1); o.y = pack2(o2, o3);
          *(uint2*)(smem + row * 528 + col * 2) = o;
        }
      }
    } else {
#pragma unroll
      for (int i = 0; i < 8; ++i) {
        const int row = wr * 128 + i * 16 + fr, m = m0 + row;
#pragma unroll
        for (int j = 0; j < 4; ++j) {
          const int col = wc * 64 + j * 16 + fq * 4, n = n0 - 2048 + col;
          f32x4 v = acc[i][j];
          if (isq) {
            float o0 = v[0] * sigmoidf_(v[0]), o1 = v[1] * sigmoidf_(v[1]), o2 = v[2] * sigmoidf_(v[2]), o3 = v[3] * sigmoidf_(v[3]);
            uint2 o; o.x = pack2(o0, o1); o.y = pack2(o2, o3);
            *(uint2*)(smem + row * 528 + col * 2) = o;
          } else {
            uint2 o; o.x = pack2(v[0], v[1]); o.y = pack2(v[2], v[3]);
            *(uint2*)(smem + row * 528 + col * 2) = o;
          }
        }
      }
    }
    __syncthreads();
    {
      u16* bdst = isq ? (nt < 8 ? QB : ZS) : (nt < 8 ? KB : VB);
      const int nb = n0 - (nt < 8 ? 0 : 2048);
#pragma unroll 4
      for (int qq = 0; qq < 16; ++qq) {
        const int c = tid + 512 * qq, row = c >> 5, ch = c & 31;
        const uint4 v = *(const uint4*)(smem + row * 528 + ch * 16);
        *(uint4*)(bdst + (size_t)(m0 + row) * 2048 + nb + ch * 8) = v;
      }
    }
    __syncthreads();
    if (!isq) {
      const int nb = n0 - (nt < 8 ? 0 : 2048);
      float* fo = (m0 < TP) ? p.out + (nt < 8 ? OFF_K_P : OFF_V_P) + (size_t)m0 * 2048 : p.out + (nt < 8 ? OFF_K_S : OFF_V_S) + (size_t)(m0 - TP) * 2048;
      const float* gain = p.in[I_KGAIN];
#pragma unroll
      for (int half = 0; half < 2; ++half) {
        if (wr == half) {
#pragma unroll
          for (int i = 0; i < 8; ++i)
#pragma unroll
            for (int j = 0; j < 4; ++j) {
              const int row = i * 16 + fr, col = wc * 64 + j * 16 + fq * 4;
              float4 g4 = make_float4(1.f, 1.f, 1.f, 1.f);
              if (nt < 8) g4 = *(const float4*)(gain + (wc & 1) * 64 + j * 16 + fq * 4);
              const float rs = rsv[i];
              f32x4 v = acc[i][j];
              *(float4*)(smem + row * 1040 + col * 4) = make_float4(v[0] * rs * g4.x, v[1] * rs * g4.y, v[2] * rs * g4.z, v[3] * rs * g4.w);
            }
        }
        __syncthreads();
#pragma unroll 4
        for (int qq = 0; qq < 16; ++qq) {
          const int c = tid + 512 * qq, row = c >> 6, ch = c & 63;
          const float4 v = *(const float4*)(smem + row * 1040 + ch * 16);
          *(float4*)(fo + (size_t)(half * 128 + row) * 2048 + nb + ch * 4) = v;
        }
        __syncthreads();
      }
    }
  }
  }
}

DEV unsigned off_b(unsigned row, unsigned ch) { return 256u * row + 16u * (ch ^ (((row & 3) << 2) | ((row >> 2) & 3))); }

DEV void phase_attn(const Params& p, char* smem) {
  const int tid = threadIdx.x, lane = tid & 63, w = tid >> 6, fr = lane & 15, fq = lane >> 4;
  char* ws = p.ws;
  const u16* KB = (const u16*)(ws + 2 * SLOT);
  const u16* VB = (const u16*)(ws + 3 * SLOT);
  const u16* QB = (const u16*)(ws + 4 * SLOT);
  const u16* ZS = (const u16*)(ws + 5 * SLOT);
  u16* OG = (u16*)(ws + 6 * SLOT);
  const int lrow = tid >> 4, lch = tid & 15;
  const unsigned lw0 = off_b(lrow, lch), lw1 = off_b(lrow + 32, lch);
  const int tq = (lane & 15) >> 2, tp = lane & 3;

  for (int item = blockIdx.x; item < 4096 + 256; item += gridDim.x) {
    int b, h, nq, qpos0, tokq0, ntiles, nkeys, tokk0; bool sample;
    if (item < 4096) {
      const int qblk = 31 - (item >> 7), bh = item & 127;
      b = bh >> 4; h = bh & 15; nq = 128; qpos0 = qblk * 128; tokq0 = b * 4096 + qpos0; ntiles = 2 * qblk + 2; nkeys = qpos0 + 128; tokk0 = b * 4096; sample = false;
    } else {
      const int bh = item - 4096;
      b = bh >> 4; h = bh & 15; nq = 32; qpos0 = 1024; tokq0 = TP + b * 32; ntiles = 17; nkeys = 1056; tokk0 = TP + b * 32 - 1024; sample = true;
    }
    const bool wactive = (w * 16) < nq;
    int* dflag = (int*)(smem + 65536);
    __syncthreads();
    if (lane == 0) dflag[w] = wactive ? 0 : 1;
    bool wdone = !wactive;
    const int qp = qpos0 + w * 16 + fr;
    const int qwmax = qpos0 + w * 16 + 15;
    bf16x8 qf[4];
#pragma unroll
    for (int ks = 0; ks < 4; ++ks) {
      if (wactive) qf[ks] = *(const bf16x8*)(QB + (size_t)(tokq0 + w * 16 + fr) * 2048 + h * 128 + ks * 32 + fq * 8);
      else qf[ks] = (bf16x8){0, 0, 0, 0, 0, 0, 0, 0};
    }
    f32x4 O[8];
#pragma unroll
    for (int dt = 0; dt < 8; ++dt) O[dt] = (f32x4){0, 0, 0, 0};
    float carry = 0.f;

    uint4 lk0, lk1, lv0, lv1;
#define ATT_LOAD(kb)                                                                                  \
    {                                                                                                 \
      const int kx0_ = (kb) * 64 + lrow, kx1_ = kx0_ + 32;                                            \
      if (sample && (kb) < 16) {                                                                      \
        const float* ck_ = p.in[I_CK] + ((size_t)(b * 1024 + kx0_) * 16 + h) * 128 + lch * 8;         \
        const float* cv_ = p.in[I_CV] + ((size_t)(b * 1024 + kx0_) * 16 + h) * 128 + lch * 8;         \
        float4 a_ = *(const float4*)ck_, b_ = *(const float4*)(ck_ + 4);                              \
        float4 c_ = *(const float4*)(ck_ + 32 * 2048), d_ = *(const float4*)(ck_ + 32 * 2048 + 4);    \
        lk0 = make_uint4(pack2(a_.x, a_.y), pack2(a_.z, a_.w), pack2(b_.x, b_.y), pack2(b_.z, b_.w)); \
        lk1 = make_uint4(pack2(c_.x, c_.y), pack2(c_.z, c_.w), pack2(d_.x, d_.y), pack2(d_.z, d_.w)); \
        a_ = *(const float4*)cv_; b_ = *(const float4*)(cv_ + 4);                                     \
        c_ = *(const float4*)(cv_ + 32 * 2048); d_ = *(const float4*)(cv_ + 32 * 2048 + 4);           \
        lv0 = make_uint4(pack2(a_.x, a_.y), pack2(a_.z, a_.w), pack2(b_.x, b_.y), pack2(b_.z, b_.w)); \
        lv1 = make_uint4(pack2(c_.x, c_.y), pack2(c_.z, c_.w), pack2(d_.x, d_.y), pack2(d_.z, d_.w)); \
      } else {                                                                                        \
        const size_t o0_ = (size_t)(tokk0 + kx0_) * 2048 + h * 128 + lch * 8;                         \
        const size_t o1_ = o0_ + (size_t)32 * 2048;                                                   \
        if (kx0_ < nkeys) { lk0 = *(const uint4*)(KB + o0_); lv0 = *(const uint4*)(VB + o0_); }       \
        else { lk0 = make_uint4(0, 0, 0, 0); lv0 = lk0; }                                             \
        if (kx1_ < nkeys) { lk1 = *(const uint4*)(KB + o1_); lv1 = *(const uint4*)(VB + o1_); }       \
        else { lk1 = make_uint4(0, 0, 0, 0); lv1 = lk1; }                                             \
      }                                                                                               \
    }
#define ATT_STORE(st)                                                                                 \
    {                                                                                                 \
      char* sK_ = smem + (st) * 32768; char* sV_ = sK_ + 16384;                                       \
      *(uint4*)(sK_ + lw0) = lk0; *(uint4*)(sK_ + lw1) = lk1;                                         \
      *(uint4*)(sV_ + lw0) = lv0; *(uint4*)(sV_ + lw1) = lv1;                                         \
    }
    ATT_LOAD(ntiles - 1);
    ATT_STORE(0);
    __syncthreads();
    for (int it = 0; it < ntiles; ++it) {
      const int kb = ntiles - 1 - it, st = it & 1;
      if (it + 1 < ntiles) ATT_LOAD(kb - 1);
      if (!wdone && kb * 64 < qwmax) {
        const char* sK = smem + st * 32768;
        const char* sV = sK + 16384;
        f32x4 S[4];
#pragma unroll
        for (int mt = 0; mt < 4; ++mt) S[mt] = (f32x4){0, 0, 0, 0};
#pragma unroll
        for (int ks = 0; ks < 4; ++ks)
#pragma unroll
          for (int mt = 0; mt < 4; ++mt) {
            bf16x8 a = *(const bf16x8*)(sK + off_b(mt * 16 + fr, ks * 4 + fq));
            S[mt] = __builtin_amdgcn_mfma_f32_16x16x32_bf16(a, qf[ks], S[mt], 0, 0, 0);
          }
        bf16x8 wf[2];
#define ATT_ELEM(MASKED) \
        { \
          float ee[4][4], tot[4], hi[4]; \
_Pragma("unroll") \
          for (int mt = 0; mt < 4; ++mt) { \
            const int kbase = kb * 64 + mt * 16 + fq * 4; \
            float ls[4]; \
_Pragma("unroll") \
            for (int jj = 0; jj < 4; ++jj) { \
              const float u = S[mt][jj]; \
              const bool valid = !(MASKED) || ((kbase + jj) < qp); \
              const float l = -__builtin_amdgcn_logf(1.0f + __builtin_amdgcn_exp2f(u)); \
              ls[jj] = valid ? l : 0.f; \
              ee[mt][jj] = valid ? (u + l) : -1e30f; \
            } \
            const float x3 = ls[3], x2 = x3 + ls[2], x1 = x2 + ls[1], seg = x1 + ls[0]; \
            ee[mt][2] += x3; ee[mt][1] += x2; ee[mt][0] += x1; \
            const float t1 = __shfl_xor(seg, 16), t2 = __shfl_xor(seg, 32), t3 = __shfl_xor(t1, 32); \
            tot[mt] = seg + t1 + t2 + t3; \
            hi[mt] = fq == 0 ? (t1 + t2 + t3) : fq == 1 ? (t2 + t3) : fq == 2 ? t1 : 0.f; \
          } \
          float run = carry; \
          float wv[4][4]; \
_Pragma("unroll") \
          for (int mt = 3; mt >= 0; --mt) { \
            const float base = run + hi[mt]; \
            run += tot[mt]; \
_Pragma("unroll") \
            for (int jj = 0; jj < 4; ++jj) wv[mt][jj] = __builtin_amdgcn_exp2f(ee[mt][jj] + base); \
          } \
          carry = run; \
          if (__all(carry < -150.0f)) { wdone = true; if (lane == 0) dflag[w] = 1; } \
_Pragma("unroll") \
          for (int p2 = 0; p2 < 2; ++p2) { \
            uint4 pk; \
            pk.x = pack2(wv[2 * p2][0], wv[2 * p2][1]); pk.y = pack2(wv[2 * p2][2], wv[2 * p2][3]); \
            pk.z = pack2(wv[2 * p2 + 1][0], wv[2 * p2 + 1][1]); pk.w = pack2(wv[2 * p2 + 1][2], wv[2 * p2 + 1][3]); \
            wf[p2] = *(bf16x8*)&pk; \
          } \
        }
        if (kb * 64 + 63 < qpos0 + w * 16) { ATT_ELEM(0) } else { ATT_ELEM(1) }
#undef ATT_ELEM
#pragma unroll
        for (int p2 = 0; p2 < 2; ++p2)
#pragma unroll
          for (int dt = 0; dt < 8; ++dt) {
            const unsigned r0 = 32 * p2 + 4 * fq + tq, r1 = r0 + 16;
            const unsigned ch = 2 * dt + (tp >> 1);
            const char* a0 = sV + off_b(r0, ch) + 8 * (tp & 1);
            const char* a1 = sV + off_b(r1, ch) + 8 * (tp & 1);
            s16x4 lo = __builtin_amdgcn_ds_read_tr16_b64_v4i16((s16x4 __attribute__((address_space(3)))*)(a0));
            s16x4 hi4 = __builtin_amdgcn_ds_read_tr16_b64_v4i16((s16x4 __attribute__((address_space(3)))*)(a1));
            bf16x8 a = {lo[0], lo[1], lo[2], lo[3], hi4[0], hi4[1], hi4[2], hi4[3]};
            O[dt] = __builtin_amdgcn_mfma_f32_16x16x32_bf16(a, wf[p2], O[dt], 0, 0, 0);
          }
      }
      if (it + 1 < ntiles) ATT_STORE(st ^ 1);
      __syncthreads();
      {
        const int4 f0 = *(const int4*)dflag, f1 = *(const int4*)(dflag + 4);
        if (f0.x & f0.y & f0.z & f0.w & f1.x & f1.y & f1.z & f1.w) break;
      }
    }
#undef ATT_LOAD
#undef ATT_STORE
    if (wactive) {
      const size_t rowoff = (size_t)(tokq0 + w * 16 + fr) * 2048 + h * 128;
#pragma unroll
      for (int dt = 0; dt < 8; ++dt) {
        const int d = dt * 16 + fq * 4;
        uint2 z = *(const uint2*)(ZS + rowoff + d);
        f32x4 v = O[dt];
        uint2 o;
        o.x = pack2(v[0] * bflo(z.x), v[1] * bfhi(z.x)); o.y = pack2(v[2] * bflo(z.y), v[3] * bfhi(z.y));
        *(uint2*)(OG + rowoff + d) = o;
      }
    }
  }
}


DEV void grid_barrier(unsigned* bar, unsigned target) {
  __syncthreads();
  if (threadIdx.x == 0) {
    __builtin_amdgcn_fence(__ATOMIC_RELEASE, "agent");
    asm volatile("s_waitcnt vmcnt(0)" ::: "memory");
    __hip_atomic_fetch_add(bar, 1u, __ATOMIC_RELAXED, __HIP_MEMORY_SCOPE_AGENT);
    while (__hip_atomic_load(bar, __ATOMIC_RELAXED, __HIP_MEMORY_SCOPE_AGENT) < target) __builtin_amdgcn_s_sleep(1);
    __builtin_amdgcn_fence(__ATOMIC_ACQUIRE, "agent");
    asm volatile("s_waitcnt vmcnt(0)" ::: "memory");
  }
  __syncthreads();
}

__global__ void __launch_bounds__(NTHREADS) __attribute__((target("no-packed-fp32-ops"))) mega(Params p, int lo, int hi) {
  __shared__ __attribute__((aligned(16))) char smem[147456];
  cg::grid_group grid = cg::this_grid();
#ifndef PROBE_DOUBLE
#define PROBE_DOUBLE -1
#endif
#define RUN_PHASE(k, call) if ((k) >= lo && (k) < hi) { if ((k) > lo) { if ((k) == lo + 1) grid.sync(); else grid_barrier((unsigned*)(p.ws + WS_BAR), (unsigned)((k) - lo - 1) * gridDim.x); } call; }
  RUN_PHASE(0, phase_prep(p, smem))
  RUN_PHASE(1, phase_norm0(p))
  RUN_PHASE(2, phase_proj0(p, smem))
  RUN_PHASE(3, phase_scan(p, smem))
  RUN_PHASE(4, phase_outproj<0>(p, smem))
  RUN_PHASE(5, phase_norm1(p))
  RUN_PHASE(6, phase_proj1(p, smem))
  RUN_PHASE(7, phase_attn(p, smem))
  RUN_PHASE(8, phase_outproj<1>(p, smem))
}

#ifndef N_LAUNCH_MODE
#define N_LAUNCH_MODE 1
#endif

extern "C" void kernel_launch(void* const* d_in, const int* in_sizes, int n_in, void* d_out, int out_size, void* d_ws, size_t ws_size,
                              hipStream_t stream) {
  Params p{};
  for (int i = 0; i < 36; ++i) p.in[i] = (const float*)d_in[i];
  p.out = (float*)d_out;
  p.ws = (char*)d_ws;
  static int grid_blocks = 0;
  if (!grid_blocks) {
    int dev = 0, cus = 0, per_cu = 0;
    hipGetDevice(&dev);
    hipDeviceGetAttribute(&cus, hipDeviceAttributeMultiprocessorCount, dev);
    hipOccupancyMaxActiveBlocksPerMultiprocessor(&per_cu, mega, NTHREADS, 0);
    if (per_cu < 1) per_cu = 1;
    grid_blocks = cus * per_cu;
  }
  if (ws_size < WS_END) { fprintf(stderr, "workspace too small: %zu < %llu\n", ws_size, (unsigned long long)WS_END); return; }
#if N_LAUNCH_MODE == 1
  int lo = 0, hi = 9;
  hipMemsetAsync((char*)d_ws + WS_BAR, 0, 256, stream);
  void* args[] = {&p, &lo, &hi};
  hipError_t e = hipLaunchCooperativeKernel((void*)mega, dim3(grid_blocks), dim3(NTHREADS), args, 0, stream);
  if (e != hipSuccess) fprintf(stderr, "cooperative launch failed: %s (grid %d)\n", hipGetErrorString(e), grid_blocks);
#else
  for (int ph = 0; ph < 9; ++ph) hipLaunchKernelGGL(mega, dim3(grid_blocks), dim3(NTHREADS), 0, stream, p, ph, ph + 1);
#endif
}
```

```cpp
#include <hip/hip_runtime.h>
#include <hip/hip_cooperative_groups.h>
#include <cstdio>
namespace cg = cooperative_groups;

typedef unsigned short u16;
typedef short bf16x8 __attribute__((ext_vector_type(8)));
typedef short s16x4 __attribute__((ext_vector_type(4)));
typedef float f32x4 __attribute__((ext_vector_type(4)));
typedef float f32x2 __attribute__((ext_vector_type(2)));
typedef __bf16 bf16x2_t __attribute__((ext_vector_type(2)));
typedef _Float16 h2_t __attribute__((ext_vector_type(2)));

#define DEV __device__ __forceinline__

#define NTOK 33280
#define TP 32768
#define NTHREADS 512

#define OFF_Y_P 0
#define OFF_Y_S 33554432
#define OFF_K_P 34078720
#define OFF_V_P 101187584
#define OFF_WKV_P 168296448
#define OFF_SH_P 169345024
#define OFF_K_S 169353216
#define OFF_V_S 170401792
#define OFF_WKV_S 171450368
#define OFF_SH_S 173547520

#define SLOT 136314880ull
#define WS_W (7ull * SLOT)
#define WS_WT_IN (WS_W)
#define WS_WT_OUTA (WS_WT_IN + 16777216ull)
#define WS_WT_KV (WS_WT_OUTA + 4194304ull)
#define WS_WT_INB (WS_WT_KV + 8388608ull)
#define WS_WT_OUTB (WS_WT_INB + 8388608ull)
#define WS_W2T (WS_WT_OUTB + 4194304ull)
#define WS_A2T (WS_W2T + 262144ull)
#define WS_L1T (WS_A2T + 262144ull)
#define WS_MOD (WS_L1T + 524288ull)
#define WS_SH (WS_MOD + 589824ull)
#define WS_CTR (WS_SH + 49152ull)
#define WS_BAR (WS_CTR + 4096ull)
#define WS_END (WS_BAR + 256ull)
#define WS_H0 (6ull * SLOT)
#define WS_T (4ull * SLOT)

struct Params {
  const float* in[36];
  float* out;
  char* ws;
};

enum { I_XP = 0, I_XS, I_CK, I_CV, I_SWKV, I_SSH, I_CP, I_CS, I_ANG, I_AADAW, I_AADAB, I_AWIN, I_AMUIN, I_AMUW, I_AMUA,
       I_AW0, I_AW1, I_AW2, I_AA0, I_AA1, I_AA2, I_AKK, I_AKA, I_ARK, I_ALNG, I_ALNB, I_AWOUT, I_KVNG, I_KVW, I_KGAIN,
       I_BNG, I_BADAW, I_BADAB, I_BWIN, I_BQG, I_BWOUT };

DEV int seq_of(int t) { return t < TP ? (t >> 12) : 8 + ((t - TP) >> 5); }
DEV bool seq_start(int t) { return t < TP ? ((t & 4095) == 0) : (((t - TP) & 31) == 0); }

DEV unsigned pack2(float a, float b) {
  f32x2 v = {a, b};
  bf16x2_t r = __builtin_convertvector(v, bf16x2_t);
  return *(unsigned*)&r;
}
DEV unsigned packh2(float a, float b) {
  f32x2 v = {a, b};
  h2_t r = __builtin_convertvector(v, h2_t);
  return *(unsigned*)&r;
}
DEV float bflo(unsigned w) { return __uint_as_float(w << 16); }
DEV float bfhi(unsigned w) { return __uint_as_float(w & 0xffff0000u); }
DEV void unpack8(const uint4& x, float* f) {
  f[0] = bflo(x.x); f[1] = bfhi(x.x); f[2] = bflo(x.y); f[3] = bfhi(x.y);
  f[4] = bflo(x.z); f[5] = bfhi(x.z); f[6] = bflo(x.w); f[7] = bfhi(x.w);
}
DEV float sigmoidf_(float x) { return 1.0f / (1.0f + __expf(-x)); }

template <int CTRL>
DEV float dppf(float x) {
  return __int_as_float(__builtin_amdgcn_update_dpp(0, __float_as_int(x), CTRL, 0xf, 0xf, true));
}
DEV float red4(float x) { x += dppf<0xB1>(x); x += dppf<0x4E>(x); return x; }
DEV float red8(float x) { x = red4(x); x += dppf<0x141>(x); return x; }
DEV float red16(float x) { x = red8(x); x += dppf<0x140>(x); return x; }
DEV float wave_sum(float x) {
#pragma unroll
  for (int o = 32; o >= 1; o >>= 1) x += __shfl_xor(x, o);
  return x;
}


#define SCHED_SLOT_OFF 147440
DEV int xcc_id() { return (int)(__builtin_amdgcn_s_getreg((3 << 11) | 20) & 0x7u); }
DEV unsigned* sched_ctr(const Params& p, int phase_slot, int list) { return (unsigned*)(p.ws + WS_CTR) + (phase_slot * 8 + list) * 16; }
DEV int sched_first(unsigned* ctr, char* smem) {
  int* slot = (int*)(smem + SCHED_SLOT_OFF);
  __syncthreads();
  if (threadIdx.x == 0) *slot = (int)atomicAdd(ctr, 1u);
  __syncthreads();
  return *slot;
}

DEV void group_sync(unsigned* bar, unsigned target) {
  __syncthreads();
  if (threadIdx.x == 0) {
    __hip_atomic_fetch_add(bar, 1u, __ATOMIC_RELAXED, __HIP_MEMORY_SCOPE_AGENT);
    while (__hip_atomic_load(bar, __ATOMIC_RELAXED, __HIP_MEMORY_SCOPE_AGENT) < target) __builtin_amdgcn_s_sleep(2);
  }
  __syncthreads();
}
DEV int sched_prefetch(unsigned* ctr) { return threadIdx.x == 0 ? (int)atomicAdd(ctr, 1u) : 0; }
DEV int sched_commit(int nxt, char* smem) {
  int* slot = (int*)(smem + SCHED_SLOT_OFF);
  __syncthreads();
  if (threadIdx.x == 0) *slot = nxt;
  __syncthreads();
  return *slot;
}

#define GEMM_STAGE_BYTES 49152

template <int AMODE>
DEV void gemm_main(f32x4 (&acc)[4][4], const u16* __restrict__ A, int lda, const u16* __restrict__ Bt, int ldb, int nk,
                   int m0, int n0, const float* __restrict__ mu, const u16* __restrict__ SH, char* smem) {
  const int tid = threadIdx.x, lane = tid & 63, wid = tid >> 6, wr = wid >> 1, wc = wid & 1, fr = lane & 15, fq = lane >> 4;
  const int lrow = tid >> 3, lch = tid & 7;
#pragma unroll
  for (int i = 0; i < 4; ++i)
#pragma unroll
    for (int j = 0; j < 4; ++j) acc[i][j] = (f32x4){0.f, 0.f, 0.f, 0.f};

  const u16* pa0; const u16* pa1; const u16* pa2; const u16* pa3;
  const u16* pp0 = nullptr;
  const int arow = 4 * lrow;
  {
    int m = m0 + arow;
    pa0 = A + (size_t)m * lda + lch * 8;
    pa1 = pa0 + lda; pa2 = pa1 + lda; pa3 = pa2 + lda;
    if (AMODE != 0) pp0 = seq_start(m) ? SH + seq_of(m) * 1024 + lch * 8 : pa0 - lda;
  }
  const u16* pb0 = Bt + (size_t)(n0 + lrow) * ldb + lch * 8;
  const u16* pb1 = pb0 + (size_t)64 * ldb;
  const int woffB = lrow * 128 + ((lch ^ ((lrow >> 1) & 7)) << 4);
  const int woffA0 = (arow + 0) * 128 + ((lch ^ (((arow + 0) >> 1) & 7)) << 4);
  const int woffA1 = (arow + 1) * 128 + ((lch ^ (((arow + 1) >> 1) & 7)) << 4);
  const int woffA2 = (arow + 2) * 128 + ((lch ^ (((arow + 2) >> 1) & 7)) << 4);
  const int woffA3 = (arow + 3) * 128 + ((lch ^ (((arow + 3) >> 1) & 7)) << 4);

  uint4 ra0, ra1, ra2, ra3, rp0, rb0, rb1;
  float4 mu0, mu1;
  rp0 = make_uint4(0, 0, 0, 0);
  mu0 = mu1 = make_float4(0, 0, 0, 0);

#define G_LOAD(kt)                                                                     \
  {                                                                                    \
    const int k0_ = (kt) * 64;                                                         \
    if (AMODE == 0) {                                                                  \
      ra0 = *(const uint4*)(pa0 + k0_); ra1 = *(const uint4*)(pa1 + k0_);              \
      ra2 = *(const uint4*)(pa2 + k0_); ra3 = *(const uint4*)(pa3 + k0_);              \
    } else if (AMODE == 1) {                                                           \
      ra0 = *(const uint4*)(pa0 + k0_); ra1 = *(const uint4*)(pa1 + k0_);              \
      ra2 = *(const uint4*)(pa2 + k0_); ra3 = *(const uint4*)(pa3 + k0_);              \
      rp0 = *(const uint4*)(pp0 + k0_);                                                \
      mu0 = *(const float4*)(mu + k0_ + lch * 8); mu1 = *(const float4*)(mu + k0_ + lch * 8 + 4); \
    } else {                                                                           \
      const int kk_ = k0_ & 1023;                                                      \
      ra0 = *(const uint4*)(pa0 + kk_); ra1 = *(const uint4*)(pa1 + kk_);              \
      ra2 = *(const uint4*)(pa2 + kk_); ra3 = *(const uint4*)(pa3 + kk_);              \
      if (k0_ >= 1024) rp0 = *(const uint4*)(pp0 + kk_);                               \
    }                                                                                  \
    rb0 = *(const uint4*)(pb0 + k0_); rb1 = *(const uint4*)(pb1 + k0_);                \
  }

#define G_XFORM(dst, a_, p_, kt)                                                       \
  {                                                                                    \
    if (AMODE == 0) dst = a_;                                                          \
    else if (AMODE == 1) {                                                             \
      float h_[8], q_[8]; unpack8(a_, h_); unpack8(p_, q_);                            \
      dst.x = pack2(h_[0] + mu0.x * (q_[0] - h_[0]), h_[1] + mu0.y * (q_[1] - h_[1])); \
      dst.y = pack2(h_[2] + mu0.z * (q_[2] - h_[2]), h_[3] + mu0.w * (q_[3] - h_[3])); \
      dst.z = pack2(h_[4] + mu1.x * (q_[4] - h_[4]), h_[5] + mu1.y * (q_[5] - h_[5])); \
      dst.w = pack2(h_[6] + mu1.z * (q_[6] - h_[6]), h_[7] + mu1.w * (q_[7] - h_[7])); \
    } else {                                                                           \
      if ((kt) * 64 >= 1024) {                                                         \
        float h_[8], q_[8]; unpack8(a_, h_); unpack8(p_, q_);                          \
        dst.x = pack2(q_[0] - h_[0], q_[1] - h_[1]); dst.y = pack2(q_[2] - h_[2], q_[3] - h_[3]); \
        dst.z = pack2(q_[4] - h_[4], q_[5] - h_[5]); dst.w = pack2(q_[6] - h_[6], q_[7] - h_[7]); \
      } else dst = a_;                                                                 \
    }                                                                                  \
  }

#define G_STORE(stage, kt)                                                             \
  {                                                                                    \
    char* sA_ = smem + (stage) * GEMM_STAGE_BYTES; char* sB_ = sA_ + 32768;            \
    uint4 v_;                                                                          \
    G_XFORM(v_, ra0, rp0, kt); *(uint4*)(sA_ + woffA0) = v_;                           \
    G_XFORM(v_, ra1, ra0, kt); *(uint4*)(sA_ + woffA1) = v_;                           \
    G_XFORM(v_, ra2, ra1, kt); *(uint4*)(sA_ + woffA2) = v_;                           \
    G_XFORM(v_, ra3, ra2, kt); *(uint4*)(sA_ + woffA3) = v_;                           \
    *(uint4*)(sB_ + woffB) = rb0; *(uint4*)(sB_ + woffB + 64 * 128) = rb1;             \
  }

  G_LOAD(0);
  G_STORE(0, 0);
  __syncthreads();
  const int rsw = (fr >> 1) & 7;
  for (int kt = 0; kt < nk; ++kt) {
    const int st = kt & 1;
    if (kt + 1 < nk) G_LOAD(kt + 1);
    __builtin_amdgcn_sched_barrier(0);
    {
      const char* sA = smem + st * GEMM_STAGE_BYTES;
      const char* sB = sA + 32768;
#pragma unroll
      for (int kk = 0; kk < 2; ++kk) {
        bf16x8 af[4], bfr[4];
        const int cho = ((kk * 4 + fq) ^ rsw) << 4;
#pragma unroll
        for (int i = 0; i < 4; ++i) af[i] = *(const bf16x8*)(sA + (wr * 64 + i * 16 + fr) * 128 + cho);
#pragma unroll
        for (int j = 0; j < 4; ++j) bfr[j] = *(const bf16x8*)(sB + (wc * 64 + j * 16 + fr) * 128 + cho);
#pragma unroll
        for (int i = 0; i < 4; ++i)
#pragma unroll
          for (int j = 0; j < 4; ++j) acc[i][j] = __builtin_amdgcn_mfma_f32_16x16x32_bf16(bfr[j], af[i], acc[i][j], 0, 0, 0);
      }
    }
    if (kt + 1 < nk) G_STORE(st ^ 1, kt + 1);
    __syncthreads();
  }
#undef G_LOAD
#undef G_XFORM
#undef G_STORE
}


#define G2_STAGE_BYTES 32768
#define G2_MU_OFF (3 * G2_STAGE_BYTES)
DEV int g2_swz(int row) { return (0x78 >> (2 * ((row >> 2) & 3))) & 3; }
template <int AMODE>
DEV void gemm_main256(f32x4 (&acc)[8][4], const u16* __restrict__ A, int lda, const u16* __restrict__ Bt, int ldb, int nk64,
                      int m0, int n0, const float* __restrict__ mu, const u16* __restrict__ SH, char* smem) {
  const int tid = threadIdx.x, lane = tid & 63, wid = tid >> 6, wr = wid >> 2, wc = wid & 3, fr = lane & 15, fq = lane >> 4;
  const int nk = nk64 * 2;
  const int lrow2 = 2 * (tid >> 2), lch = tid & 3;
#pragma unroll
  for (int i = 0; i < 8; ++i)
#pragma unroll
    for (int j = 0; j < 4; ++j) acc[i][j] = (f32x4){0.f, 0.f, 0.f, 0.f};
  const u16* pa0 = A + (size_t)(m0 + lrow2) * lda + lch * 8;
  const u16* pp0 = nullptr;
  if (AMODE != 0) pp0 = seq_start(m0 + lrow2) ? SH + seq_of(m0 + lrow2) * 1024 + lch * 8 : pa0 - lda;
  const u16* pb0 = Bt + (size_t)(n0 + lrow2) * ldb + lch * 8;
  const int woff0 = (lrow2 + 0) * 64 + ((lch ^ g2_swz(lrow2 + 0)) << 4);
  const int woff1 = (lrow2 + 1) * 64 + ((lch ^ g2_swz(lrow2 + 1)) << 4);
  const float* muL = (const float*)(smem + G2_MU_OFF);
  if (AMODE == 1) {
    if (tid < 256) *(float4*)(smem + G2_MU_OFF + tid * 16) = *(const float4*)(mu + tid * 4);
  }
  uint4 xa0, xa1, xp, xb0, xb1;
  uint4 ya0, ya1, yp, yb0, yb1;
  xp = yp = make_uint4(0, 0, 0, 0);

#define K_LOAD(S, kt)                                                                  \
  {                                                                                    \
    const int k0_ = (kt) * 32;                                                         \
    S##a0 = *(const uint4*)(pa0 + k0_); S##a1 = *(const uint4*)(pa0 + lda + k0_);      \
    if (AMODE == 1) S##p = *(const uint4*)(pp0 + k0_);                                 \
    S##b0 = *(const uint4*)(pb0 + k0_); S##b1 = *(const uint4*)(pb0 + ldb + k0_);      \
  }
#define K_XFORM(dst, a_, p_)                                                           \
  {                                                                                    \
    if (AMODE == 0) dst = a_;                                                          \
    else {                                                                             \
      float h_[8], q_[8]; unpack8(a_, h_); unpack8(p_, q_);                            \
      dst.x = pack2(h_[0] + mu0.x * (q_[0] - h_[0]), h_[1] + mu0.y * (q_[1] - h_[1])); \
      dst.y = pack2(h_[2] + mu0.z * (q_[2] - h_[2]), h_[3] + mu0.w * (q_[3] - h_[3])); \
      dst.z = pack2(h_[4] + mu1.x * (q_[4] - h_[4]), h_[5] + mu1.y * (q_[5] - h_[5])); \
      dst.w = pack2(h_[6] + mu1.z * (q_[6] - h_[6]), h_[7] + mu1.w * (q_[7] - h_[7])); \
    }                                                                                  \
  }
#define K_STORE(S, stage, kt)                                                          \
  {                                                                                    \
    char* sA_ = smem + (stage) * G2_STAGE_BYTES; char* sB_ = sA_ + 16384;              \
    uint4 v_; float4 mu0, mu1;                                                         \
    if (AMODE == 1) { mu0 = *(const float4*)(muL + (kt) * 32 + lch * 8); mu1 = *(const float4*)(muL + (kt) * 32 + lch * 8 + 4); } \
    K_XFORM(v_, S##a0, S##p); *(uint4*)(sA_ + woff0) = v_;                             \
    K_XFORM(v_, S##a1, S##a0); *(uint4*)(sA_ + woff1) = v_;                            \
    *(uint4*)(sB_ + woff0) = S##b0; *(uint4*)(sB_ + woff1) = S##b1;                    \
  }
#define K_COMPUTE_HALF(stage, i0)                                                      \
  {                                                                                    \
    const char* sA_ = smem + (stage) * G2_STAGE_BYTES;                                 \
    _Pragma("unroll") for (int i = (i0); i < (i0) + 4; ++i) {                          \
      const bf16x8 af = *(const bf16x8*)(sA_ + (wr * 128 + i * 16 + fr) * 64 + cho);   \
      _Pragma("unroll") for (int j = 0; j < 4; ++j) acc[i][j] = __builtin_amdgcn_mfma_f32_16x16x32_bf16(bfr[j], af, acc[i][j], 0, 0, 0); \
    }                                                                                  \
  }
#define K_LOAD_B(stage)                                                                \
  {                                                                                    \
    const char* sB_ = smem + (stage) * G2_STAGE_BYTES + 16384;                         \
    _Pragma("unroll") for (int j = 0; j < 4; ++j) bfr[j] = *(const bf16x8*)(sB_ + (wc * 64 + j * 16 + fr) * 64 + cho); \
  }
#define K_ITER(kt, L, S)                                                               \
  {                                                                                    \
    K_LOAD(L, min((kt) + 2, nk - 1));                                                  \
    __builtin_amdgcn_sched_barrier(0);                                                 \
    bf16x8 bfr[4];                                                                     \
    K_LOAD_B(cu);                                                                      \
    K_COMPUTE_HALF(cu, 0);                                                             \
    __builtin_amdgcn_sched_barrier(0);                                                 \
    K_STORE(S, nx, min((kt) + 1, nk - 1));                                             \
    __builtin_amdgcn_sched_barrier(0);                                                 \
    if (AMODE == 1) K_LOAD_B(cu);                                                      \
    K_COMPUTE_HALF(cu, 4);                                                             \
    __syncthreads();                                                                   \
    cu = nx; nx = (nx == 2) ? 0 : nx + 1;                                              \
  }
  const int cho = (fq ^ g2_swz(fr)) << 4;
  if (AMODE == 1) __syncthreads();
  K_LOAD(x, 0);
  K_LOAD(y, 1);
  K_STORE(x, 0, 0);
  __syncthreads();
  int cu = 0, nx = 1;
  for (int kt = 0; kt < nk; kt += 2) {
    K_ITER(kt, x, y);
    K_ITER(kt + 1, y, x);
  }
#undef K_LOAD
#undef K_XFORM
#undef K_STORE
#undef K_COMPUTE_HALF
#undef K_LOAD_B
#undef K_ITER
}


#define GD_NST 4
DEV void gemm_main256_dma(f32x4 (&acc)[8][4], const u16* __restrict__ A, int lda, const u16* __restrict__ Bt, int ldb, int nk64,
                          int m0, int n0, char* smem) {
  const int tid = threadIdx.x, lane = tid & 63, wid = tid >> 6, wr = wid >> 2, wc = wid & 3, fr = lane & 15, fq = lane >> 4;
  const int nk = nk64 * 2;
#pragma unroll
  for (int i = 0; i < 8; ++i)
#pragma unroll
    for (int j = 0; j < 4; ++j) acc[i][j] = (f32x4){0.f, 0.f, 0.f, 0.f};
  const int prow = 16 * wid + (lane >> 2);
  const int pch = (lane & 3) ^ g2_swz(prow);
  const u16* srcA = A + (size_t)(m0 + prow) * lda + pch * 8;
  const u16* srcB = Bt + (size_t)(n0 + prow) * ldb + pch * 8;
  const size_t a128 = (size_t)128 * lda, b128 = (size_t)128 * ldb;
  char* ldsw = smem + (16 * wid) * 64;
#define D_FILL(kt, stage)                                                              \
  {                                                                                    \
    const int k0_ = (kt) * 32;                                                         \
    char* d_ = ldsw + (stage) * G2_STAGE_BYTES;                                        \
    __builtin_amdgcn_global_load_lds((const unsigned*)(srcA + k0_), (unsigned*)(d_), 16, 0, 0);               \
    __builtin_amdgcn_global_load_lds((const unsigned*)(srcA + a128 + k0_), (unsigned*)(d_ + 8192), 16, 0, 0); \
    __builtin_amdgcn_global_load_lds((const unsigned*)(srcB + k0_), (unsigned*)(d_ + 16384), 16, 0, 0);       \
    __builtin_amdgcn_global_load_lds((const unsigned*)(srcB + b128 + k0_), (unsigned*)(d_ + 16384 + 8192), 16, 0, 0); \
  }
  const int cho = (fq ^ g2_swz(fr)) << 4;
  __syncthreads();
  D_FILL(0, 0);
  D_FILL(min(1, nk - 1), 1);
  D_FILL(min(2, nk - 1), 2);
  int cu = 0, fill = 3;
  for (int kt = 0; kt < nk; ++kt) {
    asm volatile("s_waitcnt vmcnt(8)" ::: "memory");
    asm volatile("s_waitcnt lgkmcnt(0)" ::: "memory");
    __builtin_amdgcn_s_barrier();
    D_FILL(min(kt + 3, nk - 1), fill);
    {
      const char* sA_ = smem + cu * G2_STAGE_BYTES;
      const char* sB_ = sA_ + 16384;
      bf16x8 bfr[4];
#pragma unroll
      for (int j = 0; j < 4; ++j) bfr[j] = *(const bf16x8*)(sB_ + (wc * 64 + j * 16 + fr) * 64 + cho);
#pragma unroll
      for (int i = 0; i < 8; ++i) {
        const bf16x8 af = *(const bf16x8*)(sA_ + (wr * 128 + i * 16 + fr) * 64 + cho);
#pragma unroll
        for (int j = 0; j < 4; ++j) acc[i][j] = __builtin_amdgcn_mfma_f32_16x16x32_bf16(bfr[j], af, acc[i][j], 0, 0, 0);
      }
    }
    cu = (cu == GD_NST - 1) ? 0 : cu + 1;
    fill = (fill == GD_NST - 1) ? 0 : fill + 1;
  }
  asm volatile("s_waitcnt vmcnt(0)" ::: "memory");
  asm volatile("s_waitcnt lgkmcnt(0)" ::: "memory");
  __builtin_amdgcn_s_barrier();
#undef D_FILL
}

DEV void transpose_tile(const float* __restrict__ src, int N, int k0, int n0, const float* __restrict__ scale, u16* __restrict__ dst,
                        int dstride, int drow0, int dcol0, char* smem) {
  float* tile = (float*)smem;
  const int tid = threadIdx.x;
#pragma unroll
  for (int i = 0; i < 2; ++i) {
    int kl = (tid >> 4) + 32 * i, n4 = (tid & 15) * 4;
    float4 v = *(const float4*)(src + (size_t)(k0 + kl) * N + n0 + n4);
    float s = scale ? scale[k0 + kl] : 1.0f;
    tile[kl * 65 + n4 + 0] = v.x * s; tile[kl * 65 + n4 + 1] = v.y * s;
    tile[kl * 65 + n4 + 2] = v.z * s; tile[kl * 65 + n4 + 3] = v.w * s;
  }
  __syncthreads();
  {
    int nl = tid >> 3, k8 = (tid & 7) * 8;
    uint4 o;
    o.x = pack2(tile[(k8 + 0) * 65 + nl], tile[(k8 + 1) * 65 + nl]);
    o.y = pack2(tile[(k8 + 2) * 65 + nl], tile[(k8 + 3) * 65 + nl]);
    o.z = pack2(tile[(k8 + 4) * 65 + nl], tile[(k8 + 5) * 65 + nl]);
    o.w = pack2(tile[(k8 + 6) * 65 + nl], tile[(k8 + 7) * 65 + nl]);
    *(uint4*)(dst + (size_t)(drow0 + n0 + nl) * dstride + dcol0 + k0 + k8) = o;
  }
  __syncthreads();
}

DEV void transpose_tile_wide(const float* __restrict__ src, int N, int k0, int n0, u16* __restrict__ dst, int dstride, char* smem) {
  float* tile = (float*)smem;
  const int tid = threadIdx.x;
#pragma unroll
  for (int i = 0; i < 8; ++i) {
    const int e = tid + 512 * i, kl = e >> 6, n4 = (e & 63) * 4;
    const float4 v = *(const float4*)(src + (size_t)(k0 + kl) * N + n0 + n4);
    float* t = tile + kl * 257 + n4;
    t[0] = v.x; t[1] = v.y; t[2] = v.z; t[3] = v.w;
  }
  __syncthreads();
#pragma unroll
  for (int i = 0; i < 4; ++i) {
    const int c = tid + 512 * i, nl = c >> 3, k8 = (c & 7) * 8;
    uint4 o;
    o.x = pack2(tile[(k8 + 0) * 257 + nl], tile[(k8 + 1) * 257 + nl]);
    o.y = pack2(tile[(k8 + 2) * 257 + nl], tile[(k8 + 3) * 257 + nl]);
    o.z = pack2(tile[(k8 + 4) * 257 + nl], tile[(k8 + 5) * 257 + nl]);
    o.w = pack2(tile[(k8 + 6) * 257 + nl], tile[(k8 + 7) * 257 + nl]);
    *(uint4*)(dst + (size_t)(n0 + nl) * dstride + k0 + k8) = o;
  }
  __syncthreads();
}

DEV void phase_prep(const Params& p, char* smem) {
  const int tid = threadIdx.x;
  char* ws = p.ws;
  if (blockIdx.x < 96) {
    float* cL = (float*)smem;
    float* red = (float*)(smem + 98304);
    for (int e = tid; e < 24 * 256; e += NTHREADS) {
      int s = e >> 8, k4 = (e & 255) * 4;
      float4 v = s < 8 ? *(const float4*)(p.in[I_CP] + s * 1024 + k4) : *(const float4*)(p.in[I_CS] + (s - 8) * 1024 + k4);
      *(float4*)(cL + s * 1024 + k4) = v;
    }
    __syncthreads();
    for (int item = blockIdx.x; item < 96; item += gridDim.x) {
      const int l = item / 48, j0 = (item % 48) * 64;
      const float* W = (l == 0 ? p.in[I_AADAW] : p.in[I_BADAW]);
      const float* bias = (l == 0 ? p.in[I_AADAB] : p.in[I_BADAB]);
      const int col = tid & 63, kg = tid >> 6;
      float acc[24];
#pragma unroll
      for (int s = 0; s < 24; ++s) acc[s] = 0.f;
      for (int k = kg * 128; k < kg * 128 + 128; ++k) {
        float w = W[(size_t)k * 3072 + j0 + col];
#pragma unroll
        for (int s = 0; s < 24; ++s) acc[s] += cL[s * 1024 + k] * w;
      }
#pragma unroll
      for (int s = 0; s < 24; ++s) red[(kg * 24 + s) * 64 + col] = acc[s];
      __syncthreads();
      float* mod = (float*)(ws + WS_MOD);
      for (int e = tid; e < 24 * 64; e += NTHREADS) {
        int s = e >> 6, c = e & 63;
        float t = bias[j0 + c];
#pragma unroll
        for (int g = 0; g < 8; ++g) t += red[(g * 24 + s) * 64 + c];
        mod[(size_t)(l * 24 + s) * 3072 + j0 + c] = t;
      }
      __syncthreads();
    }
  }
  if (blockIdx.x == 0) for (int e = tid; e < 1024; e += NTHREADS) ((unsigned*)(ws + WS_CTR))[e] = 0u;
  if (blockIdx.x == gridDim.x - 1) {
    u16* SH = (u16*)(ws + WS_SH);
    for (int e = tid; e < 24 * 1024; e += NTHREADS) {
      int s = e >> 10, k = e & 1023;
      float v = s < 8 ? 0.f : p.in[I_SSH][(s - 8) * 1024 + k];
      SH[e] = (u16)(pack2(v, 0.f) & 0xffff);
    }
  }
  const int NW = 512 + 128 + 256 + 256 + 128 + 8 + 8;
  for (int t = blockIdx.x; t < NW + 64; t += gridDim.x) {
    if (t < NW) {
      const float* src; int K, N; u16* dst; int dstride; int tt = t;
      if (tt < 512) { src = p.in[I_AWIN]; K = 1024; N = 8192; dst = (u16*)(ws + WS_WT_IN); dstride = 1024; }
      else if ((tt -= 512) < 128) { src = p.in[I_AWOUT]; K = 2048; N = 1024; dst = (u16*)(ws + WS_WT_OUTA); dstride = 2048; }
      else if ((tt -= 128) < 256) { src = p.in[I_KVW]; K = 1024; N = 4096; dst = (u16*)(ws + WS_WT_KV); dstride = 1024; }
      else if ((tt -= 256) < 256) { src = p.in[I_BWIN]; K = 1024; N = 4096; dst = (u16*)(ws + WS_WT_INB); dstride = 1024; }
      else if ((tt -= 256) < 128) { src = p.in[I_BWOUT]; K = 2048; N = 1024; dst = (u16*)(ws + WS_WT_OUTB); dstride = 2048; }
      else if ((tt -= 128) < 8) { src = p.in[I_AW2]; K = 64; N = 2048; dst = (u16*)(ws + WS_W2T); dstride = 64; }
      else { tt -= 8; src = p.in[I_AA2]; K = 64; N = 2048; dst = (u16*)(ws + WS_A2T); dstride = 64; }
      const int ntn = N / 256;
      (void)K;
      transpose_tile_wide(src, N, (tt / ntn) * 64, (tt % ntn) * 256, dst, dstride, smem);
    } else {
      int tt = t - NW;
      const int job = tt >> 4; tt &= 15;
      const float* src = (job < 2) ? p.in[I_AW1] : p.in[I_AA1];
      const float* scale = nullptr; int dcol0 = 0;
      if (job & 1) { dcol0 = 1024; scale = (job < 2) ? p.in[I_AMUW] : p.in[I_AMUA]; }
      transpose_tile(src, 64, tt * 64, 0, scale, (u16*)(ws + WS_L1T), 2048, (job < 2) ? 0 : 64, dcol0, smem);
    }
  }
}

DEV void phase_norm0(const Params& p) {
  const int lane = threadIdx.x & 63, wid = threadIdx.x >> 6;
  const float* mod = (const float*)(p.ws + WS_MOD);
  u16* H0 = (u16*)(p.ws + WS_H0);
  const float* g = p.in[I_ANG];
  for (int t = blockIdx.x * 8 + wid; t < NTOK; t += gridDim.x * 8) {
    const float* x = t < TP ? p.in[I_XP] + (size_t)t * 1024 : p.in[I_XS] + (size_t)(t - TP) * 1024;
    const int s = seq_of(t);
    const float* md = mod + (size_t)s * 3072;
    float4 v[4];
    float ss = 0.f;
#pragma unroll
    for (int i = 0; i < 4; ++i) {
      v[i] = *(const float4*)(x + lane * 4 + 256 * i);
      ss += v[i].x * v[i].x + v[i].y * v[i].y + v[i].z * v[i].z + v[i].w * v[i].w;
    }
    ss = wave_sum(ss);
    const float rstd = rsqrtf(ss * (1.0f / 1024.0f) + 1e-6f);
    bool last = t < TP ? ((t & 4095) == 4095) : (((t - TP) & 31) == 31);
    float* so = t < TP ? p.out + OFF_SH_P + (t >> 12) * 1024 : p.out + OFF_SH_S + ((t - TP) >> 5) * 1024;
#pragma unroll
    for (int i = 0; i < 4; ++i) {
      const int c = lane * 4 + 256 * i;
      float4 gg = *(const float4*)(g + c), sh = *(const float4*)(md + c), sc = *(const float4*)(md + 1024 + c);
      float4 h;
      h.x = v[i].x * rstd * gg.x * (1.f + sc.x) + sh.x;
      h.y = v[i].y * rstd * gg.y * (1.f + sc.y) + sh.y;
      h.z = v[i].z * rstd * gg.z * (1.f + sc.z) + sh.z;
      h.w = v[i].w * rstd * gg.w * (1.f + sc.w) + sh.w;
      uint2 o; o.x = pack2(h.x, h.y); o.y = pack2(h.z, h.w);
      *(uint2*)(H0 + (size_t)t * 1024 + c) = o;
      if (last) *(float4*)(so + c) = h;
    }
  }
}

DEV void phase_proj0_lora(const Params& p, char* smem) {
  const int tid = threadIdx.x, lane = tid & 63, wid = tid >> 6, fr = lane & 15, fq = lane >> 4;
  const int wr = wid >> 1, wc = wid & 1;
  char* ws = p.ws;
  const u16* H0 = (const u16*)(ws + WS_H0);
  const u16* SH = (const u16*)(ws + WS_SH);
  u16* T = (u16*)(ws + WS_T);
  const int xcc0 = xcc_id();
  int nxt;
  f32x4 acc[4][4];
  for (int ls = 0; ls < 8; ++ls) {
  const int xcd = (xcc0 + ls) & 7;
  unsigned* ctr = sched_ctr(p, 0, xcd);
  for (int li = sched_first(ctr, smem); li < 17; li = sched_commit(nxt, smem)) {
    nxt = sched_prefetch(ctr);
    const int lmt = xcd + 8 * li;
    if (lmt >= 130) continue;
    const int m0 = lmt * 256;
    gemm_main<2>(acc, H0, 1024, (const u16*)(ws + WS_L1T), 2048, 32, m0, 0, nullptr, SH, smem);
#pragma unroll
    for (int i = 0; i < 4; ++i)
#pragma unroll
      for (int j = 0; j < 4; ++j) {
        const int m = m0 + wr * 64 + i * 16 + fr, n = wc * 64 + j * 16 + fq * 4;
        f32x4 v = acc[i][j];
        if (wc == 0) { v[0] = tanhf(v[0]); v[1] = tanhf(v[1]); v[2] = tanhf(v[2]); v[3] = tanhf(v[3]); }
        uint2 o; o.x = pack2(v[0], v[1]); o.y = pack2(v[2], v[3]);
        *(uint2*)(T + (size_t)m * 128 + n) = o;
      }
  }
  }
}

DEV void phase_proj0_main(const Params& p, char* smem) {
  const int tid = threadIdx.x, lane = tid & 63, wid = tid >> 6, fr = lane & 15, fq = lane >> 4;
  const int wr = wid >> 2, wc = wid & 3;
  char* ws = p.ws;
  const u16* H0 = (const u16*)(ws + WS_H0);
  const u16* SH = (const u16*)(ws + WS_SH);
  const int xcc0 = xcc_id();
  int nxt;
  f32x4 acc[8][4];
  for (int ls = 0; ls < 8; ++ls) {
  const int xcd = (xcc0 + ls) & 7;
  unsigned* ctr = sched_ctr(p, 4, xcd);
  for (int q = sched_first(ctr, smem); q < 520; q = sched_commit(nxt, smem)) {
    nxt = sched_prefetch(ctr);
    const int mt = q >> 2, nt = 4 * xcd + (q & 3);
    const int part = nt >> 3;
    const int m0 = mt * 256, n0 = nt * 256;
    gemm_main256<1>(acc, H0, 1024, (const u16*)(ws + WS_WT_IN), 1024, 16, m0, n0, p.in[I_AMUIN] + part * 1024, SH, smem);
    u16* dst = (u16*)(ws + (size_t)part * SLOT);
    const int nb = n0 - part * 2048;
#pragma unroll
    for (int i = 0; i < 8; ++i)
#pragma unroll
      for (int j = 0; j < 4; ++j) {
        const int row = wr * 128 + i * 16 + fr, col = wc * 64 + j * 16 + fq * 4;
        f32x4 v = acc[i][j];
        uint2 o; o.x = pack2(v[0], v[1]); o.y = pack2(v[2], v[3]);
        *(uint2*)(smem + row * 528 + col * 2) = o;
      }
    __syncthreads();
#pragma unroll
    for (int qq = 0; qq < 16; ++qq) {
      const int c = tid + 512 * qq, row = c >> 5, ch = c & 31;
      const uint4 v = *(const uint4*)(smem + row * 528 + ch * 16);
      *(uint4*)(dst + (size_t)(m0 + row) * 2048 + nb + ch * 8) = v;
    }
    __syncthreads();
  }
  }
}

DEV void phase_proj0(const Params& p, char* smem) {
  phase_proj0_lora(p, smem);
  phase_proj0_main(p, smem);
}

DEV void phase_scan(const Params& p, char* smem) {
  const int tid = threadIdx.x, lane = tid & 63, wid = tid >> 6;
  u16* Hkk = (u16*)smem;
  u16* Hw = Hkk + 4096;
  u16* Hb = Hw + 4096;
  u16* Hk = Hb + 4096;
  u16* Hwr = Hk + 4096;
  unsigned* Hv2 = (unsigned*)(smem + 40960);
  float* LY = (float*)(smem + 57344);
  float* Lbon = LY + 8192;
  float* Lsc = Lbon + 64;
  float* Lwa = Lsc + 128;
  char* ws = p.ws;
  const u16* gR = (const u16*)(ws + 0 * SLOT);
  const u16* gK = (const u16*)(ws + 1 * SLOT);
  const u16* gV = (const u16*)(ws + 2 * SLOT);
  const u16* gZ = (const u16*)(ws + 3 * SLOT);
  const u16* gT = (const u16*)(ws + WS_T);
  const u16* W2T = (const u16*)(ws + WS_W2T);
  const u16* A2T = (const u16*)(ws + WS_A2T);
  const int fr = lane & 15, fq = lane >> 4, lmt = wid & 3, lnh = wid >> 2;
  u16* YG = (u16*)(ws + 6 * SLOT);
  const int tt = tid >> 3, c8 = (tid & 7) * 8;
  const int srow = tid >> 3, kc = tid & 7;

  for (int item = blockIdx.x; item < 768; item += gridDim.x) {
    int h, tok0, nsteps; const float* sinit; float* sout;
    if (item < 256) { h = item & 31; tok0 = (item >> 5) * 4096; nsteps = 4096; sinit = nullptr; sout = p.out + OFF_WKV_P + (size_t)item * 4096; }
    else { int it = item - 256; h = it & 31; tok0 = TP + (it >> 5) * 32; nsteps = 32; sinit = p.in[I_SWKV] + (size_t)it * 4096; sout = p.out + OFF_WKV_S + (size_t)it * 4096; }
    const int nch = (nsteps + 63) >> 6;
    const int col0 = h * 64 + c8;
    float ckk[8], cka[8], crk[8], clg[8], clb[8];
    {
      float4 t0, t1;
      t0 = *(const float4*)(p.in[I_AKK] + col0); t1 = *(const float4*)(p.in[I_AKK] + col0 + 4);
      ckk[0] = t0.x; ckk[1] = t0.y; ckk[2] = t0.z; ckk[3] = t0.w; ckk[4] = t1.x; ckk[5] = t1.y; ckk[6] = t1.z; ckk[7] = t1.w;
      t0 = *(const float4*)(p.in[I_AKA] + col0); t1 = *(const float4*)(p.in[I_AKA] + col0 + 4);
      cka[0] = t0.x; cka[1] = t0.y; cka[2] = t0.z; cka[3] = t0.w; cka[4] = t1.x; cka[5] = t1.y; cka[6] = t1.z; cka[7] = t1.w;
      t0 = *(const float4*)(p.in[I_ARK] + col0); t1 = *(const float4*)(p.in[I_ARK] + col0 + 4);
      crk[0] = t0.x; crk[1] = t0.y; crk[2] = t0.z; crk[3] = t0.w; crk[4] = t1.x; crk[5] = t1.y; crk[6] = t1.z; crk[7] = t1.w;
      t0 = *(const float4*)(p.in[I_ALNG] + col0); t1 = *(const float4*)(p.in[I_ALNG] + col0 + 4);
      clg[0] = t0.x; clg[1] = t0.y; clg[2] = t0.z; clg[3] = t0.w; clg[4] = t1.x; clg[5] = t1.y; clg[6] = t1.z; clg[7] = t1.w;
      t0 = *(const float4*)(p.in[I_ALNB] + col0); t1 = *(const float4*)(p.in[I_ALNB] + col0 + 4);
      clb[0] = t0.x; clb[1] = t0.y; clb[2] = t0.z; clb[3] = t0.w; clb[4] = t1.x; clb[5] = t1.y; clb[6] = t1.z; clb[7] = t1.w;
    }
    float cw0[8], ca0[8];
    {
      float4 t0 = *(const float4*)(p.in[I_AW0] + col0), t1 = *(const float4*)(p.in[I_AW0] + col0 + 4);
      cw0[0] = t0.x; cw0[1] = t0.y; cw0[2] = t0.z; cw0[3] = t0.w; cw0[4] = t1.x; cw0[5] = t1.y; cw0[6] = t1.z; cw0[7] = t1.w;
      t0 = *(const float4*)(p.in[I_AA0] + col0); t1 = *(const float4*)(p.in[I_AA0] + col0 + 4);
      ca0[0] = t0.x; ca0[1] = t0.y; ca0[2] = t0.z; ca0[3] = t0.w; ca0[4] = t1.x; ca0[5] = t1.y; ca0[6] = t1.z; ca0[7] = t1.w;
    }
    bf16x8 w2f[2][2], a2f[2][2];
#pragma unroll
    for (int n2 = 0; n2 < 2; ++n2)
#pragma unroll
      for (int ks = 0; ks < 2; ++ks) {
        const size_t o_ = (size_t)(h * 64 + lnh * 32 + n2 * 16 + fr) * 64 + ks * 32 + fq * 8;
        w2f[n2][ks] = *(const bf16x8*)(W2T + o_);
        a2f[n2][ks] = *(const bf16x8*)(A2T + o_);
      }
    h2_t sa_, sb_, sc_, sd_;
    if (sinit) {
      float4 a = *(const float4*)(sinit + srow * 64 + kc * 8), b = *(const float4*)(sinit + srow * 64 + kc * 8 + 4);
      sa_ = (h2_t){(_Float16)a.x, (_Float16)a.y}; sb_ = (h2_t){(_Float16)a.z, (_Float16)a.w};
      sc_ = (h2_t){(_Float16)b.x, (_Float16)b.y}; sd_ = (h2_t){(_Float16)b.z, (_Float16)b.w};
    } else {
      sa_ = sb_ = sc_ = sd_ = (h2_t){(_Float16)0.f, (_Float16)0.f};
    }
    uint4 cr, ck, cv, cz;
    bf16x8 t1f[2], t2f[2];
#define SCAN_LOAD(c)                                                                   \
    {                                                                                  \
      const int tl_ = (c) * 64 + tt;                                                   \
      if (tl_ < nsteps) {                                                              \
        const size_t o_ = (size_t)(tok0 + tl_) * 2048 + col0;                          \
        cr = *(const uint4*)(gR + o_); ck = *(const uint4*)(gK + o_); cv = *(const uint4*)(gV + o_); \
        cz = *(const uint4*)(gZ + o_);                                                 \
      } else { cr = ck = cv = cz = make_uint4(0, 0, 0, 0); }                           \
      const int tm_ = (c) * 64 + lmt * 16 + fr;                                        \
      if (tm_ < nsteps) {                                                              \
        const u16* tp_ = gT + (size_t)(tok0 + tm_) * 128 + fq * 8;                     \
        t1f[0] = *(const bf16x8*)(tp_); t1f[1] = *(const bf16x8*)(tp_ + 32);           \
        t2f[0] = *(const bf16x8*)(tp_ + 64); t2f[1] = *(const bf16x8*)(tp_ + 96);      \
      } else { t1f[0] = t1f[1] = t2f[0] = t2f[1] = (bf16x8){0, 0, 0, 0, 0, 0, 0, 0}; } \
    }
    SCAN_LOAD(0);
    for (int c = 0; c < nch; ++c) {
      {
#pragma unroll
        for (int n2 = 0; n2 < 2; ++n2) {
          f32x4 xw = {0.f, 0.f, 0.f, 0.f}, xa = {0.f, 0.f, 0.f, 0.f};
          xw = __builtin_amdgcn_mfma_f32_16x16x32_bf16(w2f[n2][0], t1f[0], xw, 0, 0, 0);
          xw = __builtin_amdgcn_mfma_f32_16x16x32_bf16(w2f[n2][1], t1f[1], xw, 0, 0, 0);
          xa = __builtin_amdgcn_mfma_f32_16x16x32_bf16(a2f[n2][0], t2f[0], xa, 0, 0, 0);
          xa = __builtin_amdgcn_mfma_f32_16x16x32_bf16(a2f[n2][1], t2f[1], xa, 0, 0, 0);
          const int o_ = (lmt * 16 + fr) * 64 + lnh * 32 + n2 * 16 + fq * 4;
          *(float4*)(Lwa + o_) = make_float4(xw[0], xw[1], xw[2], xw[3]);
          *(float4*)(Lwa + 4096 + o_) = make_float4(xa[0], xa[1], xa[2], xa[3]);
        }
      }
      __syncthreads();
      uint4 zc = cz;
      {
        float r[8], k[8], v[8], lw[8], a[8];
        unpack8(cr, r); unpack8(ck, k); unpack8(cv, v);
        {
          const float4 x0 = *(const float4*)(Lwa + tt * 64 + c8), x1 = *(const float4*)(Lwa + tt * 64 + c8 + 4);
          const float4 y0 = *(const float4*)(Lwa + 4096 + tt * 64 + c8), y1 = *(const float4*)(Lwa + 4096 + tt * 64 + c8 + 4);
          const float xw_[8] = {x0.x, x0.y, x0.z, x0.w, x1.x, x1.y, x1.z, x1.w};
          const float xa_[8] = {y0.x, y0.y, y0.z, y0.w, y1.x, y1.y, y1.z, y1.w};
#pragma unroll
          for (int j = 0; j < 8; ++j) {
            lw[j] = -0.60653066f * sigmoidf_(cw0[j] + xw_[j]);
            a[j] = sigmoidf_(ca0[j] + xa_[j]);
          }
        }
        float kkv[8], kp[8], w[8], bon = 0.f, ss = 0.f, kr = 0.f;
#pragma unroll
        for (int j = 0; j < 8; ++j) {
          kkv[j] = k[j] * ckk[j]; ss += kkv[j] * kkv[j];
          kp[j] = k[j] * (1.f + (a[j] - 1.f) * cka[j]);
          bon += r[j] * kp[j] * crk[j];
          kr += r[j] * kp[j];
          w[j] = __expf(lw[j]);
        }
        ss = red8(ss); bon = red8(bon); kr = red8(kr);
        const float inv = rsqrtf(ss + 1e-12f);
        float bb[8], br = 0.f;
#pragma unroll
        for (int j = 0; j < 8; ++j) { kkv[j] *= inv; bb[j] = kkv[j] * a[j]; br += bb[j] * r[j]; }
        br = red8(br);
        const int ho = tt * 64 + c8;
        *(uint4*)(Hkk + ho) = make_uint4(packh2(kkv[0], kkv[1]), packh2(kkv[2], kkv[3]), packh2(kkv[4], kkv[5]), packh2(kkv[6], kkv[7]));
        *(uint4*)(Hb + ho) = make_uint4(packh2(bb[0], bb[1]), packh2(bb[2], bb[3]), packh2(bb[4], bb[5]), packh2(bb[6], bb[7]));
        *(uint4*)(Hw + ho) = make_uint4(packh2(w[0], w[1]), packh2(w[2], w[3]), packh2(w[4], w[5]), packh2(w[6], w[7]));
        *(uint4*)(Hk + ho) = make_uint4(packh2(kp[0], kp[1]), packh2(kp[2], kp[3]), packh2(kp[4], kp[5]), packh2(kp[6], kp[7]));
        *(uint4*)(Hwr + ho) = make_uint4(packh2(w[0] * r[0], w[1] * r[1]), packh2(w[2] * r[2], w[3] * r[3]), packh2(w[4] * r[4], w[5] * r[5]), packh2(w[6] * r[6], w[7] * r[7]));
        *(uint4*)(Hv2 + ho) = make_uint4(packh2(v[0], v[0]), packh2(v[1], v[1]), packh2(v[2], v[2]), packh2(v[3], v[3]));
        *(uint4*)(Hv2 + ho + 4) = make_uint4(packh2(v[4], v[4]), packh2(v[5], v[5]), packh2(v[6], v[6]), packh2(v[7], v[7]));
        if ((tid & 7) == 0) { Lbon[tt] = bon; *(float2*)(Lsc + tt * 2) = make_float2(br, kr); }
      }
      __syncthreads();
      if (c + 1 < nch) SCAN_LOAD(c + 1);
      {
        const int nT = min(64, nsteps - c * 64);
        const u16* pk = Hkk + kc * 8; const u16* pw = Hw + kc * 8; const u16* pb = Hb + kc * 8;
        const u16* pkp = Hk + kc * 8; const u16* pwr = Hwr + kc * 8; const unsigned* pv = Hv2 + srow;
        float* py = LY + srow * 2;
#define SCAN_LD(S, o)                                                                  \
        S##kk = *(const uint4*)(pk + (o)); S##w = *(const uint4*)(pw + (o)); S##b = *(const uint4*)(pb + (o)); \
        S##k = *(const uint4*)(pkp + (o)); S##wr = *(const uint4*)(pwr + (o)); S##v = pv[(o)];
#define H2(x) (*(const h2_t*)&(x))
#define SCAN_UPD(sreg, S, c)                                                           \
        sreg = __builtin_elementwise_fma(sreg, H2(S##w.c), __builtin_elementwise_fma(-n_, H2(S##b.c), H2(S##v) * H2(S##k.c)));
#define SCAN_STEP(S, o)                                                                \
        {                                                                              \
          float d = __builtin_amdgcn_fdot2(sa_, H2(S##kk.x), 0.f, false);              \
          float e = __builtin_amdgcn_fdot2(sa_, H2(S##wr.x), 0.f, false);              \
          d = __builtin_amdgcn_fdot2(sb_, H2(S##kk.y), d, false); e = __builtin_amdgcn_fdot2(sb_, H2(S##wr.y), e, false); \
          d = __builtin_amdgcn_fdot2(sc_, H2(S##kk.z), d, false); e = __builtin_amdgcn_fdot2(sc_, H2(S##wr.z), e, false); \
          d = __builtin_amdgcn_fdot2(sd_, H2(S##kk.w), d, false); e = __builtin_amdgcn_fdot2(sd_, H2(S##wr.w), e, false); \
          d += dppf<0xB1>(d); e += dppf<0xB1>(e);                                      \
          d += dppf<0x4E>(d); e += dppf<0x4E>(e);                                      \
          d += dppf<0x141>(d); e += dppf<0x141>(e);                                    \
          const unsigned nu_ = packh2(d, d);                                           \
          const h2_t n_ = H2(nu_);                                                     \
          SCAN_UPD(sa_, S, x) SCAN_UPD(sb_, S, y) SCAN_UPD(sc_, S, z) SCAN_UPD(sd_, S, w) \
          if (kc == 0) *(float2*)(py + 2 * (o)) = make_float2(e, d);                   \
        }
        uint4 Akk, Aw, Ab, Ak, Awr, Bkk, Bw, Bb, Bk, Bwr; unsigned Av, Bv;
        SCAN_LD(A, 0);
        for (int t = 0; t < nT; t += 2) {
          SCAN_LD(B, (t + 1) * 64);
          SCAN_STEP(A, t * 64);
          SCAN_LD(A, (t + 2) * 64);
          SCAN_STEP(B, (t + 1) * 64);
        }
#undef SCAN_UPD
#undef H2
#undef SCAN_LD
#undef SCAN_STEP
      }
      __syncthreads();
      {
        const int tl = c * 64 + tt;
        if (tl < nsteps) {
          float y[8], z[8];
          const float2 sc = *(const float2*)(Lsc + tt * 2);
          const uint4 va = *(const uint4*)(Hv2 + tt * 64 + c8), vb = *(const uint4*)(Hv2 + tt * 64 + c8 + 4);
          float vv[8];
          { const unsigned vu[8] = {va.x, va.y, va.z, va.w, vb.x, vb.y, vb.z, vb.w};
#pragma unroll
            for (int j = 0; j < 8; ++j) { h2_t t_ = *(const h2_t*)&vu[j]; vv[j] = (float)t_[0]; } }
#pragma unroll
          for (int q = 0; q < 4; ++q) {
            const float4 ed = *(const float4*)(LY + tt * 128 + (c8 + 2 * q) * 2);
            y[2 * q] = ed.x - ed.y * sc.x + vv[2 * q] * sc.y;
            y[2 * q + 1] = ed.z - ed.w * sc.x + vv[2 * q + 1] * sc.y;
          }
          float sm = y[0] + y[1] + y[2] + y[3] + y[4] + y[5] + y[6] + y[7];
          sm = red8(sm);
          const float mean = sm * (1.f / 64.f);
          float vs = 0.f;
#pragma unroll
          for (int j = 0; j < 8; ++j) { y[j] -= mean; vs += y[j] * y[j]; }
          vs = red8(vs);
          const float rstd = rsqrtf(vs * (1.f / 64.f) + 64e-5f);
          const float bon = Lbon[tt];
          unpack8(zc, z);
          float o[8];
#pragma unroll
          for (int j = 0; j < 8; ++j) {
            float t = y[j] * rstd * clg[j] + clb[j] + bon * vv[j];
            o[j] = t * z[j] * sigmoidf_(z[j]);
          }
          uint4 ov; ov.x = pack2(o[0], o[1]); ov.y = pack2(o[2], o[3]); ov.z = pack2(o[4], o[5]); ov.w = pack2(o[6], o[7]);
          *(uint4*)(YG + (size_t)(tok0 + tl) * 2048 + col0) = ov;
        }
      }
      __syncthreads();
    }
#undef SCAN_LOAD
    *(float4*)(sout + srow * 64 + kc * 8) = make_float4((float)sa_[0], (float)sa_[1], (float)sb_[0], (float)sb_[1]);
    *(float4*)(sout + srow * 64 + kc * 8 + 4) = make_float4((float)sc_[0], (float)sc_[1], (float)sd_[0], (float)sd_[1]);
  }
}

template <int LAYER>
DEV void outproj_store(const Params& p, const float* mod, float* xmid, int m, int n, f32x4 v) {
  const float* gate = mod + (size_t)seq_of(m) * 3072 + 2048;
  float4 g4 = *(const float4*)(gate + n);
  if (LAYER == 0) {
    const float* xr = m < TP ? p.in[I_XP] + (size_t)m * 1024 : p.in[I_XS] + (size_t)(m - TP) * 1024;
    float4 x4 = *(const float4*)(xr + n);
    *(float4*)(xmid + (size_t)m * 1024 + n) = make_float4(x4.x + g4.x * v[0], x4.y + g4.y * v[1], x4.z + g4.z * v[2], x4.w + g4.w * v[3]);
  } else {
    float4 x4 = *(const float4*)(xmid + (size_t)m * 1024 + n);
    float* yo = m < TP ? p.out + OFF_Y_P + (size_t)m * 1024 : p.out + OFF_Y_S + (size_t)(m - TP) * 1024;
    const f32x4 yv = {x4.x + g4.x * v[0], x4.y + g4.y * v[1], x4.z + g4.z * v[2], x4.w + g4.w * v[3]};
    __builtin_nontemporal_store(yv, (f32x4*)(yo + n));
  }
}

template <int LAYER>
DEV void phase_outproj_main(const Params& p, char* smem) {
  const int tid = threadIdx.x, lane = tid & 63, wid = tid >> 6, wr = wid >> 2, wc = wid & 3, fr = lane & 15, fq = lane >> 4;
  char* ws = p.ws;
  const u16* A = (const u16*)(ws + 6 * SLOT);
  const u16* Bt = (const u16*)(ws + (LAYER == 0 ? WS_WT_OUTA : WS_WT_OUTB));
  const float* mod = (const float*)(ws + WS_MOD) + (size_t)LAYER * 24 * 3072;
  float* xmid = (float*)(ws + 0 * SLOT);
  f32x4 acc[8][4];
  const int xcc0 = xcc_id();
  int nxt;
  for (int ls = 0; ls < 8; ++ls) {
    const int xcd = (xcc0 + ls) & 7;
    unsigned* ctr = sched_ctr(p, LAYER == 0 ? 1 : 3, xcd);
    for (int li = sched_first(ctr, smem); li < 64; li = sched_commit(nxt, smem)) {
      nxt = sched_prefetch(ctr);
      const int item = 64 * xcd + li;
      const int m0 = (item >> 2) * 256, n0 = (item & 3) * 256;
      gemm_main256_dma(acc, A, 2048, Bt, 2048, 32, m0, n0, smem);
#pragma unroll
      for (int i = 0; i < 8; ++i)
#pragma unroll
        for (int j = 0; j < 4; ++j)
          outproj_store<LAYER>(p, mod, xmid, m0 + wr * 128 + i * 16 + fr, n0 + wc * 64 + j * 16 + fq * 4, acc[i][j]);
    }
  }
}

template <int LAYER>
DEV void phase_outproj_tail(const Params& p, char* smem) {
  const int tid = threadIdx.x, lane = tid & 63, wid = tid >> 6, wr = wid >> 1, wc = wid & 1, fr = lane & 15, fq = lane >> 4;
  char* ws = p.ws;
  const u16* A = (const u16*)(ws + 6 * SLOT);
  const u16* Bt = (const u16*)(ws + (LAYER == 0 ? WS_WT_OUTA : WS_WT_OUTB));
  const float* mod = (const float*)(ws + WS_MOD) + (size_t)LAYER * 24 * 3072;
  float* xmid = (float*)(ws + 0 * SLOT);
  f32x4 acc[4][4];
  const int xcc0 = xcc_id();
  int nxt;
  for (int ls = 0; ls < 8; ++ls) {
    const int xcd = (xcc0 + ls) & 7;
    unsigned* ctr = sched_ctr(p, LAYER == 0 ? 5 : 6, xcd);
    for (int li = sched_first(ctr, smem); li < 2; li = sched_commit(nxt, smem)) {
      nxt = sched_prefetch(ctr);
      const int item = 2 * xcd + li;
      const int m0 = (128 + (item >> 3)) * 256, n0 = (item & 7) * 128;
      gemm_main<0>(acc, A, 2048, Bt, 2048, 32, m0, n0, nullptr, nullptr, smem);
#pragma unroll
      for (int i = 0; i < 4; ++i)
#pragma unroll
        for (int j = 0; j < 4; ++j)
          outproj_store<LAYER>(p, mod, xmid, m0 + wr * 64 + i * 16 + fr, n0 + wc * 64 + j * 16 + fq * 4, acc[i][j]);
    }
  }
}

template <int LAYER>
DEV void phase_outproj(const Params& p, char* smem) {
  phase_outproj_tail<LAYER>(p, smem);
  phase_outproj_main<LAYER>(p, smem);
}

DEV void phase_norm1(const Params& p) {
  const int lane = threadIdx.x & 63, wid = threadIdx.x >> 6;
  const float* mod = (const float*)(p.ws + WS_MOD) + (size_t)24 * 3072;
  const float* xmid = (const float*)(p.ws + 0 * SLOT);
  u16* AKV = (u16*)(p.ws + 1 * SLOT);
  u16* AQ = AKV + (size_t)NTOK * 1024;
  const float* gkv = p.in[I_KVNG];
  const float* gb = p.in[I_BNG];
  for (int t = blockIdx.x * 8 + wid; t < NTOK; t += gridDim.x * 8) {
    const float* x = xmid + (size_t)t * 1024;
    const float* md = mod + (size_t)seq_of(t) * 3072;
    float4 v[4];
    float ss = 0.f;
#pragma unroll
    for (int i = 0; i < 4; ++i) {
      v[i] = *(const float4*)(x + lane * 4 + 256 * i);
      ss += v[i].x * v[i].x + v[i].y * v[i].y + v[i].z * v[i].z + v[i].w * v[i].w;
    }
    ss = wave_sum(ss);
    const float rstd = rsqrtf(ss * (1.0f / 1024.0f) + 1e-6f);
#pragma unroll
    for (int i = 0; i < 4; ++i) {
      const int c = lane * 4 + 256 * i;
      float4 g1 = *(const float4*)(gkv + c), g2 = *(const float4*)(gb + c), sh = *(const float4*)(md + c), sc = *(const float4*)(md + 1024 + c);
      float xn0 = v[i].x * rstd, xn1 = v[i].y * rstd, xn2 = v[i].z * rstd, xn3 = v[i].w * rstd;
      uint2 o;
      o.x = pack2(xn0 * g1.x, xn1 * g1.y); o.y = pack2(xn2 * g1.z, xn3 * g1.w);
      *(uint2*)(AKV + (size_t)t * 1024 + c) = o;
      o.x = pack2(xn0 * g2.x * (1.f + sc.x) + sh.x, xn1 * g2.y * (1.f + sc.y) + sh.y);
      o.y = pack2(xn2 * g2.z * (1.f + sc.z) + sh.z, xn3 * g2.w * (1.f + sc.w) + sh.w);
      *(uint2*)(AQ + (size_t)t * 1024 + c) = o;
    }
  }
}

#define QSCALE (0.08838834764831845f * 1.4426950408889634f)
DEV void phase_proj1(const Params& p, char* smem) {
  const int tid = threadIdx.x, lane = tid & 63, wid = tid >> 6, wr = wid >> 2, wc = wid & 3, fr = lane & 15, fq = lane >> 4;
  char* ws = p.ws;
  const u16* AKV = (const u16*)(ws + 1 * SLOT);
  const u16* AQ = AKV + (size_t)NTOK * 1024;
  u16* KB = (u16*)(ws + 2 * SLOT);
  u16* VB = (u16*)(ws + 3 * SLOT);
  u16* QB = (u16*)(ws + 4 * SLOT);
  u16* ZS = (u16*)(ws + 5 * SLOT);
  f32x4 acc[8][4];
  float* red = (float*)smem;
  const int xcc0 = xcc_id();
  int nxt;
  for (int ls = 0; ls < 8; ++ls) {
  const int xcd = (xcc0 + ls) & 7;
  unsigned* ctr = sched_ctr(p, 2, xcd);
  for (int li = sched_first(ctr, smem); li < 520; li = sched_commit(nxt, smem)) {
    nxt = sched_prefetch(ctr);
    const int mt = li >> 2, t = 4 * xcd + (li & 3);
    const int isq = t >> 4, nt = t & 15;
    const int m0 = mt * 256, n0 = nt * 256;
    gemm_main256_dma(acc, isq ? AQ : AKV, 1024, (const u16*)(ws + (isq ? WS_WT_INB : WS_WT_KV)), 1024, 16, m0, n0, smem);
    float rsv[8];
#pragma unroll
    for (int i = 0; i < 8; ++i) rsv[i] = 1.0f;
    if (nt < 8) {
#pragma unroll
      for (int i = 0; i < 8; ++i) {
        float ss = 0.f;
#pragma unroll
        for (int j = 0; j < 4; ++j) ss += acc[i][j][0] * acc[i][j][0] + acc[i][j][1] * acc[i][j][1] + acc[i][j][2] * acc[i][j][2] + acc[i][j][3] * acc[i][j][3];
        red[(wr * 128 + i * 16 + fr) * 16 + wc * 4 + fq] = ss;
      }
      __syncthreads();
#pragma unroll
      for (int i = 0; i < 8; ++i) {
        const int row = wr * 128 + i * 16 + fr;
        float4 ra = *(const float4*)(red + row * 16 + (wc >> 1) * 8), rb = *(const float4*)(red + row * 16 + (wc >> 1) * 8 + 4);
        float tot = ra.x + ra.y + ra.z + ra.w + rb.x + rb.y + rb.z + rb.w;
        rsv[i] = rsqrtf(tot * (1.f / 128.f) + 1e-6f) * (isq ? QSCALE : 1.0f);
      }
      __syncthreads();
      const float* gain = isq ? p.in[I_BQG] : p.in[I_KGAIN];
#pragma unroll
      for (int i = 0; i < 8; ++i) {
        const int row = wr * 128 + i * 16 + fr, m = m0 + row;
        const float rs = rsv[i];
#pragma unroll
        for (int j = 0; j < 4; ++j) {
          const int d = (wc & 1) * 64 + j * 16 + fq * 4, col = wc * 64 + j * 16 + fq * 4, n = n0 + col;
          float4 g4 = *(const float4*)(gain + d);
          f32x4 v = acc[i][j];
          float o0 = v[0] * rs * g4.x, o1 = v[1] * rs * g4.y, o2 = v[2] * rs * g4.z, o3 = v[3] * rs * g4.w;
          uint2 o; o.x = pack2(o0, o1); o.y = pack2(o2, o3);
          *(uint2*)(smem + row * 528 + col * 2) = o;
        }
      }
    } else {
#pragma unroll
      for (int i = 0; i < 8; ++i) {
        const int row = wr * 128 + i * 16 + fr, m = m0 + row;
#pragma unroll
        for (int j = 0; j < 4; ++j) {
          const int col = wc * 64 + j * 16 + fq * 4, n = n0 - 2048 + col;
          f32x4 v = acc[i][j];
          if (isq) {
            float o0 = v[0] * sigmoidf_(v[0]), o1 = v[1] * sigmoidf_(v[1]), o2 = v[2] * sigmoidf_(v[2]), o3 = v[3] * sigmoidf_(v[3]);
            uint2 o; o.x = pack2(o0, o1); o.y = pack2(o2, o3);
            *(uint2*)(smem + row * 528 + col * 2) = o;
          } else {
            uint2 o; o.x = pack2(v[0], v[1]); o.y = pack2(v[2], v[3]);
            *(uint2*)(smem + row * 528 + col * 2) = o;
          }
        }
      }
    }
    __syncthreads();
    {
      u16* bdst = isq ? (nt < 8 ? QB : ZS) : (nt < 8 ? KB : VB);
      const int nb = n0 - (nt < 8 ? 0 : 2048);
#pragma unroll 4
      for (int qq = 0; qq < 16; ++qq) {
        const int c = tid + 512 * qq, row = c >> 5, ch = c & 31;
        const uint4 v = *(const uint4*)(smem + row * 528 + ch * 16);
        *(uint4*)(bdst + (size_t)(m0 + row) * 2048 + nb + ch * 8) = v;
      }
    }
    __syncthreads();
    if (!isq) {
      const int nb = n0 - (nt < 8 ? 0 : 2048);
      float* fo = (m0 < TP) ? p.out + (nt < 8 ? OFF_K_P : OFF_V_P) + (size_t)m0 * 2048 : p.out + (nt < 8 ? OFF_K_S : OFF_V_S) + (size_t)(m0 - TP) * 2048;
      const float* gain = p.in[I_KGAIN];
#pragma unroll
      for (int half = 0; half < 2; ++half) {
        if (wr == half) {
#pragma unroll
          for (int i = 0; i < 8; ++i)
#pragma unroll
            for (int j = 0; j < 4; ++j) {
              const int row = i * 16 + fr, col = wc * 64 + j * 16 + fq * 4;
              float4 g4 = make_float4(1.f, 1.f, 1.f, 1.f);
              if (nt < 8) g4 = *(const float4*)(gain + (wc & 1) * 64 + j * 16 + fq * 4);
              const float rs = rsv[i];
              f32x4 v = acc[i][j];
              *(float4*)(smem + row * 1040 + col * 4) = make_float4(v[0] * rs * g4.x, v[1] * rs * g4.y, v[2] * rs * g4.z, v[3] * rs * g4.w);
            }
        }
        __syncthreads();
#pragma unroll 4
        for (int qq = 0; qq < 16; ++qq) {
          const int c = tid + 512 * qq, row = c >> 6, ch = c & 63;
          const f32x4 v = *(const f32x4*)(smem + row * 1040 + ch * 16);
          __builtin_nontemporal_store(v, (f32x4*)(fo + (size_t)(half * 128 + row) * 2048 + nb + ch * 4));
        }
        __syncthreads();
      }
    }
  }
  }
}

DEV unsigned off_b(unsigned row, unsigned ch) { return 256u * row + 16u * (ch ^ (((row & 3) << 2) | ((row >> 2) & 3))); }

DEV void phase_attn(const Params& p, char* smem) {
  const int tid = threadIdx.x, lane = tid & 63, w = tid >> 6, fr = lane & 15, fq = lane >> 4;
  char* ws = p.ws;
  const u16* KB = (const u16*)(ws + 2 * SLOT);
  const u16* VB = (const u16*)(ws + 3 * SLOT);
  const u16* QB = (const u16*)(ws + 4 * SLOT);
  const u16* ZS = (const u16*)(ws + 5 * SLOT);
  u16* OG = (u16*)(ws + 6 * SLOT);
  const int lrow = tid >> 4, lch = tid & 15;
  const unsigned lw0 = off_b(lrow, lch), lw1 = off_b(lrow + 32, lch);
  const int tq = (lane & 15) >> 2, tp = lane & 3;

  for (int item = blockIdx.x; item < 4096 + 256; item += gridDim.x) {
    int b, h, nq, qpos0, tokq0, ntiles, nkeys, tokk0; bool sample;
    if (item < 4096) {
      const int qblk = 31 - (item >> 7), bh = item & 127;
      b = bh >> 4; h = bh & 15; nq = 128; qpos0 = qblk * 128; tokq0 = b * 4096 + qpos0; ntiles = 2 * qblk + 2; nkeys = qpos0 + 128; tokk0 = b * 4096; sample = false;
    } else {
      const int bh = item - 4096;
      b = bh >> 4; h = bh & 15; nq = 32; qpos0 = 1024; tokq0 = TP + b * 32; ntiles = 17; nkeys = 1056; tokk0 = TP + b * 32 - 1024; sample = true;
    }
    const bool wactive = (w * 16) < nq;
    int* dflag = (int*)(smem + 65536);
    __syncthreads();
    if (lane == 0) dflag[w] = wactive ? 0 : 1;
    bool wdone = !wactive;
    const int qp = qpos0 + w * 16 + fr;
    const int qwmax = qpos0 + w * 16 + 15;
    bf16x8 qf[4];
#pragma unroll
    for (int ks = 0; ks < 4; ++ks) {
      if (wactive) qf[ks] = *(const bf16x8*)(QB + (size_t)(tokq0 + w * 16 + fr) * 2048 + h * 128 + ks * 32 + fq * 8);
      else qf[ks] = (bf16x8){0, 0, 0, 0, 0, 0, 0, 0};
    }
    f32x4 O[8];
#pragma unroll
    for (int dt = 0; dt < 8; ++dt) O[dt] = (f32x4){0, 0, 0, 0};
    float carry = 0.f;

    uint4 lk0, lk1, lv0, lv1;
#define ATT_LOAD(kb)                                                                                  \
    {                                                                                                 \
      const int kx0_ = (kb) * 64 + lrow, kx1_ = kx0_ + 32;                                            \
      if (sample && (kb) < 16) {                                                                      \
        const float* ck_ = p.in[I_CK] + ((size_t)(b * 1024 + kx0_) * 16 + h) * 128 + lch * 8;         \
        const float* cv_ = p.in[I_CV] + ((size_t)(b * 1024 + kx0_) * 16 + h) * 128 + lch * 8;         \
        float4 a_ = *(const float4*)ck_, b_ = *(const float4*)(ck_ + 4);                              \
        float4 c_ = *(const float4*)(ck_ + 32 * 2048), d_ = *(const float4*)(ck_ + 32 * 2048 + 4);    \
        lk0 = make_uint4(pack2(a_.x, a_.y), pack2(a_.z, a_.w), pack2(b_.x, b_.y), pack2(b_.z, b_.w)); \
        lk1 = make_uint4(pack2(c_.x, c_.y), pack2(c_.z, c_.w), pack2(d_.x, d_.y), pack2(d_.z, d_.w)); \
        a_ = *(const float4*)cv_; b_ = *(const float4*)(cv_ + 4);                                     \
        c_ = *(const float4*)(cv_ + 32 * 2048); d_ = *(const float4*)(cv_ + 32 * 2048 + 4);           \
        lv0 = make_uint4(pack2(a_.x, a_.y), pack2(a_.z, a_.w), pack2(b_.x, b_.y), pack2(b_.z, b_.w)); \
        lv1 = make_uint4(pack2(c_.x, c_.y), pack2(c_.z, c_.w), pack2(d_.x, d_.y), pack2(d_.z, d_.w)); \
      } else {                                                                                        \
        const size_t o0_ = (size_t)(tokk0 + kx0_) * 2048 + h * 128 + lch * 8;                         \
        const size_t o1_ = o0_ + (size_t)32 * 2048;                                                   \
        if (kx0_ < nkeys) { lk0 = *(const uint4*)(KB + o0_); lv0 = *(const uint4*)(VB + o0_); }       \
        else { lk0 = make_uint4(0, 0, 0, 0); lv0 = lk0; }                                             \
        if (kx1_ < nkeys) { lk1 = *(const uint4*)(KB + o1_); lv1 = *(const uint4*)(VB + o1_); }       \
        else { lk1 = make_uint4(0, 0, 0, 0); lv1 = lk1; }                                             \
      }                                                                                               \
    }
#define ATT_STORE(st)                                                                                 \
    {                                                                                                 \
      char* sK_ = smem + (st) * 32768; char* sV_ = sK_ + 16384;                                       \
      *(uint4*)(sK_ + lw0) = lk0; *(uint4*)(sK_ + lw1) = lk1;                                         \
      *(uint4*)(sV_ + lw0) = lv0; *(uint4*)(sV_ + lw1) = lv1;                                         \
    }
    ATT_LOAD(ntiles - 1);
    ATT_STORE(0);
    __syncthreads();
    for (int it = 0; it < ntiles; ++it) {
      const int kb = ntiles - 1 - it, st = it & 1;
      if (it + 1 < ntiles) ATT_LOAD(kb - 1);
      if (!wdone && kb * 64 < qwmax) {
        const char* sK = smem + st * 32768;
        const char* sV = sK + 16384;
        f32x4 S[4];
#pragma unroll
        for (int mt = 0; mt < 4; ++mt) S[mt] = (f32x4){0, 0, 0, 0};
#pragma unroll
        for (int ks = 0; ks < 4; ++ks)
#pragma unroll
          for (int mt = 0; mt < 4; ++mt) {
            bf16x8 a = *(const bf16x8*)(sK + off_b(mt * 16 + fr, ks * 4 + fq));
            S[mt] = __builtin_amdgcn_mfma_f32_16x16x32_bf16(a, qf[ks], S[mt], 0, 0, 0);
          }
        bf16x8 wf[2];
#define ATT_ELEM(MASKED) \
        { \
          float ee[4][4], tot[4], hi[4]; \
_Pragma("unroll") \
          for (int mt = 0; mt < 4; ++mt) { \
            const int kbase = kb * 64 + mt * 16 + fq * 4; \
            float ls[4]; \
_Pragma("unroll") \
            for (int jj = 0; jj < 4; ++jj) { \
              const float u = S[mt][jj]; \
              const bool valid = !(MASKED) || ((kbase + jj) < qp); \
              const float l = -__builtin_amdgcn_logf(1.0f + __builtin_amdgcn_exp2f(u)); \
              ls[jj] = valid ? l : 0.f; \
              ee[mt][jj] = valid ? (u + l) : -1e30f; \
            } \
            const float x3 = ls[3], x2 = x3 + ls[2], x1 = x2 + ls[1], seg = x1 + ls[0]; \
            ee[mt][2] += x3; ee[mt][1] += x2; ee[mt][0] += x1; \
            const float t1 = __shfl_xor(seg, 16), t2 = __shfl_xor(seg, 32), t3 = __shfl_xor(t1, 32); \
            tot[mt] = seg + t1 + t2 + t3; \
            hi[mt] = fq == 0 ? (t1 + t2 + t3) : fq == 1 ? (t2 + t3) : fq == 2 ? t1 : 0.f; \
          } \
          float run = carry; \
          float wv[4][4]; \
_Pragma("unroll") \
          for (int mt = 3; mt >= 0; --mt) { \
            const float base = run + hi[mt]; \
            run += tot[mt]; \
_Pragma("unroll") \
            for (int jj = 0; jj < 4; ++jj) wv[mt][jj] = __builtin_amdgcn_exp2f(ee[mt][jj] + base); \
          } \
          carry = run; \
          if (__all(carry < -150.0f)) { wdone = true; if (lane == 0) dflag[w] = 1; } \
_Pragma("unroll") \
          for (int p2 = 0; p2 < 2; ++p2) { \
            uint4 pk; \
            pk.x = pack2(wv[2 * p2][0], wv[2 * p2][1]); pk.y = pack2(wv[2 * p2][2], wv[2 * p2][3]); \
            pk.z = pack2(wv[2 * p2 + 1][0], wv[2 * p2 + 1][1]); pk.w = pack2(wv[2 * p2 + 1][2], wv[2 * p2 + 1][3]); \
            wf[p2] = *(bf16x8*)&pk; \
          } \
        }
        if (kb * 64 + 63 < qpos0 + w * 16) { ATT_ELEM(0) } else { ATT_ELEM(1) }
#undef ATT_ELEM
#pragma unroll
        for (int p2 = 0; p2 < 2; ++p2)
#pragma unroll
          for (int dt = 0; dt < 8; ++dt) {
            const unsigned r0 = 32 * p2 + 4 * fq + tq, r1 = r0 + 16;
            const unsigned ch = 2 * dt + (tp >> 1);
            const char* a0 = sV + off_b(r0, ch) + 8 * (tp & 1);
            const char* a1 = sV + off_b(r1, ch) + 8 * (tp & 1);
            s16x4 lo = __builtin_amdgcn_ds_read_tr16_b64_v4i16((s16x4 __attribute__((address_space(3)))*)(a0));
            s16x4 hi4 = __builtin_amdgcn_ds_read_tr16_b64_v4i16((s16x4 __attribute__((address_space(3)))*)(a1));
            bf16x8 a = {lo[0], lo[1], lo[2], lo[3], hi4[0], hi4[1], hi4[2], hi4[3]};
            O[dt] = __builtin_amdgcn_mfma_f32_16x16x32_bf16(a, wf[p2], O[dt], 0, 0, 0);
          }
      }
      if (it + 1 < ntiles) ATT_STORE(st ^ 1);
      __syncthreads();
      {
        const int4 f0 = *(const int4*)dflag, f1 = *(const int4*)(dflag + 4);
        if (f0.x & f0.y & f0.z & f0.w & f1.x & f1.y & f1.z & f1.w) break;
      }
    }
#undef ATT_LOAD
#undef ATT_STORE
    if (wactive) {
      const size_t rowoff = (size_t)(tokq0 + w * 16 + fr) * 2048 + h * 128;
#pragma unroll
      for (int dt = 0; dt < 8; ++dt) {
        const int d = dt * 16 + fq * 4;
        uint2 z = *(const uint2*)(ZS + rowoff + d);
        f32x4 v = O[dt];
        uint2 o;
        o.x = pack2(v[0] * bflo(z.x), v[1] * bfhi(z.x)); o.y = pack2(v[2] * bflo(z.y), v[3] * bfhi(z.y));
        *(uint2*)(OG + rowoff + d) = o;
      }
    }
  }
}


DEV void grid_barrier(unsigned* bar, unsigned target) {
  __syncthreads();
  if (threadIdx.x == 0) {
    __builtin_amdgcn_fence(__ATOMIC_RELEASE, "agent");
    asm volatile("s_waitcnt vmcnt(0)" ::: "memory");
    __hip_atomic_fetch_add(bar, 1u, __ATOMIC_RELAXED, __HIP_MEMORY_SCOPE_AGENT);
    while (__hip_atomic_load(bar, __ATOMIC_RELAXED, __HIP_MEMORY_SCOPE_AGENT) < target) __builtin_amdgcn_s_sleep(1);
    __builtin_amdgcn_fence(__ATOMIC_ACQUIRE, "agent");
    asm volatile("s_waitcnt vmcnt(0)" ::: "memory");
  }
  __syncthreads();
}

__global__ void __launch_bounds__(NTHREADS) __attribute__((target("no-packed-fp32-ops"))) mega(Params p, int lo, int hi) {
  __shared__ __attribute__((aligned(16))) char smem[147456];
  cg::grid_group grid = cg::this_grid();
#ifndef PROBE_DOUBLE
#define PROBE_DOUBLE -1
#endif
#define RUN_PHASE(k, call) if ((k) >= lo && (k) < hi) { if ((k) > lo) { if ((k) == lo + 1) grid.sync(); else grid_barrier((unsigned*)(p.ws + WS_BAR), (unsigned)((k) - lo - 1) * gridDim.x); } call; }
  RUN_PHASE(0, phase_prep(p, smem))
  RUN_PHASE(1, phase_norm0(p))
  RUN_PHASE(2, phase_proj0(p, smem))
  RUN_PHASE(3, phase_scan(p, smem))
  RUN_PHASE(4, phase_outproj<0>(p, smem))
  RUN_PHASE(5, phase_norm1(p))
  RUN_PHASE(6, phase_proj1(p, smem))
  RUN_PHASE(7, phase_attn(p, smem))
  RUN_PHASE(8, phase_outproj<1>(p, smem))
}

#ifndef N_LAUNCH_MODE
#define N_LAUNCH_MODE 1
#endif

extern "C" void kernel_launch(void* const* d_in, const int* in_sizes, int n_in, void* d_out, int out_size, void* d_ws, size_t ws_size,
                              hipStream_t stream) {
  Params p{};
  for (int i = 0; i < 36; ++i) p.in[i] = (const float*)d_in[i];
  p.out = (float*)d_out;
  p.ws = (char*)d_ws;
  static int grid_blocks = 0;
  if (!grid_blocks) {
    int dev = 0, cus = 0, per_cu = 0;
    hipGetDevice(&dev);
    hipDeviceGetAttribute(&cus, hipDeviceAttributeMultiprocessorCount, dev);
    hipOccupancyMaxActiveBlocksPerMultiprocessor(&per_cu, mega, NTHREADS, 0);
    if (per_cu < 1) per_cu = 1;
    grid_blocks = cus * per_cu;
  }
  if (ws_size < WS_END) { fprintf(stderr, "workspace too small: %zu < %llu\n", ws_size, (unsigned long long)WS_END); return; }
#if N_LAUNCH_MODE == 1
  int lo = 0, hi = 9;
  hipMemsetAsync((char*)d_ws + WS_BAR, 0, 256, stream);
  void* args[] = {&p, &lo, &hi};
  hipError_t e = hipLaunchCooperativeKernel((void*)mega, dim3(grid_blocks), dim3(NTHREADS), args, 0, stream);
  if (e != hipSuccess) fprintf(stderr, "cooperative launch failed: %s (grid %d)\n", hipGetErrorString(e), grid_blocks);
#else
  for (int ph = 0; ph < 9; ++ph) hipLaunchKernelGGL(mega, dim3(grid_blocks), dim3(NTHREADS), 0, stream, p, ph, ph + 1);
#endif
}
```

```cpp
#include <hip/hip_runtime.h>
#include <hip/hip_cooperative_groups.h>
#include <cstdio>
namespace cg = cooperative_groups;

typedef unsigned short u16;
typedef short bf16x8 __attribute__((ext_vector_type(8)));
typedef short s16x4 __attribute__((ext_vector_type(4)));
typedef float f32x4 __attribute__((ext_vector_type(4)));
typedef float f32x2 __attribute__((ext_vector_type(2)));
typedef __bf16 bf16x2_t __attribute__((ext_vector_type(2)));
typedef _Float16 h2_t __attribute__((ext_vector_type(2)));

#define DEV __device__ __forceinline__

#define NTOK 33280
#define TP 32768
#define NTHREADS 512

#define OFF_Y_P 0
#define OFF_Y_S 33554432
#define OFF_K_P 34078720
#define OFF_V_P 101187584
#define OFF_WKV_P 168296448
#define OFF_SH_P 169345024
#define OFF_K_S 169353216
#define OFF_V_S 170401792
#define OFF_WKV_S 171450368
#define OFF_SH_S 173547520

#define SLOT 136314880ull
#define WS_W (7ull * SLOT)
#define WS_WT_IN (WS_W)
#define WS_WT_OUTA (WS_WT_IN + 16777216ull)
#define WS_WT_KV (WS_WT_OUTA + 4194304ull)
#define WS_WT_INB (WS_WT_KV + 8388608ull)
#define WS_WT_OUTB (WS_WT_INB + 8388608ull)
#define WS_W2T (WS_WT_OUTB + 4194304ull)
#define WS_A2T (WS_W2T + 262144ull)
#define WS_L1T (WS_A2T + 262144ull)
#define WS_MOD (WS_L1T + 524288ull)
#define WS_SH (WS_MOD + 589824ull)
#define WS_CTR (WS_SH + 49152ull)
#define WS_BAR (WS_CTR + 4096ull)
#define WS_END (WS_BAR + 256ull)
#define WS_H0 (6ull * SLOT)
#define WS_T (4ull * SLOT)

struct Params {
  const float* in[36];
  float* out;
  char* ws;
};

enum { I_XP = 0, I_XS, I_CK, I_CV, I_SWKV, I_SSH, I_CP, I_CS, I_ANG, I_AADAW, I_AADAB, I_AWIN, I_AMUIN, I_AMUW, I_AMUA,
       I_AW0, I_AW1, I_AW2, I_AA0, I_AA1, I_AA2, I_AKK, I_AKA, I_ARK, I_ALNG, I_ALNB, I_AWOUT, I_KVNG, I_KVW, I_KGAIN,
       I_BNG, I_BADAW, I_BADAB, I_BWIN, I_BQG, I_BWOUT };

DEV int seq_of(int t) { return t < TP ? (t >> 12) : 8 + ((t - TP) >> 5); }
DEV bool seq_start(int t) { return t < TP ? ((t & 4095) == 0) : (((t - TP) & 31) == 0); }

DEV unsigned pack2(float a, float b) {
  f32x2 v = {a, b};
  bf16x2_t r = __builtin_convertvector(v, bf16x2_t);
  return *(unsigned*)&r;
}
DEV unsigned packh2(float a, float b) {
  f32x2 v = {a, b};
  h2_t r = __builtin_convertvector(v, h2_t);
  return *(unsigned*)&r;
}
DEV float bflo(unsigned w) { return __uint_as_float(w << 16); }
DEV float bfhi(unsigned w) { return __uint_as_float(w & 0xffff0000u); }
DEV void unpack8(const uint4& x, float* f) {
  f[0] = bflo(x.x); f[1] = bfhi(x.x); f[2] = bflo(x.y); f[3] = bfhi(x.y);
  f[4] = bflo(x.z); f[5] = bfhi(x.z); f[6] = bflo(x.w); f[7] = bfhi(x.w);
}
DEV float sigmoidf_(float x) { return 1.0f / (1.0f + __expf(-x)); }

template <int CTRL>
DEV float dppf(float x) {
  return __int_as_float(__builtin_amdgcn_update_dpp(0, __float_as_int(x), CTRL, 0xf, 0xf, true));
}
DEV float red4(float x) { x += dppf<0xB1>(x); x += dppf<0x4E>(x); return x; }
DEV float red8(float x) { x = red4(x); x += dppf<0x141>(x); return x; }
DEV float red16(float x) { x = red8(x); x += dppf<0x140>(x); return x; }
DEV float wave_sum(float x) {
#pragma unroll
  for (int o = 32; o >= 1; o >>= 1) x += __shfl_xor(x, o);
  return x;
}


#define SCHED_SLOT_OFF 147440
DEV int xcc_id() { return (int)(__builtin_amdgcn_s_getreg((3 << 11) | 20) & 0x7u); }
DEV unsigned* sched_ctr(const Params& p, int phase_slot, int list) { return (unsigned*)(p.ws + WS_CTR) + (phase_slot * 8 + list) * 16; }
DEV int sched_first(unsigned* ctr, char* smem) {
  int* slot = (int*)(smem + SCHED_SLOT_OFF);
  __syncthreads();
  if (threadIdx.x == 0) *slot = (int)atomicAdd(ctr, 1u);
  __syncthreads();
  return *slot;
}

DEV void group_sync(unsigned* bar, unsigned target) {
  __syncthreads();
  if (threadIdx.x == 0) {
    __hip_atomic_fetch_add(bar, 1u, __ATOMIC_RELAXED, __HIP_MEMORY_SCOPE_AGENT);
    while (__hip_atomic_load(bar, __ATOMIC_RELAXED, __HIP_MEMORY_SCOPE_AGENT) < target) __builtin_amdgcn_s_sleep(2);
  }
  __syncthreads();
}
DEV int sched_prefetch(unsigned* ctr) { return threadIdx.x == 0 ? (int)atomicAdd(ctr, 1u) : 0; }
DEV int sched_commit(int nxt, char* smem) {
  int* slot = (int*)(smem + SCHED_SLOT_OFF);
  __syncthreads();
  if (threadIdx.x == 0) *slot = nxt;
  __syncthreads();
  return *slot;
}

#define GEMM_STAGE_BYTES 49152

template <int AMODE>
DEV void gemm_main(f32x4 (&acc)[4][4], const u16* __restrict__ A, int lda, const u16* __restrict__ Bt, int ldb, int nk,
                   int m0, int n0, const float* __restrict__ mu, const u16* __restrict__ SH, char* smem) {
  const int tid = threadIdx.x, lane = tid & 63, wid = tid >> 6, wr = wid >> 1, wc = wid & 1, fr = lane & 15, fq = lane >> 4;
  const int lrow = tid >> 3, lch = tid & 7;
#pragma unroll
  for (int i = 0; i < 4; ++i)
#pragma unroll
    for (int j = 0; j < 4; ++j) acc[i][j] = (f32x4){0.f, 0.f, 0.f, 0.f};

  const u16* pa0; const u16* pa1; const u16* pa2; const u16* pa3;
  const u16* pp0 = nullptr;
  const int arow = 4 * lrow;
  {
    int m = m0 + arow;
    pa0 = A + (size_t)m * lda + lch * 8;
    pa1 = pa0 + lda; pa2 = pa1 + lda; pa3 = pa2 + lda;
    if (AMODE != 0) pp0 = seq_start(m) ? SH + seq_of(m) * 1024 + lch * 8 : pa0 - lda;
  }
  const u16* pb0 = Bt + (size_t)(n0 + lrow) * ldb + lch * 8;
  const u16* pb1 = pb0 + (size_t)64 * ldb;
  const int woffB = lrow * 128 + ((lch ^ ((lrow >> 1) & 7)) << 4);
  const int woffA0 = (arow + 0) * 128 + ((lch ^ (((arow + 0) >> 1) & 7)) << 4);
  const int woffA1 = (arow + 1) * 128 + ((lch ^ (((arow + 1) >> 1) & 7)) << 4);
  const int woffA2 = (arow + 2) * 128 + ((lch ^ (((arow + 2) >> 1) & 7)) << 4);
  const int woffA3 = (arow + 3) * 128 + ((lch ^ (((arow + 3) >> 1) & 7)) << 4);

  uint4 ra0, ra1, ra2, ra3, rp0, rb0, rb1;
  float4 mu0, mu1;
  rp0 = make_uint4(0, 0, 0, 0);
  mu0 = mu1 = make_float4(0, 0, 0, 0);

#define G_LOAD(kt)                                                                     \
  {                                                                                    \
    const int k0_ = (kt) * 64;                                                         \
    if (AMODE == 0) {                                                                  \
      ra0 = *(const uint4*)(pa0 + k0_); ra1 = *(const uint4*)(pa1 + k0_);              \
      ra2 = *(const uint4*)(pa2 + k0_); ra3 = *(const uint4*)(pa3 + k0_);              \
    } else if (AMODE == 1) {                                                           \
      ra0 = *(const uint4*)(pa0 + k0_); ra1 = *(const uint4*)(pa1 + k0_);              \
      ra2 = *(const uint4*)(pa2 + k0_); ra3 = *(const uint4*)(pa3 + k0_);              \
      rp0 = *(const uint4*)(pp0 + k0_);                                                \
      mu0 = *(const float4*)(mu + k0_ + lch * 8); mu1 = *(const float4*)(mu + k0_ + lch * 8 + 4); \
    } else {                                                                           \
      const int kk_ = k0_ & 1023;                                                      \
      ra0 = *(const uint4*)(pa0 + kk_); ra1 = *(const uint4*)(pa1 + kk_);              \
      ra2 = *(const uint4*)(pa2 + kk_); ra3 = *(const uint4*)(pa3 + kk_);              \
      if (k0_ >= 1024) rp0 = *(const uint4*)(pp0 + kk_);                               \
    }                                                                                  \
    rb0 = *(const uint4*)(pb0 + k0_); rb1 = *(const uint4*)(pb1 + k0_);                \
  }

#define G_XFORM(dst, a_, p_, kt)                                                       \
  {                                                                                    \
    if (AMODE == 0) dst = a_;                                                          \
    else if (AMODE == 1) {                                                             \
      float h_[8], q_[8]; unpack8(a_, h_); unpack8(p_, q_);                            \
      dst.x = pack2(h_[0] + mu0.x * (q_[0] - h_[0]), h_[1] + mu0.y * (q_[1] - h_[1])); \
      dst.y = pack2(h_[2] + mu0.z * (q_[2] - h_[2]), h_[3] + mu0.w * (q_[3] - h_[3])); \
      dst.z = pack2(h_[4] + mu1.x * (q_[4] - h_[4]), h_[5] + mu1.y * (q_[5] - h_[5])); \
      dst.w = pack2(h_[6] + mu1.z * (q_[6] - h_[6]), h_[7] + mu1.w * (q_[7] - h_[7])); \
    } else {                                                                           \
      if ((kt) * 64 >= 1024) {                                                         \
        float h_[8], q_[8]; unpack8(a_, h_); unpack8(p_, q_);                          \
        dst.x = pack2(q_[0] - h_[0], q_[1] - h_[1]); dst.y = pack2(q_[2] - h_[2], q_[3] - h_[3]); \
        dst.z = pack2(q_[4] - h_[4], q_[5] - h_[5]); dst.w = pack2(q_[6] - h_[6], q_[7] - h_[7]); \
      } else dst = a_;                                                                 \
    }                                                                                  \
  }

#define G_STORE(stage, kt)                                                             \
  {                                                                                    \
    char* sA_ = smem + (stage) * GEMM_STAGE_BYTES; char* sB_ = sA_ + 32768;            \
    uint4 v_;                                                                          \
    G_XFORM(v_, ra0, rp0, kt); *(uint4*)(sA_ + woffA0) = v_;                           \
    G_XFORM(v_, ra1, ra0, kt); *(uint4*)(sA_ + woffA1) = v_;                           \
    G_XFORM(v_, ra2, ra1, kt); *(uint4*)(sA_ + woffA2) = v_;                           \
    G_XFORM(v_, ra3, ra2, kt); *(uint4*)(sA_ + woffA3) = v_;                           \
    *(uint4*)(sB_ + woffB) = rb0; *(uint4*)(sB_ + woffB + 64 * 128) = rb1;             \
  }

  G_LOAD(0);
  G_STORE(0, 0);
  __syncthreads();
  const int rsw = (fr >> 1) & 7;
  for (int kt = 0; kt < nk; ++kt) {
    const int st = kt & 1;
    if (kt + 1 < nk) G_LOAD(kt + 1);
    __builtin_amdgcn_sched_barrier(0);
    {
      const char* sA = smem + st * GEMM_STAGE_BYTES;
      const char* sB = sA + 32768;
#pragma unroll
      for (int kk = 0; kk < 2; ++kk) {
        bf16x8 af[4], bfr[4];
        const int cho = ((kk * 4 + fq) ^ rsw) << 4;
#pragma unroll
        for (int i = 0; i < 4; ++i) af[i] = *(const bf16x8*)(sA + (wr * 64 + i * 16 + fr) * 128 + cho);
#pragma unroll
        for (int j = 0; j < 4; ++j) bfr[j] = *(const bf16x8*)(sB + (wc * 64 + j * 16 + fr) * 128 + cho);
#pragma unroll
        for (int i = 0; i < 4; ++i)
#pragma unroll
          for (int j = 0; j < 4; ++j) acc[i][j] = __builtin_amdgcn_mfma_f32_16x16x32_bf16(bfr[j], af[i], acc[i][j], 0, 0, 0);
      }
    }
    if (kt + 1 < nk) G_STORE(st ^ 1, kt + 1);
    __syncthreads();
  }
#undef G_LOAD
#undef G_XFORM
#undef G_STORE
}


#define G2_STAGE_BYTES 32768
#define G2_MU_OFF (3 * G2_STAGE_BYTES)
DEV int g2_swz(int row) { return (0x78 >> (2 * ((row >> 2) & 3))) & 3; }
template <int AMODE>
DEV void gemm_main256(f32x4 (&acc)[8][4], const u16* __restrict__ A, int lda, const u16* __restrict__ Bt, int ldb, int nk64,
                      int m0, int n0, const float* __restrict__ mu, const u16* __restrict__ SH, char* smem) {
  const int tid = threadIdx.x, lane = tid & 63, wid = tid >> 6, wr = wid >> 2, wc = wid & 3, fr = lane & 15, fq = lane >> 4;
  const int nk = nk64 * 2;
  const int lrow2 = 2 * (tid >> 2), lch = tid & 3;
#pragma unroll
  for (int i = 0; i < 8; ++i)
#pragma unroll
    for (int j = 0; j < 4; ++j) acc[i][j] = (f32x4){0.f, 0.f, 0.f, 0.f};
  const u16* pa0 = A + (size_t)(m0 + lrow2) * lda + lch * 8;
  const u16* pp0 = nullptr;
  if (AMODE != 0) pp0 = seq_start(m0 + lrow2) ? SH + seq_of(m0 + lrow2) * 1024 + lch * 8 : pa0 - lda;
  const u16* pb0 = Bt + (size_t)(n0 + lrow2) * ldb + lch * 8;
  const int woff0 = (lrow2 + 0) * 64 + ((lch ^ g2_swz(lrow2 + 0)) << 4);
  const int woff1 = (lrow2 + 1) * 64 + ((lch ^ g2_swz(lrow2 + 1)) << 4);
  const float* muL = (const float*)(smem + G2_MU_OFF);
  if (AMODE == 1) {
    if (tid < 256) *(float4*)(smem + G2_MU_OFF + tid * 16) = *(const float4*)(mu + tid * 4);
  }
  uint4 xa0, xa1, xp, xb0, xb1;
  uint4 ya0, ya1, yp, yb0, yb1;
  xp = yp = make_uint4(0, 0, 0, 0);

#define K_LOAD(S, kt)                                                                  \
  {                                                                                    \
    const int k0_ = (kt) * 32;                                                         \
    S##a0 = *(const uint4*)(pa0 + k0_); S##a1 = *(const uint4*)(pa0 + lda + k0_);      \
    if (AMODE == 1) S##p = *(const uint4*)(pp0 + k0_);                                 \
    S##b0 = *(const uint4*)(pb0 + k0_); S##b1 = *(const uint4*)(pb0 + ldb + k0_);      \
  }
#define K_XFORM(dst, a_, p_)                                                           \
  {                                                                                    \
    if (AMODE == 0) dst = a_;                                                          \
    else {                                                                             \
      float h_[8], q_[8]; unpack8(a_, h_); unpack8(p_, q_);                            \
      dst.x = pack2(h_[0] + mu0.x * (q_[0] - h_[0]), h_[1] + mu0.y * (q_[1] - h_[1])); \
      dst.y = pack2(h_[2] + mu0.z * (q_[2] - h_[2]), h_[3] + mu0.w * (q_[3] - h_[3])); \
      dst.z = pack2(h_[4] + mu1.x * (q_[4] - h_[4]), h_[5] + mu1.y * (q_[5] - h_[5])); \
      dst.w = pack2(h_[6] + mu1.z * (q_[6] - h_[6]), h_[7] + mu1.w * (q_[7] - h_[7])); \
    }                                                                                  \
  }
#define K_STORE(S, stage, kt)                                                          \
  {                                                                                    \
    char* sA_ = smem + (stage) * G2_STAGE_BYTES; char* sB_ = sA_ + 16384;              \
    uint4 v_; float4 mu0, mu1;                                                         \
    if (AMODE == 1) { mu0 = *(const float4*)(muL + (kt) * 32 + lch * 8); mu1 = *(const float4*)(muL + (kt) * 32 + lch * 8 + 4); } \
    K_XFORM(v_, S##a0, S##p); *(uint4*)(sA_ + woff0) = v_;                             \
    K_XFORM(v_, S##a1, S##a0); *(uint4*)(sA_ + woff1) = v_;                            \
    *(uint4*)(sB_ + woff0) = S##b0; *(uint4*)(sB_ + woff1) = S##b1;                    \
  }
#define K_COMPUTE_HALF(stage, i0)                                                      \
  {                                                                                    \
    const char* sA_ = smem + (stage) * G2_STAGE_BYTES;                                 \
    _Pragma("unroll") for (int i = (i0); i < (i0) + 4; ++i) {                          \
      const bf16x8 af = *(const bf16x8*)(sA_ + (wr * 128 + i * 16 + fr) * 64 + cho);   \
      _Pragma("unroll") for (int j = 0; j < 4; ++j) acc[i][j] = __builtin_amdgcn_mfma_f32_16x16x32_bf16(bfr[j], af, acc[i][j], 0, 0, 0); \
    }                                                                                  \
  }
#define K_LOAD_B(stage)                                                                \
  {                                                                                    \
    const char* sB_ = smem + (stage) * G2_STAGE_BYTES + 16384;                         \
    _Pragma("unroll") for (int j = 0; j < 4; ++j) bfr[j] = *(const bf16x8*)(sB_ + (wc * 64 + j * 16 + fr) * 64 + cho); \
  }
#define K_ITER(kt, L, S)                                                               \
  {                                                                                    \
    K_LOAD(L, min((kt) + 2, nk - 1));                                                  \
    __builtin_amdgcn_sched_barrier(0);                                                 \
    bf16x8 bfr[4];                                                                     \
    K_LOAD_B(cu);                                                                      \
    K_COMPUTE_HALF(cu, 0);                                                             \
    __builtin_amdgcn_sched_barrier(0);                                                 \
    K_STORE(S, nx, min((kt) + 1, nk - 1));                                             \
    __builtin_amdgcn_sched_barrier(0);                                                 \
    if (AMODE == 1) K_LOAD_B(cu);                                                      \
    K_COMPUTE_HALF(cu, 4);                                                             \
    __syncthreads();                                                                   \
    cu = nx; nx = (nx == 2) ? 0 : nx + 1;                                              \
  }
  const int cho = (fq ^ g2_swz(fr)) << 4;
  if (AMODE == 1) __syncthreads();
  K_LOAD(x, 0);
  K_LOAD(y, 1);
  K_STORE(x, 0, 0);
  __syncthreads();
  int cu = 0, nx = 1;
  for (int kt = 0; kt < nk; kt += 2) {
    K_ITER(kt, x, y);
    K_ITER(kt + 1, y, x);
  }
#undef K_LOAD
#undef K_XFORM
#undef K_STORE
#undef K_COMPUTE_HALF
#undef K_LOAD_B
#undef K_ITER
}


#define GD_NST 4
DEV void gemm_main256_dma(f32x4 (&acc)[8][4], const u16* __restrict__ A, int lda, const u16* __restrict__ Bt, int ldb, int nk64,
                          int m0, int n0, char* smem) {
  const int tid = threadIdx.x, lane = tid & 63, wid = tid >> 6, wr = wid >> 2, wc = wid & 3, fr = lane & 15, fq = lane >> 4;
  const int nk = nk64 * 2;
#pragma unroll
  for (int i = 0; i < 8; ++i)
#pragma unroll
    for (int j = 0; j < 4; ++j) acc[i][j] = (f32x4){0.f, 0.f, 0.f, 0.f};
  const int prow = 16 * wid + (lane >> 2);
  const int pch = (lane & 3) ^ g2_swz(prow);
  const u16* srcA = A + (size_t)(m0 + prow) * lda + pch * 8;
  const u16* srcB = Bt + (size_t)(n0 + prow) * ldb + pch * 8;
  const size_t a128 = (size_t)128 * lda, b128 = (size_t)128 * ldb;
  char* ldsw = smem + (16 * wid) * 64;
#define D_FILL(kt, stage)                                                              \
  {                                                                                    \
    const int k0_ = (kt) * 32;                                                         \
    char* d_ = ldsw + (stage) * G2_STAGE_BYTES;                                        \
    __builtin_amdgcn_global_load_lds((const unsigned*)(srcA + k0_), (unsigned*)(d_), 16, 0, 0);               \
    __builtin_amdgcn_global_load_lds((const unsigned*)(srcA + a128 + k0_), (unsigned*)(d_ + 8192), 16, 0, 0); \
    __builtin_amdgcn_global_load_lds((const unsigned*)(srcB + k0_), (unsigned*)(d_ + 16384), 16, 0, 0);       \
    __builtin_amdgcn_global_load_lds((const unsigned*)(srcB + b128 + k0_), (unsigned*)(d_ + 16384 + 8192), 16, 0, 0); \
  }
  const int cho = (fq ^ g2_swz(fr)) << 4;
  __syncthreads();
  D_FILL(0, 0);
  D_FILL(min(1, nk - 1), 1);
  D_FILL(min(2, nk - 1), 2);
  int cu = 0, fill = 3;
  for (int kt = 0; kt < nk; ++kt) {
    asm volatile("s_waitcnt vmcnt(8)" ::: "memory");
    asm volatile("s_waitcnt lgkmcnt(0)" ::: "memory");
    __builtin_amdgcn_s_barrier();
    D_FILL(min(kt + 3, nk - 1), fill);
    {
      const char* sA_ = smem + cu * G2_STAGE_BYTES;
      const char* sB_ = sA_ + 16384;
      bf16x8 bfr[4];
#pragma unroll
      for (int j = 0; j < 4; ++j) bfr[j] = *(const bf16x8*)(sB_ + (wc * 64 + j * 16 + fr) * 64 + cho);
#pragma unroll
      for (int i = 0; i < 8; ++i) {
        const bf16x8 af = *(const bf16x8*)(sA_ + (wr * 128 + i * 16 + fr) * 64 + cho);
#pragma unroll
        for (int j = 0; j < 4; ++j) acc[i][j] = __builtin_amdgcn_mfma_f32_16x16x32_bf16(bfr[j], af, acc[i][j], 0, 0, 0);
      }
    }
    cu = (cu == GD_NST - 1) ? 0 : cu + 1;
    fill = (fill == GD_NST - 1) ? 0 : fill + 1;
  }
  asm volatile("s_waitcnt vmcnt(0)" ::: "memory");
  asm volatile("s_waitcnt lgkmcnt(0)" ::: "memory");
  __builtin_amdgcn_s_barrier();
#undef D_FILL
}

DEV void transpose_tile(const float* __restrict__ src, int N, int k0, int n0, const float* __restrict__ scale, u16* __restrict__ dst,
                        int dstride, int drow0, int dcol0, char* smem) {
  float* tile = (float*)smem;
  const int tid = threadIdx.x;
#pragma unroll
  for (int i = 0; i < 2; ++i) {
    int kl = (tid >> 4) + 32 * i, n4 = (tid & 15) * 4;
    float4 v = *(const float4*)(src + (size_t)(k0 + kl) * N + n0 + n4);
    float s = scale ? scale[k0 + kl] : 1.0f;
    tile[kl * 65 + n4 + 0] = v.x * s; tile[kl * 65 + n4 + 1] = v.y * s;
    tile[kl * 65 + n4 + 2] = v.z * s; tile[kl * 65 + n4 + 3] = v.w * s;
  }
  __syncthreads();
  {
    int nl = tid >> 3, k8 = (tid & 7) * 8;
    uint4 o;
    o.x = pack2(tile[(k8 + 0) * 65 + nl], tile[(k8 + 1) * 65 + nl]);
    o.y = pack2(tile[(k8 + 2) * 65 + nl], tile[(k8 + 3) * 65 + nl]);
    o.z = pack2(tile[(k8 + 4) * 65 + nl], tile[(k8 + 5) * 65 + nl]);
    o.w = pack2(tile[(k8 + 6) * 65 + nl], tile[(k8 + 7) * 65 + nl]);
    *(uint4*)(dst + (size_t)(drow0 + n0 + nl) * dstride + dcol0 + k0 + k8) = o;
  }
  __syncthreads();
}

DEV void transpose_tile_wide(const float* __restrict__ src, int N, int k0, int n0, u16* __restrict__ dst, int dstride, char* smem) {
  float* tile = (float*)smem;
  const int tid = threadIdx.x;
#pragma unroll
  for (int i = 0; i < 8; ++i) {
    const int e = tid + 512 * i, kl = e >> 6, n4 = (e & 63) * 4;
    const float4 v = *(const float4*)(src + (size_t)(k0 + kl) * N + n0 + n4);
    float* t = tile + kl * 257 + n4;
    t[0] = v.x; t[1] = v.y; t[2] = v.z; t[3] = v.w;
  }
  __syncthreads();
#pragma unroll
  for (int i = 0; i < 4; ++i) {
    const int c = tid + 512 * i, nl = c >> 3, k8 = (c & 7) * 8;
    uint4 o;
    o.x = pack2(tile[(k8 + 0) * 257 + nl], tile[(k8 + 1) * 257 + nl]);
    o.y = pack2(tile[(k8 + 2) * 257 + nl], tile[(k8 + 3) * 257 + nl]);
    o.z = pack2(tile[(k8 + 4) * 257 + nl], tile[(k8 + 5) * 257 + nl]);
    o.w = pack2(tile[(k8 + 6) * 257 + nl], tile[(k8 + 7) * 257 + nl]);
    *(uint4*)(dst + (size_t)(n0 + nl) * dstride + k0 + k8) = o;
  }
  __syncthreads();
}

DEV void phase_prep(const Params& p, char* smem) {
  const int tid = threadIdx.x;
  char* ws = p.ws;
  if (blockIdx.x < 96) {
    float* cL = (float*)smem;
    float* red = (float*)(smem + 98304);
    for (int e = tid; e < 24 * 256; e += NTHREADS) {
      int s = e >> 8, k4 = (e & 255) * 4;
      float4 v = s < 8 ? *(const float4*)(p.in[I_CP] + s * 1024 + k4) : *(const float4*)(p.in[I_CS] + (s - 8) * 1024 + k4);
      *(float4*)(cL + s * 1024 + k4) = v;
    }
    __syncthreads();
    for (int item = blockIdx.x; item < 96; item += gridDim.x) {
      const int l = item / 48, j0 = (item % 48) * 64;
      const float* W = (l == 0 ? p.in[I_AADAW] : p.in[I_BADAW]);
      const float* bias = (l == 0 ? p.in[I_AADAB] : p.in[I_BADAB]);
      const int col = tid & 63, kg = tid >> 6;
      float acc[24];
#pragma unroll
      for (int s = 0; s < 24; ++s) acc[s] = 0.f;
      for (int k = kg * 128; k < kg * 128 + 128; ++k) {
        float w = W[(size_t)k * 3072 + j0 + col];
#pragma unroll
        for (int s = 0; s < 24; ++s) acc[s] += cL[s * 1024 + k] * w;
      }
#pragma unroll
      for (int s = 0; s < 24; ++s) red[(kg * 24 + s) * 64 + col] = acc[s];
      __syncthreads();
      float* mod = (float*)(ws + WS_MOD);
      for (int e = tid; e < 24 * 64; e += NTHREADS) {
        int s = e >> 6, c = e & 63;
        float t = bias[j0 + c];
#pragma unroll
        for (int g = 0; g < 8; ++g) t += red[(g * 24 + s) * 64 + c];
        mod[(size_t)(l * 24 + s) * 3072 + j0 + c] = t;
      }
      __syncthreads();
    }
  }
  if (blockIdx.x == 0) for (int e = tid; e < 1024; e += NTHREADS) ((unsigned*)(ws + WS_CTR))[e] = 0u;
  if (blockIdx.x == gridDim.x - 1) {
    u16* SH = (u16*)(ws + WS_SH);
    for (int e = tid; e < 24 * 1024; e += NTHREADS) {
      int s = e >> 10, k = e & 1023;
      float v = s < 8 ? 0.f : p.in[I_SSH][(s - 8) * 1024 + k];
      SH[e] = (u16)(pack2(v, 0.f) & 0xffff);
    }
  }
  const int NW = 512 + 128 + 256 + 256 + 128 + 8 + 8;
  for (int t = blockIdx.x; t < NW + 64; t += gridDim.x) {
    if (t < NW) {
      const float* src; int K, N; u16* dst; int dstride; int tt = t;
      if (tt < 512) { src = p.in[I_AWIN]; K = 1024; N = 8192; dst = (u16*)(ws + WS_WT_IN); dstride = 1024; }
      else if ((tt -= 512) < 128) { src = p.in[I_AWOUT]; K = 2048; N = 1024; dst = (u16*)(ws + WS_WT_OUTA); dstride = 2048; }
      else if ((tt -= 128) < 256) { src = p.in[I_KVW]; K = 1024; N = 4096; dst = (u16*)(ws + WS_WT_KV); dstride = 1024; }
      else if ((tt -= 256) < 256) { src = p.in[I_BWIN]; K = 1024; N = 4096; dst = (u16*)(ws + WS_WT_INB); dstride = 1024; }
      else if ((tt -= 256) < 128) { src = p.in[I_BWOUT]; K = 2048; N = 1024; dst = (u16*)(ws + WS_WT_OUTB); dstride = 2048; }
      else if ((tt -= 128) < 8) { src = p.in[I_AW2]; K = 64; N = 2048; dst = (u16*)(ws + WS_W2T); dstride = 64; }
      else { tt -= 8; src = p.in[I_AA2]; K = 64; N = 2048; dst = (u16*)(ws + WS_A2T); dstride = 64; }
      const int ntn = N / 256;
      (void)K;
      transpose_tile_wide(src, N, (tt / ntn) * 64, (tt % ntn) * 256, dst, dstride, smem);
    } else {
      int tt = t - NW;
      const int job = tt >> 4; tt &= 15;
      const float* src = (job < 2) ? p.in[I_AW1] : p.in[I_AA1];
      const float* scale = nullptr; int dcol0 = 0;
      if (job & 1) { dcol0 = 1024; scale = (job < 2) ? p.in[I_AMUW] : p.in[I_AMUA]; }
      transpose_tile(src, 64, tt * 64, 0, scale, (u16*)(ws + WS_L1T), 2048, (job < 2) ? 0 : 64, dcol0, smem);
    }
  }
}

DEV void phase_norm0(const Params& p) {
  const int lane = threadIdx.x & 63, wid = threadIdx.x >> 6;
  const float* mod = (const float*)(p.ws + WS_MOD);
  u16* H0 = (u16*)(p.ws + WS_H0);
  const float* g = p.in[I_ANG];
  for (int t = blockIdx.x * 8 + wid; t < NTOK; t += gridDim.x * 8) {
    const float* x = t < TP ? p.in[I_XP] + (size_t)t * 1024 : p.in[I_XS] + (size_t)(t - TP) * 1024;
    const int s = seq_of(t);
    const float* md = mod + (size_t)s * 3072;
    float4 v[4];
    float ss = 0.f;
#pragma unroll
    for (int i = 0; i < 4; ++i) {
      v[i] = *(const float4*)(x + lane * 4 + 256 * i);
      ss += v[i].x * v[i].x + v[i].y * v[i].y + v[i].z * v[i].z + v[i].w * v[i].w;
    }
    ss = wave_sum(ss);
    const float rstd = rsqrtf(ss * (1.0f / 1024.0f) + 1e-6f);
    bool last = t < TP ? ((t & 4095) == 4095) : (((t - TP) & 31) == 31);
    float* so = t < TP ? p.out + OFF_SH_P + (t >> 12) * 1024 : p.out + OFF_SH_S + ((t - TP) >> 5) * 1024;
#pragma unroll
    for (int i = 0; i < 4; ++i) {
      const int c = lane * 4 + 256 * i;
      float4 gg = *(const float4*)(g + c), sh = *(const float4*)(md + c), sc = *(const float4*)(md + 1024 + c);
      float4 h;
      h.x = v[i].x * rstd * gg.x * (1.f + sc.x) + sh.x;
      h.y = v[i].y * rstd * gg.y * (1.f + sc.y) + sh.y;
      h.z = v[i].z * rstd * gg.z * (1.f + sc.z) + sh.z;
      h.w = v[i].w * rstd * gg.w * (1.f + sc.w) + sh.w;
      uint2 o; o.x = pack2(h.x, h.y); o.y = pack2(h.z, h.w);
      *(uint2*)(H0 + (size_t)t * 1024 + c) = o;
      if (last) *(float4*)(so + c) = h;
    }
  }
}

DEV void phase_proj0_lora(const Params& p, char* smem) {
  const int tid = threadIdx.x, lane = tid & 63, wid = tid >> 6, fr = lane & 15, fq = lane >> 4;
  const int wr = wid >> 1, wc = wid & 1;
  char* ws = p.ws;
  const u16* H0 = (const u16*)(ws + WS_H0);
  const u16* SH = (const u16*)(ws + WS_SH);
  u16* T = (u16*)(ws + WS_T);
  const int xcc0 = xcc_id();
  int nxt;
  f32x4 acc[4][4];
  for (int ls = 0; ls < 8; ++ls) {
  const int xcd = (xcc0 + ls) & 7;
  unsigned* ctr = sched_ctr(p, 0, xcd);
  for (int li = sched_first(ctr, smem); li < 17; li = sched_commit(nxt, smem)) {
    nxt = sched_prefetch(ctr);
    const int lmt = xcd + 8 * li;
    if (lmt >= 130) continue;
    const int m0 = lmt * 256;
    gemm_main<2>(acc, H0, 1024, (const u16*)(ws + WS_L1T), 2048, 32, m0, 0, nullptr, SH, smem);
#pragma unroll
    for (int i = 0; i < 4; ++i)
#pragma unroll
      for (int j = 0; j < 4; ++j) {
        const int m = m0 + wr * 64 + i * 16 + fr, n = wc * 64 + j * 16 + fq * 4;
        f32x4 v = acc[i][j];
        if (wc == 0) { v[0] = tanhf(v[0]); v[1] = tanhf(v[1]); v[2] = tanhf(v[2]); v[3] = tanhf(v[3]); }
        uint2 o; o.x = pack2(v[0], v[1]); o.y = pack2(v[2], v[3]);
        *(uint2*)(T + (size_t)m * 128 + n) = o;
      }
  }
  }
}

DEV void phase_proj0_main(const Params& p, char* smem) {
  const int tid = threadIdx.x, lane = tid & 63, wid = tid >> 6, fr = lane & 15, fq = lane >> 4;
  const int wr = wid >> 2, wc = wid & 3;
  char* ws = p.ws;
  const u16* H0 = (const u16*)(ws + WS_H0);
  const u16* SH = (const u16*)(ws + WS_SH);
  const int xcc0 = xcc_id();
  int nxt;
  f32x4 acc[8][4];
  for (int ls = 0; ls < 8; ++ls) {
  const int xcd = (xcc0 + ls) & 7;
  unsigned* ctr = sched_ctr(p, 4, xcd);
  for (int q = sched_first(ctr, smem); q < 520; q = sched_commit(nxt, smem)) {
    nxt = sched_prefetch(ctr);
    const int mt = q >> 2, nt = 4 * xcd + (q & 3);
    const int part = nt >> 3;
    const int m0 = mt * 256, n0 = nt * 256;
    gemm_main256<1>(acc, H0, 1024, (const u16*)(ws + WS_WT_IN), 1024, 16, m0, n0, p.in[I_AMUIN] + part * 1024, SH, smem);
    u16* dst = (u16*)(ws + (size_t)part * SLOT);
    const int nb = n0 - part * 2048;
#pragma unroll
    for (int i = 0; i < 8; ++i)
#pragma unroll
      for (int j = 0; j < 4; ++j) {
        const int row = wr * 128 + i * 16 + fr, col = wc * 64 + j * 16 + fq * 4;
        f32x4 v = acc[i][j];
        uint2 o; o.x = pack2(v[0], v[1]); o.y = pack2(v[2], v[3]);
        *(uint2*)(smem + row * 528 + col * 2) = o;
      }
    __syncthreads();
#pragma unroll
    for (int qq = 0; qq < 16; ++qq) {
      const int c = tid + 512 * qq, row = c >> 5, ch = c & 31;
      const uint4 v = *(const uint4*)(smem + row * 528 + ch * 16);
      *(uint4*)(dst + (size_t)(m0 + row) * 2048 + nb + ch * 8) = v;
    }
    __syncthreads();
  }
  }
}

DEV void phase_proj0(const Params& p, char* smem) {
  phase_proj0_lora(p, smem);
  phase_proj0_main(p, smem);
}

DEV void phase_scan(const Params& p, char* smem) {
  const int tid = threadIdx.x, lane = tid & 63, wid = tid >> 6;
  u16* Hkk = (u16*)smem;
  u16* Hw = Hkk + 4096;
  u16* Hb = Hw + 4096;
  u16* Hk = Hb + 4096;
  u16* Hwr = Hk + 4096;
  unsigned* Hv2 = (unsigned*)(smem + 40960);
  float* LY = (float*)(smem + 57344);
  float* Lbon = LY + 8192;
  float* Lsc = Lbon + 64;
  float* Lwa = Lsc + 128;
  char* ws = p.ws;
  const u16* gR = (const u16*)(ws + 0 * SLOT);
  const u16* gK = (const u16*)(ws + 1 * SLOT);
  const u16* gV = (const u16*)(ws + 2 * SLOT);
  const u16* gZ = (const u16*)(ws + 3 * SLOT);
  const u16* gT = (const u16*)(ws + WS_T);
  const u16* W2T = (const u16*)(ws + WS_W2T);
  const u16* A2T = (const u16*)(ws + WS_A2T);
  const int fr = lane & 15, fq = lane >> 4, lmt = wid & 3, lnh = wid >> 2;
  u16* YG = (u16*)(ws + 6 * SLOT);
  const int tt = tid >> 3, c8 = (tid & 7) * 8;
  const int srow = tid >> 3, kc = tid & 7;

  for (int item = blockIdx.x; item < 768; item += gridDim.x) {
    int h, tok0, nsteps; const float* sinit; float* sout;
    if (item < 256) { h = item & 31; tok0 = (item >> 5) * 4096; nsteps = 4096; sinit = nullptr; sout = p.out + OFF_WKV_P + (size_t)item * 4096; }
    else { int it = item - 256; h = it & 31; tok0 = TP + (it >> 5) * 32; nsteps = 32; sinit = p.in[I_SWKV] + (size_t)it * 4096; sout = p.out + OFF_WKV_S + (size_t)it * 4096; }
    const int nch = (nsteps + 63) >> 6;
    const int col0 = h * 64 + c8;
    float ckk[8], cka[8], crk[8], clg[8], clb[8];
    {
      float4 t0, t1;
      t0 = *(const float4*)(p.in[I_AKK] + col0); t1 = *(const float4*)(p.in[I_AKK] + col0 + 4);
      ckk[0] = t0.x; ckk[1] = t0.y; ckk[2] = t0.z; ckk[3] = t0.w; ckk[4] = t1.x; ckk[5] = t1.y; ckk[6] = t1.z; ckk[7] = t1.w;
      t0 = *(const float4*)(p.in[I_AKA] + col0); t1 = *(const float4*)(p.in[I_AKA] + col0 + 4);
      cka[0] = t0.x; cka[1] = t0.y; cka[2] = t0.z; cka[3] = t0.w; cka[4] = t1.x; cka[5] = t1.y; cka[6] = t1.z; cka[7] = t1.w;
      t0 = *(const float4*)(p.in[I_ARK] + col0); t1 = *(const float4*)(p.in[I_ARK] + col0 + 4);
      crk[0] = t0.x; crk[1] = t0.y; crk[2] = t0.z; crk[3] = t0.w; crk[4] = t1.x; crk[5] = t1.y; crk[6] = t1.z; crk[7] = t1.w;
      t0 = *(const float4*)(p.in[I_ALNG] + col0); t1 = *(const float4*)(p.in[I_ALNG] + col0 + 4);
      clg[0] = t0.x; clg[1] = t0.y; clg[2] = t0.z; clg[3] = t0.w; clg[4] = t1.x; clg[5] = t1.y; clg[6] = t1.z; clg[7] = t1.w;
      t0 = *(const float4*)(p.in[I_ALNB] + col0); t1 = *(const float4*)(p.in[I_ALNB] + col0 + 4);
      clb[0] = t0.x; clb[1] = t0.y; clb[2] = t0.z; clb[3] = t0.w; clb[4] = t1.x; clb[5] = t1.y; clb[6] = t1.z; clb[7] = t1.w;
    }
    float cw0[8], ca0[8];
    {
      float4 t0 = *(const float4*)(p.in[I_AW0] + col0), t1 = *(const float4*)(p.in[I_AW0] + col0 + 4);
      cw0[0] = t0.x; cw0[1] = t0.y; cw0[2] = t0.z; cw0[3] = t0.w; cw0[4] = t1.x; cw0[5] = t1.y; cw0[6] = t1.z; cw0[7] = t1.w;
      t0 = *(const float4*)(p.in[I_AA0] + col0); t1 = *(const float4*)(p.in[I_AA0] + col0 + 4);
      ca0[0] = t0.x; ca0[1] = t0.y; ca0[2] = t0.z; ca0[3] = t0.w; ca0[4] = t1.x; ca0[5] = t1.y; ca0[6] = t1.z; ca0[7] = t1.w;
    }
    bf16x8 w2f[2][2], a2f[2][2];
#pragma unroll
    for (int n2 = 0; n2 < 2; ++n2)
#pragma unroll
      for (int ks = 0; ks < 2; ++ks) {
        const size_t o_ = (size_t)(h * 64 + lnh * 32 + n2 * 16 + fr) * 64 + ks * 32 + fq * 8;
        w2f[n2][ks] = *(const bf16x8*)(W2T + o_);
        a2f[n2][ks] = *(const bf16x8*)(A2T + o_);
      }
    h2_t sa_, sb_, sc_, sd_;
    if (sinit) {
      float4 a = *(const float4*)(sinit + srow * 64 + kc * 8), b = *(const float4*)(sinit + srow * 64 + kc * 8 + 4);
      sa_ = (h2_t){(_Float16)a.x, (_Float16)a.y}; sb_ = (h2_t){(_Float16)a.z, (_Float16)a.w};
      sc_ = (h2_t){(_Float16)b.x, (_Float16)b.y}; sd_ = (h2_t){(_Float16)b.z, (_Float16)b.w};
    } else {
      sa_ = sb_ = sc_ = sd_ = (h2_t){(_Float16)0.f, (_Float16)0.f};
    }
    uint4 cr, ck, cv, cz;
    bf16x8 t1f[2], t2f[2];
#define SCAN_LOAD(c)                                                                   \
    {                                                                                  \
      const int tl_ = (c) * 64 + tt;                                                   \
      if (tl_ < nsteps) {                                                              \
        const size_t o_ = (size_t)(tok0 + tl_) * 2048 + col0;                          \
        cr = *(const uint4*)(gR + o_); ck = *(const uint4*)(gK + o_); cv = *(const uint4*)(gV + o_); \
        cz = *(const uint4*)(gZ + o_);                                                 \
      } else { cr = ck = cv = cz = make_uint4(0, 0, 0, 0); }                           \
      const int tm_ = (c) * 64 + lmt * 16 + fr;                                        \
      if (tm_ < nsteps) {                                                              \
        const u16* tp_ = gT + (size_t)(tok0 + tm_) * 128 + fq * 8;                     \
        t1f[0] = *(const bf16x8*)(tp_); t1f[1] = *(const bf16x8*)(tp_ + 32);           \
        t2f[0] = *(const bf16x8*)(tp_ + 64); t2f[1] = *(const bf16x8*)(tp_ + 96);      \
      } else { t1f[0] = t1f[1] = t2f[0] = t2f[1] = (bf16x8){0, 0, 0, 0, 0, 0, 0, 0}; } \
    }
    SCAN_LOAD(0);
      {
#pragma unroll
        for (int n2 = 0; n2 < 2; ++n2) {
          f32x4 xw = {0.f, 0.f, 0.f, 0.f}, xa = {0.f, 0.f, 0.f, 0.f};
          xw = __builtin_amdgcn_mfma_f32_16x16x32_bf16(w2f[n2][0], t1f[0], xw, 0, 0, 0);
          xw = __builtin_amdgcn_mfma_f32_16x16x32_bf16(w2f[n2][1], t1f[1], xw, 0, 0, 0);
          xa = __builtin_amdgcn_mfma_f32_16x16x32_bf16(a2f[n2][0], t2f[0], xa, 0, 0, 0);
          xa = __builtin_amdgcn_mfma_f32_16x16x32_bf16(a2f[n2][1], t2f[1], xa, 0, 0, 0);
          const int o_ = (lmt * 16 + fr) * 64 + lnh * 32 + n2 * 16 + fq * 4;
          *(float4*)(Lwa + o_) = make_float4(xw[0], xw[1], xw[2], xw[3]);
          *(float4*)(Lwa + 4096 + o_) = make_float4(xa[0], xa[1], xa[2], xa[3]);
        }
      }
    __syncthreads();
    for (int c = 0; c < nch; ++c) {
      uint4 zc = cz;
      {
        float r[8], k[8], v[8], lw[8], a[8];
        unpack8(cr, r); unpack8(ck, k); unpack8(cv, v);
        {
          const float4 x0 = *(const float4*)(Lwa + tt * 64 + c8), x1 = *(const float4*)(Lwa + tt * 64 + c8 + 4);
          const float4 y0 = *(const float4*)(Lwa + 4096 + tt * 64 + c8), y1 = *(const float4*)(Lwa + 4096 + tt * 64 + c8 + 4);
          const float xw_[8] = {x0.x, x0.y, x0.z, x0.w, x1.x, x1.y, x1.z, x1.w};
          const float xa_[8] = {y0.x, y0.y, y0.z, y0.w, y1.x, y1.y, y1.z, y1.w};
#pragma unroll
          for (int j = 0; j < 8; ++j) {
            lw[j] = -0.60653066f * sigmoidf_(cw0[j] + xw_[j]);
            a[j] = sigmoidf_(ca0[j] + xa_[j]);
          }
        }
        float kkv[8], kp[8], w[8], bon = 0.f, ss = 0.f, kr = 0.f;
#pragma unroll
        for (int j = 0; j < 8; ++j) {
          kkv[j] = k[j] * ckk[j]; ss += kkv[j] * kkv[j];
          kp[j] = k[j] * (1.f + (a[j] - 1.f) * cka[j]);
          bon += r[j] * kp[j] * crk[j];
          kr += r[j] * kp[j];
          w[j] = __expf(lw[j]);
        }
        ss = red8(ss); bon = red8(bon); kr = red8(kr);
        const float inv = rsqrtf(ss + 1e-12f);
        float bb[8], br = 0.f;
#pragma unroll
        for (int j = 0; j < 8; ++j) { kkv[j] *= inv; bb[j] = kkv[j] * a[j]; br += bb[j] * r[j]; }
        br = red8(br);
        const int ho = tt * 64 + c8;
        *(uint4*)(Hkk + ho) = make_uint4(packh2(kkv[0], kkv[1]), packh2(kkv[2], kkv[3]), packh2(kkv[4], kkv[5]), packh2(kkv[6], kkv[7]));
        *(uint4*)(Hb + ho) = make_uint4(packh2(bb[0], bb[1]), packh2(bb[2], bb[3]), packh2(bb[4], bb[5]), packh2(bb[6], bb[7]));
        *(uint4*)(Hw + ho) = make_uint4(packh2(w[0], w[1]), packh2(w[2], w[3]), packh2(w[4], w[5]), packh2(w[6], w[7]));
        *(uint4*)(Hk + ho) = make_uint4(packh2(kp[0], kp[1]), packh2(kp[2], kp[3]), packh2(kp[4], kp[5]), packh2(kp[6], kp[7]));
        *(uint4*)(Hwr + ho) = make_uint4(packh2(w[0] * r[0], w[1] * r[1]), packh2(w[2] * r[2], w[3] * r[3]), packh2(w[4] * r[4], w[5] * r[5]), packh2(w[6] * r[6], w[7] * r[7]));
        *(uint4*)(Hv2 + ho) = make_uint4(packh2(v[0], v[0]), packh2(v[1], v[1]), packh2(v[2], v[2]), packh2(v[3], v[3]));
        *(uint4*)(Hv2 + ho + 4) = make_uint4(packh2(v[4], v[4]), packh2(v[5], v[5]), packh2(v[6], v[6]), packh2(v[7], v[7]));
        if ((tid & 7) == 0) { Lbon[tt] = bon; *(float2*)(Lsc + tt * 2) = make_float2(br, kr); }
      }
      __syncthreads();
      if (c + 1 < nch) SCAN_LOAD(c + 1);
      {
        const int nT = min(64, nsteps - c * 64);
        const u16* pk = Hkk + kc * 8; const u16* pw = Hw + kc * 8; const u16* pb = Hb + kc * 8;
        const u16* pkp = Hk + kc * 8; const u16* pwr = Hwr + kc * 8; const unsigned* pv = Hv2 + srow;
        float* py = LY + srow * 2;
#define SCAN_LD(S, o)                                                                  \
        S##kk = *(const uint4*)(pk + (o)); S##w = *(const uint4*)(pw + (o)); S##b = *(const uint4*)(pb + (o)); \
        S##k = *(const uint4*)(pkp + (o)); S##wr = *(const uint4*)(pwr + (o)); S##v = pv[(o)];
#define H2(x) (*(const h2_t*)&(x))
#define SCAN_UPD(sreg, S, c)                                                           \
        sreg = __builtin_elementwise_fma(sreg, H2(S##w.c), __builtin_elementwise_fma(-n_, H2(S##b.c), H2(S##v) * H2(S##k.c)));
#define SCAN_STEP(S, o)                                                                \
        {                                                                              \
          float d = __builtin_amdgcn_fdot2(sa_, H2(S##kk.x), 0.f, false);              \
          float e = __builtin_amdgcn_fdot2(sa_, H2(S##wr.x), 0.f, false);              \
          d = __builtin_amdgcn_fdot2(sb_, H2(S##kk.y), d, false); e = __builtin_amdgcn_fdot2(sb_, H2(S##wr.y), e, false); \
          d = __builtin_amdgcn_fdot2(sc_, H2(S##kk.z), d, false); e = __builtin_amdgcn_fdot2(sc_, H2(S##wr.z), e, false); \
          d = __builtin_amdgcn_fdot2(sd_, H2(S##kk.w), d, false); e = __builtin_amdgcn_fdot2(sd_, H2(S##wr.w), e, false); \
          d += dppf<0xB1>(d); e += dppf<0xB1>(e);                                      \
          d += dppf<0x4E>(d); e += dppf<0x4E>(e);                                      \
          d += dppf<0x141>(d); e += dppf<0x141>(e);                                    \
          const unsigned nu_ = packh2(d, d);                                           \
          const h2_t n_ = H2(nu_);                                                     \
          SCAN_UPD(sa_, S, x) SCAN_UPD(sb_, S, y) SCAN_UPD(sc_, S, z) SCAN_UPD(sd_, S, w) \
          if (kc == 0) *(float2*)(py + 2 * (o)) = make_float2(e, d);                   \
        }
        uint4 Akk, Aw, Ab, Ak, Awr, Bkk, Bw, Bb, Bk, Bwr; unsigned Av, Bv;
        SCAN_LD(A, 0);
        for (int t = 0; t < nT; t += 2) {
          SCAN_LD(B, (t + 1) * 64);
          SCAN_STEP(A, t * 64);
          SCAN_LD(A, (t + 2) * 64);
          SCAN_STEP(B, (t + 1) * 64);
        }
#undef SCAN_UPD
#undef H2
#undef SCAN_LD
#undef SCAN_STEP
      }
      __syncthreads();
      {
        const int tl = c * 64 + tt;
        if (tl < nsteps) {
          float y[8], z[8];
          const float2 sc = *(const float2*)(Lsc + tt * 2);
          const uint4 va = *(const uint4*)(Hv2 + tt * 64 + c8), vb = *(const uint4*)(Hv2 + tt * 64 + c8 + 4);
          float vv[8];
          { const unsigned vu[8] = {va.x, va.y, va.z, va.w, vb.x, vb.y, vb.z, vb.w};
#pragma unroll
            for (int j = 0; j < 8; ++j) { h2_t t_ = *(const h2_t*)&vu[j]; vv[j] = (float)t_[0]; } }
#pragma unroll
          for (int q = 0; q < 4; ++q) {
            const float4 ed = *(const float4*)(LY + tt * 128 + (c8 + 2 * q) * 2);
            y[2 * q] = ed.x - ed.y * sc.x + vv[2 * q] * sc.y;
            y[2 * q + 1] = ed.z - ed.w * sc.x + vv[2 * q + 1] * sc.y;
          }
          float sm = y[0] + y[1] + y[2] + y[3] + y[4] + y[5] + y[6] + y[7];
          sm = red8(sm);
          const float mean = sm * (1.f / 64.f);
          float vs = 0.f;
#pragma unroll
          for (int j = 0; j < 8; ++j) { y[j] -= mean; vs += y[j] * y[j]; }
          vs = red8(vs);
          const float rstd = rsqrtf(vs * (1.f / 64.f) + 64e-5f);
          const float bon = Lbon[tt];
          unpack8(zc, z);
          float o[8];
#pragma unroll
          for (int j = 0; j < 8; ++j) {
            float t = y[j] * rstd * clg[j] + clb[j] + bon * vv[j];
            o[j] = t * z[j] * sigmoidf_(z[j]);
          }
          uint4 ov; ov.x = pack2(o[0], o[1]); ov.y = pack2(o[2], o[3]); ov.z = pack2(o[4], o[5]); ov.w = pack2(o[6], o[7]);
          *(uint4*)(YG + (size_t)(tok0 + tl) * 2048 + col0) = ov;
        }
      }
      if (c + 1 < nch)
      {
#pragma unroll
        for (int n2 = 0; n2 < 2; ++n2) {
          f32x4 xw = {0.f, 0.f, 0.f, 0.f}, xa = {0.f, 0.f, 0.f, 0.f};
          xw = __builtin_amdgcn_mfma_f32_16x16x32_bf16(w2f[n2][0], t1f[0], xw, 0, 0, 0);
          xw = __builtin_amdgcn_mfma_f32_16x16x32_bf16(w2f[n2][1], t1f[1], xw, 0, 0, 0);
          xa = __builtin_amdgcn_mfma_f32_16x16x32_bf16(a2f[n2][0], t2f[0], xa, 0, 0, 0);
          xa = __builtin_amdgcn_mfma_f32_16x16x32_bf16(a2f[n2][1], t2f[1], xa, 0, 0, 0);
          const int o_ = (lmt * 16 + fr) * 64 + lnh * 32 + n2 * 16 + fq * 4;
          *(float4*)(Lwa + o_) = make_float4(xw[0], xw[1], xw[2], xw[3]);
          *(float4*)(Lwa + 4096 + o_) = make_float4(xa[0], xa[1], xa[2], xa[3]);
        }
      }
      __syncthreads();
    }
#undef SCAN_LOAD
    *(float4*)(sout + srow * 64 + kc * 8) = make_float4((float)sa_[0], (float)sa_[1], (float)sb_[0], (float)sb_[1]);
    *(float4*)(sout + srow * 64 + kc * 8 + 4) = make_float4((float)sc_[0], (float)sc_[1], (float)sd_[0], (float)sd_[1]);
  }
}

template <int LAYER>
DEV void outproj_store(const Params& p, const float* mod, float* xmid, int m, int n, f32x4 v) {
  const float* gate = mod + (size_t)seq_of(m) * 3072 + 2048;
  float4 g4 = *(const float4*)(gate + n);
  if (LAYER == 0) {
    const float* xr = m < TP ? p.in[I_XP] + (size_t)m * 1024 : p.in[I_XS] + (size_t)(m - TP) * 1024;
    float4 x4 = *(const float4*)(xr + n);
    *(float4*)(xmid + (size_t)m * 1024 + n) = make_float4(x4.x + g4.x * v[0], x4.y + g4.y * v[1], x4.z + g4.z * v[2], x4.w + g4.w * v[3]);
  } else {
    float4 x4 = *(const float4*)(xmid + (size_t)m * 1024 + n);
    float* yo = m < TP ? p.out + OFF_Y_P + (size_t)m * 1024 : p.out + OFF_Y_S + (size_t)(m - TP) * 1024;
    const f32x4 yv = {x4.x + g4.x * v[0], x4.y + g4.y * v[1], x4.z + g4.z * v[2], x4.w + g4.w * v[3]};
    __builtin_nontemporal_store(yv, (f32x4*)(yo + n));
  }
}

template <int LAYER>
DEV void phase_outproj_main(const Params& p, char* smem) {
  const int tid = threadIdx.x, lane = tid & 63, wid = tid >> 6, wr = wid >> 2, wc = wid & 3, fr = lane & 15, fq = lane >> 4;
  char* ws = p.ws;
  const u16* A = (const u16*)(ws + 6 * SLOT);
  const u16* Bt = (const u16*)(ws + (LAYER == 0 ? WS_WT_OUTA : WS_WT_OUTB));
  const float* mod = (const float*)(ws + WS_MOD) + (size_t)LAYER * 24 * 3072;
  float* xmid = (float*)(ws + 0 * SLOT);
  f32x4 acc[8][4];
  const int xcc0 = xcc_id();
  int nxt;
  for (int ls = 0; ls < 8; ++ls) {
    const int xcd = (xcc0 + ls) & 7;
    unsigned* ctr = sched_ctr(p, LAYER == 0 ? 1 : 3, xcd);
    for (int li = sched_first(ctr, smem); li < 64; li = sched_commit(nxt, smem)) {
      nxt = sched_prefetch(ctr);
      const int item = 64 * xcd + li;
      const int m0 = (item >> 2) * 256, n0 = (item & 3) * 256;
      gemm_main256_dma(acc, A, 2048, Bt, 2048, 32, m0, n0, smem);
#pragma unroll
      for (int i = 0; i < 8; ++i)
#pragma unroll
        for (int j = 0; j < 4; ++j)
          outproj_store<LAYER>(p, mod, xmid, m0 + wr * 128 + i * 16 + fr, n0 + wc * 64 + j * 16 + fq * 4, acc[i][j]);
    }
  }
}

template <int LAYER>
DEV void phase_outproj_tail(const Params& p, char* smem) {
  const int tid = threadIdx.x, lane = tid & 63, wid = tid >> 6, wr = wid >> 1, wc = wid & 1, fr = lane & 15, fq = lane >> 4;
  char* ws = p.ws;
  const u16* A = (const u16*)(ws + 6 * SLOT);
  const u16* Bt = (const u16*)(ws + (LAYER == 0 ? WS_WT_OUTA : WS_WT_OUTB));
  const float* mod = (const float*)(ws + WS_MOD) + (size_t)LAYER * 24 * 3072;
  float* xmid = (float*)(ws + 0 * SLOT);
  f32x4 acc[4][4];
  const int xcc0 = xcc_id();
  int nxt;
  for (int ls = 0; ls < 8; ++ls) {
    const int xcd = (xcc0 + ls) & 7;
    unsigned* ctr = sched_ctr(p, LAYER == 0 ? 5 : 6, xcd);
    for (int li = sched_first(ctr, smem); li < 2; li = sched_commit(nxt, smem)) {
      nxt = sched_prefetch(ctr);
      const int item = 2 * xcd + li;
      const int m0 = (128 + (item >> 3)) * 256, n0 = (item & 7) * 128;
      gemm_main<0>(acc, A, 2048, Bt, 2048, 32, m0, n0, nullptr, nullptr, smem);
#pragma unroll
      for (int i = 0; i < 4; ++i)
#pragma unroll
        for (int j = 0; j < 4; ++j)
          outproj_store<LAYER>(p, mod, xmid, m0 + wr * 64 + i * 16 + fr, n0 + wc * 64 + j * 16 + fq * 4, acc[i][j]);
    }
  }
}

template <int LAYER>
DEV void phase_outproj(const Params& p, char* smem) {
  phase_outproj_tail<LAYER>(p, smem);
  phase_outproj_main<LAYER>(p, smem);
}

DEV void phase_norm1(const Params& p) {
  const int lane = threadIdx.x & 63, wid = threadIdx.x >> 6;
  const float* mod = (const float*)(p.ws + WS_MOD) + (size_t)24 * 3072;
  const float* xmid = (const float*)(p.ws + 0 * SLOT);
  u16* AKV = (u16*)(p.ws + 1 * SLOT);
  u16* AQ = AKV + (size_t)NTOK * 1024;
  const float* gkv = p.in[I_KVNG];
  const float* gb = p.in[I_BNG];
  for (int t = blockIdx.x * 8 + wid; t < NTOK; t += gridDim.x * 8) {
    const float* x = xmid + (size_t)t * 1024;
    const float* md = mod + (size_t)seq_of(t) * 3072;
    float4 v[4];
    float ss = 0.f;
#pragma unroll
    for (int i = 0; i < 4; ++i) {
      v[i] = *(const float4*)(x + lane * 4 + 256 * i);
      ss += v[i].x * v[i].x + v[i].y * v[i].y + v[i].z * v[i].z + v[i].w * v[i].w;
    }
    ss = wave_sum(ss);
    const float rstd = rsqrtf(ss * (1.0f / 1024.0f) + 1e-6f);
#pragma unroll
    for (int i = 0; i < 4; ++i) {
      const int c = lane * 4 + 256 * i;
      float4 g1 = *(const float4*)(gkv + c), g2 = *(const float4*)(gb + c), sh = *(const float4*)(md + c), sc = *(const float4*)(md + 1024 + c);
      float xn0 = v[i].x * rstd, xn1 = v[i].y * rstd, xn2 = v[i].z * rstd, xn3 = v[i].w * rstd;
      uint2 o;
      o.x = pack2(xn0 * g1.x, xn1 * g1.y); o.y = pack2(xn2 * g1.z, xn3 * g1.w);
      *(uint2*)(AKV + (size_t)t * 1024 + c) = o;
      o.x = pack2(xn0 * g2.x * (1.f + sc.x) + sh.x, xn1 * g2.y * (1.f + sc.y) + sh.y);
      o.y = pack2(xn2 * g2.z * (1.f + sc.z) + sh.z, xn3 * g2.w * (1.f + sc.w) + sh.w);
      *(uint2*)(AQ + (size_t)t * 1024 + c) = o;
    }
  }
}

#define QSCALE (0.08838834764831845f * 1.4426950408889634f)
DEV void phase_proj1(const Params& p, char* smem) {
  const int tid = threadIdx.x, lane = tid & 63, wid = tid >> 6, wr = wid >> 2, wc = wid & 3, fr = lane & 15, fq = lane >> 4;
  char* ws = p.ws;
  const u16* AKV = (const u16*)(ws + 1 * SLOT);
  const u16* AQ = AKV + (size_t)NTOK * 1024;
  u16* KB = (u16*)(ws + 2 * SLOT);
  u16* VB = (u16*)(ws + 3 * SLOT);
  u16* QB = (u16*)(ws + 4 * SLOT);
  u16* ZS = (u16*)(ws + 5 * SLOT);
  f32x4 acc[8][4];
  float* red = (float*)smem;
  const int xcc0 = xcc_id();
  int nxt;
  for (int ls = 0; ls < 8; ++ls) {
  const int xcd = (xcc0 + ls) & 7;
  unsigned* ctr = sched_ctr(p, 2, xcd);
  for (int li = sched_first(ctr, smem); li < 520; li = sched_commit(nxt, smem)) {
    nxt = sched_prefetch(ctr);
    const int mt = li >> 2, t = 4 * xcd + (li & 3);
    const int isq = t >> 4, nt = t & 15;
    const int m0 = mt * 256, n0 = nt * 256;
    gemm_main256_dma(acc, isq ? AQ : AKV, 1024, (const u16*)(ws + (isq ? WS_WT_INB : WS_WT_KV)), 1024, 16, m0, n0, smem);
    float rsv[8];
#pragma unroll
    for (int i = 0; i < 8; ++i) rsv[i] = 1.0f;
    if (nt < 8) {
#pragma unroll
      for (int i = 0; i < 8; ++i) {
        float ss = 0.f;
#pragma unroll
        for (int j = 0; j < 4; ++j) ss += acc[i][j][0] * acc[i][j][0] + acc[i][j][1] * acc[i][j][1] + acc[i][j][2] * acc[i][j][2] + acc[i][j][3] * acc[i][j][3];
        red[(wr * 128 + i * 16 + fr) * 16 + wc * 4 + fq] = ss;
      }
      __syncthreads();
#pragma unroll
      for (int i = 0; i < 8; ++i) {
        const int row = wr * 128 + i * 16 + fr;
        float4 ra = *(const float4*)(red + row * 16 + (wc >> 1) * 8), rb = *(const float4*)(red + row * 16 + (wc >> 1) * 8 + 4);
        float tot = ra.x + ra.y + ra.z + ra.w + rb.x + rb.y + rb.z + rb.w;
        rsv[i] = rsqrtf(tot * (1.f / 128.f) + 1e-6f) * (isq ? QSCALE : 1.0f);
      }
      __syncthreads();
      const float* gain = isq ? p.in[I_BQG] : p.in[I_KGAIN];
#pragma unroll
      for (int i = 0; i < 8; ++i) {
        const int row = wr * 128 + i * 16 + fr, m = m0 + row;
        const float rs = rsv[i];
#pragma unroll
        for (int j = 0; j < 4; ++j) {
          const int d = (wc & 1) * 64 + j * 16 + fq * 4, col = wc * 64 + j * 16 + fq * 4, n = n0 + col;
          float4 g4 = *(const float4*)(gain + d);
          f32x4 v = acc[i][j];
          float o0 = v[0] * rs * g4.x, o1 = v[1] * rs * g4.y, o2 = v[2] * rs * g4.z, o3 = v[3] * rs * g4.w;
          uint2 o; o.x = pack2(o0, o1); o.y = pack2(o2, o3);
          *(uint2*)(smem + row * 528 + col * 2) = o;
        }
      }
    } else {
#pragma unroll
      for (int i = 0; i < 8; ++i) {
        const int row = wr * 128 + i * 16 + fr, m = m0 + row;
#pragma unroll
        for (int j = 0; j < 4; ++j) {
          const int col = wc * 64 + j * 16 + fq * 4, n = n0 - 2048 + col;
          f32x4 v = acc[i][j];
          if (isq) {
            float o0 = v[0] * sigmoidf_(v[0]), o1 = v[1] * sigmoidf_(v[1]), o2 = v[2] * sigmoidf_(v[2]), o3 = v[3] * sigmoidf_(v[3]);
            uint2 o; o.x = pack2(o0, o1); o.y = pack2(o2, o3);
            *(uint2*)(smem + row * 528 + col * 2) = o;
          } else {
            uint2 o; o.x = pack2(v[0], v[1]); o.y = pack2(v[2], v[3]);
            *(uint2*)(smem + row * 528 + col * 2) = o;
          }
        }
      }
    }
    __syncthreads();
    {
      u16* bdst = isq ? (nt < 8 ? QB : ZS) : (nt < 8 ? KB : VB);
      const int nb = n0 - (nt < 8 ? 0 : 2048);
#pragma unroll 4
      for (int qq = 0; qq < 16; ++qq) {
        const int c = tid + 512 * qq, row = c >> 5, ch = c & 31;
        const uint4 v = *(const uint4*)(smem + row * 528 + ch * 16);
        *(uint4*)(bdst + (size_t)(m0 + row) * 2048 + nb + ch * 8) = v;
      }
    }
    __syncthreads();
    if (!isq) {
      const int nb = n0 - (nt < 8 ? 0 : 2048);
      float* fo = (m0 < TP) ? p.out + (nt < 8 ? OFF_K_P : OFF_V_P) + (size_t)m0 * 2048 : p.out + (nt < 8 ? OFF_K_S : OFF_V_S) + (size_t)(m0 - TP) * 2048;
      const float* gain = p.in[I_KGAIN];
#pragma unroll
      for (int half = 0; half < 2; ++half) {
        if (wr == half) {
#pragma unroll
          for (int i = 0; i < 8; ++i)
#pragma unroll
            for (int j = 0; j < 4; ++j) {
              const int row = i * 16 + fr, col = wc * 64 + j * 16 + fq * 4;
              float4 g4 = make_float4(1.f, 1.f, 1.f, 1.f);
              if (nt < 8) g4 = *(const float4*)(gain + (wc & 1) * 64 + j * 16 + fq * 4);
              const float rs = rsv[i];
              f32x4 v = acc[i][j];
              *(float4*)(smem + row * 1040 + col * 4) = make_float4(v[0] * rs * g4.x, v[1] * rs * g4.y, v[2] * rs * g4.z, v[3] * rs * g4.w);
            }
        }
        __syncthreads();
#pragma unroll 4
        for (int qq = 0; qq < 16; ++qq) {
          const int c = tid + 512 * qq, row = c >> 6, ch = c & 63;
          const f32x4 v = *(const f32x4*)(smem + row * 1040 + ch * 16);
          __builtin_nontemporal_store(v, (f32x4*)(fo + (size_t)(half * 128 + row) * 2048 + nb + ch * 4));
        }
        __syncthreads();
      }
    }
  }
  }
}

DEV unsigned off_b(unsigned row, unsigned ch) { return 256u * row + 16u * (ch ^ (((row & 3) << 2) | ((row >> 2) & 3))); }

DEV void phase_attn(const Params& p, char* smem) {
  const int tid = threadIdx.x, lane = tid & 63, w = tid >> 6, fr = lane & 15, fq = lane >> 4;
  char* ws = p.ws;
  const u16* KB = (const u16*)(ws + 2 * SLOT);
  const u16* VB = (const u16*)(ws + 3 * SLOT);
  const u16* QB = (const u16*)(ws + 4 * SLOT);
  const u16* ZS = (const u16*)(ws + 5 * SLOT);
  u16* OG = (u16*)(ws + 6 * SLOT);
  const int lrow = tid >> 4, lch = tid & 15;
  const unsigned lw0 = off_b(lrow, lch), lw1 = off_b(lrow + 32, lch);
  const int tq = (lane & 15) >> 2, tp = lane & 3;

  for (int item = blockIdx.x; item < 4096 + 256; item += gridDim.x) {
    int b, h, nq, qpos0, tokq0, ntiles, nkeys, tokk0; bool sample;
    if (item < 4096) {
      const int qblk = 31 - (item >> 7), bh = item & 127;
      b = bh >> 4; h = bh & 15; nq = 128; qpos0 = qblk * 128; tokq0 = b * 4096 + qpos0; ntiles = 2 * qblk + 2; nkeys = qpos0 + 128; tokk0 = b * 4096; sample = false;
    } else {
      const int bh = item - 4096;
      b = bh >> 4; h = bh & 15; nq = 32; qpos0 = 1024; tokq0 = TP + b * 32; ntiles = 17; nkeys = 1056; tokk0 = TP + b * 32 - 1024; sample = true;
    }
    const bool wactive = (w * 16) < nq;
    int* dflag = (int*)(smem + 65536);
    __syncthreads();
    if (lane == 0) dflag[w] = wactive ? 0 : 1;
    bool wdone = !wactive;
    const int qp = qpos0 + w * 16 + fr;
    const int qwmax = qpos0 + w * 16 + 15;
    bf16x8 qf[4];
#pragma unroll
    for (int ks = 0; ks < 4; ++ks) {
      if (wactive) qf[ks] = *(const bf16x8*)(QB + (size_t)(tokq0 + w * 16 + fr) * 2048 + h * 128 + ks * 32 + fq * 8);
      else qf[ks] = (bf16x8){0, 0, 0, 0, 0, 0, 0, 0};
    }
    f32x4 O[8];
#pragma unroll
    for (int dt = 0; dt < 8; ++dt) O[dt] = (f32x4){0, 0, 0, 0};
    float carry = 0.f;

    uint4 lk0, lk1, lv0, lv1;
#define ATT_LOAD(kb)                                                                                  \
    {                                                                                                 \
      const int kx0_ = (kb) * 64 + lrow, kx1_ = kx0_ + 32;                                            \
      if (sample && (kb) < 16) {                                                                      \
        const float* ck_ = p.in[I_CK] + ((size_t)(b * 1024 + kx0_) * 16 + h) * 128 + lch * 8;         \
        const float* cv_ = p.in[I_CV] + ((size_t)(b * 1024 + kx0_) * 16 + h) * 128 + lch * 8;         \
        float4 a_ = *(const float4*)ck_, b_ = *(const float4*)(ck_ + 4);                              \
        float4 c_ = *(const float4*)(ck_ + 32 * 2048), d_ = *(const float4*)(ck_ + 32 * 2048 + 4);    \
        lk0 = make_uint4(pack2(a_.x, a_.y), pack2(a_.z, a_.w), pack2(b_.x, b_.y), pack2(b_.z, b_.w)); \
        lk1 = make_uint4(pack2(c_.x, c_.y), pack2(c_.z, c_.w), pack2(d_.x, d_.y), pack2(d_.z, d_.w)); \
        a_ = *(const float4*)cv_; b_ = *(const float4*)(cv_ + 4);                                     \
        c_ = *(const float4*)(cv_ + 32 * 2048); d_ = *(const float4*)(cv_ + 32 * 2048 + 4);           \
        lv0 = make_uint4(pack2(a_.x, a_.y), pack2(a_.z, a_.w), pack2(b_.x, b_.y), pack2(b_.z, b_.w)); \
        lv1 = make_uint4(pack2(c_.x, c_.y), pack2(c_.z, c_.w), pack2(d_.x, d_.y), pack2(d_.z, d_.w)); \
      } else {                                                                                        \
        const size_t o0_ = (size_t)(tokk0 + kx0_) * 2048 + h * 128 + lch * 8;                         \
        const size_t o1_ = o0_ + (size_t)32 * 2048;                                                   \
        if (kx0_ < nkeys) { lk0 = *(const uint4*)(KB + o0_); lv0 = *(const uint4*)(VB + o0_); }       \
        else { lk0 = make_uint4(0, 0, 0, 0); lv0 = lk0; }                                             \
        if (kx1_ < nkeys) { lk1 = *(const uint4*)(KB + o1_); lv1 = *(const uint4*)(VB + o1_); }       \
        else { lk1 = make_uint4(0, 0, 0, 0); lv1 = lk1; }                                             \
      }                                                                                               \
    }
#define ATT_STORE(st)                                                                                 \
    {                                                                                                 \
      char* sK_ = smem + (st) * 32768; char* sV_ = sK_ + 16384;                                       \
      *(uint4*)(sK_ + lw0) = lk0; *(uint4*)(sK_ + lw1) = lk1;                                         \
      *(uint4*)(sV_ + lw0) = lv0; *(uint4*)(sV_ + lw1) = lv1;                                         \
    }
    ATT_LOAD(ntiles - 1);
    ATT_STORE(0);
    __syncthreads();
    for (int it = 0; it < ntiles; ++it) {
      const int kb = ntiles - 1 - it, st = it & 1;
      if (it + 1 < ntiles) ATT_LOAD(kb - 1);
      if (!wdone && kb * 64 < qwmax) {
        const char* sK = smem + st * 32768;
        const char* sV = sK + 16384;
        f32x4 S[4];
#pragma unroll
        for (int mt = 0; mt < 4; ++mt) S[mt] = (f32x4){0, 0, 0, 0};
#pragma unroll
        for (int ks = 0; ks < 4; ++ks)
#pragma unroll
          for (int mt = 0; mt < 4; ++mt) {
            bf16x8 a = *(const bf16x8*)(sK + off_b(mt * 16 + fr, ks * 4 + fq));
            S[mt] = __builtin_amdgcn_mfma_f32_16x16x32_bf16(a, qf[ks], S[mt], 0, 0, 0);
          }
        bf16x8 wf[2];
#define ATT_ELEM(MASKED) \
        { \
          float ee[4][4], tot[4], hi[4]; \
_Pragma("unroll") \
          for (int mt = 0; mt < 4; ++mt) { \
            const int kbase = kb * 64 + mt * 16 + fq * 4; \
            float ls[4]; \
_Pragma("unroll") \
            for (int jj = 0; jj < 4; ++jj) { \
              const float u = S[mt][jj]; \
              const bool valid = !(MASKED) || ((kbase + jj) < qp); \
              const float l = -__builtin_amdgcn_logf(1.0f + __builtin_amdgcn_exp2f(u)); \
              ls[jj] = valid ? l : 0.f; \
              ee[mt][jj] = valid ? (u + l) : -1e30f; \
            } \
            const float x3 = ls[3], x2 = x3 + ls[2], x1 = x2 + ls[1], seg = x1 + ls[0]; \
            ee[mt][2] += x3; ee[mt][1] += x2; ee[mt][0] += x1; \
            const float t1 = __shfl_xor(seg, 16), t2 = __shfl_xor(seg, 32), t3 = __shfl_xor(t1, 32); \
            tot[mt] = seg + t1 + t2 + t3; \
            hi[mt] = fq == 0 ? (t1 + t2 + t3) : fq == 1 ? (t2 + t3) : fq == 2 ? t1 : 0.f; \
          } \
          float run = carry; \
          float wv[4][4]; \
_Pragma("unroll") \
          for (int mt = 3; mt >= 0; --mt) { \
            const float base = run + hi[mt]; \
            run += tot[mt]; \
_Pragma("unroll") \
            for (int jj = 0; jj < 4; ++jj) wv[mt][jj] = __builtin_amdgcn_exp2f(ee[mt][jj] + base); \
          } \
          carry = run; \
          if (__all(carry < -150.0f)) { wdone = true; if (lane == 0) dflag[w] = 1; } \
_Pragma("unroll") \
          for (int p2 = 0; p2 < 2; ++p2) { \
            uint4 pk; \
            pk.x = pack2(wv[2 * p2][0], wv[2 * p2][1]); pk.y = pack2(wv[2 * p2][2], wv[2 * p2][3]); \
            pk.z = pack2(wv[2 * p2 + 1][0], wv[2 * p2 + 1][1]); pk.w = pack2(wv[2 * p2 + 1][2], wv[2 * p2 + 1][3]); \
            wf[p2] = *(bf16x8*)&pk; \
          } \
        }
        if (kb * 64 + 63 < qpos0 + w * 16) { ATT_ELEM(0) } else { ATT_ELEM(1) }
#undef ATT_ELEM
#pragma unroll
        for (int p2 = 0; p2 < 2; ++p2)
#pragma unroll
          for (int dt = 0; dt < 8; ++dt) {
            const unsigned r0 = 32 * p2 + 4 * fq + tq, r1 = r0 + 16;
            const unsigned ch = 2 * dt + (tp >> 1);
            const char* a0 = sV + off_b(r0, ch) + 8 * (tp & 1);
            const char* a1 = sV + off_b(r1, ch) + 8 * (tp & 1);
            s16x4 lo = __builtin_amdgcn_ds_read_tr16_b64_v4i16((s16x4 __attribute__((address_space(3)))*)(a0));
            s16x4 hi4 = __builtin_amdgcn_ds_read_tr16_b64_v4i16((s16x4 __attribute__((address_space(3)))*)(a1));
            bf16x8 a = {lo[0], lo[1], lo[2], lo[3], hi4[0], hi4[1], hi4[2], hi4[3]};
            O[dt] = __builtin_amdgcn_mfma_f32_16x16x32_bf16(a, wf[p2], O[dt], 0, 0, 0);
          }
      }
      if (it + 1 < ntiles) ATT_STORE(st ^ 1);
      __syncthreads();
      {
        const int4 f0 = *(const int4*)dflag, f1 = *(const int4*)(dflag + 4);
        if (f0.x & f0.y & f0.z & f0.w & f1.x & f1.y & f1.z & f1.w) break;
      }
    }
#undef ATT_LOAD
#undef ATT_STORE
    if (wactive) {
      const size_t rowoff = (size_t)(tokq0 + w * 16 + fr) * 2048 + h * 128;
#pragma unroll
      for (int dt = 0; dt < 8; ++dt) {
        const int d = dt * 16 + fq * 4;
        uint2 z = *(const uint2*)(ZS + rowoff + d);
        f32x4 v = O[dt];
        uint2 o;
        o.x = pack2(v[0] * bflo(z.x), v[1] * bfhi(z.x)); o.y = pack2(v[2] * bflo(z.y), v[3] * bfhi(z.y));
        *(uint2*)(OG + rowoff + d) = o;
      }
    }
  }
}


DEV void grid_barrier(unsigned* bar, unsigned target) {
  __syncthreads();
  if (threadIdx.x == 0) {
    __builtin_amdgcn_fence(__ATOMIC_RELEASE, "agent");
    asm volatile("s_waitcnt vmcnt(0)" ::: "memory");
    __hip_atomic_fetch_add(bar, 1u, __ATOMIC_RELAXED, __HIP_MEMORY_SCOPE_AGENT);
    while (__hip_atomic_load(bar, __ATOMIC_RELAXED, __HIP_MEMORY_SCOPE_AGENT) < target) __builtin_amdgcn_s_sleep(1);
    __builtin_amdgcn_fence(__ATOMIC_ACQUIRE, "agent");
    asm volatile("s_waitcnt vmcnt(0)" ::: "memory");
  }
  __syncthreads();
}

__global__ void __launch_bounds__(NTHREADS) __attribute__((target("no-packed-fp32-ops"))) mega(Params p, int lo, int hi) {
  __shared__ __attribute__((aligned(16))) char smem[147456];
  cg::grid_group grid = cg::this_grid();
#ifndef PROBE_DOUBLE
#define PROBE_DOUBLE -1
#endif
#define RUN_PHASE(k, call) if ((k) >= lo && (k) < hi) { if ((k) > lo) { if ((k) == lo + 1) grid.sync(); else grid_barrier((unsigned*)(p.ws + WS_BAR), (unsigned)((k) - lo - 1) * gridDim.x); } call; }
  RUN_PHASE(0, phase_prep(p, smem))
  RUN_PHASE(1, phase_norm0(p))
  RUN_PHASE(2, phase_proj0(p, smem))
  RUN_PHASE(3, phase_scan(p, smem))
  RUN_PHASE(4, phase_outproj<0>(p, smem))
  RUN_PHASE(5, phase_norm1(p))
  RUN_PHASE(6, phase_proj1(p, smem))
  RUN_PHASE(7, phase_attn(p, smem))
  RUN_PHASE(8, phase_outproj<1>(p, smem))
}

#ifndef N_LAUNCH_MODE
#define N_LAUNCH_MODE 1
#endif

extern "C" void kernel_launch(void* const* d_in, const int* in_sizes, int n_in, void* d_out, int out_size, void* d_ws, size_t ws_size,
                              hipStream_t stream) {
  Params p{};
  for (int i = 0; i < 36; ++i) p.in[i] = (const float*)d_in[i];
  p.out = (float*)d_out;
  p.ws = (char*)d_ws;
  static int grid_blocks = 0;
  if (!grid_blocks) {
    int dev = 0, cus = 0, per_cu = 0;
    hipGetDevice(&dev);
    hipDeviceGetAttribute(&cus, hipDeviceAttributeMultiprocessorCount, dev);
    hipOccupancyMaxActiveBlocksPerMultiprocessor(&per_cu, mega, NTHREADS, 0);
    if (per_cu < 1) per_cu = 1;
    grid_blocks = cus * per_cu;
  }
  if (ws_size < WS_END) { fprintf(stderr, "workspace too small: %zu < %llu\n", ws_size, (unsigned long long)WS_END); return; }
#if N_LAUNCH_MODE == 1
  int lo = 0, hi = 9;
  hipMemsetAsync((char*)d_ws + WS_BAR, 0, 256, stream);
  void* args[] = {&p, &lo, &hi};
  hipError_t e = hipLaunchCooperativeKernel((void*)mega, dim3(grid_blocks), dim3(NTHREADS), args, 0, stream);
  if (e != hipSuccess) fprintf(stderr, "cooperative launch failed: %s (grid %d)\n", hipGetErrorString(e), grid_blocks);
#else
  for (int ph = 0; ph < 9; ++ph) hipLaunchKernelGGL(mega, dim3(grid_blocks), dim3(NTHREADS), 0, stream, p, ph, ph + 1);
#endif
}
```
